# Optimizing an MI355X kernel written in HIP

```python
import math
import jax, jax.numpy as jnp
from jax import lax
import numpy as np

D_MODEL = 1024
BATCH = 4
SEQ = 8192
DEPTH = 1

MIX_WIDTH = D_MODEL
HEAD_DIM = 64
RWKV_WIDTH = MIX_WIDTH // 2
RWKV_HEADS = RWKV_WIDTH // HEAD_DIM
MOBA_WIDTH = MIX_WIDTH - RWKV_WIDTH
MOBA_HEADS = MOBA_WIDTH // HEAD_DIM
DECAY_LORA = 64
ICLR_LORA = 64
GATE_LORA = 128
DECAY_SCALE = math.exp(-0.5)
GN_EPS = 64e-5
MOBA_BLOCK = 256
MOBA_TOPK = 3
MOBA_Q_CHUNK = 32
MEM_LEN = 256
XATTN_HEADS = 4
XATTN_HEAD_DIM = D_MODEL // XATTN_HEADS
D_FF = 4 * D_MODEL
NORM_EPS = 1e-6
RWKV_IN = 3 * RWKV_WIDTH + DECAY_LORA + ICLR_LORA + GATE_LORA
MOBA_IN = 3 * MOBA_WIDTH
IN_WIDTH = RWKV_IN + MOBA_IN

kernel_name = "hymba_rwkv7_moba_xattn_sqrelu"


def rms_norm(x, g):
    xf = x.astype(jnp.float32)
    y = xf * lax.rsqrt(jnp.mean(xf * xf, axis=-1, keepdims=True) + NORM_EPS)
    return y * g.astype(jnp.float32)


def rwkv7_time_mix(z, mu, w0, w_up, a0, a_up, g_up, k_k, k_a, r_k, ln_w, ln_b):
    z = z.astype(jnp.float32)
    B, T, _ = z.shape
    H, N = RWKV_HEADS, HEAD_DIM
    z_prev = jnp.pad(z, ((0, 0), (1, 0), (0, 0)))[:, :-1]
    z = z + (z_prev - z) * mu
    r, k, v, wd, ad, gd = jnp.split(
        z, [RWKV_WIDTH, 2 * RWKV_WIDTH, 3 * RWKV_WIDTH,
            3 * RWKV_WIDTH + DECAY_LORA, 3 * RWKV_WIDTH + DECAY_LORA + ICLR_LORA], axis=-1)
    decay = jnp.exp(-DECAY_SCALE * jax.nn.sigmoid(w0 + jnp.tanh(wd) @ w_up))
    a = jax.nn.sigmoid(a0 + ad @ a_up)
    g = jax.nn.sigmoid(gd) @ g_up
    kk = k * k_k
    k = k * (1.0 + (a - 1.0) * k_a)
    hd = lambda t: t.reshape(B, T, H, N)
    r, k, v, decay, a, kk = hd(r), hd(k), hd(v), hd(decay), hd(a), hd(kk)
    kk = kk / jnp.maximum(jnp.sqrt(jnp.sum(kk * kk, axis=-1, keepdims=True)), 1e-12)

    def step(S, inp):
        r_t, w_t, k_t, v_t, kk_t, a_t = inp
        sa = jnp.einsum('bhvk,bhk->bhv', S, -kk_t)
        S = (S * w_t[:, :, None, :] + sa[..., None] * (kk_t * a_t)[:, :, None, :]
             + v_t[..., None] * k_t[:, :, None, :])
        y = jnp.einsum('bhvk,bhk->bhv', S, r_t)
        return S, y

    tm = lambda t: jnp.swapaxes(t, 0, 1)
    S0 = jnp.zeros((B, H, N, N), jnp.float32)
    _, ys = lax.scan(step, S0, (tm(r), tm(decay), tm(k), tm(v), tm(kk), tm(a)))
    y = tm(ys)
    m = jnp.mean(y, axis=-1, keepdims=True)
    var = jnp.mean((y - m) ** 2, axis=-1, keepdims=True)
    y = ((y - m) * lax.rsqrt(var + GN_EPS)).reshape(B, T, RWKV_WIDTH) * ln_w + ln_b
    bonus = jnp.sum(r * k * r_k, axis=-1, keepdims=True) * v
    return (y + bonus.reshape(B, T, RWKV_WIDTH)) * g


def moba_attention(q, k, v):
    B, T, _ = q.shape
    H, D, BLK, QC = MOBA_HEADS, HEAD_DIM, MOBA_BLOCK, MOBA_Q_CHUNK
    Tp = ((T + BLK - 1) // BLK) * BLK
    nb = Tp // BLK
    nc = Tp // QC
    pad = lambda t: jnp.pad(t, ((0, 0), (0, Tp - T), (0, 0))).reshape(B, Tp, H, D).transpose(0, 2, 1, 3)
    q, k, v = pad(q), pad(k), pad(v)
    kb = k.reshape(B, H, nb, BLK, D)
    vb = v.reshape(B, H, nb, BLK, D)
    kmean = jnp.mean(kb.astype(jnp.float32), axis=3)
    gate = jnp.einsum('bhtd,bhnd->bhtn', q.astype(jnp.float32), kmean)
    own = jnp.arange(Tp) // BLK
    past = jnp.arange(nb)[None, :] < own[:, None]
    gate = jnp.where(past, gate, -jnp.inf)
    n_sel = min(MOBA_TOPK, nb)
    _, idx = lax.top_k(gate, n_sel)
    valid = idx < own[None, None, :, None]
    scale = HEAD_DIM ** -0.5
    chunk = lambda t: jnp.moveaxis(t.reshape(B, H, nc, QC, *t.shape[3:]), 2, 0)
    gather = jax.vmap(jax.vmap(lambda t, i: t[i]))

    def attend(args):
        c, q_c, idx_c, val_c = args
        q0 = c * QC
        ob = q0 // BLK
        k_own = lax.dynamic_index_in_dim(kb, ob, axis=2, keepdims=False)
        v_own = lax.dynamic_index_in_dim(vb, ob, axis=2, keepdims=False)
        k_sel = gather(kb, idx_c)
        v_sel = gather(vb, idx_c)
        s_sel = jnp.einsum('bhqd,bhqnkd->bhqnk', q_c, k_sel).astype(jnp.float32) * scale
        s_sel = jnp.where(val_c[..., None], s_sel, -jnp.inf).reshape(B, H, QC, n_sel * BLK)
        s_own = jnp.einsum('bhqd,bhkd->bhqk', q_c, k_own).astype(jnp.float32) * scale
        qpos = q0 + jnp.arange(QC)
        kpos = ob * BLK + jnp.arange(BLK)
        s_own = jnp.where(kpos[None, :] <= qpos[:, None], s_own, -jnp.inf)
        p = jax.nn.softmax(jnp.concatenate([s_sel, s_own], axis=-1), axis=-1)
        p_sel = p[..., :n_sel * BLK].reshape(B, H, QC, n_sel, BLK)
        p_own = p[..., n_sel * BLK:]
        return (jnp.einsum('bhqnk,bhqnkd->bhqd', p_sel, v_sel.astype(jnp.float32))
                + jnp.einsum('bhqk,bhkd->bhqd', p_own, v_own.astype(jnp.float32)))

    outs = lax.map(attend, (jnp.arange(nc), chunk(q), chunk(idx), chunk(valid)))
    out = jnp.moveaxis(outs, 0, 2).reshape(B, H, Tp, D)[:, :, :T]
    return out.transpose(0, 2, 1, 3).reshape(B, T, MOBA_WIDTH)


def memory_cross_attention(u, m, w_q, w_kv, w_o):
    B, T, _ = u.shape
    q = (u @ w_q).reshape(B, T, XATTN_HEADS, XATTN_HEAD_DIM)
    k, v = jnp.split(m @ w_kv, 2, axis=-1)
    k = k.reshape(B, MEM_LEN, XATTN_HEADS, XATTN_HEAD_DIM)
    v = v.reshape(B, MEM_LEN, XATTN_HEADS, XATTN_HEAD_DIM)
    s = jnp.einsum('bthd,bmhd->bhtm', q, k).astype(jnp.float32) * (XATTN_HEAD_DIM ** -0.5)
    p = jax.nn.softmax(s, axis=-1)
    o = jnp.einsum('bhtm,bmhd->bthd', p, v.astype(jnp.float32)).reshape(B, T, D_MODEL)
    return o @ w_o


def setup_inputs(seed: int = 0) -> dict:
    key = jax.random.key(seed)
    ks = jax.random.split(key, 26)
    L = DEPTH
    f32 = jnp.float32
    nrm = lambda k, shape, s: jax.random.normal(k, shape, f32) * s
    return {
        "x": nrm(ks[0], (BATCH, SEQ, D_MODEL), 1.0),
        "mem": nrm(ks[1], (BATCH, MEM_LEN, D_MODEL), 1.0),
        "norm_mix": 1.0 + nrm(ks[2], (L, D_MODEL), 0.02),
        "w_in": nrm(ks[3], (L, D_MODEL, IN_WIDTH), D_MODEL ** -0.5),
        "rwkv_mu": jax.random.uniform(ks[4], (L, RWKV_IN), f32),
        "rwkv_w0": jax.random.uniform(ks[5], (L, RWKV_WIDTH), f32, -3.0, 1.0),
        "rwkv_w_up": nrm(ks[6], (L, DECAY_LORA, RWKV_WIDTH), 0.1 * DECAY_LORA ** -0.5),
        "rwkv_a0": nrm(ks[7], (L, RWKV_WIDTH), 0.1),
        "rwkv_a_up": nrm(ks[8], (L, ICLR_LORA, RWKV_WIDTH), 0.1 * ICLR_LORA ** -0.5),
        "rwkv_g_up": nrm(ks[9], (L, GATE_LORA, RWKV_WIDTH), GATE_LORA ** -0.5),
        "rwkv_k_k": 0.85 + nrm(ks[10], (L, RWKV_WIDTH), 0.02),
        "rwkv_k_a": 1.0 + nrm(ks[11], (L, RWKV_WIDTH), 0.02),
        "rwkv_r_k": nrm(ks[12], (L, RWKV_HEADS, HEAD_DIM), 0.1),
        "rwkv_ln_w": 1.0 + nrm(ks[13], (L, RWKV_WIDTH), 0.02),
        "rwkv_ln_b": nrm(ks[14], (L, RWKV_WIDTH), 0.01),
        "w_mix_out": nrm(ks[15], (L, MIX_WIDTH, D_MODEL), MIX_WIDTH ** -0.5),
        "norm_xattn": 1.0 + nrm(ks[16], (L, D_MODEL), 0.02),
        "norm_mem": 1.0 + nrm(ks[17], (L, D_MODEL), 0.02),
        "w_xq": nrm(ks[18], (L, D_MODEL, D_MODEL), D_MODEL ** -0.5),
        "w_xkv": nrm(ks[19], (L, D_MODEL, 2 * D_MODEL), D_MODEL ** -0.5),
        "w_xo": nrm(ks[20], (L, D_MODEL, D_MODEL), D_MODEL ** -0.5),
        "norm_ffn": 1.0 + nrm(ks[21], (L, D_MODEL), 0.02),
        "w_ff1": nrm(ks[22], (L, D_MODEL, D_FF), D_MODEL ** -0.5),
        "w_ff2": nrm(ks[23], (L, D_FF, D_MODEL), D_FF ** -0.5),
        "norm_final": 1.0 + nrm(ks[24], (D_MODEL,), 0.02),
    }


def reference(x, mem, norm_mix, w_in, rwkv_mu, rwkv_w0, rwkv_w_up, rwkv_a0, rwkv_a_up,
              rwkv_g_up, rwkv_k_k, rwkv_k_a, rwkv_r_k, rwkv_ln_w, rwkv_ln_b, w_mix_out,
              norm_xattn, norm_mem, w_xq, w_xkv, w_xo, norm_ffn, w_ff1, w_ff2, norm_final):
    h = x.astype(jnp.float32)
    for l in range(DEPTH):
        u = rms_norm(h, norm_mix[l])
        z = u @ w_in[l]
        y_rwkv = rwkv7_time_mix(z[..., :RWKV_IN], rwkv_mu[l], rwkv_w0[l], rwkv_w_up[l],
                                rwkv_a0[l], rwkv_a_up[l], rwkv_g_up[l], rwkv_k_k[l],
                                rwkv_k_a[l], rwkv_r_k[l], rwkv_ln_w[l], rwkv_ln_b[l])
        q, k, v = jnp.split(z[..., RWKV_IN:], 3, axis=-1)
        y_moba = moba_attention(q, k, v)
        h = h + jnp.concatenate([y_rwkv, y_moba], axis=-1) @ w_mix_out[l]
        h = h + memory_cross_attention(rms_norm(h, norm_xattn[l]), rms_norm(mem, norm_mem[l]),
                                       w_xq[l], w_xkv[l], w_xo[l])
        a = jnp.square(jax.nn.relu(rms_norm(h, norm_ffn[l]) @ w_ff1[l]))
        h = h + a @ w_ff2[l]
    return rms_norm(h, norm_final).astype(x.dtype)
```

```cpp
#include <hip/hip_runtime.h>
#include <cstdio>
#include <cstdint>
#include <cmath>
namespace pg8 {
#define PG8_LAS __attribute__((address_space(3)))
typedef unsigned short bf16_t;
typedef short bf16x8 __attribute__((ext_vector_type(8)));
typedef float f32x4 __attribute__((ext_vector_type(4)));
typedef float f32x2 __attribute__((ext_vector_type(2)));
typedef unsigned u32x4 __attribute__((ext_vector_type(4)));
typedef unsigned u32x2 __attribute__((ext_vector_type(2)));
constexpr int BM = 256, BK = 64, HALF = 128, HTB = HALF * BK * 2  , STAGE_BYTES = 8 * HTB, NXCD = 8, WGM = 8;

__host__ __device__ __forceinline__ int lds_byte(int r, int c) { const int st = (r >> 4) * 2 + (c >> 5), rr = r & 15, cc = c & 31, ob = rr * 64 + cc * 2; return st * 1024 + (ob ^ (((ob >> 9) & 1) << 5)); }
__host__ __device__ __forceinline__ void stage_rc(int b, int& R, int& C) { const int st = b / 1024, sb = b % 1024, swz = sb ^ (((sb >> 9) & 1) << 5); R = (st >> 1) * 16 + swz / 64; C = (st & 1) * 32 + (swz % 64) / 2; }
__host__ __device__ __forceinline__ int perm32(int rho) { const int n = rho >> 4, i = rho & 15; return 8 * (i >> 2) + 4 * n + (i & 3); }

struct Unit { int pm, pn, z; size_t a_off, b_off; };
struct Gemm { const char* A; const char* Bt; int lda, ldb, K; };

__host__ __device__ __forceinline__ void tile_map(int L, int nM, int nN, int& pm, int& pn) {
    const int nwg = nM * nN; int wgid = L;
    { const int q = nwg / NXCD, r = nwg % NXCD, xcd = wgid % NXCD, off = wgid / NXCD; wgid = (xcd < r ? xcd * (q + 1) : r * (q + 1) + (xcd - r) * q) + off; }
    const int nig = WGM * nN, gid = wgid / nig, fm = gid * WGM, gsz = (nM - fm) < WGM ? (nM - fm) : WGM;
    pm = fm + ((wgid % nig) % gsz); pn = (wgid % nig) / gsz;
}

__device__ __forceinline__ unsigned cvt_pk_bf16(float lo, float hi) { unsigned r; asm volatile("v_cvt_pk_bf16_f32 %0, %1, %2" : "=v"(r) : "v"(lo), "v"(hi)); return r; }

template <class Epi, class Sched, bool ALIGN_EPI>
__device__ __forceinline__ void gemm_phase(PG8_LAS unsigned char* lds, const Gemm g, const Sched& S, const Epi& E, const int wid) {
    int lane_; asm volatile("v_mbcnt_lo_u32_b32 %0, -1, 0\n\tv_mbcnt_hi_u32_b32 %0, -1, %0" : "=v"(lane_));
    const int lane = lane_, tid = wid * 64 + lane, wr = wid >> 2, wc = wid & 3, fr = lane & 15, fq = lane >> 4;
    const int K = g.K, nt = K / BK;
    unsigned voffA[2], voffB[2];
#pragma unroll
    for (int i = 0; i < 2; ++i) { int R, C; stage_rc(tid * 16 + i * 8192, R, C); const int Rb = Epi::PERM ? ((R & ~31) + perm32(R & 31)) : R;
        voffA[i] = (unsigned)(R * g.lda + C) * 2u; voffB[i] = (unsigned)(Rb * g.ldb + C) * 2u; }
    const size_t kstep = (size_t)(BK * 2);
    const size_t hstepA = (size_t)HALF * g.lda * 2, hstepB = (size_t)HALF * g.ldb * 2;
    const unsigned ldsw = (unsigned)wid * 1024u;
    const int aoff = lds_byte(wr * 64 + fr, fq * 8), boff = lds_byte(wc * 32 + fr, fq * 8);
#define PG8_SA(b, h) (((b) * 2 + (h)) * HTB)
#define PG8_SB(b, h) ((4 + (b) * 2 + (h)) * HTB)
#define PG8_STAGE(bufoff, gbase, voff) do { _Pragma("unroll") for (int _i = 0; _i < 2; ++_i) \
        __builtin_amdgcn_global_load_lds((const unsigned*)((const char*)(gbase) + (voff)[_i]), (PG8_LAS unsigned*)(lds + (bufoff) + ldsw + _i * 8192), 16, 0, 0); } while (0)
#define PG8_LDA(dst, b, h) do { _Pragma("unroll") for (int m = 0; m < 4; ++m) _Pragma("unroll") for (int k = 0; k < 2; ++k) dst[m][k] = *(const PG8_LAS bf16x8*)(lds + PG8_SA(b, h) + aoff + m * 2048 + k * 1024); } while (0)
#define PG8_LDB(dst, b, h) do { _Pragma("unroll") for (int n = 0; n < 2; ++n) _Pragma("unroll") for (int k = 0; k < 2; ++k) dst[n][k] = *(const PG8_LAS bf16x8*)(lds + PG8_SB(b, h) + boff + n * 2048 + k * 1024); } while (0)
#define PG8_MMA(ai, bj, At, Bt) do { __builtin_amdgcn_s_setprio(1); _Pragma("unroll") for (int m = 0; m < 4; ++m) _Pragma("unroll") for (int n = 0; n < 2; ++n) _Pragma("unroll") for (int k = 0; k < 2; ++k) \
        acc[ai][bj][m][n] = __builtin_amdgcn_mfma_f32_16x16x32_bf16(Bt[n][k], At[m][k], acc[ai][bj][m][n], 0, 0, 0); __builtin_amdgcn_s_setprio(0); } while (0)
#define PG8_WAIT_V(n) asm volatile("s_waitcnt vmcnt(" #n ")" ::: "memory")
#define PG8_WAIT_L(n) asm volatile("s_waitcnt lgkmcnt(" #n ")" ::: "memory")
#define PG8_BAR __builtin_amdgcn_s_barrier()
#define PG8_SCHED __builtin_amdgcn_sched_barrier(0)
    Unit cur, nxt; int ui = 0;
    if (!S.next(0, cur)) return;
    f32x4 acc[2][2][4][2];
#pragma unroll
    for (int a = 0; a < 2; ++a)
#pragma unroll
        for (int b = 0; b < 2; ++b)
#pragma unroll
            for (int m = 0; m < 4; ++m)
#pragma unroll
                for (int n = 0; n < 2; ++n) acc[a][b][m][n] = (f32x4){0.f, 0.f, 0.f, 0.f};
    bf16x8 At[4][2], B0[2][2], B1[2][2];
    const char* cA = g.A + cur.a_off; const char* cB = g.Bt + cur.b_off;
    PG8_STAGE(PG8_SB(0, 0), cB, voffB); PG8_STAGE(PG8_SB(0, 1), cB + hstepB, voffB); PG8_STAGE(PG8_SA(0, 0), cA, voffA); PG8_STAGE(PG8_SA(0, 1), cA + hstepA, voffA);
    if (wr == 1) PG8_BAR;
    PG8_WAIT_V(2); PG8_BAR;
    PG8_STAGE(PG8_SB(1, 0), cB + kstep, voffB); PG8_STAGE(PG8_SA(1, 0), cA + kstep, voffA); PG8_STAGE(PG8_SB(1, 1), cB + hstepB + kstep, voffB);
    PG8_WAIT_V(6); PG8_BAR;
    for (;;) {
        const bool has_next = S.next(ui + 1, nxt);
        const char* nA = has_next ? g.A + nxt.a_off : cA; const char* nB = has_next ? g.Bt + nxt.b_off : cB;
        for (int t = 0; t < nt; t += 2) {
            const bool last = (t == nt - 2);
            const char* a1 = cA + (size_t)(t + 1) * kstep;
            const char* a2 = last ? nA : cA + (size_t)(t + 2) * kstep; const char* b2 = last ? nB : cB + (size_t)(t + 2) * kstep;
            const char* a3 = a2 + kstep; const char* b3 = b2 + kstep;
            PG8_LDB(B0, 0, 0); PG8_LDB(B1, 0, 1); PG8_SCHED; PG8_LDA(At, 0, 0); PG8_STAGE(PG8_SA(1, 1), a1 + hstepA, voffA);
            PG8_WAIT_V(8); PG8_WAIT_L(0); PG8_BAR; PG8_MMA(0, 0, At, B0); PG8_MMA(0, 1, At, B1); PG8_BAR; PG8_SCHED;
            PG8_LDA(At, 0, 1); PG8_STAGE(PG8_SB(0, 0), b2, voffB); PG8_STAGE(PG8_SB(0, 1), b2 + hstepB, voffB); PG8_STAGE(PG8_SA(0, 0), a2, voffA);
            PG8_WAIT_V(8); PG8_WAIT_L(0); PG8_BAR; PG8_MMA(1, 0, At, B0); PG8_MMA(1, 1, At, B1); PG8_BAR; PG8_SCHED;
            PG8_LDB(B0, 1, 0); PG8_LDB(B1, 1, 1); PG8_SCHED; PG8_LDA(At, 1, 0); PG8_STAGE(PG8_SA(0, 1), a2 + hstepA, voffA);
            PG8_WAIT_V(8); PG8_WAIT_L(0); PG8_BAR; PG8_MMA(0, 0, At, B0); PG8_MMA(0, 1, At, B1); PG8_BAR; PG8_SCHED;
            PG8_LDA(At, 1, 1); PG8_STAGE(PG8_SB(1, 0), b3, voffB); PG8_STAGE(PG8_SB(1, 1), b3 + hstepB, voffB); PG8_STAGE(PG8_SA(1, 0), a3, voffA);
            PG8_WAIT_V(8); PG8_WAIT_L(0); PG8_BAR; PG8_MMA(1, 0, At, B0); PG8_MMA(1, 1, At, B1); PG8_BAR; PG8_SCHED;
        }
        if constexpr (ALIGN_EPI) { if (wr == 0) PG8_BAR; }
        E(acc, cur, wr, wc, fr, fq, lane);
        if (!has_next) break;
#pragma unroll
        for (int a = 0; a < 2; ++a)
#pragma unroll
            for (int b = 0; b < 2; ++b)
#pragma unroll
                for (int m = 0; m < 4; ++m)
#pragma unroll
                    for (int n = 0; n < 2; ++n) acc[a][b][m][n] = (f32x4){0.f, 0.f, 0.f, 0.f};
        cur = nxt; cA = nA; cB = nB; ++ui;
        if constexpr (ALIGN_EPI) { if (wr == 1) PG8_BAR; }
    }
    PG8_WAIT_V(0);
    if constexpr (!ALIGN_EPI) { if (wr == 0) PG8_BAR; }
    PG8_BAR;
#undef PG8_SA
#undef PG8_SB
#undef PG8_STAGE
#undef PG8_LDA
#undef PG8_LDB
#undef PG8_MMA
#undef PG8_WAIT_V
#undef PG8_WAIT_L
#undef PG8_BAR
#undef PG8_SCHED
}
}
namespace pg8 {
struct EpiStoreBf16 {
    static constexpr bool PERM = true;
    bf16_t* O0; int ldc0; bf16_t* O1; int ldc1;
    int mode;
    __device__ __forceinline__ void operator()(const f32x4 (&acc)[2][2][4][2], const Unit& u, int wr, int wc, int fr, int fq, int lane) const {
        asm volatile("" : "+v"(fr), "+v"(fq), "+v"(lane));
        bf16_t* base; int ldc; size_t row0; int colt;
        if (mode == 0) { base = u.z ? O1 : O0; ldc = u.z ? ldc1 : ldc0; row0 = (size_t)u.pm * BM; colt = u.pn * BM; }
        else if (mode == 1) { base = O0; ldc = ldc0; row0 = (size_t)u.pm * 1024 + (size_t)u.z * 256; colt = u.pn * BM; }
        else { base = O0 + (size_t)(u.z >> 2) * 1048576; ldc = ldc0; row0 = (size_t)u.pm * BM; colt = (u.z & 3) * 256; }
        const int col0 = colt + wc * 32 + 8 * fq;
#pragma unroll
        for (int ai = 0; ai < 2; ++ai)
#pragma unroll
            for (int m = 0; m < 4; ++m) { bf16_t* rowp = base + (row0 + wr * 64 + fr + ai * HALF + m * 16) * ldc + col0;
#pragma unroll
                for (int bj = 0; bj < 2; ++bj) { const f32x4 v0 = acc[ai][bj][m][0], v1 = acc[ai][bj][m][1];
                    u32x4 w; w.x = cvt_pk_bf16(v0[0], v0[1]); w.y = cvt_pk_bf16(v0[2], v0[3]); w.z = cvt_pk_bf16(v1[0], v1[1]); w.w = cvt_pk_bf16(v1[2], v1[3]);
                    *(u32x4*)(rowp + bj * HALF) = w; } }
    }
};

__device__ __forceinline__ float row_rstd(const float* ss, size_t row) {
    const f32x4* p = (const f32x4*)(ss + row * 16); const f32x4 a = p[0], b = p[1], c = p[2], d = p[3];
    const float s = ((a[0] + a[1]) + (a[2] + a[3])) + ((b[0] + b[1]) + (b[2] + b[3])) + ((c[0] + c[1]) + (c[2] + c[3])) + ((d[0] + d[1]) + (d[2] + d[3]));
    return 1.0f / sqrtf(s * (1.0f / 1024.0f) + 1e-6f);
}
__device__ __forceinline__ void wave_rstd(float (&rs)[2][4], const float* ss, int pm, int wr, int fr, int lane) {
    const float my0 = row_rstd(ss, (size_t)pm * BM + wr * 64 + lane), my1 = row_rstd(ss, (size_t)pm * BM + HALF + wr * 64 + lane);
#pragma unroll
    for (int m = 0; m < 4; ++m) { rs[0][m] = __shfl(my0, m * 16 + fr); rs[1][m] = __shfl(my1, m * 16 + fr); }
}

struct EpiRes {
    static constexpr bool PERM = false;
    const float* base; float* out; bf16_t* hb; float* ss; int ldc;
    __device__ __forceinline__ void operator()(f32x4 (&acc)[2][2][4][2], const Unit& u, int wr, int wc, int fr, int fq, int lane) const {
        asm volatile("" : "+v"(fr), "+v"(fq), "+v"(lane));
        const int col0 = u.pn * BM + wc * 32 + 4 * fq;
#pragma unroll
        for (int ai = 0; ai < 2; ++ai)
#pragma unroll
            for (int m = 0; m < 4; ++m) { const size_t row = (size_t)u.pm * BM + ai * HALF + wr * 64 + m * 16 + fr; const size_t off = row * ldc + col0; float q = 0.f;
#pragma unroll
                for (int bj = 0; bj < 2; ++bj)
#pragma unroll
                    for (int n = 0; n < 2; ++n) { const f32x4 bs = *(const f32x4*)(base + off + bj * HALF + n * 16); const f32x4 o = bs + acc[ai][bj][m][n];
                        *(f32x4*)(out + off + bj * HALF + n * 16) = o; q += (o[0] * o[0] + o[1] * o[1]) + (o[2] * o[2] + o[3] * o[3]);
                        if (hb) { u32x2 w; w.x = cvt_pk_bf16(o[0], o[1]); w.y = cvt_pk_bf16(o[2], o[3]); *(u32x2*)(hb + off + bj * HALF + n * 16) = w; } }
                q += __shfl_xor(q, 16); q += __shfl_xor(q, 32);
                if (fq == 0) ss[row * 16 + u.pn * 4 + wc] = q;
                if (m & 1) asm volatile("" ::: "memory"); }
    }
};

struct EpiSqRelu {
    static constexpr bool PERM = true;
    bf16_t* O; int ldc; const float* ss;
    __device__ __forceinline__ void operator()(const f32x4 (&acc)[2][2][4][2], const Unit& u, int wr, int wc, int fr, int fq, int lane) const {
        asm volatile("" : "+v"(fr), "+v"(fq), "+v"(lane));
        float rs[2][4]; wave_rstd(rs, ss, u.pm, wr, fr, lane);
        const int col0 = u.pn * BM + wc * 32 + 8 * fq;
#pragma unroll
        for (int ai = 0; ai < 2; ++ai)
#pragma unroll
            for (int m = 0; m < 4; ++m) { bf16_t* rowp = O + ((size_t)u.pm * BM + wr * 64 + fr + ai * HALF + m * 16) * ldc + col0; const float s = rs[ai][m];
#pragma unroll
                for (int bj = 0; bj < 2; ++bj) { f32x4 v0 = acc[ai][bj][m][0] * s, v1 = acc[ai][bj][m][1] * s;
#pragma unroll
                    for (int i = 0; i < 4; ++i) { const float a = fmaxf(v0[i], 0.f), b = fmaxf(v1[i], 0.f); v0[i] = a * a; v1[i] = b * b; }
                    u32x4 w; w.x = cvt_pk_bf16(v0[0], v0[1]); w.y = cvt_pk_bf16(v0[2], v0[3]); w.z = cvt_pk_bf16(v1[0], v1[1]); w.w = cvt_pk_bf16(v1[2], v1[3]);
                    *(u32x4*)(rowp + bj * HALF) = w; } }
    }
};

struct EpiSoftmax {
    static constexpr bool PERM = true;
    bf16_t* O; int ldc; const float* ss; PG8_LAS f32x2* xl;
    __device__ __forceinline__ void operator()(f32x4 (&acc)[2][2][4][2], const Unit& u, int wr, int wc, int fr, int fq, int lane) const {
        asm volatile("" : "+v"(fr), "+v"(fq), "+v"(lane));
        float rs[2][4]; wave_rstd(rs, ss, u.pm, wr, fr, lane);
#pragma unroll
        for (int ai = 0; ai < 2; ++ai)
#pragma unroll
            for (int m = 0; m < 4; ++m) { const float s = rs[ai][m] * (0.0625f * 1.4426950408889634f); float mx = -INFINITY;
#pragma unroll
                for (int bj = 0; bj < 2; ++bj)
#pragma unroll
                    for (int n = 0; n < 2; ++n) { f32x4 v = acc[ai][bj][m][n] * s; acc[ai][bj][m][n] = v; mx = fmaxf(fmaxf(mx, fmaxf(v[0], v[1])), fmaxf(v[2], v[3])); }
                mx = fmaxf(mx, __shfl_xor(mx, 16)); mx = fmaxf(mx, __shfl_xor(mx, 32)); float sm = 0.f;
#pragma unroll
                for (int bj = 0; bj < 2; ++bj)
#pragma unroll
                    for (int n = 0; n < 2; ++n) { f32x4 v = acc[ai][bj][m][n];
#pragma unroll
                        for (int i = 0; i < 4; ++i) { v[i] = __builtin_amdgcn_exp2f(v[i] - mx); sm += v[i]; } acc[ai][bj][m][n] = v; }
                sm += __shfl_xor(sm, 16); sm += __shfl_xor(sm, 32);
                if (fq == 0) xl[(ai * HALF + wr * 64 + m * 16 + fr) * 4 + wc] = (f32x2){mx, sm}; }
        asm volatile("s_waitcnt lgkmcnt(0)" ::: "memory"); __builtin_amdgcn_s_barrier(); asm volatile("" ::: "memory");
        const int col0 = u.pn * BM + wc * 32 + 8 * fq;
#pragma unroll
        for (int ai = 0; ai < 2; ++ai)
#pragma unroll
            for (int m = 0; m < 4; ++m) { const int r = ai * HALF + wr * 64 + m * 16 + fr;
                const f32x4 x01 = *(const PG8_LAS f32x4*)(xl + r * 4), x23 = *(const PG8_LAS f32x4*)(xl + r * 4 + 2);
                const float mg = fmaxf(fmaxf(x01[0], x01[2]), fmaxf(x23[0], x23[2]));
                const float tot = x01[1] * __builtin_amdgcn_exp2f(x01[0] - mg) + x01[3] * __builtin_amdgcn_exp2f(x01[2] - mg) + x23[1] * __builtin_amdgcn_exp2f(x23[0] - mg) + x23[3] * __builtin_amdgcn_exp2f(x23[2] - mg);
                const float mown = wc == 0 ? x01[0] : (wc == 1 ? x01[2] : (wc == 2 ? x23[0] : x23[2]));
                const float f = __builtin_amdgcn_exp2f(mown - mg) / tot;
                bf16_t* rowp = O + ((size_t)u.pm * BM + r) * ldc + col0;
#pragma unroll
                for (int bj = 0; bj < 2; ++bj) { const f32x4 v0 = acc[ai][bj][m][0] * f, v1 = acc[ai][bj][m][1] * f;
                    u32x4 w; w.x = cvt_pk_bf16(v0[0], v0[1]); w.y = cvt_pk_bf16(v0[2], v0[3]); w.z = cvt_pk_bf16(v1[0], v1[1]); w.w = cvt_pk_bf16(v1[2], v1[3]);
                    *(u32x4*)(rowp + bj * HALF) = w; } }
    }
};
}
constexpr int NWAVES = 8;
constexpr int BATCH = 4, T = 8192, D = 1024, M = BATCH * T;
constexpr int NIN = 3328, RW = 512, NH = 8, HD = 64;
constexpr int ZK_R = 512, ZV_R = 1024, ZWD = 1536, ZAD = 1600, ZGD = 1664;
constexpr int ZQ = 1792, ZK = 1792 + 512, ZV = 1792 + 1024;
constexpr int MEML = 256, MEMR = BATCH * MEML, FF = 4096;
constexpr int NBLK = T / 256;
constexpr float NORM_EPS = 1e-6f, GN_EPS = 64e-5f, DECAY_SCALE = 0.6065306597126334f;

constexpr size_t MiB = 1u << 20;
constexpr size_t WS_CTL = 0, CTL_ZERO_BYTES = 1 * MiB;
constexpr size_t WS_WIN_T = 1 * MiB, WS_WMIX_T = 8 * MiB, WS_WQ_S = 10 * MiB, WS_WXKV_T = 12 * MiB, WS_WO_T = 16 * MiB, WS_W1_T = 18 * MiB, WS_W2_T = 26 * MiB;
constexpr size_t WS_MEMN = 34 * MiB, WS_KV = 36 * MiB, WS_GT = 40 * MiB, WS_VWT = 48 * MiB;
constexpr size_t WS_SS = 56 * MiB;
constexpr size_t WS_KMEAN = 62 * MiB, WS_BON = 63 * MiB;
constexpr size_t WS_XN = 64 * MiB;
constexpr size_t WS_GATE = 64 * MiB, WS_YRAW = 96 * MiB;
constexpr size_t WS_HB = 64 * MiB;
constexpr size_t WS_Z = 128 * MiB;
constexpr size_t WS_Y = 336 * MiB;
constexpr size_t WS_PR = 400 * MiB, WS_PV = 432 * MiB;
constexpr size_t WS_P = 400 * MiB;
constexpr size_t WS_AH = 128 * MiB;
constexpr size_t WS_END = 512 * MiB;
constexpr size_t DO_W = 0, DO_KP = 32 * MiB, DO_KKN = 64 * MiB, DO_B = 96 * MiB;

constexpr int CW_TMO = 0, CW_CODE = 1;
constexpr int CW_BAR = 4096;

constexpr int RING_OFF = 0, RING_BYTES = 131072;
constexpr int LDSCTL_OFF = RING_BYTES, MISC_OFF = LDSCTL_OFF + 320;
constexpr int EPI_LDS_OFF = 132096;
constexpr int LDS_BYTES = 147456;
static_assert(MISC_OFF + 128 <= EPI_LDS_OFF && EPI_LDS_OFF + 8192 <= LDS_BYTES, "LDS map");

#define GAS __attribute__((address_space(1)))
#define LAS __attribute__((address_space(3)))
typedef unsigned short bf16;
typedef unsigned v4u __attribute__((ext_vector_type(4)));
typedef float f32x4 __attribute__((ext_vector_type(4)));
typedef GAS unsigned gu32;
#define RLX_AGENT __ATOMIC_RELAXED, __HIP_MEMORY_SCOPE_AGENT
#define LDS_WAIT() asm volatile("s_waitcnt lgkmcnt(0)" ::: "memory")
#define VM_WAIT() asm volatile("s_waitcnt vmcnt(0)" ::: "memory")
__device__ __forceinline__ unsigned f2bf(float f) { unsigned u = __builtin_bit_cast(unsigned, f); return (u + 0x7fffu + ((u >> 16) & 1u)) >> 16; }
__device__ __forceinline__ unsigned pk2(float lo, float hi) { return f2bf(lo) | (f2bf(hi) << 16); }
__device__ __forceinline__ float bf2f(unsigned short u) { return __builtin_bit_cast(float, (unsigned)u << 16); }
__device__ __forceinline__ float bflo(unsigned u) { return __builtin_bit_cast(float, u << 16); }
__device__ __forceinline__ float bfhi(unsigned u) { return __builtin_bit_cast(float, u & 0xffff0000u); }

#define XB_TMO      128
#define XB_XCNT(j)  (256  + 64 * (j))
#define XB_XSUB(j)  (1280 + 64 * (j))
#define XB_XGEN(j)  (2304 + 64 * (j))
#define XB_TOP      3328
#define XB_TOPGEN   3392
#define XCD_BAR_WORDS 3456
#define XB_SPIN_CAP (1u << 18)
__device__ __forceinline__ unsigned xb_ld(unsigned* p)              { return __hip_atomic_load(p, __ATOMIC_RELAXED, __HIP_MEMORY_SCOPE_AGENT); }
__device__ __forceinline__ unsigned xb_add(unsigned* p, unsigned v) { return __hip_atomic_fetch_add(p, v, __ATOMIC_RELAXED, __HIP_MEMORY_SCOPE_AGENT); }
__device__ __forceinline__ unsigned xb_xcc_id() { return (unsigned)__builtin_amdgcn_s_getreg((3 << 11) | 20) & 0xFu; }
#define XB_SPIN(cond, bar) do { unsigned _sp = 0; while (cond) { __builtin_amdgcn_s_sleep(1); \
    if ((++_sp & 255u) == 0u) { if (xb_ld(&(bar)[XB_TMO])) break; if (_sp > XB_SPIN_CAP) { atomicAdd(&(bar)[XB_TMO], 1u); break; } } } } while (0)
struct XcdBarrier { unsigned* bar; unsigned x; volatile LAS unsigned* st; };
__device__ __forceinline__ XcdBarrier xcd_barrier_post(unsigned* bar, volatile LAS unsigned* st) {
    XcdBarrier b; b.bar = bar; b.x = xb_xcc_id(); b.st = st;
    if (threadIdx.x == 0) (void)xb_add(&bar[XB_XCNT(b.x)], 1u);
    return b;
}
__device__ __forceinline__ void xcd_barrier_complete(unsigned* bar, unsigned x, unsigned& nloc, unsigned& nx) {
    const unsigned G = gridDim.x * gridDim.y * gridDim.z;
    unsigned sum, cnt, mine, sp = 0u;
    for (;;) {
        sum = 0u; cnt = 0u; mine = 0u;
#pragma unroll
        for (unsigned j = 0; j < 16; ++j) { const unsigned c = xb_ld(&bar[XB_XCNT(j)]); sum += c; cnt += (c > 0u) ? 1u : 0u; mine = (j == x) ? c : mine; }
        if (sum == G) break;
        __builtin_amdgcn_s_sleep(1);
        if ((++sp & 255u) == 0u) { if (xb_ld(&bar[XB_TMO])) break; if (sp > XB_SPIN_CAP) { atomicAdd(&bar[XB_TMO], 1u); break; } }
    }
    nloc = mine > 0u ? mine : 1u; nx = cnt > 0u ? cnt : 1u;
}
__device__ __forceinline__ void xcd_barrier(const XcdBarrier& b) {
    asm volatile("s_waitcnt vmcnt(0)" ::: "memory");
    __syncthreads();
    if (threadIdx.x == 0) {
        unsigned* bar = b.bar;
        __builtin_amdgcn_s_waitcnt(0);
        unsigned nloc = b.st[0], nx = b.st[1];
        if (nloc == 0u) { xcd_barrier_complete(bar, b.x, nloc, nx); b.st[0] = nloc; b.st[1] = nx; }
        const unsigned old = xb_add(&bar[XB_XSUB(b.x)], 1u);
        const unsigned gen = old / nloc;
        if (old + 1u == (gen + 1u) * nloc) {
            __builtin_amdgcn_fence(__ATOMIC_RELEASE, "agent");
            asm volatile("s_waitcnt vmcnt(0)" ::: "memory");
            const unsigned og = xb_add(&bar[XB_TOP], 1u);
            const unsigned tg = og / nx;
            if (og + 1u == (tg + 1u) * nx) xb_add(&bar[XB_TOPGEN], 1u);
            else XB_SPIN(xb_ld(&bar[XB_TOPGEN]) == tg, bar);
            __builtin_amdgcn_fence(__ATOMIC_ACQUIRE, "agent");
            xb_add(&bar[XB_XGEN(b.x)], 1u);
            asm volatile("s_waitcnt vmcnt(0)" ::: "memory");
        } else {
            XB_SPIN(xb_ld(&bar[XB_XGEN(b.x)]) == gen, bar);
            __builtin_amdgcn_fence(__ATOMIC_ACQUIRE, "agent");
            asm volatile("s_waitcnt vmcnt(0)" ::: "memory");
        }
    }
    __syncthreads();
}

struct Frame {
    LAS unsigned char* lds;
    volatile LAS unsigned* MISC;
    gu32* ctl;
    int tid, lane, wave;
    int vcu, G;
    unsigned char* ws; unsigned char* dout;
    const float* in[25];
};
__device__ __forceinline__ float wave_sum(float v) {
#pragma unroll
    for (int o = 1; o < 64; o <<= 1) v += __shfl_xor(v, o);
    return v;
}
__device__ __forceinline__ float wave_max(float v) {
#pragma unroll
    for (int o = 1; o < 64; o <<= 1) v = fmaxf(v, __shfl_xor(v, o));
    return v;
}
template <int CTRL> __device__ __forceinline__ float dpp_mov(float x) { return __builtin_bit_cast(float, __builtin_amdgcn_update_dpp(0, __builtin_bit_cast(int, x), CTRL, 0xf, 0xf, false)); }
__device__ __forceinline__ float red16(float x) { x += dpp_mov<0xB1>(x); x += dpp_mov<0x4E>(x); x += dpp_mov<0x124>(x); x += dpp_mov<0x128>(x); return x; }
__device__ __forceinline__ void p0_transpose_item(const float* W, int K, int N, bf16* WT, const float* kscale, LAS float* scr, int item, int lane) {
    const int nblk = N / 32, kb = item / nblk, nb = item % nblk, k0 = 64 * kb, n0 = 32 * nb;
#pragma unroll 8
    for (int i = 0; i < 32; ++i) { const int kk = 2 * i + (lane >> 5); const float s = kscale ? kscale[k0 + kk] : 1.f; scr[kk * 33 + (lane & 31)] = W[(size_t)(k0 + kk) * N + n0 + (lane & 31)] * s; }
    LDS_WAIT(); asm volatile("" ::: "memory");
    const int c = lane & 7;
#pragma unroll
    for (int j = 0; j < 4; ++j) { const int n = (lane >> 3) + 8 * j; const LAS float* s = scr + (8 * c) * 33 + n;
        v4u o; o.x = pk2(s[0 * 33], s[1 * 33]); o.y = pk2(s[2 * 33], s[3 * 33]); o.z = pk2(s[4 * 33], s[5 * 33]); o.w = pk2(s[6 * 33], s[7 * 33]);
        *(GAS v4u*)(WT + (size_t)(n0 + n) * K + k0 + 8 * c) = o; }
    LDS_WAIT(); asm volatile("" ::: "memory");
}
__device__ __forceinline__ void rms_row_to_bf16(const float* xrow, const float* g, bf16* orow, int lane) {
    const GAS f32x4* xr = (const GAS f32x4*)xrow + lane; const GAS f32x4* gr = (const GAS f32x4*)g + lane;
    f32x4 v[4]; float s = 0.f;
#pragma unroll
    for (int j = 0; j < 4; ++j) { v[j] = xr[64 * j]; s += (v[j].x * v[j].x + v[j].y * v[j].y) + (v[j].z * v[j].z + v[j].w * v[j].w); }
    const float rstd = 1.f / sqrtf(wave_sum(s) * (1.f / D) + NORM_EPS);
    GAS unsigned long long* o8 = (GAS unsigned long long*)orow + lane;
#pragma unroll
    for (int j = 0; j < 4; ++j) { const f32x4 gg = gr[64 * j]; o8[64 * j] = (unsigned long long)pk2(v[j].x * rstd * gg.x, v[j].y * rstd * gg.y) | ((unsigned long long)pk2(v[j].z * rstd * gg.z, v[j].w * rstd * gg.w) << 32); }
}
__device__ __forceinline__ void p0_prologue(Frame& F) {
    LAS float* scr = (LAS float*)(F.lds + RING_OFF + F.wave * 16384);
    const int gw = F.vcu * NWAVES + F.wave, NGW = F.G * NWAVES;
    constexpr int I_IN = (D / 64) * (NIN / 32), I_MIX = (D / 64) * (D / 32), I_KV = (D / 64) * (2 * D / 32), I_O = I_MIX, I_1 = (D / 64) * (FF / 32), I_2 = (FF / 64) * (D / 32);
    constexpr int NITEMS = I_IN + I_MIX + I_KV + I_O + I_1 + I_2;
    for (int it = gw; it < NITEMS; it += NGW) {
        int r = it;
        if (r < I_IN) { p0_transpose_item(F.in[3], D, NIN, (bf16*)(F.ws + WS_WIN_T), nullptr, scr, r, F.lane); continue; } r -= I_IN;
        if (r < I_MIX) { p0_transpose_item(F.in[15], D, D, (bf16*)(F.ws + WS_WMIX_T), nullptr, scr, r, F.lane); continue; } r -= I_MIX;
        if (r < I_KV) { p0_transpose_item(F.in[19], D, 2 * D, (bf16*)(F.ws + WS_WXKV_T), nullptr, scr, r, F.lane); continue; } r -= I_KV;
        if (r < I_O) { p0_transpose_item(F.in[20], D, D, (bf16*)(F.ws + WS_WO_T), nullptr, scr, r, F.lane); continue; } r -= I_O;
        if (r < I_1) { p0_transpose_item(F.in[22], D, FF, (bf16*)(F.ws + WS_W1_T), F.in[21], scr, r, F.lane); continue; } r -= I_1;
        p0_transpose_item(F.in[23], FF, D, (bf16*)(F.ws + WS_W2_T), nullptr, scr, r, F.lane);
    }
    { const float* wq = F.in[18]; const float* gx = F.in[16]; bf16* o = (bf16*)(F.ws + WS_WQ_S);
      for (int i = (F.vcu * 512 + F.tid); i < D * D / 4; i += F.G * 512) { const f32x4 v = ((const GAS f32x4*)wq)[i]; const float s = gx[(i * 4) / D];
          ((GAS unsigned long long*)o)[i] = (unsigned long long)pk2(v.x * s, v.y * s) | ((unsigned long long)pk2(v.z * s, v.w * s) << 32); } }
    for (int m = gw; m < M; m += NGW) rms_row_to_bf16(F.in[0] + (size_t)m * D, F.in[2], (bf16*)(F.ws + WS_XN) + (size_t)m * D, F.lane);
    for (int m = gw; m < MEMR; m += NGW) rms_row_to_bf16(F.in[1] + (size_t)m * D, F.in[17], (bf16*)(F.ws + WS_MEMN) + (size_t)m * D, F.lane);
}

__device__ __forceinline__ float zshift(const bf16* Z, const float* mu, int m, int col) {
    const float z = bf2f(Z[(size_t)m * NIN + col]); const float zp = (m % T == 0) ? 0.f : bf2f(Z[(size_t)(m - 1) * NIN + col]);
    return z + (zp - z) * mu[col];
}
__device__ __forceinline__ void rwkv_prep_simple(Frame& F) {
    const bf16* Z = (const bf16*)(F.ws + WS_Z); const float* mu = F.in[4];
    LAS float* lo = (LAS float*)(F.lds + RING_OFF);
    const int c = F.tid;
    const float w0 = F.in[5][c], a0 = F.in[7][c], kkc = F.in[10][c], kac = F.in[11][c], rkc = F.in[12][c];
    const float* wup = F.in[6]; const float* aup = F.in[8]; const float* gup = F.in[9];
    bf16* oR = (bf16*)(F.ws + WS_PR); bf16* oV = (bf16*)(F.ws + WS_PV); bf16* oW = (bf16*)(F.dout + DO_W); bf16* oKP = (bf16*)(F.dout + DO_KP); bf16* oKK = (bf16*)(F.dout + DO_KKN); bf16* oB = (bf16*)(F.dout + DO_B);
    bf16* oG = (bf16*)(F.ws + WS_GATE); float* oBon = (float*)(F.ws + WS_BON);
    for (int m0 = F.vcu * 4; m0 < M; m0 += F.G * 4) {
#pragma unroll
        for (int i = 0; i < 2; ++i) { const int e = F.tid + 512 * i, tk = e >> 8, j = e & 255; const float zs = zshift(Z, mu, m0 + tk, ZWD + j);
            lo[e] = j < 64 ? tanhf(zs) : (j < 128 ? zs : 1.f / (1.f + __expf(-zs))); }
        __syncthreads();
        float aw[4], aa[4], ag[4];
#pragma unroll
        for (int k = 0; k < 4; ++k) { aw[k] = 0.f; aa[k] = 0.f; ag[k] = 0.f; }
        for (int j = 0; j < 64; ++j) { const float wv = wup[j * RW + c], av = aup[j * RW + c];
#pragma unroll
            for (int k = 0; k < 4; ++k) { aw[k] += lo[k * 256 + j] * wv; aa[k] += lo[k * 256 + 64 + j] * av; } }
        for (int j = 0; j < 128; ++j) { const float gv = gup[j * RW + c];
#pragma unroll
            for (int k = 0; k < 4; ++k) ag[k] += lo[k * 256 + 128 + j] * gv; }
#pragma unroll
        for (int k = 0; k < 4; ++k) { const int m = m0 + k;
            const float r = zshift(Z, mu, m, c), kx = zshift(Z, mu, m, ZK_R + c), v = zshift(Z, mu, m, ZV_R + c);
            const float dec = __expf(-DECAY_SCALE / (1.f + __expf(-(w0 + aw[k]))));
            const float a = 1.f / (1.f + __expf(-(a0 + aa[k])));
            const float kk = kx * kkc; const float nn = wave_sum(kk * kk); const float kkn = kk / fmaxf(sqrtf(nn), 1e-12f);
            const float kp = kx * (1.f + (a - 1.f) * kac);
            const float bon = wave_sum(r * kp * rkc);
            const size_t o = (size_t)m * RW + c;
            oR[o] = (bf16)f2bf(r); oV[o] = (bf16)f2bf(v); oW[o] = (bf16)f2bf(dec); oKP[o] = (bf16)f2bf(kp); oKK[o] = (bf16)f2bf(kkn); oB[o] = (bf16)f2bf(kkn * a); oG[o] = (bf16)f2bf(ag[k]);
            if (F.lane == 0) oBon[(size_t)m * NH + F.wave] = bon; }
        __syncthreads();
    }
}
__device__ __forceinline__ void kmean_simple(Frame& F) {
    const bf16* Z = (const bf16*)(F.ws + WS_Z); float* KM = (float*)(F.ws + WS_KMEAN);
    const int gw = F.vcu * NWAVES + F.wave, NGW = F.G * NWAVES;
    for (int u = gw; u < BATCH * NH * NBLK; u += NGW) { const int j = u % NBLK, bh = u / NBLK, b = bh / NH, h = bh % NH;
        const bf16* kp = Z + ((size_t)b * T + j * 256) * NIN + ZK + h * HD + F.lane; float s = 0.f;
        for (int i = 0; i < 256; ++i) s += bf2f(kp[(size_t)i * NIN]);
        KM[(size_t)u * HD + F.lane] = s * (1.f / 256.f); }
}
constexpr int SC_TC = 32, SC_REC = 352;
__device__ __forceinline__ void scan_simple(Frame& F, int unit) {
    const int bh = unit >> 1, hf = unit & 1, b = bh / NH, h = bh % NH;
    const size_t rowbase = (size_t)b * T;
    const bf16* aR = (const bf16*)(F.ws + WS_PR); const bf16* aV = (const bf16*)(F.ws + WS_PV); const bf16* aW = (const bf16*)(F.dout + DO_W); const bf16* aKP = (const bf16*)(F.dout + DO_KP);
    const bf16* aKK = (const bf16*)(F.dout + DO_KKN); const bf16* aB = (const bf16*)(F.dout + DO_B);
    bf16* yout = (bf16*)(F.ws + WS_YRAW);
    LAS float* buf = (LAS float*)(F.lds + RING_OFF);
    const int rowl = F.tid >> 4, p = F.tid & 15;
    float S0 = 0.f, S1 = 0.f, S2 = 0.f, S3 = 0.f;
    unsigned short raw[22];
#define SC_GLOAD(t0) do { _Pragma("unroll") for (int i = 0; i < 22; ++i) { const int e = F.tid + 512 * i, tk = e / SC_REC, rem = e % SC_REC, q = rem >> 6, cc = rem & 63; \
            const size_t rowo = (rowbase + (t0) + tk) * RW + h * HD; \
            const bf16* src = q == 0 ? aR : (q == 1 ? aW : (q == 2 ? aKP : (q == 3 ? aKK : (q == 4 ? aB : aV)))); \
            raw[i] = src[rowo + (q == 5 ? hf * 32 + cc : cc)]; } } while (0)
#define SC_LSTORE(bi) do { _Pragma("unroll") for (int i = 0; i < 22; ++i) { const int e = F.tid + 512 * i; buf[(bi) * SC_TC * SC_REC + e] = bf2f(raw[i]); } } while (0)
    SC_GLOAD(0); SC_LSTORE(0); __syncthreads();
    for (int ch = 0; ch < T / SC_TC; ++ch) {
        const int cur = ch & 1; const bool more = (ch + 1 < T / SC_TC);
        if (more) SC_GLOAD((ch + 1) * SC_TC);
        const LAS float* rec = buf + cur * SC_TC * SC_REC;
        for (int tt = 0; tt < SC_TC; ++tt, rec += SC_REC) {
            const f32x4 r4 = *(const LAS f32x4*)(rec + 4 * p), w4 = *(const LAS f32x4*)(rec + 64 + 4 * p), k4 = *(const LAS f32x4*)(rec + 128 + 4 * p),
                        n4 = *(const LAS f32x4*)(rec + 192 + 4 * p), b4 = *(const LAS f32x4*)(rec + 256 + 4 * p);
            const float vv = rec[320 + rowl];
            float sa = (S0 * n4.x + S1 * n4.y) + (S2 * n4.z + S3 * n4.w); sa = -red16(sa);
            S0 = S0 * w4.x + sa * b4.x + vv * k4.x; S1 = S1 * w4.y + sa * b4.y + vv * k4.y; S2 = S2 * w4.z + sa * b4.z + vv * k4.z; S3 = S3 * w4.w + sa * b4.w + vv * k4.w;
            float y = (S0 * r4.x + S1 * r4.y) + (S2 * r4.z + S3 * r4.w); y = red16(y);
            if (p == 0) yout[(rowbase + ch * SC_TC + tt) * RW + h * HD + hf * 32 + rowl] = (bf16)f2bf(y);
        }
        if (more) SC_LSTORE(cur ^ 1);
        __syncthreads();
    }
#undef SC_GLOAD
#undef SC_LSTORE
}
__device__ __forceinline__ void load_row64(float (&q)[64], const bf16* p) {
#pragma unroll
    for (int i = 0; i < 8; ++i) { const v4u w = ((const GAS v4u*)p)[i];
        q[8 * i + 0] = bflo(w.x); q[8 * i + 1] = bfhi(w.x); q[8 * i + 2] = bflo(w.y); q[8 * i + 3] = bfhi(w.y); q[8 * i + 4] = bflo(w.z); q[8 * i + 5] = bfhi(w.z); q[8 * i + 6] = bflo(w.w); q[8 * i + 7] = bfhi(w.w); }
}
__device__ __forceinline__ void moba_simple(Frame& F, int wg, int nwg) {
    const bf16* Z = (const bf16*)(F.ws + WS_Z); const float* KM = (const float*)(F.ws + WS_KMEAN); bf16* Y = (bf16*)(F.ws + WS_Y);
    LAS float* red = (LAS float*)(F.lds + RING_OFF) + F.wave * (64 * 33);
    const int lane = F.lane;
    for (int qi = wg * NWAVES + F.wave; qi < BATCH * NH * T; qi += nwg * NWAVES) {
        const int bh = qi / T, t = qi % T, b = bh / NH, h = bh % NH, own = t >> 8;
        const size_t rowbase = (size_t)b * T;
        float q[64]; load_row64(q, Z + (rowbase + t) * NIN + ZQ + h * HD);
        float gate = -INFINITY;
        if (lane < own) { const float* km = KM + ((size_t)bh * NBLK + lane) * HD; float g = 0.f;
#pragma unroll
            for (int d = 0; d < 64; ++d) g += q[d] * km[d];
            gate = g; }
        int sel[3];
#pragma unroll
        for (int n = 0; n < 3; ++n) { const float mx = wave_max(gate); const unsigned long long bal = __ballot(gate == mx && mx > -INFINITY);
            int idx = -1; if (bal != 0ull) { idx = __ffsll((long long)bal) - 1; if (lane == idx) gate = -INFINITY; } sel[n] = idx; }
        float sc[16]; float mx = -INFINITY;
#pragma unroll
        for (int bi = 0; bi < 4; ++bi) { const int blk = bi < 3 ? sel[bi] : own;
#pragma unroll
            for (int i = 0; i < 4; ++i) { const int key = blk * 256 + i * 64 + lane; float s = -INFINITY;
                if (blk >= 0 && (bi < 3 || key <= t)) { const GAS v4u* kp = (const GAS v4u*)(Z + (rowbase + key) * NIN + ZK + h * HD); float a = 0.f;
#pragma unroll
                    for (int j = 0; j < 8; ++j) { const v4u w = kp[j];
                        a += q[8 * j + 0] * bflo(w.x) + q[8 * j + 1] * bfhi(w.x) + q[8 * j + 2] * bflo(w.y) + q[8 * j + 3] * bfhi(w.y) + q[8 * j + 4] * bflo(w.z) + q[8 * j + 5] * bfhi(w.z) + q[8 * j + 6] * bflo(w.w) + q[8 * j + 7] * bfhi(w.w); }
                    s = a * 0.125f; }
                sc[bi * 4 + i] = s; mx = fmaxf(mx, s); } }
        mx = wave_max(mx);
        float o[64]; float l = 0.f;
#pragma unroll
        for (int d = 0; d < 64; ++d) o[d] = 0.f;
#pragma unroll
        for (int bi = 0; bi < 4; ++bi) { const int blk = bi < 3 ? sel[bi] : own;
#pragma unroll
            for (int i = 0; i < 4; ++i) { const int key = blk * 256 + i * 64 + lane; const float pr = __expf(sc[bi * 4 + i] - mx);
                if (pr > 0.f) { const GAS v4u* vp = (const GAS v4u*)(Z + (rowbase + key) * NIN + ZV + h * HD); l += pr;
#pragma unroll
                    for (int j = 0; j < 8; ++j) { const v4u w = vp[j];
                        o[8 * j + 0] += pr * bflo(w.x); o[8 * j + 1] += pr * bfhi(w.x); o[8 * j + 2] += pr * bflo(w.y); o[8 * j + 3] += pr * bfhi(w.y); o[8 * j + 4] += pr * bflo(w.z); o[8 * j + 5] += pr * bfhi(w.z); o[8 * j + 6] += pr * bflo(w.w); o[8 * j + 7] += pr * bfhi(w.w); } } } }
        l = wave_sum(l);
        float res = 0.f;
#pragma unroll
        for (int hp = 0; hp < 2; ++hp) {
#pragma unroll
            for (int d = 0; d < 32; ++d) red[lane * 33 + d] = o[hp * 32 + d];
            LDS_WAIT(); asm volatile("" ::: "memory");
            float part = 0.f; const int dc = lane & 31, r0 = (lane >> 5) * 32;
#pragma unroll 8
            for (int r = 0; r < 32; ++r) part += red[(r0 + r) * 33 + dc];
            part += __shfl_xor(part, 32);
            if ((lane >> 5) == hp) res = part;
            LDS_WAIT(); asm volatile("" ::: "memory");
        }
        Y[(rowbase + t) * D + RW + h * HD + lane] = (bf16)f2bf(res / l);
    }
}
__device__ __forceinline__ void rwkv_post_simple(Frame& F) {
    const bf16* yr = (const bf16*)(F.ws + WS_YRAW); const bf16* aV = (const bf16*)(F.ws + WS_PV); const bf16* aG = (const bf16*)(F.ws + WS_GATE); const float* bon = (const float*)(F.ws + WS_BON);
    bf16* Y = (bf16*)(F.ws + WS_Y); const float* lnw = F.in[13]; const float* lnb = F.in[14];
    const int gw = F.vcu * NWAVES + F.wave, NGW = F.G * NWAVES;
    for (int u = gw; u < M * NH; u += NGW) { const int m = u >> 3, h = u & 7, c = h * HD + F.lane; const size_t o = (size_t)m * RW + c;
        const float y = bf2f(yr[o]); const float mean = wave_sum(y) * (1.f / 64.f); const float dlt = y - mean; const float var = wave_sum(dlt * dlt) * (1.f / 64.f);
        const float yn = dlt * (1.f / sqrtf(var + GN_EPS)) * lnw[c] + lnb[c];
        const float outv = (yn + bon[u] * bf2f(aV[o])) * bf2f(aG[o]);
        Y[(size_t)m * D + c] = (bf16)f2bf(outv); }
}
__device__ __forceinline__ void final_norm(Frame& F) {
    float* out = (float*)F.dout; const float* ss = (const float*)(F.ws + WS_SS) + (size_t)2 * M * 16; const float* g = F.in[24];
    const int gw = F.vcu * NWAVES + F.wave, NGW = F.G * NWAVES;
    for (int m = gw; m < M; m += NGW) { const float rstd = pg8::row_rstd(ss, (size_t)m);
        GAS f32x4* o = (GAS f32x4*)(out + (size_t)m * D) + F.lane; const GAS f32x4* gr = (const GAS f32x4*)g + F.lane;
#pragma unroll
        for (int j = 0; j < 4; ++j) { f32x4 v = o[64 * j]; const f32x4 gg = gr[64 * j]; v = v * rstd * gg; o[64 * j] = v; } }
}
using pg8::Unit;
constexpr size_t TILE_B = 256 * 2;
struct SchedBase { int G, c; };
struct SchedZ : SchedBase {
    __device__ __forceinline__ bool next(int i, Unit& u) const {
        const int L = i * G + c; constexpr int NZ = (M / 256) * (NIN / 256), NKV = (MEMR / 256) * (2 * D / 256);
        if (L < NZ) { pg8::tile_map(L, M / 256, NIN / 256, u.pm, u.pn); u.z = 0; u.a_off = WS_XN + (size_t)u.pm * 256 * D * 2; u.b_off = WS_WIN_T + (size_t)u.pn * 256 * D * 2; return true; }
        if (L < NZ + NKV) { const int l = L - NZ; u.pm = l / 8; u.pn = l % 8; u.z = 1; u.a_off = WS_MEMN + (size_t)u.pm * 256 * D * 2; u.b_off = WS_WXKV_T + (size_t)u.pn * 256 * D * 2; return true; }
        return false;
    }
};
struct SchedG : SchedBase {
    __device__ __forceinline__ bool next(int i, Unit& u) const {
        const int L = i * G + c; if (L >= 64) return false;
        u.z = L >> 4; u.pm = (L >> 2) & 3; u.pn = L & 3; u.a_off = WS_KV + ((size_t)u.pm * 256 * 2048 + u.z * 256) * 2; u.b_off = WS_WQ_S + ((size_t)u.pn * 256 * 1024 + u.z * 256) * 2; return true;
    }
};
struct SchedVW : SchedBase {
    __device__ __forceinline__ bool next(int i, Unit& u) const {
        const int L = i * G + (G - 1 - c); if (L >= 64) return false;
        u.z = L >> 2; u.pm = L & 3; u.pn = 0; const int b = u.z >> 2, h = u.z & 3;
        u.a_off = WS_WO_T + ((size_t)u.pm * 256 * 1024 + h * 256) * 2; u.b_off = WS_KV + ((size_t)b * 256 * 2048 + 1024 + h * 256) * 2; return true;
    }
};
struct SchedMN : SchedBase {
    int nN; size_t a_base, b_base; int lda, ldb, bsel;
    __device__ __forceinline__ bool next(int i, Unit& u) const {
        const int L = i * G + c; if (L >= (M / 256) * nN) return false;
        pg8::tile_map(L, M / 256, nN, u.pm, u.pn); u.z = 0;
        u.a_off = a_base + (size_t)u.pm * 256 * lda * 2; u.b_off = b_base + ((size_t)u.pn * 256 + (bsel ? (size_t)(u.pm >> 5) * 1024 : 0)) * ldb * 2; return true;
    }
};

#ifndef MK_N_LAUNCHES
#define MK_N_LAUNCHES 11
#endif
constexpr int PER_PHASE = 11;
constexpr int N_LAUNCHES = MK_N_LAUNCHES;
constexpr int SCAN_WGS = 64;
struct Args { const float* in[25]; float* out; unsigned char* ws; int ph_lo, ph_hi, li, pad; };
__global__ void __launch_bounds__(NWAVES * 64, 2) skel_fwd(Args args) {
    extern __shared__ __attribute__((aligned(16))) unsigned char lds[];
    Frame F;
    F.lds = (LAS unsigned char*)lds;
    F.MISC = (volatile LAS unsigned*)(F.lds + MISC_OFF);
    F.tid = threadIdx.x; F.lane = F.tid & 63; F.wave = __builtin_amdgcn_readfirstlane(F.tid >> 6);
    F.G = gridDim.x; { const int bx = blockIdx.x; F.vcu = (F.G % 8 == 0) ? (bx % 8) * (F.G / 8) + bx / 8 : bx; }
    F.ws = args.ws; F.dout = (unsigned char*)args.out;
#pragma unroll
    for (int i = 0; i < 25; ++i) F.in[i] = args.in[i];
    F.ctl = (gu32*)(F.ws + WS_CTL);
    for (int u = F.tid; u < (EPI_LDS_OFF - LDSCTL_OFF) / 4; u += NWAVES * 64) ((LAS unsigned*)(F.lds + LDSCTL_OFF))[u] = 0u;
    __syncthreads();
    XcdBarrier bar; bar.bar = (unsigned*)(F.ctl + CW_BAR); bar.x = 0; bar.st = nullptr;
    if (N_LAUNCHES == 1) bar = xcd_barrier_post((unsigned*)(F.ctl + CW_BAR), F.MISC + 8);
#define GRID_BAR() do { if (N_LAUNCHES == 1) xcd_barrier(bar); } while (0)
    const int lo = args.ph_lo, hi = args.ph_hi;
#ifndef PHASE_MASK
#define PHASE_MASK 0xFFFF
#endif
#define IN(k) (((PHASE_MASK >> (k)) & 1) && lo <= (k) && (k) < hi)
#define BOTH(k) (IN(k) && IN((k) + 1))
#define FRESH() do { int l_; asm volatile("v_mbcnt_lo_u32_b32 %0, -1, 0\n\tv_mbcnt_hi_u32_b32 %0, -1, %0" : "=v"(l_)); F.lane = l_; F.tid = F.wave * 64 + l_; } while (0)
    const char* wsc = (const char*)F.ws;
    const int bx = (int)blockIdx.x;

    if (IN(0)) { FRESH(); p0_prologue(F); if (BOTH(0)) GRID_BAR(); }
    if (IN(1)) {
        pg8::Gemm g{wsc, wsc, D, D, D}; SchedZ S; S.G = F.G; S.c = bx;
        pg8::EpiStoreBf16 E{(bf16*)(F.ws + WS_Z), NIN, (bf16*)(F.ws + WS_KV), 2 * D, 0};
        pg8::gemm_phase<pg8::EpiStoreBf16, SchedZ, true>(F.lds + RING_OFF, g, S, E, F.wave);
        if (BOTH(1)) GRID_BAR();
    }
    if (IN(2)) {
        { pg8::Gemm g{wsc, wsc, 2 * D, D, 256}; SchedG S; S.G = F.G; S.c = bx;
          pg8::EpiStoreBf16 E{(bf16*)(F.ws + WS_GT), D, nullptr, 0, 1};
          pg8::gemm_phase<pg8::EpiStoreBf16, SchedG, true>(F.lds + RING_OFF, g, S, E, F.wave); }
        { pg8::Gemm g{wsc, wsc, D, 2 * D, 256}; SchedVW S; S.G = F.G; S.c = bx;
          pg8::EpiStoreBf16 E{(bf16*)(F.ws + WS_VWT), D, nullptr, 0, 2};
          pg8::gemm_phase<pg8::EpiStoreBf16, SchedVW, true>(F.lds + RING_OFF, g, S, E, F.wave); }
        __syncthreads();
        FRESH(); kmean_simple(F);
        FRESH(); rwkv_prep_simple(F);
        if (BOTH(2)) GRID_BAR();
    }
    if (IN(3)) {
        FRESH();
        if (bx < SCAN_WGS) scan_simple(F, bx);
        else moba_simple(F, bx - SCAN_WGS, F.G - SCAN_WGS);
        if (BOTH(3)) GRID_BAR();
    }
    if (IN(4)) { FRESH(); rwkv_post_simple(F); if (BOTH(4)) GRID_BAR(); }
    if (IN(5)) {
        pg8::Gemm g{wsc, wsc, D, D, D}; SchedMN S; S.G = F.G; S.c = bx; S.nN = D / 256; S.a_base = WS_Y; S.b_base = WS_WMIX_T; S.lda = D; S.ldb = D; S.bsel = 0;
        pg8::EpiRes E{F.in[0], (float*)F.dout, (bf16*)(F.ws + WS_HB), (float*)(F.ws + WS_SS), D};
        pg8::gemm_phase<pg8::EpiRes, SchedMN, true>(F.lds + RING_OFF, g, S, E, F.wave);
        if (BOTH(5)) GRID_BAR();
    }
    if (IN(6)) {
        pg8::Gemm g{wsc, wsc, D, D, D}; SchedMN S; S.G = F.G; S.c = bx; S.nN = D / 256; S.a_base = WS_HB; S.b_base = WS_GT; S.lda = D; S.ldb = D; S.bsel = 1;
        pg8::EpiSoftmax E{(bf16*)(F.ws + WS_P), D, (const float*)(F.ws + WS_SS), (PG8_LAS pg8::f32x2*)(F.lds + EPI_LDS_OFF)};
        pg8::gemm_phase<pg8::EpiSoftmax, SchedMN, true>(F.lds + RING_OFF, g, S, E, F.wave);
        if (BOTH(6)) GRID_BAR();
    }
    if (IN(7)) {
        pg8::Gemm g{wsc, wsc, D, D, D}; SchedMN S; S.G = F.G; S.c = bx; S.nN = D / 256; S.a_base = WS_P; S.b_base = WS_VWT; S.lda = D; S.ldb = D; S.bsel = 1;
        pg8::EpiRes E{(const float*)F.dout, (float*)F.dout, (bf16*)(F.ws + WS_HB), (float*)(F.ws + WS_SS) + (size_t)M * 16, D};
        pg8::gemm_phase<pg8::EpiRes, SchedMN, true>(F.lds + RING_OFF, g, S, E, F.wave);
        if (BOTH(7)) GRID_BAR();
    }
    if (IN(8)) {
        pg8::Gemm g{wsc, wsc, D, D, D}; SchedMN S; S.G = F.G; S.c = bx; S.nN = FF / 256; S.a_base = WS_HB; S.b_base = WS_W1_T; S.lda = D; S.ldb = D; S.bsel = 0;
        pg8::EpiSqRelu E{(bf16*)(F.ws + WS_AH), FF, (const float*)(F.ws + WS_SS) + (size_t)M * 16};
        pg8::gemm_phase<pg8::EpiSqRelu, SchedMN, true>(F.lds + RING_OFF, g, S, E, F.wave);
        if (BOTH(8)) GRID_BAR();
    }
    if (IN(9)) {
        pg8::Gemm g{wsc, wsc, FF, FF, FF}; SchedMN S; S.G = F.G; S.c = bx; S.nN = D / 256; S.a_base = WS_AH; S.b_base = WS_W2_T; S.lda = FF; S.ldb = FF; S.bsel = 0;
        pg8::EpiRes E{(const float*)F.dout, (float*)F.dout, nullptr, (float*)(F.ws + WS_SS) + (size_t)2 * M * 16, D};
        pg8::gemm_phase<pg8::EpiRes, SchedMN, true>(F.lds + RING_OFF, g, S, E, F.wave);
        if (BOTH(9)) GRID_BAR();
    }
    if (IN(10)) { FRESH(); final_norm(F); }
#undef IN
#undef BOTH
}

extern "C" void kernel_launch(void* const* d_in, const int* in_sizes, int n_in, void* d_out, int out_size, void* d_ws, size_t ws_size, hipStream_t stream) {
    static int grid = 0;
    if (grid == 0) {
        if (n_in != 25 || in_sizes[0] != M * D || out_size != M * D || ws_size < WS_END) { fprintf(stderr, "kernel_launch: unexpected problem (n_in %d, in0 %d, out %d, ws %zu); nothing launched\n", n_in, n_in > 0 ? in_sizes[0] : -1, out_size, ws_size); grid = -1; return; }
        int dev = 0, cus = 0, per_cu = 0;
        if (hipGetDevice(&dev) != hipSuccess || hipDeviceGetAttribute(&cus, hipDeviceAttributeMultiprocessorCount, dev) != hipSuccess) { grid = -1; return; }
        if (hipFuncSetAttribute((const void*)skel_fwd, hipFuncAttributeMaxDynamicSharedMemorySize, LDS_BYTES) != hipSuccess) { fprintf(stderr, "kernel_launch: hipFuncSetAttribute failed\n"); grid = -1; return; }
        if (hipOccupancyMaxActiveBlocksPerMultiprocessor(&per_cu, (const void*)skel_fwd, NWAVES * 64, LDS_BYTES) != hipSuccess || per_cu < 1)
            fprintf(stderr, "kernel_launch: note: occupancy query reports %d workgroups per CU\n", per_cu);
        (void)hipGetLastError();
        grid = cus;
    }
    if (grid < 0) return;
    if (hipMemsetAsync((char*)d_ws + WS_CTL, 0, CTL_ZERO_BYTES, stream) != hipSuccess) { fprintf(stderr, "kernel_launch: hipMemsetAsync failed\n"); return; }
    Args a{};
    for (int i = 0; i < 25; ++i) a.in[i] = (const float*)d_in[i];
    a.out = (float*)d_out; a.ws = (unsigned char*)d_ws;
    for (int li = 0; li < N_LAUNCHES; ++li) {
        a.ph_lo = (N_LAUNCHES == PER_PHASE) ? li : 0; a.ph_hi = (N_LAUNCHES == PER_PHASE) ? li + 1 : PER_PHASE; a.li = li;
        hipLaunchKernelGGL(skel_fwd, dim3(grid), dim3(NWAVES * 64), LDS_BYTES, stream, a);
        const hipError_t le = hipPeekAtLastError();
        if (le != hipSuccess) { fprintf(stderr, "kernel_launch: launch %d failed: %s\n", li, hipGetErrorName(le)); break; }
    }
}
```

```cpp
#include <hip/hip_runtime.h>
#include <cstdio>
#include <cstdint>
#include <cmath>
namespace pg8 {
#define PG8_LAS __attribute__((address_space(3)))
typedef unsigned short bf16_t;
typedef short bf16x8 __attribute__((ext_vector_type(8)));
typedef float f32x4 __attribute__((ext_vector_type(4)));
typedef float f32x2 __attribute__((ext_vector_type(2)));
typedef unsigned u32x4 __attribute__((ext_vector_type(4)));
typedef unsigned u32x2 __attribute__((ext_vector_type(2)));
constexpr int BM = 256, BK = 64, HALF = 128, HTB = HALF * BK * 2  , STAGE_BYTES = 8 * HTB, NXCD = 8, WGM = 8;

__host__ __device__ __forceinline__ int lds_byte(int r, int c) { const int st = (r >> 4) * 2 + (c >> 5), rr = r & 15, cc = c & 31, ob = rr * 64 + cc * 2; return st * 1024 + (ob ^ (((ob >> 9) & 1) << 5)); }
__host__ __device__ __forceinline__ void stage_rc(int b, int& R, int& C) { const int st = b / 1024, sb = b % 1024, swz = sb ^ (((sb >> 9) & 1) << 5); R = (st >> 1) * 16 + swz / 64; C = (st & 1) * 32 + (swz % 64) / 2; }
__host__ __device__ __forceinline__ int perm32(int rho) { const int n = rho >> 4, i = rho & 15; return 8 * (i >> 2) + 4 * n + (i & 3); }

struct Unit { int pm, pn, z; size_t a_off, b_off; };
struct Gemm { const char* A; const char* Bt; int lda, ldb, K; };

__host__ __device__ __forceinline__ void tile_map(int L, int nM, int nN, int& pm, int& pn) {
    const int nwg = nM * nN; int wgid = L;
    { const int q = nwg / NXCD, r = nwg % NXCD, xcd = wgid % NXCD, off = wgid / NXCD; wgid = (xcd < r ? xcd * (q + 1) : r * (q + 1) + (xcd - r) * q) + off; }
    const int nig = WGM * nN, gid = wgid / nig, fm = gid * WGM, gsz = (nM - fm) < WGM ? (nM - fm) : WGM;
    pm = fm + ((wgid % nig) % gsz); pn = (wgid % nig) / gsz;
}

__device__ __forceinline__ unsigned cvt_pk_bf16(float lo, float hi) { unsigned r; asm volatile("v_cvt_pk_bf16_f32 %0, %1, %2" : "=v"(r) : "v"(lo), "v"(hi)); return r; }

template <class Epi, class Sched, bool ALIGN_EPI>
__device__ __forceinline__ void gemm_phase(PG8_LAS unsigned char* lds, const Gemm g, const Sched& S, const Epi& E, const int wid) {
    int lane_; asm volatile("v_mbcnt_lo_u32_b32 %0, -1, 0\n\tv_mbcnt_hi_u32_b32 %0, -1, %0" : "=v"(lane_));
    const int lane = lane_, tid = wid * 64 + lane, wr = wid >> 2, wc = wid & 3, fr = lane & 15, fq = lane >> 4;
    const int K = g.K, nt = K / BK;
    unsigned voffA[2], voffB[2];
#pragma unroll
    for (int i = 0; i < 2; ++i) { int R, C; stage_rc(tid * 16 + i * 8192, R, C); const int Rb = Epi::PERM ? ((R & ~31) + perm32(R & 31)) : R;
        voffA[i] = (unsigned)(R * g.lda + C) * 2u; voffB[i] = (unsigned)(Rb * g.ldb + C) * 2u; }
    const size_t kstep = (size_t)(BK * 2);
    const size_t hstepA = (size_t)HALF * g.lda * 2, hstepB = (size_t)HALF * g.ldb * 2;
    const unsigned ldsw = (unsigned)wid * 1024u;
    const int aoff = lds_byte(wr * 64 + fr, fq * 8), boff = lds_byte(wc * 32 + fr, fq * 8);
#define PG8_SA(b, h) (((b) * 2 + (h)) * HTB)
#define PG8_SB(b, h) ((4 + (b) * 2 + (h)) * HTB)
#define PG8_STAGE(bufoff, gbase, voff) do { _Pragma("unroll") for (int _i = 0; _i < 2; ++_i) \
        __builtin_amdgcn_global_load_lds((const unsigned*)((const char*)(gbase) + (voff)[_i]), (PG8_LAS unsigned*)(lds + (bufoff) + ldsw + _i * 8192), 16, 0, 0); } while (0)
#define PG8_LDA(dst, b, h) do { _Pragma("unroll") for (int m = 0; m < 4; ++m) _Pragma("unroll") for (int k = 0; k < 2; ++k) dst[m][k] = *(const PG8_LAS bf16x8*)(lds + PG8_SA(b, h) + aoff + m * 2048 + k * 1024); } while (0)
#define PG8_LDB(dst, b, h) do { _Pragma("unroll") for (int n = 0; n < 2; ++n) _Pragma("unroll") for (int k = 0; k < 2; ++k) dst[n][k] = *(const PG8_LAS bf16x8*)(lds + PG8_SB(b, h) + boff + n * 2048 + k * 1024); } while (0)
#define PG8_MMA(ai, bj, At, Bt) do { __builtin_amdgcn_s_setprio(1); _Pragma("unroll") for (int m = 0; m < 4; ++m) _Pragma("unroll") for (int n = 0; n < 2; ++n) _Pragma("unroll") for (int k = 0; k < 2; ++k) \
        acc[ai][bj][m][n] = __builtin_amdgcn_mfma_f32_16x16x32_bf16(Bt[n][k], At[m][k], acc[ai][bj][m][n], 0, 0, 0); __builtin_amdgcn_s_setprio(0); } while (0)
#define PG8_WAIT_V(n) asm volatile("s_waitcnt vmcnt(" #n ")" ::: "memory")
#define PG8_WAIT_L(n) asm volatile("s_waitcnt lgkmcnt(" #n ")" ::: "memory")
#define PG8_BAR __builtin_amdgcn_s_barrier()
#define PG8_SCHED __builtin_amdgcn_sched_barrier(0)
    Unit cur, nxt; int ui = 0;
    if (!S.next(0, cur)) return;
    f32x4 acc[2][2][4][2];
#pragma unroll
    for (int a = 0; a < 2; ++a)
#pragma unroll
        for (int b = 0; b < 2; ++b)
#pragma unroll
            for (int m = 0; m < 4; ++m)
#pragma unroll
                for (int n = 0; n < 2; ++n) acc[a][b][m][n] = (f32x4){0.f, 0.f, 0.f, 0.f};
    bf16x8 At[4][2], B0[2][2], B1[2][2];
    const char* cA = g.A + cur.a_off; const char* cB = g.Bt + cur.b_off;
    PG8_STAGE(PG8_SB(0, 0), cB, voffB); PG8_STAGE(PG8_SB(0, 1), cB + hstepB, voffB); PG8_STAGE(PG8_SA(0, 0), cA, voffA); PG8_STAGE(PG8_SA(0, 1), cA + hstepA, voffA);
    if (wr == 1) PG8_BAR;
    PG8_WAIT_V(2); PG8_BAR;
    PG8_STAGE(PG8_SB(1, 0), cB + kstep, voffB); PG8_STAGE(PG8_SA(1, 0), cA + kstep, voffA); PG8_STAGE(PG8_SB(1, 1), cB + hstepB + kstep, voffB);
    PG8_WAIT_V(6); PG8_BAR;
    for (;;) {
        const bool has_next = S.next(ui + 1, nxt);
        const char* nA = has_next ? g.A + nxt.a_off : cA; const char* nB = has_next ? g.Bt + nxt.b_off : cB;
        for (int t = 0; t < nt; t += 2) {
            const bool last = (t == nt - 2);
            const char* a1 = cA + (size_t)(t + 1) * kstep;
            const char* a2 = last ? nA : cA + (size_t)(t + 2) * kstep; const char* b2 = last ? nB : cB + (size_t)(t + 2) * kstep;
            const char* a3 = a2 + kstep; const char* b3 = b2 + kstep;
            PG8_LDB(B0, 0, 0); PG8_LDB(B1, 0, 1); PG8_SCHED; PG8_LDA(At, 0, 0); PG8_STAGE(PG8_SA(1, 1), a1 + hstepA, voffA);
            PG8_WAIT_V(8); PG8_WAIT_L(0); PG8_BAR; PG8_MMA(0, 0, At, B0); PG8_MMA(0, 1, At, B1); PG8_BAR; PG8_SCHED;
            PG8_LDA(At, 0, 1); PG8_STAGE(PG8_SB(0, 0), b2, voffB); PG8_STAGE(PG8_SB(0, 1), b2 + hstepB, voffB); PG8_STAGE(PG8_SA(0, 0), a2, voffA);
            PG8_WAIT_V(8); PG8_WAIT_L(0); PG8_BAR; PG8_MMA(1, 0, At, B0); PG8_MMA(1, 1, At, B1); PG8_BAR; PG8_SCHED;
            PG8_LDB(B0, 1, 0); PG8_LDB(B1, 1, 1); PG8_SCHED; PG8_LDA(At, 1, 0); PG8_STAGE(PG8_SA(0, 1), a2 + hstepA, voffA);
            PG8_WAIT_V(8); PG8_WAIT_L(0); PG8_BAR; PG8_MMA(0, 0, At, B0); PG8_MMA(0, 1, At, B1); PG8_BAR; PG8_SCHED;
            PG8_LDA(At, 1, 1); PG8_STAGE(PG8_SB(1, 0), b3, voffB); PG8_STAGE(PG8_SB(1, 1), b3 + hstepB, voffB); PG8_STAGE(PG8_SA(1, 0), a3, voffA);
            PG8_WAIT_V(8); PG8_WAIT_L(0); PG8_BAR; PG8_MMA(1, 0, At, B0); PG8_MMA(1, 1, At, B1); PG8_BAR; PG8_SCHED;
        }
        if constexpr (ALIGN_EPI) { if (wr == 0) PG8_BAR; }
        E(acc, cur, wr, wc, fr, fq, lane);
        if (!has_next) break;
#pragma unroll
        for (int a = 0; a < 2; ++a)
#pragma unroll
            for (int b = 0; b < 2; ++b)
#pragma unroll
                for (int m = 0; m < 4; ++m)
#pragma unroll
                    for (int n = 0; n < 2; ++n) acc[a][b][m][n] = (f32x4){0.f, 0.f, 0.f, 0.f};
        cur = nxt; cA = nA; cB = nB; ++ui;
        if constexpr (ALIGN_EPI) { if (wr == 1) PG8_BAR; }
    }
    PG8_WAIT_V(0);
    if constexpr (!ALIGN_EPI) { if (wr == 0) PG8_BAR; }
    PG8_BAR;
#undef PG8_SA
#undef PG8_SB
#undef PG8_STAGE
#undef PG8_LDA
#undef PG8_LDB
#undef PG8_MMA
#undef PG8_WAIT_V
#undef PG8_WAIT_L
#undef PG8_BAR
#undef PG8_SCHED
}
}
namespace pg8 {
struct EpiStoreBf16 {
    static constexpr bool PERM = true;
    bf16_t* O0; int ldc0; bf16_t* O1; int ldc1;
    int mode;
    __device__ __forceinline__ void operator()(const f32x4 (&acc)[2][2][4][2], const Unit& u, int wr, int wc, int fr, int fq, int lane) const {
        asm volatile("" : "+v"(fr), "+v"(fq), "+v"(lane));
        bf16_t* base; int ldc; size_t row0; int colt;
        if (mode == 0) { base = u.z ? O1 : O0; ldc = u.z ? ldc1 : ldc0; row0 = (size_t)u.pm * BM; colt = u.pn * BM; }
        else if (mode == 1) { base = O0; ldc = ldc0; row0 = (size_t)u.pm * 1024 + (size_t)u.z * 256; colt = u.pn * BM; }
        else { base = O0 + (size_t)(u.z >> 2) * 1048576; ldc = ldc0; row0 = (size_t)u.pm * BM; colt = (u.z & 3) * 256; }
        const int col0 = colt + wc * 32 + 8 * fq;
#pragma unroll
        for (int ai = 0; ai < 2; ++ai)
#pragma unroll
            for (int m = 0; m < 4; ++m) { bf16_t* rowp = base + (row0 + wr * 64 + fr + ai * HALF + m * 16) * ldc + col0;
#pragma unroll
                for (int bj = 0; bj < 2; ++bj) { const f32x4 v0 = acc[ai][bj][m][0], v1 = acc[ai][bj][m][1];
                    u32x4 w; w.x = cvt_pk_bf16(v0[0], v0[1]); w.y = cvt_pk_bf16(v0[2], v0[3]); w.z = cvt_pk_bf16(v1[0], v1[1]); w.w = cvt_pk_bf16(v1[2], v1[3]);
                    *(u32x4*)(rowp + bj * HALF) = w; } }
    }
};

__device__ __forceinline__ float row_rstd(const float* ss, size_t row) {
    const f32x4* p = (const f32x4*)(ss + row * 16); const f32x4 a = p[0], b = p[1], c = p[2], d = p[3];
    const float s = ((a[0] + a[1]) + (a[2] + a[3])) + ((b[0] + b[1]) + (b[2] + b[3])) + ((c[0] + c[1]) + (c[2] + c[3])) + ((d[0] + d[1]) + (d[2] + d[3]));
    return 1.0f / sqrtf(s * (1.0f / 1024.0f) + 1e-6f);
}
__device__ __forceinline__ void wave_rstd(float (&rs)[2][4], const float* ss, int pm, int wr, int fr, int lane) {
    const float my0 = row_rstd(ss, (size_t)pm * BM + wr * 64 + lane), my1 = row_rstd(ss, (size_t)pm * BM + HALF + wr * 64 + lane);
#pragma unroll
    for (int m = 0; m < 4; ++m) { rs[0][m] = __shfl(my0, m * 16 + fr); rs[1][m] = __shfl(my1, m * 16 + fr); }
}

struct EpiRes {
    static constexpr bool PERM = false;
    const float* base; float* out; bf16_t* hb; float* ss; int ldc;
    __device__ __forceinline__ void operator()(f32x4 (&acc)[2][2][4][2], const Unit& u, int wr, int wc, int fr, int fq, int lane) const {
        asm volatile("" : "+v"(fr), "+v"(fq), "+v"(lane));
        const int col0 = u.pn * BM + wc * 32 + 4 * fq;
#pragma unroll
        for (int ai = 0; ai < 2; ++ai)
#pragma unroll
            for (int m = 0; m < 4; ++m) { const size_t row = (size_t)u.pm * BM + ai * HALF + wr * 64 + m * 16 + fr; const size_t off = row * ldc + col0; float q = 0.f;
#pragma unroll
                for (int bj = 0; bj < 2; ++bj)
#pragma unroll
                    for (int n = 0; n < 2; ++n) { const f32x4 bs = *(const f32x4*)(base + off + bj * HALF + n * 16); const f32x4 o = bs + acc[ai][bj][m][n];
                        *(f32x4*)(out + off + bj * HALF + n * 16) = o; q += (o[0] * o[0] + o[1] * o[1]) + (o[2] * o[2] + o[3] * o[3]);
                        if (hb) { u32x2 w; w.x = cvt_pk_bf16(o[0], o[1]); w.y = cvt_pk_bf16(o[2], o[3]); *(u32x2*)(hb + off + bj * HALF + n * 16) = w; } }
                q += __shfl_xor(q, 16); q += __shfl_xor(q, 32);
                if (fq == 0) ss[row * 16 + u.pn * 4 + wc] = q;
                if (m & 1) asm volatile("" ::: "memory"); }
    }
};

struct EpiSqRelu {
    static constexpr bool PERM = true;
    bf16_t* O; int ldc; const float* ss;
    __device__ __forceinline__ void operator()(const f32x4 (&acc)[2][2][4][2], const Unit& u, int wr, int wc, int fr, int fq, int lane) const {
        asm volatile("" : "+v"(fr), "+v"(fq), "+v"(lane));
        float rs[2][4]; wave_rstd(rs, ss, u.pm, wr, fr, lane);
        const int col0 = u.pn * BM + wc * 32 + 8 * fq;
#pragma unroll
        for (int ai = 0; ai < 2; ++ai)
#pragma unroll
            for (int m = 0; m < 4; ++m) { bf16_t* rowp = O + ((size_t)u.pm * BM + wr * 64 + fr + ai * HALF + m * 16) * ldc + col0; const float s = rs[ai][m];
#pragma unroll
                for (int bj = 0; bj < 2; ++bj) { f32x4 v0 = acc[ai][bj][m][0] * s, v1 = acc[ai][bj][m][1] * s;
#pragma unroll
                    for (int i = 0; i < 4; ++i) { const float a = fmaxf(v0[i], 0.f), b = fmaxf(v1[i], 0.f); v0[i] = a * a; v1[i] = b * b; }
                    u32x4 w; w.x = cvt_pk_bf16(v0[0], v0[1]); w.y = cvt_pk_bf16(v0[2], v0[3]); w.z = cvt_pk_bf16(v1[0], v1[1]); w.w = cvt_pk_bf16(v1[2], v1[3]);
                    *(u32x4*)(rowp + bj * HALF) = w; } }
    }
};

struct EpiSoftmax {
    static constexpr bool PERM = true;
    bf16_t* O; int ldc; const float* ss; PG8_LAS f32x2* xl;
    __device__ __forceinline__ void operator()(f32x4 (&acc)[2][2][4][2], const Unit& u, int wr, int wc, int fr, int fq, int lane) const {
        asm volatile("" : "+v"(fr), "+v"(fq), "+v"(lane));
        float rs[2][4]; wave_rstd(rs, ss, u.pm, wr, fr, lane);
#pragma unroll
        for (int ai = 0; ai < 2; ++ai)
#pragma unroll
            for (int m = 0; m < 4; ++m) { const float s = rs[ai][m] * (0.0625f * 1.4426950408889634f); float mx = -INFINITY;
#pragma unroll
                for (int bj = 0; bj < 2; ++bj)
#pragma unroll
                    for (int n = 0; n < 2; ++n) { f32x4 v = acc[ai][bj][m][n] * s; acc[ai][bj][m][n] = v; mx = fmaxf(fmaxf(mx, fmaxf(v[0], v[1])), fmaxf(v[2], v[3])); }
                mx = fmaxf(mx, __shfl_xor(mx, 16)); mx = fmaxf(mx, __shfl_xor(mx, 32)); float sm = 0.f;
#pragma unroll
                for (int bj = 0; bj < 2; ++bj)
#pragma unroll
                    for (int n = 0; n < 2; ++n) { f32x4 v = acc[ai][bj][m][n];
#pragma unroll
                        for (int i = 0; i < 4; ++i) { v[i] = __builtin_amdgcn_exp2f(v[i] - mx); sm += v[i]; } acc[ai][bj][m][n] = v; }
                sm += __shfl_xor(sm, 16); sm += __shfl_xor(sm, 32);
                if (fq == 0) xl[(ai * HALF + wr * 64 + m * 16 + fr) * 4 + wc] = (f32x2){mx, sm}; }
        asm volatile("s_waitcnt lgkmcnt(0)" ::: "memory"); __builtin_amdgcn_s_barrier(); asm volatile("" ::: "memory");
        const int col0 = u.pn * BM + wc * 32 + 8 * fq;
#pragma unroll
        for (int ai = 0; ai < 2; ++ai)
#pragma unroll
            for (int m = 0; m < 4; ++m) { const int r = ai * HALF + wr * 64 + m * 16 + fr;
                const f32x4 x01 = *(const PG8_LAS f32x4*)(xl + r * 4), x23 = *(const PG8_LAS f32x4*)(xl + r * 4 + 2);
                const float mg = fmaxf(fmaxf(x01[0], x01[2]), fmaxf(x23[0], x23[2]));
                const float tot = x01[1] * __builtin_amdgcn_exp2f(x01[0] - mg) + x01[3] * __builtin_amdgcn_exp2f(x01[2] - mg) + x23[1] * __builtin_amdgcn_exp2f(x23[0] - mg) + x23[3] * __builtin_amdgcn_exp2f(x23[2] - mg);
                const float mown = wc == 0 ? x01[0] : (wc == 1 ? x01[2] : (wc == 2 ? x23[0] : x23[2]));
                const float f = __builtin_amdgcn_exp2f(mown - mg) / tot;
                bf16_t* rowp = O + ((size_t)u.pm * BM + r) * ldc + col0;
#pragma unroll
                for (int bj = 0; bj < 2; ++bj) { const f32x4 v0 = acc[ai][bj][m][0] * f, v1 = acc[ai][bj][m][1] * f;
                    u32x4 w; w.x = cvt_pk_bf16(v0[0], v0[1]); w.y = cvt_pk_bf16(v0[2], v0[3]); w.z = cvt_pk_bf16(v1[0], v1[1]); w.w = cvt_pk_bf16(v1[2], v1[3]);
                    *(u32x4*)(rowp + bj * HALF) = w; } }
    }
};
}
constexpr int NWAVES = 8;
constexpr int BATCH = 4, T = 8192, D = 1024, M = BATCH * T;
constexpr int NIN = 3328, RW = 512, NH = 8, HD = 64;
constexpr int ZK_R = 512, ZV_R = 1024, ZWD = 1536, ZAD = 1600, ZGD = 1664;
constexpr int ZQ = 1792, ZK = 1792 + 512, ZV = 1792 + 1024;
constexpr int MEML = 256, MEMR = BATCH * MEML, FF = 4096;
constexpr int NBLK = T / 256;
constexpr float NORM_EPS = 1e-6f, GN_EPS = 64e-5f, DECAY_SCALE = 0.6065306597126334f;

constexpr size_t MiB = 1u << 20;
constexpr size_t WS_CTL = 0, CTL_ZERO_BYTES = 1 * MiB;
constexpr size_t WS_WIN_T = 1 * MiB, WS_WMIX_T = 8 * MiB, WS_WQ_S = 10 * MiB, WS_WXKV_T = 12 * MiB, WS_WO_T = 16 * MiB, WS_W1_T = 18 * MiB, WS_W2_T = 26 * MiB;
constexpr size_t WS_MEMN = 34 * MiB, WS_KV = 36 * MiB, WS_GT = 40 * MiB, WS_VWT = 48 * MiB;
constexpr size_t WS_SS = 56 * MiB;
constexpr size_t WS_KMEAN = 62 * MiB, WS_BON = 63 * MiB;
constexpr size_t WS_XN = 64 * MiB;
constexpr size_t WS_GATE = 64 * MiB, WS_YRAW = 96 * MiB;
constexpr size_t WS_HB = 64 * MiB;
constexpr size_t WS_Z = 128 * MiB;
constexpr size_t WS_Y = 336 * MiB;
constexpr size_t WS_PR = 400 * MiB, WS_PV = 432 * MiB;
constexpr size_t WS_P = 400 * MiB;
constexpr size_t WS_AH = 128 * MiB;
constexpr size_t WS_END = 512 * MiB;
constexpr size_t DO_W = 0, DO_KP = 32 * MiB, DO_KKN = 64 * MiB, DO_B = 96 * MiB;

constexpr int CW_TMO = 0, CW_CODE = 1;
constexpr int CW_BAR = 4096;

constexpr int RING_OFF = 0, RING_BYTES = 131072;
constexpr int LDSCTL_OFF = RING_BYTES, MISC_OFF = LDSCTL_OFF + 320;
constexpr int EPI_LDS_OFF = 132096;
constexpr int LDS_BYTES = 147456;
static_assert(MISC_OFF + 128 <= EPI_LDS_OFF && EPI_LDS_OFF + 8192 <= LDS_BYTES, "LDS map");

#define GAS __attribute__((address_space(1)))
#define LAS __attribute__((address_space(3)))
typedef unsigned short bf16;
typedef unsigned v4u __attribute__((ext_vector_type(4)));
typedef float f32x4 __attribute__((ext_vector_type(4)));
typedef GAS unsigned gu32;
#define RLX_AGENT __ATOMIC_RELAXED, __HIP_MEMORY_SCOPE_AGENT
#define LDS_WAIT() asm volatile("s_waitcnt lgkmcnt(0)" ::: "memory")
#define VM_WAIT() asm volatile("s_waitcnt vmcnt(0)" ::: "memory")
__device__ __forceinline__ unsigned f2bf(float f) { unsigned u = __builtin_bit_cast(unsigned, f); return (u + 0x7fffu + ((u >> 16) & 1u)) >> 16; }
__device__ __forceinline__ unsigned pk2(float lo, float hi) { return f2bf(lo) | (f2bf(hi) << 16); }
__device__ __forceinline__ float bf2f(unsigned short u) { return __builtin_bit_cast(float, (unsigned)u << 16); }
__device__ __forceinline__ float bflo(unsigned u) { return __builtin_bit_cast(float, u << 16); }
__device__ __forceinline__ float bfhi(unsigned u) { return __builtin_bit_cast(float, u & 0xffff0000u); }

#define XB_TMO      128
#define XB_XCNT(j)  (256  + 64 * (j))
#define XB_XSUB(j)  (1280 + 64 * (j))
#define XB_XGEN(j)  (2304 + 64 * (j))
#define XB_TOP      3328
#define XB_TOPGEN   3392
#define XCD_BAR_WORDS 3456
#define XB_SPIN_CAP (1u << 18)
__device__ __forceinline__ unsigned xb_ld(unsigned* p)              { return __hip_atomic_load(p, __ATOMIC_RELAXED, __HIP_MEMORY_SCOPE_AGENT); }
__device__ __forceinline__ unsigned xb_add(unsigned* p, unsigned v) { return __hip_atomic_fetch_add(p, v, __ATOMIC_RELAXED, __HIP_MEMORY_SCOPE_AGENT); }
__device__ __forceinline__ unsigned xb_xcc_id() { return (unsigned)__builtin_amdgcn_s_getreg((3 << 11) | 20) & 0xFu; }
#define XB_SPIN(cond, bar) do { unsigned _sp = 0; while (cond) { __builtin_amdgcn_s_sleep(1); \
    if ((++_sp & 255u) == 0u) { if (xb_ld(&(bar)[XB_TMO])) break; if (_sp > XB_SPIN_CAP) { atomicAdd(&(bar)[XB_TMO], 1u); break; } } } } while (0)
struct XcdBarrier { unsigned* bar; unsigned x; volatile LAS unsigned* st; };
__device__ __forceinline__ XcdBarrier xcd_barrier_post(unsigned* bar, volatile LAS unsigned* st) {
    XcdBarrier b; b.bar = bar; b.x = xb_xcc_id(); b.st = st;
    if (threadIdx.x == 0) (void)xb_add(&bar[XB_XCNT(b.x)], 1u);
    return b;
}
__device__ __forceinline__ void xcd_barrier_complete(unsigned* bar, unsigned x, unsigned& nloc, unsigned& nx) {
    const unsigned G = gridDim.x * gridDim.y * gridDim.z;
    unsigned sum, cnt, mine, sp = 0u;
    for (;;) {
        sum = 0u; cnt = 0u; mine = 0u;
#pragma unroll
        for (unsigned j = 0; j < 16; ++j) { const unsigned c = xb_ld(&bar[XB_XCNT(j)]); sum += c; cnt += (c > 0u) ? 1u : 0u; mine = (j == x) ? c : mine; }
        if (sum == G) break;
        __builtin_amdgcn_s_sleep(1);
        if ((++sp & 255u) == 0u) { if (xb_ld(&bar[XB_TMO])) break; if (sp > XB_SPIN_CAP) { atomicAdd(&bar[XB_TMO], 1u); break; } }
    }
    nloc = mine > 0u ? mine : 1u; nx = cnt > 0u ? cnt : 1u;
}
__device__ __forceinline__ void xcd_barrier(const XcdBarrier& b) {
    asm volatile("s_waitcnt vmcnt(0)" ::: "memory");
    __syncthreads();
    if (threadIdx.x == 0) {
        unsigned* bar = b.bar;
        __builtin_amdgcn_s_waitcnt(0);
        unsigned nloc = b.st[0], nx = b.st[1];
        if (nloc == 0u) { xcd_barrier_complete(bar, b.x, nloc, nx); b.st[0] = nloc; b.st[1] = nx; }
        const unsigned old = xb_add(&bar[XB_XSUB(b.x)], 1u);
        const unsigned gen = old / nloc;
        if (old + 1u == (gen + 1u) * nloc) {
            __builtin_amdgcn_fence(__ATOMIC_RELEASE, "agent");
            asm volatile("s_waitcnt vmcnt(0)" ::: "memory");
            const unsigned og = xb_add(&bar[XB_TOP], 1u);
            const unsigned tg = og / nx;
            if (og + 1u == (tg + 1u) * nx) xb_add(&bar[XB_TOPGEN], 1u);
            else XB_SPIN(xb_ld(&bar[XB_TOPGEN]) == tg, bar);
            __builtin_amdgcn_fence(__ATOMIC_ACQUIRE, "agent");
            xb_add(&bar[XB_XGEN(b.x)], 1u);
            asm volatile("s_waitcnt vmcnt(0)" ::: "memory");
        } else {
            XB_SPIN(xb_ld(&bar[XB_XGEN(b.x)]) == gen, bar);
            __builtin_amdgcn_fence(__ATOMIC_ACQUIRE, "agent");
            asm volatile("s_waitcnt vmcnt(0)" ::: "memory");
        }
    }
    __syncthreads();
}

struct Frame {
    LAS unsigned char* lds;
    volatile LAS unsigned* MISC;
    gu32* ctl;
    int tid, lane, wave;
    int vcu, G;
    unsigned char* ws; unsigned char* dout;
    const float* in[25];
};
__device__ __forceinline__ float wave_sum(float v) {
#pragma unroll
    for (int o = 1; o < 64; o <<= 1) v += __shfl_xor(v, o);
    return v;
}
__device__ __forceinline__ float wave_max(float v) {
#pragma unroll
    for (int o = 1; o < 64; o <<= 1) v = fmaxf(v, __shfl_xor(v, o));
    return v;
}
template <int CTRL> __device__ __forceinline__ float dpp_mov(float x) { return __builtin_bit_cast(float, __builtin_amdgcn_update_dpp(0, __builtin_bit_cast(int, x), CTRL, 0xf, 0xf, false)); }
__device__ __forceinline__ float red16(float x) { x += dpp_mov<0xB1>(x); x += dpp_mov<0x4E>(x); x += dpp_mov<0x124>(x); x += dpp_mov<0x128>(x); return x; }
__device__ __forceinline__ void p0_transpose_item(const float* W, int K, int N, bf16* WT, const float* kscale, LAS float* scr, int item, int lane) {
    const int nblk = N / 32, kb = item / nblk, nb = item % nblk, k0 = 64 * kb, n0 = 32 * nb;
#pragma unroll 8
    for (int i = 0; i < 32; ++i) { const int kk = 2 * i + (lane >> 5); const float s = kscale ? kscale[k0 + kk] : 1.f; scr[kk * 33 + (lane & 31)] = W[(size_t)(k0 + kk) * N + n0 + (lane & 31)] * s; }
    LDS_WAIT(); asm volatile("" ::: "memory");
    const int c = lane & 7;
#pragma unroll
    for (int j = 0; j < 4; ++j) { const int n = (lane >> 3) + 8 * j; const LAS float* s = scr + (8 * c) * 33 + n;
        v4u o; o.x = pk2(s[0 * 33], s[1 * 33]); o.y = pk2(s[2 * 33], s[3 * 33]); o.z = pk2(s[4 * 33], s[5 * 33]); o.w = pk2(s[6 * 33], s[7 * 33]);
        *(GAS v4u*)(WT + (size_t)(n0 + n) * K + k0 + 8 * c) = o; }
    LDS_WAIT(); asm volatile("" ::: "memory");
}
__device__ __forceinline__ void rms_row_to_bf16(const float* xrow, const float* g, bf16* orow, int lane) {
    const GAS f32x4* xr = (const GAS f32x4*)xrow + lane; const GAS f32x4* gr = (const GAS f32x4*)g + lane;
    f32x4 v[4]; float s = 0.f;
#pragma unroll
    for (int j = 0; j < 4; ++j) { v[j] = xr[64 * j]; s += (v[j].x * v[j].x + v[j].y * v[j].y) + (v[j].z * v[j].z + v[j].w * v[j].w); }
    const float rstd = 1.f / sqrtf(wave_sum(s) * (1.f / D) + NORM_EPS);
    GAS unsigned long long* o8 = (GAS unsigned long long*)orow + lane;
#pragma unroll
    for (int j = 0; j < 4; ++j) { const f32x4 gg = gr[64 * j]; o8[64 * j] = (unsigned long long)pk2(v[j].x * rstd * gg.x, v[j].y * rstd * gg.y) | ((unsigned long long)pk2(v[j].z * rstd * gg.z, v[j].w * rstd * gg.w) << 32); }
}
__device__ __forceinline__ void p0_prologue(Frame& F) {
    LAS float* scr = (LAS float*)(F.lds + RING_OFF + F.wave * 16384);
    const int gw = F.vcu * NWAVES + F.wave, NGW = F.G * NWAVES;
    constexpr int I_IN = (D / 64) * (NIN / 32), I_MIX = (D / 64) * (D / 32), I_KV = (D / 64) * (2 * D / 32), I_O = I_MIX, I_1 = (D / 64) * (FF / 32), I_2 = (FF / 64) * (D / 32);
    constexpr int NITEMS = I_IN + I_MIX + I_KV + I_O + I_1 + I_2;
    for (int it = gw; it < NITEMS; it += NGW) {
        int r = it;
        if (r < I_IN) { p0_transpose_item(F.in[3], D, NIN, (bf16*)(F.ws + WS_WIN_T), nullptr, scr, r, F.lane); continue; } r -= I_IN;
        if (r < I_MIX) { p0_transpose_item(F.in[15], D, D, (bf16*)(F.ws + WS_WMIX_T), nullptr, scr, r, F.lane); continue; } r -= I_MIX;
        if (r < I_KV) { p0_transpose_item(F.in[19], D, 2 * D, (bf16*)(F.ws + WS_WXKV_T), nullptr, scr, r, F.lane); continue; } r -= I_KV;
        if (r < I_O) { p0_transpose_item(F.in[20], D, D, (bf16*)(F.ws + WS_WO_T), nullptr, scr, r, F.lane); continue; } r -= I_O;
        if (r < I_1) { p0_transpose_item(F.in[22], D, FF, (bf16*)(F.ws + WS_W1_T), F.in[21], scr, r, F.lane); continue; } r -= I_1;
        p0_transpose_item(F.in[23], FF, D, (bf16*)(F.ws + WS_W2_T), nullptr, scr, r, F.lane);
    }
    { const float* wq = F.in[18]; const float* gx = F.in[16]; bf16* o = (bf16*)(F.ws + WS_WQ_S);
      for (int i = (F.vcu * 512 + F.tid); i < D * D / 4; i += F.G * 512) { const f32x4 v = ((const GAS f32x4*)wq)[i]; const float s = gx[(i * 4) / D];
          ((GAS unsigned long long*)o)[i] = (unsigned long long)pk2(v.x * s, v.y * s) | ((unsigned long long)pk2(v.z * s, v.w * s) << 32); } }
    for (int m = gw; m < M; m += NGW) rms_row_to_bf16(F.in[0] + (size_t)m * D, F.in[2], (bf16*)(F.ws + WS_XN) + (size_t)m * D, F.lane);
    for (int m = gw; m < MEMR; m += NGW) rms_row_to_bf16(F.in[1] + (size_t)m * D, F.in[17], (bf16*)(F.ws + WS_MEMN) + (size_t)m * D, F.lane);
}

__device__ __forceinline__ float zshift(const bf16* Z, const float* mu, int m, int col) {
    const float z = bf2f(Z[(size_t)m * NIN + col]); const float zp = (m % T == 0) ? 0.f : bf2f(Z[(size_t)(m - 1) * NIN + col]);
    return z + (zp - z) * mu[col];
}
__device__ __forceinline__ void rwkv_prep_simple(Frame& F) {
    const bf16* Z = (const bf16*)(F.ws + WS_Z); const float* mu = F.in[4];
    LAS float* lo = (LAS float*)(F.lds + RING_OFF);
    const int c = F.tid;
    const float w0 = F.in[5][c], a0 = F.in[7][c], kkc = F.in[10][c], kac = F.in[11][c], rkc = F.in[12][c];
    const float* wup = F.in[6]; const float* aup = F.in[8]; const float* gup = F.in[9];
    bf16* oR = (bf16*)(F.ws + WS_PR); bf16* oV = (bf16*)(F.ws + WS_PV); bf16* oW = (bf16*)(F.dout + DO_W); bf16* oKP = (bf16*)(F.dout + DO_KP); bf16* oKK = (bf16*)(F.dout + DO_KKN); bf16* oB = (bf16*)(F.dout + DO_B);
    bf16* oG = (bf16*)(F.ws + WS_GATE); float* oBon = (float*)(F.ws + WS_BON);
    for (int m0 = F.vcu * 4; m0 < M; m0 += F.G * 4) {
#pragma unroll
        for (int i = 0; i < 2; ++i) { const int e = F.tid + 512 * i, tk = e >> 8, j = e & 255; const float zs = zshift(Z, mu, m0 + tk, ZWD + j);
            lo[e] = j < 64 ? tanhf(zs) : (j < 128 ? zs : 1.f / (1.f + __expf(-zs))); }
        __syncthreads();
        float aw[4], aa[4], ag[4];
#pragma unroll
        for (int k = 0; k < 4; ++k) { aw[k] = 0.f; aa[k] = 0.f; ag[k] = 0.f; }
        for (int j = 0; j < 64; ++j) { const float wv = wup[j * RW + c], av = aup[j * RW + c];
#pragma unroll
            for (int k = 0; k < 4; ++k) { aw[k] += lo[k * 256 + j] * wv; aa[k] += lo[k * 256 + 64 + j] * av; } }
        for (int j = 0; j < 128; ++j) { const float gv = gup[j * RW + c];
#pragma unroll
            for (int k = 0; k < 4; ++k) ag[k] += lo[k * 256 + 128 + j] * gv; }
#pragma unroll
        for (int k = 0; k < 4; ++k) { const int m = m0 + k;
            const float r = zshift(Z, mu, m, c), kx = zshift(Z, mu, m, ZK_R + c), v = zshift(Z, mu, m, ZV_R + c);
            const float dec = __expf(-DECAY_SCALE / (1.f + __expf(-(w0 + aw[k]))));
            const float a = 1.f / (1.f + __expf(-(a0 + aa[k])));
            const float kk = kx * kkc; const float nn = wave_sum(kk * kk); const float kkn = kk / fmaxf(sqrtf(nn), 1e-12f);
            const float kp = kx * (1.f + (a - 1.f) * kac);
            const float bon = wave_sum(r * kp * rkc);
            const size_t o = (size_t)m * RW + c;
            oR[o] = (bf16)f2bf(r); oV[o] = (bf16)f2bf(v); oW[o] = (bf16)f2bf(dec); oKP[o] = (bf16)f2bf(kp); oKK[o] = (bf16)f2bf(kkn); oB[o] = (bf16)f2bf(kkn * a); oG[o] = (bf16)f2bf(ag[k]);
            if (F.lane == 0) oBon[(size_t)m * NH + F.wave] = bon; }
        __syncthreads();
    }
}
__device__ __forceinline__ void kmean_simple(Frame& F) {
    const bf16* Z = (const bf16*)(F.ws + WS_Z); float* KM = (float*)(F.ws + WS_KMEAN);
    const int gw = F.vcu * NWAVES + F.wave, NGW = F.G * NWAVES;
    for (int u = gw; u < BATCH * NH * NBLK; u += NGW) { const int j = u % NBLK, bh = u / NBLK, b = bh / NH, h = bh % NH;
        const bf16* kp = Z + ((size_t)b * T + j * 256) * NIN + ZK + h * HD + F.lane; float s = 0.f;
        for (int i = 0; i < 256; ++i) s += bf2f(kp[(size_t)i * NIN]);
        KM[(size_t)u * HD + F.lane] = s * (1.f / 256.f); }
}
constexpr int SC_TC = 32, SC_REC = 352;
__device__ __forceinline__ void scan_simple(Frame& F, int unit) {
    const int bh = unit >> 1, hf = unit & 1, b = bh / NH, h = bh % NH;
    const size_t rowbase = (size_t)b * T;
    const bf16* aR = (const bf16*)(F.ws + WS_PR); const bf16* aV = (const bf16*)(F.ws + WS_PV); const bf16* aW = (const bf16*)(F.dout + DO_W); const bf16* aKP = (const bf16*)(F.dout + DO_KP);
    const bf16* aKK = (const bf16*)(F.dout + DO_KKN); const bf16* aB = (const bf16*)(F.dout + DO_B);
    bf16* yout = (bf16*)(F.ws + WS_YRAW);
    LAS float* buf = (LAS float*)(F.lds + RING_OFF);
    const int rowl = F.tid >> 4, p = F.tid & 15;
    float S0 = 0.f, S1 = 0.f, S2 = 0.f, S3 = 0.f;
    unsigned short raw[22];
#define SC_GLOAD(t0) do { _Pragma("unroll") for (int i = 0; i < 22; ++i) { const int e = F.tid + 512 * i, tk = e / SC_REC, rem = e % SC_REC, q = rem >> 6, cc = rem & 63; \
            const size_t rowo = (rowbase + (t0) + tk) * RW + h * HD; \
            const bf16* src = q == 0 ? aR : (q == 1 ? aW : (q == 2 ? aKP : (q == 3 ? aKK : (q == 4 ? aB : aV)))); \
            raw[i] = src[rowo + (q == 5 ? hf * 32 + cc : cc)]; } } while (0)
#define SC_LSTORE(bi) do { _Pragma("unroll") for (int i = 0; i < 22; ++i) { const int e = F.tid + 512 * i; buf[(bi) * SC_TC * SC_REC + e] = bf2f(raw[i]); } } while (0)
    SC_GLOAD(0); SC_LSTORE(0); __syncthreads();
    for (int ch = 0; ch < T / SC_TC; ++ch) {
        const int cur = ch & 1; const bool more = (ch + 1 < T / SC_TC);
        if (more) SC_GLOAD((ch + 1) * SC_TC);
        const LAS float* rec = buf + cur * SC_TC * SC_REC;
        for (int tt = 0; tt < SC_TC; ++tt, rec += SC_REC) {
            const f32x4 r4 = *(const LAS f32x4*)(rec + 4 * p), w4 = *(const LAS f32x4*)(rec + 64 + 4 * p), k4 = *(const LAS f32x4*)(rec + 128 + 4 * p),
                        n4 = *(const LAS f32x4*)(rec + 192 + 4 * p), b4 = *(const LAS f32x4*)(rec + 256 + 4 * p);
            const float vv = rec[320 + rowl];
            float sa = (S0 * n4.x + S1 * n4.y) + (S2 * n4.z + S3 * n4.w); sa = -red16(sa);
            S0 = S0 * w4.x + sa * b4.x + vv * k4.x; S1 = S1 * w4.y + sa * b4.y + vv * k4.y; S2 = S2 * w4.z + sa * b4.z + vv * k4.z; S3 = S3 * w4.w + sa * b4.w + vv * k4.w;
            float y = (S0 * r4.x + S1 * r4.y) + (S2 * r4.z + S3 * r4.w); y = red16(y);
            if (p == 0) yout[(rowbase + ch * SC_TC + tt) * RW + h * HD + hf * 32 + rowl] = (bf16)f2bf(y);
        }
        if (more) SC_LSTORE(cur ^ 1);
        __syncthreads();
    }
#undef SC_GLOAD
#undef SC_LSTORE
}
__device__ __forceinline__ void load_row64(float (&q)[64], const bf16* p) {
#pragma unroll
    for (int i = 0; i < 8; ++i) { const v4u w = ((const GAS v4u*)p)[i];
        q[8 * i + 0] = bflo(w.x); q[8 * i + 1] = bfhi(w.x); q[8 * i + 2] = bflo(w.y); q[8 * i + 3] = bfhi(w.y); q[8 * i + 4] = bflo(w.z); q[8 * i + 5] = bfhi(w.z); q[8 * i + 6] = bflo(w.w); q[8 * i + 7] = bfhi(w.w); }
}
__device__ __forceinline__ void moba_simple(Frame& F, int wg, int nwg) {
    const bf16* Z = (const bf16*)(F.ws + WS_Z); const float* KM = (const float*)(F.ws + WS_KMEAN); bf16* Y = (bf16*)(F.ws + WS_Y);
    LAS float* red = (LAS float*)(F.lds + RING_OFF) + F.wave * (64 * 33);
    const int lane = F.lane;
    for (int qi = wg * NWAVES + F.wave; qi < BATCH * NH * T; qi += nwg * NWAVES) {
        const int bh = qi / T, t = qi % T, b = bh / NH, h = bh % NH, own = t >> 8;
        const size_t rowbase = (size_t)b * T;
        float q[64]; load_row64(q, Z + (rowbase + t) * NIN + ZQ + h * HD);
        float gate = -INFINITY;
        if (lane < own) { const float* km = KM + ((size_t)bh * NBLK + lane) * HD; float g = 0.f;
#pragma unroll
            for (int d = 0; d < 64; ++d) g += q[d] * km[d];
            gate = g; }
        int sel[3];
#pragma unroll
        for (int n = 0; n < 3; ++n) { const float mx = wave_max(gate); const unsigned long long bal = __ballot(gate == mx && mx > -INFINITY);
            int idx = -1; if (bal != 0ull) { idx = __ffsll((long long)bal) - 1; if (lane == idx) gate = -INFINITY; } sel[n] = idx; }
        float sc[16]; float mx = -INFINITY;
#pragma unroll
        for (int bi = 0; bi < 4; ++bi) { const int blk = bi < 3 ? sel[bi] : own;
#pragma unroll
            for (int i = 0; i < 4; ++i) { const int key = blk * 256 + i * 64 + lane; float s = -INFINITY;
                if (blk >= 0 && (bi < 3 || key <= t)) { const GAS v4u* kp = (const GAS v4u*)(Z + (rowbase + key) * NIN + ZK + h * HD); float a = 0.f;
#pragma unroll
                    for (int j = 0; j < 8; ++j) { const v4u w = kp[j];
                        a += q[8 * j + 0] * bflo(w.x) + q[8 * j + 1] * bfhi(w.x) + q[8 * j + 2] * bflo(w.y) + q[8 * j + 3] * bfhi(w.y) + q[8 * j + 4] * bflo(w.z) + q[8 * j + 5] * bfhi(w.z) + q[8 * j + 6] * bflo(w.w) + q[8 * j + 7] * bfhi(w.w); }
                    s = a * 0.125f; }
                sc[bi * 4 + i] = s; mx = fmaxf(mx, s); } }
        mx = wave_max(mx);
        float o[64]; float l = 0.f;
#pragma unroll
        for (int d = 0; d < 64; ++d) o[d] = 0.f;
#pragma unroll
        for (int bi = 0; bi < 4; ++bi) { const int blk = bi < 3 ? sel[bi] : own;
#pragma unroll
            for (int i = 0; i < 4; ++i) { const int key = blk * 256 + i * 64 + lane; const float pr = __expf(sc[bi * 4 + i] - mx);
                if (pr > 0.f) { const GAS v4u* vp = (const GAS v4u*)(Z + (rowbase + key) * NIN + ZV + h * HD); l += pr;
#pragma unroll
                    for (int j = 0; j < 8; ++j) { const v4u w = vp[j];
                        o[8 * j + 0] += pr * bflo(w.x); o[8 * j + 1] += pr * bfhi(w.x); o[8 * j + 2] += pr * bflo(w.y); o[8 * j + 3] += pr * bfhi(w.y); o[8 * j + 4] += pr * bflo(w.z); o[8 * j + 5] += pr * bfhi(w.z); o[8 * j + 6] += pr * bflo(w.w); o[8 * j + 7] += pr * bfhi(w.w); } } } }
        l = wave_sum(l);
        float res = 0.f;
#pragma unroll
        for (int hp = 0; hp < 2; ++hp) {
#pragma unroll
            for (int d = 0; d < 32; ++d) red[lane * 33 + d] = o[hp * 32 + d];
            LDS_WAIT(); asm volatile("" ::: "memory");
            float part = 0.f; const int dc = lane & 31, r0 = (lane >> 5) * 32;
#pragma unroll 8
            for (int r = 0; r < 32; ++r) part += red[(r0 + r) * 33 + dc];
            part += __shfl_xor(part, 32);
            if ((lane >> 5) == hp) res = part;
            LDS_WAIT(); asm volatile("" ::: "memory");
        }
        Y[(rowbase + t) * D + RW + h * HD + lane] = (bf16)f2bf(res / l);
    }
}
__device__ __forceinline__ void rwkv_post_simple(Frame& F) {
    const bf16* yr = (const bf16*)(F.ws + WS_YRAW); const bf16* aV = (const bf16*)(F.ws + WS_PV); const bf16* aG = (const bf16*)(F.ws + WS_GATE); const float* bon = (const float*)(F.ws + WS_BON);
    bf16* Y = (bf16*)(F.ws + WS_Y); const float* lnw = F.in[13]; const float* lnb = F.in[14];
    const int gw = F.vcu * NWAVES + F.wave, NGW = F.G * NWAVES;
    for (int u = gw; u < M * NH; u += NGW) { const int m = u >> 3, h = u & 7, c = h * HD + F.lane; const size_t o = (size_t)m * RW + c;
        const float y = bf2f(yr[o]); const float mean = wave_sum(y) * (1.f / 64.f); const float dlt = y - mean; const float var = wave_sum(dlt * dlt) * (1.f / 64.f);
        const float yn = dlt * (1.f / sqrtf(var + GN_EPS)) * lnw[c] + lnb[c];
        const float outv = (yn + bon[u] * bf2f(aV[o])) * bf2f(aG[o]);
        Y[(size_t)m * D + c] = (bf16)f2bf(outv); }
}
__device__ __forceinline__ void final_norm(Frame& F) {
    float* out = (float*)F.dout; const float* ss = (const float*)(F.ws + WS_SS) + (size_t)2 * M * 16; const float* g = F.in[24];
    const int gw = F.vcu * NWAVES + F.wave, NGW = F.G * NWAVES;
    for (int m = gw; m < M; m += NGW) { const float rstd = pg8::row_rstd(ss, (size_t)m);
        GAS f32x4* o = (GAS f32x4*)(out + (size_t)m * D) + F.lane; const GAS f32x4* gr = (const GAS f32x4*)g + F.lane;
#pragma unroll
        for (int j = 0; j < 4; ++j) { f32x4 v = o[64 * j]; const f32x4 gg = gr[64 * j]; v = v * rstd * gg; o[64 * j] = v; } }
}
using pg8::Unit;
constexpr size_t TILE_B = 256 * 2;
struct SchedBase { int G, c; };
struct SchedZ : SchedBase {
    __device__ __forceinline__ bool next(int i, Unit& u) const {
        const int L = i * G + c; constexpr int NZ = (M / 256) * (NIN / 256), NKV = (MEMR / 256) * (2 * D / 256);
        if (L < NZ) { pg8::tile_map(L, M / 256, NIN / 256, u.pm, u.pn); u.z = 0; u.a_off = WS_XN + (size_t)u.pm * 256 * D * 2; u.b_off = WS_WIN_T + (size_t)u.pn * 256 * D * 2; return true; }
        if (L < NZ + NKV) { const int l = L - NZ; u.pm = l / 8; u.pn = l % 8; u.z = 1; u.a_off = WS_MEMN + (size_t)u.pm * 256 * D * 2; u.b_off = WS_WXKV_T + (size_t)u.pn * 256 * D * 2; return true; }
        return false;
    }
};
struct SchedG : SchedBase {
    __device__ __forceinline__ bool next(int i, Unit& u) const {
        const int L = i * G + c; if (L >= 64) return false;
        u.z = L >> 4; u.pm = (L >> 2) & 3; u.pn = L & 3; u.a_off = WS_KV + ((size_t)u.pm * 256 * 2048 + u.z * 256) * 2; u.b_off = WS_WQ_S + ((size_t)u.pn * 256 * 1024 + u.z * 256) * 2; return true;
    }
};
struct SchedVW : SchedBase {
    __device__ __forceinline__ bool next(int i, Unit& u) const {
        const int L = i * G + (G - 1 - c); if (L >= 64) return false;
        u.z = L >> 2; u.pm = L & 3; u.pn = 0; const int b = u.z >> 2, h = u.z & 3;
        u.a_off = WS_WO_T + ((size_t)u.pm * 256 * 1024 + h * 256) * 2; u.b_off = WS_KV + ((size_t)b * 256 * 2048 + 1024 + h * 256) * 2; return true;
    }
};
struct SchedMN : SchedBase {
    int nN; size_t a_base, b_base; int lda, ldb, bsel;
    __device__ __forceinline__ bool next(int i, Unit& u) const {
        const int L = i * G + c; if (L >= (M / 256) * nN) return false;
        pg8::tile_map(L, M / 256, nN, u.pm, u.pn); u.z = 0;
        u.a_off = a_base + (size_t)u.pm * 256 * lda * 2; u.b_off = b_base + ((size_t)u.pn * 256 + (bsel ? (size_t)(u.pm >> 5) * 1024 : 0)) * ldb * 2; return true;
    }
};

#ifndef MK_N_LAUNCHES
#define MK_N_LAUNCHES 1
#endif
constexpr int PER_PHASE = 11;
constexpr int N_LAUNCHES = MK_N_LAUNCHES;
constexpr int SCAN_WGS = 64;
struct Args { const float* in[25]; float* out; unsigned char* ws; int ph_lo, ph_hi, li, pad; };
__global__ void __launch_bounds__(NWAVES * 64, 2) skel_fwd(Args args) {
    extern __shared__ __attribute__((aligned(16))) unsigned char lds[];
    Frame F;
    F.lds = (LAS unsigned char*)lds;
    F.MISC = (volatile LAS unsigned*)(F.lds + MISC_OFF);
    F.tid = threadIdx.x; F.lane = F.tid & 63; F.wave = __builtin_amdgcn_readfirstlane(F.tid >> 6);
    F.G = gridDim.x; { const int bx = blockIdx.x; F.vcu = (F.G % 8 == 0) ? (bx % 8) * (F.G / 8) + bx / 8 : bx; }
    F.ws = args.ws; F.dout = (unsigned char*)args.out;
#pragma unroll
    for (int i = 0; i < 25; ++i) F.in[i] = args.in[i];
    F.ctl = (gu32*)(F.ws + WS_CTL);
    for (int u = F.tid; u < (EPI_LDS_OFF - LDSCTL_OFF) / 4; u += NWAVES * 64) ((LAS unsigned*)(F.lds + LDSCTL_OFF))[u] = 0u;
    __syncthreads();
    XcdBarrier bar; bar.bar = (unsigned*)(F.ctl + CW_BAR); bar.x = 0; bar.st = nullptr;
    if (N_LAUNCHES == 1) bar = xcd_barrier_post((unsigned*)(F.ctl + CW_BAR), F.MISC + 8);
#define GRID_BAR() do { if (N_LAUNCHES == 1) xcd_barrier(bar); } while (0)
    const int lo = args.ph_lo, hi = args.ph_hi;
#ifndef PHASE_MASK
#define PHASE_MASK 0xFFFF
#endif
#define IN(k) (((PHASE_MASK >> (k)) & 1) && lo <= (k) && (k) < hi)
#define BOTH(k) (IN(k) && IN((k) + 1))
#define FRESH() do { int l_; asm volatile("v_mbcnt_lo_u32_b32 %0, -1, 0\n\tv_mbcnt_hi_u32_b32 %0, -1, %0" : "=v"(l_)); F.lane = l_; F.tid = F.wave * 64 + l_; } while (0)
    const char* wsc = (const char*)F.ws;
    const int bx = (int)blockIdx.x;

    if (IN(0)) { FRESH(); p0_prologue(F); if (BOTH(0)) GRID_BAR(); }
    if (IN(1)) {
        pg8::Gemm g{wsc, wsc, D, D, D}; SchedZ S; S.G = F.G; S.c = bx;
        pg8::EpiStoreBf16 E{(bf16*)(F.ws + WS_Z), NIN, (bf16*)(F.ws + WS_KV), 2 * D, 0};
        pg8::gemm_phase<pg8::EpiStoreBf16, SchedZ, true>(F.lds + RING_OFF, g, S, E, F.wave);
        if (BOTH(1)) GRID_BAR();
    }
    if (IN(2)) {
        { pg8::Gemm g{wsc, wsc, 2 * D, D, 256}; SchedG S; S.G = F.G; S.c = bx;
          pg8::EpiStoreBf16 E{(bf16*)(F.ws + WS_GT), D, nullptr, 0, 1};
          pg8::gemm_phase<pg8::EpiStoreBf16, SchedG, true>(F.lds + RING_OFF, g, S, E, F.wave); }
        { pg8::Gemm g{wsc, wsc, D, 2 * D, 256}; SchedVW S; S.G = F.G; S.c = bx;
          pg8::EpiStoreBf16 E{(bf16*)(F.ws + WS_VWT), D, nullptr, 0, 2};
          pg8::gemm_phase<pg8::EpiStoreBf16, SchedVW, true>(F.lds + RING_OFF, g, S, E, F.wave); }
        __syncthreads();
        FRESH(); kmean_simple(F);
        FRESH(); rwkv_prep_simple(F);
        if (BOTH(2)) GRID_BAR();
    }
    if (IN(3)) {
        FRESH();
        if (bx < SCAN_WGS) scan_simple(F, bx);
        else moba_simple(F, bx - SCAN_WGS, F.G - SCAN_WGS);
        if (BOTH(3)) GRID_BAR();
    }
    if (IN(4)) { FRESH(); rwkv_post_simple(F); if (BOTH(4)) GRID_BAR(); }
    if (IN(5)) {
        pg8::Gemm g{wsc, wsc, D, D, D}; SchedMN S; S.G = F.G; S.c = bx; S.nN = D / 256; S.a_base = WS_Y; S.b_base = WS_WMIX_T; S.lda = D; S.ldb = D; S.bsel = 0;
        pg8::EpiRes E{F.in[0], (float*)F.dout, (bf16*)(F.ws + WS_HB), (float*)(F.ws + WS_SS), D};
        pg8::gemm_phase<pg8::EpiRes, SchedMN, true>(F.lds + RING_OFF, g, S, E, F.wave);
        if (BOTH(5)) GRID_BAR();
    }
    if (IN(6)) {
        pg8::Gemm g{wsc, wsc, D, D, D}; SchedMN S; S.G = F.G; S.c = bx; S.nN = D / 256; S.a_base = WS_HB; S.b_base = WS_GT; S.lda = D; S.ldb = D; S.bsel = 1;
        pg8::EpiSoftmax E{(bf16*)(F.ws + WS_P), D, (const float*)(F.ws + WS_SS), (PG8_LAS pg8::f32x2*)(F.lds + EPI_LDS_OFF)};
        pg8::gemm_phase<pg8::EpiSoftmax, SchedMN, true>(F.lds + RING_OFF, g, S, E, F.wave);
        if (BOTH(6)) GRID_BAR();
    }
    if (IN(7)) {
        pg8::Gemm g{wsc, wsc, D, D, D}; SchedMN S; S.G = F.G; S.c = bx; S.nN = D / 256; S.a_base = WS_P; S.b_base = WS_VWT; S.lda = D; S.ldb = D; S.bsel = 1;
        pg8::EpiRes E{(const float*)F.dout, (float*)F.dout, (bf16*)(F.ws + WS_HB), (float*)(F.ws + WS_SS) + (size_t)M * 16, D};
        pg8::gemm_phase<pg8::EpiRes, SchedMN, true>(F.lds + RING_OFF, g, S, E, F.wave);
        if (BOTH(7)) GRID_BAR();
    }
    if (IN(8)) {
        pg8::Gemm g{wsc, wsc, D, D, D}; SchedMN S; S.G = F.G; S.c = bx; S.nN = FF / 256; S.a_base = WS_HB; S.b_base = WS_W1_T; S.lda = D; S.ldb = D; S.bsel = 0;
        pg8::EpiSqRelu E{(bf16*)(F.ws + WS_AH), FF, (const float*)(F.ws + WS_SS) + (size_t)M * 16};
        pg8::gemm_phase<pg8::EpiSqRelu, SchedMN, true>(F.lds + RING_OFF, g, S, E, F.wave);
        if (BOTH(8)) GRID_BAR();
    }
    if (IN(9)) {
        pg8::Gemm g{wsc, wsc, FF, FF, FF}; SchedMN S; S.G = F.G; S.c = bx; S.nN = D / 256; S.a_base = WS_AH; S.b_base = WS_W2_T; S.lda = FF; S.ldb = FF; S.bsel = 0;
        pg8::EpiRes E{(const float*)F.dout, (float*)F.dout, nullptr, (float*)(F.ws + WS_SS) + (size_t)2 * M * 16, D};
        pg8::gemm_phase<pg8::EpiRes, SchedMN, true>(F.lds + RING_OFF, g, S, E, F.wave);
        if (BOTH(9)) GRID_BAR();
    }
    if (IN(10)) { FRESH(); final_norm(F); }
#undef IN
#undef BOTH
}

extern "C" void kernel_launch(void* const* d_in, const int* in_sizes, int n_in, void* d_out, int out_size, void* d_ws, size_t ws_size, hipStream_t stream) {
    static int grid = 0;
    if (grid == 0) {
        if (n_in != 25 || in_sizes[0] != M * D || out_size != M * D || ws_size < WS_END) { fprintf(stderr, "kernel_launch: unexpected problem (n_in %d, in0 %d, out %d, ws %zu); nothing launched\n", n_in, n_in > 0 ? in_sizes[0] : -1, out_size, ws_size); grid = -1; return; }
        int dev = 0, cus = 0, per_cu = 0;
        if (hipGetDevice(&dev) != hipSuccess || hipDeviceGetAttribute(&cus, hipDeviceAttributeMultiprocessorCount, dev) != hipSuccess) { grid = -1; return; }
        if (hipFuncSetAttribute((const void*)skel_fwd, hipFuncAttributeMaxDynamicSharedMemorySize, LDS_BYTES) != hipSuccess) { fprintf(stderr, "kernel_launch: hipFuncSetAttribute failed\n"); grid = -1; return; }
        if (hipOccupancyMaxActiveBlocksPerMultiprocessor(&per_cu, (const void*)skel_fwd, NWAVES * 64, LDS_BYTES) != hipSuccess || per_cu < 1)
            fprintf(stderr, "kernel_launch: note: occupancy query reports %d workgroups per CU\n", per_cu);
        (void)hipGetLastError();
        grid = cus;
    }
    if (grid < 0) return;
    if (hipMemsetAsync((char*)d_ws + WS_CTL, 0, CTL_ZERO_BYTES, stream) != hipSuccess) { fprintf(stderr, "kernel_launch: hipMemsetAsync failed\n"); return; }
    Args a{};
    for (int i = 0; i < 25; ++i) a.in[i] = (const float*)d_in[i];
    a.out = (float*)d_out; a.ws = (unsigned char*)d_ws;
    for (int li = 0; li < N_LAUNCHES; ++li) {
        a.ph_lo = (N_LAUNCHES == PER_PHASE) ? li : 0; a.ph_hi = (N_LAUNCHES == PER_PHASE) ? li + 1 : PER_PHASE; a.li = li;
        hipLaunchKernelGGL(skel_fwd, dim3(grid), dim3(NWAVES * 64), LDS_BYTES, stream, a);
        const hipError_t le = hipPeekAtLastError();
        if (le != hipSuccess) { fprintf(stderr, "kernel_launch: launch %d failed: %s\n", li, hipGetErrorName(le)); break; }
    }
}
```

```cpp
#include <hip/hip_runtime.h>
#include <cstdio>
#include <cstdint>
#include <cmath>
namespace pg8 {
#define PG8_LAS __attribute__((address_space(3)))
typedef unsigned short bf16_t;
typedef short bf16x8 __attribute__((ext_vector_type(8)));
typedef float f32x4 __attribute__((ext_vector_type(4)));
typedef float f32x2 __attribute__((ext_vector_type(2)));
typedef unsigned u32x4 __attribute__((ext_vector_type(4)));
typedef unsigned u32x2 __attribute__((ext_vector_type(2)));
constexpr int BM = 256, BK = 64, HALF = 128, HTB = HALF * BK * 2  , STAGE_BYTES = 8 * HTB, NXCD = 8, WGM = 8;

__host__ __device__ __forceinline__ int lds_byte(int r, int c) { const int st = (r >> 4) * 2 + (c >> 5), rr = r & 15, cc = c & 31, ob = rr * 64 + cc * 2; return st * 1024 + (ob ^ (((ob >> 9) & 1) << 5)); }
__host__ __device__ __forceinline__ void stage_rc(int b, int& R, int& C) { const int st = b / 1024, sb = b % 1024, swz = sb ^ (((sb >> 9) & 1) << 5); R = (st >> 1) * 16 + swz / 64; C = (st & 1) * 32 + (swz % 64) / 2; }
__host__ __device__ __forceinline__ int perm32(int rho) { const int n = rho >> 4, i = rho & 15; return 8 * (i >> 2) + 4 * n + (i & 3); }

struct Unit { int pm, pn, z; size_t a_off, b_off; };
struct Gemm { const char* A; const char* Bt; int lda, ldb, K; };

__host__ __device__ __forceinline__ void tile_map(int L, int nM, int nN, int& pm, int& pn) {
    const int nwg = nM * nN; int wgid = L;
    { const int q = nwg / NXCD, r = nwg % NXCD, xcd = wgid % NXCD, off = wgid / NXCD; wgid = (xcd < r ? xcd * (q + 1) : r * (q + 1) + (xcd - r) * q) + off; }
    const int nig = WGM * nN, gid = wgid / nig, fm = gid * WGM, gsz = (nM - fm) < WGM ? (nM - fm) : WGM;
    pm = fm + ((wgid % nig) % gsz); pn = (wgid % nig) / gsz;
}

__device__ __forceinline__ unsigned cvt_pk_bf16(float lo, float hi) { unsigned r; asm volatile("v_cvt_pk_bf16_f32 %0, %1, %2" : "=v"(r) : "v"(lo), "v"(hi)); return r; }

template <class Epi, class Sched, bool ALIGN_EPI>
__device__ __forceinline__ void gemm_phase(PG8_LAS unsigned char* lds, const Gemm g, const Sched& S, const Epi& E, const int wid_) {
    int lane_; asm volatile("v_mbcnt_lo_u32_b32 %0, -1, 0\n\tv_mbcnt_hi_u32_b32 %0, -1, %0" : "=v"(lane_));
    const int lane = lane_ & 63, wid = wid_ & 7, tid = wid * 64 + lane, wr = wid >> 2, wc = wid & 3, fr = lane & 15, fq = lane >> 4;
    const int K = g.K, nt = K / BK;
    unsigned voffA[2], voffB[2];
#pragma unroll
    for (int i = 0; i < 2; ++i) { int R, C; stage_rc(tid * 16 + i * 8192, R, C); const int Rb = Epi::PERM ? ((R & ~31) + perm32(R & 31)) : R;
        voffA[i] = (unsigned)(R * g.lda + C) * 2u; voffB[i] = (unsigned)(Rb * g.ldb + C) * 2u; }
    const size_t kstep = (size_t)(BK * 2);
    const size_t hstepA = (size_t)HALF * g.lda * 2, hstepB = (size_t)HALF * g.ldb * 2;
    const unsigned ldsw = (unsigned)wid * 1024u;
    const int aoff = lds_byte(wr * 64 + fr, fq * 8), boff = lds_byte(wc * 32 + fr, fq * 8);
#define PG8_SA(b, h) (((b) * 2 + (h)) * HTB)
#define PG8_SB(b, h) ((4 + (b) * 2 + (h)) * HTB)
#define PG8_STAGE(bufoff, gbase, voff) do { _Pragma("unroll") for (int _i = 0; _i < 2; ++_i) \
        __builtin_amdgcn_global_load_lds((const unsigned*)((const char*)(gbase) + (voff)[_i]), (PG8_LAS unsigned*)(lds + (bufoff) + ldsw + _i * 8192), 16, 0, 0); } while (0)
#define PG8_LDA(dst, b, h) do { _Pragma("unroll") for (int m = 0; m < 4; ++m) _Pragma("unroll") for (int k = 0; k < 2; ++k) dst[m][k] = *(const PG8_LAS bf16x8*)(lds + PG8_SA(b, h) + aoff + m * 2048 + k * 1024); } while (0)
#define PG8_LDB(dst, b, h) do { _Pragma("unroll") for (int n = 0; n < 2; ++n) _Pragma("unroll") for (int k = 0; k < 2; ++k) dst[n][k] = *(const PG8_LAS bf16x8*)(lds + PG8_SB(b, h) + boff + n * 2048 + k * 1024); } while (0)
#define PG8_MMA(ai, bj, At, Bt) do { __builtin_amdgcn_s_setprio(1); _Pragma("unroll") for (int m = 0; m < 4; ++m) _Pragma("unroll") for (int n = 0; n < 2; ++n) _Pragma("unroll") for (int k = 0; k < 2; ++k) \
        acc[ai][bj][m][n] = __builtin_amdgcn_mfma_f32_16x16x32_bf16(Bt[n][k], At[m][k], acc[ai][bj][m][n], 0, 0, 0); __builtin_amdgcn_s_setprio(0); } while (0)
#define PG8_WAIT_V(n) asm volatile("s_waitcnt vmcnt(" #n ")" ::: "memory")
#define PG8_WAIT_L(n) asm volatile("s_waitcnt lgkmcnt(" #n ")" ::: "memory")
#define PG8_BAR __builtin_amdgcn_s_barrier()
#define PG8_SCHED __builtin_amdgcn_sched_barrier(0)
    Unit cur, nxt; int ui = 0;
    if (!S.next(0, cur)) return;
    f32x4 acc[2][2][4][2];
#pragma unroll
    for (int a = 0; a < 2; ++a)
#pragma unroll
        for (int b = 0; b < 2; ++b)
#pragma unroll
            for (int m = 0; m < 4; ++m)
#pragma unroll
                for (int n = 0; n < 2; ++n) acc[a][b][m][n] = (f32x4){0.f, 0.f, 0.f, 0.f};
    bf16x8 At[4][2], B0[2][2], B1[2][2];
    const char* cA = g.A + cur.a_off; const char* cB = g.Bt + cur.b_off;
    PG8_STAGE(PG8_SB(0, 0), cB, voffB); PG8_STAGE(PG8_SB(0, 1), cB + hstepB, voffB); PG8_STAGE(PG8_SA(0, 0), cA, voffA); PG8_STAGE(PG8_SA(0, 1), cA + hstepA, voffA);
    if (wr == 1) PG8_BAR;
    PG8_WAIT_V(2); PG8_BAR;
    PG8_STAGE(PG8_SB(1, 0), cB + kstep, voffB); PG8_STAGE(PG8_SA(1, 0), cA + kstep, voffA); PG8_STAGE(PG8_SB(1, 1), cB + hstepB + kstep, voffB);
    PG8_WAIT_V(6); PG8_BAR;
    for (;;) {
        const bool has_next = S.next(ui + 1, nxt);
        const char* nA = has_next ? g.A + nxt.a_off : cA; const char* nB = has_next ? g.Bt + nxt.b_off : cB;
        for (int t = 0; t < nt; t += 2) {
            const bool last = (t == nt - 2);
            const char* a1 = cA + (size_t)(t + 1) * kstep;
            const char* a2 = last ? nA : cA + (size_t)(t + 2) * kstep; const char* b2 = last ? nB : cB + (size_t)(t + 2) * kstep;
            const char* a3 = a2 + kstep; const char* b3 = b2 + kstep;
            PG8_LDB(B0, 0, 0); PG8_LDB(B1, 0, 1); PG8_SCHED; PG8_LDA(At, 0, 0); PG8_STAGE(PG8_SA(1, 1), a1 + hstepA, voffA);
            PG8_WAIT_V(8); PG8_WAIT_L(0); PG8_BAR; PG8_MMA(0, 0, At, B0); PG8_MMA(0, 1, At, B1); PG8_BAR; PG8_SCHED;
            PG8_LDA(At, 0, 1); PG8_STAGE(PG8_SB(0, 0), b2, voffB); PG8_STAGE(PG8_SB(0, 1), b2 + hstepB, voffB); PG8_STAGE(PG8_SA(0, 0), a2, voffA);
            PG8_WAIT_V(8); PG8_WAIT_L(0); PG8_BAR; PG8_MMA(1, 0, At, B0); PG8_MMA(1, 1, At, B1); PG8_BAR; PG8_SCHED;
            PG8_LDB(B0, 1, 0); PG8_LDB(B1, 1, 1); PG8_SCHED; PG8_LDA(At, 1, 0); PG8_STAGE(PG8_SA(0, 1), a2 + hstepA, voffA);
            PG8_WAIT_V(8); PG8_WAIT_L(0); PG8_BAR; PG8_MMA(0, 0, At, B0); PG8_MMA(0, 1, At, B1); PG8_BAR; PG8_SCHED;
            PG8_LDA(At, 1, 1); PG8_STAGE(PG8_SB(1, 0), b3, voffB); PG8_STAGE(PG8_SB(1, 1), b3 + hstepB, voffB); PG8_STAGE(PG8_SA(1, 0), a3, voffA);
            PG8_WAIT_V(8); PG8_WAIT_L(0); PG8_BAR; PG8_MMA(1, 0, At, B0); PG8_MMA(1, 1, At, B1); PG8_BAR; PG8_SCHED;
        }
        if constexpr (ALIGN_EPI) { if (wr == 0) PG8_BAR; }
        E(acc, cur, wr, wc, fr, fq, lane);
        if (!has_next) break;
#pragma unroll
        for (int a = 0; a < 2; ++a)
#pragma unroll
            for (int b = 0; b < 2; ++b)
#pragma unroll
                for (int m = 0; m < 4; ++m)
#pragma unroll
                    for (int n = 0; n < 2; ++n) acc[a][b][m][n] = (f32x4){0.f, 0.f, 0.f, 0.f};
        cur = nxt; cA = nA; cB = nB; ++ui;
        if constexpr (ALIGN_EPI) { if (wr == 1) PG8_BAR; }
    }
    PG8_WAIT_V(0);
    if constexpr (!ALIGN_EPI) { if (wr == 0) PG8_BAR; }
    PG8_BAR;
#undef PG8_SA
#undef PG8_SB
#undef PG8_STAGE
#undef PG8_LDA
#undef PG8_LDB
#undef PG8_MMA
#undef PG8_WAIT_V
#undef PG8_WAIT_L
#undef PG8_BAR
#undef PG8_SCHED
}
}
namespace pg8 {
struct EpiStoreBf16 {
    static constexpr bool PERM = true;
    bf16_t* O0; int ldc0; bf16_t* O1; int ldc1; int qs_lo; float qscale;
    int mode;
    __device__ __forceinline__ void operator()(const f32x4 (&acc)[2][2][4][2], const Unit& u, int wr, int wc, int fr, int fq, int lane) const {
        asm volatile("" : "+v"(fr), "+v"(fq), "+v"(lane));
        bf16_t* base; int ldc; size_t row0; int colt;
        if (mode == 0) { base = u.z ? O1 : O0; ldc = u.z ? ldc1 : ldc0; row0 = (size_t)u.pm * BM; colt = u.pn * BM; }
        else if (mode == 1) { base = O0; ldc = ldc0; row0 = (size_t)u.pm * 1024 + (size_t)u.z * 256; colt = u.pn * BM; }
        else { base = O0 + (size_t)(u.z >> 2) * 1048576; ldc = ldc0; row0 = (size_t)u.pm * BM; colt = (u.z & 3) * 256; }
        const float sc = (mode == 0 && u.z == 0 && (u.pn == qs_lo || u.pn == qs_lo + 1)) ? qscale : 1.f;
        const int col0 = colt + wc * 32 + 8 * fq;
#pragma unroll
        for (int ai = 0; ai < 2; ++ai)
#pragma unroll
            for (int m = 0; m < 4; ++m) { bf16_t* rowp = base + (row0 + wr * 64 + fr + ai * HALF + m * 16) * ldc + col0;
#pragma unroll
                for (int bj = 0; bj < 2; ++bj) { const f32x4 v0 = acc[ai][bj][m][0] * sc, v1 = acc[ai][bj][m][1] * sc;
                    u32x4 w; w.x = cvt_pk_bf16(v0[0], v0[1]); w.y = cvt_pk_bf16(v0[2], v0[3]); w.z = cvt_pk_bf16(v1[0], v1[1]); w.w = cvt_pk_bf16(v1[2], v1[3]);
                    *(u32x4*)(rowp + bj * HALF) = w; } }
    }
};

__device__ __forceinline__ float row_rstd(const float* ss, size_t row) {
    const f32x4* p = (const f32x4*)(ss + row * 16); const f32x4 a = p[0], b = p[1], c = p[2], d = p[3];
    const float s = ((a[0] + a[1]) + (a[2] + a[3])) + ((b[0] + b[1]) + (b[2] + b[3])) + ((c[0] + c[1]) + (c[2] + c[3])) + ((d[0] + d[1]) + (d[2] + d[3]));
    return 1.0f / sqrtf(s * (1.0f / 1024.0f) + 1e-6f);
}
__device__ __forceinline__ void wave_rstd(float (&rs)[2][4], const float* ss, int pm, int wr, int fr, int lane) {
    const float my0 = row_rstd(ss, (size_t)pm * BM + wr * 64 + lane), my1 = row_rstd(ss, (size_t)pm * BM + HALF + wr * 64 + lane);
#pragma unroll
    for (int m = 0; m < 4; ++m) { rs[0][m] = __shfl(my0, m * 16 + fr); rs[1][m] = __shfl(my1, m * 16 + fr); }
}

struct EpiRes {
    static constexpr bool PERM = false;
    const float* base; float* out; bf16_t* hb; float* ss; int ldc;
    __device__ __forceinline__ void operator()(f32x4 (&acc)[2][2][4][2], const Unit& u, int wr, int wc, int fr, int fq, int lane) const {
        asm volatile("" : "+v"(fr), "+v"(fq), "+v"(lane));
        const int col0 = u.pn * BM + wc * 32 + 4 * fq;
#pragma unroll
        for (int ai = 0; ai < 2; ++ai)
#pragma unroll
            for (int m = 0; m < 4; ++m) { const size_t row = (size_t)u.pm * BM + ai * HALF + wr * 64 + m * 16 + fr; const size_t off = row * ldc + col0; float q = 0.f;
#pragma unroll
                for (int bj = 0; bj < 2; ++bj)
#pragma unroll
                    for (int n = 0; n < 2; ++n) { const f32x4 bs = *(const f32x4*)(base + off + bj * HALF + n * 16); const f32x4 o = bs + acc[ai][bj][m][n];
                        *(f32x4*)(out + off + bj * HALF + n * 16) = o; q += (o[0] * o[0] + o[1] * o[1]) + (o[2] * o[2] + o[3] * o[3]);
                        if (hb) { u32x2 w; w.x = cvt_pk_bf16(o[0], o[1]); w.y = cvt_pk_bf16(o[2], o[3]); *(u32x2*)(hb + off + bj * HALF + n * 16) = w; } }
                q += __shfl_xor(q, 16); q += __shfl_xor(q, 32);
                if (fq == 0) ss[row * 16 + u.pn * 4 + wc] = q;
                if (m & 1) asm volatile("" ::: "memory"); }
    }
};

struct EpiSqRelu {
    static constexpr bool PERM = true;
    bf16_t* O; int ldc; const float* ss;
    __device__ __forceinline__ void operator()(const f32x4 (&acc)[2][2][4][2], const Unit& u, int wr, int wc, int fr, int fq, int lane) const {
        asm volatile("" : "+v"(fr), "+v"(fq), "+v"(lane));
        float rs[2][4]; wave_rstd(rs, ss, u.pm, wr, fr, lane);
        const int col0 = u.pn * BM + wc * 32 + 8 * fq;
#pragma unroll
        for (int ai = 0; ai < 2; ++ai)
#pragma unroll
            for (int m = 0; m < 4; ++m) { bf16_t* rowp = O + ((size_t)u.pm * BM + wr * 64 + fr + ai * HALF + m * 16) * ldc + col0; const float s = rs[ai][m];
#pragma unroll
                for (int bj = 0; bj < 2; ++bj) { f32x4 v0 = acc[ai][bj][m][0] * s, v1 = acc[ai][bj][m][1] * s;
#pragma unroll
                    for (int i = 0; i < 4; ++i) { const float a = fmaxf(v0[i], 0.f), b = fmaxf(v1[i], 0.f); v0[i] = a * a; v1[i] = b * b; }
                    u32x4 w; w.x = cvt_pk_bf16(v0[0], v0[1]); w.y = cvt_pk_bf16(v0[2], v0[3]); w.z = cvt_pk_bf16(v1[0], v1[1]); w.w = cvt_pk_bf16(v1[2], v1[3]);
                    *(u32x4*)(rowp + bj * HALF) = w; } }
    }
};

struct EpiSoftmax {
    static constexpr bool PERM = true;
    bf16_t* O; int ldc; const float* ss; PG8_LAS f32x2* xl;
    __device__ __forceinline__ void operator()(f32x4 (&acc)[2][2][4][2], const Unit& u, int wr, int wc, int fr, int fq, int lane) const {
        asm volatile("" : "+v"(fr), "+v"(fq), "+v"(lane));
        float rs[2][4]; wave_rstd(rs, ss, u.pm, wr, fr, lane);
#pragma unroll
        for (int ai = 0; ai < 2; ++ai)
#pragma unroll
            for (int m = 0; m < 4; ++m) { const float s = rs[ai][m] * (0.0625f * 1.4426950408889634f); float mx = -INFINITY;
#pragma unroll
                for (int bj = 0; bj < 2; ++bj)
#pragma unroll
                    for (int n = 0; n < 2; ++n) { f32x4 v = acc[ai][bj][m][n] * s; acc[ai][bj][m][n] = v; mx = fmaxf(fmaxf(mx, fmaxf(v[0], v[1])), fmaxf(v[2], v[3])); }
                mx = fmaxf(mx, __shfl_xor(mx, 16)); mx = fmaxf(mx, __shfl_xor(mx, 32)); float sm = 0.f;
#pragma unroll
                for (int bj = 0; bj < 2; ++bj)
#pragma unroll
                    for (int n = 0; n < 2; ++n) { f32x4 v = acc[ai][bj][m][n];
#pragma unroll
                        for (int i = 0; i < 4; ++i) { v[i] = __builtin_amdgcn_exp2f(v[i] - mx); sm += v[i]; } acc[ai][bj][m][n] = v; }
                sm += __shfl_xor(sm, 16); sm += __shfl_xor(sm, 32);
                if (fq == 0) xl[(ai * HALF + wr * 64 + m * 16 + fr) * 4 + wc] = (f32x2){mx, sm}; }
        asm volatile("s_waitcnt lgkmcnt(0)" ::: "memory"); __builtin_amdgcn_s_barrier(); asm volatile("" ::: "memory");
        const int col0 = u.pn * BM + wc * 32 + 8 * fq;
#pragma unroll
        for (int ai = 0; ai < 2; ++ai)
#pragma unroll
            for (int m = 0; m < 4; ++m) { const int r = ai * HALF + wr * 64 + m * 16 + fr;
                const f32x4 x01 = *(const PG8_LAS f32x4*)(xl + r * 4), x23 = *(const PG8_LAS f32x4*)(xl + r * 4 + 2);
                const float mg = fmaxf(fmaxf(x01[0], x01[2]), fmaxf(x23[0], x23[2]));
                const float tot = x01[1] * __builtin_amdgcn_exp2f(x01[0] - mg) + x01[3] * __builtin_amdgcn_exp2f(x01[2] - mg) + x23[1] * __builtin_amdgcn_exp2f(x23[0] - mg) + x23[3] * __builtin_amdgcn_exp2f(x23[2] - mg);
                const float mown = wc == 0 ? x01[0] : (wc == 1 ? x01[2] : (wc == 2 ? x23[0] : x23[2]));
                const float f = __builtin_amdgcn_exp2f(mown - mg) / tot;
                bf16_t* rowp = O + ((size_t)u.pm * BM + r) * ldc + col0;
#pragma unroll
                for (int bj = 0; bj < 2; ++bj) { const f32x4 v0 = acc[ai][bj][m][0] * f, v1 = acc[ai][bj][m][1] * f;
                    u32x4 w; w.x = cvt_pk_bf16(v0[0], v0[1]); w.y = cvt_pk_bf16(v0[2], v0[3]); w.z = cvt_pk_bf16(v1[0], v1[1]); w.w = cvt_pk_bf16(v1[2], v1[3]);
                    *(u32x4*)(rowp + bj * HALF) = w; } }
    }
};
}
constexpr int NWAVES = 8;
constexpr int BATCH = 4, T = 8192, D = 1024, M = BATCH * T;
constexpr int NIN = 3328, RW = 512, NH = 8, HD = 64;
constexpr int ZK_R = 512, ZV_R = 1024, ZWD = 1536, ZAD = 1600, ZGD = 1664;
constexpr int ZQ = 1792, ZK = 1792 + 512, ZV = 1792 + 1024;
constexpr int MEML = 256, MEMR = BATCH * MEML, FF = 4096;
constexpr int NBLK = T / 256;
constexpr float NORM_EPS = 1e-6f, GN_EPS = 64e-5f, DECAY_SCALE = 0.6065306597126334f;

constexpr size_t MiB = 1u << 20;
constexpr size_t WS_CTL = 0, CTL_ZERO_BYTES = 1 * MiB;
constexpr size_t WS_WIN_T = 1 * MiB, WS_WMIX_T = 8 * MiB, WS_WQ_S = 10 * MiB, WS_WXKV_T = 12 * MiB, WS_WO_T = 16 * MiB, WS_W1_T = 18 * MiB, WS_W2_T = 26 * MiB;
constexpr size_t WS_MEMN = 34 * MiB, WS_KV = 36 * MiB, WS_GT = 40 * MiB, WS_VWT = 48 * MiB;
constexpr size_t WS_SS = 56 * MiB;
constexpr size_t WS_KMEAN = 62 * MiB, WS_BON = 63 * MiB;
constexpr size_t WS_XN = 64 * MiB;
constexpr size_t WS_GATE = 64 * MiB, WS_YRAW = 96 * MiB;
constexpr size_t WS_HB = 64 * MiB;
constexpr size_t WS_Z = 128 * MiB;
constexpr size_t WS_Y = 336 * MiB;
constexpr size_t WS_PR = 400 * MiB, WS_PV = 432 * MiB;
constexpr size_t WS_P = 400 * MiB;
constexpr size_t WS_AH = 128 * MiB;
constexpr size_t WS_END = 512 * MiB;
constexpr size_t DO_W = 0, DO_KP = 32 * MiB, DO_KKN = 64 * MiB, DO_B = 96 * MiB;

constexpr int CW_TMO = 0, CW_CODE = 1;
constexpr int CW_BAR = 4096;

constexpr int RING_OFF = 0, RING_BYTES = 131072;
constexpr int LDSCTL_OFF = RING_BYTES, MISC_OFF = LDSCTL_OFF + 320;
constexpr int EPI_LDS_OFF = 132096;
constexpr int LDS_BYTES = 147456;
static_assert(MISC_OFF + 128 <= EPI_LDS_OFF && EPI_LDS_OFF + 8192 <= LDS_BYTES, "LDS map");

#define GAS __attribute__((address_space(1)))
#define LAS __attribute__((address_space(3)))
typedef unsigned short bf16;
typedef unsigned v4u __attribute__((ext_vector_type(4)));
typedef float f32x4 __attribute__((ext_vector_type(4)));
typedef GAS unsigned gu32;
#define RLX_AGENT __ATOMIC_RELAXED, __HIP_MEMORY_SCOPE_AGENT
#define LDS_WAIT() asm volatile("s_waitcnt lgkmcnt(0)" ::: "memory")
#define VM_WAIT() asm volatile("s_waitcnt vmcnt(0)" ::: "memory")
__device__ __forceinline__ unsigned f2bf(float f) { unsigned u = __builtin_bit_cast(unsigned, f); return (u + 0x7fffu + ((u >> 16) & 1u)) >> 16; }
__device__ __forceinline__ unsigned pk2(float lo, float hi) { return f2bf(lo) | (f2bf(hi) << 16); }
__device__ __forceinline__ float bf2f(unsigned short u) { return __builtin_bit_cast(float, (unsigned)u << 16); }
__device__ __forceinline__ float bflo(unsigned u) { return __builtin_bit_cast(float, u << 16); }
__device__ __forceinline__ float bfhi(unsigned u) { return __builtin_bit_cast(float, u & 0xffff0000u); }

#define XB_TMO      128
#define XB_XCNT(j)  (256  + 64 * (j))
#define XB_XSUB(j)  (1280 + 64 * (j))
#define XB_XGEN(j)  (2304 + 64 * (j))
#define XB_TOP      3328
#define XB_TOPGEN   3392
#define XCD_BAR_WORDS 3456
#define XB_SPIN_CAP (1u << 18)
__device__ __forceinline__ unsigned xb_ld(unsigned* p)              { return __hip_atomic_load(p, __ATOMIC_RELAXED, __HIP_MEMORY_SCOPE_AGENT); }
__device__ __forceinline__ unsigned xb_add(unsigned* p, unsigned v) { return __hip_atomic_fetch_add(p, v, __ATOMIC_RELAXED, __HIP_MEMORY_SCOPE_AGENT); }
__device__ __forceinline__ unsigned xb_xcc_id() { return (unsigned)__builtin_amdgcn_s_getreg((3 << 11) | 20) & 0xFu; }
#define XB_SPIN(cond, bar) do { unsigned _sp = 0; while (cond) { __builtin_amdgcn_s_sleep(1); \
    if ((++_sp & 255u) == 0u) { if (xb_ld(&(bar)[XB_TMO])) break; if (_sp > XB_SPIN_CAP) { atomicAdd(&(bar)[XB_TMO], 1u); break; } } } } while (0)
struct XcdBarrier { unsigned* bar; unsigned x; volatile LAS unsigned* st; };
__device__ __forceinline__ XcdBarrier xcd_barrier_post(unsigned* bar, volatile LAS unsigned* st) {
    XcdBarrier b; b.bar = bar; b.x = xb_xcc_id(); b.st = st;
    if (threadIdx.x == 0) (void)xb_add(&bar[XB_XCNT(b.x)], 1u);
    return b;
}
__device__ __forceinline__ void xcd_barrier_complete(unsigned* bar, unsigned x, unsigned& nloc, unsigned& nx) {
    const unsigned G = gridDim.x * gridDim.y * gridDim.z;
    unsigned sum, cnt, mine, sp = 0u;
    for (;;) {
        sum = 0u; cnt = 0u; mine = 0u;
#pragma unroll
        for (unsigned j = 0; j < 16; ++j) { const unsigned c = xb_ld(&bar[XB_XCNT(j)]); sum += c; cnt += (c > 0u) ? 1u : 0u; mine = (j == x) ? c : mine; }
        if (sum == G) break;
        __builtin_amdgcn_s_sleep(1);
        if ((++sp & 255u) == 0u) { if (xb_ld(&bar[XB_TMO])) break; if (sp > XB_SPIN_CAP) { atomicAdd(&bar[XB_TMO], 1u); break; } }
    }
    nloc = mine > 0u ? mine : 1u; nx = cnt > 0u ? cnt : 1u;
}
__device__ __forceinline__ void xcd_barrier(const XcdBarrier& b) {
    asm volatile("s_waitcnt vmcnt(0)" ::: "memory");
    __syncthreads();
    if (threadIdx.x == 0) {
        unsigned* bar = b.bar;
        __builtin_amdgcn_s_waitcnt(0);
        unsigned nloc = b.st[0], nx = b.st[1];
        if (nloc == 0u) { xcd_barrier_complete(bar, b.x, nloc, nx); b.st[0] = nloc; b.st[1] = nx; }
        const unsigned old = xb_add(&bar[XB_XSUB(b.x)], 1u);
        const unsigned gen = old / nloc;
        if (old + 1u == (gen + 1u) * nloc) {
            __builtin_amdgcn_fence(__ATOMIC_RELEASE, "agent");
            asm volatile("s_waitcnt vmcnt(0)" ::: "memory");
            const unsigned og = xb_add(&bar[XB_TOP], 1u);
            const unsigned tg = og / nx;
            if (og + 1u == (tg + 1u) * nx) xb_add(&bar[XB_TOPGEN], 1u);
            else XB_SPIN(xb_ld(&bar[XB_TOPGEN]) == tg, bar);
            __builtin_amdgcn_fence(__ATOMIC_ACQUIRE, "agent");
            xb_add(&bar[XB_XGEN(b.x)], 1u);
            asm volatile("s_waitcnt vmcnt(0)" ::: "memory");
        } else {
            XB_SPIN(xb_ld(&bar[XB_XGEN(b.x)]) == gen, bar);
            __builtin_amdgcn_fence(__ATOMIC_ACQUIRE, "agent");
            asm volatile("s_waitcnt vmcnt(0)" ::: "memory");
        }
    }
    __syncthreads();
}

struct Frame {
    LAS unsigned char* lds;
    volatile LAS unsigned* MISC;
    gu32* ctl;
    int tid, lane, wave;
    int vcu, G;
    unsigned char* ws; unsigned char* dout;
    const float* in[25];
};
__device__ __forceinline__ float wave_sum(float v) {
#pragma unroll
    for (int o = 1; o < 64; o <<= 1) v += __shfl_xor(v, o);
    return v;
}
__device__ __forceinline__ float wave_max(float v) {
#pragma unroll
    for (int o = 1; o < 64; o <<= 1) v = fmaxf(v, __shfl_xor(v, o));
    return v;
}
template <int CTRL> __device__ __forceinline__ float dpp_mov(float x) { return __builtin_bit_cast(float, __builtin_amdgcn_update_dpp(0, __builtin_bit_cast(int, x), CTRL, 0xf, 0xf, false)); }
__device__ __forceinline__ float red16(float x) { x += dpp_mov<0xB1>(x); x += dpp_mov<0x4E>(x); x += dpp_mov<0x124>(x); x += dpp_mov<0x128>(x); return x; }
__device__ __forceinline__ void p0_transpose_item(const float* W, int K, int N, bf16* WT, const float* kscale, LAS float* scr, int item, int lane) {
    const int nblk = N / 32, kb = item / nblk, nb = item % nblk, k0 = 64 * kb, n0 = 32 * nb;
#pragma unroll 8
    for (int i = 0; i < 32; ++i) { const int kk = 2 * i + (lane >> 5); const float s = kscale ? kscale[k0 + kk] : 1.f; scr[kk * 33 + (lane & 31)] = W[(size_t)(k0 + kk) * N + n0 + (lane & 31)] * s; }
    LDS_WAIT(); asm volatile("" ::: "memory");
    const int c = lane & 7;
#pragma unroll
    for (int j = 0; j < 4; ++j) { const int n = (lane >> 3) + 8 * j; const LAS float* s = scr + (8 * c) * 33 + n;
        v4u o; o.x = pk2(s[0 * 33], s[1 * 33]); o.y = pk2(s[2 * 33], s[3 * 33]); o.z = pk2(s[4 * 33], s[5 * 33]); o.w = pk2(s[6 * 33], s[7 * 33]);
        *(GAS v4u*)(WT + (size_t)(n0 + n) * K + k0 + 8 * c) = o; }
    LDS_WAIT(); asm volatile("" ::: "memory");
}
__device__ __forceinline__ void rms_row_to_bf16(const float* xrow, const float* g, bf16* orow, int lane) {
    const GAS f32x4* xr = (const GAS f32x4*)xrow + lane; const GAS f32x4* gr = (const GAS f32x4*)g + lane;
    f32x4 v[4]; float s = 0.f;
#pragma unroll
    for (int j = 0; j < 4; ++j) { v[j] = xr[64 * j]; s += (v[j].x * v[j].x + v[j].y * v[j].y) + (v[j].z * v[j].z + v[j].w * v[j].w); }
    const float rstd = 1.f / sqrtf(wave_sum(s) * (1.f / D) + NORM_EPS);
    GAS unsigned long long* o8 = (GAS unsigned long long*)orow + lane;
#pragma unroll
    for (int j = 0; j < 4; ++j) { const f32x4 gg = gr[64 * j]; o8[64 * j] = (unsigned long long)pk2(v[j].x * rstd * gg.x, v[j].y * rstd * gg.y) | ((unsigned long long)pk2(v[j].z * rstd * gg.z, v[j].w * rstd * gg.w) << 32); }
}
__device__ __forceinline__ void p0_prologue(Frame& F) {
    LAS float* scr = (LAS float*)(F.lds + RING_OFF + F.wave * 16384);
    const int gw = F.vcu * NWAVES + F.wave, NGW = F.G * NWAVES;
    constexpr int I_IN = (D / 64) * (NIN / 32), I_MIX = (D / 64) * (D / 32), I_KV = (D / 64) * (2 * D / 32), I_O = I_MIX, I_1 = (D / 64) * (FF / 32), I_2 = (FF / 64) * (D / 32);
    constexpr int NITEMS = I_IN + I_MIX + I_KV + I_O + I_1 + I_2;
    for (int it = gw; it < NITEMS; it += NGW) {
        int r = it;
        if (r < I_IN) { p0_transpose_item(F.in[3], D, NIN, (bf16*)(F.ws + WS_WIN_T), nullptr, scr, r, F.lane); continue; } r -= I_IN;
        if (r < I_MIX) { p0_transpose_item(F.in[15], D, D, (bf16*)(F.ws + WS_WMIX_T), nullptr, scr, r, F.lane); continue; } r -= I_MIX;
        if (r < I_KV) { p0_transpose_item(F.in[19], D, 2 * D, (bf16*)(F.ws + WS_WXKV_T), nullptr, scr, r, F.lane); continue; } r -= I_KV;
        if (r < I_O) { p0_transpose_item(F.in[20], D, D, (bf16*)(F.ws + WS_WO_T), nullptr, scr, r, F.lane); continue; } r -= I_O;
        if (r < I_1) { p0_transpose_item(F.in[22], D, FF, (bf16*)(F.ws + WS_W1_T), F.in[21], scr, r, F.lane); continue; } r -= I_1;
        p0_transpose_item(F.in[23], FF, D, (bf16*)(F.ws + WS_W2_T), nullptr, scr, r, F.lane);
    }
    { const float* wq = F.in[18]; const float* gx = F.in[16]; bf16* o = (bf16*)(F.ws + WS_WQ_S);
      for (int i = (F.vcu * 512 + F.tid); i < D * D / 4; i += F.G * 512) { const f32x4 v = ((const GAS f32x4*)wq)[i]; const float s = gx[(i * 4) / D];
          ((GAS unsigned long long*)o)[i] = (unsigned long long)pk2(v.x * s, v.y * s) | ((unsigned long long)pk2(v.z * s, v.w * s) << 32); } }
    for (int m = gw; m < M; m += NGW) rms_row_to_bf16(F.in[0] + (size_t)m * D, F.in[2], (bf16*)(F.ws + WS_XN) + (size_t)m * D, F.lane);
    for (int m = gw; m < MEMR; m += NGW) rms_row_to_bf16(F.in[1] + (size_t)m * D, F.in[17], (bf16*)(F.ws + WS_MEMN) + (size_t)m * D, F.lane);
}

__device__ __forceinline__ float zshift(const bf16* Z, const float* mu, int m, int col) {
    const float z = bf2f(Z[(size_t)m * NIN + col]); const float zp = (m % T == 0) ? 0.f : bf2f(Z[(size_t)(m - 1) * NIN + col]);
    return z + (zp - z) * mu[col];
}
__device__ __forceinline__ void rwkv_prep_simple(Frame& F) {
    const bf16* Z = (const bf16*)(F.ws + WS_Z); const float* mu = F.in[4];
    LAS float* lo = (LAS float*)(F.lds + RING_OFF);
    const int c = F.tid;
    const float w0 = F.in[5][c], a0 = F.in[7][c], kkc = F.in[10][c], kac = F.in[11][c], rkc = F.in[12][c];
    const float* wup = F.in[6]; const float* aup = F.in[8]; const float* gup = F.in[9];
    bf16* oR = (bf16*)(F.ws + WS_PR); bf16* oV = (bf16*)(F.ws + WS_PV); bf16* oW = (bf16*)(F.dout + DO_W); bf16* oKP = (bf16*)(F.dout + DO_KP); bf16* oKK = (bf16*)(F.dout + DO_KKN); bf16* oB = (bf16*)(F.dout + DO_B);
    bf16* oG = (bf16*)(F.ws + WS_GATE); float* oBon = (float*)(F.ws + WS_BON);
    for (int m0 = F.vcu * 4; m0 < M; m0 += F.G * 4) {
#pragma unroll
        for (int i = 0; i < 2; ++i) { const int e = F.tid + 512 * i, tk = e >> 8, j = e & 255; const float zs = zshift(Z, mu, m0 + tk, ZWD + j);
            lo[e] = j < 64 ? tanhf(zs) : (j < 128 ? zs : 1.f / (1.f + __expf(-zs))); }
        __syncthreads();
        float aw[4], aa[4], ag[4];
#pragma unroll
        for (int k = 0; k < 4; ++k) { aw[k] = 0.f; aa[k] = 0.f; ag[k] = 0.f; }
        for (int j = 0; j < 64; ++j) { const float wv = wup[j * RW + c], av = aup[j * RW + c];
#pragma unroll
            for (int k = 0; k < 4; ++k) { aw[k] += lo[k * 256 + j] * wv; aa[k] += lo[k * 256 + 64 + j] * av; } }
        for (int j = 0; j < 128; ++j) { const float gv = gup[j * RW + c];
#pragma unroll
            for (int k = 0; k < 4; ++k) ag[k] += lo[k * 256 + 128 + j] * gv; }
#pragma unroll
        for (int k = 0; k < 4; ++k) { const int m = m0 + k;
            const float r = zshift(Z, mu, m, c), kx = zshift(Z, mu, m, ZK_R + c), v = zshift(Z, mu, m, ZV_R + c);
            const float dec = __expf(-DECAY_SCALE / (1.f + __expf(-(w0 + aw[k]))));
            const float a = 1.f / (1.f + __expf(-(a0 + aa[k])));
            const float kk = kx * kkc; const float nn = wave_sum(kk * kk); const float kkn = kk / fmaxf(sqrtf(nn), 1e-12f);
            const float kp = kx * (1.f + (a - 1.f) * kac);
            const float bon = wave_sum(r * kp * rkc);
            const size_t o = (size_t)m * RW + c;
            oR[o] = (bf16)f2bf(r); oV[o] = (bf16)f2bf(v); oW[o] = (bf16)f2bf(dec); oKP[o] = (bf16)f2bf(kp); oKK[o] = (bf16)f2bf(kkn); oB[o] = (bf16)f2bf(kkn * a); oG[o] = (bf16)f2bf(ag[k]);
            if (F.lane == 0) oBon[(size_t)m * NH + F.wave] = bon; }
        __syncthreads();
    }
}
__device__ __forceinline__ void kmean_simple(Frame& F) {
    const bf16* Z = (const bf16*)(F.ws + WS_Z); float* KM = (float*)(F.ws + WS_KMEAN);
    const int gw = F.vcu * NWAVES + F.wave, NGW = F.G * NWAVES;
    for (int u = gw; u < BATCH * NH * NBLK; u += NGW) { const int j = u % NBLK, bh = u / NBLK, b = bh / NH, h = bh % NH;
        const bf16* kp = Z + ((size_t)b * T + j * 256) * NIN + ZK + h * HD + F.lane; float s = 0.f;
        for (int i = 0; i < 256; ++i) s += bf2f(kp[(size_t)i * NIN]);
        KM[(size_t)u * HD + F.lane] = s * (1.f / 256.f); }
}
constexpr int SC_TC = 32, SC_REC = 352;
__device__ __forceinline__ void scan_simple(Frame& F, int unit) {
    const int bh = unit >> 1, hf = unit & 1, b = bh / NH, h = bh % NH;
    const size_t rowbase = (size_t)b * T;
    const bf16* aR = (const bf16*)(F.ws + WS_PR); const bf16* aV = (const bf16*)(F.ws + WS_PV); const bf16* aW = (const bf16*)(F.dout + DO_W); const bf16* aKP = (const bf16*)(F.dout + DO_KP);
    const bf16* aKK = (const bf16*)(F.dout + DO_KKN); const bf16* aB = (const bf16*)(F.dout + DO_B);
    bf16* yout = (bf16*)(F.ws + WS_YRAW);
    LAS float* buf = (LAS float*)(F.lds + RING_OFF);
    const int rowl = F.tid >> 4, p = F.tid & 15;
    float S0 = 0.f, S1 = 0.f, S2 = 0.f, S3 = 0.f;
    unsigned short raw[22];
#define SC_GLOAD(t0) do { _Pragma("unroll") for (int i = 0; i < 22; ++i) { const int e = F.tid + 512 * i, tk = e / SC_REC, rem = e % SC_REC, q = rem >> 6, cc = rem & 63; \
            const size_t rowo = (rowbase + (t0) + tk) * RW + h * HD; \
            const bf16* src = q == 0 ? aR : (q == 1 ? aW : (q == 2 ? aKP : (q == 3 ? aKK : (q == 4 ? aB : aV)))); \
            raw[i] = src[rowo + (q == 5 ? hf * 32 + cc : cc)]; } } while (0)
#define SC_LSTORE(bi) do { _Pragma("unroll") for (int i = 0; i < 22; ++i) { const int e = F.tid + 512 * i; buf[(bi) * SC_TC * SC_REC + e] = bf2f(raw[i]); } } while (0)
    SC_GLOAD(0); SC_LSTORE(0); __syncthreads();
    for (int ch = 0; ch < T / SC_TC; ++ch) {
        const int cur = ch & 1; const bool more = (ch + 1 < T / SC_TC);
        if (more) SC_GLOAD((ch + 1) * SC_TC);
        const LAS float* rec = buf + cur * SC_TC * SC_REC;
        for (int tt = 0; tt < SC_TC; ++tt, rec += SC_REC) {
            const f32x4 r4 = *(const LAS f32x4*)(rec + 4 * p), w4 = *(const LAS f32x4*)(rec + 64 + 4 * p), k4 = *(const LAS f32x4*)(rec + 128 + 4 * p),
                        n4 = *(const LAS f32x4*)(rec + 192 + 4 * p), b4 = *(const LAS f32x4*)(rec + 256 + 4 * p);
            const float vv = rec[320 + rowl];
            float sa = (S0 * n4.x + S1 * n4.y) + (S2 * n4.z + S3 * n4.w); sa = -red16(sa);
            S0 = S0 * w4.x + sa * b4.x + vv * k4.x; S1 = S1 * w4.y + sa * b4.y + vv * k4.y; S2 = S2 * w4.z + sa * b4.z + vv * k4.z; S3 = S3 * w4.w + sa * b4.w + vv * k4.w;
            float y = (S0 * r4.x + S1 * r4.y) + (S2 * r4.z + S3 * r4.w); y = red16(y);
            if (p == 0) yout[(rowbase + ch * SC_TC + tt) * RW + h * HD + hf * 32 + rowl] = (bf16)f2bf(y);
        }
        if (more) SC_LSTORE(cur ^ 1);
        __syncthreads();
    }
#undef SC_GLOAD
#undef SC_LSTORE
}
__device__ __forceinline__ void load_row64(float (&q)[64], const bf16* p) {
#pragma unroll
    for (int i = 0; i < 8; ++i) { const v4u w = ((const GAS v4u*)p)[i];
        q[8 * i + 0] = bflo(w.x); q[8 * i + 1] = bfhi(w.x); q[8 * i + 2] = bflo(w.y); q[8 * i + 3] = bfhi(w.y); q[8 * i + 4] = bflo(w.z); q[8 * i + 5] = bfhi(w.z); q[8 * i + 6] = bflo(w.w); q[8 * i + 7] = bfhi(w.w); }
}
__device__ __forceinline__ void moba_simple(Frame& F, int wg, int nwg) {
    const bf16* Z = (const bf16*)(F.ws + WS_Z); const float* KM = (const float*)(F.ws + WS_KMEAN); bf16* Y = (bf16*)(F.ws + WS_Y);
    LAS float* red = (LAS float*)(F.lds + RING_OFF) + F.wave * (64 * 33);
    const int lane = F.lane;
    for (int qi = wg * NWAVES + F.wave; qi < BATCH * NH * T; qi += nwg * NWAVES) {
        const int bh = qi / T, t = qi % T, b = bh / NH, h = bh % NH, own = t >> 8;
        const size_t rowbase = (size_t)b * T;
        float q[64]; load_row64(q, Z + (rowbase + t) * NIN + ZQ + h * HD);
        float gate = -INFINITY;
        if (lane < own) { const float* km = KM + ((size_t)bh * NBLK + lane) * HD; float g = 0.f;
#pragma unroll
            for (int d = 0; d < 64; ++d) g += q[d] * km[d];
            gate = g; }
        int sel[3];
#pragma unroll
        for (int n = 0; n < 3; ++n) { const float mx = wave_max(gate); const unsigned long long bal = __ballot(gate == mx && mx > -INFINITY);
            int idx = -1; if (bal != 0ull) { idx = __ffsll((long long)bal) - 1; if (lane == idx) gate = -INFINITY; } sel[n] = idx; }
        float sc[16]; float mx = -INFINITY;
#pragma unroll
        for (int bi = 0; bi < 4; ++bi) { const int blk = bi < 3 ? sel[bi] : own;
#pragma unroll
            for (int i = 0; i < 4; ++i) { const int key = blk * 256 + i * 64 + lane; float s = -INFINITY;
                if (blk >= 0 && (bi < 3 || key <= t)) { const GAS v4u* kp = (const GAS v4u*)(Z + (rowbase + key) * NIN + ZK + h * HD); float a = 0.f;
#pragma unroll
                    for (int j = 0; j < 8; ++j) { const v4u w = kp[j];
                        a += q[8 * j + 0] * bflo(w.x) + q[8 * j + 1] * bfhi(w.x) + q[8 * j + 2] * bflo(w.y) + q[8 * j + 3] * bfhi(w.y) + q[8 * j + 4] * bflo(w.z) + q[8 * j + 5] * bfhi(w.z) + q[8 * j + 6] * bflo(w.w) + q[8 * j + 7] * bfhi(w.w); }
                    s = a * 0.125f; }
                sc[bi * 4 + i] = s; mx = fmaxf(mx, s); } }
        mx = wave_max(mx);
        float o[64]; float l = 0.f;
#pragma unroll
        for (int d = 0; d < 64; ++d) o[d] = 0.f;
#pragma unroll
        for (int bi = 0; bi < 4; ++bi) { const int blk = bi < 3 ? sel[bi] : own;
#pragma unroll
            for (int i = 0; i < 4; ++i) { const int key = blk * 256 + i * 64 + lane; const float pr = __expf(sc[bi * 4 + i] - mx);
                if (pr > 0.f) { const GAS v4u* vp = (const GAS v4u*)(Z + (rowbase + key) * NIN + ZV + h * HD); l += pr;
#pragma unroll
                    for (int j = 0; j < 8; ++j) { const v4u w = vp[j];
                        o[8 * j + 0] += pr * bflo(w.x); o[8 * j + 1] += pr * bfhi(w.x); o[8 * j + 2] += pr * bflo(w.y); o[8 * j + 3] += pr * bfhi(w.y); o[8 * j + 4] += pr * bflo(w.z); o[8 * j + 5] += pr * bfhi(w.z); o[8 * j + 6] += pr * bflo(w.w); o[8 * j + 7] += pr * bfhi(w.w); } } } }
        l = wave_sum(l);
        float res = 0.f;
#pragma unroll
        for (int hp = 0; hp < 2; ++hp) {
#pragma unroll
            for (int d = 0; d < 32; ++d) red[lane * 33 + d] = o[hp * 32 + d];
            LDS_WAIT(); asm volatile("" ::: "memory");
            float part = 0.f; const int dc = lane & 31, r0 = (lane >> 5) * 32;
#pragma unroll 8
            for (int r = 0; r < 32; ++r) part += red[(r0 + r) * 33 + dc];
            part += __shfl_xor(part, 32);
            if ((lane >> 5) == hp) res = part;
            LDS_WAIT(); asm volatile("" ::: "memory");
        }
        Y[(rowbase + t) * D + RW + h * HD + lane] = (bf16)f2bf(res / l);
    }
}
__device__ __forceinline__ void rwkv_post_simple(Frame& F) {
    const bf16* yr = (const bf16*)(F.ws + WS_YRAW); const bf16* aV = (const bf16*)(F.ws + WS_PV); const bf16* aG = (const bf16*)(F.ws + WS_GATE); const float* bon = (const float*)(F.ws + WS_BON);
    bf16* Y = (bf16*)(F.ws + WS_Y); const float* lnw = F.in[13]; const float* lnb = F.in[14];
    const int gw = F.vcu * NWAVES + F.wave, NGW = F.G * NWAVES;
    for (int u = gw; u < M * NH; u += NGW) { const int m = u >> 3, h = u & 7, c = h * HD + F.lane; const size_t o = (size_t)m * RW + c;
        const float y = bf2f(yr[o]); const float mean = wave_sum(y) * (1.f / 64.f); const float dlt = y - mean; const float var = wave_sum(dlt * dlt) * (1.f / 64.f);
        const float yn = dlt * (1.f / sqrtf(var + GN_EPS)) * lnw[c] + lnb[c];
        const float outv = (yn + bon[u] * bf2f(aV[o])) * bf2f(aG[o]);
        Y[(size_t)m * D + c] = (bf16)f2bf(outv); }
}
__device__ __forceinline__ void final_norm(Frame& F) {
    float* out = (float*)F.dout; const float* ss = (const float*)(F.ws + WS_SS) + (size_t)2 * M * 16; const float* g = F.in[24];
    const int gw = F.vcu * NWAVES + F.wave, NGW = F.G * NWAVES;
    for (int m = gw; m < M; m += NGW) { const float rstd = pg8::row_rstd(ss, (size_t)m);
        GAS f32x4* o = (GAS f32x4*)(out + (size_t)m * D) + F.lane; const GAS f32x4* gr = (const GAS f32x4*)g + F.lane;
#pragma unroll
        for (int j = 0; j < 4; ++j) { f32x4 v = o[64 * j]; const f32x4 gg = gr[64 * j]; v = v * rstd * gg; o[64 * j] = v; } }
}
namespace attn_body {
typedef unsigned short bf16;
using bf16x8=__attribute__((ext_vector_type(8)))short;
using s16x4=__attribute__((ext_vector_type(4)))short;
using f32x16=__attribute__((ext_vector_type(16)))float;
using u32x4=__attribute__((ext_vector_type(4)))unsigned;
constexpr int SEQ=8192,D=64,QP=3328,OP=1024;
constexpr int NW=8,QBLK=32,QB=QBLK*NW,KVBLK=64,NQB=SEQ/QB;
__device__ __forceinline__ int crow(int r,int hi){return (r&3)+8*(r>>2)+4*hi;}
#define SBAR() __builtin_amdgcn_sched_barrier(0)
__device__ __forceinline__ void cmask(f32x16&p0,f32x16&p1,int jb,int qrel,int hi){
  const float NEG=-INFINITY; int kb=64*jb+4*hi;
  #pragma unroll
  for(int r=0;r<16;++r){int kv=kb+(r&3)+8*(r>>2); if(kv>qrel)p0[r]=NEG; if(kv+32>qrel)p1[r]=NEG;}
}

constexpr int NSLOT=3, SLOTB=8192;
constexpr int LDS_K=0, LDS_V=NSLOT*SLOTB, LDS_WS=2*NSLOT*SLOTB, LDS_OST=LDS_WS+NW*64*4, LDS_BYTES=LDS_OST+NW*4096;
constexpr float C2=0.125f*1.4426950408889634f;
__device__ __forceinline__ void glds16(const void*gsrc,unsigned lds_dst){unsigned keep;
  asm volatile("s_mov_b32 %0, m0\n\ts_mov_b32 m0, %2\n\ts_nop 0\n\tglobal_load_lds_dwordx4 %1, off\n\ts_mov_b32 m0, %0":"=&s"(keep):"v"(gsrc),"s"(lds_dst):"memory");}
__device__ __forceinline__ float max3f(float a,float b,float c){float r;asm("v_max3_f32 %0, %1, %2, %3":"=v"(r):"v"(a),"v"(b),"v"(c));return r;}
__device__ __forceinline__ float max2f(float a,float b){float r;asm("v_max_f32_e32 %0, %1, %2":"=v"(r):"v"(a),"v"(b));return r;}
__device__ __forceinline__ float fadd_s(float a,float b){float r;asm("v_add_f32_e32 %0, %1, %2":"=v"(r):"v"(a),"v"(b));return r;}
__device__ __forceinline__ float fsub_s(float a,float b){float r;asm("v_sub_f32_e32 %0, %1, %2":"=v"(r):"v"(a),"v"(b));return r;}
typedef float f32x2_t __attribute__((ext_vector_type(2))); typedef __bf16 bf16x2_t __attribute__((ext_vector_type(2)));
__device__ __forceinline__ unsigned cvtpk_s(float lo,float hi){f32x2_t v={lo,hi};bf16x2_t b=__builtin_convertvector(v,bf16x2_t);return __builtin_bit_cast(unsigned,b);}
#define WAIT_BAR(N) asm volatile("s_waitcnt vmcnt(" #N ") lgkmcnt(0)\n\ts_barrier":::"memory")

__device__ __forceinline__ void qkt(f32x16&p0,f32x16&p1,const char*Kslot,const bf16x8*qr,const f32x16&negm,int r32,int hi){
  const char*kb=Kslot+hi*1024+r32*16;
  #pragma unroll
  for(int d0=0;d0<4;++d0){
    const bf16x8 b0=*reinterpret_cast<const bf16x8*>(kb+d0*2048);
    const bf16x8 b1=*reinterpret_cast<const bf16x8*>(kb+d0*2048+512);
    if(d0==0){p0=__builtin_amdgcn_mfma_f32_32x32x16_bf16(b0,qr[0],negm,0,0,0);p1=__builtin_amdgcn_mfma_f32_32x32x16_bf16(b1,qr[0],negm,0,0,0);}
    else{p0=__builtin_amdgcn_mfma_f32_32x32x16_bf16(b0,qr[d0],p0,0,0,0);p1=__builtin_amdgcn_mfma_f32_32x32x16_bf16(b1,qr[d0],p1,0,0,0);}}
}
typedef __attribute__((address_space(3))) const char* lds_cptr;
typedef short v4i16_t __attribute__((ext_vector_type(4)));
__device__ __forceinline__ void kload8(bf16x8*kf,lds_cptr kp){
  kf[0]=*(const __attribute__((address_space(3))) bf16x8*)(kp);      kf[1]=*(const __attribute__((address_space(3))) bf16x8*)(kp+512);
  kf[2]=*(const __attribute__((address_space(3))) bf16x8*)(kp+2048); kf[3]=*(const __attribute__((address_space(3))) bf16x8*)(kp+2560);
  kf[4]=*(const __attribute__((address_space(3))) bf16x8*)(kp+4096); kf[5]=*(const __attribute__((address_space(3))) bf16x8*)(kp+4608);
  kf[6]=*(const __attribute__((address_space(3))) bf16x8*)(kp+6144); kf[7]=*(const __attribute__((address_space(3))) bf16x8*)(kp+6656);
}
__device__ __forceinline__ void kload2(bf16x8*kf,lds_cptr kp,int j){ kf[2*j]=*(const __attribute__((address_space(3))) bf16x8*)(kp+j*2048); kf[2*j+1]=*(const __attribute__((address_space(3))) bf16x8*)(kp+j*2048+512); }
__device__ __forceinline__ s16x4 vtr(lds_cptr p){ return __builtin_bit_cast(s16x4,__builtin_amdgcn_ds_read_tr16_b64_v4i16((__attribute__((address_space(3))) v4i16_t*)p)); }
__device__ __forceinline__ float rowmax(const f32x16&p0,const f32x16&p1){
  float a=max3f(p0[0],p0[1],p1[0]),b=max3f(p0[2],p0[3],p1[1]);a=max3f(a,p1[2],p1[3]);
  #pragma unroll
  for(int r=4;r<16;r+=4){a=max3f(a,p0[r],p0[r+1]);b=max3f(b,p0[r+2],p0[r+3]);a=max3f(a,p1[r],p1[r+1]);b=max3f(b,p1[r+2],p1[r+3]);}
  const float m=max2f(a,b);
  auto rr=__builtin_amdgcn_permlane32_swap(__float_as_uint(m),__float_as_uint(m),false,false);
  return max2f(__uint_as_float(rr[0]),__uint_as_float(rr[1]));
}
__device__ __forceinline__ void pv(f32x16*o,int vb,bf16x8 pa0,bf16x8 pa1,bf16x8 pa2,bf16x8 pa3){
  #pragma unroll
  for(int d0=0;d0<2;++d0){s16x4 lo[4],hi[4];
    #pragma unroll
    for(int ks=0;ks<4;++ks){
      asm volatile("ds_read_b64_tr_b16 %0,%1 offset:%c2":"=&v"(lo[ks]):"v"(vb),"i"(d0*4096+ks*1024):"memory");
      asm volatile("ds_read_b64_tr_b16 %0,%1 offset:%c2":"=&v"(hi[ks]):"v"(vb),"i"(d0*4096+ks*1024+512):"memory");}
    asm volatile("s_waitcnt lgkmcnt(0)":::"memory");SBAR();
    #define PK(k) (bf16x8){lo[k][0],lo[k][1],lo[k][2],lo[k][3],hi[k][0],hi[k][1],hi[k][2],hi[k][3]}
    o[d0]=__builtin_amdgcn_mfma_f32_32x32x16_bf16(pa0,PK(0),o[d0],0,0,0);
    o[d0]=__builtin_amdgcn_mfma_f32_32x32x16_bf16(pa1,PK(1),o[d0],0,0,0);
    o[d0]=__builtin_amdgcn_mfma_f32_32x32x16_bf16(pa2,PK(2),o[d0],0,0,0);
    o[d0]=__builtin_amdgcn_mfma_f32_32x32x16_bf16(pa3,PK(3),o[d0],0,0,0);
    #undef PK
  }
}

#ifndef ATTN_STORE16
#define ATTN_STORE16(p,v) (*(u32x4*)(p)=(v))
#endif
template<int THRL> __device__ __forceinline__ void attn_unit(int b,int h,int qb,const bf16*Q,const bf16*__restrict__ K,const bf16*__restrict__ V,bf16*O,const float*__restrict__ KMbh,char*shm,const int wid,const int lane){
  const int r32=lane&31,hi=lane>>5;
  const long rowbase=(long)b*SEQ; const int q0=qb*QB;
  const bf16*Qw=Q+(rowbase+q0+wid*QBLK)*QP+h*D;
  const bf16*Kh=K+rowbase*QP+h*D,*Vh=V+rowbase*QP+h*D;
  unsigned selmask=0u;
  { f32x16 g=f32x16{}; bf16x8 qg[4];
    #pragma unroll
    for(int d0=0;d0<4;++d0)qg[d0]=*reinterpret_cast<const bf16x8*>(&Qw[(long)r32*QP+d0*16+hi*8]);
    #pragma unroll
    for(int d0=0;d0<4;++d0){ const float4 a0=*reinterpret_cast<const float4*>(KMbh+r32*64+d0*16+hi*8), a1=*reinterpret_cast<const float4*>(KMbh+r32*64+d0*16+hi*8+4);
      u32x4 pk; pk[0]=cvtpk_s(a0.x,a0.y); pk[1]=cvtpk_s(a0.z,a0.w); pk[2]=cvtpk_s(a1.x,a1.y); pk[3]=cvtpk_s(a1.z,a1.w);
      g=__builtin_amdgcn_mfma_f32_32x32x16_bf16(__builtin_bit_cast(bf16x8,pk),qg[d0],g,0,0,0); }
    #pragma unroll
    for(int r=0;r<16;++r){ if(crow(r,hi)>=qb) g[r]=-INFINITY; }
    #pragma unroll
    for(int n=0;n<3;++n){ float bv=-INFINITY; int bi=64;
      #pragma unroll
      for(int r=0;r<16;++r){ if(g[r]>bv){bv=g[r];bi=crow(r,hi);} }
      const float pv_=__shfl_xor(bv,32); const int pi_=__shfl_xor(bi,32);
      const bool mine=(bv>pv_)||(bv==pv_&&bi<pi_); const float wv=mine?bv:pv_; const int wi=mine?bi:pi_;
      if(wv>-INFINITY){ selmask|=1u<<wi;
        #pragma unroll
        for(int r=0;r<16;++r){ if(crow(r,hi)==wi) g[r]=-INFINITY; } } }
    selmask|=1u<<qb; }
  asm volatile("":"+v"(selmask)); SBAR();
  const unsigned lds0=(unsigned)(uintptr_t)shm;
  float*wsf=(float*)(shm+LDS_WS)+wid*64;
  const bf16*ksrc=Kh+(long)lane*QP+wid*8;
  const bf16*vsrc=Vh+(long)(16*(wid&3)+(lane>>2))*QP+(wid>>2)*32+(lane&3)*8;
  const unsigned kdst=lds0+LDS_K+wid*1024, vdst=lds0+LDS_V+wid*1024;
  #define DMA_K(t,slot) glds16(ksrc+(long)(t)*KVBLK*QP,(unsigned)__builtin_amdgcn_readfirstlane(kdst+(slot)))
  #define DMA_V(t,slot) glds16(vsrc+(long)(t)*KVBLK*QP,(unsigned)__builtin_amdgcn_readfirstlane(vdst+(slot)))
  const int vb0=(int)(lds0+LDS_V)+((lane>>4)&1)*32+(lane&3)*8+(4*hi+((lane&15)>>2))*64;
  const char*Kbase=shm+LDS_K; bf16x8 kf[8];
  const lds_cptr shm3=(lds_cptr)shm; const lds_cptr kp0=shm3+LDS_K+hi*1024+r32*16; const lds_cptr vp0=shm3+LDS_V+((lane>>4)&1)*32+(lane&3)*8+(4*hi+((lane&15)>>2))*64;
  const int NT=(q0+QB)/KVBLK;
  DMA_K(0,0);DMA_V(0,0);DMA_K(1,SLOTB);
  bf16x8 qr[4];
  #pragma unroll
  for(int d0=0;d0<4;++d0)qr[d0]=*reinterpret_cast<const bf16x8*>(&Qw[(long)r32*QP+d0*16+hi*8]);
  float nok=((selmask&1u)!=0u||qb==0)?0.f:-INFINITY;
  float mhat=0.f,l_reg=0.f;f32x16 o[2];o[0]=f32x16{};o[1]=f32x16{};f32x16 negm;
  _Pragma("unroll") for(int r=0;r<16;++r)negm[r]=nok; asm volatile("":"+v"(negm));
  const int qrel=wid*QBLK+r32;
  #define CMASK(P0,P1,t) do{int jb_=(t)-(NT-4); if(jb_>=0)cmask(P0,P1,jb_,qrel,hi);}while(0)
  bool resc=false;
  #define START(P0,P1) do{ const float rm=rowmax(P0,P1); resc=false; \
    { const float dl=(rm==-INFINITY)?0.f:rm; mhat=fadd_s(mhat,dl); \
      _Pragma("unroll") for(int r=0;r<16;++r){P0[r]=fsub_s(P0[r],dl);P1[r]=fsub_s(P1[r],dl);} \
      { const float cv_=nok-mhat; _Pragma("unroll") for(int r=0;r<16;++r)negm[r]=cv_; } asm volatile("":"+v"(negm)); } \
    _Pragma("unroll") for(int r=0;r<16;++r)P0[r]=__builtin_amdgcn_exp2f(P0[r]); }while(0)
  #define RESC() do{ if(resc){ asm volatile("s_waitcnt lgkmcnt(0)":::"memory"); \
      _Pragma("unroll") for(int d_=0;d_<2;++d_) _Pragma("unroll") for(int r=0;r<16;++r)o[d_][r]*=wsf[crow(r,hi)]; } }while(0)
  f32x16 pA0,pA1,pB0,pB1;
  int sl_prev=0,sl_cur=0,sl_next=SLOTB;
  #define ROT() do{sl_prev=sl_cur;sl_cur=sl_next;sl_next=(sl_next==(NSLOT-1)*SLOTB)?0:sl_next+SLOTB;}while(0)
  DMA_K(2,2*SLOTB);
  WAIT_BAR(3);
  qkt(pA0,pA1,Kbase,qr,negm,r32,hi);asm volatile("s_nop 15\n\ts_nop 7":"+v"(pA0),"+v"(pA1));CMASK(pA0,pA1,0);
  START(pA0,pA1);
  _Pragma("unroll") for(int r=0;r<16;++r)pA1[r]=__builtin_amdgcn_exp2f(pA1[r]);
  WAIT_BAR(0);
  DMA_K(3,0);DMA_V(1,SLOTB);
  ROT();
  kload8(kf,kp0+sl_cur);
  WAIT_BAR(2);
  s16x4 vlo[8],vhi[8]; u32x4 pw0,pw1,pw2,pw3;
  #define PKW(P,B) cvtpk_s(P[B],P[B+1])
  #define PAF(k) __builtin_bit_cast(bf16x8,pw##k)
  #define VFR(i) (bf16x8){vlo[i][0],vlo[i][1],vlo[i][2],vlo[i][3],vhi[i][0],vhi[i][1],vhi[i][2],vhi[i][3]}
  #define PIN(x) asm volatile("":"+v"(x))
  #define MX3(a,b,c) __builtin_fmaxf(__builtin_fmaxf((a),(b)),(c))
  #define GAPA(MF,A0,A1,A2,A3,W0,W1,PW) do{ MF; sacc+=A0; sacc+=A1; sacc+=A2; sacc+=A3; PIN(sacc); W0; W1; PIN(PW); SBAR(); }while(0)
  #define EX(v) __builtin_amdgcn_exp2f(v)
  #define GAPB(MF,X,B) do{ MF; X[B]=EX(X[B]); X[B+1]=EX(X[B+1]); X[B+2]=EX(X[B+2]); X[B+3]=EX(X[B+3]); PIN(X); SBAR(); }while(0)
  #define VRD(i) do{ vlo[i]=vtr(vp_+(((i)>>2)*4096+((i)&3)*1024)); vhi[i]=vtr(vp_+(((i)>>2)*4096+((i)&3)*1024+512)); }while(0)
  #define KRD(G,j) do{ if(G){ kload2(kf,kp0+sl_next,j); SBAR(); } }while(0)
  #define STEP(C0,C1,P0,P1,t,GK,GV,GL) do{ SBAR(); \
    const lds_cptr vp_=vp0+sl_prev; \
    VRD(0); SBAR(); float sacc=(P0[0]+P0[1]); \
    GAPA(C0=__builtin_amdgcn_mfma_f32_32x32x16_bf16(kf[0],qr[0],negm,0,0,0), P0[2],P0[3],P0[4],P0[5],     pw0[0]=PKW(P0,0), pw0[1]=PKW(P0,2), pw0); \
    VRD(4); SBAR(); GAPA(C1=__builtin_amdgcn_mfma_f32_32x32x16_bf16(kf[1],qr[0],negm,0,0,0), P0[6],P0[7],P0[8],P0[9],     pw0[2]=PKW(P0,4), pw0[3]=PKW(P0,6), pw0); \
    VRD(1); SBAR(); GAPA(C0=__builtin_amdgcn_mfma_f32_32x32x16_bf16(kf[2],qr[1],C0,0,0,0),   P0[10],P0[11],P0[12],P0[13], pw1[0]=PKW(P0,8), pw1[1]=PKW(P0,10), pw1); \
    VRD(5); SBAR(); GAPA(C1=__builtin_amdgcn_mfma_f32_32x32x16_bf16(kf[3],qr[1],C1,0,0,0),   P0[14],P0[15],P1[0],P1[1],   pw1[2]=PKW(P0,12),pw1[3]=PKW(P0,14), pw1); \
    VRD(2); SBAR(); GAPA(C0=__builtin_amdgcn_mfma_f32_32x32x16_bf16(kf[4],qr[2],C0,0,0,0),   P1[2],P1[3],P1[4],P1[5],     pw2[0]=PKW(P1,0), pw2[1]=PKW(P1,2), pw2); \
    VRD(6); SBAR(); GAPA(C1=__builtin_amdgcn_mfma_f32_32x32x16_bf16(kf[5],qr[2],C1,0,0,0),   P1[6],P1[7],P1[8],P1[9],     pw2[2]=PKW(P1,4), pw2[3]=PKW(P1,6), pw2); \
    VRD(3); SBAR(); GAPA(C0=__builtin_amdgcn_mfma_f32_32x32x16_bf16(kf[6],qr[3],C0,0,0,0),   P1[10],P1[11],P1[12],P1[13], pw3[0]=PKW(P1,8), pw3[1]=PKW(P1,10), pw3); \
    VRD(7); SBAR(); GAPA(C1=__builtin_amdgcn_mfma_f32_32x32x16_bf16(kf[7],qr[3],C1,0,0,0),   P1[14],P1[15],0.f,0.f,       pw3[2]=PKW(P1,12),pw3[3]=PKW(P1,14), pw3); \
    l_reg+=sacc; \
    if(GK){DMA_K((t)+3,sl_cur);} if(GV){DMA_V((t)+1,sl_next);} \
    CMASK(C0,C1,t); \
    { float a=MX3(C0[0],C0[1],C1[0]),b=MX3(C0[2],C0[3],C1[1]); a=MX3(a,C1[2],C1[3]); \
      _Pragma("unroll") for(int r=4;r<16;r+=4){a=MX3(a,C0[r],C0[r+1]);b=MX3(b,C0[r+2],C0[r+3]);a=MX3(a,C1[r],C1[r+1]);b=MX3(b,C1[r+2],C1[r+3]);} \
      float rm=__builtin_fmaxf(a,b); { auto rr=__builtin_amdgcn_permlane32_swap(__float_as_uint(rm),__float_as_uint(rm),false,false); rm=__builtin_fmaxf(__uint_as_float(rr[0]),__uint_as_float(rr[1])); } \
      resc=false; \
      if(__builtin_expect(__any(rm>(float)THRL),0)){ const float dl=__builtin_fmaxf(rm,0.f); mhat+=dl; \
        _Pragma("unroll") for(int r=0;r<16;++r){C0[r]-=dl;C1[r]-=dl;} \
        { const float cv_=nok-mhat; _Pragma("unroll") for(int r=0;r<16;++r)negm[r]=cv_; } asm volatile("":"+v"(negm)); \
        const float f=__builtin_amdgcn_exp2f(-dl); l_reg*=f; if(hi==0)wsf[r32]=f; resc=true; } } \
    SBAR(); \
    GAPB(o[0]=__builtin_amdgcn_mfma_f32_32x32x16_bf16(PAF(0),VFR(0),o[0],0,0,0), C0,0); \
    GAPB(o[1]=__builtin_amdgcn_mfma_f32_32x32x16_bf16(PAF(0),VFR(4),o[1],0,0,0), C0,4); \
    KRD(GL,0); GAPB(o[0]=__builtin_amdgcn_mfma_f32_32x32x16_bf16(PAF(1),VFR(1),o[0],0,0,0), C0,8); \
    KRD(GL,1); GAPB(o[1]=__builtin_amdgcn_mfma_f32_32x32x16_bf16(PAF(1),VFR(5),o[1],0,0,0), C0,12); \
    KRD(GL,2); GAPB(o[0]=__builtin_amdgcn_mfma_f32_32x32x16_bf16(PAF(2),VFR(2),o[0],0,0,0), C1,0); \
    KRD(GL,3); GAPB(o[1]=__builtin_amdgcn_mfma_f32_32x32x16_bf16(PAF(2),VFR(6),o[1],0,0,0), C1,4); \
    GAPB(o[0]=__builtin_amdgcn_mfma_f32_32x32x16_bf16(PAF(3),VFR(3),o[0],0,0,0), C1,8); \
    GAPB(o[1]=__builtin_amdgcn_mfma_f32_32x32x16_bf16(PAF(3),VFR(7),o[1],0,0,0), C1,12); \
    }while(0)
  #define MASKUPD(tt) do{ if((((tt))&3)==0){ nok=((selmask>>((tt)>>2))&1u)?0.f:-INFINITY; const float cv_=nok-mhat; _Pragma("unroll") for(int r=0;r<16;++r)negm[r]=cv_; asm volatile("":"+v"(negm)); } }while(0)
  int t=1;
  #undef CMASK
  #define CMASK(P0,P1,t) do{}while(0)
  for(;t+5<NT;t+=2){
    STEP(pB0,pB1,pA0,pA1,t,true,true,true);     WAIT_BAR(2); RESC(); ROT(); MASKUPD(t+1);
    STEP(pA0,pA1,pB0,pB1,t+1,true,true,true);   WAIT_BAR(2); RESC(); ROT();
  }
  #undef CMASK
  #define CMASK(P0,P1,t) do{int jb_=(t)-(NT-4); if(jb_>=0)cmask(P0,P1,jb_,qrel,hi);}while(0)
  #define ENDW(tt) do{ if((tt)+3<NT){WAIT_BAR(2);} else if((tt)+2<NT){WAIT_BAR(1);} else {WAIT_BAR(0);} }while(0)
  for(;t+1<NT;t+=2){
    STEP(pB0,pB1,pA0,pA1,t,(t+3<NT),(t+1<NT),(t+1<NT));       ENDW(t);   RESC(); ROT(); MASKUPD(t+1);
    STEP(pA0,pA1,pB0,pB1,t+1,(t+4<NT),(t+2<NT),(t+2<NT));     ENDW(t+1); RESC(); ROT();
  }
  STEP(pB0,pB1,pA0,pA1,NT-1,false,false,false); RESC();
  { float sacc=pB0[0]+pB0[1]; _Pragma("unroll") for(int r=2;r<16;++r)sacc+=pB0[r]; _Pragma("unroll") for(int r=0;r<16;++r)sacc+=pB1[r]; l_reg+=sacc;
    pw0=(u32x4){PKW(pB0,0),PKW(pB0,2),PKW(pB0,4),PKW(pB0,6)};pw1=(u32x4){PKW(pB0,8),PKW(pB0,10),PKW(pB0,12),PKW(pB0,14)};pw2=(u32x4){PKW(pB1,0),PKW(pB1,2),PKW(pB1,4),PKW(pB1,6)};pw3=(u32x4){PKW(pB1,8),PKW(pB1,10),PKW(pB1,12),PKW(pB1,14)};
    SBAR(); pv(o,vb0+sl_cur,PAF(0),PAF(1),PAF(2),PAF(3)); }
  #undef PKW
  #undef PAF
  #undef VFR
  #undef PIN
  #undef MX3
  #undef GAPA
  #undef GAPB
  #undef EX
  #undef VRD
  #undef KRD
  #undef STEP
  #undef ENDW
  #undef MASKUPD
  {auto rr=__builtin_amdgcn_permlane32_swap(__float_as_uint(l_reg),__float_as_uint(l_reg),false,false);l_reg=__uint_as_float(rr[0])+__uint_as_float(rr[1]);}
  if(hi==0)wsf[32+r32]=l_reg;asm volatile("s_waitcnt lgkmcnt(0)":::"memory");
  float rli[16];
  #pragma unroll
  for(int r=0;r<16;++r)rli[r]=__builtin_amdgcn_rcpf(wsf[32+crow(r,hi)]);
  bf16*Ow=O+(rowbase+q0+wid*QBLK)*OP+h*D;
  { bf16*stg=(bf16*)(shm+LDS_OST)+wid*2048;
    #pragma unroll
    for(int r=0;r<16;++r){const int orow=crow(r,hi);
      #pragma unroll
      for(int d0=0;d0<2;++d0)stg[orow*64+d0*32+r32]=(bf16)(cvtpk_s(o[d0][r]*rli[r],0.f)&0xffffu);}
    asm volatile("s_waitcnt lgkmcnt(0)":::"memory");
    #pragma unroll
    for(int i=0;i<4;++i){const int row=i*8+(lane>>3),ch=lane&7; const u32x4 v=*(const u32x4*)(stg+row*64+ch*8); ATTN_STORE16(Ow+(long)row*OP+ch*8,v);} }
  asm volatile("s_waitcnt lgkmcnt(0)\n\ts_barrier":::"memory");
  #undef DMA_K
  #undef DMA_V
  #undef CMASK
  #undef START
  #undef RESC
  #undef ROT
}
constexpr int ATTN_LDS_BYTES=LDS_BYTES;
#undef SBAR
#undef WAIT_BAR
}
using pg8::Unit;
constexpr size_t TILE_B = 256 * 2;
struct SchedBase { int G, c; };
struct SchedZ : SchedBase {
    __device__ __forceinline__ bool next(int i, Unit& u) const {
        const int L = i * G + c; constexpr int NZ = (M / 256) * (NIN / 256), NKV = (MEMR / 256) * (2 * D / 256);
        if (L < NZ) { pg8::tile_map(L, M / 256, NIN / 256, u.pm, u.pn); u.z = 0; u.a_off = WS_XN + (size_t)u.pm * 256 * D * 2; u.b_off = WS_WIN_T + (size_t)u.pn * 256 * D * 2; return true; }
        if (L < NZ + NKV) { const int l = L - NZ; u.pm = l / 8; u.pn = l % 8; u.z = 1; u.a_off = WS_MEMN + (size_t)u.pm * 256 * D * 2; u.b_off = WS_WXKV_T + (size_t)u.pn * 256 * D * 2; return true; }
        return false;
    }
};
struct SchedG : SchedBase {
    __device__ __forceinline__ bool next(int i, Unit& u) const {
        const int L = i * G + c; if (L >= 64) return false;
        u.z = L >> 4; u.pm = (L >> 2) & 3; u.pn = L & 3; u.a_off = WS_KV + ((size_t)u.pm * 256 * 2048 + u.z * 256) * 2; u.b_off = WS_WQ_S + ((size_t)u.pn * 256 * 1024 + u.z * 256) * 2; return true;
    }
};
struct SchedVW : SchedBase {
    __device__ __forceinline__ bool next(int i, Unit& u) const {
        const int L = i * G + (G - 1 - c); if (L >= 64) return false;
        u.z = L >> 2; u.pm = L & 3; u.pn = 0; const int b = u.z >> 2, h = u.z & 3;
        u.a_off = WS_WO_T + ((size_t)u.pm * 256 * 1024 + h * 256) * 2; u.b_off = WS_KV + ((size_t)b * 256 * 2048 + 1024 + h * 256) * 2; return true;
    }
};
struct SchedMN : SchedBase {
    int nN; size_t a_base, b_base; int lda, ldb, bsel;
    __device__ __forceinline__ bool next(int i, Unit& u) const {
        const int L = i * G + c; if (L >= (M / 256) * nN) return false;
        pg8::tile_map(L, M / 256, nN, u.pm, u.pn); u.z = 0;
        u.a_off = a_base + (size_t)u.pm * 256 * lda * 2; u.b_off = b_base + ((size_t)u.pn * 256 + (bsel ? (size_t)(u.pm >> 5) * 1024 : 0)) * ldb * 2; return true;
    }
};

constexpr int CW_MQ = 8192;
__device__ __forceinline__ void moba_attn_phase(Frame& F, int bx) {
    const bf16* Z = (const bf16*)(F.ws + WS_Z); bf16* Y = (bf16*)(F.ws + WS_Y) + RW; const float* KM = (const float*)(F.ws + WS_KMEAN);
    const bool perx = (F.G % 8 == 0); const int x = perx ? (bx & 7) : 0; const int nun = perx ? 128 : 1024;
    unsigned* qc = (unsigned*)(F.ctl + CW_MQ + 64 * x);
    volatile LAS unsigned* slot = F.MISC + 16;
    for (int it = 0;; ++it) {
        if (F.tid == 0) slot[it & 1] = __hip_atomic_fetch_add(qc, 1u, __ATOMIC_RELAXED, __HIP_MEMORY_SCOPE_AGENT);
        asm volatile("s_waitcnt vmcnt(0) lgkmcnt(0)" ::: "memory"); __builtin_amdgcn_s_barrier(); asm volatile("" ::: "memory");
        const int idx = __builtin_amdgcn_readfirstlane((int)slot[it & 1]);
        if (idx >= nun) break;
        const int bh = perx ? x * 4 + (idx & 3) : (idx & 31), qb = perx ? 31 - (idx >> 2) : 31 - (idx >> 5);
        int ln = F.lane; asm volatile("" : "+v"(ln)); ln &= 63;
        attn_body::attn_unit<8>(bh / NH, bh % NH, qb, Z + ZQ, Z + ZK, Z + ZV, Y, KM + (size_t)bh * NBLK * HD, (char*)F.lds + RING_OFF, F.wave, ln);
    }
}

#ifndef MK_N_LAUNCHES
#define MK_N_LAUNCHES 1
#endif
constexpr int PER_PHASE = 11;
constexpr int N_LAUNCHES = MK_N_LAUNCHES;
constexpr int SCAN_WGS = 64;
struct Args { const float* in[25]; float* out; unsigned char* ws; int ph_lo, ph_hi, li, pad; };
__global__ void __launch_bounds__(NWAVES * 64, 2) skel_fwd(Args args) {
    extern __shared__ __attribute__((aligned(16))) unsigned char lds[];
    Frame F;
    F.lds = (LAS unsigned char*)lds;
    F.MISC = (volatile LAS unsigned*)(F.lds + MISC_OFF);
    F.tid = threadIdx.x; F.lane = F.tid & 63; F.wave = __builtin_amdgcn_readfirstlane(F.tid >> 6) & 7;
    F.G = gridDim.x; { const int bx = blockIdx.x; F.vcu = (F.G % 8 == 0) ? (bx % 8) * (F.G / 8) + bx / 8 : bx; }
    F.ws = args.ws; F.dout = (unsigned char*)args.out;
#pragma unroll
    for (int i = 0; i < 25; ++i) F.in[i] = args.in[i];
    F.ctl = (gu32*)(F.ws + WS_CTL);
    for (int u = F.tid; u < (EPI_LDS_OFF - LDSCTL_OFF) / 4; u += NWAVES * 64) ((LAS unsigned*)(F.lds + LDSCTL_OFF))[u] = 0u;
    __syncthreads();
    XcdBarrier bar; bar.bar = (unsigned*)(F.ctl + CW_BAR); bar.x = 0; bar.st = nullptr;
    if (N_LAUNCHES == 1) bar = xcd_barrier_post((unsigned*)(F.ctl + CW_BAR), F.MISC + 8);
#define GRID_BAR() do { if (N_LAUNCHES == 1) xcd_barrier(bar); } while (0)
    const int lo = args.ph_lo, hi = args.ph_hi;
#ifndef PHASE_MASK
#define PHASE_MASK 0xFFFF
#endif
#define IN(k) (((PHASE_MASK >> (k)) & 1) && lo <= (k) && (k) < hi)
#define BOTH(k) (IN(k) && IN((k) + 1))
#define FRESH() do { int l_; asm volatile("v_mbcnt_lo_u32_b32 %0, -1, 0\n\tv_mbcnt_hi_u32_b32 %0, -1, %0" : "=v"(l_)); F.lane = l_ & 63; F.tid = F.wave * 64 + F.lane; } while (0)
    const char* wsc = (const char*)F.ws;
    const int bx = (int)blockIdx.x;

    if (IN(0)) { FRESH(); p0_prologue(F); if (BOTH(0)) GRID_BAR(); }
    if (IN(1)) {
        pg8::Gemm g{wsc, wsc, D, D, D}; SchedZ S; S.G = F.G; S.c = bx;
        pg8::EpiStoreBf16 E{(bf16*)(F.ws + WS_Z), NIN, (bf16*)(F.ws + WS_KV), 2 * D, ZQ / 256, attn_body::C2, 0};
        pg8::gemm_phase<pg8::EpiStoreBf16, SchedZ, true>(F.lds + RING_OFF, g, S, E, F.wave);
        if (BOTH(1)) GRID_BAR();
    }
    if (IN(2)) {
        { pg8::Gemm g{wsc, wsc, 2 * D, D, 256}; SchedG S; S.G = F.G; S.c = bx;
          pg8::EpiStoreBf16 E{(bf16*)(F.ws + WS_GT), D, nullptr, 0, 0, 1.f, 1};
          pg8::gemm_phase<pg8::EpiStoreBf16, SchedG, true>(F.lds + RING_OFF, g, S, E, F.wave); }
        { pg8::Gemm g{wsc, wsc, D, 2 * D, 256}; SchedVW S; S.G = F.G; S.c = bx;
          pg8::EpiStoreBf16 E{(bf16*)(F.ws + WS_VWT), D, nullptr, 0, 0, 1.f, 2};
          pg8::gemm_phase<pg8::EpiStoreBf16, SchedVW, true>(F.lds + RING_OFF, g, S, E, F.wave); }
        __syncthreads();
        FRESH(); kmean_simple(F);
        FRESH(); rwkv_prep_simple(F);
        if (BOTH(2)) GRID_BAR();
    }
    if (IN(3)) {
        FRESH();
        if (bx < SCAN_WGS) scan_simple(F, bx);
        else moba_attn_phase(F, bx);
        if (BOTH(3)) GRID_BAR();
    }
    if (IN(4)) { FRESH(); rwkv_post_simple(F); if (BOTH(4)) GRID_BAR(); }
    if (IN(5)) {
        pg8::Gemm g{wsc, wsc, D, D, D}; SchedMN S; S.G = F.G; S.c = bx; S.nN = D / 256; S.a_base = WS_Y; S.b_base = WS_WMIX_T; S.lda = D; S.ldb = D; S.bsel = 0;
        pg8::EpiRes E{F.in[0], (float*)F.dout, (bf16*)(F.ws + WS_HB), (float*)(F.ws + WS_SS), D};
        pg8::gemm_phase<pg8::EpiRes, SchedMN, true>(F.lds + RING_OFF, g, S, E, F.wave);
        if (BOTH(5)) GRID_BAR();
    }
    if (IN(6)) {
        pg8::Gemm g{wsc, wsc, D, D, D}; SchedMN S; S.G = F.G; S.c = bx; S.nN = D / 256; S.a_base = WS_HB; S.b_base = WS_GT; S.lda = D; S.ldb = D; S.bsel = 1;
        pg8::EpiSoftmax E{(bf16*)(F.ws + WS_P), D, (const float*)(F.ws + WS_SS), (PG8_LAS pg8::f32x2*)(F.lds + EPI_LDS_OFF)};
        pg8::gemm_phase<pg8::EpiSoftmax, SchedMN, true>(F.lds + RING_OFF, g, S, E, F.wave);
        if (BOTH(6)) GRID_BAR();
    }
    if (IN(7)) {
        pg8::Gemm g{wsc, wsc, D, D, D}; SchedMN S; S.G = F.G; S.c = bx; S.nN = D / 256; S.a_base = WS_P; S.b_base = WS_VWT; S.lda = D; S.ldb = D; S.bsel = 1;
        pg8::EpiRes E{(const float*)F.dout, (float*)F.dout, (bf16*)(F.ws + WS_HB), (float*)(F.ws + WS_SS) + (size_t)M * 16, D};
        pg8::gemm_phase<pg8::EpiRes, SchedMN, true>(F.lds + RING_OFF, g, S, E, F.wave);
        if (BOTH(7)) GRID_BAR();
    }
    if (IN(8)) {
        pg8::Gemm g{wsc, wsc, D, D, D}; SchedMN S; S.G = F.G; S.c = bx; S.nN = FF / 256; S.a_base = WS_HB; S.b_base = WS_W1_T; S.lda = D; S.ldb = D; S.bsel = 0;
        pg8::EpiSqRelu E{(bf16*)(F.ws + WS_AH), FF, (const float*)(F.ws + WS_SS) + (size_t)M * 16};
        pg8::gemm_phase<pg8::EpiSqRelu, SchedMN, true>(F.lds + RING_OFF, g, S, E, F.wave);
        if (BOTH(8)) GRID_BAR();
    }
    if (IN(9)) {
        pg8::Gemm g{wsc, wsc, FF, FF, FF}; SchedMN S; S.G = F.G; S.c = bx; S.nN = D / 256; S.a_base = WS_AH; S.b_base = WS_W2_T; S.lda = FF; S.ldb = FF; S.bsel = 0;
        pg8::EpiRes E{(const float*)F.dout, (float*)F.dout, nullptr, (float*)(F.ws + WS_SS) + (size_t)2 * M * 16, D};
        pg8::gemm_phase<pg8::EpiRes, SchedMN, true>(F.lds + RING_OFF, g, S, E, F.wave);
        if (BOTH(9)) GRID_BAR();
    }
    if (IN(10)) { FRESH(); final_norm(F); }
#undef IN
#undef BOTH
}

extern "C" void kernel_launch(void* const* d_in, const int* in_sizes, int n_in, void* d_out, int out_size, void* d_ws, size_t ws_size, hipStream_t stream) {
    static int grid = 0;
    if (grid == 0) {
        if (n_in != 25 || in_sizes[0] != M * D || out_size != M * D || ws_size < WS_END) { fprintf(stderr, "kernel_launch: unexpected problem (n_in %d, in0 %d, out %d, ws %zu); nothing launched\n", n_in, n_in > 0 ? in_sizes[0] : -1, out_size, ws_size); grid = -1; return; }
        int dev = 0, cus = 0, per_cu = 0;
        if (hipGetDevice(&dev) != hipSuccess || hipDeviceGetAttribute(&cus, hipDeviceAttributeMultiprocessorCount, dev) != hipSuccess) { grid = -1; return; }
        if (hipFuncSetAttribute((const void*)skel_fwd, hipFuncAttributeMaxDynamicSharedMemorySize, LDS_BYTES) != hipSuccess) { fprintf(stderr, "kernel_launch: hipFuncSetAttribute failed\n"); grid = -1; return; }
        if (hipOccupancyMaxActiveBlocksPerMultiprocessor(&per_cu, (const void*)skel_fwd, NWAVES * 64, LDS_BYTES) != hipSuccess || per_cu < 1)
            fprintf(stderr, "kernel_launch: note: occupancy query reports %d workgroups per CU\n", per_cu);
        (void)hipGetLastError();
        grid = cus;
    }
    if (grid < 0) return;
    if (hipMemsetAsync((char*)d_ws + WS_CTL, 0, CTL_ZERO_BYTES, stream) != hipSuccess) { fprintf(stderr, "kernel_launch: hipMemsetAsync failed\n"); return; }
    Args a{};
    for (int i = 0; i < 25; ++i) a.in[i] = (const float*)d_in[i];
    a.out = (float*)d_out; a.ws = (unsigned char*)d_ws;
    for (int li = 0; li < N_LAUNCHES; ++li) {
        a.ph_lo = (N_LAUNCHES == PER_PHASE) ? li : 0; a.ph_hi = (N_LAUNCHES == PER_PHASE) ? li + 1 : PER_PHASE; a.li = li;
        hipLaunchKernelGGL(skel_fwd, dim3(grid), dim3(NWAVES * 64), LDS_BYTES, stream, a);
        const hipError_t le = hipPeekAtLastError();
        if (le != hipSuccess) { fprintf(stderr, "kernel_launch: launch %d failed: %s\n", li, hipGetErrorName(le)); break; }
    }
}
```

```cpp
#include <hip/hip_runtime.h>
#include <cstdio>
#include <cstdint>
#include <cmath>
namespace pg8 {
#define PG8_LAS __attribute__((address_space(3)))
typedef unsigned short bf16_t;
typedef short bf16x8 __attribute__((ext_vector_type(8)));
typedef float f32x4 __attribute__((ext_vector_type(4)));
typedef float f32x2 __attribute__((ext_vector_type(2)));
typedef unsigned u32x4 __attribute__((ext_vector_type(4)));
typedef unsigned u32x2 __attribute__((ext_vector_type(2)));
constexpr int BM = 256, BK = 64, HALF = 128, HTB = HALF * BK * 2  , STAGE_BYTES = 8 * HTB, NXCD = 8, WGM = 8;

__host__ __device__ __forceinline__ int lds_byte(int r, int c) { const int st = (r >> 4) * 2 + (c >> 5), rr = r & 15, cc = c & 31, ob = rr * 64 + cc * 2; return st * 1024 + (ob ^ (((ob >> 9) & 1) << 5)); }
__host__ __device__ __forceinline__ void stage_rc(int b, int& R, int& C) { const int st = b / 1024, sb = b % 1024, swz = sb ^ (((sb >> 9) & 1) << 5); R = (st >> 1) * 16 + swz / 64; C = (st & 1) * 32 + (swz % 64) / 2; }
__host__ __device__ __forceinline__ int perm32(int rho) { const int n = rho >> 4, i = rho & 15; return 8 * (i >> 2) + 4 * n + (i & 3); }

struct Unit { int pm, pn, z; size_t a_off, b_off; };
struct Gemm { const char* A; const char* Bt; int lda, ldb, K; };

__host__ __device__ __forceinline__ void tile_map(int L, int nM, int nN, int& pm, int& pn) {
    const int nwg = nM * nN; int wgid = L;
    { const int q = nwg / NXCD, r = nwg % NXCD, xcd = wgid % NXCD, off = wgid / NXCD; wgid = (xcd < r ? xcd * (q + 1) : r * (q + 1) + (xcd - r) * q) + off; }
    const int nig = WGM * nN, gid = wgid / nig, fm = gid * WGM, gsz = (nM - fm) < WGM ? (nM - fm) : WGM;
    pm = fm + ((wgid % nig) % gsz); pn = (wgid % nig) / gsz;
}

__device__ __forceinline__ unsigned cvt_pk_bf16(float lo, float hi) { unsigned r; asm volatile("v_cvt_pk_bf16_f32 %0, %1, %2" : "=v"(r) : "v"(lo), "v"(hi)); return r; }

template <class Epi, class Sched, bool ALIGN_EPI>
__device__ __forceinline__ void gemm_phase(PG8_LAS unsigned char* lds, const Gemm g, const Sched& S, const Epi& E, const int wid_) {
    int lane_; asm volatile("v_mbcnt_lo_u32_b32 %0, -1, 0\n\tv_mbcnt_hi_u32_b32 %0, -1, %0" : "=v"(lane_));
    const int lane = lane_ & 63, wid = wid_ & 7, tid = wid * 64 + lane, wr = wid >> 2, wc = wid & 3, fr = lane & 15, fq = lane >> 4;
    const int K = g.K, nt = K / BK;
    unsigned voffA[2], voffB[2];
#pragma unroll
    for (int i = 0; i < 2; ++i) { int R, C; stage_rc(tid * 16 + i * 8192, R, C); const int Rb = Epi::PERM ? ((R & ~31) + perm32(R & 31)) : R;
        voffA[i] = (unsigned)(R * g.lda + C) * 2u; voffB[i] = (unsigned)(Rb * g.ldb + C) * 2u; }
    const size_t kstep = (size_t)(BK * 2);
    const size_t hstepA = (size_t)HALF * g.lda * 2, hstepB = (size_t)HALF * g.ldb * 2;
    const unsigned ldsw = (unsigned)wid * 1024u;
    const int aoff = lds_byte(wr * 64 + fr, fq * 8), boff = lds_byte(wc * 32 + fr, fq * 8);
#define PG8_SA(b, h) (((b) * 2 + (h)) * HTB)
#define PG8_SB(b, h) ((4 + (b) * 2 + (h)) * HTB)
#define PG8_STAGE(bufoff, gbase, voff) do { _Pragma("unroll") for (int _i = 0; _i < 2; ++_i) \
        __builtin_amdgcn_global_load_lds((const unsigned*)((const char*)(gbase) + (voff)[_i]), (PG8_LAS unsigned*)(lds + (bufoff) + ldsw + _i * 8192), 16, 0, 0); } while (0)
#define PG8_LDA(dst, b, h) do { _Pragma("unroll") for (int m = 0; m < 4; ++m) _Pragma("unroll") for (int k = 0; k < 2; ++k) dst[m][k] = *(const PG8_LAS bf16x8*)(lds + PG8_SA(b, h) + aoff + m * 2048 + k * 1024); } while (0)
#define PG8_LDB(dst, b, h) do { _Pragma("unroll") for (int n = 0; n < 2; ++n) _Pragma("unroll") for (int k = 0; k < 2; ++k) dst[n][k] = *(const PG8_LAS bf16x8*)(lds + PG8_SB(b, h) + boff + n * 2048 + k * 1024); } while (0)
#define PG8_MMA(ai, bj, At, Bt) do { __builtin_amdgcn_s_setprio(1); _Pragma("unroll") for (int m = 0; m < 4; ++m) _Pragma("unroll") for (int n = 0; n < 2; ++n) _Pragma("unroll") for (int k = 0; k < 2; ++k) \
        acc[ai][bj][m][n] = __builtin_amdgcn_mfma_f32_16x16x32_bf16(Bt[n][k], At[m][k], acc[ai][bj][m][n], 0, 0, 0); __builtin_amdgcn_s_setprio(0); } while (0)
#define PG8_WAIT_V(n) asm volatile("s_waitcnt vmcnt(" #n ")" ::: "memory")
#define PG8_WAIT_L(n) asm volatile("s_waitcnt lgkmcnt(" #n ")" ::: "memory")
#define PG8_BAR __builtin_amdgcn_s_barrier()
#define PG8_SCHED __builtin_amdgcn_sched_barrier(0)
    Unit cur, nxt; int ui = 0;
    if (!S.next(0, cur)) return;
    f32x4 acc[2][2][4][2];
#pragma unroll
    for (int a = 0; a < 2; ++a)
#pragma unroll
        for (int b = 0; b < 2; ++b)
#pragma unroll
            for (int m = 0; m < 4; ++m)
#pragma unroll
                for (int n = 0; n < 2; ++n) acc[a][b][m][n] = (f32x4){0.f, 0.f, 0.f, 0.f};
    bf16x8 At[4][2], B0[2][2], B1[2][2];
    const char* cA = g.A + cur.a_off; const char* cB = g.Bt + cur.b_off;
    PG8_STAGE(PG8_SB(0, 0), cB, voffB); PG8_STAGE(PG8_SB(0, 1), cB + hstepB, voffB); PG8_STAGE(PG8_SA(0, 0), cA, voffA); PG8_STAGE(PG8_SA(0, 1), cA + hstepA, voffA);
    if (wr == 1) PG8_BAR;
    PG8_WAIT_V(2); PG8_BAR;
    PG8_STAGE(PG8_SB(1, 0), cB + kstep, voffB); PG8_STAGE(PG8_SA(1, 0), cA + kstep, voffA); PG8_STAGE(PG8_SB(1, 1), cB + hstepB + kstep, voffB);
    PG8_WAIT_V(6); PG8_BAR;
    for (;;) {
        const bool has_next = S.next(ui + 1, nxt);
        const char* nA = has_next ? g.A + nxt.a_off : cA; const char* nB = has_next ? g.Bt + nxt.b_off : cB;
        for (int t = 0; t < nt; t += 2) {
            const bool last = (t == nt - 2);
            const char* a1 = cA + (size_t)(t + 1) * kstep;
            const char* a2 = last ? nA : cA + (size_t)(t + 2) * kstep; const char* b2 = last ? nB : cB + (size_t)(t + 2) * kstep;
            const char* a3 = a2 + kstep; const char* b3 = b2 + kstep;
            PG8_LDB(B0, 0, 0); PG8_LDB(B1, 0, 1); PG8_SCHED; PG8_LDA(At, 0, 0); PG8_STAGE(PG8_SA(1, 1), a1 + hstepA, voffA);
            PG8_WAIT_V(8); PG8_WAIT_L(0); PG8_BAR; PG8_MMA(0, 0, At, B0); PG8_MMA(0, 1, At, B1); PG8_BAR; PG8_SCHED;
            PG8_LDA(At, 0, 1); PG8_STAGE(PG8_SB(0, 0), b2, voffB); PG8_STAGE(PG8_SB(0, 1), b2 + hstepB, voffB); PG8_STAGE(PG8_SA(0, 0), a2, voffA);
            PG8_WAIT_V(8); PG8_WAIT_L(0); PG8_BAR; PG8_MMA(1, 0, At, B0); PG8_MMA(1, 1, At, B1); PG8_BAR; PG8_SCHED;
            PG8_LDB(B0, 1, 0); PG8_LDB(B1, 1, 1); PG8_SCHED; PG8_LDA(At, 1, 0); PG8_STAGE(PG8_SA(0, 1), a2 + hstepA, voffA);
            PG8_WAIT_V(8); PG8_WAIT_L(0); PG8_BAR; PG8_MMA(0, 0, At, B0); PG8_MMA(0, 1, At, B1); PG8_BAR; PG8_SCHED;
            PG8_LDA(At, 1, 1); PG8_STAGE(PG8_SB(1, 0), b3, voffB); PG8_STAGE(PG8_SB(1, 1), b3 + hstepB, voffB); PG8_STAGE(PG8_SA(1, 0), a3, voffA);
            PG8_WAIT_V(8); PG8_WAIT_L(0); PG8_BAR; PG8_MMA(1, 0, At, B0); PG8_MMA(1, 1, At, B1); PG8_BAR; PG8_SCHED;
        }
        if constexpr (ALIGN_EPI) { if (wr == 0) PG8_BAR; }
        E(acc, cur, wr, wc, fr, fq, lane);
        if (!has_next) break;
#pragma unroll
        for (int a = 0; a < 2; ++a)
#pragma unroll
            for (int b = 0; b < 2; ++b)
#pragma unroll
                for (int m = 0; m < 4; ++m)
#pragma unroll
                    for (int n = 0; n < 2; ++n) acc[a][b][m][n] = (f32x4){0.f, 0.f, 0.f, 0.f};
        cur = nxt; cA = nA; cB = nB; ++ui;
        if constexpr (ALIGN_EPI) { if (wr == 1) PG8_BAR; }
    }
    PG8_WAIT_V(0);
    if constexpr (!ALIGN_EPI) { if (wr == 0) PG8_BAR; }
    PG8_BAR;
#undef PG8_SA
#undef PG8_SB
#undef PG8_STAGE
#undef PG8_LDA
#undef PG8_LDB
#undef PG8_MMA
#undef PG8_WAIT_V
#undef PG8_WAIT_L
#undef PG8_BAR
#undef PG8_SCHED
}
}
namespace pg8 {
struct EpiStoreBf16 {
    static constexpr bool PERM = true;
    bf16_t* O0; int ldc0; bf16_t* O1; int ldc1; int qs_lo; float qscale;
    int mode;
    __device__ __forceinline__ void operator()(const f32x4 (&acc)[2][2][4][2], const Unit& u, int wr, int wc, int fr, int fq, int lane) const {
        asm volatile("" : "+v"(fr), "+v"(fq), "+v"(lane));
        bf16_t* base; int ldc; size_t row0; int colt;
        if (mode == 0) { base = u.z ? O1 : O0; ldc = u.z ? ldc1 : ldc0; row0 = (size_t)u.pm * BM; colt = u.pn * BM; }
        else if (mode == 1) { base = O0; ldc = ldc0; row0 = (size_t)u.pm * 1024 + (size_t)u.z * 256; colt = u.pn * BM; }
        else { base = O0 + (size_t)(u.z >> 2) * 1048576; ldc = ldc0; row0 = (size_t)u.pm * BM; colt = (u.z & 3) * 256; }
        const float sc = (mode == 0 && u.z == 0 && (u.pn == qs_lo || u.pn == qs_lo + 1)) ? qscale : 1.f;
        const int col0 = colt + wc * 32 + 8 * fq;
#pragma unroll
        for (int ai = 0; ai < 2; ++ai)
#pragma unroll
            for (int m = 0; m < 4; ++m) { bf16_t* rowp = base + (row0 + wr * 64 + fr + ai * HALF + m * 16) * ldc + col0;
#pragma unroll
                for (int bj = 0; bj < 2; ++bj) { const f32x4 v0 = acc[ai][bj][m][0] * sc, v1 = acc[ai][bj][m][1] * sc;
                    u32x4 w; w.x = cvt_pk_bf16(v0[0], v0[1]); w.y = cvt_pk_bf16(v0[2], v0[3]); w.z = cvt_pk_bf16(v1[0], v1[1]); w.w = cvt_pk_bf16(v1[2], v1[3]);
                    *(u32x4*)(rowp + bj * HALF) = w; } }
    }
};

__device__ __forceinline__ float row_rstd(const float* ss, size_t row) {
    const f32x4* p = (const f32x4*)(ss + row * 16); const f32x4 a = p[0], b = p[1], c = p[2], d = p[3];
    const float s = ((a[0] + a[1]) + (a[2] + a[3])) + ((b[0] + b[1]) + (b[2] + b[3])) + ((c[0] + c[1]) + (c[2] + c[3])) + ((d[0] + d[1]) + (d[2] + d[3]));
    return 1.0f / sqrtf(s * (1.0f / 1024.0f) + 1e-6f);
}
__device__ __forceinline__ void wave_rstd(float (&rs)[2][4], const float* ss, int pm, int wr, int fr, int lane) {
    const float my0 = row_rstd(ss, (size_t)pm * BM + wr * 64 + lane), my1 = row_rstd(ss, (size_t)pm * BM + HALF + wr * 64 + lane);
#pragma unroll
    for (int m = 0; m < 4; ++m) { rs[0][m] = __shfl(my0, m * 16 + fr); rs[1][m] = __shfl(my1, m * 16 + fr); }
}

struct EpiRes {
    static constexpr bool PERM = false;
    const float* base; float* out; bf16_t* hb; float* ss; int ldc;
    __device__ __forceinline__ void operator()(f32x4 (&acc)[2][2][4][2], const Unit& u, int wr, int wc, int fr, int fq, int lane) const {
        asm volatile("" : "+v"(fr), "+v"(fq), "+v"(lane));
        const int col0 = u.pn * BM + wc * 32 + 4 * fq;
#pragma unroll
        for (int ai = 0; ai < 2; ++ai)
#pragma unroll
            for (int m = 0; m < 4; ++m) { const size_t row = (size_t)u.pm * BM + ai * HALF + wr * 64 + m * 16 + fr; const size_t off = row * ldc + col0; float q = 0.f;
#pragma unroll
                for (int bj = 0; bj < 2; ++bj)
#pragma unroll
                    for (int n = 0; n < 2; ++n) { const f32x4 bs = *(const f32x4*)(base + off + bj * HALF + n * 16); const f32x4 o = bs + acc[ai][bj][m][n];
                        *(f32x4*)(out + off + bj * HALF + n * 16) = o; q += (o[0] * o[0] + o[1] * o[1]) + (o[2] * o[2] + o[3] * o[3]);
                        if (hb) { u32x2 w; w.x = cvt_pk_bf16(o[0], o[1]); w.y = cvt_pk_bf16(o[2], o[3]); *(u32x2*)(hb + off + bj * HALF + n * 16) = w; } }
                q += __shfl_xor(q, 16); q += __shfl_xor(q, 32);
                if (fq == 0) ss[row * 16 + u.pn * 4 + wc] = q;
                if (m & 1) asm volatile("" ::: "memory"); }
    }
};

struct EpiSqRelu {
    static constexpr bool PERM = true;
    bf16_t* O; int ldc; const float* ss;
    __device__ __forceinline__ void operator()(const f32x4 (&acc)[2][2][4][2], const Unit& u, int wr, int wc, int fr, int fq, int lane) const {
        asm volatile("" : "+v"(fr), "+v"(fq), "+v"(lane));
        float rs[2][4]; wave_rstd(rs, ss, u.pm, wr, fr, lane);
        const int col0 = u.pn * BM + wc * 32 + 8 * fq;
#pragma unroll
        for (int ai = 0; ai < 2; ++ai)
#pragma unroll
            for (int m = 0; m < 4; ++m) { bf16_t* rowp = O + ((size_t)u.pm * BM + wr * 64 + fr + ai * HALF + m * 16) * ldc + col0; const float s = rs[ai][m];
#pragma unroll
                for (int bj = 0; bj < 2; ++bj) { f32x4 v0 = acc[ai][bj][m][0] * s, v1 = acc[ai][bj][m][1] * s;
#pragma unroll
                    for (int i = 0; i < 4; ++i) { const float a = fmaxf(v0[i], 0.f), b = fmaxf(v1[i], 0.f); v0[i] = a * a; v1[i] = b * b; }
                    u32x4 w; w.x = cvt_pk_bf16(v0[0], v0[1]); w.y = cvt_pk_bf16(v0[2], v0[3]); w.z = cvt_pk_bf16(v1[0], v1[1]); w.w = cvt_pk_bf16(v1[2], v1[3]);
                    *(u32x4*)(rowp + bj * HALF) = w; } }
    }
};

struct EpiSoftmax {
    static constexpr bool PERM = true;
    bf16_t* O; int ldc; const float* ss; PG8_LAS f32x2* xl;
    __device__ __forceinline__ void operator()(f32x4 (&acc)[2][2][4][2], const Unit& u, int wr, int wc, int fr, int fq, int lane) const {
        asm volatile("" : "+v"(fr), "+v"(fq), "+v"(lane));
        float rs[2][4]; wave_rstd(rs, ss, u.pm, wr, fr, lane);
#pragma unroll
        for (int ai = 0; ai < 2; ++ai)
#pragma unroll
            for (int m = 0; m < 4; ++m) { const float s = rs[ai][m] * (0.0625f * 1.4426950408889634f); float mx = -INFINITY;
#pragma unroll
                for (int bj = 0; bj < 2; ++bj)
#pragma unroll
                    for (int n = 0; n < 2; ++n) { f32x4 v = acc[ai][bj][m][n] * s; acc[ai][bj][m][n] = v; mx = fmaxf(fmaxf(mx, fmaxf(v[0], v[1])), fmaxf(v[2], v[3])); }
                mx = fmaxf(mx, __shfl_xor(mx, 16)); mx = fmaxf(mx, __shfl_xor(mx, 32)); float sm = 0.f;
#pragma unroll
                for (int bj = 0; bj < 2; ++bj)
#pragma unroll
                    for (int n = 0; n < 2; ++n) { f32x4 v = acc[ai][bj][m][n];
#pragma unroll
                        for (int i = 0; i < 4; ++i) { v[i] = __builtin_amdgcn_exp2f(v[i] - mx); sm += v[i]; } acc[ai][bj][m][n] = v; }
                sm += __shfl_xor(sm, 16); sm += __shfl_xor(sm, 32);
                if (fq == 0) xl[(ai * HALF + wr * 64 + m * 16 + fr) * 4 + wc] = (f32x2){mx, sm}; }
        asm volatile("s_waitcnt lgkmcnt(0)" ::: "memory"); __builtin_amdgcn_s_barrier(); asm volatile("" ::: "memory");
        const int col0 = u.pn * BM + wc * 32 + 8 * fq;
#pragma unroll
        for (int ai = 0; ai < 2; ++ai)
#pragma unroll
            for (int m = 0; m < 4; ++m) { const int r = ai * HALF + wr * 64 + m * 16 + fr;
                const f32x4 x01 = *(const PG8_LAS f32x4*)(xl + r * 4), x23 = *(const PG8_LAS f32x4*)(xl + r * 4 + 2);
                const float mg = fmaxf(fmaxf(x01[0], x01[2]), fmaxf(x23[0], x23[2]));
                const float tot = x01[1] * __builtin_amdgcn_exp2f(x01[0] - mg) + x01[3] * __builtin_amdgcn_exp2f(x01[2] - mg) + x23[1] * __builtin_amdgcn_exp2f(x23[0] - mg) + x23[3] * __builtin_amdgcn_exp2f(x23[2] - mg);
                const float mown = wc == 0 ? x01[0] : (wc == 1 ? x01[2] : (wc == 2 ? x23[0] : x23[2]));
                const float f = __builtin_amdgcn_exp2f(mown - mg) / tot;
                bf16_t* rowp = O + ((size_t)u.pm * BM + r) * ldc + col0;
#pragma unroll
                for (int bj = 0; bj < 2; ++bj) { const f32x4 v0 = acc[ai][bj][m][0] * f, v1 = acc[ai][bj][m][1] * f;
                    u32x4 w; w.x = cvt_pk_bf16(v0[0], v0[1]); w.y = cvt_pk_bf16(v0[2], v0[3]); w.z = cvt_pk_bf16(v1[0], v1[1]); w.w = cvt_pk_bf16(v1[2], v1[3]);
                    *(u32x4*)(rowp + bj * HALF) = w; } }
    }
};
}
constexpr int NWAVES = 8;
constexpr int BATCH = 4, T = 8192, D = 1024, M = BATCH * T;
constexpr int NIN = 3328, RW = 512, NH = 8, HD = 64;
constexpr int ZK_R = 512, ZV_R = 1024, ZWD = 1536, ZAD = 1600, ZGD = 1664;
constexpr int ZQ = 1792, ZK = 1792 + 512, ZV = 1792 + 1024;
constexpr int MEML = 256, MEMR = BATCH * MEML, FF = 4096;
constexpr int NBLK = T / 256;
constexpr float NORM_EPS = 1e-6f, GN_EPS = 64e-5f, DECAY_SCALE = 0.6065306597126334f;

constexpr size_t MiB = 1u << 20;
constexpr size_t WS_CTL = 0, CTL_ZERO_BYTES = 1 * MiB;
constexpr size_t WS_WIN_T = 1 * MiB, WS_WMIX_T = 8 * MiB, WS_WQ_S = 10 * MiB, WS_WXKV_T = 12 * MiB, WS_WO_T = 16 * MiB, WS_W1_T = 18 * MiB, WS_W2_T = 26 * MiB;
constexpr size_t WS_MEMN = 34 * MiB, WS_KV = 36 * MiB, WS_GT = 40 * MiB, WS_VWT = 48 * MiB;
constexpr size_t WS_SS = 56 * MiB;
constexpr size_t WS_KMEAN = 62 * MiB, WS_BON = 63 * MiB;
constexpr size_t WS_XN = 64 * MiB;
constexpr size_t WS_GATE = 64 * MiB, WS_YRAW = 96 * MiB;
constexpr size_t WS_HB = 64 * MiB;
constexpr size_t WS_Z = 128 * MiB;
constexpr size_t WS_Y = 336 * MiB;
constexpr size_t WS_PR = 400 * MiB, WS_PV = 432 * MiB;
constexpr size_t WS_P = 400 * MiB;
constexpr size_t WS_AH = 128 * MiB;
constexpr size_t WS_END = 512 * MiB;
constexpr size_t DO_W = 0, DO_KP = 32 * MiB, DO_KKN = 64 * MiB, DO_B = 96 * MiB;

constexpr int CW_TMO = 0, CW_CODE = 1;
constexpr int CW_BAR = 4096;

constexpr int RING_OFF = 0, RING_BYTES = 131072;
constexpr int LDSCTL_OFF = RING_BYTES, MISC_OFF = LDSCTL_OFF + 320;
constexpr int EPI_LDS_OFF = 132096;
constexpr int LDS_BYTES = 147456;
static_assert(MISC_OFF + 128 <= EPI_LDS_OFF && EPI_LDS_OFF + 8192 <= LDS_BYTES, "LDS map");

#define GAS __attribute__((address_space(1)))
#define LAS __attribute__((address_space(3)))
typedef unsigned short bf16;
typedef unsigned v4u __attribute__((ext_vector_type(4)));
typedef float f32x4 __attribute__((ext_vector_type(4)));
typedef GAS unsigned gu32;
#define RLX_AGENT __ATOMIC_RELAXED, __HIP_MEMORY_SCOPE_AGENT
#define LDS_WAIT() asm volatile("s_waitcnt lgkmcnt(0)" ::: "memory")
#define VM_WAIT() asm volatile("s_waitcnt vmcnt(0)" ::: "memory")
__device__ __forceinline__ unsigned f2bf(float f) { unsigned u = __builtin_bit_cast(unsigned, f); return (u + 0x7fffu + ((u >> 16) & 1u)) >> 16; }
__device__ __forceinline__ unsigned pk2(float lo, float hi) { return f2bf(lo) | (f2bf(hi) << 16); }
__device__ __forceinline__ float bf2f(unsigned short u) { return __builtin_bit_cast(float, (unsigned)u << 16); }
__device__ __forceinline__ float bflo(unsigned u) { return __builtin_bit_cast(float, u << 16); }
__device__ __forceinline__ float bfhi(unsigned u) { return __builtin_bit_cast(float, u & 0xffff0000u); }

#define XB_TMO      128
#define XB_XCNT(j)  (256  + 64 * (j))
#define XB_XSUB(j)  (1280 + 64 * (j))
#define XB_XGEN(j)  (2304 + 64 * (j))
#define XB_TOP      3328
#define XB_TOPGEN   3392
#define XCD_BAR_WORDS 3456
#define XB_SPIN_CAP (1u << 18)
__device__ __forceinline__ unsigned xb_ld(unsigned* p)              { return __hip_atomic_load(p, __ATOMIC_RELAXED, __HIP_MEMORY_SCOPE_AGENT); }
__device__ __forceinline__ unsigned xb_add(unsigned* p, unsigned v) { return __hip_atomic_fetch_add(p, v, __ATOMIC_RELAXED, __HIP_MEMORY_SCOPE_AGENT); }
__device__ __forceinline__ unsigned xb_xcc_id() { return (unsigned)__builtin_amdgcn_s_getreg((3 << 11) | 20) & 0xFu; }
#define XB_SPIN(cond, bar) do { unsigned _sp = 0; while (cond) { __builtin_amdgcn_s_sleep(1); \
    if ((++_sp & 255u) == 0u) { if (xb_ld(&(bar)[XB_TMO])) break; if (_sp > XB_SPIN_CAP) { atomicAdd(&(bar)[XB_TMO], 1u); break; } } } } while (0)
struct XcdBarrier { unsigned* bar; unsigned x; volatile LAS unsigned* st; };
__device__ __forceinline__ XcdBarrier xcd_barrier_post(unsigned* bar, volatile LAS unsigned* st) {
    XcdBarrier b; b.bar = bar; b.x = xb_xcc_id(); b.st = st;
    if (threadIdx.x == 0) (void)xb_add(&bar[XB_XCNT(b.x)], 1u);
    return b;
}
__device__ __forceinline__ void xcd_barrier_complete(unsigned* bar, unsigned x, unsigned& nloc, unsigned& nx) {
    const unsigned G = gridDim.x * gridDim.y * gridDim.z;
    unsigned sum, cnt, mine, sp = 0u;
    for (;;) {
        sum = 0u; cnt = 0u; mine = 0u;
#pragma unroll
        for (unsigned j = 0; j < 16; ++j) { const unsigned c = xb_ld(&bar[XB_XCNT(j)]); sum += c; cnt += (c > 0u) ? 1u : 0u; mine = (j == x) ? c : mine; }
        if (sum == G) break;
        __builtin_amdgcn_s_sleep(1);
        if ((++sp & 255u) == 0u) { if (xb_ld(&bar[XB_TMO])) break; if (sp > XB_SPIN_CAP) { atomicAdd(&bar[XB_TMO], 1u); break; } }
    }
    nloc = mine > 0u ? mine : 1u; nx = cnt > 0u ? cnt : 1u;
}
__device__ __forceinline__ void xcd_barrier(const XcdBarrier& b) {
    asm volatile("s_waitcnt vmcnt(0)" ::: "memory");
    __syncthreads();
    if (threadIdx.x == 0) {
        unsigned* bar = b.bar;
        __builtin_amdgcn_s_waitcnt(0);
        unsigned nloc = b.st[0], nx = b.st[1];
        if (nloc == 0u) { xcd_barrier_complete(bar, b.x, nloc, nx); b.st[0] = nloc; b.st[1] = nx; }
        const unsigned old = xb_add(&bar[XB_XSUB(b.x)], 1u);
        const unsigned gen = old / nloc;
        if (old + 1u == (gen + 1u) * nloc) {
            __builtin_amdgcn_fence(__ATOMIC_RELEASE, "agent");
            asm volatile("s_waitcnt vmcnt(0)" ::: "memory");
            const unsigned og = xb_add(&bar[XB_TOP], 1u);
            const unsigned tg = og / nx;
            if (og + 1u == (tg + 1u) * nx) xb_add(&bar[XB_TOPGEN], 1u);
            else XB_SPIN(xb_ld(&bar[XB_TOPGEN]) == tg, bar);
            __builtin_amdgcn_fence(__ATOMIC_ACQUIRE, "agent");
            xb_add(&bar[XB_XGEN(b.x)], 1u);
            asm volatile("s_waitcnt vmcnt(0)" ::: "memory");
        } else {
            XB_SPIN(xb_ld(&bar[XB_XGEN(b.x)]) == gen, bar);
            __builtin_amdgcn_fence(__ATOMIC_ACQUIRE, "agent");
            asm volatile("s_waitcnt vmcnt(0)" ::: "memory");
        }
    }
    __syncthreads();
}

struct Frame {
    LAS unsigned char* lds;
    volatile LAS unsigned* MISC;
    gu32* ctl;
    int tid, lane, wave;
    int vcu, G;
    unsigned char* ws; unsigned char* dout;
    const float* in[25];
};
__device__ __forceinline__ float wave_sum(float v) {
#pragma unroll
    for (int o = 1; o < 64; o <<= 1) v += __shfl_xor(v, o);
    return v;
}
__device__ __forceinline__ float wave_max(float v) {
#pragma unroll
    for (int o = 1; o < 64; o <<= 1) v = fmaxf(v, __shfl_xor(v, o));
    return v;
}
template <int CTRL> __device__ __forceinline__ float dpp_mov(float x) { return __builtin_bit_cast(float, __builtin_amdgcn_update_dpp(0, __builtin_bit_cast(int, x), CTRL, 0xf, 0xf, false)); }
__device__ __forceinline__ float red16(float x) { x += dpp_mov<0xB1>(x); x += dpp_mov<0x4E>(x); x += dpp_mov<0x124>(x); x += dpp_mov<0x128>(x); return x; }
__device__ __forceinline__ void p0_transpose_item(const float* W, int K, int N, bf16* WT, const float* kscale, LAS float* scr, int item, int lane) {
    const int nblk = N / 32, kb = item / nblk, nb = item % nblk, k0 = 64 * kb, n0 = 32 * nb;
#pragma unroll 8
    for (int i = 0; i < 32; ++i) { const int kk = 2 * i + (lane >> 5); const float s = kscale ? kscale[k0 + kk] : 1.f; scr[kk * 33 + (lane & 31)] = W[(size_t)(k0 + kk) * N + n0 + (lane & 31)] * s; }
    LDS_WAIT(); asm volatile("" ::: "memory");
    const int c = lane & 7;
#pragma unroll
    for (int j = 0; j < 4; ++j) { const int n = (lane >> 3) + 8 * j; const LAS float* s = scr + (8 * c) * 33 + n;
        v4u o; o.x = pk2(s[0 * 33], s[1 * 33]); o.y = pk2(s[2 * 33], s[3 * 33]); o.z = pk2(s[4 * 33], s[5 * 33]); o.w = pk2(s[6 * 33], s[7 * 33]);
        *(GAS v4u*)(WT + (size_t)(n0 + n) * K + k0 + 8 * c) = o; }
    LDS_WAIT(); asm volatile("" ::: "memory");
}
__device__ __forceinline__ void rms_row_to_bf16(const float* xrow, const float* g, bf16* orow, int lane) {
    const GAS f32x4* xr = (const GAS f32x4*)xrow + lane; const GAS f32x4* gr = (const GAS f32x4*)g + lane;
    f32x4 v[4]; float s = 0.f;
#pragma unroll
    for (int j = 0; j < 4; ++j) { v[j] = xr[64 * j]; s += (v[j].x * v[j].x + v[j].y * v[j].y) + (v[j].z * v[j].z + v[j].w * v[j].w); }
    const float rstd = 1.f / sqrtf(wave_sum(s) * (1.f / D) + NORM_EPS);
    GAS unsigned long long* o8 = (GAS unsigned long long*)orow + lane;
#pragma unroll
    for (int j = 0; j < 4; ++j) { const f32x4 gg = gr[64 * j]; o8[64 * j] = (unsigned long long)pk2(v[j].x * rstd * gg.x, v[j].y * rstd * gg.y) | ((unsigned long long)pk2(v[j].z * rstd * gg.z, v[j].w * rstd * gg.w) << 32); }
}
__device__ __forceinline__ void p0_prologue(Frame& F) {
    LAS float* scr = (LAS float*)(F.lds + RING_OFF + F.wave * 16384);
    const int gw = F.vcu * NWAVES + F.wave, NGW = F.G * NWAVES;
    constexpr int I_IN = (D / 64) * (NIN / 32), I_MIX = (D / 64) * (D / 32), I_KV = (D / 64) * (2 * D / 32), I_O = I_MIX, I_1 = (D / 64) * (FF / 32), I_2 = (FF / 64) * (D / 32);
    constexpr int NITEMS = I_IN + I_MIX + I_KV + I_O + I_1 + I_2;
    for (int it = gw; it < NITEMS; it += NGW) {
        int r = it;
        if (r < I_IN) { p0_transpose_item(F.in[3], D, NIN, (bf16*)(F.ws + WS_WIN_T), nullptr, scr, r, F.lane); continue; } r -= I_IN;
        if (r < I_MIX) { p0_transpose_item(F.in[15], D, D, (bf16*)(F.ws + WS_WMIX_T), nullptr, scr, r, F.lane); continue; } r -= I_MIX;
        if (r < I_KV) { p0_transpose_item(F.in[19], D, 2 * D, (bf16*)(F.ws + WS_WXKV_T), nullptr, scr, r, F.lane); continue; } r -= I_KV;
        if (r < I_O) { p0_transpose_item(F.in[20], D, D, (bf16*)(F.ws + WS_WO_T), nullptr, scr, r, F.lane); continue; } r -= I_O;
        if (r < I_1) { p0_transpose_item(F.in[22], D, FF, (bf16*)(F.ws + WS_W1_T), F.in[21], scr, r, F.lane); continue; } r -= I_1;
        p0_transpose_item(F.in[23], FF, D, (bf16*)(F.ws + WS_W2_T), nullptr, scr, r, F.lane);
    }
    { const float* wq = F.in[18]; const float* gx = F.in[16]; bf16* o = (bf16*)(F.ws + WS_WQ_S);
      for (int i = (F.vcu * 512 + F.tid); i < D * D / 4; i += F.G * 512) { const f32x4 v = ((const GAS f32x4*)wq)[i]; const float s = gx[(i * 4) / D];
          ((GAS unsigned long long*)o)[i] = (unsigned long long)pk2(v.x * s, v.y * s) | ((unsigned long long)pk2(v.z * s, v.w * s) << 32); } }
    for (int m = gw; m < M; m += NGW) rms_row_to_bf16(F.in[0] + (size_t)m * D, F.in[2], (bf16*)(F.ws + WS_XN) + (size_t)m * D, F.lane);
    for (int m = gw; m < MEMR; m += NGW) rms_row_to_bf16(F.in[1] + (size_t)m * D, F.in[17], (bf16*)(F.ws + WS_MEMN) + (size_t)m * D, F.lane);
}

__device__ __forceinline__ float zshift(const bf16* Z, const float* mu, int m, int col) {
    const float z = bf2f(Z[(size_t)m * NIN + col]); const float zp = (m % T == 0) ? 0.f : bf2f(Z[(size_t)(m - 1) * NIN + col]);
    return z + (zp - z) * mu[col];
}
__device__ __forceinline__ void rwkv_prep_simple(Frame& F) {
    const bf16* Z = (const bf16*)(F.ws + WS_Z); const float* mu = F.in[4];
    LAS float* lo = (LAS float*)(F.lds + RING_OFF);
    const int c = F.tid;
    const float w0 = F.in[5][c], a0 = F.in[7][c], kkc = F.in[10][c], kac = F.in[11][c], rkc = F.in[12][c];
    const float* wup = F.in[6]; const float* aup = F.in[8]; const float* gup = F.in[9];
    bf16* oR = (bf16*)(F.ws + WS_PR); bf16* oV = (bf16*)(F.ws + WS_PV); bf16* oW = (bf16*)(F.dout + DO_W); bf16* oKP = (bf16*)(F.dout + DO_KP); bf16* oKK = (bf16*)(F.dout + DO_KKN); bf16* oB = (bf16*)(F.dout + DO_B);
    bf16* oG = (bf16*)(F.ws + WS_GATE); float* oBon = (float*)(F.ws + WS_BON);
    for (int m0 = F.vcu * 4; m0 < M; m0 += F.G * 4) {
#pragma unroll
        for (int i = 0; i < 2; ++i) { const int e = F.tid + 512 * i, tk = e >> 8, j = e & 255; const float zs = zshift(Z, mu, m0 + tk, ZWD + j);
            lo[e] = j < 64 ? tanhf(zs) : (j < 128 ? zs : 1.f / (1.f + __expf(-zs))); }
        __syncthreads();
        float aw[4], aa[4], ag[4];
#pragma unroll
        for (int k = 0; k < 4; ++k) { aw[k] = 0.f; aa[k] = 0.f; ag[k] = 0.f; }
        for (int j = 0; j < 64; ++j) { const float wv = wup[j * RW + c], av = aup[j * RW + c];
#pragma unroll
            for (int k = 0; k < 4; ++k) { aw[k] += lo[k * 256 + j] * wv; aa[k] += lo[k * 256 + 64 + j] * av; } }
        for (int j = 0; j < 128; ++j) { const float gv = gup[j * RW + c];
#pragma unroll
            for (int k = 0; k < 4; ++k) ag[k] += lo[k * 256 + 128 + j] * gv; }
#pragma unroll
        for (int k = 0; k < 4; ++k) { const int m = m0 + k;
            const float r = zshift(Z, mu, m, c), kx = zshift(Z, mu, m, ZK_R + c), v = zshift(Z, mu, m, ZV_R + c);
            const float dec = -DECAY_SCALE / (1.f + __expf(-(w0 + aw[k])));
            const float a = 1.f / (1.f + __expf(-(a0 + aa[k])));
            const float kk = kx * kkc; const float nn = wave_sum(kk * kk); const float kkn = kk / fmaxf(sqrtf(nn), 1e-12f);
            const float kp = kx * (1.f + (a - 1.f) * kac);
            const float bon = wave_sum(r * kp * rkc);
            const size_t o = (size_t)m * RW + c;
            oR[o] = (bf16)f2bf(r); oV[o] = (bf16)f2bf(v); oW[o] = (bf16)f2bf(dec); oKP[o] = (bf16)f2bf(kp); oKK[o] = (bf16)f2bf(kkn); oB[o] = (bf16)f2bf(kkn * a); oG[o] = (bf16)f2bf(ag[k]);
            if (F.lane == 0) oBon[(size_t)m * NH + F.wave] = bon; }
        __syncthreads();
    }
}
__device__ __forceinline__ void kmean_simple(Frame& F) {
    const bf16* Z = (const bf16*)(F.ws + WS_Z); float* KM = (float*)(F.ws + WS_KMEAN);
    const int gw = F.vcu * NWAVES + F.wave, NGW = F.G * NWAVES;
    for (int u = gw; u < BATCH * NH * NBLK; u += NGW) { const int j = u % NBLK, bh = u / NBLK, b = bh / NH, h = bh % NH;
        const bf16* kp = Z + ((size_t)b * T + j * 256) * NIN + ZK + h * HD + F.lane; float s = 0.f;
        for (int i = 0; i < 256; ++i) s += bf2f(kp[(size_t)i * NIN]);
        KM[(size_t)u * HD + F.lane] = s * (1.f / 256.f); }
}
constexpr int SC_TC = 32, SC_REC = 352;
__device__ __forceinline__ void scan_simple(Frame& F, int unit) {
    const int bh = unit >> 1, hf = unit & 1, b = bh / NH, h = bh % NH;
    const size_t rowbase = (size_t)b * T;
    const bf16* aR = (const bf16*)(F.ws + WS_PR); const bf16* aV = (const bf16*)(F.ws + WS_PV); const bf16* aW = (const bf16*)(F.dout + DO_W); const bf16* aKP = (const bf16*)(F.dout + DO_KP);
    const bf16* aKK = (const bf16*)(F.dout + DO_KKN); const bf16* aB = (const bf16*)(F.dout + DO_B);
    bf16* yout = (bf16*)(F.ws + WS_YRAW);
    LAS float* buf = (LAS float*)(F.lds + RING_OFF);
    const int rowl = F.tid >> 4, p = F.tid & 15;
    float S0 = 0.f, S1 = 0.f, S2 = 0.f, S3 = 0.f;
    unsigned short raw[22];
#define SC_GLOAD(t0) do { _Pragma("unroll") for (int i = 0; i < 22; ++i) { const int e = F.tid + 512 * i, tk = e / SC_REC, rem = e % SC_REC, q = rem >> 6, cc = rem & 63; \
            const size_t rowo = (rowbase + (t0) + tk) * RW + h * HD; \
            const bf16* src = q == 0 ? aR : (q == 1 ? aW : (q == 2 ? aKP : (q == 3 ? aKK : (q == 4 ? aB : aV)))); \
            raw[i] = src[rowo + (q == 5 ? hf * 32 + cc : cc)]; } } while (0)
#define SC_LSTORE(bi) do { _Pragma("unroll") for (int i = 0; i < 22; ++i) { const int e = F.tid + 512 * i; buf[(bi) * SC_TC * SC_REC + e] = bf2f(raw[i]); } } while (0)
    SC_GLOAD(0); SC_LSTORE(0); __syncthreads();
    for (int ch = 0; ch < T / SC_TC; ++ch) {
        const int cur = ch & 1; const bool more = (ch + 1 < T / SC_TC);
        if (more) SC_GLOAD((ch + 1) * SC_TC);
        const LAS float* rec = buf + cur * SC_TC * SC_REC;
        for (int tt = 0; tt < SC_TC; ++tt, rec += SC_REC) {
            const f32x4 r4 = *(const LAS f32x4*)(rec + 4 * p), w4 = *(const LAS f32x4*)(rec + 64 + 4 * p), k4 = *(const LAS f32x4*)(rec + 128 + 4 * p),
                        n4 = *(const LAS f32x4*)(rec + 192 + 4 * p), b4 = *(const LAS f32x4*)(rec + 256 + 4 * p);
            const float vv = rec[320 + rowl];
            float sa = (S0 * n4.x + S1 * n4.y) + (S2 * n4.z + S3 * n4.w); sa = -red16(sa);
            S0 = S0 * w4.x + sa * b4.x + vv * k4.x; S1 = S1 * w4.y + sa * b4.y + vv * k4.y; S2 = S2 * w4.z + sa * b4.z + vv * k4.z; S3 = S3 * w4.w + sa * b4.w + vv * k4.w;
            float y = (S0 * r4.x + S1 * r4.y) + (S2 * r4.z + S3 * r4.w); y = red16(y);
            if (p == 0) yout[(rowbase + ch * SC_TC + tt) * RW + h * HD + hf * 32 + rowl] = (bf16)f2bf(y);
        }
        if (more) SC_LSTORE(cur ^ 1);
        __syncthreads();
    }
#undef SC_GLOAD
#undef SC_LSTORE
}
__device__ __forceinline__ void load_row64(float (&q)[64], const bf16* p) {
#pragma unroll
    for (int i = 0; i < 8; ++i) { const v4u w = ((const GAS v4u*)p)[i];
        q[8 * i + 0] = bflo(w.x); q[8 * i + 1] = bfhi(w.x); q[8 * i + 2] = bflo(w.y); q[8 * i + 3] = bfhi(w.y); q[8 * i + 4] = bflo(w.z); q[8 * i + 5] = bfhi(w.z); q[8 * i + 6] = bflo(w.w); q[8 * i + 7] = bfhi(w.w); }
}
__device__ __forceinline__ void moba_simple(Frame& F, int wg, int nwg) {
    const bf16* Z = (const bf16*)(F.ws + WS_Z); const float* KM = (const float*)(F.ws + WS_KMEAN); bf16* Y = (bf16*)(F.ws + WS_Y);
    LAS float* red = (LAS float*)(F.lds + RING_OFF) + F.wave * (64 * 33);
    const int lane = F.lane;
    for (int qi = wg * NWAVES + F.wave; qi < BATCH * NH * T; qi += nwg * NWAVES) {
        const int bh = qi / T, t = qi % T, b = bh / NH, h = bh % NH, own = t >> 8;
        const size_t rowbase = (size_t)b * T;
        float q[64]; load_row64(q, Z + (rowbase + t) * NIN + ZQ + h * HD);
        float gate = -INFINITY;
        if (lane < own) { const float* km = KM + ((size_t)bh * NBLK + lane) * HD; float g = 0.f;
#pragma unroll
            for (int d = 0; d < 64; ++d) g += q[d] * km[d];
            gate = g; }
        int sel[3];
#pragma unroll
        for (int n = 0; n < 3; ++n) { const float mx = wave_max(gate); const unsigned long long bal = __ballot(gate == mx && mx > -INFINITY);
            int idx = -1; if (bal != 0ull) { idx = __ffsll((long long)bal) - 1; if (lane == idx) gate = -INFINITY; } sel[n] = idx; }
        float sc[16]; float mx = -INFINITY;
#pragma unroll
        for (int bi = 0; bi < 4; ++bi) { const int blk = bi < 3 ? sel[bi] : own;
#pragma unroll
            for (int i = 0; i < 4; ++i) { const int key = blk * 256 + i * 64 + lane; float s = -INFINITY;
                if (blk >= 0 && (bi < 3 || key <= t)) { const GAS v4u* kp = (const GAS v4u*)(Z + (rowbase + key) * NIN + ZK + h * HD); float a = 0.f;
#pragma unroll
                    for (int j = 0; j < 8; ++j) { const v4u w = kp[j];
                        a += q[8 * j + 0] * bflo(w.x) + q[8 * j + 1] * bfhi(w.x) + q[8 * j + 2] * bflo(w.y) + q[8 * j + 3] * bfhi(w.y) + q[8 * j + 4] * bflo(w.z) + q[8 * j + 5] * bfhi(w.z) + q[8 * j + 6] * bflo(w.w) + q[8 * j + 7] * bfhi(w.w); }
                    s = a * 0.125f; }
                sc[bi * 4 + i] = s; mx = fmaxf(mx, s); } }
        mx = wave_max(mx);
        float o[64]; float l = 0.f;
#pragma unroll
        for (int d = 0; d < 64; ++d) o[d] = 0.f;
#pragma unroll
        for (int bi = 0; bi < 4; ++bi) { const int blk = bi < 3 ? sel[bi] : own;
#pragma unroll
            for (int i = 0; i < 4; ++i) { const int key = blk * 256 + i * 64 + lane; const float pr = __expf(sc[bi * 4 + i] - mx);
                if (pr > 0.f) { const GAS v4u* vp = (const GAS v4u*)(Z + (rowbase + key) * NIN + ZV + h * HD); l += pr;
#pragma unroll
                    for (int j = 0; j < 8; ++j) { const v4u w = vp[j];
                        o[8 * j + 0] += pr * bflo(w.x); o[8 * j + 1] += pr * bfhi(w.x); o[8 * j + 2] += pr * bflo(w.y); o[8 * j + 3] += pr * bfhi(w.y); o[8 * j + 4] += pr * bflo(w.z); o[8 * j + 5] += pr * bfhi(w.z); o[8 * j + 6] += pr * bflo(w.w); o[8 * j + 7] += pr * bfhi(w.w); } } } }
        l = wave_sum(l);
        float res = 0.f;
#pragma unroll
        for (int hp = 0; hp < 2; ++hp) {
#pragma unroll
            for (int d = 0; d < 32; ++d) red[lane * 33 + d] = o[hp * 32 + d];
            LDS_WAIT(); asm volatile("" ::: "memory");
            float part = 0.f; const int dc = lane & 31, r0 = (lane >> 5) * 32;
#pragma unroll 8
            for (int r = 0; r < 32; ++r) part += red[(r0 + r) * 33 + dc];
            part += __shfl_xor(part, 32);
            if ((lane >> 5) == hp) res = part;
            LDS_WAIT(); asm volatile("" ::: "memory");
        }
        Y[(rowbase + t) * D + RW + h * HD + lane] = (bf16)f2bf(res / l);
    }
}
__device__ __forceinline__ void rwkv_post_simple(Frame& F) {
    const bf16* yr = (const bf16*)(F.ws + WS_YRAW); const bf16* aV = (const bf16*)(F.ws + WS_PV); const bf16* aG = (const bf16*)(F.ws + WS_GATE); const float* bon = (const float*)(F.ws + WS_BON);
    bf16* Y = (bf16*)(F.ws + WS_Y); const float* lnw = F.in[13]; const float* lnb = F.in[14];
    const int gw = F.vcu * NWAVES + F.wave, NGW = F.G * NWAVES;
    for (int u = gw; u < M * NH; u += NGW) { const int m = u >> 3, h = u & 7, c = h * HD + F.lane; const size_t o = (size_t)m * RW + c;
        const float y = bf2f(yr[o]); const float mean = wave_sum(y) * (1.f / 64.f); const float dlt = y - mean; const float var = wave_sum(dlt * dlt) * (1.f / 64.f);
        const float yn = dlt * (1.f / sqrtf(var + GN_EPS)) * lnw[c] + lnb[c];
        const float outv = (yn + bon[u] * bf2f(aV[o])) * bf2f(aG[o]);
        Y[(size_t)m * D + c] = (bf16)f2bf(outv); }
}
__device__ __forceinline__ void final_norm(Frame& F) {
    float* out = (float*)F.dout; const float* ss = (const float*)(F.ws + WS_SS) + (size_t)2 * M * 16; const float* g = F.in[24];
    const int gw = F.vcu * NWAVES + F.wave, NGW = F.G * NWAVES;
    for (int m = gw; m < M; m += NGW) { const float rstd = pg8::row_rstd(ss, (size_t)m);
        GAS f32x4* o = (GAS f32x4*)(out + (size_t)m * D) + F.lane; const GAS f32x4* gr = (const GAS f32x4*)g + F.lane;
#pragma unroll
        for (int j = 0; j < 4; ++j) { f32x4 v = o[64 * j]; const f32x4 gg = gr[64 * j]; v = v * rstd * gg; o[64 * j] = v; } }
}
namespace attn_body {
typedef unsigned short bf16;
using bf16x8=__attribute__((ext_vector_type(8)))short;
using s16x4=__attribute__((ext_vector_type(4)))short;
using f32x16=__attribute__((ext_vector_type(16)))float;
using u32x4=__attribute__((ext_vector_type(4)))unsigned;
constexpr int SEQ=8192,D=64,QP=3328,OP=1024;
constexpr int NW=8,QBLK=32,QB=QBLK*NW,KVBLK=64,NQB=SEQ/QB;
__device__ __forceinline__ int crow(int r,int hi){return (r&3)+8*(r>>2)+4*hi;}
#define SBAR() __builtin_amdgcn_sched_barrier(0)
__device__ __forceinline__ void cmask(f32x16&p0,f32x16&p1,int jb,int qrel,int hi){
  const float NEG=-INFINITY; int kb=64*jb+4*hi;
  #pragma unroll
  for(int r=0;r<16;++r){int kv=kb+(r&3)+8*(r>>2); if(kv>qrel)p0[r]=NEG; if(kv+32>qrel)p1[r]=NEG;}
}

constexpr int NSLOT=3, SLOTB=8192;
constexpr int LDS_K=0, LDS_V=NSLOT*SLOTB, LDS_WS=2*NSLOT*SLOTB, LDS_OST=LDS_WS+NW*64*4, LDS_BYTES=LDS_OST+NW*4096;
constexpr float C2=0.125f*1.4426950408889634f;
__device__ __forceinline__ void glds16(const void*gsrc,unsigned lds_dst){unsigned keep;
  asm volatile("s_mov_b32 %0, m0\n\ts_mov_b32 m0, %2\n\ts_nop 0\n\tglobal_load_lds_dwordx4 %1, off\n\ts_mov_b32 m0, %0":"=&s"(keep):"v"(gsrc),"s"(lds_dst):"memory");}
__device__ __forceinline__ float max3f(float a,float b,float c){float r;asm("v_max3_f32 %0, %1, %2, %3":"=v"(r):"v"(a),"v"(b),"v"(c));return r;}
__device__ __forceinline__ float max2f(float a,float b){float r;asm("v_max_f32_e32 %0, %1, %2":"=v"(r):"v"(a),"v"(b));return r;}
__device__ __forceinline__ float fadd_s(float a,float b){float r;asm("v_add_f32_e32 %0, %1, %2":"=v"(r):"v"(a),"v"(b));return r;}
__device__ __forceinline__ float fsub_s(float a,float b){float r;asm("v_sub_f32_e32 %0, %1, %2":"=v"(r):"v"(a),"v"(b));return r;}
typedef float f32x2_t __attribute__((ext_vector_type(2))); typedef __bf16 bf16x2_t __attribute__((ext_vector_type(2)));
__device__ __forceinline__ unsigned cvtpk_s(float lo,float hi){f32x2_t v={lo,hi};bf16x2_t b=__builtin_convertvector(v,bf16x2_t);return __builtin_bit_cast(unsigned,b);}
#define WAIT_BAR(N) asm volatile("s_waitcnt vmcnt(" #N ") lgkmcnt(0)\n\ts_barrier":::"memory")

__device__ __forceinline__ void qkt(f32x16&p0,f32x16&p1,const char*Kslot,const bf16x8*qr,const f32x16&negm,int r32,int hi){
  const char*kb=Kslot+hi*1024+r32*16;
  #pragma unroll
  for(int d0=0;d0<4;++d0){
    const bf16x8 b0=*reinterpret_cast<const bf16x8*>(kb+d0*2048);
    const bf16x8 b1=*reinterpret_cast<const bf16x8*>(kb+d0*2048+512);
    if(d0==0){p0=__builtin_amdgcn_mfma_f32_32x32x16_bf16(b0,qr[0],negm,0,0,0);p1=__builtin_amdgcn_mfma_f32_32x32x16_bf16(b1,qr[0],negm,0,0,0);}
    else{p0=__builtin_amdgcn_mfma_f32_32x32x16_bf16(b0,qr[d0],p0,0,0,0);p1=__builtin_amdgcn_mfma_f32_32x32x16_bf16(b1,qr[d0],p1,0,0,0);}}
}
typedef __attribute__((address_space(3))) const char* lds_cptr;
typedef short v4i16_t __attribute__((ext_vector_type(4)));
__device__ __forceinline__ void kload8(bf16x8*kf,lds_cptr kp){
  kf[0]=*(const __attribute__((address_space(3))) bf16x8*)(kp);      kf[1]=*(const __attribute__((address_space(3))) bf16x8*)(kp+512);
  kf[2]=*(const __attribute__((address_space(3))) bf16x8*)(kp+2048); kf[3]=*(const __attribute__((address_space(3))) bf16x8*)(kp+2560);
  kf[4]=*(const __attribute__((address_space(3))) bf16x8*)(kp+4096); kf[5]=*(const __attribute__((address_space(3))) bf16x8*)(kp+4608);
  kf[6]=*(const __attribute__((address_space(3))) bf16x8*)(kp+6144); kf[7]=*(const __attribute__((address_space(3))) bf16x8*)(kp+6656);
}
__device__ __forceinline__ void kload2(bf16x8*kf,lds_cptr kp,int j){ kf[2*j]=*(const __attribute__((address_space(3))) bf16x8*)(kp+j*2048); kf[2*j+1]=*(const __attribute__((address_space(3))) bf16x8*)(kp+j*2048+512); }
__device__ __forceinline__ s16x4 vtr(lds_cptr p){ return __builtin_bit_cast(s16x4,__builtin_amdgcn_ds_read_tr16_b64_v4i16((__attribute__((address_space(3))) v4i16_t*)p)); }
__device__ __forceinline__ float rowmax(const f32x16&p0,const f32x16&p1){
  float a=max3f(p0[0],p0[1],p1[0]),b=max3f(p0[2],p0[3],p1[1]);a=max3f(a,p1[2],p1[3]);
  #pragma unroll
  for(int r=4;r<16;r+=4){a=max3f(a,p0[r],p0[r+1]);b=max3f(b,p0[r+2],p0[r+3]);a=max3f(a,p1[r],p1[r+1]);b=max3f(b,p1[r+2],p1[r+3]);}
  const float m=max2f(a,b);
  auto rr=__builtin_amdgcn_permlane32_swap(__float_as_uint(m),__float_as_uint(m),false,false);
  return max2f(__uint_as_float(rr[0]),__uint_as_float(rr[1]));
}
__device__ __forceinline__ void pv(f32x16*o,int vb,bf16x8 pa0,bf16x8 pa1,bf16x8 pa2,bf16x8 pa3){
  #pragma unroll
  for(int d0=0;d0<2;++d0){s16x4 lo[4],hi[4];
    #pragma unroll
    for(int ks=0;ks<4;++ks){
      asm volatile("ds_read_b64_tr_b16 %0,%1 offset:%c2":"=&v"(lo[ks]):"v"(vb),"i"(d0*4096+ks*1024):"memory");
      asm volatile("ds_read_b64_tr_b16 %0,%1 offset:%c2":"=&v"(hi[ks]):"v"(vb),"i"(d0*4096+ks*1024+512):"memory");}
    asm volatile("s_waitcnt lgkmcnt(0)":::"memory");SBAR();
    #define PK(k) (bf16x8){lo[k][0],lo[k][1],lo[k][2],lo[k][3],hi[k][0],hi[k][1],hi[k][2],hi[k][3]}
    o[d0]=__builtin_amdgcn_mfma_f32_32x32x16_bf16(pa0,PK(0),o[d0],0,0,0);
    o[d0]=__builtin_amdgcn_mfma_f32_32x32x16_bf16(pa1,PK(1),o[d0],0,0,0);
    o[d0]=__builtin_amdgcn_mfma_f32_32x32x16_bf16(pa2,PK(2),o[d0],0,0,0);
    o[d0]=__builtin_amdgcn_mfma_f32_32x32x16_bf16(pa3,PK(3),o[d0],0,0,0);
    #undef PK
  }
}

#ifndef ATTN_STORE16
#define ATTN_STORE16(p,v) (*(u32x4*)(p)=(v))
#endif
template<int THRL> __device__ __forceinline__ void attn_unit(int b,int h,int qb,const bf16*Q,const bf16*__restrict__ K,const bf16*__restrict__ V,bf16*O,const float*__restrict__ KMbh,char*shm,const int wid,const int lane){
  const int r32=lane&31,hi=lane>>5;
  const long rowbase=(long)b*SEQ; const int q0=qb*QB;
  const bf16*Qw=Q+(rowbase+q0+wid*QBLK)*QP+h*D;
  const bf16*Kh=K+rowbase*QP+h*D,*Vh=V+rowbase*QP+h*D;
  unsigned selmask=0u;
  { f32x16 g=f32x16{}; bf16x8 qg[4];
    #pragma unroll
    for(int d0=0;d0<4;++d0)qg[d0]=*reinterpret_cast<const bf16x8*>(&Qw[(long)r32*QP+d0*16+hi*8]);
    #pragma unroll
    for(int d0=0;d0<4;++d0){ const float4 a0=*reinterpret_cast<const float4*>(KMbh+r32*64+d0*16+hi*8), a1=*reinterpret_cast<const float4*>(KMbh+r32*64+d0*16+hi*8+4);
      u32x4 pk; pk[0]=cvtpk_s(a0.x,a0.y); pk[1]=cvtpk_s(a0.z,a0.w); pk[2]=cvtpk_s(a1.x,a1.y); pk[3]=cvtpk_s(a1.z,a1.w);
      g=__builtin_amdgcn_mfma_f32_32x32x16_bf16(__builtin_bit_cast(bf16x8,pk),qg[d0],g,0,0,0); }
    #pragma unroll
    for(int r=0;r<16;++r){ if(crow(r,hi)>=qb) g[r]=-INFINITY; }
    #pragma unroll
    for(int n=0;n<3;++n){ float bv=-INFINITY; int bi=64;
      #pragma unroll
      for(int r=0;r<16;++r){ if(g[r]>bv){bv=g[r];bi=crow(r,hi);} }
      const float pv_=__shfl_xor(bv,32); const int pi_=__shfl_xor(bi,32);
      const bool mine=(bv>pv_)||(bv==pv_&&bi<pi_); const float wv=mine?bv:pv_; const int wi=mine?bi:pi_;
      if(wv>-INFINITY){ selmask|=1u<<wi;
        #pragma unroll
        for(int r=0;r<16;++r){ if(crow(r,hi)==wi) g[r]=-INFINITY; } } }
    selmask|=1u<<qb; }
  asm volatile("":"+v"(selmask)); SBAR();
  const unsigned lds0=(unsigned)(uintptr_t)shm;
  float*wsf=(float*)(shm+LDS_WS)+wid*64;
  const bf16*ksrc=Kh+(long)lane*QP+wid*8;
  const bf16*vsrc=Vh+(long)(16*(wid&3)+(lane>>2))*QP+(wid>>2)*32+(lane&3)*8;
  const unsigned kdst=lds0+LDS_K+wid*1024, vdst=lds0+LDS_V+wid*1024;
  #define DMA_K(t,slot) glds16(ksrc+(long)(t)*KVBLK*QP,(unsigned)__builtin_amdgcn_readfirstlane(kdst+(slot)))
  #define DMA_V(t,slot) glds16(vsrc+(long)(t)*KVBLK*QP,(unsigned)__builtin_amdgcn_readfirstlane(vdst+(slot)))
  const int vb0=(int)(lds0+LDS_V)+((lane>>4)&1)*32+(lane&3)*8+(4*hi+((lane&15)>>2))*64;
  const char*Kbase=shm+LDS_K; bf16x8 kf[8];
  const lds_cptr shm3=(lds_cptr)shm; const lds_cptr kp0=shm3+LDS_K+hi*1024+r32*16; const lds_cptr vp0=shm3+LDS_V+((lane>>4)&1)*32+(lane&3)*8+(4*hi+((lane&15)>>2))*64;
  const int NT=(q0+QB)/KVBLK;
  DMA_K(0,0);DMA_V(0,0);DMA_K(1,SLOTB);
  bf16x8 qr[4];
  #pragma unroll
  for(int d0=0;d0<4;++d0)qr[d0]=*reinterpret_cast<const bf16x8*>(&Qw[(long)r32*QP+d0*16+hi*8]);
  float nok=((selmask&1u)!=0u||qb==0)?0.f:-INFINITY;
  float mhat=0.f,l_reg=0.f;f32x16 o[2];o[0]=f32x16{};o[1]=f32x16{};f32x16 negm;
  _Pragma("unroll") for(int r=0;r<16;++r)negm[r]=nok; asm volatile("":"+v"(negm));
  const int qrel=wid*QBLK+r32;
  #define CMASK(P0,P1,t) do{int jb_=(t)-(NT-4); if(jb_>=0)cmask(P0,P1,jb_,qrel,hi);}while(0)
  bool resc=false;
  #define START(P0,P1) do{ const float rm=rowmax(P0,P1); resc=false; \
    { const float dl=(rm==-INFINITY)?0.f:rm; mhat=fadd_s(mhat,dl); \
      _Pragma("unroll") for(int r=0;r<16;++r){P0[r]=fsub_s(P0[r],dl);P1[r]=fsub_s(P1[r],dl);} \
      { const float cv_=nok-mhat; _Pragma("unroll") for(int r=0;r<16;++r)negm[r]=cv_; } asm volatile("":"+v"(negm)); } \
    _Pragma("unroll") for(int r=0;r<16;++r)P0[r]=__builtin_amdgcn_exp2f(P0[r]); }while(0)
  #define RESC() do{ if(resc){ asm volatile("s_waitcnt lgkmcnt(0)":::"memory"); \
      _Pragma("unroll") for(int d_=0;d_<2;++d_) _Pragma("unroll") for(int r=0;r<16;++r)o[d_][r]*=wsf[crow(r,hi)]; } }while(0)
  f32x16 pA0,pA1,pB0,pB1;
  int sl_prev=0,sl_cur=0,sl_next=SLOTB;
  #define ROT() do{sl_prev=sl_cur;sl_cur=sl_next;sl_next=(sl_next==(NSLOT-1)*SLOTB)?0:sl_next+SLOTB;}while(0)
  DMA_K(2,2*SLOTB);
  WAIT_BAR(3);
  qkt(pA0,pA1,Kbase,qr,negm,r32,hi);asm volatile("s_nop 15\n\ts_nop 7":"+v"(pA0),"+v"(pA1));CMASK(pA0,pA1,0);
  START(pA0,pA1);
  _Pragma("unroll") for(int r=0;r<16;++r)pA1[r]=__builtin_amdgcn_exp2f(pA1[r]);
  WAIT_BAR(0);
  DMA_K(3,0);DMA_V(1,SLOTB);
  ROT();
  kload8(kf,kp0+sl_cur);
  WAIT_BAR(2);
  s16x4 vlo[8],vhi[8]; u32x4 pw0,pw1,pw2,pw3;
  #define PKW(P,B) cvtpk_s(P[B],P[B+1])
  #define PAF(k) __builtin_bit_cast(bf16x8,pw##k)
  #define VFR(i) (bf16x8){vlo[i][0],vlo[i][1],vlo[i][2],vlo[i][3],vhi[i][0],vhi[i][1],vhi[i][2],vhi[i][3]}
  #define PIN(x) asm volatile("":"+v"(x))
  #define MX3(a,b,c) __builtin_fmaxf(__builtin_fmaxf((a),(b)),(c))
  #define GAPA(MF,A0,A1,A2,A3,W0,W1,PW) do{ MF; sacc+=A0; sacc+=A1; sacc+=A2; sacc+=A3; PIN(sacc); W0; W1; PIN(PW); SBAR(); }while(0)
  #define EX(v) __builtin_amdgcn_exp2f(v)
  #define GAPB(MF,X,B) do{ MF; X[B]=EX(X[B]); X[B+1]=EX(X[B+1]); X[B+2]=EX(X[B+2]); X[B+3]=EX(X[B+3]); PIN(X); SBAR(); }while(0)
  #define VRD(i) do{ vlo[i]=vtr(vp_+(((i)>>2)*4096+((i)&3)*1024)); vhi[i]=vtr(vp_+(((i)>>2)*4096+((i)&3)*1024+512)); }while(0)
  #define KRD(G,j) do{ if(G){ kload2(kf,kp0+sl_next,j); SBAR(); } }while(0)
  #define STEP(C0,C1,P0,P1,t,GK,GV,GL) do{ SBAR(); \
    const lds_cptr vp_=vp0+sl_prev; \
    VRD(0); SBAR(); float sacc=(P0[0]+P0[1]); \
    GAPA(C0=__builtin_amdgcn_mfma_f32_32x32x16_bf16(kf[0],qr[0],negm,0,0,0), P0[2],P0[3],P0[4],P0[5],     pw0[0]=PKW(P0,0), pw0[1]=PKW(P0,2), pw0); \
    VRD(4); SBAR(); GAPA(C1=__builtin_amdgcn_mfma_f32_32x32x16_bf16(kf[1],qr[0],negm,0,0,0), P0[6],P0[7],P0[8],P0[9],     pw0[2]=PKW(P0,4), pw0[3]=PKW(P0,6), pw0); \
    VRD(1); SBAR(); GAPA(C0=__builtin_amdgcn_mfma_f32_32x32x16_bf16(kf[2],qr[1],C0,0,0,0),   P0[10],P0[11],P0[12],P0[13], pw1[0]=PKW(P0,8), pw1[1]=PKW(P0,10), pw1); \
    VRD(5); SBAR(); GAPA(C1=__builtin_amdgcn_mfma_f32_32x32x16_bf16(kf[3],qr[1],C1,0,0,0),   P0[14],P0[15],P1[0],P1[1],   pw1[2]=PKW(P0,12),pw1[3]=PKW(P0,14), pw1); \
    VRD(2); SBAR(); GAPA(C0=__builtin_amdgcn_mfma_f32_32x32x16_bf16(kf[4],qr[2],C0,0,0,0),   P1[2],P1[3],P1[4],P1[5],     pw2[0]=PKW(P1,0), pw2[1]=PKW(P1,2), pw2); \
    VRD(6); SBAR(); GAPA(C1=__builtin_amdgcn_mfma_f32_32x32x16_bf16(kf[5],qr[2],C1,0,0,0),   P1[6],P1[7],P1[8],P1[9],     pw2[2]=PKW(P1,4), pw2[3]=PKW(P1,6), pw2); \
    VRD(3); SBAR(); GAPA(C0=__builtin_amdgcn_mfma_f32_32x32x16_bf16(kf[6],qr[3],C0,0,0,0),   P1[10],P1[11],P1[12],P1[13], pw3[0]=PKW(P1,8), pw3[1]=PKW(P1,10), pw3); \
    VRD(7); SBAR(); GAPA(C1=__builtin_amdgcn_mfma_f32_32x32x16_bf16(kf[7],qr[3],C1,0,0,0),   P1[14],P1[15],0.f,0.f,       pw3[2]=PKW(P1,12),pw3[3]=PKW(P1,14), pw3); \
    l_reg+=sacc; \
    if(GK){DMA_K((t)+3,sl_cur);} if(GV){DMA_V((t)+1,sl_next);} \
    CMASK(C0,C1,t); \
    { float a=MX3(C0[0],C0[1],C1[0]),b=MX3(C0[2],C0[3],C1[1]); a=MX3(a,C1[2],C1[3]); \
      _Pragma("unroll") for(int r=4;r<16;r+=4){a=MX3(a,C0[r],C0[r+1]);b=MX3(b,C0[r+2],C0[r+3]);a=MX3(a,C1[r],C1[r+1]);b=MX3(b,C1[r+2],C1[r+3]);} \
      float rm=__builtin_fmaxf(a,b); { auto rr=__builtin_amdgcn_permlane32_swap(__float_as_uint(rm),__float_as_uint(rm),false,false); rm=__builtin_fmaxf(__uint_as_float(rr[0]),__uint_as_float(rr[1])); } \
      resc=false; \
      if(__builtin_expect(__any(rm>(float)THRL),0)){ const float dl=__builtin_fmaxf(rm,0.f); mhat+=dl; \
        _Pragma("unroll") for(int r=0;r<16;++r){C0[r]-=dl;C1[r]-=dl;} \
        { const float cv_=nok-mhat; _Pragma("unroll") for(int r=0;r<16;++r)negm[r]=cv_; } asm volatile("":"+v"(negm)); \
        const float f=__builtin_amdgcn_exp2f(-dl); l_reg*=f; if(hi==0)wsf[r32]=f; resc=true; } } \
    SBAR(); \
    GAPB(o[0]=__builtin_amdgcn_mfma_f32_32x32x16_bf16(PAF(0),VFR(0),o[0],0,0,0), C0,0); \
    GAPB(o[1]=__builtin_amdgcn_mfma_f32_32x32x16_bf16(PAF(0),VFR(4),o[1],0,0,0), C0,4); \
    KRD(GL,0); GAPB(o[0]=__builtin_amdgcn_mfma_f32_32x32x16_bf16(PAF(1),VFR(1),o[0],0,0,0), C0,8); \
    KRD(GL,1); GAPB(o[1]=__builtin_amdgcn_mfma_f32_32x32x16_bf16(PAF(1),VFR(5),o[1],0,0,0), C0,12); \
    KRD(GL,2); GAPB(o[0]=__builtin_amdgcn_mfma_f32_32x32x16_bf16(PAF(2),VFR(2),o[0],0,0,0), C1,0); \
    KRD(GL,3); GAPB(o[1]=__builtin_amdgcn_mfma_f32_32x32x16_bf16(PAF(2),VFR(6),o[1],0,0,0), C1,4); \
    GAPB(o[0]=__builtin_amdgcn_mfma_f32_32x32x16_bf16(PAF(3),VFR(3),o[0],0,0,0), C1,8); \
    GAPB(o[1]=__builtin_amdgcn_mfma_f32_32x32x16_bf16(PAF(3),VFR(7),o[1],0,0,0), C1,12); \
    }while(0)
  #define MASKUPD(tt) do{ if((((tt))&3)==0){ nok=((selmask>>((tt)>>2))&1u)?0.f:-INFINITY; const float cv_=nok-mhat; _Pragma("unroll") for(int r=0;r<16;++r)negm[r]=cv_; asm volatile("":"+v"(negm)); } }while(0)
  int t=1;
  #undef CMASK
  #define CMASK(P0,P1,t) do{}while(0)
  for(;t+5<NT;t+=2){
    STEP(pB0,pB1,pA0,pA1,t,true,true,true);     WAIT_BAR(2); RESC(); ROT(); MASKUPD(t+1);
    STEP(pA0,pA1,pB0,pB1,t+1,true,true,true);   WAIT_BAR(2); RESC(); ROT();
  }
  #undef CMASK
  #define CMASK(P0,P1,t) do{int jb_=(t)-(NT-4); if(jb_>=0)cmask(P0,P1,jb_,qrel,hi);}while(0)
  #define ENDW(tt) do{ if((tt)+3<NT){WAIT_BAR(2);} else if((tt)+2<NT){WAIT_BAR(1);} else {WAIT_BAR(0);} }while(0)
  for(;t+1<NT;t+=2){
    STEP(pB0,pB1,pA0,pA1,t,(t+3<NT),(t+1<NT),(t+1<NT));       ENDW(t);   RESC(); ROT(); MASKUPD(t+1);
    STEP(pA0,pA1,pB0,pB1,t+1,(t+4<NT),(t+2<NT),(t+2<NT));     ENDW(t+1); RESC(); ROT();
  }
  STEP(pB0,pB1,pA0,pA1,NT-1,false,false,false); RESC();
  { float sacc=pB0[0]+pB0[1]; _Pragma("unroll") for(int r=2;r<16;++r)sacc+=pB0[r]; _Pragma("unroll") for(int r=0;r<16;++r)sacc+=pB1[r]; l_reg+=sacc;
    pw0=(u32x4){PKW(pB0,0),PKW(pB0,2),PKW(pB0,4),PKW(pB0,6)};pw1=(u32x4){PKW(pB0,8),PKW(pB0,10),PKW(pB0,12),PKW(pB0,14)};pw2=(u32x4){PKW(pB1,0),PKW(pB1,2),PKW(pB1,4),PKW(pB1,6)};pw3=(u32x4){PKW(pB1,8),PKW(pB1,10),PKW(pB1,12),PKW(pB1,14)};
    SBAR(); pv(o,vb0+sl_cur,PAF(0),PAF(1),PAF(2),PAF(3)); }
  #undef PKW
  #undef PAF
  #undef VFR
  #undef PIN
  #undef MX3
  #undef GAPA
  #undef GAPB
  #undef EX
  #undef VRD
  #undef KRD
  #undef STEP
  #undef ENDW
  #undef MASKUPD
  {auto rr=__builtin_amdgcn_permlane32_swap(__float_as_uint(l_reg),__float_as_uint(l_reg),false,false);l_reg=__uint_as_float(rr[0])+__uint_as_float(rr[1]);}
  if(hi==0)wsf[32+r32]=l_reg;asm volatile("s_waitcnt lgkmcnt(0)":::"memory");
  float rli[16];
  #pragma unroll
  for(int r=0;r<16;++r)rli[r]=__builtin_amdgcn_rcpf(wsf[32+crow(r,hi)]);
  bf16*Ow=O+(rowbase+q0+wid*QBLK)*OP+h*D;
  { bf16*stg=(bf16*)(shm+LDS_OST)+wid*2048;
    #pragma unroll
    for(int r=0;r<16;++r){const int orow=crow(r,hi);
      #pragma unroll
      for(int d0=0;d0<2;++d0)stg[orow*64+d0*32+r32]=(bf16)(cvtpk_s(o[d0][r]*rli[r],0.f)&0xffffu);}
    asm volatile("s_waitcnt lgkmcnt(0)":::"memory");
    #pragma unroll
    for(int i=0;i<4;++i){const int row=i*8+(lane>>3),ch=lane&7; const u32x4 v=*(const u32x4*)(stg+row*64+ch*8); ATTN_STORE16(Ow+(long)row*OP+ch*8,v);} }
  asm volatile("s_waitcnt lgkmcnt(0)\n\ts_barrier":::"memory");
  #undef DMA_K
  #undef DMA_V
  #undef CMASK
  #undef START
  #undef RESC
  #undef ROT
}
constexpr int ATTN_LDS_BYTES=LDS_BYTES;
#undef SBAR
#undef WAIT_BAR
}
namespace rscan {
typedef short bf16x8 __attribute__((ext_vector_type(8)));
typedef float f32x4 __attribute__((ext_vector_type(4)));
typedef float f32x16 __attribute__((ext_vector_type(16)));
typedef unsigned u32x2 __attribute__((ext_vector_type(2)));
typedef unsigned u32x4 __attribute__((ext_vector_type(4)));
constexpr int LS = 144;
constexpr int LB = 64 * LS;
constexpr int NCHUNK = T / 64;
__device__ __forceinline__ unsigned pkbf(float lo, float hi) { typedef float f2 __attribute__((ext_vector_type(2))); typedef __bf16 b2 __attribute__((ext_vector_type(2))); f2 v = {lo, hi}; return __builtin_bit_cast(unsigned, __builtin_convertvector(v, b2)); }

__device__ __forceinline__ void mm(f32x4 (&acc)[2], LAS unsigned char* lds, int z1, int z2, int ta, int tbh, int fr, int fq) {
    const LAS unsigned char* p1 = lds + z1 + (16 * ta + fr) * LS + fq * 16;
    const LAS unsigned char* p2 = lds + z2 + (32 * tbh + fr) * LS + fq * 16;
    const bf16x8 a0 = *(const LAS bf16x8*)(p1), a1 = *(const LAS bf16x8*)(p1 + 64);
    const bf16x8 b00 = *(const LAS bf16x8*)(p2), b01 = *(const LAS bf16x8*)(p2 + 64), b10 = *(const LAS bf16x8*)(p2 + 16 * LS), b11 = *(const LAS bf16x8*)(p2 + 16 * LS + 64);
    acc[0] = __builtin_amdgcn_mfma_f32_16x16x32_bf16(a0, b00, acc[0], 0, 0, 0); acc[0] = __builtin_amdgcn_mfma_f32_16x16x32_bf16(a1, b01, acc[0], 0, 0, 0);
    acc[1] = __builtin_amdgcn_mfma_f32_16x16x32_bf16(a0, b10, acc[1], 0, 0, 0); acc[1] = __builtin_amdgcn_mfma_f32_16x16x32_bf16(a1, b11, acc[1], 0, 0, 0);
}
template <int MASK, bool DIAG1> __device__ __forceinline__ void st_lds(const f32x4 (&acc)[2], LAS unsigned char* lds, int dst, int ta, int tbh, int fr, int fq) {
#pragma unroll
    for (int tb = 0; tb < 2; ++tb) { const int b = 32 * tbh + 16 * tb + fr, a0 = 16 * ta + 4 * fq; float v[4];
#pragma unroll
        for (int i = 0; i < 4; ++i) { const int a = a0 + i; float x = acc[tb][i];
            if (MASK == 1) x = (a < b) ? x : 0.f; if (MASK == 2) x = (a <= b) ? x : 0.f; if (MASK == 3) x = (b < a) ? x : 0.f; if (DIAG1) x = (a == b) ? 1.f : x; v[i] = x; }
        u32x2 w; w.x = pkbf(v[0], v[1]); w.y = pkbf(v[2], v[3]); *(LAS u32x2*)(lds + dst + b * LS + a0 * 2) = w; }
}
template <bool PERM> __device__ __forceinline__ void st_glb(const f32x4 (&acc)[2], bf16* g, int ta, int tbh, int fr, int fq) {
#pragma unroll
    for (int tb = 0; tb < 2; ++tb) { const int b = 32 * tbh + 16 * tb + fr; int a0 = 16 * ta + 4 * fq; if (PERM) a0 = (a0 & ~12) | ((a0 & 4) << 1) | ((a0 & 8) >> 1);
        u32x2 w; w.x = pkbf(acc[tb][0], acc[tb][1]); w.y = pkbf(acc[tb][2], acc[tb][3]); *(GAS u32x2*)(g + (size_t)b * RW + a0) = w; }
}

__device__ __forceinline__ void scan_pre(Frame& F) {
    LAS unsigned char* lds = F.lds + RING_OFF;
    const int w = F.wave, lane = F.lane, fr = lane & 15, fq = lane >> 4, ta = w & 3, tbh = w >> 2;
    const bf16* aR = (const bf16*)(F.ws + WS_PR); const bf16* aV = (const bf16*)(F.ws + WS_PV);
    bf16* aLW = (bf16*)(F.dout + DO_W); bf16* aKP = (bf16*)(F.dout + DO_KP); bf16* aKK = (bf16*)(F.dout + DO_KKN); bf16* aB = (bf16*)(F.dout + DO_B);
    enum { bAt = 0, bBt = LB, bKt = 2 * LB, bRt = 3 * LB, bAtT = 4 * LB, bVT = 5 * LB, bBhT = 6 * LB, bKhT = 7 * LB, b8 = 8 * LB, b9 = 9 * LB, b10 = 10 * LB, bAak = 11 * LB, bArb = 12 * LB, bArk = 13 * LB };
    for (int u = F.vcu; u < BATCH * NH * NCHUNK; u += F.G) {
        const int c = u % NCHUNK, bh = u / NCHUNK, b = bh / NH, h = bh % NH;
        const size_t so = ((size_t)b * T + (size_t)c * 64) * RW + h * HD;
        { float ltot = 0.f, lst = 0.f;
          for (int t = 0; t < 64; ++t) { if (t == 8 * w) lst = ltot; ltot += bf2f(aLW[so + (size_t)t * RW + lane]); }
          float L = lst; unsigned short pAtT[8], pVT[8], pBhT[8], pKhT[8];
#pragma unroll
          for (int i = 0; i < 8; ++i) { const int t = 8 * w + i; const size_t o = so + (size_t)t * RW + lane;
              const float lw = bf2f(aLW[o]), r = bf2f(aR[o]), kp = bf2f(aKP[o]), v = bf2f(aV[o]), kkn = bf2f(aKK[o]), bb = bf2f(aB[o]);
              const float Pm = __expf(L); L += lw; const float P = __expf(L), iP = __expf(-L), Ph = __expf(ltot - L);
              const unsigned short at = (unsigned short)f2bf(-kkn * Pm);
              *(LAS unsigned short*)(lds + bAt + t * LS + lane * 2) = at; *(LAS unsigned short*)(lds + bBt + t * LS + lane * 2) = (unsigned short)f2bf(bb * iP);
              *(LAS unsigned short*)(lds + bKt + t * LS + lane * 2) = (unsigned short)f2bf(kp * iP); *(LAS unsigned short*)(lds + bRt + t * LS + lane * 2) = (unsigned short)f2bf(r * P);
              pAtT[i] = at; pVT[i] = (unsigned short)f2bf(v); pBhT[i] = (unsigned short)f2bf(bb * Ph); pKhT[i] = (unsigned short)f2bf(kp * Ph); }
#define RS_W16(buf, p) do { u32x4 q_; q_.x = p[0] | ((unsigned)p[1] << 16); q_.y = p[2] | ((unsigned)p[3] << 16); q_.z = p[4] | ((unsigned)p[5] << 16); q_.w = p[6] | ((unsigned)p[7] << 16); *(LAS u32x4*)(lds + (buf) + lane * LS + 16 * w) = q_; } while (0)
          RS_W16(bAtT, pAtT); RS_W16(bVT, pVT); RS_W16(bBhT, pBhT); RS_W16(bKhT, pKhT);
#undef RS_W16
          asm volatile("" :: "v"(ltot));
          __syncthreads();
          f32x4 acc[2], tacc[2];
#define RS_Z(a) do { a[0] = (f32x4){0.f, 0.f, 0.f, 0.f}; a[1] = (f32x4){0.f, 0.f, 0.f, 0.f}; } while (0)
          RS_Z(acc); mm(acc, lds, bAt, bBt, ta, tbh, fr, fq); st_lds<3, false>(acc, lds, b9, ta, tbh, fr, fq);
          RS_Z(acc); mm(acc, lds, bKt, bAt, ta, tbh, fr, fq); st_lds<1, false>(acc, lds, bAak, ta, tbh, fr, fq);
          RS_Z(acc); mm(acc, lds, bBt, bRt, ta, tbh, fr, fq); st_lds<2, false>(acc, lds, bArb, ta, tbh, fr, fq);
          RS_Z(acc); mm(acc, lds, bKt, bRt, ta, tbh, fr, fq); st_lds<2, false>(acc, lds, bArk, ta, tbh, fr, fq);
          RS_Z(tacc); mm(tacc, lds, bBt, bAt, ta, tbh, fr, fq);
#pragma unroll
          for (int tb = 0; tb < 2; ++tb)
#pragma unroll
              for (int i = 0; i < 4; ++i) { const int bb_ = 32 * tbh + 16 * tb + fr, a = 16 * ta + 4 * fq + i; tacc[tb][i] = (a < bb_) ? tacc[tb][i] : 0.f; }
          st_lds<0, false>(tacc, lds, b8, ta, tbh, fr, fq);
#pragma unroll
          for (int tb = 0; tb < 2; ++tb)
#pragma unroll
              for (int i = 0; i < 4; ++i) { const int bb_ = 32 * tbh + 16 * tb + fr, a = 16 * ta + 4 * fq + i; if (a == bb_) tacc[tb][i] = 1.f; }
          st_lds<0, false>(tacc, lds, b10, ta, tbh, fr, fq);
          __syncthreads();
          RS_Z(acc); mm(acc, lds, b9, b8, ta, tbh, fr, fq); st_lds<0, false>(acc, lds, bAt, ta, tbh, fr, fq);
          RS_Z(acc); mm(acc, lds, b8, b9, ta, tbh, fr, fq); st_lds<0, false>(acc, lds, bBt, ta, tbh, fr, fq);
          __syncthreads();
          mm(tacc, lds, bBt, b10, ta, tbh, fr, fq); st_lds<0, false>(tacc, lds, bKt, ta, tbh, fr, fq);
          RS_Z(acc); mm(acc, lds, bBt, bAt, ta, tbh, fr, fq); st_lds<0, false>(acc, lds, b8, ta, tbh, fr, fq);
          RS_Z(acc); mm(acc, lds, bAt, bBt, ta, tbh, fr, fq); st_lds<0, false>(acc, lds, b9, ta, tbh, fr, fq);
          __syncthreads();
          mm(tacc, lds, b9, bKt, ta, tbh, fr, fq); st_lds<0, false>(tacc, lds, b10, ta, tbh, fr, fq);
          RS_Z(acc); mm(acc, lds, b9, b8, ta, tbh, fr, fq); st_lds<0, false>(acc, lds, bAt, ta, tbh, fr, fq);
          RS_Z(acc); mm(acc, lds, b8, b9, ta, tbh, fr, fq); st_lds<0, false>(acc, lds, bBt, ta, tbh, fr, fq);
          __syncthreads();
          mm(tacc, lds, bBt, b10, ta, tbh, fr, fq); st_lds<0, false>(tacc, lds, bKt, ta, tbh, fr, fq);
          RS_Z(acc); mm(acc, lds, bBt, bAt, ta, tbh, fr, fq); st_lds<0, false>(acc, lds, b8, ta, tbh, fr, fq);
          RS_Z(acc); mm(acc, lds, bAt, bBt, ta, tbh, fr, fq); st_lds<0, false>(acc, lds, b9, ta, tbh, fr, fq);
          __syncthreads();
          mm(tacc, lds, b9, bKt, ta, tbh, fr, fq); st_lds<0, false>(tacc, lds, b10, ta, tbh, fr, fq);
          RS_Z(acc); mm(acc, lds, b8, b9, ta, tbh, fr, fq); st_lds<0, false>(acc, lds, bBt, ta, tbh, fr, fq);
          __syncthreads();
          mm(tacc, lds, bBt, b10, ta, tbh, fr, fq); st_lds<0, false>(tacc, lds, bKt, ta, tbh, fr, fq);
          __syncthreads();
          RS_Z(acc); mm(acc, lds, bKt, bAtT, ta, tbh, fr, fq); st_lds<0, false>(acc, lds, bAt, ta, tbh, fr, fq);
          RS_Z(acc); mm(acc, lds, bAak, bVT, ta, tbh, fr, fq); st_lds<0, false>(acc, lds, b8, ta, tbh, fr, fq);
          __syncthreads();
          RS_Z(acc); mm(acc, lds, bKt, b8, ta, tbh, fr, fq); st_lds<0, false>(acc, lds, b9, ta, tbh, fr, fq);
          __syncthreads();
          RS_Z(acc); mm(acc, lds, bAt, bArb, ta, tbh, fr, fq);
#pragma unroll
          for (int tb = 0; tb < 2; ++tb) { const int bb_ = 32 * tbh + 16 * tb + fr, a0 = 16 * ta + 4 * fq; const u32x2 q_ = *(const LAS u32x2*)(lds + bRt + bb_ * LS + a0 * 2);
              acc[tb][0] += bflo(q_.x); acc[tb][1] += bfhi(q_.x); acc[tb][2] += bflo(q_.y); acc[tb][3] += bfhi(q_.y); }
          st_glb<false>(acc, aLW + so, ta, tbh, fr, fq);
          RS_Z(acc); mm(acc, lds, b9, bArb, ta, tbh, fr, fq); mm(acc, lds, bVT, bArk, ta, tbh, fr, fq); st_glb<false>(acc, aKK + so, ta, tbh, fr, fq);
          RS_Z(acc); mm(acc, lds, bAt, bBhT, ta, tbh, fr, fq);
          { const float pc = __expf(ltot);
#pragma unroll
            for (int tb = 0; tb < 2; ++tb) { const int bb_ = 32 * tbh + 16 * tb + fr; const float pcb = __shfl(pc, bb_);
#pragma unroll
                for (int i = 0; i < 4; ++i) { const int a = 16 * ta + 4 * fq + i; if (a == bb_) acc[tb][i] += pcb; } } }
          st_glb<true>(acc, aKP + so, ta, tbh, fr, fq);
          RS_Z(acc); mm(acc, lds, bBhT, b9, ta, tbh, fr, fq); mm(acc, lds, bKhT, bVT, ta, tbh, fr, fq); st_glb<false>(acc, aB + so, ta, tbh, fr, fq);
#undef RS_Z
          __syncthreads();
        }
    }
}

__device__ __forceinline__ void scan_seq(Frame& F, int bh) {
    const int lane = F.lane, r32 = lane & 31, hi = lane >> 5; const int b = bh / NH, h = bh % NH;
    const bf16* aM = (const bf16*)(F.dout + DO_KP); const bf16* aN = (const bf16*)(F.dout + DO_B); bf16* XS = (bf16*)(F.ws + WS_YRAW);
    f32x16 X[2][2];
#pragma unroll
    for (int i = 0; i < 2; ++i)
#pragma unroll
        for (int j = 0; j < 2; ++j) X[i][j] = f32x16{};
    for (int c = 0; c < NCHUNK; ++c) {
        const size_t so = ((size_t)b * T + (size_t)c * 64) * RW + h * HD;
        bf16* xs = XS + ((size_t)bh * NCHUNK + c) * 4096;
        bf16x8 am[2][2][2];
#pragma unroll
        for (int t1 = 0; t1 < 2; ++t1)
#pragma unroll
            for (int t2 = 0; t2 < 2; ++t2)
#pragma unroll
                for (int s = 0; s < 2; ++s) am[t1][t2][s] = *(const GAS bf16x8*)(aM + so + (size_t)(32 * t1 + r32) * RW + 32 * t2 + 16 * s + 8 * hi);
        u32x2 nn[2][2][4];
#pragma unroll
        for (int tk = 0; tk < 2; ++tk)
#pragma unroll
            for (int tv = 0; tv < 2; ++tv)
#pragma unroll
                for (int g = 0; g < 4; ++g) nn[tk][tv][g] = *(const GAS u32x2*)(aN + so + (size_t)(32 * tv + r32) * RW + 32 * tk + 8 * g + 4 * hi);
        bf16x8 xb[2][2][2];
#pragma unroll
        for (int tk = 0; tk < 2; ++tk)
#pragma unroll
            for (int tv = 0; tv < 2; ++tv) { unsigned pk[8];
#pragma unroll
                for (int q = 0; q < 8; ++q) pk[q] = pkbf(X[tk][tv][2 * q], X[tk][tv][2 * q + 1]);
#pragma unroll
                for (int g = 0; g < 4; ++g) { u32x2 w_; w_.x = pk[2 * g]; w_.y = pk[2 * g + 1]; *(GAS u32x2*)(xs + (size_t)(32 * tv + r32) * 64 + 32 * tk + 8 * g + 4 * hi) = w_; }
                u32x4 f0, f1; f0.x = pk[0]; f0.y = pk[1]; f0.z = pk[2]; f0.w = pk[3]; f1.x = pk[4]; f1.y = pk[5]; f1.z = pk[6]; f1.w = pk[7];
                xb[tk][tv][0] = __builtin_bit_cast(bf16x8, f0); xb[tk][tv][1] = __builtin_bit_cast(bf16x8, f1); }
#pragma unroll
        for (int t1 = 0; t1 < 2; ++t1)
#pragma unroll
            for (int tv = 0; tv < 2; ++tv) { f32x16 a;
#pragma unroll
                for (int g = 0; g < 4; ++g) { const u32x2 q_ = nn[t1][tv][g]; a[4 * g + 0] = bflo(q_.x); a[4 * g + 1] = bfhi(q_.x); a[4 * g + 2] = bflo(q_.y); a[4 * g + 3] = bfhi(q_.y); }
#pragma unroll
                for (int t2 = 0; t2 < 2; ++t2)
#pragma unroll
                    for (int s = 0; s < 2; ++s) a = __builtin_amdgcn_mfma_f32_32x32x16_bf16(am[t1][t2][s], xb[t2][tv][s], a, 0, 0, 0);
                X[t1][tv] = a; }
    }
}

__device__ __forceinline__ void scan_post(Frame& F) {
    const int lane = F.lane, fr = lane & 15, fq = lane >> 4, tb = F.wave & 3;
    const bf16* aRh = (const bf16*)(F.dout + DO_W); const bf16* aYl = (const bf16*)(F.dout + DO_KKN); const bf16* XS = (const bf16*)(F.ws + WS_YRAW);
    const bf16* aV = (const bf16*)(F.ws + WS_PV); const bf16* aG = (const bf16*)(F.ws + WS_GATE); const float* bon = (const float*)(F.ws + WS_BON);
    bf16* Y = (bf16*)(F.ws + WS_Y); const float* lnw = F.in[13]; const float* lnb = F.in[14];
    for (int u = F.vcu * 2 + (F.wave >> 2); u < BATCH * NH * NCHUNK; u += F.G * 2) {
        const int c = u % NCHUNK, bh = u / NCHUNK, b = bh / NH, h = bh % NH;
        const size_t m0 = (size_t)b * T + (size_t)c * 64, so = m0 * RW + h * HD;
        const bf16* xs = XS + (size_t)u * 4096;
        const size_t trow = m0 + 16 * tb + fr;
        bf16x8 bf_[2];
#pragma unroll
        for (int s = 0; s < 2; ++s) bf_[s] = *(const GAS bf16x8*)(aRh + trow * RW + h * HD + 32 * s + 8 * fq);
        f32x4 acc[4];
#pragma unroll
        for (int ta = 0; ta < 4; ++ta) { const u32x2 q_ = *(const GAS u32x2*)(aYl + trow * RW + h * HD + 16 * ta + 4 * fq);
            acc[ta] = (f32x4){bflo(q_.x), bfhi(q_.x), bflo(q_.y), bfhi(q_.y)};
#pragma unroll
            for (int s = 0; s < 2; ++s) { const bf16x8 af = *(const GAS bf16x8*)(xs + (size_t)(16 * ta + fr) * 64 + 32 * s + 8 * fq); acc[ta] = __builtin_amdgcn_mfma_f32_16x16x32_bf16(af, bf_[s], acc[ta], 0, 0, 0); } }
        float s1 = 0.f;
#pragma unroll
        for (int ta = 0; ta < 4; ++ta) s1 += (acc[ta][0] + acc[ta][1]) + (acc[ta][2] + acc[ta][3]);
        s1 += __shfl_xor(s1, 16); s1 += __shfl_xor(s1, 32); const float mean = s1 * (1.f / 64.f); float s2 = 0.f;
#pragma unroll
        for (int ta = 0; ta < 4; ++ta)
#pragma unroll
            for (int i = 0; i < 4; ++i) { const float d_ = acc[ta][i] - mean; acc[ta][i] = d_; s2 += d_ * d_; }
        s2 += __shfl_xor(s2, 16); s2 += __shfl_xor(s2, 32); const float rstd = 1.f / sqrtf(s2 * (1.f / 64.f) + GN_EPS);
        const float bn = bon[trow * NH + h];
#pragma unroll
        for (int ta = 0; ta < 4; ++ta) { const int ch = h * HD + 16 * ta + 4 * fq; const f32x4 lw4 = *(const GAS f32x4*)(lnw + ch), lb4 = *(const GAS f32x4*)(lnb + ch);
            const u32x2 vq = *(const GAS u32x2*)(aV + trow * RW + ch), gq = *(const GAS u32x2*)(aG + trow * RW + ch);
            const float o0 = (acc[ta][0] * rstd * lw4[0] + lb4[0] + bn * bflo(vq.x)) * bflo(gq.x), o1 = (acc[ta][1] * rstd * lw4[1] + lb4[1] + bn * bfhi(vq.x)) * bfhi(gq.x);
            const float o2 = (acc[ta][2] * rstd * lw4[2] + lb4[2] + bn * bflo(vq.y)) * bflo(gq.y), o3 = (acc[ta][3] * rstd * lw4[3] + lb4[3] + bn * bfhi(vq.y)) * bfhi(gq.y);
            u32x2 w_; w_.x = pkbf(o0, o1); w_.y = pkbf(o2, o3); *(GAS u32x2*)(Y + trow * D + ch) = w_; }
    }
}
}
using pg8::Unit;
constexpr size_t TILE_B = 256 * 2;
struct SchedBase { int G, c; };
struct SchedZ : SchedBase {
    __device__ __forceinline__ bool next(int i, Unit& u) const {
        const int L = i * G + c; constexpr int NZ = (M / 256) * (NIN / 256), NKV = (MEMR / 256) * (2 * D / 256);
        if (L < NZ) { pg8::tile_map(L, M / 256, NIN / 256, u.pm, u.pn); u.z = 0; u.a_off = WS_XN + (size_t)u.pm * 256 * D * 2; u.b_off = WS_WIN_T + (size_t)u.pn * 256 * D * 2; return true; }
        if (L < NZ + NKV) { const int l = L - NZ; u.pm = l / 8; u.pn = l % 8; u.z = 1; u.a_off = WS_MEMN + (size_t)u.pm * 256 * D * 2; u.b_off = WS_WXKV_T + (size_t)u.pn * 256 * D * 2; return true; }
        return false;
    }
};
struct SchedG : SchedBase {
    __device__ __forceinline__ bool next(int i, Unit& u) const {
        const int L = i * G + c; if (L >= 64) return false;
        u.z = L >> 4; u.pm = (L >> 2) & 3; u.pn = L & 3; u.a_off = WS_KV + ((size_t)u.pm * 256 * 2048 + u.z * 256) * 2; u.b_off = WS_WQ_S + ((size_t)u.pn * 256 * 1024 + u.z * 256) * 2; return true;
    }
};
struct SchedVW : SchedBase {
    __device__ __forceinline__ bool next(int i, Unit& u) const {
        const int L = i * G + (G - 1 - c); if (L >= 64) return false;
        u.z = L >> 2; u.pm = L & 3; u.pn = 0; const int b = u.z >> 2, h = u.z & 3;
        u.a_off = WS_WO_T + ((size_t)u.pm * 256 * 1024 + h * 256) * 2; u.b_off = WS_KV + ((size_t)b * 256 * 2048 + 1024 + h * 256) * 2; return true;
    }
};
struct SchedMN : SchedBase {
    int nN; size_t a_base, b_base; int lda, ldb, bsel;
    __device__ __forceinline__ bool next(int i, Unit& u) const {
        const int L = i * G + c; if (L >= (M / 256) * nN) return false;
        pg8::tile_map(L, M / 256, nN, u.pm, u.pn); u.z = 0;
        u.a_off = a_base + (size_t)u.pm * 256 * lda * 2; u.b_off = b_base + ((size_t)u.pn * 256 + (bsel ? (size_t)(u.pm >> 5) * 1024 : 0)) * ldb * 2; return true;
    }
};

constexpr int CW_MQ = 8192;
__device__ __forceinline__ void moba_attn_phase(Frame& F, int bx) {
    const bf16* Z = (const bf16*)(F.ws + WS_Z); bf16* Y = (bf16*)(F.ws + WS_Y) + RW; const float* KM = (const float*)(F.ws + WS_KMEAN);
    const bool perx = (F.G % 8 == 0); const int x = perx ? (bx & 7) : 0; const int nun = perx ? 128 : 1024;
    unsigned* qc = (unsigned*)(F.ctl + CW_MQ + 64 * x);
    volatile LAS unsigned* slot = F.MISC + 16;
    for (int it = 0;; ++it) {
        if (F.tid == 0) slot[it & 1] = __hip_atomic_fetch_add(qc, 1u, __ATOMIC_RELAXED, __HIP_MEMORY_SCOPE_AGENT);
        asm volatile("s_waitcnt vmcnt(0) lgkmcnt(0)" ::: "memory"); __builtin_amdgcn_s_barrier(); asm volatile("" ::: "memory");
        const int idx = __builtin_amdgcn_readfirstlane((int)slot[it & 1]);
        if (idx >= nun) break;
        const int bh = perx ? x * 4 + (idx & 3) : (idx & 31), qb = perx ? 31 - (idx >> 2) : 31 - (idx >> 5);
        int ln = F.lane; asm volatile("" : "+v"(ln)); ln &= 63;
        attn_body::attn_unit<8>(bh / NH, bh % NH, qb, Z + ZQ, Z + ZK, Z + ZV, Y, KM + (size_t)bh * NBLK * HD, (char*)F.lds + RING_OFF, F.wave, ln);
    }
}

#ifndef MK_N_LAUNCHES
#define MK_N_LAUNCHES 1
#endif
constexpr int PER_PHASE = 12;
constexpr int N_LAUNCHES = MK_N_LAUNCHES;
constexpr int SCAN_WGS = 64;
struct Args { const float* in[25]; float* out; unsigned char* ws; int ph_lo, ph_hi, li, pad; };
__global__ void __launch_bounds__(NWAVES * 64, 2) skel_fwd(Args args) {
    extern __shared__ __attribute__((aligned(16))) unsigned char lds[];
    Frame F;
    F.lds = (LAS unsigned char*)lds;
    F.MISC = (volatile LAS unsigned*)(F.lds + MISC_OFF);
    F.tid = threadIdx.x; F.lane = F.tid & 63; F.wave = __builtin_amdgcn_readfirstlane(F.tid >> 6) & 7;
    F.G = gridDim.x; { const int bx = blockIdx.x; F.vcu = (F.G % 8 == 0) ? (bx % 8) * (F.G / 8) + bx / 8 : bx; }
    F.ws = args.ws; F.dout = (unsigned char*)args.out;
#pragma unroll
    for (int i = 0; i < 25; ++i) F.in[i] = args.in[i];
    F.ctl = (gu32*)(F.ws + WS_CTL);
    for (int u = F.tid; u < (EPI_LDS_OFF - LDSCTL_OFF) / 4; u += NWAVES * 64) ((LAS unsigned*)(F.lds + LDSCTL_OFF))[u] = 0u;
    __syncthreads();
    XcdBarrier bar; bar.bar = (unsigned*)(F.ctl + CW_BAR); bar.x = 0; bar.st = nullptr;
    if (N_LAUNCHES == 1) bar = xcd_barrier_post((unsigned*)(F.ctl + CW_BAR), F.MISC + 8);
#define GRID_BAR() do { if (N_LAUNCHES == 1) xcd_barrier(bar); } while (0)
    const int lo = args.ph_lo, hi = args.ph_hi;
#ifndef PHASE_MASK
#define PHASE_MASK 0xFFFF
#endif
#define IN(k) (((PHASE_MASK >> (k)) & 1) && lo <= (k) && (k) < hi)
#define BOTH(k) (IN(k) && IN((k) + 1))
#define FRESH() do { int l_; asm volatile("v_mbcnt_lo_u32_b32 %0, -1, 0\n\tv_mbcnt_hi_u32_b32 %0, -1, %0" : "=v"(l_)); F.lane = l_ & 63; F.tid = F.wave * 64 + F.lane; } while (0)
    const char* wsc = (const char*)F.ws;
    const int bx = (int)blockIdx.x;

    if (IN(0)) { FRESH(); p0_prologue(F); if (BOTH(0)) GRID_BAR(); }
    if (IN(1)) {
        pg8::Gemm g{wsc, wsc, D, D, D}; SchedZ S; S.G = F.G; S.c = bx;
        pg8::EpiStoreBf16 E{(bf16*)(F.ws + WS_Z), NIN, (bf16*)(F.ws + WS_KV), 2 * D, ZQ / 256, attn_body::C2, 0};
        pg8::gemm_phase<pg8::EpiStoreBf16, SchedZ, true>(F.lds + RING_OFF, g, S, E, F.wave);
        if (BOTH(1)) GRID_BAR();
    }
    if (IN(2)) {
        { pg8::Gemm g{wsc, wsc, 2 * D, D, 256}; SchedG S; S.G = F.G; S.c = bx;
          pg8::EpiStoreBf16 E{(bf16*)(F.ws + WS_GT), D, nullptr, 0, 0, 1.f, 1};
          pg8::gemm_phase<pg8::EpiStoreBf16, SchedG, true>(F.lds + RING_OFF, g, S, E, F.wave); }
        { pg8::Gemm g{wsc, wsc, D, 2 * D, 256}; SchedVW S; S.G = F.G; S.c = bx;
          pg8::EpiStoreBf16 E{(bf16*)(F.ws + WS_VWT), D, nullptr, 0, 0, 1.f, 2};
          pg8::gemm_phase<pg8::EpiStoreBf16, SchedVW, true>(F.lds + RING_OFF, g, S, E, F.wave); }
        __syncthreads();
        FRESH(); kmean_simple(F);
        FRESH(); rwkv_prep_simple(F);
        if (BOTH(2)) GRID_BAR();
    }
    if (IN(3)) { FRESH(); rscan::scan_pre(F); if (BOTH(3)) GRID_BAR(); }
    if (IN(4)) {
        FRESH();
        if (bx < BATCH * NH) { if (F.wave == 0) rscan::scan_seq(F, bx); __syncthreads(); }
        moba_attn_phase(F, bx);
        if (BOTH(4)) GRID_BAR();
    }
    if (IN(5)) { FRESH(); rscan::scan_post(F); if (BOTH(5)) GRID_BAR(); }
    if (IN(6)) {
        pg8::Gemm g{wsc, wsc, D, D, D}; SchedMN S; S.G = F.G; S.c = bx; S.nN = D / 256; S.a_base = WS_Y; S.b_base = WS_WMIX_T; S.lda = D; S.ldb = D; S.bsel = 0;
        pg8::EpiRes E{F.in[0], (float*)F.dout, (bf16*)(F.ws + WS_HB), (float*)(F.ws + WS_SS), D};
        pg8::gemm_phase<pg8::EpiRes, SchedMN, true>(F.lds + RING_OFF, g, S, E, F.wave);
        if (BOTH(6)) GRID_BAR();
    }
    if (IN(7)) {
        pg8::Gemm g{wsc, wsc, D, D, D}; SchedMN S; S.G = F.G; S.c = bx; S.nN = D / 256; S.a_base = WS_HB; S.b_base = WS_GT; S.lda = D; S.ldb = D; S.bsel = 1;
        pg8::EpiSoftmax E{(bf16*)(F.ws + WS_P), D, (const float*)(F.ws + WS_SS), (PG8_LAS pg8::f32x2*)(F.lds + EPI_LDS_OFF)};
        pg8::gemm_phase<pg8::EpiSoftmax, SchedMN, true>(F.lds + RING_OFF, g, S, E, F.wave);
        if (BOTH(7)) GRID_BAR();
    }
    if (IN(8)) {
        pg8::Gemm g{wsc, wsc, D, D, D}; SchedMN S; S.G = F.G; S.c = bx; S.nN = D / 256; S.a_base = WS_P; S.b_base = WS_VWT; S.lda = D; S.ldb = D; S.bsel = 1;
        pg8::EpiRes E{(const float*)F.dout, (float*)F.dout, (bf16*)(F.ws + WS_HB), (float*)(F.ws + WS_SS) + (size_t)M * 16, D};
        pg8::gemm_phase<pg8::EpiRes, SchedMN, true>(F.lds + RING_OFF, g, S, E, F.wave);
        if (BOTH(8)) GRID_BAR();
    }
    if (IN(9)) {
        pg8::Gemm g{wsc, wsc, D, D, D}; SchedMN S; S.G = F.G; S.c = bx; S.nN = FF / 256; S.a_base = WS_HB; S.b_base = WS_W1_T; S.lda = D; S.ldb = D; S.bsel = 0;
        pg8::EpiSqRelu E{(bf16*)(F.ws + WS_AH), FF, (const float*)(F.ws + WS_SS) + (size_t)M * 16};
        pg8::gemm_phase<pg8::EpiSqRelu, SchedMN, true>(F.lds + RING_OFF, g, S, E, F.wave);
        if (BOTH(9)) GRID_BAR();
    }
    if (IN(10)) {
        pg8::Gemm g{wsc, wsc, FF, FF, FF}; SchedMN S; S.G = F.G; S.c = bx; S.nN = D / 256; S.a_base = WS_AH; S.b_base = WS_W2_T; S.lda = FF; S.ldb = FF; S.bsel = 0;
        pg8::EpiRes E{(const float*)F.dout, (float*)F.dout, nullptr, (float*)(F.ws + WS_SS) + (size_t)2 * M * 16, D};
        pg8::gemm_phase<pg8::EpiRes, SchedMN, true>(F.lds + RING_OFF, g, S, E, F.wave);
        if (BOTH(10)) GRID_BAR();
    }
    if (IN(11)) { FRESH(); final_norm(F); }
#undef IN
#undef BOTH
}

extern "C" void kernel_launch(void* const* d_in, const int* in_sizes, int n_in, void* d_out, int out_size, void* d_ws, size_t ws_size, hipStream_t stream) {
    static int grid = 0;
    if (grid == 0) {
        if (n_in != 25 || in_sizes[0] != M * D || out_size != M * D || ws_size < WS_END) { fprintf(stderr, "kernel_launch: unexpected problem (n_in %d, in0 %d, out %d, ws %zu); nothing launched\n", n_in, n_in > 0 ? in_sizes[0] : -1, out_size, ws_size); grid = -1; return; }
        int dev = 0, cus = 0, per_cu = 0;
        if (hipGetDevice(&dev) != hipSuccess || hipDeviceGetAttribute(&cus, hipDeviceAttributeMultiprocessorCount, dev) != hipSuccess) { grid = -1; return; }
        if (hipFuncSetAttribute((const void*)skel_fwd, hipFuncAttributeMaxDynamicSharedMemorySize, LDS_BYTES) != hipSuccess) { fprintf(stderr, "kernel_launch: hipFuncSetAttribute failed\n"); grid = -1; return; }
        if (hipOccupancyMaxActiveBlocksPerMultiprocessor(&per_cu, (const void*)skel_fwd, NWAVES * 64, LDS_BYTES) != hipSuccess || per_cu < 1)
            fprintf(stderr, "kernel_launch: note: occupancy query reports %d workgroups per CU\n", per_cu);
        (void)hipGetLastError();
        grid = cus;
    }
    if (grid < 0) return;
    if (hipMemsetAsync((char*)d_ws + WS_CTL, 0, CTL_ZERO_BYTES, stream) != hipSuccess) { fprintf(stderr, "kernel_launch: hipMemsetAsync failed\n"); return; }
    Args a{};
    for (int i = 0; i < 25; ++i) a.in[i] = (const float*)d_in[i];
    a.out = (float*)d_out; a.ws = (unsigned char*)d_ws;
    for (int li = 0; li < N_LAUNCHES; ++li) {
        a.ph_lo = (N_LAUNCHES == PER_PHASE) ? li : 0; a.ph_hi = (N_LAUNCHES == PER_PHASE) ? li + 1 : PER_PHASE; a.li = li;
        hipLaunchKernelGGL(skel_fwd, dim3(grid), dim3(NWAVES * 64), LDS_BYTES, stream, a);
        const hipError_t le = hipPeekAtLastError();
        if (le != hipSuccess) { fprintf(stderr, "kernel_launch: launch %d failed: %s\n", li, hipGetErrorName(le)); break; }
    }
}
```

```cpp
#include <hip/hip_runtime.h>
#include <cstdio>
#include <cstdint>
#include <cmath>
namespace pg8 {
#define PG8_LAS __attribute__((address_space(3)))
typedef unsigned short bf16_t;
typedef short bf16x8 __attribute__((ext_vector_type(8)));
typedef float f32x4 __attribute__((ext_vector_type(4)));
typedef float f32x2 __attribute__((ext_vector_type(2)));
typedef unsigned u32x4 __attribute__((ext_vector_type(4)));
typedef unsigned u32x2 __attribute__((ext_vector_type(2)));
constexpr int BM = 256, BK = 64, HALF = 128, HTB = HALF * BK * 2  , STAGE_BYTES = 8 * HTB, NXCD = 8, WGM = 8;

__host__ __device__ __forceinline__ int lds_byte(int r, int c) { const int st = (r >> 4) * 2 + (c >> 5), rr = r & 15, cc = c & 31, ob = rr * 64 + cc * 2; return st * 1024 + (ob ^ (((ob >> 9) & 1) << 5)); }
__host__ __device__ __forceinline__ void stage_rc(int b, int& R, int& C) { const int st = b / 1024, sb = b % 1024, swz = sb ^ (((sb >> 9) & 1) << 5); R = (st >> 1) * 16 + swz / 64; C = (st & 1) * 32 + (swz % 64) / 2; }
__host__ __device__ __forceinline__ int perm32(int rho) { const int n = rho >> 4, i = rho & 15; return 8 * (i >> 2) + 4 * n + (i & 3); }

struct Unit { int pm, pn, z; size_t a_off, b_off; };
struct Gemm { const char* A; const char* Bt; int lda, ldb, K; };

__host__ __device__ __forceinline__ void tile_map(int L, int nM, int nN, int& pm, int& pn) {
    const int nwg = nM * nN; int wgid = L;
    { const int q = nwg / NXCD, r = nwg % NXCD, xcd = wgid % NXCD, off = wgid / NXCD; wgid = (xcd < r ? xcd * (q + 1) : r * (q + 1) + (xcd - r) * q) + off; }
    const int nig = WGM * nN, gid = wgid / nig, fm = gid * WGM, gsz = (nM - fm) < WGM ? (nM - fm) : WGM;
    pm = fm + ((wgid % nig) % gsz); pn = (wgid % nig) / gsz;
}

__device__ __forceinline__ unsigned cvt_pk_bf16(float lo, float hi) { unsigned r; asm volatile("v_cvt_pk_bf16_f32 %0, %1, %2" : "=v"(r) : "v"(lo), "v"(hi)); return r; }

template <class Epi, class Sched, bool ALIGN_EPI>
__device__ __forceinline__ void gemm_phase(PG8_LAS unsigned char* lds, const Gemm g, const Sched& S, const Epi& E, const int wid_) {
    int lane_; asm volatile("v_mbcnt_lo_u32_b32 %0, -1, 0\n\tv_mbcnt_hi_u32_b32 %0, -1, %0" : "=v"(lane_));
    const int lane = lane_ & 63, wid = wid_ & 7, tid = wid * 64 + lane, wr = wid >> 2, wc = wid & 3, fr = lane & 15, fq = lane >> 4;
    const int K = g.K, nt = K / BK;
    unsigned voffA[2], voffB[2];
#pragma unroll
    for (int i = 0; i < 2; ++i) { int R, C; stage_rc(tid * 16 + i * 8192, R, C); const int Rb = Epi::PERM ? ((R & ~31) + perm32(R & 31)) : R;
        voffA[i] = (unsigned)(R * g.lda + C) * 2u; voffB[i] = (unsigned)(Rb * g.ldb + C) * 2u; }
    const size_t kstep = (size_t)(BK * 2);
    const size_t hstepA = (size_t)HALF * g.lda * 2, hstepB = (size_t)HALF * g.ldb * 2;
    const unsigned ldsw = (unsigned)wid * 1024u;
    const int aoff = lds_byte(wr * 64 + fr, fq * 8), boff = lds_byte(wc * 32 + fr, fq * 8);
#define PG8_SA(b, h) (((b) * 2 + (h)) * HTB)
#define PG8_SB(b, h) ((4 + (b) * 2 + (h)) * HTB)
#define PG8_STAGE(bufoff, gbase, voff) do { _Pragma("unroll") for (int _i = 0; _i < 2; ++_i) \
        __builtin_amdgcn_global_load_lds((const unsigned*)((const char*)(gbase) + (voff)[_i]), (PG8_LAS unsigned*)(lds + (bufoff) + ldsw + _i * 8192), 16, 0, 0); } while (0)
#define PG8_LDA(dst, b, h) do { _Pragma("unroll") for (int m = 0; m < 4; ++m) _Pragma("unroll") for (int k = 0; k < 2; ++k) dst[m][k] = *(const PG8_LAS bf16x8*)(lds + PG8_SA(b, h) + aoff + m * 2048 + k * 1024); } while (0)
#define PG8_LDB(dst, b, h) do { _Pragma("unroll") for (int n = 0; n < 2; ++n) _Pragma("unroll") for (int k = 0; k < 2; ++k) dst[n][k] = *(const PG8_LAS bf16x8*)(lds + PG8_SB(b, h) + boff + n * 2048 + k * 1024); } while (0)
#define PG8_MMA(ai, bj, At, Bt) do { __builtin_amdgcn_s_setprio(1); _Pragma("unroll") for (int m = 0; m < 4; ++m) _Pragma("unroll") for (int n = 0; n < 2; ++n) _Pragma("unroll") for (int k = 0; k < 2; ++k) \
        acc[ai][bj][m][n] = __builtin_amdgcn_mfma_f32_16x16x32_bf16(Bt[n][k], At[m][k], acc[ai][bj][m][n], 0, 0, 0); __builtin_amdgcn_s_setprio(0); } while (0)
#define PG8_WAIT_V(n) asm volatile("s_waitcnt vmcnt(" #n ")" ::: "memory")
#define PG8_WAIT_L(n) asm volatile("s_waitcnt lgkmcnt(" #n ")" ::: "memory")
#define PG8_BAR __builtin_amdgcn_s_barrier()
#define PG8_SCHED __builtin_amdgcn_sched_barrier(0)
    Unit cur, nxt; int ui = 0;
    if (!S.next(0, cur)) return;
    f32x4 acc[2][2][4][2];
#pragma unroll
    for (int a = 0; a < 2; ++a)
#pragma unroll
        for (int b = 0; b < 2; ++b)
#pragma unroll
            for (int m = 0; m < 4; ++m)
#pragma unroll
                for (int n = 0; n < 2; ++n) acc[a][b][m][n] = (f32x4){0.f, 0.f, 0.f, 0.f};
    bf16x8 At[4][2], B0[2][2], B1[2][2];
    const char* cA = g.A + cur.a_off; const char* cB = g.Bt + cur.b_off;
    PG8_STAGE(PG8_SB(0, 0), cB, voffB); PG8_STAGE(PG8_SB(0, 1), cB + hstepB, voffB); PG8_STAGE(PG8_SA(0, 0), cA, voffA); PG8_STAGE(PG8_SA(0, 1), cA + hstepA, voffA);
    if (wr == 1) PG8_BAR;
    PG8_WAIT_V(2); PG8_BAR;
    PG8_STAGE(PG8_SB(1, 0), cB + kstep, voffB); PG8_STAGE(PG8_SA(1, 0), cA + kstep, voffA); PG8_STAGE(PG8_SB(1, 1), cB + hstepB + kstep, voffB);
    PG8_WAIT_V(6); PG8_BAR;
    for (;;) {
        const bool has_next = S.next(ui + 1, nxt);
        const char* nA = has_next ? g.A + nxt.a_off : cA; const char* nB = has_next ? g.Bt + nxt.b_off : cB;
        for (int t = 0; t < nt; t += 2) {
            const bool last = (t == nt - 2);
            const char* a1 = cA + (size_t)(t + 1) * kstep;
            const char* a2 = last ? nA : cA + (size_t)(t + 2) * kstep; const char* b2 = last ? nB : cB + (size_t)(t + 2) * kstep;
            const char* a3 = a2 + kstep; const char* b3 = b2 + kstep;
            PG8_LDB(B0, 0, 0); PG8_LDB(B1, 0, 1); PG8_SCHED; PG8_LDA(At, 0, 0); PG8_STAGE(PG8_SA(1, 1), a1 + hstepA, voffA);
            PG8_WAIT_V(8); PG8_WAIT_L(0); PG8_BAR; PG8_MMA(0, 0, At, B0); PG8_MMA(0, 1, At, B1); PG8_BAR; PG8_SCHED;
            PG8_LDA(At, 0, 1); PG8_STAGE(PG8_SB(0, 0), b2, voffB); PG8_STAGE(PG8_SB(0, 1), b2 + hstepB, voffB); PG8_STAGE(PG8_SA(0, 0), a2, voffA);
            PG8_WAIT_V(8); PG8_WAIT_L(0); PG8_BAR; PG8_MMA(1, 0, At, B0); PG8_MMA(1, 1, At, B1); PG8_BAR; PG8_SCHED;
            PG8_LDB(B0, 1, 0); PG8_LDB(B1, 1, 1); PG8_SCHED; PG8_LDA(At, 1, 0); PG8_STAGE(PG8_SA(0, 1), a2 + hstepA, voffA);
            PG8_WAIT_V(8); PG8_WAIT_L(0); PG8_BAR; PG8_MMA(0, 0, At, B0); PG8_MMA(0, 1, At, B1); PG8_BAR; PG8_SCHED;
            PG8_LDA(At, 1, 1); PG8_STAGE(PG8_SB(1, 0), b3, voffB); PG8_STAGE(PG8_SB(1, 1), b3 + hstepB, voffB); PG8_STAGE(PG8_SA(1, 0), a3, voffA);
            PG8_WAIT_V(8); PG8_WAIT_L(0); PG8_BAR; PG8_MMA(1, 0, At, B0); PG8_MMA(1, 1, At, B1); PG8_BAR; PG8_SCHED;
        }
        if constexpr (ALIGN_EPI) { if (wr == 0) PG8_BAR; }
        E(acc, cur, wr, wc, fr, fq, lane);
        if (!has_next) break;
#pragma unroll
        for (int a = 0; a < 2; ++a)
#pragma unroll
            for (int b = 0; b < 2; ++b)
#pragma unroll
                for (int m = 0; m < 4; ++m)
#pragma unroll
                    for (int n = 0; n < 2; ++n) acc[a][b][m][n] = (f32x4){0.f, 0.f, 0.f, 0.f};
        cur = nxt; cA = nA; cB = nB; ++ui;
        if constexpr (ALIGN_EPI) { if (wr == 1) PG8_BAR; }
    }
    PG8_WAIT_V(0);
    if constexpr (!ALIGN_EPI) { if (wr == 0) PG8_BAR; }
    PG8_BAR;
#undef PG8_SA
#undef PG8_SB
#undef PG8_STAGE
#undef PG8_LDA
#undef PG8_LDB
#undef PG8_MMA
#undef PG8_WAIT_V
#undef PG8_WAIT_L
#undef PG8_BAR
#undef PG8_SCHED
}
}
namespace pg8 {
struct EpiStoreBf16 {
    static constexpr bool PERM = true;
    bf16_t* O0; int ldc0; bf16_t* O1; int ldc1; int qs_lo; float qscale;
    int mode;
    __device__ __forceinline__ void operator()(const f32x4 (&acc)[2][2][4][2], const Unit& u, int wr, int wc, int fr, int fq, int lane) const {
        asm volatile("" : "+v"(fr), "+v"(fq), "+v"(lane));
        bf16_t* base; int ldc; size_t row0; int colt;
        if (mode == 0) { base = u.z ? O1 : O0; ldc = u.z ? ldc1 : ldc0; row0 = (size_t)u.pm * BM; colt = u.pn * BM; }
        else if (mode == 1) { base = O0; ldc = ldc0; row0 = (size_t)u.pm * 1024 + (size_t)u.z * 256; colt = u.pn * BM; }
        else { base = O0 + (size_t)(u.z >> 2) * 1048576; ldc = ldc0; row0 = (size_t)u.pm * BM; colt = (u.z & 3) * 256; }
        const float sc = (mode == 0 && u.z == 0 && (u.pn == qs_lo || u.pn == qs_lo + 1)) ? qscale : 1.f;
        const int col0 = colt + wc * 32 + 8 * fq;
#pragma unroll
        for (int ai = 0; ai < 2; ++ai)
#pragma unroll
            for (int m = 0; m < 4; ++m) { bf16_t* rowp = base + (row0 + wr * 64 + fr + ai * HALF + m * 16) * ldc + col0;
#pragma unroll
                for (int bj = 0; bj < 2; ++bj) { const f32x4 v0 = acc[ai][bj][m][0] * sc, v1 = acc[ai][bj][m][1] * sc;
                    u32x4 w; w.x = cvt_pk_bf16(v0[0], v0[1]); w.y = cvt_pk_bf16(v0[2], v0[3]); w.z = cvt_pk_bf16(v1[0], v1[1]); w.w = cvt_pk_bf16(v1[2], v1[3]);
                    *(u32x4*)(rowp + bj * HALF) = w; } }
    }
};

__device__ __forceinline__ float row_rstd(const float* ss, size_t row) {
    const f32x4* p = (const f32x4*)(ss + row * 16); const f32x4 a = p[0], b = p[1], c = p[2], d = p[3];
    const float s = ((a[0] + a[1]) + (a[2] + a[3])) + ((b[0] + b[1]) + (b[2] + b[3])) + ((c[0] + c[1]) + (c[2] + c[3])) + ((d[0] + d[1]) + (d[2] + d[3]));
    return 1.0f / sqrtf(s * (1.0f / 1024.0f) + 1e-6f);
}
__device__ __forceinline__ void wave_rstd(float (&rs)[2][4], const float* ss, int pm, int wr, int fr, int lane) {
    const float my0 = row_rstd(ss, (size_t)pm * BM + wr * 64 + lane), my1 = row_rstd(ss, (size_t)pm * BM + HALF + wr * 64 + lane);
#pragma unroll
    for (int m = 0; m < 4; ++m) { rs[0][m] = __shfl(my0, m * 16 + fr); rs[1][m] = __shfl(my1, m * 16 + fr); }
}

struct EpiRes {
    static constexpr bool PERM = false;
    const float* base; float* out; bf16_t* hb; float* ss; int ldc;
    __device__ __forceinline__ void operator()(f32x4 (&acc)[2][2][4][2], const Unit& u, int wr, int wc, int fr, int fq, int lane) const {
        asm volatile("" : "+v"(fr), "+v"(fq), "+v"(lane));
        const int col0 = u.pn * BM + wc * 32 + 4 * fq;
#pragma unroll
        for (int ai = 0; ai < 2; ++ai)
#pragma unroll
            for (int m = 0; m < 4; ++m) { const size_t row = (size_t)u.pm * BM + ai * HALF + wr * 64 + m * 16 + fr; const size_t off = row * ldc + col0; float q = 0.f;
#pragma unroll
                for (int bj = 0; bj < 2; ++bj)
#pragma unroll
                    for (int n = 0; n < 2; ++n) { const f32x4 bs = *(const f32x4*)(base + off + bj * HALF + n * 16); const f32x4 o = bs + acc[ai][bj][m][n];
                        *(f32x4*)(out + off + bj * HALF + n * 16) = o; q += (o[0] * o[0] + o[1] * o[1]) + (o[2] * o[2] + o[3] * o[3]);
                        if (hb) { u32x2 w; w.x = cvt_pk_bf16(o[0], o[1]); w.y = cvt_pk_bf16(o[2], o[3]); *(u32x2*)(hb + off + bj * HALF + n * 16) = w; } }
                q += __shfl_xor(q, 16); q += __shfl_xor(q, 32);
                if (fq == 0) ss[row * 16 + u.pn * 4 + wc] = q;
                if (m & 1) asm volatile("" ::: "memory"); }
    }
};

struct EpiSqRelu {
    static constexpr bool PERM = true;
    bf16_t* O; int ldc; const float* ss;
    __device__ __forceinline__ void operator()(const f32x4 (&acc)[2][2][4][2], const Unit& u, int wr, int wc, int fr, int fq, int lane) const {
        asm volatile("" : "+v"(fr), "+v"(fq), "+v"(lane));
        float rs[2][4]; wave_rstd(rs, ss, u.pm, wr, fr, lane);
        const int col0 = u.pn * BM + wc * 32 + 8 * fq;
#pragma unroll
        for (int ai = 0; ai < 2; ++ai)
#pragma unroll
            for (int m = 0; m < 4; ++m) { bf16_t* rowp = O + ((size_t)u.pm * BM + wr * 64 + fr + ai * HALF + m * 16) * ldc + col0; const float s = rs[ai][m];
#pragma unroll
                for (int bj = 0; bj < 2; ++bj) { f32x4 v0 = acc[ai][bj][m][0] * s, v1 = acc[ai][bj][m][1] * s;
#pragma unroll
                    for (int i = 0; i < 4; ++i) { const float a = fmaxf(v0[i], 0.f), b = fmaxf(v1[i], 0.f); v0[i] = a * a; v1[i] = b * b; }
                    u32x4 w; w.x = cvt_pk_bf16(v0[0], v0[1]); w.y = cvt_pk_bf16(v0[2], v0[3]); w.z = cvt_pk_bf16(v1[0], v1[1]); w.w = cvt_pk_bf16(v1[2], v1[3]);
                    *(u32x4*)(rowp + bj * HALF) = w; } }
    }
};

struct EpiSoftmax {
    static constexpr bool PERM = true;
    bf16_t* O; int ldc; const float* ss; PG8_LAS f32x2* xl;
    __device__ __forceinline__ void operator()(f32x4 (&acc)[2][2][4][2], const Unit& u, int wr, int wc, int fr, int fq, int lane) const {
        asm volatile("" : "+v"(fr), "+v"(fq), "+v"(lane));
        float rs[2][4]; wave_rstd(rs, ss, u.pm, wr, fr, lane);
#pragma unroll
        for (int ai = 0; ai < 2; ++ai)
#pragma unroll
            for (int m = 0; m < 4; ++m) { const float s = rs[ai][m] * (0.0625f * 1.4426950408889634f); float mx = -INFINITY;
#pragma unroll
                for (int bj = 0; bj < 2; ++bj)
#pragma unroll
                    for (int n = 0; n < 2; ++n) { f32x4 v = acc[ai][bj][m][n] * s; acc[ai][bj][m][n] = v; mx = fmaxf(fmaxf(mx, fmaxf(v[0], v[1])), fmaxf(v[2], v[3])); }
                mx = fmaxf(mx, __shfl_xor(mx, 16)); mx = fmaxf(mx, __shfl_xor(mx, 32)); float sm = 0.f;
#pragma unroll
                for (int bj = 0; bj < 2; ++bj)
#pragma unroll
                    for (int n = 0; n < 2; ++n) { f32x4 v = acc[ai][bj][m][n];
#pragma unroll
                        for (int i = 0; i < 4; ++i) { v[i] = __builtin_amdgcn_exp2f(v[i] - mx); sm += v[i]; } acc[ai][bj][m][n] = v; }
                sm += __shfl_xor(sm, 16); sm += __shfl_xor(sm, 32);
                if (fq == 0) xl[(ai * HALF + wr * 64 + m * 16 + fr) * 4 + wc] = (f32x2){mx, sm}; }
        asm volatile("s_waitcnt lgkmcnt(0)" ::: "memory"); __builtin_amdgcn_s_barrier(); asm volatile("" ::: "memory");
        const int col0 = u.pn * BM + wc * 32 + 8 * fq;
#pragma unroll
        for (int ai = 0; ai < 2; ++ai)
#pragma unroll
            for (int m = 0; m < 4; ++m) { const int r = ai * HALF + wr * 64 + m * 16 + fr;
                const f32x4 x01 = *(const PG8_LAS f32x4*)(xl + r * 4), x23 = *(const PG8_LAS f32x4*)(xl + r * 4 + 2);
                const float mg = fmaxf(fmaxf(x01[0], x01[2]), fmaxf(x23[0], x23[2]));
                const float tot = x01[1] * __builtin_amdgcn_exp2f(x01[0] - mg) + x01[3] * __builtin_amdgcn_exp2f(x01[2] - mg) + x23[1] * __builtin_amdgcn_exp2f(x23[0] - mg) + x23[3] * __builtin_amdgcn_exp2f(x23[2] - mg);
                const float mown = wc == 0 ? x01[0] : (wc == 1 ? x01[2] : (wc == 2 ? x23[0] : x23[2]));
                const float f = __builtin_amdgcn_exp2f(mown - mg) / tot;
                bf16_t* rowp = O + ((size_t)u.pm * BM + r) * ldc + col0;
#pragma unroll
                for (int bj = 0; bj < 2; ++bj) { const f32x4 v0 = acc[ai][bj][m][0] * f, v1 = acc[ai][bj][m][1] * f;
                    u32x4 w; w.x = cvt_pk_bf16(v0[0], v0[1]); w.y = cvt_pk_bf16(v0[2], v0[3]); w.z = cvt_pk_bf16(v1[0], v1[1]); w.w = cvt_pk_bf16(v1[2], v1[3]);
                    *(u32x4*)(rowp + bj * HALF) = w; } }
    }
};
}
constexpr int NWAVES = 8;
constexpr int BATCH = 4, T = 8192, D = 1024, M = BATCH * T;
constexpr int NIN = 3328, RW = 512, NH = 8, HD = 64;
constexpr int ZK_R = 512, ZV_R = 1024, ZWD = 1536, ZAD = 1600, ZGD = 1664;
constexpr int ZQ = 1792, ZK = 1792 + 512, ZV = 1792 + 1024;
constexpr int MEML = 256, MEMR = BATCH * MEML, FF = 4096;
constexpr int NBLK = T / 256;
constexpr float NORM_EPS = 1e-6f, GN_EPS = 64e-5f, DECAY_SCALE = 0.6065306597126334f;

constexpr size_t MiB = 1u << 20;
constexpr size_t WS_CTL = 0, CTL_ZERO_BYTES = 1 * MiB;
constexpr size_t WS_WIN_T = 1 * MiB, WS_WMIX_T = 8 * MiB, WS_WQ_S = 10 * MiB, WS_WXKV_T = 12 * MiB, WS_WO_T = 16 * MiB, WS_W1_T = 18 * MiB, WS_W2_T = 26 * MiB;
constexpr size_t WS_MEMN = 34 * MiB, WS_KV = 36 * MiB, WS_GT = 40 * MiB, WS_VWT = 48 * MiB;
constexpr size_t WS_SS = 56 * MiB;
constexpr size_t WS_KMEAN = 62 * MiB, WS_LORA = 62 * MiB + 512 * 1024, WS_BON = 63 * MiB;
constexpr size_t WS_XN = 64 * MiB;
constexpr size_t WS_GATE = 64 * MiB, WS_YRAW = 96 * MiB;
constexpr size_t WS_HB = 64 * MiB;
constexpr size_t WS_Z = 128 * MiB;
constexpr size_t WS_Y = 336 * MiB;
constexpr size_t WS_PR = 400 * MiB, WS_PV = 432 * MiB;
constexpr size_t WS_P = 400 * MiB;
constexpr size_t WS_AH = 128 * MiB;
constexpr size_t WS_END = 512 * MiB;
constexpr size_t DO_W = 0, DO_KP = 32 * MiB, DO_KKN = 64 * MiB, DO_B = 96 * MiB;

constexpr int CW_TMO = 0, CW_CODE = 1;
constexpr int CW_BAR = 4096;

constexpr int RING_OFF = 0, RING_BYTES = 131072;
constexpr int LDSCTL_OFF = RING_BYTES, MISC_OFF = LDSCTL_OFF + 320;
constexpr int EPI_LDS_OFF = 132096;
constexpr int LDS_BYTES = 147456;
static_assert(MISC_OFF + 128 <= EPI_LDS_OFF && EPI_LDS_OFF + 8192 <= LDS_BYTES, "LDS map");

#define GAS __attribute__((address_space(1)))
#define LAS __attribute__((address_space(3)))
typedef unsigned short bf16;
typedef unsigned v4u __attribute__((ext_vector_type(4)));
typedef float f32x4 __attribute__((ext_vector_type(4)));
typedef GAS unsigned gu32;
#define RLX_AGENT __ATOMIC_RELAXED, __HIP_MEMORY_SCOPE_AGENT
#define LDS_WAIT() asm volatile("s_waitcnt lgkmcnt(0)" ::: "memory")
#define VM_WAIT() asm volatile("s_waitcnt vmcnt(0)" ::: "memory")
__device__ __forceinline__ unsigned f2bf(float f) { unsigned u = __builtin_bit_cast(unsigned, f); return (u + 0x7fffu + ((u >> 16) & 1u)) >> 16; }
__device__ __forceinline__ unsigned pk2(float lo, float hi) { return f2bf(lo) | (f2bf(hi) << 16); }
__device__ __forceinline__ float bf2f(unsigned short u) { return __builtin_bit_cast(float, (unsigned)u << 16); }
__device__ __forceinline__ float bflo(unsigned u) { return __builtin_bit_cast(float, u << 16); }
__device__ __forceinline__ float bfhi(unsigned u) { return __builtin_bit_cast(float, u & 0xffff0000u); }

#define XB_TMO      128
#define XB_XCNT(j)  (256  + 64 * (j))
#define XB_XSUB(j)  (1280 + 64 * (j))
#define XB_XGEN(j)  (2304 + 64 * (j))
#define XB_TOP      3328
#define XB_TOPGEN   3392
#define XCD_BAR_WORDS 3456
#define XB_SPIN_CAP (1u << 18)
__device__ __forceinline__ unsigned xb_ld(unsigned* p)              { return __hip_atomic_load(p, __ATOMIC_RELAXED, __HIP_MEMORY_SCOPE_AGENT); }
__device__ __forceinline__ unsigned xb_add(unsigned* p, unsigned v) { return __hip_atomic_fetch_add(p, v, __ATOMIC_RELAXED, __HIP_MEMORY_SCOPE_AGENT); }
__device__ __forceinline__ unsigned xb_xcc_id() { return (unsigned)__builtin_amdgcn_s_getreg((3 << 11) | 20) & 0xFu; }
#define XB_SPIN(cond, bar) do { unsigned _sp = 0; while (cond) { __builtin_amdgcn_s_sleep(1); \
    if ((++_sp & 255u) == 0u) { if (xb_ld(&(bar)[XB_TMO])) break; if (_sp > XB_SPIN_CAP) { atomicAdd(&(bar)[XB_TMO], 1u); break; } } } } while (0)
struct XcdBarrier { unsigned* bar; unsigned x; volatile LAS unsigned* st; };
__device__ __forceinline__ XcdBarrier xcd_barrier_post(unsigned* bar, volatile LAS unsigned* st) {
    XcdBarrier b; b.bar = bar; b.x = xb_xcc_id(); b.st = st;
    if (threadIdx.x == 0) (void)xb_add(&bar[XB_XCNT(b.x)], 1u);
    return b;
}
__device__ __forceinline__ void xcd_barrier_complete(unsigned* bar, unsigned x, unsigned& nloc, unsigned& nx) {
    const unsigned G = gridDim.x * gridDim.y * gridDim.z;
    unsigned sum, cnt, mine, sp = 0u;
    for (;;) {
        sum = 0u; cnt = 0u; mine = 0u;
#pragma unroll
        for (unsigned j = 0; j < 16; ++j) { const unsigned c = xb_ld(&bar[XB_XCNT(j)]); sum += c; cnt += (c > 0u) ? 1u : 0u; mine = (j == x) ? c : mine; }
        if (sum == G) break;
        __builtin_amdgcn_s_sleep(1);
        if ((++sp & 255u) == 0u) { if (xb_ld(&bar[XB_TMO])) break; if (sp > XB_SPIN_CAP) { atomicAdd(&bar[XB_TMO], 1u); break; } }
    }
    nloc = mine > 0u ? mine : 1u; nx = cnt > 0u ? cnt : 1u;
}
__device__ __forceinline__ void xcd_barrier(const XcdBarrier& b) {
    asm volatile("s_waitcnt vmcnt(0)" ::: "memory");
    __syncthreads();
    if (threadIdx.x == 0) {
        unsigned* bar = b.bar;
        __builtin_amdgcn_s_waitcnt(0);
        unsigned nloc = b.st[0], nx = b.st[1];
        if (nloc == 0u) { xcd_barrier_complete(bar, b.x, nloc, nx); b.st[0] = nloc; b.st[1] = nx; }
        const unsigned old = xb_add(&bar[XB_XSUB(b.x)], 1u);
        const unsigned gen = old / nloc;
        if (old + 1u == (gen + 1u) * nloc) {
            __builtin_amdgcn_fence(__ATOMIC_RELEASE, "agent");
            asm volatile("s_waitcnt vmcnt(0)" ::: "memory");
            const unsigned og = xb_add(&bar[XB_TOP], 1u);
            const unsigned tg = og / nx;
            if (og + 1u == (tg + 1u) * nx) xb_add(&bar[XB_TOPGEN], 1u);
            else XB_SPIN(xb_ld(&bar[XB_TOPGEN]) == tg, bar);
            __builtin_amdgcn_fence(__ATOMIC_ACQUIRE, "agent");
            xb_add(&bar[XB_XGEN(b.x)], 1u);
            asm volatile("s_waitcnt vmcnt(0)" ::: "memory");
        } else {
            XB_SPIN(xb_ld(&bar[XB_XGEN(b.x)]) == gen, bar);
            __builtin_amdgcn_fence(__ATOMIC_ACQUIRE, "agent");
            asm volatile("s_waitcnt vmcnt(0)" ::: "memory");
        }
    }
    __syncthreads();
}

struct Frame {
    LAS unsigned char* lds;
    volatile LAS unsigned* MISC;
    gu32* ctl;
    int tid, lane, wave;
    int vcu, G;
    unsigned char* ws; unsigned char* dout;
    const float* in[25];
};
__device__ __forceinline__ float wave_sum(float v) {
#pragma unroll
    for (int o = 1; o < 64; o <<= 1) v += __shfl_xor(v, o);
    return v;
}
__device__ __forceinline__ float wave_max(float v) {
#pragma unroll
    for (int o = 1; o < 64; o <<= 1) v = fmaxf(v, __shfl_xor(v, o));
    return v;
}
template <int CTRL> __device__ __forceinline__ float dpp_mov(float x) { return __builtin_bit_cast(float, __builtin_amdgcn_update_dpp(0, __builtin_bit_cast(int, x), CTRL, 0xf, 0xf, false)); }
__device__ __forceinline__ float red16(float x) { x += dpp_mov<0xB1>(x); x += dpp_mov<0x4E>(x); x += dpp_mov<0x124>(x); x += dpp_mov<0x128>(x); return x; }
__device__ __forceinline__ void p0_transpose_item(const float* W, int K, int N, bf16* WT, const float* kscale, LAS float* scr, int item, int lane) {
    const int nblk = N / 32, kb = item / nblk, nb = item % nblk, k0 = 64 * kb, n0 = 32 * nb;
#pragma unroll 8
    for (int i = 0; i < 32; ++i) { const int kk = 2 * i + (lane >> 5); const float s = kscale ? kscale[k0 + kk] : 1.f; scr[kk * 33 + (lane & 31)] = W[(size_t)(k0 + kk) * N + n0 + (lane & 31)] * s; }
    LDS_WAIT(); asm volatile("" ::: "memory");
    const int c = lane & 7;
#pragma unroll
    for (int j = 0; j < 4; ++j) { const int n = (lane >> 3) + 8 * j; const LAS float* s = scr + (8 * c) * 33 + n;
        v4u o; o.x = pk2(s[0 * 33], s[1 * 33]); o.y = pk2(s[2 * 33], s[3 * 33]); o.z = pk2(s[4 * 33], s[5 * 33]); o.w = pk2(s[6 * 33], s[7 * 33]);
        *(GAS v4u*)(WT + (size_t)(n0 + n) * K + k0 + 8 * c) = o; }
    LDS_WAIT(); asm volatile("" ::: "memory");
}
__device__ __forceinline__ void rms_row_to_bf16(const float* xrow, const float* g, bf16* orow, int lane) {
    const GAS f32x4* xr = (const GAS f32x4*)xrow + lane; const GAS f32x4* gr = (const GAS f32x4*)g + lane;
    f32x4 v[4]; float s = 0.f;
#pragma unroll
    for (int j = 0; j < 4; ++j) { v[j] = xr[64 * j]; s += (v[j].x * v[j].x + v[j].y * v[j].y) + (v[j].z * v[j].z + v[j].w * v[j].w); }
    const float rstd = 1.f / sqrtf(wave_sum(s) * (1.f / D) + NORM_EPS);
    GAS unsigned long long* o8 = (GAS unsigned long long*)orow + lane;
#pragma unroll
    for (int j = 0; j < 4; ++j) { const f32x4 gg = gr[64 * j]; o8[64 * j] = (unsigned long long)pk2(v[j].x * rstd * gg.x, v[j].y * rstd * gg.y) | ((unsigned long long)pk2(v[j].z * rstd * gg.z, v[j].w * rstd * gg.w) << 32); }
}
__device__ __forceinline__ void p0_prologue(Frame& F) {
    LAS float* scr = (LAS float*)(F.lds + RING_OFF + F.wave * 16384);
    const int gw = F.vcu * NWAVES + F.wave, NGW = F.G * NWAVES;
    constexpr int I_IN = (D / 64) * (NIN / 32), I_MIX = (D / 64) * (D / 32), I_KV = (D / 64) * (2 * D / 32), I_O = I_MIX, I_1 = (D / 64) * (FF / 32), I_2 = (FF / 64) * (D / 32);
    constexpr int I_LW = RW / 32, I_LG = 2 * (RW / 32);
    constexpr int NITEMS = I_IN + I_MIX + I_KV + I_O + I_1 + I_2 + 2 * I_LW + I_LG;
    for (int it = gw; it < NITEMS; it += NGW) {
        int r = it;
        if (r < I_IN) { p0_transpose_item(F.in[3], D, NIN, (bf16*)(F.ws + WS_WIN_T), nullptr, scr, r, F.lane); continue; } r -= I_IN;
        if (r < I_MIX) { p0_transpose_item(F.in[15], D, D, (bf16*)(F.ws + WS_WMIX_T), nullptr, scr, r, F.lane); continue; } r -= I_MIX;
        if (r < I_KV) { p0_transpose_item(F.in[19], D, 2 * D, (bf16*)(F.ws + WS_WXKV_T), nullptr, scr, r, F.lane); continue; } r -= I_KV;
        if (r < I_O) { p0_transpose_item(F.in[20], D, D, (bf16*)(F.ws + WS_WO_T), nullptr, scr, r, F.lane); continue; } r -= I_O;
        if (r < I_1) { p0_transpose_item(F.in[22], D, FF, (bf16*)(F.ws + WS_W1_T), F.in[21], scr, r, F.lane); continue; } r -= I_1;
        if (r < I_2) { p0_transpose_item(F.in[23], FF, D, (bf16*)(F.ws + WS_W2_T), nullptr, scr, r, F.lane); continue; } r -= I_2;
        if (r < I_LW) { p0_transpose_item(F.in[6], 64, RW, (bf16*)(F.ws + WS_LORA), nullptr, scr, r, F.lane); continue; } r -= I_LW;
        if (r < I_LW) { p0_transpose_item(F.in[8], 64, RW, (bf16*)(F.ws + WS_LORA) + RW * 64, nullptr, scr, r, F.lane); continue; } r -= I_LW;
        p0_transpose_item(F.in[9], 128, RW, (bf16*)(F.ws + WS_LORA) + 2 * RW * 64, nullptr, scr, r, F.lane);
    }
    { const float* wq = F.in[18]; const float* gx = F.in[16]; bf16* o = (bf16*)(F.ws + WS_WQ_S);
      for (int i = (F.vcu * 512 + F.tid); i < D * D / 4; i += F.G * 512) { const f32x4 v = ((const GAS f32x4*)wq)[i]; const float s = gx[(i * 4) / D];
          ((GAS unsigned long long*)o)[i] = (unsigned long long)pk2(v.x * s, v.y * s) | ((unsigned long long)pk2(v.z * s, v.w * s) << 32); } }
    for (int m = gw; m < M; m += NGW) rms_row_to_bf16(F.in[0] + (size_t)m * D, F.in[2], (bf16*)(F.ws + WS_XN) + (size_t)m * D, F.lane);
    for (int m = gw; m < MEMR; m += NGW) rms_row_to_bf16(F.in[1] + (size_t)m * D, F.in[17], (bf16*)(F.ws + WS_MEMN) + (size_t)m * D, F.lane);
}

__device__ __forceinline__ float zshift(const bf16* Z, const float* mu, int m, int col) {
    const float z = bf2f(Z[(size_t)m * NIN + col]); const float zp = (m % T == 0) ? 0.f : bf2f(Z[(size_t)(m - 1) * NIN + col]);
    return z + (zp - z) * mu[col];
}
__device__ __forceinline__ void rwkv_prep_simple(Frame& F) {
    const bf16* Z = (const bf16*)(F.ws + WS_Z); const float* mu = F.in[4];
    LAS float* lo = (LAS float*)(F.lds + RING_OFF);
    const int c = F.tid;
    const float w0 = F.in[5][c], a0 = F.in[7][c], kkc = F.in[10][c], kac = F.in[11][c], rkc = F.in[12][c];
    const float* wup = F.in[6]; const float* aup = F.in[8]; const float* gup = F.in[9];
    bf16* oR = (bf16*)(F.ws + WS_PR); bf16* oV = (bf16*)(F.ws + WS_PV); bf16* oW = (bf16*)(F.dout + DO_W); bf16* oKP = (bf16*)(F.dout + DO_KP); bf16* oKK = (bf16*)(F.dout + DO_KKN); bf16* oB = (bf16*)(F.dout + DO_B);
    bf16* oG = (bf16*)(F.ws + WS_GATE); float* oBon = (float*)(F.ws + WS_BON);
    for (int m0 = F.vcu * 4; m0 < M; m0 += F.G * 4) {
#pragma unroll
        for (int i = 0; i < 2; ++i) { const int e = F.tid + 512 * i, tk = e >> 8, j = e & 255; const float zs = zshift(Z, mu, m0 + tk, ZWD + j);
            lo[e] = j < 64 ? tanhf(zs) : (j < 128 ? zs : 1.f / (1.f + __expf(-zs))); }
        __syncthreads();
        float aw[4], aa[4], ag[4];
#pragma unroll
        for (int k = 0; k < 4; ++k) { aw[k] = 0.f; aa[k] = 0.f; ag[k] = 0.f; }
        for (int j = 0; j < 64; ++j) { const float wv = wup[j * RW + c], av = aup[j * RW + c];
#pragma unroll
            for (int k = 0; k < 4; ++k) { aw[k] += lo[k * 256 + j] * wv; aa[k] += lo[k * 256 + 64 + j] * av; } }
        for (int j = 0; j < 128; ++j) { const float gv = gup[j * RW + c];
#pragma unroll
            for (int k = 0; k < 4; ++k) ag[k] += lo[k * 256 + 128 + j] * gv; }
#pragma unroll
        for (int k = 0; k < 4; ++k) { const int m = m0 + k;
            const float r = zshift(Z, mu, m, c), kx = zshift(Z, mu, m, ZK_R + c), v = zshift(Z, mu, m, ZV_R + c);
            const float dec = -DECAY_SCALE / (1.f + __expf(-(w0 + aw[k])));
            const float a = 1.f / (1.f + __expf(-(a0 + aa[k])));
            const float kk = kx * kkc; const float nn = wave_sum(kk * kk); const float kkn = kk / fmaxf(sqrtf(nn), 1e-12f);
            const float kp = kx * (1.f + (a - 1.f) * kac);
            const float bon = wave_sum(r * kp * rkc);
            const size_t o = (size_t)m * RW + c;
            oR[o] = (bf16)f2bf(r); oV[o] = (bf16)f2bf(v); oW[o] = (bf16)f2bf(dec); oKP[o] = (bf16)f2bf(kp); oKK[o] = (bf16)f2bf(kkn); oB[o] = (bf16)f2bf(kkn * a); oG[o] = (bf16)f2bf(ag[k]);
            if (F.lane == 0) oBon[(size_t)m * NH + F.wave] = bon; }
        __syncthreads();
    }
}
__device__ __forceinline__ void kmean_simple(Frame& F) {
    const bf16* Z = (const bf16*)(F.ws + WS_Z); float* KM = (float*)(F.ws + WS_KMEAN);
    const int gw = F.vcu * NWAVES + F.wave, NGW = F.G * NWAVES;
    for (int u = gw; u < BATCH * NH * NBLK; u += NGW) { const int j = u % NBLK, bh = u / NBLK, b = bh / NH, h = bh % NH;
        const bf16* kp = Z + ((size_t)b * T + j * 256) * NIN + ZK + h * HD + F.lane; float s = 0.f;
        for (int i = 0; i < 256; ++i) s += bf2f(kp[(size_t)i * NIN]);
        KM[(size_t)u * HD + F.lane] = s * (1.f / 256.f); }
}
constexpr int SC_TC = 32, SC_REC = 352;
__device__ __forceinline__ void scan_simple(Frame& F, int unit) {
    const int bh = unit >> 1, hf = unit & 1, b = bh / NH, h = bh % NH;
    const size_t rowbase = (size_t)b * T;
    const bf16* aR = (const bf16*)(F.ws + WS_PR); const bf16* aV = (const bf16*)(F.ws + WS_PV); const bf16* aW = (const bf16*)(F.dout + DO_W); const bf16* aKP = (const bf16*)(F.dout + DO_KP);
    const bf16* aKK = (const bf16*)(F.dout + DO_KKN); const bf16* aB = (const bf16*)(F.dout + DO_B);
    bf16* yout = (bf16*)(F.ws + WS_YRAW);
    LAS float* buf = (LAS float*)(F.lds + RING_OFF);
    const int rowl = F.tid >> 4, p = F.tid & 15;
    float S0 = 0.f, S1 = 0.f, S2 = 0.f, S3 = 0.f;
    unsigned short raw[22];
#define SC_GLOAD(t0) do { _Pragma("unroll") for (int i = 0; i < 22; ++i) { const int e = F.tid + 512 * i, tk = e / SC_REC, rem = e % SC_REC, q = rem >> 6, cc = rem & 63; \
            const size_t rowo = (rowbase + (t0) + tk) * RW + h * HD; \
            const bf16* src = q == 0 ? aR : (q == 1 ? aW : (q == 2 ? aKP : (q == 3 ? aKK : (q == 4 ? aB : aV)))); \
            raw[i] = src[rowo + (q == 5 ? hf * 32 + cc : cc)]; } } while (0)
#define SC_LSTORE(bi) do { _Pragma("unroll") for (int i = 0; i < 22; ++i) { const int e = F.tid + 512 * i; buf[(bi) * SC_TC * SC_REC + e] = bf2f(raw[i]); } } while (0)
    SC_GLOAD(0); SC_LSTORE(0); __syncthreads();
    for (int ch = 0; ch < T / SC_TC; ++ch) {
        const int cur = ch & 1; const bool more = (ch + 1 < T / SC_TC);
        if (more) SC_GLOAD((ch + 1) * SC_TC);
        const LAS float* rec = buf + cur * SC_TC * SC_REC;
        for (int tt = 0; tt < SC_TC; ++tt, rec += SC_REC) {
            const f32x4 r4 = *(const LAS f32x4*)(rec + 4 * p), w4 = *(const LAS f32x4*)(rec + 64 + 4 * p), k4 = *(const LAS f32x4*)(rec + 128 + 4 * p),
                        n4 = *(const LAS f32x4*)(rec + 192 + 4 * p), b4 = *(const LAS f32x4*)(rec + 256 + 4 * p);
            const float vv = rec[320 + rowl];
            float sa = (S0 * n4.x + S1 * n4.y) + (S2 * n4.z + S3 * n4.w); sa = -red16(sa);
            S0 = S0 * w4.x + sa * b4.x + vv * k4.x; S1 = S1 * w4.y + sa * b4.y + vv * k4.y; S2 = S2 * w4.z + sa * b4.z + vv * k4.z; S3 = S3 * w4.w + sa * b4.w + vv * k4.w;
            float y = (S0 * r4.x + S1 * r4.y) + (S2 * r4.z + S3 * r4.w); y = red16(y);
            if (p == 0) yout[(rowbase + ch * SC_TC + tt) * RW + h * HD + hf * 32 + rowl] = (bf16)f2bf(y);
        }
        if (more) SC_LSTORE(cur ^ 1);
        __syncthreads();
    }
#undef SC_GLOAD
#undef SC_LSTORE
}
__device__ __forceinline__ void load_row64(float (&q)[64], const bf16* p) {
#pragma unroll
    for (int i = 0; i < 8; ++i) { const v4u w = ((const GAS v4u*)p)[i];
        q[8 * i + 0] = bflo(w.x); q[8 * i + 1] = bfhi(w.x); q[8 * i + 2] = bflo(w.y); q[8 * i + 3] = bfhi(w.y); q[8 * i + 4] = bflo(w.z); q[8 * i + 5] = bfhi(w.z); q[8 * i + 6] = bflo(w.w); q[8 * i + 7] = bfhi(w.w); }
}
__device__ __forceinline__ void moba_simple(Frame& F, int wg, int nwg) {
    const bf16* Z = (const bf16*)(F.ws + WS_Z); const float* KM = (const float*)(F.ws + WS_KMEAN); bf16* Y = (bf16*)(F.ws + WS_Y);
    LAS float* red = (LAS float*)(F.lds + RING_OFF) + F.wave * (64 * 33);
    const int lane = F.lane;
    for (int qi = wg * NWAVES + F.wave; qi < BATCH * NH * T; qi += nwg * NWAVES) {
        const int bh = qi / T, t = qi % T, b = bh / NH, h = bh % NH, own = t >> 8;
        const size_t rowbase = (size_t)b * T;
        float q[64]; load_row64(q, Z + (rowbase + t) * NIN + ZQ + h * HD);
        float gate = -INFINITY;
        if (lane < own) { const float* km = KM + ((size_t)bh * NBLK + lane) * HD; float g = 0.f;
#pragma unroll
            for (int d = 0; d < 64; ++d) g += q[d] * km[d];
            gate = g; }
        int sel[3];
#pragma unroll
        for (int n = 0; n < 3; ++n) { const float mx = wave_max(gate); const unsigned long long bal = __ballot(gate == mx && mx > -INFINITY);
            int idx = -1; if (bal != 0ull) { idx = __ffsll((long long)bal) - 1; if (lane == idx) gate = -INFINITY; } sel[n] = idx; }
        float sc[16]; float mx = -INFINITY;
#pragma unroll
        for (int bi = 0; bi < 4; ++bi) { const int blk = bi < 3 ? sel[bi] : own;
#pragma unroll
            for (int i = 0; i < 4; ++i) { const int key = blk * 256 + i * 64 + lane; float s = -INFINITY;
                if (blk >= 0 && (bi < 3 || key <= t)) { const GAS v4u* kp = (const GAS v4u*)(Z + (rowbase + key) * NIN + ZK + h * HD); float a = 0.f;
#pragma unroll
                    for (int j = 0; j < 8; ++j) { const v4u w = kp[j];
                        a += q[8 * j + 0] * bflo(w.x) + q[8 * j + 1] * bfhi(w.x) + q[8 * j + 2] * bflo(w.y) + q[8 * j + 3] * bfhi(w.y) + q[8 * j + 4] * bflo(w.z) + q[8 * j + 5] * bfhi(w.z) + q[8 * j + 6] * bflo(w.w) + q[8 * j + 7] * bfhi(w.w); }
                    s = a * 0.125f; }
                sc[bi * 4 + i] = s; mx = fmaxf(mx, s); } }
        mx = wave_max(mx);
        float o[64]; float l = 0.f;
#pragma unroll
        for (int d = 0; d < 64; ++d) o[d] = 0.f;
#pragma unroll
        for (int bi = 0; bi < 4; ++bi) { const int blk = bi < 3 ? sel[bi] : own;
#pragma unroll
            for (int i = 0; i < 4; ++i) { const int key = blk * 256 + i * 64 + lane; const float pr = __expf(sc[bi * 4 + i] - mx);
                if (pr > 0.f) { const GAS v4u* vp = (const GAS v4u*)(Z + (rowbase + key) * NIN + ZV + h * HD); l += pr;
#pragma unroll
                    for (int j = 0; j < 8; ++j) { const v4u w = vp[j];
                        o[8 * j + 0] += pr * bflo(w.x); o[8 * j + 1] += pr * bfhi(w.x); o[8 * j + 2] += pr * bflo(w.y); o[8 * j + 3] += pr * bfhi(w.y); o[8 * j + 4] += pr * bflo(w.z); o[8 * j + 5] += pr * bfhi(w.z); o[8 * j + 6] += pr * bflo(w.w); o[8 * j + 7] += pr * bfhi(w.w); } } } }
        l = wave_sum(l);
        float res = 0.f;
#pragma unroll
        for (int hp = 0; hp < 2; ++hp) {
#pragma unroll
            for (int d = 0; d < 32; ++d) red[lane * 33 + d] = o[hp * 32 + d];
            LDS_WAIT(); asm volatile("" ::: "memory");
            float part = 0.f; const int dc = lane & 31, r0 = (lane >> 5) * 32;
#pragma unroll 8
            for (int r = 0; r < 32; ++r) part += red[(r0 + r) * 33 + dc];
            part += __shfl_xor(part, 32);
            if ((lane >> 5) == hp) res = part;
            LDS_WAIT(); asm volatile("" ::: "memory");
        }
        Y[(rowbase + t) * D + RW + h * HD + lane] = (bf16)f2bf(res / l);
    }
}
__device__ __forceinline__ void rwkv_post_simple(Frame& F) {
    const bf16* yr = (const bf16*)(F.ws + WS_YRAW); const bf16* aV = (const bf16*)(F.ws + WS_PV); const bf16* aG = (const bf16*)(F.ws + WS_GATE); const float* bon = (const float*)(F.ws + WS_BON);
    bf16* Y = (bf16*)(F.ws + WS_Y); const float* lnw = F.in[13]; const float* lnb = F.in[14];
    const int gw = F.vcu * NWAVES + F.wave, NGW = F.G * NWAVES;
    for (int u = gw; u < M * NH; u += NGW) { const int m = u >> 3, h = u & 7, c = h * HD + F.lane; const size_t o = (size_t)m * RW + c;
        const float y = bf2f(yr[o]); const float mean = wave_sum(y) * (1.f / 64.f); const float dlt = y - mean; const float var = wave_sum(dlt * dlt) * (1.f / 64.f);
        const float yn = dlt * (1.f / sqrtf(var + GN_EPS)) * lnw[c] + lnb[c];
        const float outv = (yn + bon[u] * bf2f(aV[o])) * bf2f(aG[o]);
        Y[(size_t)m * D + c] = (bf16)f2bf(outv); }
}
__device__ __forceinline__ void final_norm(Frame& F) {
    float* out = (float*)F.dout; const float* ss = (const float*)(F.ws + WS_SS) + (size_t)2 * M * 16; const float* g = F.in[24];
    const int gw = F.vcu * NWAVES + F.wave, NGW = F.G * NWAVES;
    for (int m = gw; m < M; m += NGW) { const float rstd = pg8::row_rstd(ss, (size_t)m);
        GAS f32x4* o = (GAS f32x4*)(out + (size_t)m * D) + F.lane; const GAS f32x4* gr = (const GAS f32x4*)g + F.lane;
#pragma unroll
        for (int j = 0; j < 4; ++j) { f32x4 v = o[64 * j]; const f32x4 gg = gr[64 * j]; v = v * rstd * gg; o[64 * j] = v; } }
}
namespace attn_body {
typedef unsigned short bf16;
using bf16x8=__attribute__((ext_vector_type(8)))short;
using s16x4=__attribute__((ext_vector_type(4)))short;
using f32x16=__attribute__((ext_vector_type(16)))float;
using u32x4=__attribute__((ext_vector_type(4)))unsigned;
constexpr int SEQ=8192,D=64,QP=3328,OP=1024;
constexpr int NW=8,QBLK=32,QB=QBLK*NW,KVBLK=64,NQB=SEQ/QB;
__device__ __forceinline__ int crow(int r,int hi){return (r&3)+8*(r>>2)+4*hi;}
#define SBAR() __builtin_amdgcn_sched_barrier(0)
__device__ __forceinline__ void cmask(f32x16&p0,f32x16&p1,int jb,int qrel,int hi){
  const float NEG=-INFINITY; int kb=64*jb+4*hi;
  #pragma unroll
  for(int r=0;r<16;++r){int kv=kb+(r&3)+8*(r>>2); if(kv>qrel)p0[r]=NEG; if(kv+32>qrel)p1[r]=NEG;}
}

constexpr int NSLOT=3, SLOTB=8192;
constexpr int LDS_K=0, LDS_V=NSLOT*SLOTB, LDS_WS=2*NSLOT*SLOTB, LDS_OST=LDS_WS+NW*64*4, LDS_BYTES=LDS_OST+NW*4096;
constexpr float C2=0.125f*1.4426950408889634f;
__device__ __forceinline__ void glds16(const void*gsrc,unsigned lds_dst){unsigned keep;
  asm volatile("s_mov_b32 %0, m0\n\ts_mov_b32 m0, %2\n\ts_nop 0\n\tglobal_load_lds_dwordx4 %1, off\n\ts_mov_b32 m0, %0":"=&s"(keep):"v"(gsrc),"s"(lds_dst):"memory");}
__device__ __forceinline__ float max3f(float a,float b,float c){float r;asm("v_max3_f32 %0, %1, %2, %3":"=v"(r):"v"(a),"v"(b),"v"(c));return r;}
__device__ __forceinline__ float max2f(float a,float b){float r;asm("v_max_f32_e32 %0, %1, %2":"=v"(r):"v"(a),"v"(b));return r;}
__device__ __forceinline__ float fadd_s(float a,float b){float r;asm("v_add_f32_e32 %0, %1, %2":"=v"(r):"v"(a),"v"(b));return r;}
__device__ __forceinline__ float fsub_s(float a,float b){float r;asm("v_sub_f32_e32 %0, %1, %2":"=v"(r):"v"(a),"v"(b));return r;}
typedef float f32x2_t __attribute__((ext_vector_type(2))); typedef __bf16 bf16x2_t __attribute__((ext_vector_type(2)));
__device__ __forceinline__ unsigned cvtpk_s(float lo,float hi){f32x2_t v={lo,hi};bf16x2_t b=__builtin_convertvector(v,bf16x2_t);return __builtin_bit_cast(unsigned,b);}
#define WAIT_BAR(N) asm volatile("s_waitcnt vmcnt(" #N ") lgkmcnt(0)\n\ts_barrier":::"memory")

__device__ __forceinline__ void qkt(f32x16&p0,f32x16&p1,const char*Kslot,const bf16x8*qr,const f32x16&negm,int r32,int hi){
  const char*kb=Kslot+hi*1024+r32*16;
  #pragma unroll
  for(int d0=0;d0<4;++d0){
    const bf16x8 b0=*reinterpret_cast<const bf16x8*>(kb+d0*2048);
    const bf16x8 b1=*reinterpret_cast<const bf16x8*>(kb+d0*2048+512);
    if(d0==0){p0=__builtin_amdgcn_mfma_f32_32x32x16_bf16(b0,qr[0],negm,0,0,0);p1=__builtin_amdgcn_mfma_f32_32x32x16_bf16(b1,qr[0],negm,0,0,0);}
    else{p0=__builtin_amdgcn_mfma_f32_32x32x16_bf16(b0,qr[d0],p0,0,0,0);p1=__builtin_amdgcn_mfma_f32_32x32x16_bf16(b1,qr[d0],p1,0,0,0);}}
}
typedef __attribute__((address_space(3))) const char* lds_cptr;
typedef short v4i16_t __attribute__((ext_vector_type(4)));
__device__ __forceinline__ void kload8(bf16x8*kf,lds_cptr kp){
  kf[0]=*(const __attribute__((address_space(3))) bf16x8*)(kp);      kf[1]=*(const __attribute__((address_space(3))) bf16x8*)(kp+512);
  kf[2]=*(const __attribute__((address_space(3))) bf16x8*)(kp+2048); kf[3]=*(const __attribute__((address_space(3))) bf16x8*)(kp+2560);
  kf[4]=*(const __attribute__((address_space(3))) bf16x8*)(kp+4096); kf[5]=*(const __attribute__((address_space(3))) bf16x8*)(kp+4608);
  kf[6]=*(const __attribute__((address_space(3))) bf16x8*)(kp+6144); kf[7]=*(const __attribute__((address_space(3))) bf16x8*)(kp+6656);
}
__device__ __forceinline__ void kload2(bf16x8*kf,lds_cptr kp,int j){ kf[2*j]=*(const __attribute__((address_space(3))) bf16x8*)(kp+j*2048); kf[2*j+1]=*(const __attribute__((address_space(3))) bf16x8*)(kp+j*2048+512); }
__device__ __forceinline__ s16x4 vtr(lds_cptr p){ return __builtin_bit_cast(s16x4,__builtin_amdgcn_ds_read_tr16_b64_v4i16((__attribute__((address_space(3))) v4i16_t*)p)); }
__device__ __forceinline__ float rowmax(const f32x16&p0,const f32x16&p1){
  float a=max3f(p0[0],p0[1],p1[0]),b=max3f(p0[2],p0[3],p1[1]);a=max3f(a,p1[2],p1[3]);
  #pragma unroll
  for(int r=4;r<16;r+=4){a=max3f(a,p0[r],p0[r+1]);b=max3f(b,p0[r+2],p0[r+3]);a=max3f(a,p1[r],p1[r+1]);b=max3f(b,p1[r+2],p1[r+3]);}
  const float m=max2f(a,b);
  auto rr=__builtin_amdgcn_permlane32_swap(__float_as_uint(m),__float_as_uint(m),false,false);
  return max2f(__uint_as_float(rr[0]),__uint_as_float(rr[1]));
}
__device__ __forceinline__ void pv(f32x16*o,int vb,bf16x8 pa0,bf16x8 pa1,bf16x8 pa2,bf16x8 pa3){
  #pragma unroll
  for(int d0=0;d0<2;++d0){s16x4 lo[4],hi[4];
    #pragma unroll
    for(int ks=0;ks<4;++ks){
      asm volatile("ds_read_b64_tr_b16 %0,%1 offset:%c2":"=&v"(lo[ks]):"v"(vb),"i"(d0*4096+ks*1024):"memory");
      asm volatile("ds_read_b64_tr_b16 %0,%1 offset:%c2":"=&v"(hi[ks]):"v"(vb),"i"(d0*4096+ks*1024+512):"memory");}
    asm volatile("s_waitcnt lgkmcnt(0)":::"memory");SBAR();
    #define PK(k) (bf16x8){lo[k][0],lo[k][1],lo[k][2],lo[k][3],hi[k][0],hi[k][1],hi[k][2],hi[k][3]}
    o[d0]=__builtin_amdgcn_mfma_f32_32x32x16_bf16(pa0,PK(0),o[d0],0,0,0);
    o[d0]=__builtin_amdgcn_mfma_f32_32x32x16_bf16(pa1,PK(1),o[d0],0,0,0);
    o[d0]=__builtin_amdgcn_mfma_f32_32x32x16_bf16(pa2,PK(2),o[d0],0,0,0);
    o[d0]=__builtin_amdgcn_mfma_f32_32x32x16_bf16(pa3,PK(3),o[d0],0,0,0);
    #undef PK
  }
}

#ifndef ATTN_STORE16
#define ATTN_STORE16(p,v) (*(u32x4*)(p)=(v))
#endif
template<int THRL> __device__ __forceinline__ void attn_unit(int b,int h,int qb,const bf16*Q,const bf16*__restrict__ K,const bf16*__restrict__ V,bf16*O,const float*__restrict__ KMbh,char*shm,const int wid,const int lane){
  const int r32=lane&31,hi=lane>>5;
  const long rowbase=(long)b*SEQ; const int q0=qb*QB;
  const bf16*Qw=Q+(rowbase+q0+wid*QBLK)*QP+h*D;
  const bf16*Kh=K+rowbase*QP+h*D,*Vh=V+rowbase*QP+h*D;
  unsigned selmask=0u;
  { f32x16 g=f32x16{}; bf16x8 qg[4];
    #pragma unroll
    for(int d0=0;d0<4;++d0)qg[d0]=*reinterpret_cast<const bf16x8*>(&Qw[(long)r32*QP+d0*16+hi*8]);
    #pragma unroll
    for(int d0=0;d0<4;++d0){ const float4 a0=*reinterpret_cast<const float4*>(KMbh+r32*64+d0*16+hi*8), a1=*reinterpret_cast<const float4*>(KMbh+r32*64+d0*16+hi*8+4);
      u32x4 pk; pk[0]=cvtpk_s(a0.x,a0.y); pk[1]=cvtpk_s(a0.z,a0.w); pk[2]=cvtpk_s(a1.x,a1.y); pk[3]=cvtpk_s(a1.z,a1.w);
      g=__builtin_amdgcn_mfma_f32_32x32x16_bf16(__builtin_bit_cast(bf16x8,pk),qg[d0],g,0,0,0); }
    #pragma unroll
    for(int r=0;r<16;++r){ if(crow(r,hi)>=qb) g[r]=-INFINITY; }
    #pragma unroll
    for(int n=0;n<3;++n){ float bv=-INFINITY; int bi=64;
      #pragma unroll
      for(int r=0;r<16;++r){ if(g[r]>bv){bv=g[r];bi=crow(r,hi);} }
      const float pv_=__shfl_xor(bv,32); const int pi_=__shfl_xor(bi,32);
      const bool mine=(bv>pv_)||(bv==pv_&&bi<pi_); const float wv=mine?bv:pv_; const int wi=mine?bi:pi_;
      if(wv>-INFINITY){ selmask|=1u<<wi;
        #pragma unroll
        for(int r=0;r<16;++r){ if(crow(r,hi)==wi) g[r]=-INFINITY; } } }
    selmask|=1u<<qb; }
  asm volatile("":"+v"(selmask)); SBAR();
  const unsigned lds0=(unsigned)(uintptr_t)shm;
  float*wsf=(float*)(shm+LDS_WS)+wid*64;
  const bf16*ksrc=Kh+(long)lane*QP+wid*8;
  const bf16*vsrc=Vh+(long)(16*(wid&3)+(lane>>2))*QP+(wid>>2)*32+(lane&3)*8;
  const unsigned kdst=lds0+LDS_K+wid*1024, vdst=lds0+LDS_V+wid*1024;
  #define DMA_K(t,slot) glds16(ksrc+(long)(t)*KVBLK*QP,(unsigned)__builtin_amdgcn_readfirstlane(kdst+(slot)))
  #define DMA_V(t,slot) glds16(vsrc+(long)(t)*KVBLK*QP,(unsigned)__builtin_amdgcn_readfirstlane(vdst+(slot)))
  const int vb0=(int)(lds0+LDS_V)+((lane>>4)&1)*32+(lane&3)*8+(4*hi+((lane&15)>>2))*64;
  const char*Kbase=shm+LDS_K; bf16x8 kf[8];
  const lds_cptr shm3=(lds_cptr)shm; const lds_cptr kp0=shm3+LDS_K+hi*1024+r32*16; const lds_cptr vp0=shm3+LDS_V+((lane>>4)&1)*32+(lane&3)*8+(4*hi+((lane&15)>>2))*64;
  const int NT=(q0+QB)/KVBLK;
  DMA_K(0,0);DMA_V(0,0);DMA_K(1,SLOTB);
  bf16x8 qr[4];
  #pragma unroll
  for(int d0=0;d0<4;++d0)qr[d0]=*reinterpret_cast<const bf16x8*>(&Qw[(long)r32*QP+d0*16+hi*8]);
  float nok=((selmask&1u)!=0u||qb==0)?0.f:-INFINITY;
  float mhat=0.f,l_reg=0.f;f32x16 o[2];o[0]=f32x16{};o[1]=f32x16{};f32x16 negm;
  _Pragma("unroll") for(int r=0;r<16;++r)negm[r]=nok; asm volatile("":"+v"(negm));
  const int qrel=wid*QBLK+r32;
  #define CMASK(P0,P1,t) do{int jb_=(t)-(NT-4); if(jb_>=0)cmask(P0,P1,jb_,qrel,hi);}while(0)
  bool resc=false;
  #define START(P0,P1) do{ const float rm=rowmax(P0,P1); resc=false; \
    { const float dl=(rm==-INFINITY)?0.f:rm; mhat=fadd_s(mhat,dl); \
      _Pragma("unroll") for(int r=0;r<16;++r){P0[r]=fsub_s(P0[r],dl);P1[r]=fsub_s(P1[r],dl);} \
      { const float cv_=nok-mhat; _Pragma("unroll") for(int r=0;r<16;++r)negm[r]=cv_; } asm volatile("":"+v"(negm)); } \
    _Pragma("unroll") for(int r=0;r<16;++r)P0[r]=__builtin_amdgcn_exp2f(P0[r]); }while(0)
  #define RESC() do{ if(resc){ asm volatile("s_waitcnt lgkmcnt(0)":::"memory"); \
      _Pragma("unroll") for(int d_=0;d_<2;++d_) _Pragma("unroll") for(int r=0;r<16;++r)o[d_][r]*=wsf[crow(r,hi)]; } }while(0)
  f32x16 pA0,pA1,pB0,pB1;
  int sl_prev=0,sl_cur=0,sl_next=SLOTB;
  #define ROT() do{sl_prev=sl_cur;sl_cur=sl_next;sl_next=(sl_next==(NSLOT-1)*SLOTB)?0:sl_next+SLOTB;}while(0)
  DMA_K(2,2*SLOTB);
  WAIT_BAR(3);
  qkt(pA0,pA1,Kbase,qr,negm,r32,hi);asm volatile("s_nop 15\n\ts_nop 7":"+v"(pA0),"+v"(pA1));CMASK(pA0,pA1,0);
  START(pA0,pA1);
  _Pragma("unroll") for(int r=0;r<16;++r)pA1[r]=__builtin_amdgcn_exp2f(pA1[r]);
  WAIT_BAR(0);
  DMA_K(3,0);DMA_V(1,SLOTB);
  ROT();
  kload8(kf,kp0+sl_cur);
  WAIT_BAR(2);
  s16x4 vlo[8],vhi[8]; u32x4 pw0,pw1,pw2,pw3;
  #define PKW(P,B) cvtpk_s(P[B],P[B+1])
  #define PAF(k) __builtin_bit_cast(bf16x8,pw##k)
  #define VFR(i) (bf16x8){vlo[i][0],vlo[i][1],vlo[i][2],vlo[i][3],vhi[i][0],vhi[i][1],vhi[i][2],vhi[i][3]}
  #define PIN(x) asm volatile("":"+v"(x))
  #define MX3(a,b,c) __builtin_fmaxf(__builtin_fmaxf((a),(b)),(c))
  #define GAPA(MF,A0,A1,A2,A3,W0,W1,PW) do{ MF; sacc+=A0; sacc+=A1; sacc+=A2; sacc+=A3; PIN(sacc); W0; W1; PIN(PW); SBAR(); }while(0)
  #define EX(v) __builtin_amdgcn_exp2f(v)
  #define GAPB(MF,X,B) do{ MF; X[B]=EX(X[B]); X[B+1]=EX(X[B+1]); X[B+2]=EX(X[B+2]); X[B+3]=EX(X[B+3]); PIN(X); SBAR(); }while(0)
  #define VRD(i) do{ vlo[i]=vtr(vp_+(((i)>>2)*4096+((i)&3)*1024)); vhi[i]=vtr(vp_+(((i)>>2)*4096+((i)&3)*1024+512)); }while(0)
  #define KRD(G,j) do{ if(G){ kload2(kf,kp0+sl_next,j); SBAR(); } }while(0)
  #define STEP(C0,C1,P0,P1,t,GK,GV,GL) do{ SBAR(); \
    const lds_cptr vp_=vp0+sl_prev; \
    VRD(0); SBAR(); float sacc=(P0[0]+P0[1]); \
    GAPA(C0=__builtin_amdgcn_mfma_f32_32x32x16_bf16(kf[0],qr[0],negm,0,0,0), P0[2],P0[3],P0[4],P0[5],     pw0[0]=PKW(P0,0), pw0[1]=PKW(P0,2), pw0); \
    VRD(4); SBAR(); GAPA(C1=__builtin_amdgcn_mfma_f32_32x32x16_bf16(kf[1],qr[0],negm,0,0,0), P0[6],P0[7],P0[8],P0[9],     pw0[2]=PKW(P0,4), pw0[3]=PKW(P0,6), pw0); \
    VRD(1); SBAR(); GAPA(C0=__builtin_amdgcn_mfma_f32_32x32x16_bf16(kf[2],qr[1],C0,0,0,0),   P0[10],P0[11],P0[12],P0[13], pw1[0]=PKW(P0,8), pw1[1]=PKW(P0,10), pw1); \
    VRD(5); SBAR(); GAPA(C1=__builtin_amdgcn_mfma_f32_32x32x16_bf16(kf[3],qr[1],C1,0,0,0),   P0[14],P0[15],P1[0],P1[1],   pw1[2]=PKW(P0,12),pw1[3]=PKW(P0,14), pw1); \
    VRD(2); SBAR(); GAPA(C0=__builtin_amdgcn_mfma_f32_32x32x16_bf16(kf[4],qr[2],C0,0,0,0),   P1[2],P1[3],P1[4],P1[5],     pw2[0]=PKW(P1,0), pw2[1]=PKW(P1,2), pw2); \
    VRD(6); SBAR(); GAPA(C1=__builtin_amdgcn_mfma_f32_32x32x16_bf16(kf[5],qr[2],C1,0,0,0),   P1[6],P1[7],P1[8],P1[9],     pw2[2]=PKW(P1,4), pw2[3]=PKW(P1,6), pw2); \
    VRD(3); SBAR(); GAPA(C0=__builtin_amdgcn_mfma_f32_32x32x16_bf16(kf[6],qr[3],C0,0,0,0),   P1[10],P1[11],P1[12],P1[13], pw3[0]=PKW(P1,8), pw3[1]=PKW(P1,10), pw3); \
    VRD(7); SBAR(); GAPA(C1=__builtin_amdgcn_mfma_f32_32x32x16_bf16(kf[7],qr[3],C1,0,0,0),   P1[14],P1[15],0.f,0.f,       pw3[2]=PKW(P1,12),pw3[3]=PKW(P1,14), pw3); \
    l_reg+=sacc; \
    if(GK){DMA_K((t)+3,sl_cur);} if(GV){DMA_V((t)+1,sl_next);} \
    CMASK(C0,C1,t); \
    { float a=MX3(C0[0],C0[1],C1[0]),b=MX3(C0[2],C0[3],C1[1]); a=MX3(a,C1[2],C1[3]); \
      _Pragma("unroll") for(int r=4;r<16;r+=4){a=MX3(a,C0[r],C0[r+1]);b=MX3(b,C0[r+2],C0[r+3]);a=MX3(a,C1[r],C1[r+1]);b=MX3(b,C1[r+2],C1[r+3]);} \
      float rm=__builtin_fmaxf(a,b); { auto rr=__builtin_amdgcn_permlane32_swap(__float_as_uint(rm),__float_as_uint(rm),false,false); rm=__builtin_fmaxf(__uint_as_float(rr[0]),__uint_as_float(rr[1])); } \
      resc=false; \
      if(__builtin_expect(__any(rm>(float)THRL),0)){ const float dl=__builtin_fmaxf(rm,0.f); mhat+=dl; \
        _Pragma("unroll") for(int r=0;r<16;++r){C0[r]-=dl;C1[r]-=dl;} \
        { const float cv_=nok-mhat; _Pragma("unroll") for(int r=0;r<16;++r)negm[r]=cv_; } asm volatile("":"+v"(negm)); \
        const float f=__builtin_amdgcn_exp2f(-dl); l_reg*=f; if(hi==0)wsf[r32]=f; resc=true; } } \
    SBAR(); \
    GAPB(o[0]=__builtin_amdgcn_mfma_f32_32x32x16_bf16(PAF(0),VFR(0),o[0],0,0,0), C0,0); \
    GAPB(o[1]=__builtin_amdgcn_mfma_f32_32x32x16_bf16(PAF(0),VFR(4),o[1],0,0,0), C0,4); \
    KRD(GL,0); GAPB(o[0]=__builtin_amdgcn_mfma_f32_32x32x16_bf16(PAF(1),VFR(1),o[0],0,0,0), C0,8); \
    KRD(GL,1); GAPB(o[1]=__builtin_amdgcn_mfma_f32_32x32x16_bf16(PAF(1),VFR(5),o[1],0,0,0), C0,12); \
    KRD(GL,2); GAPB(o[0]=__builtin_amdgcn_mfma_f32_32x32x16_bf16(PAF(2),VFR(2),o[0],0,0,0), C1,0); \
    KRD(GL,3); GAPB(o[1]=__builtin_amdgcn_mfma_f32_32x32x16_bf16(PAF(2),VFR(6),o[1],0,0,0), C1,4); \
    GAPB(o[0]=__builtin_amdgcn_mfma_f32_32x32x16_bf16(PAF(3),VFR(3),o[0],0,0,0), C1,8); \
    GAPB(o[1]=__builtin_amdgcn_mfma_f32_32x32x16_bf16(PAF(3),VFR(7),o[1],0,0,0), C1,12); \
    }while(0)
  #define MASKUPD(tt) do{ if((((tt))&3)==0){ nok=((selmask>>((tt)>>2))&1u)?0.f:-INFINITY; const float cv_=nok-mhat; _Pragma("unroll") for(int r=0;r<16;++r)negm[r]=cv_; asm volatile("":"+v"(negm)); } }while(0)
  int t=1;
  #undef CMASK
  #define CMASK(P0,P1,t) do{}while(0)
  for(;t+5<NT;t+=2){
    STEP(pB0,pB1,pA0,pA1,t,true,true,true);     WAIT_BAR(2); RESC(); ROT(); MASKUPD(t+1);
    STEP(pA0,pA1,pB0,pB1,t+1,true,true,true);   WAIT_BAR(2); RESC(); ROT();
  }
  #undef CMASK
  #define CMASK(P0,P1,t) do{int jb_=(t)-(NT-4); if(jb_>=0)cmask(P0,P1,jb_,qrel,hi);}while(0)
  #define ENDW(tt) do{ if((tt)+3<NT){WAIT_BAR(2);} else if((tt)+2<NT){WAIT_BAR(1);} else {WAIT_BAR(0);} }while(0)
  for(;t+1<NT;t+=2){
    STEP(pB0,pB1,pA0,pA1,t,(t+3<NT),(t+1<NT),(t+1<NT));       ENDW(t);   RESC(); ROT(); MASKUPD(t+1);
    STEP(pA0,pA1,pB0,pB1,t+1,(t+4<NT),(t+2<NT),(t+2<NT));     ENDW(t+1); RESC(); ROT();
  }
  STEP(pB0,pB1,pA0,pA1,NT-1,false,false,false); RESC();
  { float sacc=pB0[0]+pB0[1]; _Pragma("unroll") for(int r=2;r<16;++r)sacc+=pB0[r]; _Pragma("unroll") for(int r=0;r<16;++r)sacc+=pB1[r]; l_reg+=sacc;
    pw0=(u32x4){PKW(pB0,0),PKW(pB0,2),PKW(pB0,4),PKW(pB0,6)};pw1=(u32x4){PKW(pB0,8),PKW(pB0,10),PKW(pB0,12),PKW(pB0,14)};pw2=(u32x4){PKW(pB1,0),PKW(pB1,2),PKW(pB1,4),PKW(pB1,6)};pw3=(u32x4){PKW(pB1,8),PKW(pB1,10),PKW(pB1,12),PKW(pB1,14)};
    SBAR(); pv(o,vb0+sl_cur,PAF(0),PAF(1),PAF(2),PAF(3)); }
  #undef PKW
  #undef PAF
  #undef VFR
  #undef PIN
  #undef MX3
  #undef GAPA
  #undef GAPB
  #undef EX
  #undef VRD
  #undef KRD
  #undef STEP
  #undef ENDW
  #undef MASKUPD
  {auto rr=__builtin_amdgcn_permlane32_swap(__float_as_uint(l_reg),__float_as_uint(l_reg),false,false);l_reg=__uint_as_float(rr[0])+__uint_as_float(rr[1]);}
  if(hi==0)wsf[32+r32]=l_reg;asm volatile("s_waitcnt lgkmcnt(0)":::"memory");
  float rli[16];
  #pragma unroll
  for(int r=0;r<16;++r)rli[r]=__builtin_amdgcn_rcpf(wsf[32+crow(r,hi)]);
  bf16*Ow=O+(rowbase+q0+wid*QBLK)*OP+h*D;
  { bf16*stg=(bf16*)(shm+LDS_OST)+wid*2048;
    #pragma unroll
    for(int r=0;r<16;++r){const int orow=crow(r,hi);
      #pragma unroll
      for(int d0=0;d0<2;++d0)stg[orow*64+d0*32+r32]=(bf16)(cvtpk_s(o[d0][r]*rli[r],0.f)&0xffffu);}
    asm volatile("s_waitcnt lgkmcnt(0)":::"memory");
    #pragma unroll
    for(int i=0;i<4;++i){const int row=i*8+(lane>>3),ch=lane&7; const u32x4 v=*(const u32x4*)(stg+row*64+ch*8); ATTN_STORE16(Ow+(long)row*OP+ch*8,v);} }
  asm volatile("s_waitcnt lgkmcnt(0)\n\ts_barrier":::"memory");
  #undef DMA_K
  #undef DMA_V
  #undef CMASK
  #undef START
  #undef RESC
  #undef ROT
}
constexpr int ATTN_LDS_BYTES=LDS_BYTES;
#undef SBAR
#undef WAIT_BAR
}
namespace rscan {
typedef short bf16x8 __attribute__((ext_vector_type(8)));
typedef float f32x4 __attribute__((ext_vector_type(4)));
typedef float f32x16 __attribute__((ext_vector_type(16)));
typedef unsigned u32x2 __attribute__((ext_vector_type(2)));
typedef unsigned u32x4 __attribute__((ext_vector_type(4)));
constexpr int LS = 144;
constexpr int LB = 64 * LS;
constexpr int NCHUNK = T / 64;
__device__ __forceinline__ unsigned pkbf(float lo, float hi) { typedef float f2 __attribute__((ext_vector_type(2))); typedef __bf16 b2 __attribute__((ext_vector_type(2))); f2 v = {lo, hi}; return __builtin_bit_cast(unsigned, __builtin_convertvector(v, b2)); }

__device__ __forceinline__ void mm(f32x4 (&acc)[2], LAS unsigned char* lds, int z1, int z2, int ta, int tbh, int fr, int fq) {
    const LAS unsigned char* p1 = lds + z1 + (16 * ta + fr) * LS + fq * 16;
    const LAS unsigned char* p2 = lds + z2 + (32 * tbh + fr) * LS + fq * 16;
    const bf16x8 a0 = *(const LAS bf16x8*)(p1), a1 = *(const LAS bf16x8*)(p1 + 64);
    const bf16x8 b00 = *(const LAS bf16x8*)(p2), b01 = *(const LAS bf16x8*)(p2 + 64), b10 = *(const LAS bf16x8*)(p2 + 16 * LS), b11 = *(const LAS bf16x8*)(p2 + 16 * LS + 64);
    acc[0] = __builtin_amdgcn_mfma_f32_16x16x32_bf16(a0, b00, acc[0], 0, 0, 0); acc[0] = __builtin_amdgcn_mfma_f32_16x16x32_bf16(a1, b01, acc[0], 0, 0, 0);
    acc[1] = __builtin_amdgcn_mfma_f32_16x16x32_bf16(a0, b10, acc[1], 0, 0, 0); acc[1] = __builtin_amdgcn_mfma_f32_16x16x32_bf16(a1, b11, acc[1], 0, 0, 0);
}
template <int MASK, bool DIAG1> __device__ __forceinline__ void st_lds(const f32x4 (&acc)[2], LAS unsigned char* lds, int dst, int ta, int tbh, int fr, int fq) {
#pragma unroll
    for (int tb = 0; tb < 2; ++tb) { const int b = 32 * tbh + 16 * tb + fr, a0 = 16 * ta + 4 * fq; float v[4];
#pragma unroll
        for (int i = 0; i < 4; ++i) { const int a = a0 + i; float x = acc[tb][i];
            if (MASK == 1) x = (a < b) ? x : 0.f; if (MASK == 2) x = (a <= b) ? x : 0.f; if (MASK == 3) x = (b < a) ? x : 0.f; if (DIAG1) x = (a == b) ? 1.f : x; v[i] = x; }
        u32x2 w; w.x = pkbf(v[0], v[1]); w.y = pkbf(v[2], v[3]); *(LAS u32x2*)(lds + dst + b * LS + a0 * 2) = w; }
}
template <bool PERM> __device__ __forceinline__ void st_glb(const f32x4 (&acc)[2], bf16* g, int ta, int tbh, int fr, int fq) {
#pragma unroll
    for (int tb = 0; tb < 2; ++tb) { const int b = 32 * tbh + 16 * tb + fr; int a0 = 16 * ta + 4 * fq; if (PERM) a0 = (a0 & ~12) | ((a0 & 4) << 1) | ((a0 & 8) >> 1);
        u32x2 w; w.x = pkbf(acc[tb][0], acc[tb][1]); w.y = pkbf(acc[tb][2], acc[tb][3]); *(GAS u32x2*)(g + (size_t)b * RW + a0) = w; }
}

constexpr int LS2 = 272;
__device__ __forceinline__ void mm128(f32x4 (&acc)[2], LAS unsigned char* lds, int z1, int z2, int ta, int tbh, int fr, int fq) {
    const LAS unsigned char* p1 = lds + z1 + (16 * ta + fr) * LS2 + fq * 16;
    const LAS unsigned char* p2 = lds + z2 + (32 * tbh + fr) * LS2 + fq * 16;
#pragma unroll
    for (int s = 0; s < 4; ++s) { const bf16x8 a = *(const LAS bf16x8*)(p1 + 64 * s), b0 = *(const LAS bf16x8*)(p2 + 64 * s), b1 = *(const LAS bf16x8*)(p2 + 16 * LS2 + 64 * s);
        acc[0] = __builtin_amdgcn_mfma_f32_16x16x32_bf16(a, b0, acc[0], 0, 0, 0); acc[1] = __builtin_amdgcn_mfma_f32_16x16x32_bf16(a, b1, acc[1], 0, 0, 0); }
}
__device__ __forceinline__ void st_lds_f32(const f32x4 (&acc)[2], LAS unsigned char* lds, int dst, int ta, int tbh, int fr, int fq) {
#pragma unroll
    for (int tb = 0; tb < 2; ++tb) { const int b = 32 * tbh + 16 * tb + fr, a0 = 16 * ta + 4 * fq; *(LAS f32x4*)(lds + dst + b * LS2 + a0 * 4) = acc[tb]; }
}

__device__ __forceinline__ void scan_pre(Frame& F) {
    LAS unsigned char* lds = F.lds + RING_OFF;
    const int w = F.wave, lane = F.lane, fr = lane & 15, fq = lane >> 4, ta = w & 3, tbh = w >> 2;
    const bf16* Z = (const bf16*)(F.ws + WS_Z); const float* mu = F.in[4];
    const bf16* WupT = (const bf16*)(F.ws + WS_LORA); const bf16* AupT = WupT + RW * 64; const bf16* GupT = AupT + RW * 64;
    bf16* aLW = (bf16*)(F.dout + DO_W); bf16* aKP = (bf16*)(F.dout + DO_KP); bf16* aKK = (bf16*)(F.dout + DO_KKN); bf16* aB = (bf16*)(F.dout + DO_B);
    bf16* oG = (bf16*)(F.ws + WS_GATE); float* oBon = (float*)(F.ws + WS_BON);
    enum { bAt = 0, bBt = LB, bKt = 2 * LB, bRt = 3 * LB, bAtT = 4 * LB, bVT = 5 * LB, bBhT = 6 * LB, bKhT = 7 * LB, b8 = 8 * LB, b9 = 9 * LB, b10 = 10 * LB, bAak = 11 * LB, bArb = 12 * LB, bArk = 13 * LB };
    enum { lXw = 0, lXa = LB, lXg = 2 * LB, lWw = 2 * LB + 64 * LS2, lWa = lWw + LB, lWg = lWa + LB, lDw = 8 * LB, lDa = lDw + 64 * LS2, lDg = lDa + 64 * LS2 };
    static_assert(lWg + 64 * LS2 <= 8 * LB && lDg + 64 * LS2 <= 14 * LB, "LoRA stage LDS carve");
    for (int u = F.vcu; u < BATCH * NH * NCHUNK; u += F.G) {
        const int c = u % NCHUNK, bh = u / NCHUNK, b = bh / NH, h = bh % NH;
        const size_t m0 = (size_t)b * T + (size_t)c * 64;
        const size_t so = m0 * RW + h * HD;
        { const int col = F.tid & 255, t0 = (F.tid >> 8) * 32; const bf16* zp = Z + (m0 + t0) * NIN + ZWD + col; const float mu_ = mu[ZWD + col];
          float prev = (c == 0 && t0 == 0) ? 0.f : bf2f(zp[-(long)NIN]);
          const int dbase = col < 64 ? lXw + col * 2 : (col < 128 ? lXa + (col - 64) * 2 : lXg + (col - 128) * 2); const int dstr = col < 128 ? LS : LS2;
          for (int i = 0; i < 32; ++i) { const float cur = bf2f(zp[(size_t)i * NIN]); const float zs = cur + (prev - cur) * mu_; prev = cur;
              const float val = col < 64 ? tanhf(zs) : (col < 128 ? zs : 1.f / (1.f + __expf(-zs)));
              *(LAS unsigned short*)(lds + dbase + (t0 + i) * dstr) = (unsigned short)f2bf(val); }
          { const int row = F.tid >> 3, ch = F.tid & 7;
            *(LAS u32x4*)(lds + lWw + row * LS + ch * 16) = *(const GAS u32x4*)(WupT + (size_t)(h * HD + row) * 64 + ch * 8);
            *(LAS u32x4*)(lds + lWa + row * LS + ch * 16) = *(const GAS u32x4*)(AupT + (size_t)(h * HD + row) * 64 + ch * 8); }
#pragma unroll
          for (int i = 0; i < 2; ++i) { const int p = F.tid + 512 * i, row = p >> 4, ch = p & 15; *(LAS u32x4*)(lds + lWg + row * LS2 + ch * 16) = *(const GAS u32x4*)(GupT + (size_t)(h * HD + row) * 128 + ch * 8); }
        }
        __syncthreads();
        { f32x4 acc[2];
          acc[0] = (f32x4){0.f, 0.f, 0.f, 0.f}; acc[1] = acc[0]; mm(acc, lds, lWw, lXw, ta, tbh, fr, fq); st_lds_f32(acc, lds, lDw, ta, tbh, fr, fq);
          acc[0] = (f32x4){0.f, 0.f, 0.f, 0.f}; acc[1] = acc[0]; mm(acc, lds, lWa, lXa, ta, tbh, fr, fq); st_lds_f32(acc, lds, lDa, ta, tbh, fr, fq);
          acc[0] = (f32x4){0.f, 0.f, 0.f, 0.f}; acc[1] = acc[0]; mm128(acc, lds, lWg, lXg, ta, tbh, fr, fq); st_lds_f32(acc, lds, lDg, ta, tbh, fr, fq); }
        __syncthreads();
        { const int cg = h * HD + lane;
          const float w0_ = F.in[5][cg], a0_ = F.in[7][cg], kkc = F.in[10][cg], kac = F.in[11][cg], rkc = F.in[12][cg], mur = mu[cg], muk = mu[ZK_R + cg], muv = mu[ZV_R + cg];
          float ltot = 0.f, lst = 0.f;
          for (int t = 0; t < 64; ++t) { if (t == 8 * w) lst = ltot; const float dw = w0_ + *(const LAS float*)(lds + lDw + t * LS2 + lane * 4); ltot += -DECAY_SCALE / (1.f + __expf(-dw)); }
          float L = lst; unsigned short pAtT[8], pVT[8], pBhT[8], pKhT[8];
          const bf16* zr = Z + (m0 + 8 * w) * NIN + cg; const bool first = (c == 0 && w == 0);
          float pr = first ? 0.f : bf2f(zr[-(long)NIN]), pk = first ? 0.f : bf2f(zr[-(long)NIN + ZK_R]), pv = first ? 0.f : bf2f(zr[-(long)NIN + ZV_R]);
#pragma unroll
          for (int i = 0; i < 8; ++i) { const int t = 8 * w + i; const size_t zo = (size_t)i * NIN;
              const float cr = bf2f(zr[zo]), ck = bf2f(zr[zo + ZK_R]), cv = bf2f(zr[zo + ZV_R]);
              const float r = cr + (pr - cr) * mur, kx = ck + (pk - ck) * muk, v = cv + (pv - cv) * muv; pr = cr; pk = ck; pv = cv;
              const float dw = w0_ + *(const LAS float*)(lds + lDw + t * LS2 + lane * 4), da = a0_ + *(const LAS float*)(lds + lDa + t * LS2 + lane * 4), gg = *(const LAS float*)(lds + lDg + t * LS2 + lane * 4);
              const float lw = -DECAY_SCALE / (1.f + __expf(-dw)), a = 1.f / (1.f + __expf(-da));
              const float kk = kx * kkc; const float nn = wave_sum(kk * kk); const float kkn = kk / fmaxf(sqrtf(nn), 1e-12f);
              const float kp = kx * (1.f + (a - 1.f) * kac), bb = kkn * a; const float bon = wave_sum(r * kp * rkc);
              oG[(m0 + t) * RW + cg] = (bf16)f2bf(gg); if (lane == 0) oBon[(m0 + t) * NH + h] = bon;
              const float Pm = __expf(L); L += lw; const float P = __expf(L), iP = __expf(-L), Ph = __expf(ltot - L);
              const unsigned short at = (unsigned short)f2bf(-kkn * Pm);
              *(LAS unsigned short*)(lds + bAt + t * LS + lane * 2) = at; *(LAS unsigned short*)(lds + bBt + t * LS + lane * 2) = (unsigned short)f2bf(bb * iP);
              *(LAS unsigned short*)(lds + bKt + t * LS + lane * 2) = (unsigned short)f2bf(kp * iP); *(LAS unsigned short*)(lds + bRt + t * LS + lane * 2) = (unsigned short)f2bf(r * P);
              pAtT[i] = at; pVT[i] = (unsigned short)f2bf(v); pBhT[i] = (unsigned short)f2bf(bb * Ph); pKhT[i] = (unsigned short)f2bf(kp * Ph); }
#define RS_W16(buf, p) do { u32x4 q_; q_.x = p[0] | ((unsigned)p[1] << 16); q_.y = p[2] | ((unsigned)p[3] << 16); q_.z = p[4] | ((unsigned)p[5] << 16); q_.w = p[6] | ((unsigned)p[7] << 16); *(LAS u32x4*)(lds + (buf) + lane * LS + 16 * w) = q_; } while (0)
          RS_W16(bAtT, pAtT); RS_W16(bVT, pVT); RS_W16(bBhT, pBhT); RS_W16(bKhT, pKhT);
#undef RS_W16
          asm volatile("" :: "v"(ltot));
          __syncthreads();
          f32x4 acc[2], tacc[2];
#define RS_Z(a) do { a[0] = (f32x4){0.f, 0.f, 0.f, 0.f}; a[1] = (f32x4){0.f, 0.f, 0.f, 0.f}; } while (0)
          RS_Z(acc); mm(acc, lds, bAt, bBt, ta, tbh, fr, fq); st_lds<3, false>(acc, lds, b9, ta, tbh, fr, fq);
          RS_Z(acc); mm(acc, lds, bKt, bAt, ta, tbh, fr, fq); st_lds<1, false>(acc, lds, bAak, ta, tbh, fr, fq);
          RS_Z(acc); mm(acc, lds, bBt, bRt, ta, tbh, fr, fq); st_lds<2, false>(acc, lds, bArb, ta, tbh, fr, fq);
          RS_Z(acc); mm(acc, lds, bKt, bRt, ta, tbh, fr, fq); st_lds<2, false>(acc, lds, bArk, ta, tbh, fr, fq);
          RS_Z(tacc); mm(tacc, lds, bBt, bAt, ta, tbh, fr, fq);
#pragma unroll
          for (int tb = 0; tb < 2; ++tb)
#pragma unroll
              for (int i = 0; i < 4; ++i) { const int bb_ = 32 * tbh + 16 * tb + fr, a = 16 * ta + 4 * fq + i; tacc[tb][i] = (a < bb_) ? tacc[tb][i] : 0.f; }
          st_lds<0, false>(tacc, lds, b8, ta, tbh, fr, fq);
#pragma unroll
          for (int tb = 0; tb < 2; ++tb)
#pragma unroll
              for (int i = 0; i < 4; ++i) { const int bb_ = 32 * tbh + 16 * tb + fr, a = 16 * ta + 4 * fq + i; if (a == bb_) tacc[tb][i] = 1.f; }
          st_lds<0, false>(tacc, lds, b10, ta, tbh, fr, fq);
          __syncthreads();
          RS_Z(acc); mm(acc, lds, b9, b8, ta, tbh, fr, fq); st_lds<0, false>(acc, lds, bAt, ta, tbh, fr, fq);
          RS_Z(acc); mm(acc, lds, b8, b9, ta, tbh, fr, fq); st_lds<0, false>(acc, lds, bBt, ta, tbh, fr, fq);
          __syncthreads();
          mm(tacc, lds, bBt, b10, ta, tbh, fr, fq); st_lds<0, false>(tacc, lds, bKt, ta, tbh, fr, fq);
          RS_Z(acc); mm(acc, lds, bBt, bAt, ta, tbh, fr, fq); st_lds<0, false>(acc, lds, b8, ta, tbh, fr, fq);
          RS_Z(acc); mm(acc, lds, bAt, bBt, ta, tbh, fr, fq); st_lds<0, false>(acc, lds, b9, ta, tbh, fr, fq);
          __syncthreads();
          mm(tacc, lds, b9, bKt, ta, tbh, fr, fq); st_lds<0, false>(tacc, lds, b10, ta, tbh, fr, fq);
          RS_Z(acc); mm(acc, lds, b9, b8, ta, tbh, fr, fq); st_lds<0, false>(acc, lds, bAt, ta, tbh, fr, fq);
          RS_Z(acc); mm(acc, lds, b8, b9, ta, tbh, fr, fq); st_lds<0, false>(acc, lds, bBt, ta, tbh, fr, fq);
          __syncthreads();
          mm(tacc, lds, bBt, b10, ta, tbh, fr, fq); st_lds<0, false>(tacc, lds, bKt, ta, tbh, fr, fq);
          RS_Z(acc); mm(acc, lds, bBt, bAt, ta, tbh, fr, fq); st_lds<0, false>(acc, lds, b8, ta, tbh, fr, fq);
          RS_Z(acc); mm(acc, lds, bAt, bBt, ta, tbh, fr, fq); st_lds<0, false>(acc, lds, b9, ta, tbh, fr, fq);
          __syncthreads();
          mm(tacc, lds, b9, bKt, ta, tbh, fr, fq); st_lds<0, false>(tacc, lds, b10, ta, tbh, fr, fq);
          RS_Z(acc); mm(acc, lds, b8, b9, ta, tbh, fr, fq); st_lds<0, false>(acc, lds, bBt, ta, tbh, fr, fq);
          __syncthreads();
          mm(tacc, lds, bBt, b10, ta, tbh, fr, fq); st_lds<0, false>(tacc, lds, bKt, ta, tbh, fr, fq);
          __syncthreads();
          RS_Z(acc); mm(acc, lds, bKt, bAtT, ta, tbh, fr, fq); st_lds<0, false>(acc, lds, bAt, ta, tbh, fr, fq);
          RS_Z(acc); mm(acc, lds, bAak, bVT, ta, tbh, fr, fq); st_lds<0, false>(acc, lds, b8, ta, tbh, fr, fq);
          __syncthreads();
          RS_Z(acc); mm(acc, lds, bKt, b8, ta, tbh, fr, fq); st_lds<0, false>(acc, lds, b9, ta, tbh, fr, fq);
          __syncthreads();
          RS_Z(acc); mm(acc, lds, bAt, bArb, ta, tbh, fr, fq);
#pragma unroll
          for (int tb = 0; tb < 2; ++tb) { const int bb_ = 32 * tbh + 16 * tb + fr, a0 = 16 * ta + 4 * fq; const u32x2 q_ = *(const LAS u32x2*)(lds + bRt + bb_ * LS + a0 * 2);
              acc[tb][0] += bflo(q_.x); acc[tb][1] += bfhi(q_.x); acc[tb][2] += bflo(q_.y); acc[tb][3] += bfhi(q_.y); }
          st_glb<false>(acc, aLW + so, ta, tbh, fr, fq);
          RS_Z(acc); mm(acc, lds, b9, bArb, ta, tbh, fr, fq); mm(acc, lds, bVT, bArk, ta, tbh, fr, fq); st_glb<false>(acc, aKK + so, ta, tbh, fr, fq);
          RS_Z(acc); mm(acc, lds, bAt, bBhT, ta, tbh, fr, fq);
          { const float pc = __expf(ltot);
#pragma unroll
            for (int tb = 0; tb < 2; ++tb) { const int bb_ = 32 * tbh + 16 * tb + fr; const float pcb = __shfl(pc, bb_);
#pragma unroll
                for (int i = 0; i < 4; ++i) { const int a = 16 * ta + 4 * fq + i; if (a == bb_) acc[tb][i] += pcb; } } }
          st_glb<true>(acc, aKP + so, ta, tbh, fr, fq);
          RS_Z(acc); mm(acc, lds, bBhT, b9, ta, tbh, fr, fq); mm(acc, lds, bKhT, bVT, ta, tbh, fr, fq); st_glb<false>(acc, aB + so, ta, tbh, fr, fq);
#undef RS_Z
          __syncthreads();
        }
    }
}

__device__ __forceinline__ void scan_seq(Frame& F, int bh) {
    const int lane = F.lane, r32 = lane & 31, hi = lane >> 5; const int b = bh / NH, h = bh % NH;
    const bf16* aM = (const bf16*)(F.dout + DO_KP); const bf16* aN = (const bf16*)(F.dout + DO_B); bf16* XS = (bf16*)(F.ws + WS_YRAW);
    f32x16 X[2][2];
#pragma unroll
    for (int i = 0; i < 2; ++i)
#pragma unroll
        for (int j = 0; j < 2; ++j) X[i][j] = f32x16{};
    for (int c = 0; c < NCHUNK; ++c) {
        const size_t so = ((size_t)b * T + (size_t)c * 64) * RW + h * HD;
        bf16* xs = XS + ((size_t)bh * NCHUNK + c) * 4096;
        bf16x8 am[2][2][2];
#pragma unroll
        for (int t1 = 0; t1 < 2; ++t1)
#pragma unroll
            for (int t2 = 0; t2 < 2; ++t2)
#pragma unroll
                for (int s = 0; s < 2; ++s) am[t1][t2][s] = *(const GAS bf16x8*)(aM + so + (size_t)(32 * t1 + r32) * RW + 32 * t2 + 16 * s + 8 * hi);
        u32x2 nn[2][2][4];
#pragma unroll
        for (int tk = 0; tk < 2; ++tk)
#pragma unroll
            for (int tv = 0; tv < 2; ++tv)
#pragma unroll
                for (int g = 0; g < 4; ++g) nn[tk][tv][g] = *(const GAS u32x2*)(aN + so + (size_t)(32 * tv + r32) * RW + 32 * tk + 8 * g + 4 * hi);
        bf16x8 xb[2][2][2];
#pragma unroll
        for (int tk = 0; tk < 2; ++tk)
#pragma unroll
            for (int tv = 0; tv < 2; ++tv) { unsigned pk[8];
#pragma unroll
                for (int q = 0; q < 8; ++q) pk[q] = pkbf(X[tk][tv][2 * q], X[tk][tv][2 * q + 1]);
#pragma unroll
                for (int g = 0; g < 4; ++g) { u32x2 w_; w_.x = pk[2 * g]; w_.y = pk[2 * g + 1]; *(GAS u32x2*)(xs + (size_t)(32 * tv + r32) * 64 + 32 * tk + 8 * g + 4 * hi) = w_; }
                u32x4 f0, f1; f0.x = pk[0]; f0.y = pk[1]; f0.z = pk[2]; f0.w = pk[3]; f1.x = pk[4]; f1.y = pk[5]; f1.z = pk[6]; f1.w = pk[7];
                xb[tk][tv][0] = __builtin_bit_cast(bf16x8, f0); xb[tk][tv][1] = __builtin_bit_cast(bf16x8, f1); }
#pragma unroll
        for (int t1 = 0; t1 < 2; ++t1)
#pragma unroll
            for (int tv = 0; tv < 2; ++tv) { f32x16 a;
#pragma unroll
                for (int g = 0; g < 4; ++g) { const u32x2 q_ = nn[t1][tv][g]; a[4 * g + 0] = bflo(q_.x); a[4 * g + 1] = bfhi(q_.x); a[4 * g + 2] = bflo(q_.y); a[4 * g + 3] = bfhi(q_.y); }
#pragma unroll
                for (int t2 = 0; t2 < 2; ++t2)
#pragma unroll
                    for (int s = 0; s < 2; ++s) a = __builtin_amdgcn_mfma_f32_32x32x16_bf16(am[t1][t2][s], xb[t2][tv][s], a, 0, 0, 0);
                X[t1][tv] = a; }
    }
}

__device__ __forceinline__ void scan_post(Frame& F) {
    const int lane = F.lane, fr = lane & 15, fq = lane >> 4, tb = F.wave & 3;
    const bf16* aRh = (const bf16*)(F.dout + DO_W); const bf16* aYl = (const bf16*)(F.dout + DO_KKN); const bf16* XS = (const bf16*)(F.ws + WS_YRAW);
    const bf16* Zb = (const bf16*)(F.ws + WS_Z); const float* mu = F.in[4]; const bf16* aG = (const bf16*)(F.ws + WS_GATE); const float* bon = (const float*)(F.ws + WS_BON);
    bf16* Y = (bf16*)(F.ws + WS_Y); const float* lnw = F.in[13]; const float* lnb = F.in[14];
    for (int u = F.vcu * 2 + (F.wave >> 2); u < BATCH * NH * NCHUNK; u += F.G * 2) {
        const int c = u % NCHUNK, bh = u / NCHUNK, b = bh / NH, h = bh % NH;
        const size_t m0 = (size_t)b * T + (size_t)c * 64, so = m0 * RW + h * HD;
        const bf16* xs = XS + (size_t)u * 4096;
        const size_t trow = m0 + 16 * tb + fr;
        bf16x8 bf_[2];
#pragma unroll
        for (int s = 0; s < 2; ++s) bf_[s] = *(const GAS bf16x8*)(aRh + trow * RW + h * HD + 32 * s + 8 * fq);
        f32x4 acc[4];
#pragma unroll
        for (int ta = 0; ta < 4; ++ta) { const u32x2 q_ = *(const GAS u32x2*)(aYl + trow * RW + h * HD + 16 * ta + 4 * fq);
            acc[ta] = (f32x4){bflo(q_.x), bfhi(q_.x), bflo(q_.y), bfhi(q_.y)};
#pragma unroll
            for (int s = 0; s < 2; ++s) { const bf16x8 af = *(const GAS bf16x8*)(xs + (size_t)(16 * ta + fr) * 64 + 32 * s + 8 * fq); acc[ta] = __builtin_amdgcn_mfma_f32_16x16x32_bf16(af, bf_[s], acc[ta], 0, 0, 0); } }
        float s1 = 0.f;
#pragma unroll
        for (int ta = 0; ta < 4; ++ta) s1 += (acc[ta][0] + acc[ta][1]) + (acc[ta][2] + acc[ta][3]);
        s1 += __shfl_xor(s1, 16); s1 += __shfl_xor(s1, 32); const float mean = s1 * (1.f / 64.f); float s2 = 0.f;
#pragma unroll
        for (int ta = 0; ta < 4; ++ta)
#pragma unroll
            for (int i = 0; i < 4; ++i) { const float d_ = acc[ta][i] - mean; acc[ta][i] = d_; s2 += d_ * d_; }
        s2 += __shfl_xor(s2, 16); s2 += __shfl_xor(s2, 32); const float rstd = 1.f / sqrtf(s2 * (1.f / 64.f) + GN_EPS);
        const float bn = bon[trow * NH + h];
#pragma unroll
        for (int ta = 0; ta < 4; ++ta) { const int ch = h * HD + 16 * ta + 4 * fq; const f32x4 lw4 = *(const GAS f32x4*)(lnw + ch), lb4 = *(const GAS f32x4*)(lnb + ch);
            const u32x2 vc = *(const GAS u32x2*)(Zb + trow * NIN + ZV_R + ch), gq = *(const GAS u32x2*)(aG + trow * RW + ch); u32x2 vp; vp.x = 0u; vp.y = 0u;
            if ((trow % T) != 0) vp = *(const GAS u32x2*)(Zb + (trow - 1) * NIN + ZV_R + ch);
            const f32x4 mv = *(const GAS f32x4*)(mu + ZV_R + ch);
            const float v0 = bflo(vc.x) + (bflo(vp.x) - bflo(vc.x)) * mv[0], v1 = bfhi(vc.x) + (bfhi(vp.x) - bfhi(vc.x)) * mv[1], v2 = bflo(vc.y) + (bflo(vp.y) - bflo(vc.y)) * mv[2], v3 = bfhi(vc.y) + (bfhi(vp.y) - bfhi(vc.y)) * mv[3];
            const float o0 = (acc[ta][0] * rstd * lw4[0] + lb4[0] + bn * v0) * bflo(gq.x), o1 = (acc[ta][1] * rstd * lw4[1] + lb4[1] + bn * v1) * bfhi(gq.x);
            const float o2 = (acc[ta][2] * rstd * lw4[2] + lb4[2] + bn * v2) * bflo(gq.y), o3 = (acc[ta][3] * rstd * lw4[3] + lb4[3] + bn * v3) * bfhi(gq.y);
            u32x2 w_; w_.x = pkbf(o0, o1); w_.y = pkbf(o2, o3); *(GAS u32x2*)(Y + trow * D + ch) = w_; }
    }
}
}
using pg8::Unit;
constexpr size_t TILE_B = 256 * 2;
struct SchedBase { int G, c; };
struct SchedZ : SchedBase {
    __device__ __forceinline__ bool next(int i, Unit& u) const {
        const int L = i * G + c; constexpr int NZ = (M / 256) * (NIN / 256), NKV = (MEMR / 256) * (2 * D / 256);
        if (L < NZ) { pg8::tile_map(L, M / 256, NIN / 256, u.pm, u.pn); u.z = 0; u.a_off = WS_XN + (size_t)u.pm * 256 * D * 2; u.b_off = WS_WIN_T + (size_t)u.pn * 256 * D * 2; return true; }
        if (L < NZ + NKV) { const int l = L - NZ; u.pm = l / 8; u.pn = l % 8; u.z = 1; u.a_off = WS_MEMN + (size_t)u.pm * 256 * D * 2; u.b_off = WS_WXKV_T + (size_t)u.pn * 256 * D * 2; return true; }
        return false;
    }
};
struct SchedG : SchedBase {
    __device__ __forceinline__ bool next(int i, Unit& u) const {
        const int L = i * G + c; if (L >= 64) return false;
        u.z = L >> 4; u.pm = (L >> 2) & 3; u.pn = L & 3; u.a_off = WS_KV + ((size_t)u.pm * 256 * 2048 + u.z * 256) * 2; u.b_off = WS_WQ_S + ((size_t)u.pn * 256 * 1024 + u.z * 256) * 2; return true;
    }
};
struct SchedVW : SchedBase {
    __device__ __forceinline__ bool next(int i, Unit& u) const {
        const int L = i * G + (G - 1 - c); if (L >= 64) return false;
        u.z = L >> 2; u.pm = L & 3; u.pn = 0; const int b = u.z >> 2, h = u.z & 3;
        u.a_off = WS_WO_T + ((size_t)u.pm * 256 * 1024 + h * 256) * 2; u.b_off = WS_KV + ((size_t)b * 256 * 2048 + 1024 + h * 256) * 2; return true;
    }
};
struct SchedMN : SchedBase {
    int nN; size_t a_base, b_base; int lda, ldb, bsel;
    __device__ __forceinline__ bool next(int i, Unit& u) const {
        const int L = i * G + c; if (L >= (M / 256) * nN) return false;
        pg8::tile_map(L, M / 256, nN, u.pm, u.pn); u.z = 0;
        u.a_off = a_base + (size_t)u.pm * 256 * lda * 2; u.b_off = b_base + ((size_t)u.pn * 256 + (bsel ? (size_t)(u.pm >> 5) * 1024 : 0)) * ldb * 2; return true;
    }
};

constexpr int CW_MQ = 8192;
__device__ __forceinline__ void moba_attn_phase(Frame& F, int bx) {
    const bf16* Z = (const bf16*)(F.ws + WS_Z); bf16* Y = (bf16*)(F.ws + WS_Y) + RW; const float* KM = (const float*)(F.ws + WS_KMEAN);
    const bool perx = (F.G % 8 == 0); const int x = perx ? (bx & 7) : 0; const int nun = perx ? 128 : 1024;
    unsigned* qc = (unsigned*)(F.ctl + CW_MQ + 64 * x);
    volatile LAS unsigned* slot = F.MISC + 16;
    for (int it = 0;; ++it) {
        if (F.tid == 0) slot[it & 1] = __hip_atomic_fetch_add(qc, 1u, __ATOMIC_RELAXED, __HIP_MEMORY_SCOPE_AGENT);
        asm volatile("s_waitcnt vmcnt(0) lgkmcnt(0)" ::: "memory"); __builtin_amdgcn_s_barrier(); asm volatile("" ::: "memory");
        const int idx = __builtin_amdgcn_readfirstlane((int)slot[it & 1]);
        if (idx >= nun) break;
        const int bh = perx ? x * 4 + (idx & 3) : (idx & 31), qb = perx ? 31 - (idx >> 2) : 31 - (idx >> 5);
        int ln = F.lane; asm volatile("" : "+v"(ln)); ln &= 63;
        attn_body::attn_unit<8>(bh / NH, bh % NH, qb, Z + ZQ, Z + ZK, Z + ZV, Y, KM + (size_t)bh * NBLK * HD, (char*)F.lds + RING_OFF, F.wave, ln);
    }
}

#ifndef MK_N_LAUNCHES
#define MK_N_LAUNCHES 1
#endif
constexpr int PER_PHASE = 12;
constexpr int N_LAUNCHES = MK_N_LAUNCHES;
constexpr int SCAN_WGS = 64;
struct Args { const float* in[25]; float* out; unsigned char* ws; int ph_lo, ph_hi, li, pad; };
__global__ void __launch_bounds__(NWAVES * 64, 2) skel_fwd(Args args) {
    extern __shared__ __attribute__((aligned(16))) unsigned char lds[];
    Frame F;
    F.lds = (LAS unsigned char*)lds;
    F.MISC = (volatile LAS unsigned*)(F.lds + MISC_OFF);
    F.tid = threadIdx.x; F.lane = F.tid & 63; F.wave = __builtin_amdgcn_readfirstlane(F.tid >> 6) & 7;
    F.G = gridDim.x; { const int bx = blockIdx.x; F.vcu = (F.G % 8 == 0) ? (bx % 8) * (F.G / 8) + bx / 8 : bx; }
    F.ws = args.ws; F.dout = (unsigned char*)args.out;
#pragma unroll
    for (int i = 0; i < 25; ++i) F.in[i] = args.in[i];
    F.ctl = (gu32*)(F.ws + WS_CTL);
    for (int u = F.tid; u < (EPI_LDS_OFF - LDSCTL_OFF) / 4; u += NWAVES * 64) ((LAS unsigned*)(F.lds + LDSCTL_OFF))[u] = 0u;
    __syncthreads();
    XcdBarrier bar; bar.bar = (unsigned*)(F.ctl + CW_BAR); bar.x = 0; bar.st = nullptr;
    if (N_LAUNCHES == 1) bar = xcd_barrier_post((unsigned*)(F.ctl + CW_BAR), F.MISC + 8);
#define GRID_BAR() do { if (N_LAUNCHES == 1) xcd_barrier(bar); } while (0)
    const int lo = args.ph_lo, hi = args.ph_hi;
#ifndef PHASE_MASK
#define PHASE_MASK 0xFFFF
#endif
#define IN(k) (((PHASE_MASK >> (k)) & 1) && lo <= (k) && (k) < hi)
#define BOTH(k) (IN(k) && IN((k) + 1))
#define FRESH() do { int l_; asm volatile("v_mbcnt_lo_u32_b32 %0, -1, 0\n\tv_mbcnt_hi_u32_b32 %0, -1, %0" : "=v"(l_)); F.lane = l_ & 63; F.tid = F.wave * 64 + F.lane; } while (0)
    const char* wsc = (const char*)F.ws;
    const int bx = (int)blockIdx.x;

    if (IN(0)) { FRESH(); p0_prologue(F); if (BOTH(0)) GRID_BAR(); }
    if (IN(1)) {
        pg8::Gemm g{wsc, wsc, D, D, D}; SchedZ S; S.G = F.G; S.c = bx;
        pg8::EpiStoreBf16 E{(bf16*)(F.ws + WS_Z), NIN, (bf16*)(F.ws + WS_KV), 2 * D, ZQ / 256, attn_body::C2, 0};
        pg8::gemm_phase<pg8::EpiStoreBf16, SchedZ, true>(F.lds + RING_OFF, g, S, E, F.wave);
        if (BOTH(1)) GRID_BAR();
    }
    if (IN(2)) {
        { pg8::Gemm g{wsc, wsc, 2 * D, D, 256}; SchedG S; S.G = F.G; S.c = bx;
          pg8::EpiStoreBf16 E{(bf16*)(F.ws + WS_GT), D, nullptr, 0, 0, 1.f, 1};
          pg8::gemm_phase<pg8::EpiStoreBf16, SchedG, true>(F.lds + RING_OFF, g, S, E, F.wave); }
        { pg8::Gemm g{wsc, wsc, D, 2 * D, 256}; SchedVW S; S.G = F.G; S.c = bx;
          pg8::EpiStoreBf16 E{(bf16*)(F.ws + WS_VWT), D, nullptr, 0, 0, 1.f, 2};
          pg8::gemm_phase<pg8::EpiStoreBf16, SchedVW, true>(F.lds + RING_OFF, g, S, E, F.wave); }
        __syncthreads();
        FRESH(); kmean_simple(F);
        if (BOTH(2)) GRID_BAR();
    }
    if (IN(3)) { FRESH(); rscan::scan_pre(F); if (BOTH(3)) GRID_BAR(); }
    if (IN(4)) {
        FRESH();
        if (bx < BATCH * NH) { if (F.wave == 0) rscan::scan_seq(F, bx); __syncthreads(); }
        moba_attn_phase(F, bx);
        if (BOTH(4)) GRID_BAR();
    }
    if (IN(5)) { FRESH(); rscan::scan_post(F); if (BOTH(5)) GRID_BAR(); }
    if (IN(6)) {
        pg8::Gemm g{wsc, wsc, D, D, D}; SchedMN S; S.G = F.G; S.c = bx; S.nN = D / 256; S.a_base = WS_Y; S.b_base = WS_WMIX_T; S.lda = D; S.ldb = D; S.bsel = 0;
        pg8::EpiRes E{F.in[0], (float*)F.dout, (bf16*)(F.ws + WS_HB), (float*)(F.ws + WS_SS), D};
        pg8::gemm_phase<pg8::EpiRes, SchedMN, true>(F.lds + RING_OFF, g, S, E, F.wave);
        if (BOTH(6)) GRID_BAR();
    }
    if (IN(7)) {
        pg8::Gemm g{wsc, wsc, D, D, D}; SchedMN S; S.G = F.G; S.c = bx; S.nN = D / 256; S.a_base = WS_HB; S.b_base = WS_GT; S.lda = D; S.ldb = D; S.bsel = 1;
        pg8::EpiSoftmax E{(bf16*)(F.ws + WS_P), D, (const float*)(F.ws + WS_SS), (PG8_LAS pg8::f32x2*)(F.lds + EPI_LDS_OFF)};
        pg8::gemm_phase<pg8::EpiSoftmax, SchedMN, true>(F.lds + RING_OFF, g, S, E, F.wave);
        if (BOTH(7)) GRID_BAR();
    }
    if (IN(8)) {
        pg8::Gemm g{wsc, wsc, D, D, D}; SchedMN S; S.G = F.G; S.c = bx; S.nN = D / 256; S.a_base = WS_P; S.b_base = WS_VWT; S.lda = D; S.ldb = D; S.bsel = 1;
        pg8::EpiRes E{(const float*)F.dout, (float*)F.dout, (bf16*)(F.ws + WS_HB), (float*)(F.ws + WS_SS) + (size_t)M * 16, D};
        pg8::gemm_phase<pg8::EpiRes, SchedMN, true>(F.lds + RING_OFF, g, S, E, F.wave);
        if (BOTH(8)) GRID_BAR();
    }
    if (IN(9)) {
        pg8::Gemm g{wsc, wsc, D, D, D}; SchedMN S; S.G = F.G; S.c = bx; S.nN = FF / 256; S.a_base = WS_HB; S.b_base = WS_W1_T; S.lda = D; S.ldb = D; S.bsel = 0;
        pg8::EpiSqRelu E{(bf16*)(F.ws + WS_AH), FF, (const float*)(F.ws + WS_SS) + (size_t)M * 16};
        pg8::gemm_phase<pg8::EpiSqRelu, SchedMN, true>(F.lds + RING_OFF, g, S, E, F.wave);
        if (BOTH(9)) GRID_BAR();
    }
    if (IN(10)) {
        pg8::Gemm g{wsc, wsc, FF, FF, FF}; SchedMN S; S.G = F.G; S.c = bx; S.nN = D / 256; S.a_base = WS_AH; S.b_base = WS_W2_T; S.lda = FF; S.ldb = FF; S.bsel = 0;
        pg8::EpiRes E{(const float*)F.dout, (float*)F.dout, nullptr, (float*)(F.ws + WS_SS) + (size_t)2 * M * 16, D};
        pg8::gemm_phase<pg8::EpiRes, SchedMN, true>(F.lds + RING_OFF, g, S, E, F.wave);
        if (BOTH(10)) GRID_BAR();
    }
    if (IN(11)) { FRESH(); final_norm(F); }
#undef IN
#undef BOTH
}

extern "C" void kernel_launch(void* const* d_in, const int* in_sizes, int n_in, void* d_out, int out_size, void* d_ws, size_t ws_size, hipStream_t stream) {
    static int grid = 0;
    if (grid == 0) {
        if (n_in != 25 || in_sizes[0] != M * D || out_size != M * D || ws_size < WS_END) { fprintf(stderr, "kernel_launch: unexpected problem (n_in %d, in0 %d, out %d, ws %zu); nothing launched\n", n_in, n_in > 0 ? in_sizes[0] : -1, out_size, ws_size); grid = -1; return; }
        int dev = 0, cus = 0, per_cu = 0;
        if (hipGetDevice(&dev) != hipSuccess || hipDeviceGetAttribute(&cus, hipDeviceAttributeMultiprocessorCount, dev) != hipSuccess) { grid = -1; return; }
        if (hipFuncSetAttribute((const void*)skel_fwd, hipFuncAttributeMaxDynamicSharedMemorySize, LDS_BYTES) != hipSuccess) { fprintf(stderr, "kernel_launch: hipFuncSetAttribute failed\n"); grid = -1; return; }
        if (hipOccupancyMaxActiveBlocksPerMultiprocessor(&per_cu, (const void*)skel_fwd, NWAVES * 64, LDS_BYTES) != hipSuccess || per_cu < 1)
            fprintf(stderr, "kernel_launch: note: occupancy query reports %d workgroups per CU\n", per_cu);
        (void)hipGetLastError();
        grid = cus;
    }
    if (grid < 0) return;
    if (hipMemsetAsync((char*)d_ws + WS_CTL, 0, CTL_ZERO_BYTES, stream) != hipSuccess) { fprintf(stderr, "kernel_launch: hipMemsetAsync failed\n"); return; }
    Args a{};
    for (int i = 0; i < 25; ++i) a.in[i] = (const float*)d_in[i];
    a.out = (float*)d_out; a.ws = (unsigned char*)d_ws;
    for (int li = 0; li < N_LAUNCHES; ++li) {
        a.ph_lo = (N_LAUNCHES == PER_PHASE) ? li : 0; a.ph_hi = (N_LAUNCHES == PER_PHASE) ? li + 1 : PER_PHASE; a.li = li;
        hipLaunchKernelGGL(skel_fwd, dim3(grid), dim3(NWAVES * 64), LDS_BYTES, stream, a);
        const hipError_t le = hipPeekAtLastError();
        if (le != hipSuccess) { fprintf(stderr, "kernel_launch: launch %d failed: %s\n", li, hipGetErrorName(le)); break; }
    }
}
```

```cpp
#include <hip/hip_runtime.h>
#include <cstdio>
#include <cstdint>
#include <cmath>
namespace pg8 {
#define PG8_LAS __attribute__((address_space(3)))
typedef unsigned short bf16_t;
typedef short bf16x8 __attribute__((ext_vector_type(8)));
typedef float f32x4 __attribute__((ext_vector_type(4)));
typedef float f32x2 __attribute__((ext_vector_type(2)));
typedef unsigned u32x4 __attribute__((ext_vector_type(4)));
typedef unsigned u32x2 __attribute__((ext_vector_type(2)));
constexpr int BM = 256, BK = 64, HALF = 128, HTB = HALF * BK * 2  , STAGE_BYTES = 8 * HTB, NXCD = 8, WGM = 8;

__host__ __device__ __forceinline__ int lds_byte(int r, int c) { const int st = (r >> 4) * 2 + (c >> 5), rr = r & 15, cc = c & 31, ob = rr * 64 + cc * 2; return st * 1024 + (ob ^ (((ob >> 9) & 1) << 5)); }
__host__ __device__ __forceinline__ void stage_rc(int b, int& R, int& C) { const int st = b / 1024, sb = b % 1024, swz = sb ^ (((sb >> 9) & 1) << 5); R = (st >> 1) * 16 + swz / 64; C = (st & 1) * 32 + (swz % 64) / 2; }
__host__ __device__ __forceinline__ int perm32(int rho) { const int n = rho >> 4, i = rho & 15; return 8 * (i >> 2) + 4 * n + (i & 3); }

struct Unit { int pm, pn, z; size_t a_off, b_off; };
struct Gemm { const char* A; const char* Bt; int lda, ldb, K; };

__host__ __device__ __forceinline__ void tile_map(int L, int nM, int nN, int& pm, int& pn) {
    const int nwg = nM * nN; int wgid = L;
    { const int q = nwg / NXCD, r = nwg % NXCD, xcd = wgid % NXCD, off = wgid / NXCD; wgid = (xcd < r ? xcd * (q + 1) : r * (q + 1) + (xcd - r) * q) + off; }
    const int nig = WGM * nN, gid = wgid / nig, fm = gid * WGM, gsz = (nM - fm) < WGM ? (nM - fm) : WGM;
    pm = fm + ((wgid % nig) % gsz); pn = (wgid % nig) / gsz;
}

__device__ __forceinline__ unsigned cvt_pk_bf16(float lo, float hi) { unsigned r; asm volatile("v_cvt_pk_bf16_f32 %0, %1, %2" : "=v"(r) : "v"(lo), "v"(hi)); return r; }

template <class Epi, class Sched, bool ALIGN_EPI>
__device__ __forceinline__ void gemm_phase(PG8_LAS unsigned char* lds, const Gemm g, const Sched& S, const Epi& E, const int wid_) {
    int lane_; asm volatile("v_mbcnt_lo_u32_b32 %0, -1, 0\n\tv_mbcnt_hi_u32_b32 %0, -1, %0" : "=v"(lane_));
    const int lane = lane_ & 63, wid = wid_ & 7, tid = wid * 64 + lane, wr = wid >> 2, wc = wid & 3, fr = lane & 15, fq = lane >> 4;
    const int K = g.K, nt = K / BK;
    unsigned voffA[2], voffB[2];
#pragma unroll
    for (int i = 0; i < 2; ++i) { int R, C; stage_rc(tid * 16 + i * 8192, R, C); const int Rb = Epi::PERM ? ((R & ~31) + perm32(R & 31)) : R;
        voffA[i] = (unsigned)(R * g.lda + C) * 2u; voffB[i] = (unsigned)(Rb * g.ldb + C) * 2u; }
    const size_t kstep = (size_t)(BK * 2);
    const size_t hstepA = (size_t)HALF * g.lda * 2, hstepB = (size_t)HALF * g.ldb * 2;
    const unsigned ldsw = (unsigned)wid * 1024u;
    const int aoff = lds_byte(wr * 64 + fr, fq * 8), boff = lds_byte(wc * 32 + fr, fq * 8);
#define PG8_SA(b, h) (((b) * 2 + (h)) * HTB)
#define PG8_SB(b, h) ((4 + (b) * 2 + (h)) * HTB)
#define PG8_STAGE(bufoff, gbase, voff) do { _Pragma("unroll") for (int _i = 0; _i < 2; ++_i) \
        __builtin_amdgcn_global_load_lds((const unsigned*)((const char*)(gbase) + (voff)[_i]), (PG8_LAS unsigned*)(lds + (bufoff) + ldsw + _i * 8192), 16, 0, 0); } while (0)
#define PG8_LDA(dst, b, h) do { _Pragma("unroll") for (int m = 0; m < 4; ++m) _Pragma("unroll") for (int k = 0; k < 2; ++k) dst[m][k] = *(const PG8_LAS bf16x8*)(lds + PG8_SA(b, h) + aoff + m * 2048 + k * 1024); } while (0)
#define PG8_LDB(dst, b, h) do { _Pragma("unroll") for (int n = 0; n < 2; ++n) _Pragma("unroll") for (int k = 0; k < 2; ++k) dst[n][k] = *(const PG8_LAS bf16x8*)(lds + PG8_SB(b, h) + boff + n * 2048 + k * 1024); } while (0)
#define PG8_MMA(ai, bj, At, Bt) do { __builtin_amdgcn_s_setprio(1); _Pragma("unroll") for (int m = 0; m < 4; ++m) _Pragma("unroll") for (int n = 0; n < 2; ++n) _Pragma("unroll") for (int k = 0; k < 2; ++k) \
        acc[ai][bj][m][n] = __builtin_amdgcn_mfma_f32_16x16x32_bf16(Bt[n][k], At[m][k], acc[ai][bj][m][n], 0, 0, 0); __builtin_amdgcn_s_setprio(0); } while (0)
#define PG8_WAIT_V(n) asm volatile("s_waitcnt vmcnt(" #n ")" ::: "memory")
#define PG8_WAIT_L(n) asm volatile("s_waitcnt lgkmcnt(" #n ")" ::: "memory")
#define PG8_BAR __builtin_amdgcn_s_barrier()
#define PG8_SCHED __builtin_amdgcn_sched_barrier(0)
    Unit cur, nxt; int ui = 0;
    if (!S.next(0, cur)) return;
    f32x4 acc[2][2][4][2];
#pragma unroll
    for (int a = 0; a < 2; ++a)
#pragma unroll
        for (int b = 0; b < 2; ++b)
#pragma unroll
            for (int m = 0; m < 4; ++m)
#pragma unroll
                for (int n = 0; n < 2; ++n) acc[a][b][m][n] = (f32x4){0.f, 0.f, 0.f, 0.f};
    bf16x8 At[4][2], B0[2][2], B1[2][2];
    const char* cA = g.A + cur.a_off; const char* cB = g.Bt + cur.b_off;
    PG8_STAGE(PG8_SB(0, 0), cB, voffB); PG8_STAGE(PG8_SB(0, 1), cB + hstepB, voffB); PG8_STAGE(PG8_SA(0, 0), cA, voffA); PG8_STAGE(PG8_SA(0, 1), cA + hstepA, voffA);
    if (wr == 1) PG8_BAR;
    PG8_WAIT_V(2); PG8_BAR;
    PG8_STAGE(PG8_SB(1, 0), cB + kstep, voffB); PG8_STAGE(PG8_SA(1, 0), cA + kstep, voffA); PG8_STAGE(PG8_SB(1, 1), cB + hstepB + kstep, voffB);
    PG8_WAIT_V(6); PG8_BAR;
    for (;;) {
        const bool has_next = S.next(ui + 1, nxt);
        const char* nA = has_next ? g.A + nxt.a_off : cA; const char* nB = has_next ? g.Bt + nxt.b_off : cB;
        for (int t = 0; t < nt; t += 2) {
            const bool last = (t == nt - 2);
            const char* a1 = cA + (size_t)(t + 1) * kstep;
            const char* a2 = last ? nA : cA + (size_t)(t + 2) * kstep; const char* b2 = last ? nB : cB + (size_t)(t + 2) * kstep;
            const char* a3 = a2 + kstep; const char* b3 = b2 + kstep;
            PG8_LDB(B0, 0, 0); PG8_LDB(B1, 0, 1); PG8_SCHED; PG8_LDA(At, 0, 0); PG8_STAGE(PG8_SA(1, 1), a1 + hstepA, voffA);
            PG8_WAIT_V(8); PG8_WAIT_L(0); PG8_BAR; PG8_MMA(0, 0, At, B0); PG8_MMA(0, 1, At, B1); PG8_BAR; PG8_SCHED;
            PG8_LDA(At, 0, 1); PG8_STAGE(PG8_SB(0, 0), b2, voffB); PG8_STAGE(PG8_SB(0, 1), b2 + hstepB, voffB); PG8_STAGE(PG8_SA(0, 0), a2, voffA);
            PG8_WAIT_V(8); PG8_WAIT_L(0); PG8_BAR; PG8_MMA(1, 0, At, B0); PG8_MMA(1, 1, At, B1); PG8_BAR; PG8_SCHED;
            PG8_LDB(B0, 1, 0); PG8_LDB(B1, 1, 1); PG8_SCHED; PG8_LDA(At, 1, 0); PG8_STAGE(PG8_SA(0, 1), a2 + hstepA, voffA);
            PG8_WAIT_V(8); PG8_WAIT_L(0); PG8_BAR; PG8_MMA(0, 0, At, B0); PG8_MMA(0, 1, At, B1); PG8_BAR; PG8_SCHED;
            PG8_LDA(At, 1, 1); PG8_STAGE(PG8_SB(1, 0), b3, voffB); PG8_STAGE(PG8_SB(1, 1), b3 + hstepB, voffB); PG8_STAGE(PG8_SA(1, 0), a3, voffA);
            PG8_WAIT_V(8); PG8_WAIT_L(0); PG8_BAR; PG8_MMA(1, 0, At, B0); PG8_MMA(1, 1, At, B1); PG8_BAR; PG8_SCHED;
        }
        if constexpr (ALIGN_EPI) { if (wr == 0) PG8_BAR; }
        E(acc, cur, wr, wc, fr, fq, lane);
        if (!has_next) break;
#pragma unroll
        for (int a = 0; a < 2; ++a)
#pragma unroll
            for (int b = 0; b < 2; ++b)
#pragma unroll
                for (int m = 0; m < 4; ++m)
#pragma unroll
                    for (int n = 0; n < 2; ++n) acc[a][b][m][n] = (f32x4){0.f, 0.f, 0.f, 0.f};
        cur = nxt; cA = nA; cB = nB; ++ui;
        if constexpr (ALIGN_EPI) { if (wr == 1) PG8_BAR; }
    }
    PG8_WAIT_V(0);
    if constexpr (!ALIGN_EPI) { if (wr == 0) PG8_BAR; }
    PG8_BAR;
#undef PG8_SA
#undef PG8_SB
#undef PG8_STAGE
#undef PG8_LDA
#undef PG8_LDB
#undef PG8_MMA
#undef PG8_WAIT_V
#undef PG8_WAIT_L
#undef PG8_BAR
#undef PG8_SCHED
}
}
namespace pg8 {
struct EpiStoreBf16 {
    static constexpr bool PERM = true;
    bf16_t* O0; int ldc0; bf16_t* O1; int ldc1; int qs_lo; float qscale;
    int mode;
    __device__ __forceinline__ void operator()(const f32x4 (&acc)[2][2][4][2], const Unit& u, int wr, int wc, int fr, int fq, int lane) const {
        asm volatile("" : "+v"(fr), "+v"(fq), "+v"(lane));
        bf16_t* base; int ldc; size_t row0; int colt;
        if (mode == 0) { base = u.z ? O1 : O0; ldc = u.z ? ldc1 : ldc0; row0 = (size_t)u.pm * BM; colt = u.pn * BM; }
        else if (mode == 1) { base = O0; ldc = ldc0; row0 = (size_t)u.pm * 1024 + (size_t)u.z * 256; colt = u.pn * BM; }
        else { base = O0 + (size_t)(u.z >> 2) * 1048576; ldc = ldc0; row0 = (size_t)u.pm * BM; colt = (u.z & 3) * 256; }
        const float sc = (mode == 0 && u.z == 0 && (u.pn == qs_lo || u.pn == qs_lo + 1)) ? qscale : 1.f;
        const int col0 = colt + wc * 32 + 8 * fq;
#pragma unroll
        for (int ai = 0; ai < 2; ++ai)
#pragma unroll
            for (int m = 0; m < 4; ++m) { bf16_t* rowp = base + (row0 + wr * 64 + fr + ai * HALF + m * 16) * ldc + col0;
#pragma unroll
                for (int bj = 0; bj < 2; ++bj) { const f32x4 v0 = acc[ai][bj][m][0] * sc, v1 = acc[ai][bj][m][1] * sc;
                    u32x4 w; w.x = cvt_pk_bf16(v0[0], v0[1]); w.y = cvt_pk_bf16(v0[2], v0[3]); w.z = cvt_pk_bf16(v1[0], v1[1]); w.w = cvt_pk_bf16(v1[2], v1[3]);
                    *(u32x4*)(rowp + bj * HALF) = w; } }
    }
};

__device__ __forceinline__ float row_rstd(const float* ss, size_t row) {
    const f32x4* p = (const f32x4*)(ss + row * 16); const f32x4 a = p[0], b = p[1], c = p[2], d = p[3];
    const float s = ((a[0] + a[1]) + (a[2] + a[3])) + ((b[0] + b[1]) + (b[2] + b[3])) + ((c[0] + c[1]) + (c[2] + c[3])) + ((d[0] + d[1]) + (d[2] + d[3]));
    return 1.0f / sqrtf(s * (1.0f / 1024.0f) + 1e-6f);
}
__device__ __forceinline__ void wave_rstd(float (&rs)[2][4], const float* ss, int pm, int wr, int fr, int lane) {
    const float my0 = row_rstd(ss, (size_t)pm * BM + wr * 64 + lane), my1 = row_rstd(ss, (size_t)pm * BM + HALF + wr * 64 + lane);
#pragma unroll
    for (int m = 0; m < 4; ++m) { rs[0][m] = __shfl(my0, m * 16 + fr); rs[1][m] = __shfl(my1, m * 16 + fr); }
}

struct EpiRes {
    static constexpr bool PERM = false;
    const float* base; float* out; bf16_t* hb; float* ss; int ldc;
    __device__ __forceinline__ void operator()(f32x4 (&acc)[2][2][4][2], const Unit& u, int wr, int wc, int fr, int fq, int lane) const {
        asm volatile("" : "+v"(fr), "+v"(fq), "+v"(lane));
        const int col0 = u.pn * BM + wc * 32 + 4 * fq;
#pragma unroll
        for (int ai = 0; ai < 2; ++ai)
#pragma unroll
            for (int m = 0; m < 4; ++m) { const size_t row = (size_t)u.pm * BM + ai * HALF + wr * 64 + m * 16 + fr; const size_t off = row * ldc + col0; float q = 0.f;
#pragma unroll
                for (int bj = 0; bj < 2; ++bj)
#pragma unroll
                    for (int n = 0; n < 2; ++n) { const f32x4 bs = *(const f32x4*)(base + off + bj * HALF + n * 16); const f32x4 o = bs + acc[ai][bj][m][n];
                        *(f32x4*)(out + off + bj * HALF + n * 16) = o; q += (o[0] * o[0] + o[1] * o[1]) + (o[2] * o[2] + o[3] * o[3]);
                        if (hb) { u32x2 w; w.x = cvt_pk_bf16(o[0], o[1]); w.y = cvt_pk_bf16(o[2], o[3]); *(u32x2*)(hb + off + bj * HALF + n * 16) = w; } }
                q += __shfl_xor(q, 16); q += __shfl_xor(q, 32);
                if (fq == 0) ss[row * 16 + u.pn * 4 + wc] = q;
                if (m & 1) asm volatile("" ::: "memory"); }
    }
};

struct EpiSqRelu {
    static constexpr bool PERM = true;
    bf16_t* O; int ldc; const float* ss;
    __device__ __forceinline__ void operator()(const f32x4 (&acc)[2][2][4][2], const Unit& u, int wr, int wc, int fr, int fq, int lane) const {
        asm volatile("" : "+v"(fr), "+v"(fq), "+v"(lane));
        float rs[2][4]; wave_rstd(rs, ss, u.pm, wr, fr, lane);
        const int col0 = u.pn * BM + wc * 32 + 8 * fq;
#pragma unroll
        for (int ai = 0; ai < 2; ++ai)
#pragma unroll
            for (int m = 0; m < 4; ++m) { bf16_t* rowp = O + ((size_t)u.pm * BM + wr * 64 + fr + ai * HALF + m * 16) * ldc + col0; const float s = rs[ai][m];
#pragma unroll
                for (int bj = 0; bj < 2; ++bj) { f32x4 v0 = acc[ai][bj][m][0] * s, v1 = acc[ai][bj][m][1] * s;
#pragma unroll
                    for (int i = 0; i < 4; ++i) { const float a = fmaxf(v0[i], 0.f), b = fmaxf(v1[i], 0.f); v0[i] = a * a; v1[i] = b * b; }
                    u32x4 w; w.x = cvt_pk_bf16(v0[0], v0[1]); w.y = cvt_pk_bf16(v0[2], v0[3]); w.z = cvt_pk_bf16(v1[0], v1[1]); w.w = cvt_pk_bf16(v1[2], v1[3]);
                    *(u32x4*)(rowp + bj * HALF) = w; } }
    }
};

struct EpiSoftmax {
    static constexpr bool PERM = true;
    bf16_t* O; int ldc; const float* ss; PG8_LAS f32x2* xl;
    __device__ __forceinline__ void operator()(f32x4 (&acc)[2][2][4][2], const Unit& u, int wr, int wc, int fr, int fq, int lane) const {
        asm volatile("" : "+v"(fr), "+v"(fq), "+v"(lane));
        float rs[2][4]; wave_rstd(rs, ss, u.pm, wr, fr, lane);
#pragma unroll
        for (int ai = 0; ai < 2; ++ai)
#pragma unroll
            for (int m = 0; m < 4; ++m) { const float s = rs[ai][m] * (0.0625f * 1.4426950408889634f); float mx = -INFINITY;
#pragma unroll
                for (int bj = 0; bj < 2; ++bj)
#pragma unroll
                    for (int n = 0; n < 2; ++n) { f32x4 v = acc[ai][bj][m][n] * s; acc[ai][bj][m][n] = v; mx = fmaxf(fmaxf(mx, fmaxf(v[0], v[1])), fmaxf(v[2], v[3])); }
                mx = fmaxf(mx, __shfl_xor(mx, 16)); mx = fmaxf(mx, __shfl_xor(mx, 32)); float sm = 0.f;
#pragma unroll
                for (int bj = 0; bj < 2; ++bj)
#pragma unroll
                    for (int n = 0; n < 2; ++n) { f32x4 v = acc[ai][bj][m][n];
#pragma unroll
                        for (int i = 0; i < 4; ++i) { v[i] = __builtin_amdgcn_exp2f(v[i] - mx); sm += v[i]; } acc[ai][bj][m][n] = v; }
                sm += __shfl_xor(sm, 16); sm += __shfl_xor(sm, 32);
                if (fq == 0) xl[(ai * HALF + wr * 64 + m * 16 + fr) * 4 + wc] = (f32x2){mx, sm}; }
        asm volatile("s_waitcnt lgkmcnt(0)" ::: "memory"); __builtin_amdgcn_s_barrier(); asm volatile("" ::: "memory");
        const int col0 = u.pn * BM + wc * 32 + 8 * fq;
#pragma unroll
        for (int ai = 0; ai < 2; ++ai)
#pragma unroll
            for (int m = 0; m < 4; ++m) { const int r = ai * HALF + wr * 64 + m * 16 + fr;
                const f32x4 x01 = *(const PG8_LAS f32x4*)(xl + r * 4), x23 = *(const PG8_LAS f32x4*)(xl + r * 4 + 2);
                const float mg = fmaxf(fmaxf(x01[0], x01[2]), fmaxf(x23[0], x23[2]));
                const float tot = x01[1] * __builtin_amdgcn_exp2f(x01[0] - mg) + x01[3] * __builtin_amdgcn_exp2f(x01[2] - mg) + x23[1] * __builtin_amdgcn_exp2f(x23[0] - mg) + x23[3] * __builtin_amdgcn_exp2f(x23[2] - mg);
                const float mown = wc == 0 ? x01[0] : (wc == 1 ? x01[2] : (wc == 2 ? x23[0] : x23[2]));
                const float f = __builtin_amdgcn_exp2f(mown - mg) / tot;
                bf16_t* rowp = O + ((size_t)u.pm * BM + r) * ldc + col0;
#pragma unroll
                for (int bj = 0; bj < 2; ++bj) { const f32x4 v0 = acc[ai][bj][m][0] * f, v1 = acc[ai][bj][m][1] * f;
                    u32x4 w; w.x = cvt_pk_bf16(v0[0], v0[1]); w.y = cvt_pk_bf16(v0[2], v0[3]); w.z = cvt_pk_bf16(v1[0], v1[1]); w.w = cvt_pk_bf16(v1[2], v1[3]);
                    *(u32x4*)(rowp + bj * HALF) = w; } }
    }
};
}
constexpr int NWAVES = 8;
constexpr int BATCH = 4, T = 8192, D = 1024, M = BATCH * T;
constexpr int NIN = 3328, RW = 512, NH = 8, HD = 64;
constexpr int ZK_R = 512, ZV_R = 1024, ZWD = 1536, ZAD = 1600, ZGD = 1664;
constexpr int ZQ = 1792, ZK = 1792 + 512, ZV = 1792 + 1024;
constexpr int MEML = 256, MEMR = BATCH * MEML, FF = 4096;
constexpr int NBLK = T / 256;
constexpr float NORM_EPS = 1e-6f, GN_EPS = 64e-5f, DECAY_SCALE = 0.6065306597126334f;

constexpr size_t MiB = 1u << 20;
constexpr size_t WS_CTL = 0, CTL_ZERO_BYTES = 1 * MiB;
constexpr size_t WS_WIN_T = 1 * MiB, WS_WMIX_T = 8 * MiB, WS_WQ_S = 10 * MiB, WS_WXKV_T = 12 * MiB, WS_WO_T = 16 * MiB, WS_W1_T = 18 * MiB, WS_W2_T = 26 * MiB;
constexpr size_t WS_MEMN = 34 * MiB, WS_KV = 36 * MiB, WS_GT = 40 * MiB, WS_VWT = 48 * MiB;
constexpr size_t WS_SS = 56 * MiB;
constexpr size_t WS_KMEAN = 62 * MiB, WS_LORA = 62 * MiB + 512 * 1024, WS_BON = 63 * MiB;
constexpr size_t WS_XN = 64 * MiB;
constexpr size_t WS_GATE = 64 * MiB, WS_YRAW = 96 * MiB;
constexpr size_t WS_HB = 64 * MiB;
constexpr size_t WS_Z = 128 * MiB;
constexpr size_t WS_Y = 336 * MiB;
constexpr size_t WS_PR = 400 * MiB, WS_PV = 432 * MiB;
constexpr size_t WS_P = 400 * MiB;
constexpr size_t WS_AH = 128 * MiB;
constexpr size_t WS_END = 512 * MiB;
constexpr size_t DO_W = 0, DO_KP = 32 * MiB, DO_KKN = 64 * MiB, DO_B = 96 * MiB;

constexpr int CW_TMO = 0, CW_CODE = 1;
constexpr int CW_BAR = 4096;

constexpr int RING_OFF = 0, RING_BYTES = 131072;
constexpr int LDSCTL_OFF = RING_BYTES, MISC_OFF = LDSCTL_OFF + 320;
constexpr int EPI_LDS_OFF = 132096;
constexpr int LDS_BYTES = 147456;
static_assert(MISC_OFF + 128 <= EPI_LDS_OFF && EPI_LDS_OFF + 8192 <= LDS_BYTES, "LDS map");

#define GAS __attribute__((address_space(1)))
#define LAS __attribute__((address_space(3)))
typedef unsigned short bf16;
typedef unsigned v4u __attribute__((ext_vector_type(4)));
typedef float f32x4 __attribute__((ext_vector_type(4)));
typedef GAS unsigned gu32;
#define RLX_AGENT __ATOMIC_RELAXED, __HIP_MEMORY_SCOPE_AGENT
#define LDS_WAIT() asm volatile("s_waitcnt lgkmcnt(0)" ::: "memory")
#define VM_WAIT() asm volatile("s_waitcnt vmcnt(0)" ::: "memory")
__device__ __forceinline__ unsigned f2bf(float f) { unsigned u = __builtin_bit_cast(unsigned, f); return (u + 0x7fffu + ((u >> 16) & 1u)) >> 16; }
__device__ __forceinline__ unsigned pk2(float lo, float hi) { return f2bf(lo) | (f2bf(hi) << 16); }
__device__ __forceinline__ float bf2f(unsigned short u) { return __builtin_bit_cast(float, (unsigned)u << 16); }
__device__ __forceinline__ float bflo(unsigned u) { return __builtin_bit_cast(float, u << 16); }
__device__ __forceinline__ float bfhi(unsigned u) { return __builtin_bit_cast(float, u & 0xffff0000u); }

#define XB_TMO      128
#define XB_XCNT(j)  (256  + 64 * (j))
#define XB_XSUB(j)  (1280 + 64 * (j))
#define XB_XGEN(j)  (2304 + 64 * (j))
#define XB_TOP      3328
#define XB_TOPGEN   3392
#define XCD_BAR_WORDS 3456
#define XB_SPIN_CAP (1u << 18)
__device__ __forceinline__ unsigned xb_ld(unsigned* p)              { return __hip_atomic_load(p, __ATOMIC_RELAXED, __HIP_MEMORY_SCOPE_AGENT); }
__device__ __forceinline__ unsigned xb_add(unsigned* p, unsigned v) { return __hip_atomic_fetch_add(p, v, __ATOMIC_RELAXED, __HIP_MEMORY_SCOPE_AGENT); }
__device__ __forceinline__ unsigned xb_xcc_id() { return (unsigned)__builtin_amdgcn_s_getreg((3 << 11) | 20) & 0xFu; }
#define XB_SPIN(cond, bar) do { unsigned _sp = 0; while (cond) { __builtin_amdgcn_s_sleep(1); \
    if ((++_sp & 255u) == 0u) { if (xb_ld(&(bar)[XB_TMO])) break; if (_sp > XB_SPIN_CAP) { atomicAdd(&(bar)[XB_TMO], 1u); break; } } } } while (0)
struct XcdBarrier { unsigned* bar; unsigned x; volatile LAS unsigned* st; };
__device__ __forceinline__ XcdBarrier xcd_barrier_post(unsigned* bar, volatile LAS unsigned* st) {
    XcdBarrier b; b.bar = bar; b.x = xb_xcc_id(); b.st = st;
    if (threadIdx.x == 0) (void)xb_add(&bar[XB_XCNT(b.x)], 1u);
    return b;
}
__device__ __forceinline__ void xcd_barrier_complete(unsigned* bar, unsigned x, unsigned& nloc, unsigned& nx) {
    const unsigned G = gridDim.x * gridDim.y * gridDim.z;
    unsigned sum, cnt, mine, sp = 0u;
    for (;;) {
        sum = 0u; cnt = 0u; mine = 0u;
#pragma unroll
        for (unsigned j = 0; j < 16; ++j) { const unsigned c = xb_ld(&bar[XB_XCNT(j)]); sum += c; cnt += (c > 0u) ? 1u : 0u; mine = (j == x) ? c : mine; }
        if (sum == G) break;
        __builtin_amdgcn_s_sleep(1);
        if ((++sp & 255u) == 0u) { if (xb_ld(&bar[XB_TMO])) break; if (sp > XB_SPIN_CAP) { atomicAdd(&bar[XB_TMO], 1u); break; } }
    }
    nloc = mine > 0u ? mine : 1u; nx = cnt > 0u ? cnt : 1u;
}
__device__ __forceinline__ void xcd_barrier(const XcdBarrier& b) {
    asm volatile("s_waitcnt vmcnt(0)" ::: "memory");
    __syncthreads();
    if (threadIdx.x == 0) {
        unsigned* bar = b.bar;
        __builtin_amdgcn_s_waitcnt(0);
        unsigned nloc = b.st[0], nx = b.st[1];
        if (nloc == 0u) { xcd_barrier_complete(bar, b.x, nloc, nx); b.st[0] = nloc; b.st[1] = nx; }
        const unsigned old = xb_add(&bar[XB_XSUB(b.x)], 1u);
        const unsigned gen = old / nloc;
        if (old + 1u == (gen + 1u) * nloc) {
            __builtin_amdgcn_fence(__ATOMIC_RELEASE, "agent");
            asm volatile("s_waitcnt vmcnt(0)" ::: "memory");
            const unsigned og = xb_add(&bar[XB_TOP], 1u);
            const unsigned tg = og / nx;
            if (og + 1u == (tg + 1u) * nx) xb_add(&bar[XB_TOPGEN], 1u);
            else XB_SPIN(xb_ld(&bar[XB_TOPGEN]) == tg, bar);
            __builtin_amdgcn_fence(__ATOMIC_ACQUIRE, "agent");
            xb_add(&bar[XB_XGEN(b.x)], 1u);
            asm volatile("s_waitcnt vmcnt(0)" ::: "memory");
        } else {
            XB_SPIN(xb_ld(&bar[XB_XGEN(b.x)]) == gen, bar);
            __builtin_amdgcn_fence(__ATOMIC_ACQUIRE, "agent");
            asm volatile("s_waitcnt vmcnt(0)" ::: "memory");
        }
    }
    __syncthreads();
}

struct Frame {
    LAS unsigned char* lds;
    volatile LAS unsigned* MISC;
    gu32* ctl;
    int tid, lane, wave;
    int vcu, G;
    unsigned char* ws; unsigned char* dout;
    const float* in[25];
};
constexpr size_t WS_TAB = 131072;
__device__ __forceinline__ const float* inp(const Frame& F, int i) {
    const unsigned long long v = ((const GAS unsigned long long*)(F.ws + WS_TAB))[i];
    const unsigned lo = __builtin_amdgcn_readfirstlane((unsigned)v), hi = __builtin_amdgcn_readfirstlane((unsigned)(v >> 32));
    return (const float*)(((unsigned long long)hi << 32) | lo);
}
#define INP(i) inp(F, (i))
__device__ __forceinline__ float wave_sum(float v) {
#pragma unroll
    for (int o = 1; o < 64; o <<= 1) v += __shfl_xor(v, o);
    return v;
}
__device__ __forceinline__ float wave_max(float v) {
#pragma unroll
    for (int o = 1; o < 64; o <<= 1) v = fmaxf(v, __shfl_xor(v, o));
    return v;
}
template <int CTRL> __device__ __forceinline__ float dpp_mov(float x) { return __builtin_bit_cast(float, __builtin_amdgcn_update_dpp(0, __builtin_bit_cast(int, x), CTRL, 0xf, 0xf, false)); }
__device__ __forceinline__ float red16(float x) { x += dpp_mov<0xB1>(x); x += dpp_mov<0x4E>(x); x += dpp_mov<0x124>(x); x += dpp_mov<0x128>(x); return x; }
__device__ __forceinline__ void p0_transpose_item(const float* W, int K, int N, bf16* WT, const float* kscale, LAS float* scr, int item, int lane) {
    const int nblk = N / 32, kb = item / nblk, nb = item % nblk, k0 = 64 * kb, n0 = 32 * nb;
#pragma unroll 8
    for (int i = 0; i < 32; ++i) { const int kk = 2 * i + (lane >> 5); const float s = kscale ? kscale[k0 + kk] : 1.f; scr[kk * 33 + (lane & 31)] = W[(size_t)(k0 + kk) * N + n0 + (lane & 31)] * s; }
    LDS_WAIT(); asm volatile("" ::: "memory");
    const int c = lane & 7;
#pragma unroll
    for (int j = 0; j < 4; ++j) { const int n = (lane >> 3) + 8 * j; const LAS float* s = scr + (8 * c) * 33 + n;
        v4u o; o.x = pk2(s[0 * 33], s[1 * 33]); o.y = pk2(s[2 * 33], s[3 * 33]); o.z = pk2(s[4 * 33], s[5 * 33]); o.w = pk2(s[6 * 33], s[7 * 33]);
        *(GAS v4u*)(WT + (size_t)(n0 + n) * K + k0 + 8 * c) = o; }
    LDS_WAIT(); asm volatile("" ::: "memory");
}
__device__ __forceinline__ void rms_row_to_bf16(const float* xrow, const float* g, bf16* orow, int lane) {
    const GAS f32x4* xr = (const GAS f32x4*)xrow + lane; const GAS f32x4* gr = (const GAS f32x4*)g + lane;
    f32x4 v[4]; float s = 0.f;
#pragma unroll
    for (int j = 0; j < 4; ++j) { v[j] = xr[64 * j]; s += (v[j].x * v[j].x + v[j].y * v[j].y) + (v[j].z * v[j].z + v[j].w * v[j].w); }
    const float rstd = 1.f / sqrtf(wave_sum(s) * (1.f / D) + NORM_EPS);
    GAS unsigned long long* o8 = (GAS unsigned long long*)orow + lane;
#pragma unroll
    for (int j = 0; j < 4; ++j) { const f32x4 gg = gr[64 * j]; o8[64 * j] = (unsigned long long)pk2(v[j].x * rstd * gg.x, v[j].y * rstd * gg.y) | ((unsigned long long)pk2(v[j].z * rstd * gg.z, v[j].w * rstd * gg.w) << 32); }
}
__device__ __forceinline__ void p0_prologue(Frame& F) {
    LAS float* scr = (LAS float*)(F.lds + RING_OFF + F.wave * 16384);
    const int gw = F.vcu * NWAVES + F.wave, NGW = F.G * NWAVES;
    constexpr int I_IN = (D / 64) * (NIN / 32), I_MIX = (D / 64) * (D / 32), I_KV = (D / 64) * (2 * D / 32), I_O = I_MIX, I_1 = (D / 64) * (FF / 32), I_2 = (FF / 64) * (D / 32);
    constexpr int I_LW = RW / 32, I_LG = 2 * (RW / 32);
    constexpr int NITEMS = I_IN + I_MIX + I_KV + I_O + I_1 + I_2 + 2 * I_LW + I_LG;
    for (int it = gw; it < NITEMS; it += NGW) {
        int r = it;
        if (r < I_IN) { p0_transpose_item(F.in[3], D, NIN, (bf16*)(F.ws + WS_WIN_T), nullptr, scr, r, F.lane); continue; } r -= I_IN;
        if (r < I_MIX) { p0_transpose_item(F.in[15], D, D, (bf16*)(F.ws + WS_WMIX_T), nullptr, scr, r, F.lane); continue; } r -= I_MIX;
        if (r < I_KV) { p0_transpose_item(F.in[19], D, 2 * D, (bf16*)(F.ws + WS_WXKV_T), nullptr, scr, r, F.lane); continue; } r -= I_KV;
        if (r < I_O) { p0_transpose_item(F.in[20], D, D, (bf16*)(F.ws + WS_WO_T), nullptr, scr, r, F.lane); continue; } r -= I_O;
        if (r < I_1) { p0_transpose_item(F.in[22], D, FF, (bf16*)(F.ws + WS_W1_T), F.in[21], scr, r, F.lane); continue; } r -= I_1;
        if (r < I_2) { p0_transpose_item(F.in[23], FF, D, (bf16*)(F.ws + WS_W2_T), nullptr, scr, r, F.lane); continue; } r -= I_2;
        if (r < I_LW) { p0_transpose_item(F.in[6], 64, RW, (bf16*)(F.ws + WS_LORA), nullptr, scr, r, F.lane); continue; } r -= I_LW;
        if (r < I_LW) { p0_transpose_item(F.in[8], 64, RW, (bf16*)(F.ws + WS_LORA) + RW * 64, nullptr, scr, r, F.lane); continue; } r -= I_LW;
        p0_transpose_item(F.in[9], 128, RW, (bf16*)(F.ws + WS_LORA) + 2 * RW * 64, nullptr, scr, r, F.lane);
    }
    { const float* wq = F.in[18]; const float* gx = F.in[16]; bf16* o = (bf16*)(F.ws + WS_WQ_S);
      for (int i = (F.vcu * 512 + F.tid); i < D * D / 4; i += F.G * 512) { const f32x4 v = ((const GAS f32x4*)wq)[i]; const float s = gx[(i * 4) / D];
          ((GAS unsigned long long*)o)[i] = (unsigned long long)pk2(v.x * s, v.y * s) | ((unsigned long long)pk2(v.z * s, v.w * s) << 32); } }
    for (int m = gw; m < M; m += NGW) rms_row_to_bf16(F.in[0] + (size_t)m * D, F.in[2], (bf16*)(F.ws + WS_XN) + (size_t)m * D, F.lane);
    for (int m = gw; m < MEMR; m += NGW) rms_row_to_bf16(F.in[1] + (size_t)m * D, F.in[17], (bf16*)(F.ws + WS_MEMN) + (size_t)m * D, F.lane);
}

__device__ __forceinline__ void kmean_simple(Frame& F) {
    const bf16* Z = (const bf16*)(F.ws + WS_Z); float* KM = (float*)(F.ws + WS_KMEAN);
    const int gw = F.vcu * NWAVES + F.wave, NGW = F.G * NWAVES;
    for (int u = gw; u < BATCH * NH * NBLK; u += NGW) { const int j = u % NBLK, bh = u / NBLK, b = bh / NH, h = bh % NH;
        const bf16* kp = Z + ((size_t)b * T + j * 256) * NIN + ZK + h * HD + F.lane; float s = 0.f;
        for (int i = 0; i < 256; ++i) s += bf2f(kp[(size_t)i * NIN]);
        KM[(size_t)u * HD + F.lane] = s * (1.f / 256.f); }
}
__device__ __forceinline__ void final_norm(Frame& F, const float pscale) {
    float* out = (float*)F.dout; const float* ss = (const float*)(F.ws + WS_SS) + (size_t)2 * M * 16; const float* g = INP(24);
    const int gw = F.vcu * NWAVES + F.wave, NGW = F.G * NWAVES;
    for (int m = gw; m < M; m += NGW) { const float rstd = pg8::row_rstd(ss, (size_t)m) * pscale;
        GAS f32x4* o = (GAS f32x4*)(out + (size_t)m * D) + F.lane; const GAS f32x4* gr = (const GAS f32x4*)g + F.lane;
#pragma unroll
        for (int j = 0; j < 4; ++j) { f32x4 v = o[64 * j]; const f32x4 gg = gr[64 * j]; v = v * rstd * gg; o[64 * j] = v; } }
}
namespace attn_body {
typedef unsigned short bf16;
using bf16x8=__attribute__((ext_vector_type(8)))short;
using s16x4=__attribute__((ext_vector_type(4)))short;
using f32x16=__attribute__((ext_vector_type(16)))float;
using u32x4=__attribute__((ext_vector_type(4)))unsigned;
constexpr int SEQ=8192,D=64,QP=3328,OP=1024;
constexpr int NW=8,QBLK=32,QB=QBLK*NW,KVBLK=64,NQB=SEQ/QB;
__device__ __forceinline__ int crow(int r,int hi){return (r&3)+8*(r>>2)+4*hi;}
#define SBAR() __builtin_amdgcn_sched_barrier(0)
__device__ __forceinline__ void cmask(f32x16&p0,f32x16&p1,int jb,int qrel,int hi){
  const float NEG=-INFINITY; int kb=64*jb+4*hi;
  #pragma unroll
  for(int r=0;r<16;++r){int kv=kb+(r&3)+8*(r>>2); if(kv>qrel)p0[r]=NEG; if(kv+32>qrel)p1[r]=NEG;}
}

constexpr int NSLOT=3, SLOTB=8192;
constexpr int LDS_K=0, LDS_V=NSLOT*SLOTB, LDS_WS=2*NSLOT*SLOTB, LDS_OST=LDS_WS+NW*64*4, LDS_BYTES=LDS_OST+NW*4096;
constexpr float C2=0.125f*1.4426950408889634f;
__device__ __forceinline__ void glds16(const void*gsrc,unsigned lds_dst){unsigned keep;
  asm volatile("s_mov_b32 %0, m0\n\ts_mov_b32 m0, %2\n\ts_nop 0\n\tglobal_load_lds_dwordx4 %1, off\n\ts_mov_b32 m0, %0":"=&s"(keep):"v"(gsrc),"s"(lds_dst):"memory");}
__device__ __forceinline__ float max3f(float a,float b,float c){float r;asm("v_max3_f32 %0, %1, %2, %3":"=v"(r):"v"(a),"v"(b),"v"(c));return r;}
__device__ __forceinline__ float max2f(float a,float b){float r;asm("v_max_f32_e32 %0, %1, %2":"=v"(r):"v"(a),"v"(b));return r;}
__device__ __forceinline__ float fadd_s(float a,float b){float r;asm("v_add_f32_e32 %0, %1, %2":"=v"(r):"v"(a),"v"(b));return r;}
__device__ __forceinline__ float fsub_s(float a,float b){float r;asm("v_sub_f32_e32 %0, %1, %2":"=v"(r):"v"(a),"v"(b));return r;}
typedef float f32x2_t __attribute__((ext_vector_type(2))); typedef __bf16 bf16x2_t __attribute__((ext_vector_type(2)));
__device__ __forceinline__ unsigned cvtpk_s(float lo,float hi){f32x2_t v={lo,hi};bf16x2_t b=__builtin_convertvector(v,bf16x2_t);return __builtin_bit_cast(unsigned,b);}
#define WAIT_BAR(N) asm volatile("s_waitcnt vmcnt(" #N ") lgkmcnt(0)\n\ts_barrier":::"memory")

__device__ __forceinline__ void qkt(f32x16&p0,f32x16&p1,const char*Kslot,const bf16x8*qr,const f32x16&negm,int r32,int hi){
  const char*kb=Kslot+hi*1024+r32*16;
  #pragma unroll
  for(int d0=0;d0<4;++d0){
    const bf16x8 b0=*reinterpret_cast<const bf16x8*>(kb+d0*2048);
    const bf16x8 b1=*reinterpret_cast<const bf16x8*>(kb+d0*2048+512);
    if(d0==0){p0=__builtin_amdgcn_mfma_f32_32x32x16_bf16(b0,qr[0],negm,0,0,0);p1=__builtin_amdgcn_mfma_f32_32x32x16_bf16(b1,qr[0],negm,0,0,0);}
    else{p0=__builtin_amdgcn_mfma_f32_32x32x16_bf16(b0,qr[d0],p0,0,0,0);p1=__builtin_amdgcn_mfma_f32_32x32x16_bf16(b1,qr[d0],p1,0,0,0);}}
}
typedef __attribute__((address_space(3))) const char* lds_cptr;
typedef short v4i16_t __attribute__((ext_vector_type(4)));
__device__ __forceinline__ void kload8(bf16x8*kf,lds_cptr kp){
  kf[0]=*(const __attribute__((address_space(3))) bf16x8*)(kp);      kf[1]=*(const __attribute__((address_space(3))) bf16x8*)(kp+512);
  kf[2]=*(const __attribute__((address_space(3))) bf16x8*)(kp+2048); kf[3]=*(const __attribute__((address_space(3))) bf16x8*)(kp+2560);
  kf[4]=*(const __attribute__((address_space(3))) bf16x8*)(kp+4096); kf[5]=*(const __attribute__((address_space(3))) bf16x8*)(kp+4608);
  kf[6]=*(const __attribute__((address_space(3))) bf16x8*)(kp+6144); kf[7]=*(const __attribute__((address_space(3))) bf16x8*)(kp+6656);
}
__device__ __forceinline__ void kload2(bf16x8*kf,lds_cptr kp,int j){ kf[2*j]=*(const __attribute__((address_space(3))) bf16x8*)(kp+j*2048); kf[2*j+1]=*(const __attribute__((address_space(3))) bf16x8*)(kp+j*2048+512); }
__device__ __forceinline__ s16x4 vtr(lds_cptr p){ return __builtin_bit_cast(s16x4,__builtin_amdgcn_ds_read_tr16_b64_v4i16((__attribute__((address_space(3))) v4i16_t*)p)); }
__device__ __forceinline__ float rowmax(const f32x16&p0,const f32x16&p1){
  float a=max3f(p0[0],p0[1],p1[0]),b=max3f(p0[2],p0[3],p1[1]);a=max3f(a,p1[2],p1[3]);
  #pragma unroll
  for(int r=4;r<16;r+=4){a=max3f(a,p0[r],p0[r+1]);b=max3f(b,p0[r+2],p0[r+3]);a=max3f(a,p1[r],p1[r+1]);b=max3f(b,p1[r+2],p1[r+3]);}
  const float m=max2f(a,b);
  auto rr=__builtin_amdgcn_permlane32_swap(__float_as_uint(m),__float_as_uint(m),false,false);
  return max2f(__uint_as_float(rr[0]),__uint_as_float(rr[1]));
}
__device__ __forceinline__ void pv(f32x16*o,int vb,bf16x8 pa0,bf16x8 pa1,bf16x8 pa2,bf16x8 pa3){
  #pragma unroll
  for(int d0=0;d0<2;++d0){s16x4 lo[4],hi[4];
    #pragma unroll
    for(int ks=0;ks<4;++ks){
      asm volatile("ds_read_b64_tr_b16 %0,%1 offset:%c2":"=&v"(lo[ks]):"v"(vb),"i"(d0*4096+ks*1024):"memory");
      asm volatile("ds_read_b64_tr_b16 %0,%1 offset:%c2":"=&v"(hi[ks]):"v"(vb),"i"(d0*4096+ks*1024+512):"memory");}
    asm volatile("s_waitcnt lgkmcnt(0)":::"memory");SBAR();
    #define PK(k) (bf16x8){lo[k][0],lo[k][1],lo[k][2],lo[k][3],hi[k][0],hi[k][1],hi[k][2],hi[k][3]}
    o[d0]=__builtin_amdgcn_mfma_f32_32x32x16_bf16(pa0,PK(0),o[d0],0,0,0);
    o[d0]=__builtin_amdgcn_mfma_f32_32x32x16_bf16(pa1,PK(1),o[d0],0,0,0);
    o[d0]=__builtin_amdgcn_mfma_f32_32x32x16_bf16(pa2,PK(2),o[d0],0,0,0);
    o[d0]=__builtin_amdgcn_mfma_f32_32x32x16_bf16(pa3,PK(3),o[d0],0,0,0);
    #undef PK
  }
}

#ifndef ATTN_STORE16
#define ATTN_STORE16(p,v) (*(u32x4*)(p)=(v))
#endif
template<int THRL> __device__ __forceinline__ void attn_unit(int b,int h,int qb,const bf16*Q,const bf16*__restrict__ K,const bf16*__restrict__ V,bf16*O,const float*__restrict__ KMbh,char*shm,const int wid,const int lane){
  const int r32=lane&31,hi=lane>>5;
  const long rowbase=(long)b*SEQ; const int q0=qb*QB;
  const bf16*Qw=Q+(rowbase+q0+wid*QBLK)*QP+h*D;
  const bf16*Kh=K+rowbase*QP+h*D,*Vh=V+rowbase*QP+h*D;
  unsigned selmask=0u;
  { f32x16 g=f32x16{}; bf16x8 qg[4];
    #pragma unroll
    for(int d0=0;d0<4;++d0)qg[d0]=*reinterpret_cast<const bf16x8*>(&Qw[(long)r32*QP+d0*16+hi*8]);
    #pragma unroll
    for(int d0=0;d0<4;++d0){ const float4 a0=*reinterpret_cast<const float4*>(KMbh+r32*64+d0*16+hi*8), a1=*reinterpret_cast<const float4*>(KMbh+r32*64+d0*16+hi*8+4);
      u32x4 pk; pk[0]=cvtpk_s(a0.x,a0.y); pk[1]=cvtpk_s(a0.z,a0.w); pk[2]=cvtpk_s(a1.x,a1.y); pk[3]=cvtpk_s(a1.z,a1.w);
      g=__builtin_amdgcn_mfma_f32_32x32x16_bf16(__builtin_bit_cast(bf16x8,pk),qg[d0],g,0,0,0); }
    #pragma unroll
    for(int r=0;r<16;++r){ if(crow(r,hi)>=qb) g[r]=-INFINITY; }
    #pragma unroll
    for(int n=0;n<3;++n){ float bv=-INFINITY; int bi=64;
      #pragma unroll
      for(int r=0;r<16;++r){ if(g[r]>bv){bv=g[r];bi=crow(r,hi);} }
      const float pv_=__shfl_xor(bv,32); const int pi_=__shfl_xor(bi,32);
      const bool mine=(bv>pv_)||(bv==pv_&&bi<pi_); const float wv=mine?bv:pv_; const int wi=mine?bi:pi_;
      if(wv>-INFINITY){ selmask|=1u<<wi;
        #pragma unroll
        for(int r=0;r<16;++r){ if(crow(r,hi)==wi) g[r]=-INFINITY; } } }
    selmask|=1u<<qb; }
  asm volatile("":"+v"(selmask)); SBAR();
  const unsigned lds0=(unsigned)(uintptr_t)shm;
  float*wsf=(float*)(shm+LDS_WS)+wid*64;
  const bf16*ksrc=Kh+(long)lane*QP+wid*8;
  const bf16*vsrc=Vh+(long)(16*(wid&3)+(lane>>2))*QP+(wid>>2)*32+(lane&3)*8;
  const unsigned kdst=lds0+LDS_K+wid*1024, vdst=lds0+LDS_V+wid*1024;
  #define DMA_K(t,slot) glds16(ksrc+(long)(t)*KVBLK*QP,(unsigned)__builtin_amdgcn_readfirstlane(kdst+(slot)))
  #define DMA_V(t,slot) glds16(vsrc+(long)(t)*KVBLK*QP,(unsigned)__builtin_amdgcn_readfirstlane(vdst+(slot)))
  const int vb0=(int)(lds0+LDS_V)+((lane>>4)&1)*32+(lane&3)*8+(4*hi+((lane&15)>>2))*64;
  const char*Kbase=shm+LDS_K; bf16x8 kf[8];
  const lds_cptr shm3=(lds_cptr)shm; const lds_cptr kp0=shm3+LDS_K+hi*1024+r32*16; const lds_cptr vp0=shm3+LDS_V+((lane>>4)&1)*32+(lane&3)*8+(4*hi+((lane&15)>>2))*64;
  const int NT=(q0+QB)/KVBLK;
  DMA_K(0,0);DMA_V(0,0);DMA_K(1,SLOTB);
  bf16x8 qr[4];
  #pragma unroll
  for(int d0=0;d0<4;++d0)qr[d0]=*reinterpret_cast<const bf16x8*>(&Qw[(long)r32*QP+d0*16+hi*8]);
  float nok=((selmask&1u)!=0u||qb==0)?0.f:-INFINITY;
  float mhat=0.f,l_reg=0.f;f32x16 o[2];o[0]=f32x16{};o[1]=f32x16{};f32x16 negm;
  _Pragma("unroll") for(int r=0;r<16;++r)negm[r]=nok; asm volatile("":"+v"(negm));
  const int qrel=wid*QBLK+r32;
  #define CMASK(P0,P1,t) do{int jb_=(t)-(NT-4); if(jb_>=0)cmask(P0,P1,jb_,qrel,hi);}while(0)
  bool resc=false;
  #define START(P0,P1) do{ const float rm=rowmax(P0,P1); resc=false; \
    { const float dl=(rm==-INFINITY)?0.f:rm; mhat=fadd_s(mhat,dl); \
      _Pragma("unroll") for(int r=0;r<16;++r){P0[r]=fsub_s(P0[r],dl);P1[r]=fsub_s(P1[r],dl);} \
      { const float cv_=nok-mhat; _Pragma("unroll") for(int r=0;r<16;++r)negm[r]=cv_; } asm volatile("":"+v"(negm)); } \
    _Pragma("unroll") for(int r=0;r<16;++r)P0[r]=__builtin_amdgcn_exp2f(P0[r]); }while(0)
  #define RESC() do{ if(resc){ asm volatile("s_waitcnt lgkmcnt(0)":::"memory"); \
      _Pragma("unroll") for(int d_=0;d_<2;++d_) _Pragma("unroll") for(int r=0;r<16;++r)o[d_][r]*=wsf[crow(r,hi)]; } }while(0)
  f32x16 pA0,pA1,pB0,pB1;
  int sl_prev=0,sl_cur=0,sl_next=SLOTB;
  #define ROT() do{sl_prev=sl_cur;sl_cur=sl_next;sl_next=(sl_next==(NSLOT-1)*SLOTB)?0:sl_next+SLOTB;}while(0)
  DMA_K(2,2*SLOTB);
  WAIT_BAR(3);
  qkt(pA0,pA1,Kbase,qr,negm,r32,hi);asm volatile("s_nop 15\n\ts_nop 7":"+v"(pA0),"+v"(pA1));CMASK(pA0,pA1,0);
  START(pA0,pA1);
  _Pragma("unroll") for(int r=0;r<16;++r)pA1[r]=__builtin_amdgcn_exp2f(pA1[r]);
  WAIT_BAR(0);
  DMA_K(3,0);DMA_V(1,SLOTB);
  ROT();
  kload8(kf,kp0+sl_cur);
  WAIT_BAR(2);
  s16x4 vlo[8],vhi[8]; u32x4 pw0,pw1,pw2,pw3;
  #define PKW(P,B) cvtpk_s(P[B],P[B+1])
  #define PAF(k) __builtin_bit_cast(bf16x8,pw##k)
  #define VFR(i) (bf16x8){vlo[i][0],vlo[i][1],vlo[i][2],vlo[i][3],vhi[i][0],vhi[i][1],vhi[i][2],vhi[i][3]}
  #define PIN(x) asm volatile("":"+v"(x))
  #define MX3(a,b,c) __builtin_fmaxf(__builtin_fmaxf((a),(b)),(c))
  #define GAPA(MF,A0,A1,A2,A3,W0,W1,PW) do{ MF; sacc+=A0; sacc+=A1; sacc+=A2; sacc+=A3; PIN(sacc); W0; W1; PIN(PW); SBAR(); }while(0)
  #define EX(v) __builtin_amdgcn_exp2f(v)
  #define GAPB(MF,X,B) do{ MF; X[B]=EX(X[B]); X[B+1]=EX(X[B+1]); X[B+2]=EX(X[B+2]); X[B+3]=EX(X[B+3]); PIN(X); SBAR(); }while(0)
  #define VRD(i) do{ vlo[i]=vtr(vp_+(((i)>>2)*4096+((i)&3)*1024)); vhi[i]=vtr(vp_+(((i)>>2)*4096+((i)&3)*1024+512)); }while(0)
  #define KRD(G,j) do{ if(G){ kload2(kf,kp0+sl_next,j); SBAR(); } }while(0)
  #define STEP(C0,C1,P0,P1,t,GK,GV,GL) do{ SBAR(); \
    const lds_cptr vp_=vp0+sl_prev; \
    VRD(0); SBAR(); float sacc=(P0[0]+P0[1]); \
    GAPA(C0=__builtin_amdgcn_mfma_f32_32x32x16_bf16(kf[0],qr[0],negm,0,0,0), P0[2],P0[3],P0[4],P0[5],     pw0[0]=PKW(P0,0), pw0[1]=PKW(P0,2), pw0); \
    VRD(4); SBAR(); GAPA(C1=__builtin_amdgcn_mfma_f32_32x32x16_bf16(kf[1],qr[0],negm,0,0,0), P0[6],P0[7],P0[8],P0[9],     pw0[2]=PKW(P0,4), pw0[3]=PKW(P0,6), pw0); \
    VRD(1); SBAR(); GAPA(C0=__builtin_amdgcn_mfma_f32_32x32x16_bf16(kf[2],qr[1],C0,0,0,0),   P0[10],P0[11],P0[12],P0[13], pw1[0]=PKW(P0,8), pw1[1]=PKW(P0,10), pw1); \
    VRD(5); SBAR(); GAPA(C1=__builtin_amdgcn_mfma_f32_32x32x16_bf16(kf[3],qr[1],C1,0,0,0),   P0[14],P0[15],P1[0],P1[1],   pw1[2]=PKW(P0,12),pw1[3]=PKW(P0,14), pw1); \
    VRD(2); SBAR(); GAPA(C0=__builtin_amdgcn_mfma_f32_32x32x16_bf16(kf[4],qr[2],C0,0,0,0),   P1[2],P1[3],P1[4],P1[5],     pw2[0]=PKW(P1,0), pw2[1]=PKW(P1,2), pw2); \
    VRD(6); SBAR(); GAPA(C1=__builtin_amdgcn_mfma_f32_32x32x16_bf16(kf[5],qr[2],C1,0,0,0),   P1[6],P1[7],P1[8],P1[9],     pw2[2]=PKW(P1,4), pw2[3]=PKW(P1,6), pw2); \
    VRD(3); SBAR(); GAPA(C0=__builtin_amdgcn_mfma_f32_32x32x16_bf16(kf[6],qr[3],C0,0,0,0),   P1[10],P1[11],P1[12],P1[13], pw3[0]=PKW(P1,8), pw3[1]=PKW(P1,10), pw3); \
    VRD(7); SBAR(); GAPA(C1=__builtin_amdgcn_mfma_f32_32x32x16_bf16(kf[7],qr[3],C1,0,0,0),   P1[14],P1[15],0.f,0.f,       pw3[2]=PKW(P1,12),pw3[3]=PKW(P1,14), pw3); \
    l_reg+=sacc; \
    if(GK){DMA_K((t)+3,sl_cur);} if(GV){DMA_V((t)+1,sl_next);} \
    CMASK(C0,C1,t); \
    { float a=MX3(C0[0],C0[1],C1[0]),b=MX3(C0[2],C0[3],C1[1]); a=MX3(a,C1[2],C1[3]); \
      _Pragma("unroll") for(int r=4;r<16;r+=4){a=MX3(a,C0[r],C0[r+1]);b=MX3(b,C0[r+2],C0[r+3]);a=MX3(a,C1[r],C1[r+1]);b=MX3(b,C1[r+2],C1[r+3]);} \
      float rm=__builtin_fmaxf(a,b); { auto rr=__builtin_amdgcn_permlane32_swap(__float_as_uint(rm),__float_as_uint(rm),false,false); rm=__builtin_fmaxf(__uint_as_float(rr[0]),__uint_as_float(rr[1])); } \
      resc=false; \
      if(__builtin_expect(__any(rm>(float)THRL),0)){ const float dl=__builtin_fmaxf(rm,0.f); mhat+=dl; \
        _Pragma("unroll") for(int r=0;r<16;++r){C0[r]-=dl;C1[r]-=dl;} \
        { const float cv_=nok-mhat; _Pragma("unroll") for(int r=0;r<16;++r)negm[r]=cv_; } asm volatile("":"+v"(negm)); \
        const float f=__builtin_amdgcn_exp2f(-dl); l_reg*=f; if(hi==0)wsf[r32]=f; resc=true; } } \
    SBAR(); \
    GAPB(o[0]=__builtin_amdgcn_mfma_f32_32x32x16_bf16(PAF(0),VFR(0),o[0],0,0,0), C0,0); \
    GAPB(o[1]=__builtin_amdgcn_mfma_f32_32x32x16_bf16(PAF(0),VFR(4),o[1],0,0,0), C0,4); \
    KRD(GL,0); GAPB(o[0]=__builtin_amdgcn_mfma_f32_32x32x16_bf16(PAF(1),VFR(1),o[0],0,0,0), C0,8); \
    KRD(GL,1); GAPB(o[1]=__builtin_amdgcn_mfma_f32_32x32x16_bf16(PAF(1),VFR(5),o[1],0,0,0), C0,12); \
    KRD(GL,2); GAPB(o[0]=__builtin_amdgcn_mfma_f32_32x32x16_bf16(PAF(2),VFR(2),o[0],0,0,0), C1,0); \
    KRD(GL,3); GAPB(o[1]=__builtin_amdgcn_mfma_f32_32x32x16_bf16(PAF(2),VFR(6),o[1],0,0,0), C1,4); \
    GAPB(o[0]=__builtin_amdgcn_mfma_f32_32x32x16_bf16(PAF(3),VFR(3),o[0],0,0,0), C1,8); \
    GAPB(o[1]=__builtin_amdgcn_mfma_f32_32x32x16_bf16(PAF(3),VFR(7),o[1],0,0,0), C1,12); \
    }while(0)
  #define MASKUPD(tt) do{ if((((tt))&3)==0){ nok=((selmask>>((tt)>>2))&1u)?0.f:-INFINITY; const float cv_=nok-mhat; _Pragma("unroll") for(int r=0;r<16;++r)negm[r]=cv_; asm volatile("":"+v"(negm)); } }while(0)
  int t=1;
  #undef CMASK
  #define CMASK(P0,P1,t) do{}while(0)
  for(;t+5<NT;t+=2){
    STEP(pB0,pB1,pA0,pA1,t,true,true,true);     WAIT_BAR(2); RESC(); ROT(); MASKUPD(t+1);
    STEP(pA0,pA1,pB0,pB1,t+1,true,true,true);   WAIT_BAR(2); RESC(); ROT();
  }
  #undef CMASK
  #define CMASK(P0,P1,t) do{int jb_=(t)-(NT-4); if(jb_>=0)cmask(P0,P1,jb_,qrel,hi);}while(0)
  #define ENDW(tt) do{ if((tt)+3<NT){WAIT_BAR(2);} else if((tt)+2<NT){WAIT_BAR(1);} else {WAIT_BAR(0);} }while(0)
  for(;t+1<NT;t+=2){
    STEP(pB0,pB1,pA0,pA1,t,(t+3<NT),(t+1<NT),(t+1<NT));       ENDW(t);   RESC(); ROT(); MASKUPD(t+1);
    STEP(pA0,pA1,pB0,pB1,t+1,(t+4<NT),(t+2<NT),(t+2<NT));     ENDW(t+1); RESC(); ROT();
  }
  STEP(pB0,pB1,pA0,pA1,NT-1,false,false,false); RESC();
  { float sacc=pB0[0]+pB0[1]; _Pragma("unroll") for(int r=2;r<16;++r)sacc+=pB0[r]; _Pragma("unroll") for(int r=0;r<16;++r)sacc+=pB1[r]; l_reg+=sacc;
    pw0=(u32x4){PKW(pB0,0),PKW(pB0,2),PKW(pB0,4),PKW(pB0,6)};pw1=(u32x4){PKW(pB0,8),PKW(pB0,10),PKW(pB0,12),PKW(pB0,14)};pw2=(u32x4){PKW(pB1,0),PKW(pB1,2),PKW(pB1,4),PKW(pB1,6)};pw3=(u32x4){PKW(pB1,8),PKW(pB1,10),PKW(pB1,12),PKW(pB1,14)};
    SBAR(); pv(o,vb0+sl_cur,PAF(0),PAF(1),PAF(2),PAF(3)); }
  #undef PKW
  #undef PAF
  #undef VFR
  #undef PIN
  #undef MX3
  #undef GAPA
  #undef GAPB
  #undef EX
  #undef VRD
  #undef KRD
  #undef STEP
  #undef ENDW
  #undef MASKUPD
  {auto rr=__builtin_amdgcn_permlane32_swap(__float_as_uint(l_reg),__float_as_uint(l_reg),false,false);l_reg=__uint_as_float(rr[0])+__uint_as_float(rr[1]);}
  if(hi==0)wsf[32+r32]=l_reg;asm volatile("s_waitcnt lgkmcnt(0)":::"memory");
  float rli[16];
  #pragma unroll
  for(int r=0;r<16;++r)rli[r]=__builtin_amdgcn_rcpf(wsf[32+crow(r,hi)]);
  bf16*Ow=O+(rowbase+q0+wid*QBLK)*OP+h*D;
  { bf16*stg=(bf16*)(shm+LDS_OST)+wid*2048;
    #pragma unroll
    for(int r=0;r<16;++r){const int orow=crow(r,hi);
      #pragma unroll
      for(int d0=0;d0<2;++d0)stg[orow*64+d0*32+r32]=(bf16)(cvtpk_s(o[d0][r]*rli[r],0.f)&0xffffu);}
    asm volatile("s_waitcnt lgkmcnt(0)":::"memory");
    #pragma unroll
    for(int i=0;i<4;++i){const int row=i*8+(lane>>3),ch=lane&7; const u32x4 v=*(const u32x4*)(stg+row*64+ch*8); ATTN_STORE16(Ow+(long)row*OP+ch*8,v);} }
  asm volatile("s_waitcnt lgkmcnt(0)\n\ts_barrier":::"memory");
  #undef DMA_K
  #undef DMA_V
  #undef CMASK
  #undef START
  #undef RESC
  #undef ROT
}
constexpr int ATTN_LDS_BYTES=LDS_BYTES;
#undef SBAR
#undef WAIT_BAR
}
namespace rscan {
typedef short bf16x8 __attribute__((ext_vector_type(8)));
typedef float f32x4 __attribute__((ext_vector_type(4)));
typedef float f32x16 __attribute__((ext_vector_type(16)));
typedef unsigned u32x2 __attribute__((ext_vector_type(2)));
typedef unsigned u32x4 __attribute__((ext_vector_type(4)));
constexpr int LS = 144;
constexpr int LB = 64 * LS;
constexpr int NCHUNK = T / 64;
__device__ __forceinline__ unsigned pkbf(float lo, float hi) { typedef float f2 __attribute__((ext_vector_type(2))); typedef __bf16 b2 __attribute__((ext_vector_type(2))); f2 v = {lo, hi}; return __builtin_bit_cast(unsigned, __builtin_convertvector(v, b2)); }

__device__ __forceinline__ void mm(f32x4 (&acc)[2], LAS unsigned char* lds, int z1, int z2, int ta, int tbh, int fr, int fq) {
    const LAS unsigned char* p1 = lds + z1 + (16 * ta + fr) * LS + fq * 16;
    const LAS unsigned char* p2 = lds + z2 + (32 * tbh + fr) * LS + fq * 16;
    const bf16x8 a0 = *(const LAS bf16x8*)(p1), a1 = *(const LAS bf16x8*)(p1 + 64);
    const bf16x8 b00 = *(const LAS bf16x8*)(p2), b01 = *(const LAS bf16x8*)(p2 + 64), b10 = *(const LAS bf16x8*)(p2 + 16 * LS), b11 = *(const LAS bf16x8*)(p2 + 16 * LS + 64);
    acc[0] = __builtin_amdgcn_mfma_f32_16x16x32_bf16(a0, b00, acc[0], 0, 0, 0); acc[0] = __builtin_amdgcn_mfma_f32_16x16x32_bf16(a1, b01, acc[0], 0, 0, 0);
    acc[1] = __builtin_amdgcn_mfma_f32_16x16x32_bf16(a0, b10, acc[1], 0, 0, 0); acc[1] = __builtin_amdgcn_mfma_f32_16x16x32_bf16(a1, b11, acc[1], 0, 0, 0);
}
template <int MASK, bool DIAG1> __device__ __forceinline__ void st_lds(const f32x4 (&acc)[2], LAS unsigned char* lds, int dst, int ta, int tbh, int fr, int fq) {
#pragma unroll
    for (int tb = 0; tb < 2; ++tb) { const int b = 32 * tbh + 16 * tb + fr, a0 = 16 * ta + 4 * fq; float v[4];
#pragma unroll
        for (int i = 0; i < 4; ++i) { const int a = a0 + i; float x = acc[tb][i];
            if (MASK == 1) x = (a < b) ? x : 0.f; if (MASK == 2) x = (a <= b) ? x : 0.f; if (MASK == 3) x = (b < a) ? x : 0.f; if (DIAG1) x = (a == b) ? 1.f : x; v[i] = x; }
        u32x2 w; w.x = pkbf(v[0], v[1]); w.y = pkbf(v[2], v[3]); *(LAS u32x2*)(lds + dst + b * LS + a0 * 2) = w; }
}
template <bool PERM> __device__ __forceinline__ void st_glb(const f32x4 (&acc)[2], bf16* g, int ta, int tbh, int fr, int fq) {
#pragma unroll
    for (int tb = 0; tb < 2; ++tb) { const int b = 32 * tbh + 16 * tb + fr; int a0 = 16 * ta + 4 * fq; if (PERM) a0 = (a0 & ~12) | ((a0 & 4) << 1) | ((a0 & 8) >> 1);
        u32x2 w; w.x = pkbf(acc[tb][0], acc[tb][1]); w.y = pkbf(acc[tb][2], acc[tb][3]); *(GAS u32x2*)(g + (size_t)b * RW + a0) = w; }
}

__device__ __forceinline__ float wsum_fast(float x) { x = red16(x);
    x += __builtin_bit_cast(float, __builtin_amdgcn_update_dpp(0, __builtin_bit_cast(int, x), 0x142, 0xa, 0xf, false));
    x += __builtin_bit_cast(float, __builtin_amdgcn_update_dpp(0, __builtin_bit_cast(int, x), 0x143, 0xc, 0xf, false));
    return __builtin_bit_cast(float, __builtin_amdgcn_readlane(__builtin_bit_cast(int, x), 63)); }
constexpr int LS2 = 272;
__device__ __forceinline__ void mm128(f32x4 (&acc)[2], LAS unsigned char* lds, int z1, int z2, int ta, int tbh, int fr, int fq) {
    const LAS unsigned char* p1 = lds + z1 + (16 * ta + fr) * LS2 + fq * 16;
    const LAS unsigned char* p2 = lds + z2 + (32 * tbh + fr) * LS2 + fq * 16;
#pragma unroll
    for (int s = 0; s < 4; ++s) { const bf16x8 a = *(const LAS bf16x8*)(p1 + 64 * s), b0 = *(const LAS bf16x8*)(p2 + 64 * s), b1 = *(const LAS bf16x8*)(p2 + 16 * LS2 + 64 * s);
        acc[0] = __builtin_amdgcn_mfma_f32_16x16x32_bf16(a, b0, acc[0], 0, 0, 0); acc[1] = __builtin_amdgcn_mfma_f32_16x16x32_bf16(a, b1, acc[1], 0, 0, 0); }
}
__device__ __forceinline__ void st_lds_f32(const f32x4 (&acc)[2], LAS unsigned char* lds, int dst, int ta, int tbh, int fr, int fq) {
#pragma unroll
    for (int tb = 0; tb < 2; ++tb) { const int b = 32 * tbh + 16 * tb + fr, a0 = 16 * ta + 4 * fq; *(LAS f32x4*)(lds + dst + b * LS2 + a0 * 4) = acc[tb]; }
}

__device__ __forceinline__ void scan_pre(Frame& F) {
    LAS unsigned char* lds = F.lds + RING_OFF;
    const int w = F.wave, lane = F.lane, fr = lane & 15, fq = lane >> 4, ta = w & 3, tbh = w >> 2;
    const bf16* Z = (const bf16*)(F.ws + WS_Z); const float* mu = INP(4);
    const bf16* WupT = (const bf16*)(F.ws + WS_LORA); const bf16* AupT = WupT + RW * 64; const bf16* GupT = AupT + RW * 64;
    bf16* aLW = (bf16*)(F.dout + DO_W); bf16* aKP = (bf16*)(F.dout + DO_KP); bf16* aKK = (bf16*)(F.dout + DO_KKN); bf16* aB = (bf16*)(F.dout + DO_B);
    bf16* oG = (bf16*)(F.ws + WS_GATE); float* oBon = (float*)(F.ws + WS_BON);
    enum { bAt = 0, bBt = LB, bKt = 2 * LB, bRt = 3 * LB, bAtT = 4 * LB, bVT = 5 * LB, bBhT = 6 * LB, bKhT = 7 * LB, b8 = 8 * LB, b9 = 9 * LB, b10 = 10 * LB, bAak = 11 * LB, bArb = 12 * LB, bArk = 13 * LB };
    enum { lXw = 0, lXa = LB, lXg = 2 * LB, lWw = 2 * LB + 64 * LS2, lWa = lWw + LB, lWg = lWa + LB, lDw = 8 * LB, lDa = lDw + 64 * LS2, lDg = lDa + 64 * LS2 };
    static_assert(lWg + 64 * LS2 <= 8 * LB && lDg + 64 * LS2 <= 14 * LB, "LoRA stage LDS carve");
    for (int u = F.vcu; u < BATCH * NH * NCHUNK; u += F.G) {
        const int c = u % NCHUNK, bh = u / NCHUNK, b = bh / NH, h = bh % NH;
        const size_t m0 = (size_t)b * T + (size_t)c * 64;
        const size_t so = m0 * RW + h * HD;
        { const int t = F.tid >> 3, g0 = F.tid & 7; const bf16* zrow = Z + (m0 + t) * NIN + ZWD; const bool firstrow = (c == 0 && t == 0);
          u32x4 cur[4], prv[4];
#pragma unroll
          for (int i = 0; i < 4; ++i) { cur[i] = *(const GAS u32x4*)(zrow + 8 * (g0 + 8 * i)); prv[i] = (u32x4){0u, 0u, 0u, 0u}; if (!firstrow) prv[i] = *(const GAS u32x4*)(zrow - (long)NIN + 8 * (g0 + 8 * i)); }
          { const int row = F.tid >> 3, ch = F.tid & 7;
            *(LAS u32x4*)(lds + lWw + row * LS + ch * 16) = *(const GAS u32x4*)(WupT + (size_t)(h * HD + row) * 64 + ch * 8);
            *(LAS u32x4*)(lds + lWa + row * LS + ch * 16) = *(const GAS u32x4*)(AupT + (size_t)(h * HD + row) * 64 + ch * 8); }
#pragma unroll
          for (int i = 0; i < 2; ++i) { const int pp = F.tid + 512 * i, row = pp >> 4, ch = pp & 15; *(LAS u32x4*)(lds + lWg + row * LS2 + ch * 16) = *(const GAS u32x4*)(GupT + (size_t)(h * HD + row) * 128 + ch * 8); }
#pragma unroll
          for (int i = 0; i < 4; ++i) { const int col0 = 8 * (g0 + 8 * i); const f32x4 ma = *(const GAS f32x4*)(mu + ZWD + col0), mb = *(const GAS f32x4*)(mu + ZWD + col0 + 4);
              float z[8];
#pragma unroll
              for (int q = 0; q < 4; ++q) { const unsigned cw = cur[i][q], pw = prv[i][q]; const float c0 = bflo(cw), c1 = bfhi(cw), p0 = bflo(pw), p1 = bfhi(pw);
                  const float m0_ = q < 2 ? ma[2 * q] : mb[2 * q - 4], m1_ = q < 2 ? ma[2 * q + 1] : mb[2 * q - 3];
                  z[2 * q] = c0 + (p0 - c0) * m0_; z[2 * q + 1] = c1 + (p1 - c1) * m1_; }
#pragma unroll
              for (int q = 0; q < 8; ++q) { if (i == 0) z[q] = 1.f - 2.f / (1.f + __expf(2.f * z[q])); else if (i >= 2) z[q] = 1.f / (1.f + __expf(-z[q])); }
              u32x4 o; o.x = pkbf(z[0], z[1]); o.y = pkbf(z[2], z[3]); o.z = pkbf(z[4], z[5]); o.w = pkbf(z[6], z[7]);
              const int dst = i == 0 ? lXw + t * LS : (i == 1 ? lXa + t * LS : lXg + t * LS2 + (i - 2) * 128);
              *(LAS u32x4*)(lds + dst + g0 * 16) = o; }
        }
        __syncthreads();
        { f32x4 acc[2];
          acc[0] = (f32x4){0.f, 0.f, 0.f, 0.f}; acc[1] = acc[0]; mm(acc, lds, lWw, lXw, ta, tbh, fr, fq); st_lds_f32(acc, lds, lDw, ta, tbh, fr, fq);
          acc[0] = (f32x4){0.f, 0.f, 0.f, 0.f}; acc[1] = acc[0]; mm(acc, lds, lWa, lXa, ta, tbh, fr, fq); st_lds_f32(acc, lds, lDa, ta, tbh, fr, fq);
          acc[0] = (f32x4){0.f, 0.f, 0.f, 0.f}; acc[1] = acc[0]; mm128(acc, lds, lWg, lXg, ta, tbh, fr, fq); st_lds_f32(acc, lds, lDg, ta, tbh, fr, fq); }
        __syncthreads();
        { const int cg = h * HD + lane;
          const float w0_ = INP(5)[cg], a0_ = INP(7)[cg], kkc = INP(10)[cg], kac = INP(11)[cg], rkc = INP(12)[cg], mur = mu[cg], muk = mu[ZK_R + cg], muv = mu[ZV_R + cg];
          const bf16* zr = Z + (m0 + 8 * w) * NIN + cg; const bool first = (c == 0 && w == 0);
          unsigned short zr_[9], zk_[9], zv_[9];
          zr_[0] = 0; zk_[0] = 0; zv_[0] = 0; if (!first) { zr_[0] = zr[-(long)NIN]; zk_[0] = zr[-(long)NIN + ZK_R]; zv_[0] = zr[-(long)NIN + ZV_R]; }
#pragma unroll
          for (int i = 0; i < 8; ++i) { zr_[i + 1] = zr[(size_t)i * NIN]; zk_[i + 1] = zr[(size_t)i * NIN + ZK_R]; zv_[i + 1] = zr[(size_t)i * NIN + ZV_R]; }
          float lwv[8], e_at[8], e_bb[8], e_kp[8], e_r[8], e_v[8]; float lsum = 0.f;
#pragma unroll
          for (int i = 0; i < 8; ++i) { const int t = 8 * w + i;
              const float cr = bf2f(zr_[i + 1]), ck = bf2f(zk_[i + 1]), cv = bf2f(zv_[i + 1]), pr = bf2f(zr_[i]), pk = bf2f(zk_[i]), pv = bf2f(zv_[i]);
              const float r = cr + (pr - cr) * mur, kx = ck + (pk - ck) * muk, v = cv + (pv - cv) * muv;
              const float dw = w0_ + *(const LAS float*)(lds + lDw + t * LS2 + lane * 4), da = a0_ + *(const LAS float*)(lds + lDa + t * LS2 + lane * 4), gg = *(const LAS float*)(lds + lDg + t * LS2 + lane * 4);
              const float lw = -DECAY_SCALE / (1.f + __expf(-dw)), a = 1.f / (1.f + __expf(-da));
              const float kk = kx * kkc; const float nn = wsum_fast(kk * kk); const float kkn = kk / fmaxf(sqrtf(nn), 1e-12f);
              const float kp = kx * (1.f + (a - 1.f) * kac), bb = kkn * a; const float bon = wsum_fast(r * kp * rkc);
              oG[(m0 + t) * RW + cg] = (bf16)f2bf(gg); if (lane == 0) oBon[(m0 + t) * NH + h] = bon;
              lwv[i] = lw; lsum += lw; e_at[i] = -kkn; e_bb[i] = bb; e_kp[i] = kp; e_r[i] = r; e_v[i] = v; }
          *(LAS float*)(lds + 14 * LB + (w * 64 + lane) * 4) = lsum;
          __syncthreads();
          float ltot = 0.f, lst = 0.f;
#pragma unroll
          for (int q = 0; q < 8; ++q) { const float sq = *(const LAS float*)(lds + 14 * LB + (q * 64 + lane) * 4); if (q < w) lst += sq; ltot += sq; }
          float L = lst; unsigned short pAtT[8], pVT[8], pBhT[8], pKhT[8];
#pragma unroll
          for (int i = 0; i < 8; ++i) { const int t = 8 * w + i;
              const float Pm = __expf(L); L += lwv[i]; const float P = __expf(L), iP = __expf(-L), Ph = __expf(ltot - L);
              const unsigned short at = (unsigned short)f2bf(e_at[i] * Pm);
              *(LAS unsigned short*)(lds + bAt + t * LS + lane * 2) = at; *(LAS unsigned short*)(lds + bBt + t * LS + lane * 2) = (unsigned short)f2bf(e_bb[i] * iP);
              *(LAS unsigned short*)(lds + bKt + t * LS + lane * 2) = (unsigned short)f2bf(e_kp[i] * iP); *(LAS unsigned short*)(lds + bRt + t * LS + lane * 2) = (unsigned short)f2bf(e_r[i] * P);
              pAtT[i] = at; pVT[i] = (unsigned short)f2bf(e_v[i]); pBhT[i] = (unsigned short)f2bf(e_bb[i] * Ph); pKhT[i] = (unsigned short)f2bf(e_kp[i] * Ph); }
#define RS_W16(buf, p) do { u32x4 q_; q_.x = p[0] | ((unsigned)p[1] << 16); q_.y = p[2] | ((unsigned)p[3] << 16); q_.z = p[4] | ((unsigned)p[5] << 16); q_.w = p[6] | ((unsigned)p[7] << 16); *(LAS u32x4*)(lds + (buf) + lane * LS + 16 * w) = q_; } while (0)
          RS_W16(bAtT, pAtT); RS_W16(bVT, pVT); RS_W16(bBhT, pBhT); RS_W16(bKhT, pKhT);
#undef RS_W16
          asm volatile("" :: "v"(ltot));
          __syncthreads();
          f32x4 acc[2], tacc[2];
#define RS_Z(a) do { a[0] = (f32x4){0.f, 0.f, 0.f, 0.f}; a[1] = (f32x4){0.f, 0.f, 0.f, 0.f}; } while (0)
          RS_Z(acc); mm(acc, lds, bAt, bBt, ta, tbh, fr, fq); st_lds<3, false>(acc, lds, b9, ta, tbh, fr, fq);
          RS_Z(acc); mm(acc, lds, bKt, bAt, ta, tbh, fr, fq); st_lds<1, false>(acc, lds, bAak, ta, tbh, fr, fq);
          RS_Z(acc); mm(acc, lds, bBt, bRt, ta, tbh, fr, fq); st_lds<2, false>(acc, lds, bArb, ta, tbh, fr, fq);
          RS_Z(acc); mm(acc, lds, bKt, bRt, ta, tbh, fr, fq); st_lds<2, false>(acc, lds, bArk, ta, tbh, fr, fq);
          RS_Z(tacc); mm(tacc, lds, bBt, bAt, ta, tbh, fr, fq);
#pragma unroll
          for (int tb = 0; tb < 2; ++tb)
#pragma unroll
              for (int i = 0; i < 4; ++i) { const int bb_ = 32 * tbh + 16 * tb + fr, a = 16 * ta + 4 * fq + i; tacc[tb][i] = (a < bb_) ? tacc[tb][i] : 0.f; }
          st_lds<0, false>(tacc, lds, b8, ta, tbh, fr, fq);
#pragma unroll
          for (int tb = 0; tb < 2; ++tb)
#pragma unroll
              for (int i = 0; i < 4; ++i) { const int bb_ = 32 * tbh + 16 * tb + fr, a = 16 * ta + 4 * fq + i; if (a == bb_) tacc[tb][i] = 1.f; }
          st_lds<0, false>(tacc, lds, b10, ta, tbh, fr, fq);
          __syncthreads();
          RS_Z(acc); mm(acc, lds, b9, b8, ta, tbh, fr, fq); st_lds<0, false>(acc, lds, bAt, ta, tbh, fr, fq);
          RS_Z(acc); mm(acc, lds, b8, b9, ta, tbh, fr, fq); st_lds<0, false>(acc, lds, bBt, ta, tbh, fr, fq);
          __syncthreads();
          mm(tacc, lds, bBt, b10, ta, tbh, fr, fq); st_lds<0, false>(tacc, lds, bKt, ta, tbh, fr, fq);
          RS_Z(acc); mm(acc, lds, bBt, bAt, ta, tbh, fr, fq); st_lds<0, false>(acc, lds, b8, ta, tbh, fr, fq);
          RS_Z(acc); mm(acc, lds, bAt, bBt, ta, tbh, fr, fq); st_lds<0, false>(acc, lds, b9, ta, tbh, fr, fq);
          __syncthreads();
          mm(tacc, lds, b9, bKt, ta, tbh, fr, fq); st_lds<0, false>(tacc, lds, b10, ta, tbh, fr, fq);
          RS_Z(acc); mm(acc, lds, b9, b8, ta, tbh, fr, fq); st_lds<0, false>(acc, lds, bAt, ta, tbh, fr, fq);
          RS_Z(acc); mm(acc, lds, b8, b9, ta, tbh, fr, fq); st_lds<0, false>(acc, lds, bBt, ta, tbh, fr, fq);
          __syncthreads();
          mm(tacc, lds, bBt, b10, ta, tbh, fr, fq); st_lds<0, false>(tacc, lds, bKt, ta, tbh, fr, fq);
          RS_Z(acc); mm(acc, lds, bBt, bAt, ta, tbh, fr, fq); st_lds<0, false>(acc, lds, b8, ta, tbh, fr, fq);
          RS_Z(acc); mm(acc, lds, bAt, bBt, ta, tbh, fr, fq); st_lds<0, false>(acc, lds, b9, ta, tbh, fr, fq);
          __syncthreads();
          mm(tacc, lds, b9, bKt, ta, tbh, fr, fq); st_lds<0, false>(tacc, lds, b10, ta, tbh, fr, fq);
          RS_Z(acc); mm(acc, lds, b8, b9, ta, tbh, fr, fq); st_lds<0, false>(acc, lds, bBt, ta, tbh, fr, fq);
          __syncthreads();
          mm(tacc, lds, bBt, b10, ta, tbh, fr, fq); st_lds<0, false>(tacc, lds, bKt, ta, tbh, fr, fq);
          __syncthreads();
          RS_Z(acc); mm(acc, lds, bKt, bAtT, ta, tbh, fr, fq); st_lds<0, false>(acc, lds, bAt, ta, tbh, fr, fq);
          RS_Z(acc); mm(acc, lds, bAak, bVT, ta, tbh, fr, fq); st_lds<0, false>(acc, lds, b8, ta, tbh, fr, fq);
          __syncthreads();
          RS_Z(acc); mm(acc, lds, bKt, b8, ta, tbh, fr, fq); st_lds<0, false>(acc, lds, b9, ta, tbh, fr, fq);
          __syncthreads();
          RS_Z(acc); mm(acc, lds, bAt, bArb, ta, tbh, fr, fq);
#pragma unroll
          for (int tb = 0; tb < 2; ++tb) { const int bb_ = 32 * tbh + 16 * tb + fr, a0 = 16 * ta + 4 * fq; const u32x2 q_ = *(const LAS u32x2*)(lds + bRt + bb_ * LS + a0 * 2);
              acc[tb][0] += bflo(q_.x); acc[tb][1] += bfhi(q_.x); acc[tb][2] += bflo(q_.y); acc[tb][3] += bfhi(q_.y); }
          st_glb<false>(acc, aLW + so, ta, tbh, fr, fq);
          RS_Z(acc); mm(acc, lds, b9, bArb, ta, tbh, fr, fq); mm(acc, lds, bVT, bArk, ta, tbh, fr, fq); st_glb<false>(acc, aKK + so, ta, tbh, fr, fq);
          RS_Z(acc); mm(acc, lds, bAt, bBhT, ta, tbh, fr, fq);
          { const float pc = __expf(ltot);
#pragma unroll
            for (int tb = 0; tb < 2; ++tb) { const int bb_ = 32 * tbh + 16 * tb + fr; const float pcb = __shfl(pc, bb_);
#pragma unroll
                for (int i = 0; i < 4; ++i) { const int a = 16 * ta + 4 * fq + i; if (a == bb_) acc[tb][i] += pcb; } } }
          st_glb<true>(acc, aKP + so, ta, tbh, fr, fq);
          RS_Z(acc); mm(acc, lds, bBhT, b9, ta, tbh, fr, fq); mm(acc, lds, bKhT, bVT, ta, tbh, fr, fq); st_glb<false>(acc, aB + so, ta, tbh, fr, fq);
#undef RS_Z
          __syncthreads();
        }
    }
}

__device__ __forceinline__ void scan_seq(Frame& F, int bh) {
    const int lane = F.lane, r32 = lane & 31, hi = lane >> 5; const int b = bh / NH, h = bh % NH;
    const bf16* aM = (const bf16*)(F.dout + DO_KP); const bf16* aN = (const bf16*)(F.dout + DO_B); bf16* XS = (bf16*)(F.ws + WS_YRAW);
    f32x16 X[2][2];
#pragma unroll
    for (int i = 0; i < 2; ++i)
#pragma unroll
        for (int j = 0; j < 2; ++j) X[i][j] = f32x16{};
    for (int c = 0; c < NCHUNK; ++c) {
        const size_t so = ((size_t)b * T + (size_t)c * 64) * RW + h * HD;
        bf16* xs = XS + ((size_t)bh * NCHUNK + c) * 4096;
        bf16x8 am[2][2][2];
#pragma unroll
        for (int t1 = 0; t1 < 2; ++t1)
#pragma unroll
            for (int t2 = 0; t2 < 2; ++t2)
#pragma unroll
                for (int s = 0; s < 2; ++s) am[t1][t2][s] = *(const GAS bf16x8*)(aM + so + (size_t)(32 * t1 + r32) * RW + 32 * t2 + 16 * s + 8 * hi);
        u32x2 nn[2][2][4];
#pragma unroll
        for (int tk = 0; tk < 2; ++tk)
#pragma unroll
            for (int tv = 0; tv < 2; ++tv)
#pragma unroll
                for (int g = 0; g < 4; ++g) nn[tk][tv][g] = *(const GAS u32x2*)(aN + so + (size_t)(32 * tv + r32) * RW + 32 * tk + 8 * g + 4 * hi);
        bf16x8 xb[2][2][2];
#pragma unroll
        for (int tk = 0; tk < 2; ++tk)
#pragma unroll
            for (int tv = 0; tv < 2; ++tv) { unsigned pk[8];
#pragma unroll
                for (int q = 0; q < 8; ++q) pk[q] = pkbf(X[tk][tv][2 * q], X[tk][tv][2 * q + 1]);
#pragma unroll
                for (int g = 0; g < 4; ++g) { u32x2 w_; w_.x = pk[2 * g]; w_.y = pk[2 * g + 1]; *(GAS u32x2*)(xs + (size_t)(32 * tv + r32) * 64 + 32 * tk + 8 * g + 4 * hi) = w_; }
                u32x4 f0, f1; f0.x = pk[0]; f0.y = pk[1]; f0.z = pk[2]; f0.w = pk[3]; f1.x = pk[4]; f1.y = pk[5]; f1.z = pk[6]; f1.w = pk[7];
                xb[tk][tv][0] = __builtin_bit_cast(bf16x8, f0); xb[tk][tv][1] = __builtin_bit_cast(bf16x8, f1); }
#pragma unroll
        for (int t1 = 0; t1 < 2; ++t1)
#pragma unroll
            for (int tv = 0; tv < 2; ++tv) { f32x16 a;
#pragma unroll
                for (int g = 0; g < 4; ++g) { const u32x2 q_ = nn[t1][tv][g]; a[4 * g + 0] = bflo(q_.x); a[4 * g + 1] = bfhi(q_.x); a[4 * g + 2] = bflo(q_.y); a[4 * g + 3] = bfhi(q_.y); }
#pragma unroll
                for (int t2 = 0; t2 < 2; ++t2)
#pragma unroll
                    for (int s = 0; s < 2; ++s) a = __builtin_amdgcn_mfma_f32_32x32x16_bf16(am[t1][t2][s], xb[t2][tv][s], a, 0, 0, 0);
                X[t1][tv] = a; }
    }
}

__device__ __forceinline__ void scan_post(Frame& F) {
    const int lane = F.lane, fr = lane & 15, fq = lane >> 4, tb = F.wave & 3;
    const bf16* aRh = (const bf16*)(F.dout + DO_W); const bf16* aYl = (const bf16*)(F.dout + DO_KKN); const bf16* XS = (const bf16*)(F.ws + WS_YRAW);
    const bf16* Zb = (const bf16*)(F.ws + WS_Z); const float* mu = INP(4); const bf16* aG = (const bf16*)(F.ws + WS_GATE); const float* bon = (const float*)(F.ws + WS_BON);
    bf16* Y = (bf16*)(F.ws + WS_Y); const float* lnw = INP(13); const float* lnb = INP(14);
    for (int u = F.vcu * 2 + (F.wave >> 2); u < BATCH * NH * NCHUNK; u += F.G * 2) {
        const int c = u % NCHUNK, bh = u / NCHUNK, b = bh / NH, h = bh % NH;
        const size_t m0 = (size_t)b * T + (size_t)c * 64, so = m0 * RW + h * HD;
        const bf16* xs = XS + (size_t)u * 4096;
        const size_t trow = m0 + 16 * tb + fr;
        bf16x8 bf_[2];
#pragma unroll
        for (int s = 0; s < 2; ++s) bf_[s] = *(const GAS bf16x8*)(aRh + trow * RW + h * HD + 32 * s + 8 * fq);
        f32x4 acc[4];
#pragma unroll
        for (int ta = 0; ta < 4; ++ta) { const u32x2 q_ = *(const GAS u32x2*)(aYl + trow * RW + h * HD + 16 * ta + 4 * fq);
            acc[ta] = (f32x4){bflo(q_.x), bfhi(q_.x), bflo(q_.y), bfhi(q_.y)};
#pragma unroll
            for (int s = 0; s < 2; ++s) { const bf16x8 af = *(const GAS bf16x8*)(xs + (size_t)(16 * ta + fr) * 64 + 32 * s + 8 * fq); acc[ta] = __builtin_amdgcn_mfma_f32_16x16x32_bf16(af, bf_[s], acc[ta], 0, 0, 0); } }
        float s1 = 0.f;
#pragma unroll
        for (int ta = 0; ta < 4; ++ta) s1 += (acc[ta][0] + acc[ta][1]) + (acc[ta][2] + acc[ta][3]);
        s1 += __shfl_xor(s1, 16); s1 += __shfl_xor(s1, 32); const float mean = s1 * (1.f / 64.f); float s2 = 0.f;
#pragma unroll
        for (int ta = 0; ta < 4; ++ta)
#pragma unroll
            for (int i = 0; i < 4; ++i) { const float d_ = acc[ta][i] - mean; acc[ta][i] = d_; s2 += d_ * d_; }
        s2 += __shfl_xor(s2, 16); s2 += __shfl_xor(s2, 32); const float rstd = 1.f / sqrtf(s2 * (1.f / 64.f) + GN_EPS);
        const float bn = bon[trow * NH + h];
#pragma unroll
        for (int ta = 0; ta < 4; ++ta) { const int ch = h * HD + 16 * ta + 4 * fq; const f32x4 lw4 = *(const GAS f32x4*)(lnw + ch), lb4 = *(const GAS f32x4*)(lnb + ch);
            const u32x2 vc = *(const GAS u32x2*)(Zb + trow * NIN + ZV_R + ch), gq = *(const GAS u32x2*)(aG + trow * RW + ch); u32x2 vp; vp.x = 0u; vp.y = 0u;
            if ((trow % T) != 0) vp = *(const GAS u32x2*)(Zb + (trow - 1) * NIN + ZV_R + ch);
            const f32x4 mv = *(const GAS f32x4*)(mu + ZV_R + ch);
            const float v0 = bflo(vc.x) + (bflo(vp.x) - bflo(vc.x)) * mv[0], v1 = bfhi(vc.x) + (bfhi(vp.x) - bfhi(vc.x)) * mv[1], v2 = bflo(vc.y) + (bflo(vp.y) - bflo(vc.y)) * mv[2], v3 = bfhi(vc.y) + (bfhi(vp.y) - bfhi(vc.y)) * mv[3];
            const float o0 = (acc[ta][0] * rstd * lw4[0] + lb4[0] + bn * v0) * bflo(gq.x), o1 = (acc[ta][1] * rstd * lw4[1] + lb4[1] + bn * v1) * bfhi(gq.x);
            const float o2 = (acc[ta][2] * rstd * lw4[2] + lb4[2] + bn * v2) * bflo(gq.y), o3 = (acc[ta][3] * rstd * lw4[3] + lb4[3] + bn * v3) * bfhi(gq.y);
            u32x2 w_; w_.x = pkbf(o0, o1); w_.y = pkbf(o2, o3); *(GAS u32x2*)(Y + trow * D + ch) = w_; }
    }
}
}
using pg8::Unit;
constexpr size_t TILE_B = 256 * 2;
struct SchedBase { int G, c; };
struct SchedZ : SchedBase {
    __device__ __forceinline__ bool next(int i, Unit& u) const {
        const int L = i * G + c; constexpr int NZ = (M / 256) * (NIN / 256), NKV = (MEMR / 256) * (2 * D / 256);
        if (L < NZ) { pg8::tile_map(L, M / 256, NIN / 256, u.pm, u.pn); u.z = 0; u.a_off = WS_XN + (size_t)u.pm * 256 * D * 2; u.b_off = WS_WIN_T + (size_t)u.pn * 256 * D * 2; return true; }
        if (L < NZ + NKV) { const int l = L - NZ; u.pm = l / 8; u.pn = l % 8; u.z = 1; u.a_off = WS_MEMN + (size_t)u.pm * 256 * D * 2; u.b_off = WS_WXKV_T + (size_t)u.pn * 256 * D * 2; return true; }
        return false;
    }
};
struct SchedG : SchedBase {
    __device__ __forceinline__ bool next(int i, Unit& u) const {
        const int L = i * G + c; if (L >= 64) return false;
        u.z = L >> 4; u.pm = (L >> 2) & 3; u.pn = L & 3; u.a_off = WS_KV + ((size_t)u.pm * 256 * 2048 + u.z * 256) * 2; u.b_off = WS_WQ_S + ((size_t)u.pn * 256 * 1024 + u.z * 256) * 2; return true;
    }
};
struct SchedVW : SchedBase {
    __device__ __forceinline__ bool next(int i, Unit& u) const {
        const int L = i * G + (G - 1 - c); if (L >= 64) return false;
        u.z = L >> 2; u.pm = L & 3; u.pn = 0; const int b = u.z >> 2, h = u.z & 3;
        u.a_off = WS_WO_T + ((size_t)u.pm * 256 * 1024 + h * 256) * 2; u.b_off = WS_KV + ((size_t)b * 256 * 2048 + 1024 + h * 256) * 2; return true;
    }
};
struct SchedMN : SchedBase {
    int nN; size_t a_base, b_base; int lda, ldb, bsel;
    __device__ __forceinline__ bool next(int i, Unit& u) const {
        const int L = i * G + c; if (L >= (M / 256) * nN) return false;
        pg8::tile_map(L, M / 256, nN, u.pm, u.pn); u.z = 0;
        u.a_off = a_base + (size_t)u.pm * 256 * lda * 2; u.b_off = b_base + ((size_t)u.pn * 256 + (bsel ? (size_t)(u.pm >> 5) * 1024 : 0)) * ldb * 2; return true;
    }
};

constexpr int CW_MQ = 8192;
__device__ __forceinline__ void moba_attn_phase(Frame& F, int bx) {
    const bf16* Z = (const bf16*)(F.ws + WS_Z); bf16* Y = (bf16*)(F.ws + WS_Y) + RW; const float* KM = (const float*)(F.ws + WS_KMEAN);
    const bool perx = (F.G % 8 == 0); const int x = perx ? (bx & 7) : 0; const int nun = perx ? 128 : 1024;
    unsigned* qc = (unsigned*)(F.ctl + CW_MQ + 64 * x);
    volatile LAS unsigned* slot = F.MISC + 16;
    for (int it = 0;; ++it) {
        if (F.tid == 0) slot[it & 1] = __hip_atomic_fetch_add(qc, 1u, __ATOMIC_RELAXED, __HIP_MEMORY_SCOPE_AGENT);
        asm volatile("s_waitcnt vmcnt(0) lgkmcnt(0)" ::: "memory"); __builtin_amdgcn_s_barrier(); asm volatile("" ::: "memory");
        const int idx = __builtin_amdgcn_readfirstlane((int)slot[it & 1]);
        if (idx >= nun) break;
        const int bh = perx ? x * 4 + (idx & 3) : (idx & 31), qb = perx ? 31 - (idx >> 2) : 31 - (idx >> 5);
        int ln = F.lane; asm volatile("" : "+v"(ln)); ln &= 63;
        attn_body::attn_unit<8>(bh / NH, bh % NH, qb, Z + ZQ, Z + ZK, Z + ZV, Y, KM + (size_t)bh * NBLK * HD, (char*)F.lds + RING_OFF, F.wave, ln);
    }
}

#ifndef MK_N_LAUNCHES
#define MK_N_LAUNCHES 1
#endif
constexpr int PER_PHASE = 12;
constexpr int N_LAUNCHES = MK_N_LAUNCHES;
constexpr int SCAN_WGS = 64;
struct Args { const float* in[25]; float* out; unsigned char* ws; int ph_lo, ph_hi, li, pad; };
__global__ void __launch_bounds__(NWAVES * 64, 2) skel_fwd(Args args) {
    extern __shared__ __attribute__((aligned(16))) unsigned char lds[];
    Frame F;
    F.lds = (LAS unsigned char*)lds;
    F.MISC = (volatile LAS unsigned*)(F.lds + MISC_OFF);
    F.tid = threadIdx.x; F.lane = F.tid & 63; F.wave = __builtin_amdgcn_readfirstlane(F.tid >> 6) & 7;
    F.G = gridDim.x; { const int bx = blockIdx.x; F.vcu = (F.G % 8 == 0) ? (bx % 8) * (F.G / 8) + bx / 8 : bx; }
    F.ws = args.ws; F.dout = (unsigned char*)args.out;
#pragma unroll
    for (int i = 0; i < 25; ++i) F.in[i] = args.in[i];
    F.ctl = (gu32*)(F.ws + WS_CTL);
    for (int u = F.tid; u < (EPI_LDS_OFF - LDSCTL_OFF) / 4; u += NWAVES * 64) ((LAS unsigned*)(F.lds + LDSCTL_OFF))[u] = 0u;
    __syncthreads();
    XcdBarrier bar; bar.bar = (unsigned*)(F.ctl + CW_BAR); bar.x = 0; bar.st = nullptr;
    if (N_LAUNCHES == 1) bar = xcd_barrier_post((unsigned*)(F.ctl + CW_BAR), F.MISC + 8);
#ifdef PROBE_PHASE
    unsigned long long* stamps = (unsigned long long*)(F.ws + WS_CTL + 65536); int nst = 0;
#define STAMP() do { if (blockIdx.x == 0 && threadIdx.x == 0) stamps[nst] = __builtin_amdgcn_s_memrealtime(); ++nst; } while (0)
#else
#define STAMP() do {} while (0)
#endif
#define GRID_BAR() do { if (N_LAUNCHES == 1) xcd_barrier(bar); STAMP(); } while (0)
    const int lo = args.ph_lo, hi = args.ph_hi;
#ifndef PHASE_MASK
#define PHASE_MASK 0xFFFF
#endif
#define IN(k) (((PHASE_MASK >> (k)) & 1) && lo <= (k) && (k) < hi)
#define BOTH(k) (IN(k) && IN((k) + 1))
#define FRESH() do { int l_; asm volatile("v_mbcnt_lo_u32_b32 %0, -1, 0\n\tv_mbcnt_hi_u32_b32 %0, -1, %0" : "=v"(l_)); F.lane = l_ & 63; F.tid = F.wave * 64 + F.lane; } while (0)
    const char* wsc = (const char*)F.ws;
    const int bx = (int)blockIdx.x;

    STAMP();
    if (IN(0)) { FRESH(); if (blockIdx.x == 0 && F.tid == 0) { _Pragma("unroll") for (int i = 0; i < 25; ++i) ((GAS unsigned long long*)(F.ws + WS_TAB))[i] = (unsigned long long)F.in[i]; }
        p0_prologue(F); if (BOTH(0)) GRID_BAR(); }
    if (IN(1)) {
        pg8::Gemm g{wsc, wsc, D, D, D}; SchedZ S; S.G = F.G; S.c = bx;
        pg8::EpiStoreBf16 E{(bf16*)(F.ws + WS_Z), NIN, (bf16*)(F.ws + WS_KV), 2 * D, ZQ / 256, attn_body::C2, 0};
        pg8::gemm_phase<pg8::EpiStoreBf16, SchedZ, true>(F.lds + RING_OFF, g, S, E, F.wave);
        if (BOTH(1)) GRID_BAR();
    }
    if (IN(2)) {
        { pg8::Gemm g{wsc, wsc, 2 * D, D, 256}; SchedG S; S.G = F.G; S.c = bx;
          pg8::EpiStoreBf16 E{(bf16*)(F.ws + WS_GT), D, nullptr, 0, 0, 1.f, 1};
          pg8::gemm_phase<pg8::EpiStoreBf16, SchedG, true>(F.lds + RING_OFF, g, S, E, F.wave); }
        { pg8::Gemm g{wsc, wsc, D, 2 * D, 256}; SchedVW S; S.G = F.G; S.c = bx;
          pg8::EpiStoreBf16 E{(bf16*)(F.ws + WS_VWT), D, nullptr, 0, 0, 1.f, 2};
          pg8::gemm_phase<pg8::EpiStoreBf16, SchedVW, true>(F.lds + RING_OFF, g, S, E, F.wave); }
        __syncthreads();
        FRESH(); kmean_simple(F);
        if (BOTH(2)) GRID_BAR();
    }
    if (IN(3)) { FRESH(); rscan::scan_pre(F); if (BOTH(3)) GRID_BAR(); }
    if (IN(4)) {
        FRESH();
        if (bx < BATCH * NH) { if (F.wave == 0) rscan::scan_seq(F, bx); __syncthreads(); }
        moba_attn_phase(F, bx);
        if (BOTH(4)) GRID_BAR();
    }
    if (IN(5)) { FRESH(); rscan::scan_post(F); if (BOTH(5)) GRID_BAR(); }
    if (IN(6)) {
        pg8::Gemm g{wsc, wsc, D, D, D}; SchedMN S; S.G = F.G; S.c = bx; S.nN = D / 256; S.a_base = WS_Y; S.b_base = WS_WMIX_T; S.lda = D; S.ldb = D; S.bsel = 0;
        pg8::EpiRes E{INP(0), (float*)F.dout, (bf16*)(F.ws + WS_HB), (float*)(F.ws + WS_SS), D};
        pg8::gemm_phase<pg8::EpiRes, SchedMN, true>(F.lds + RING_OFF, g, S, E, F.wave);
        if (BOTH(6)) GRID_BAR();
    }
    if (IN(7)) {
        pg8::Gemm g{wsc, wsc, D, D, D}; SchedMN S; S.G = F.G; S.c = bx; S.nN = D / 256; S.a_base = WS_HB; S.b_base = WS_GT; S.lda = D; S.ldb = D; S.bsel = 1;
        pg8::EpiSoftmax E{(bf16*)(F.ws + WS_P), D, (const float*)(F.ws + WS_SS), (PG8_LAS pg8::f32x2*)(F.lds + EPI_LDS_OFF)};
        pg8::gemm_phase<pg8::EpiSoftmax, SchedMN, true>(F.lds + RING_OFF, g, S, E, F.wave);
        if (BOTH(7)) GRID_BAR();
    }
    if (IN(8)) {
        pg8::Gemm g{wsc, wsc, D, D, D}; SchedMN S; S.G = F.G; S.c = bx; S.nN = D / 256; S.a_base = WS_P; S.b_base = WS_VWT; S.lda = D; S.ldb = D; S.bsel = 1;
        pg8::EpiRes E{(const float*)F.dout, (float*)F.dout, (bf16*)(F.ws + WS_HB), (float*)(F.ws + WS_SS) + (size_t)M * 16, D};
        pg8::gemm_phase<pg8::EpiRes, SchedMN, true>(F.lds + RING_OFF, g, S, E, F.wave);
        if (BOTH(8)) GRID_BAR();
    }
    if (IN(9)) {
        pg8::Gemm g{wsc, wsc, D, D, D}; SchedMN S; S.G = F.G; S.c = bx; S.nN = FF / 256; S.a_base = WS_HB; S.b_base = WS_W1_T; S.lda = D; S.ldb = D; S.bsel = 0;
        pg8::EpiSqRelu E{(bf16*)(F.ws + WS_AH), FF, (const float*)(F.ws + WS_SS) + (size_t)M * 16};
        pg8::gemm_phase<pg8::EpiSqRelu, SchedMN, true>(F.lds + RING_OFF, g, S, E, F.wave);
        if (BOTH(9)) GRID_BAR();
    }
    if (IN(10)) {
        pg8::Gemm g{wsc, wsc, FF, FF, FF}; SchedMN S; S.G = F.G; S.c = bx; S.nN = D / 256; S.a_base = WS_AH; S.b_base = WS_W2_T; S.lda = FF; S.ldb = FF; S.bsel = 0;
        pg8::EpiRes E{(const float*)F.dout, (float*)F.dout, nullptr, (float*)(F.ws + WS_SS) + (size_t)2 * M * 16, D};
        pg8::gemm_phase<pg8::EpiRes, SchedMN, true>(F.lds + RING_OFF, g, S, E, F.wave);
        if (BOTH(10)) GRID_BAR();
    }
    if (IN(11)) { FRESH();
#ifdef PROBE_PHASE
        float pscale; { const unsigned long long* st = (const unsigned long long*)(F.ws + WS_CTL + 65536); pscale = 1.f + (float)(st[PROBE_PHASE + 1] - st[PROBE_PHASE]) * 1e-6f; }
        final_norm(F, pscale);
#else
        final_norm(F, 1.f);
#endif
    }
#undef IN
#undef BOTH
}

extern "C" void kernel_launch(void* const* d_in, const int* in_sizes, int n_in, void* d_out, int out_size, void* d_ws, size_t ws_size, hipStream_t stream) {
    static int grid = 0;
    if (grid == 0) {
        if (n_in != 25 || in_sizes[0] != M * D || out_size != M * D || ws_size < WS_END) { fprintf(stderr, "kernel_launch: unexpected problem (n_in %d, in0 %d, out %d, ws %zu); nothing launched\n", n_in, n_in > 0 ? in_sizes[0] : -1, out_size, ws_size); grid = -1; return; }
        int dev = 0, cus = 0, per_cu = 0;
        if (hipGetDevice(&dev) != hipSuccess || hipDeviceGetAttribute(&cus, hipDeviceAttributeMultiprocessorCount, dev) != hipSuccess) { grid = -1; return; }
        if (hipFuncSetAttribute((const void*)skel_fwd, hipFuncAttributeMaxDynamicSharedMemorySize, LDS_BYTES) != hipSuccess) { fprintf(stderr, "kernel_launch: hipFuncSetAttribute failed\n"); grid = -1; return; }
        if (hipOccupancyMaxActiveBlocksPerMultiprocessor(&per_cu, (const void*)skel_fwd, NWAVES * 64, LDS_BYTES) != hipSuccess || per_cu < 1)
            fprintf(stderr, "kernel_launch: note: occupancy query reports %d workgroups per CU\n", per_cu);
        (void)hipGetLastError();
        grid = cus;
    }
    if (grid < 0) return;
    if (hipMemsetAsync((char*)d_ws + WS_CTL, 0, CTL_ZERO_BYTES, stream) != hipSuccess) { fprintf(stderr, "kernel_launch: hipMemsetAsync failed\n"); return; }
    Args a{};
    for (int i = 0; i < 25; ++i) a.in[i] = (const float*)d_in[i];
    a.out = (float*)d_out; a.ws = (unsigned char*)d_ws;
    for (int li = 0; li < N_LAUNCHES; ++li) {
        a.ph_lo = (N_LAUNCHES == PER_PHASE) ? li : 0; a.ph_hi = (N_LAUNCHES == PER_PHASE) ? li + 1 : PER_PHASE; a.li = li;
        hipLaunchKernelGGL(skel_fwd, dim3(grid), dim3(NWAVES * 64), LDS_BYTES, stream, a);
        const hipError_t le = hipPeekAtLastError();
        if (le != hipSuccess) { fprintf(stderr, "kernel_launch: launch %d failed: %s\n", li, hipGetErrorName(le)); break; }
    }
}
```

```cpp
#include <hip/hip_runtime.h>
#include <cstdio>
#include <cstdint>
#include <cmath>
namespace pg8 {
#define PG8_LAS __attribute__((address_space(3)))
typedef unsigned short bf16_t;
typedef short bf16x8 __attribute__((ext_vector_type(8)));
typedef float f32x4 __attribute__((ext_vector_type(4)));
typedef float f32x2 __attribute__((ext_vector_type(2)));
typedef unsigned u32x4 __attribute__((ext_vector_type(4)));
typedef unsigned u32x2 __attribute__((ext_vector_type(2)));
constexpr int BM = 256, BK = 64, HALF = 128, HTB = HALF * BK * 2  , STAGE_BYTES = 8 * HTB, NXCD = 8, WGM = 8;

__host__ __device__ __forceinline__ int lds_byte(int r, int c) { const int st = (r >> 4) * 2 + (c >> 5), rr = r & 15, cc = c & 31, ob = rr * 64 + cc * 2; return st * 1024 + (ob ^ (((ob >> 9) & 1) << 5)); }
__host__ __device__ __forceinline__ void stage_rc(int b, int& R, int& C) { const int st = b / 1024, sb = b % 1024, swz = sb ^ (((sb >> 9) & 1) << 5); R = (st >> 1) * 16 + swz / 64; C = (st & 1) * 32 + (swz % 64) / 2; }
__host__ __device__ __forceinline__ int perm32(int rho) { const int n = rho >> 4, i = rho & 15; return 8 * (i >> 2) + 4 * n + (i & 3); }

struct Unit { int pm, pn, z; size_t a_off, b_off; };
struct Gemm { const char* A; const char* Bt; int lda, ldb, K; };

__host__ __device__ __forceinline__ void tile_map(int L, int nM, int nN, int& pm, int& pn) {
    const int nwg = nM * nN; int wgid = L;
    { const int q = nwg / NXCD, r = nwg % NXCD, xcd = wgid % NXCD, off = wgid / NXCD; wgid = (xcd < r ? xcd * (q + 1) : r * (q + 1) + (xcd - r) * q) + off; }
    const int nig = WGM * nN, gid = wgid / nig, fm = gid * WGM, gsz = (nM - fm) < WGM ? (nM - fm) : WGM;
    pm = fm + ((wgid % nig) % gsz); pn = (wgid % nig) / gsz;
}

__device__ __forceinline__ unsigned cvt_pk_bf16(float lo, float hi) { unsigned r; asm volatile("v_cvt_pk_bf16_f32 %0, %1, %2" : "=v"(r) : "v"(lo), "v"(hi)); return r; }

template <class Epi, class Sched, bool ALIGN_EPI>
__device__ __forceinline__ void gemm_phase(PG8_LAS unsigned char* lds, const Gemm g, const Sched& S, const Epi& E, const int wid_) {
    int lane_; asm volatile("v_mbcnt_lo_u32_b32 %0, -1, 0\n\tv_mbcnt_hi_u32_b32 %0, -1, %0" : "=v"(lane_));
    const int lane = lane_ & 63, wid = wid_ & 7, tid = wid * 64 + lane, wr = wid >> 2, wc = wid & 3, fr = lane & 15, fq = lane >> 4;
    const int K = g.K, nt = K / BK;
    unsigned voffA[2], voffB[2];
#pragma unroll
    for (int i = 0; i < 2; ++i) { int R, C; stage_rc(tid * 16 + i * 8192, R, C); const int Rb = Epi::PERM ? ((R & ~31) + perm32(R & 31)) : R;
        voffA[i] = (unsigned)(R * g.lda + C) * 2u; voffB[i] = (unsigned)(Rb * g.ldb + C) * 2u; }
    const size_t kstep = (size_t)(BK * 2);
    const size_t hstepA = (size_t)HALF * g.lda * 2, hstepB = (size_t)HALF * g.ldb * 2;
    const unsigned ldsw = (unsigned)wid * 1024u;
    const int aoff = lds_byte(wr * 64 + fr, fq * 8), boff = lds_byte(wc * 32 + fr, fq * 8);
#define PG8_SA(b, h) (((b) * 2 + (h)) * HTB)
#define PG8_SB(b, h) ((4 + (b) * 2 + (h)) * HTB)
#define PG8_STAGE(bufoff, gbase, voff) do { _Pragma("unroll") for (int _i = 0; _i < 2; ++_i) \
        __builtin_amdgcn_global_load_lds((const unsigned*)((const char*)(gbase) + (voff)[_i]), (PG8_LAS unsigned*)(lds + (bufoff) + ldsw + _i * 8192), 16, 0, 0); } while (0)
#define PG8_LDA(dst, b, h) do { _Pragma("unroll") for (int m = 0; m < 4; ++m) _Pragma("unroll") for (int k = 0; k < 2; ++k) dst[m][k] = *(const PG8_LAS bf16x8*)(lds + PG8_SA(b, h) + aoff + m * 2048 + k * 1024); } while (0)
#define PG8_LDB(dst, b, h) do { _Pragma("unroll") for (int n = 0; n < 2; ++n) _Pragma("unroll") for (int k = 0; k < 2; ++k) dst[n][k] = *(const PG8_LAS bf16x8*)(lds + PG8_SB(b, h) + boff + n * 2048 + k * 1024); } while (0)
#define PG8_MMA(ai, bj, At, Bt) do { __builtin_amdgcn_s_setprio(1); _Pragma("unroll") for (int m = 0; m < 4; ++m) _Pragma("unroll") for (int n = 0; n < 2; ++n) _Pragma("unroll") for (int k = 0; k < 2; ++k) \
        acc[ai][bj][m][n] = __builtin_amdgcn_mfma_f32_16x16x32_bf16(Bt[n][k], At[m][k], acc[ai][bj][m][n], 0, 0, 0); __builtin_amdgcn_s_setprio(0); } while (0)
#define PG8_WAIT_V(n) asm volatile("s_waitcnt vmcnt(" #n ")" ::: "memory")
#define PG8_WAIT_L(n) asm volatile("s_waitcnt lgkmcnt(" #n ")" ::: "memory")
#define PG8_BAR __builtin_amdgcn_s_barrier()
#define PG8_SCHED __builtin_amdgcn_sched_barrier(0)
    Unit cur, nxt; int ui = 0;
    if (!S.next(0, cur)) return;
    f32x4 acc[2][2][4][2];
#pragma unroll
    for (int a = 0; a < 2; ++a)
#pragma unroll
        for (int b = 0; b < 2; ++b)
#pragma unroll
            for (int m = 0; m < 4; ++m)
#pragma unroll
                for (int n = 0; n < 2; ++n) acc[a][b][m][n] = (f32x4){0.f, 0.f, 0.f, 0.f};
    bf16x8 At[4][2], B0[2][2], B1[2][2];
    const char* cA = g.A + cur.a_off; const char* cB = g.Bt + cur.b_off;
    PG8_STAGE(PG8_SB(0, 0), cB, voffB); PG8_STAGE(PG8_SB(0, 1), cB + hstepB, voffB); PG8_STAGE(PG8_SA(0, 0), cA, voffA); PG8_STAGE(PG8_SA(0, 1), cA + hstepA, voffA);
    if (wr == 1) PG8_BAR;
    PG8_WAIT_V(2); PG8_BAR;
    PG8_STAGE(PG8_SB(1, 0), cB + kstep, voffB); PG8_STAGE(PG8_SA(1, 0), cA + kstep, voffA); PG8_STAGE(PG8_SB(1, 1), cB + hstepB + kstep, voffB);
    PG8_WAIT_V(6); PG8_BAR;
    for (;;) {
        const bool has_next = S.next(ui + 1, nxt);
        const char* nA = has_next ? g.A + nxt.a_off : cA; const char* nB = has_next ? g.Bt + nxt.b_off : cB;
        for (int t = 0; t < nt; t += 2) {
            const bool last = (t == nt - 2);
            const char* a1 = cA + (size_t)(t + 1) * kstep;
            const char* a2 = last ? nA : cA + (size_t)(t + 2) * kstep; const char* b2 = last ? nB : cB + (size_t)(t + 2) * kstep;
            const char* a3 = a2 + kstep; const char* b3 = b2 + kstep;
            PG8_LDB(B0, 0, 0); PG8_LDB(B1, 0, 1); PG8_SCHED; PG8_LDA(At, 0, 0); PG8_STAGE(PG8_SA(1, 1), a1 + hstepA, voffA);
            PG8_WAIT_V(8); PG8_WAIT_L(0); PG8_BAR; PG8_MMA(0, 0, At, B0); PG8_MMA(0, 1, At, B1); PG8_BAR; PG8_SCHED;
            PG8_LDA(At, 0, 1); PG8_STAGE(PG8_SB(0, 0), b2, voffB); PG8_STAGE(PG8_SB(0, 1), b2 + hstepB, voffB); PG8_STAGE(PG8_SA(0, 0), a2, voffA);
            PG8_WAIT_V(8); PG8_WAIT_L(0); PG8_BAR; PG8_MMA(1, 0, At, B0); PG8_MMA(1, 1, At, B1); PG8_BAR; PG8_SCHED;
            PG8_LDB(B0, 1, 0); PG8_LDB(B1, 1, 1); PG8_SCHED; PG8_LDA(At, 1, 0); PG8_STAGE(PG8_SA(0, 1), a2 + hstepA, voffA);
            PG8_WAIT_V(8); PG8_WAIT_L(0); PG8_BAR; PG8_MMA(0, 0, At, B0); PG8_MMA(0, 1, At, B1); PG8_BAR; PG8_SCHED;
            PG8_LDA(At, 1, 1); PG8_STAGE(PG8_SB(1, 0), b3, voffB); PG8_STAGE(PG8_SB(1, 1), b3 + hstepB, voffB); PG8_STAGE(PG8_SA(1, 0), a3, voffA);
            PG8_WAIT_V(8); PG8_WAIT_L(0); PG8_BAR; PG8_MMA(1, 0, At, B0); PG8_MMA(1, 1, At, B1); PG8_BAR; PG8_SCHED;
        }
        if constexpr (ALIGN_EPI) { if (wr == 0) PG8_BAR; }
        E(acc, cur, wr, wc, fr, fq, lane);
        if (!has_next) break;
#pragma unroll
        for (int a = 0; a < 2; ++a)
#pragma unroll
            for (int b = 0; b < 2; ++b)
#pragma unroll
                for (int m = 0; m < 4; ++m)
#pragma unroll
                    for (int n = 0; n < 2; ++n) acc[a][b][m][n] = (f32x4){0.f, 0.f, 0.f, 0.f};
        cur = nxt; cA = nA; cB = nB; ++ui;
        if constexpr (ALIGN_EPI) { if (wr == 1) PG8_BAR; }
    }
    PG8_WAIT_V(0);
    if constexpr (!ALIGN_EPI) { if (wr == 0) PG8_BAR; }
    PG8_BAR;
#undef PG8_SA
#undef PG8_SB
#undef PG8_STAGE
#undef PG8_LDA
#undef PG8_LDB
#undef PG8_MMA
#undef PG8_WAIT_V
#undef PG8_WAIT_L
#undef PG8_BAR
#undef PG8_SCHED
}
}
namespace pg8 {
struct EpiStoreBf16 {
    static constexpr bool PERM = true;
    bf16_t* O0; int ldc0; bf16_t* O1; int ldc1; int qs_lo; float qscale;
    int mode;
    __device__ __forceinline__ void operator()(const f32x4 (&acc)[2][2][4][2], const Unit& u, int wr, int wc, int fr, int fq, int lane) const {
        asm volatile("" : "+v"(fr), "+v"(fq), "+v"(lane));
        bf16_t* base; int ldc; size_t row0; int colt;
        if (mode == 0) { base = u.z ? O1 : O0; ldc = u.z ? ldc1 : ldc0; row0 = (size_t)u.pm * BM; colt = u.pn * BM; }
        else if (mode == 1) { base = O0; ldc = ldc0; row0 = (size_t)u.pm * 1024 + (size_t)u.z * 256; colt = u.pn * BM; }
        else { base = O0 + (size_t)(u.z >> 2) * 1048576; ldc = ldc0; row0 = (size_t)u.pm * BM; colt = (u.z & 3) * 256; }
        const float sc = (mode == 0 && u.z == 0 && (u.pn == qs_lo || u.pn == qs_lo + 1)) ? qscale : 1.f;
        const int col0 = colt + wc * 32 + 8 * fq;
#pragma unroll
        for (int ai = 0; ai < 2; ++ai)
#pragma unroll
            for (int m = 0; m < 4; ++m) { bf16_t* rowp = base + (row0 + wr * 64 + fr + ai * HALF + m * 16) * ldc + col0;
#pragma unroll
                for (int bj = 0; bj < 2; ++bj) { const f32x4 v0 = acc[ai][bj][m][0] * sc, v1 = acc[ai][bj][m][1] * sc;
                    u32x4 w; w.x = cvt_pk_bf16(v0[0], v0[1]); w.y = cvt_pk_bf16(v0[2], v0[3]); w.z = cvt_pk_bf16(v1[0], v1[1]); w.w = cvt_pk_bf16(v1[2], v1[3]);
                    *(u32x4*)(rowp + bj * HALF) = w; } }
    }
};

__device__ __forceinline__ float row_rstd(const float* ss, size_t row) {
    const f32x4* p = (const f32x4*)(ss + row * 16); const f32x4 a = p[0], b = p[1], c = p[2], d = p[3];
    const float s = ((a[0] + a[1]) + (a[2] + a[3])) + ((b[0] + b[1]) + (b[2] + b[3])) + ((c[0] + c[1]) + (c[2] + c[3])) + ((d[0] + d[1]) + (d[2] + d[3]));
    return 1.0f / sqrtf(s * (1.0f / 1024.0f) + 1e-6f);
}
__device__ __forceinline__ void wave_rstd(float (&rs)[2][4], const float* ss, int pm, int wr, int fr, int lane) {
    const float my0 = row_rstd(ss, (size_t)pm * BM + wr * 64 + lane), my1 = row_rstd(ss, (size_t)pm * BM + HALF + wr * 64 + lane);
#pragma unroll
    for (int m = 0; m < 4; ++m) { rs[0][m] = __shfl(my0, m * 16 + fr); rs[1][m] = __shfl(my1, m * 16 + fr); }
}

struct EpiRes {
    static constexpr bool PERM = false;
    const float* base; float* out; bf16_t* hb; float* ss; int ldc;
    __device__ __forceinline__ void operator()(f32x4 (&acc)[2][2][4][2], const Unit& u, int wr, int wc, int fr, int fq, int lane) const {
        asm volatile("" : "+v"(fr), "+v"(fq), "+v"(lane));
        const int col0 = u.pn * BM + wc * 32 + 4 * fq;
#pragma unroll
        for (int ai = 0; ai < 2; ++ai)
#pragma unroll
            for (int m = 0; m < 4; ++m) { const size_t row = (size_t)u.pm * BM + ai * HALF + wr * 64 + m * 16 + fr; const size_t off = row * ldc + col0; float q = 0.f;
#pragma unroll
                for (int bj = 0; bj < 2; ++bj)
#pragma unroll
                    for (int n = 0; n < 2; ++n) { const f32x4 bs = *(const f32x4*)(base + off + bj * HALF + n * 16); const f32x4 o = bs + acc[ai][bj][m][n];
                        *(f32x4*)(out + off + bj * HALF + n * 16) = o; q += (o[0] * o[0] + o[1] * o[1]) + (o[2] * o[2] + o[3] * o[3]);
                        if (hb) { u32x2 w; w.x = cvt_pk_bf16(o[0], o[1]); w.y = cvt_pk_bf16(o[2], o[3]); *(u32x2*)(hb + off + bj * HALF + n * 16) = w; } }
                q += __shfl_xor(q, 16); q += __shfl_xor(q, 32);
                if (fq == 0) ss[row * 16 + u.pn * 4 + wc] = q;
                if (m & 1) asm volatile("" ::: "memory"); }
    }
};

struct EpiSqRelu {
    static constexpr bool PERM = true;
    bf16_t* O; int ldc; const float* ss;
    __device__ __forceinline__ void operator()(const f32x4 (&acc)[2][2][4][2], const Unit& u, int wr, int wc, int fr, int fq, int lane) const {
        asm volatile("" : "+v"(fr), "+v"(fq), "+v"(lane));
        float rs[2][4]; wave_rstd(rs, ss, u.pm, wr, fr, lane);
        const int col0 = u.pn * BM + wc * 32 + 8 * fq;
#pragma unroll
        for (int ai = 0; ai < 2; ++ai)
#pragma unroll
            for (int m = 0; m < 4; ++m) { bf16_t* rowp = O + ((size_t)u.pm * BM + wr * 64 + fr + ai * HALF + m * 16) * ldc + col0; const float s = rs[ai][m];
#pragma unroll
                for (int bj = 0; bj < 2; ++bj) { f32x4 v0 = acc[ai][bj][m][0] * s, v1 = acc[ai][bj][m][1] * s;
#pragma unroll
                    for (int i = 0; i < 4; ++i) { const float a = fmaxf(v0[i], 0.f), b = fmaxf(v1[i], 0.f); v0[i] = a * a; v1[i] = b * b; }
                    u32x4 w; w.x = cvt_pk_bf16(v0[0], v0[1]); w.y = cvt_pk_bf16(v0[2], v0[3]); w.z = cvt_pk_bf16(v1[0], v1[1]); w.w = cvt_pk_bf16(v1[2], v1[3]);
                    *(u32x4*)(rowp + bj * HALF) = w; } }
    }
};

struct EpiSoftmax {
    static constexpr bool PERM = true;
    bf16_t* O; int ldc; const float* ss; PG8_LAS f32x2* xl;
    __device__ __forceinline__ void operator()(f32x4 (&acc)[2][2][4][2], const Unit& u, int wr, int wc, int fr, int fq, int lane) const {
        asm volatile("" : "+v"(fr), "+v"(fq), "+v"(lane));
        float rs[2][4]; wave_rstd(rs, ss, u.pm, wr, fr, lane);
#pragma unroll
        for (int ai = 0; ai < 2; ++ai)
#pragma unroll
            for (int m = 0; m < 4; ++m) { const float s = rs[ai][m] * (0.0625f * 1.4426950408889634f); float mx = -INFINITY;
#pragma unroll
                for (int bj = 0; bj < 2; ++bj)
#pragma unroll
                    for (int n = 0; n < 2; ++n) { f32x4 v = acc[ai][bj][m][n] * s; acc[ai][bj][m][n] = v; mx = fmaxf(fmaxf(mx, fmaxf(v[0], v[1])), fmaxf(v[2], v[3])); }
                mx = fmaxf(mx, __shfl_xor(mx, 16)); mx = fmaxf(mx, __shfl_xor(mx, 32)); float sm = 0.f;
#pragma unroll
                for (int bj = 0; bj < 2; ++bj)
#pragma unroll
                    for (int n = 0; n < 2; ++n) { f32x4 v = acc[ai][bj][m][n];
#pragma unroll
                        for (int i = 0; i < 4; ++i) { v[i] = __builtin_amdgcn_exp2f(v[i] - mx); sm += v[i]; } acc[ai][bj][m][n] = v; }
                sm += __shfl_xor(sm, 16); sm += __shfl_xor(sm, 32);
                if (fq == 0) xl[(ai * HALF + wr * 64 + m * 16 + fr) * 4 + wc] = (f32x2){mx, sm}; }
        asm volatile("s_waitcnt lgkmcnt(0)" ::: "memory"); __builtin_amdgcn_s_barrier(); asm volatile("" ::: "memory");
        const int col0 = u.pn * BM + wc * 32 + 8 * fq;
#pragma unroll
        for (int ai = 0; ai < 2; ++ai)
#pragma unroll
            for (int m = 0; m < 4; ++m) { const int r = ai * HALF + wr * 64 + m * 16 + fr;
                const f32x4 x01 = *(const PG8_LAS f32x4*)(xl + r * 4), x23 = *(const PG8_LAS f32x4*)(xl + r * 4 + 2);
                const float mg = fmaxf(fmaxf(x01[0], x01[2]), fmaxf(x23[0], x23[2]));
                const float tot = x01[1] * __builtin_amdgcn_exp2f(x01[0] - mg) + x01[3] * __builtin_amdgcn_exp2f(x01[2] - mg) + x23[1] * __builtin_amdgcn_exp2f(x23[0] - mg) + x23[3] * __builtin_amdgcn_exp2f(x23[2] - mg);
                const float mown = wc == 0 ? x01[0] : (wc == 1 ? x01[2] : (wc == 2 ? x23[0] : x23[2]));
                const float f = __builtin_amdgcn_exp2f(mown - mg) / tot;
                bf16_t* rowp = O + ((size_t)u.pm * BM + r) * ldc + col0;
#pragma unroll
                for (int bj = 0; bj < 2; ++bj) { const f32x4 v0 = acc[ai][bj][m][0] * f, v1 = acc[ai][bj][m][1] * f;
                    u32x4 w; w.x = cvt_pk_bf16(v0[0], v0[1]); w.y = cvt_pk_bf16(v0[2], v0[3]); w.z = cvt_pk_bf16(v1[0], v1[1]); w.w = cvt_pk_bf16(v1[2], v1[3]);
                    *(u32x4*)(rowp + bj * HALF) = w; } }
    }
};
}
constexpr int NWAVES = 8;
constexpr int BATCH = 4, T = 8192, D = 1024, M = BATCH * T;
constexpr int NIN = 3328, RW = 512, NH = 8, HD = 64;
constexpr int ZK_R = 512, ZV_R = 1024, ZWD = 1536, ZAD = 1600, ZGD = 1664;
constexpr int ZQ = 1792, ZK = 1792 + 512, ZV = 1792 + 1024;
constexpr int MEML = 256, MEMR = BATCH * MEML, FF = 4096;
constexpr int NBLK = T / 256;
constexpr float NORM_EPS = 1e-6f, GN_EPS = 64e-5f, DECAY_SCALE = 0.6065306597126334f;

constexpr size_t MiB = 1u << 20;
constexpr size_t WS_CTL = 0, CTL_ZERO_BYTES = 1 * MiB;
constexpr size_t WS_WIN_T = 1 * MiB, WS_WMIX_T = 8 * MiB, WS_WQ_S = 10 * MiB, WS_WXKV_T = 12 * MiB, WS_WO_T = 16 * MiB, WS_W1_T = 18 * MiB, WS_W2_T = 26 * MiB;
constexpr size_t WS_MEMN = 34 * MiB, WS_KV = 36 * MiB, WS_GT = 40 * MiB, WS_VWT = 48 * MiB;
constexpr size_t WS_SS = 56 * MiB;
constexpr size_t WS_KMEAN = 62 * MiB, WS_LORA = 62 * MiB + 512 * 1024, WS_BON = 63 * MiB;
constexpr size_t WS_XN = 64 * MiB;
constexpr size_t WS_GATE = 64 * MiB, WS_YRAW = 96 * MiB;
constexpr size_t WS_HB = 64 * MiB;
constexpr size_t WS_Z = 128 * MiB;
constexpr size_t WS_Y = 336 * MiB;
constexpr size_t WS_PR = 400 * MiB, WS_PV = 432 * MiB;
constexpr size_t WS_P = 400 * MiB;
constexpr size_t WS_AH = 128 * MiB;
constexpr size_t WS_END = 512 * MiB;
constexpr size_t DO_W = 0, DO_KP = 32 * MiB, DO_KKN = 64 * MiB, DO_B = 96 * MiB;

constexpr int CW_TMO = 0, CW_CODE = 1;
constexpr int CW_BAR = 4096;

constexpr int RING_OFF = 0, RING_BYTES = 131072;
constexpr int LDSCTL_OFF = RING_BYTES, MISC_OFF = LDSCTL_OFF + 320;
constexpr int EPI_LDS_OFF = 132096;
constexpr int LDS_BYTES = 147456;
static_assert(MISC_OFF + 128 <= EPI_LDS_OFF && EPI_LDS_OFF + 8192 <= LDS_BYTES, "LDS map");

#define GAS __attribute__((address_space(1)))
#define LAS __attribute__((address_space(3)))
typedef unsigned short bf16;
typedef unsigned v4u __attribute__((ext_vector_type(4)));
typedef float f32x4 __attribute__((ext_vector_type(4)));
typedef GAS unsigned gu32;
#define RLX_AGENT __ATOMIC_RELAXED, __HIP_MEMORY_SCOPE_AGENT
#define LDS_WAIT() asm volatile("s_waitcnt lgkmcnt(0)" ::: "memory")
#define VM_WAIT() asm volatile("s_waitcnt vmcnt(0)" ::: "memory")
__device__ __forceinline__ unsigned f2bf(float f) { unsigned u = __builtin_bit_cast(unsigned, f); return (u + 0x7fffu + ((u >> 16) & 1u)) >> 16; }
__device__ __forceinline__ unsigned pk2(float lo, float hi) { return f2bf(lo) | (f2bf(hi) << 16); }
__device__ __forceinline__ float bf2f(unsigned short u) { return __builtin_bit_cast(float, (unsigned)u << 16); }
__device__ __forceinline__ float bflo(unsigned u) { return __builtin_bit_cast(float, u << 16); }
__device__ __forceinline__ float bfhi(unsigned u) { return __builtin_bit_cast(float, u & 0xffff0000u); }

#define XB_TMO      128
#define XB_XCNT(j)  (256  + 64 * (j))
#define XB_XSUB(j)  (1280 + 64 * (j))
#define XB_XGEN(j)  (2304 + 64 * (j))
#define XB_TOP      3328
#define XB_TOPGEN   3392
#define XCD_BAR_WORDS 3456
#define XB_SPIN_CAP (1u << 18)
__device__ __forceinline__ unsigned xb_ld(unsigned* p)              { return __hip_atomic_load(p, __ATOMIC_RELAXED, __HIP_MEMORY_SCOPE_AGENT); }
__device__ __forceinline__ unsigned xb_add(unsigned* p, unsigned v) { return __hip_atomic_fetch_add(p, v, __ATOMIC_RELAXED, __HIP_MEMORY_SCOPE_AGENT); }
__device__ __forceinline__ unsigned xb_xcc_id() { return (unsigned)__builtin_amdgcn_s_getreg((3 << 11) | 20) & 0xFu; }
#define XB_SPIN(cond, bar) do { unsigned _sp = 0; while (cond) { __builtin_amdgcn_s_sleep(1); \
    if ((++_sp & 255u) == 0u) { if (xb_ld(&(bar)[XB_TMO])) break; if (_sp > XB_SPIN_CAP) { atomicAdd(&(bar)[XB_TMO], 1u); break; } } } } while (0)
struct XcdBarrier { unsigned* bar; unsigned x; volatile LAS unsigned* st; };
__device__ __forceinline__ XcdBarrier xcd_barrier_post(unsigned* bar, volatile LAS unsigned* st) {
    XcdBarrier b; b.bar = bar; b.x = xb_xcc_id(); b.st = st;
    if (threadIdx.x == 0) (void)xb_add(&bar[XB_XCNT(b.x)], 1u);
    return b;
}
__device__ __forceinline__ void xcd_barrier_complete(unsigned* bar, unsigned x, unsigned& nloc, unsigned& nx) {
    const unsigned G = gridDim.x * gridDim.y * gridDim.z;
    unsigned sum, cnt, mine, sp = 0u;
    for (;;) {
        sum = 0u; cnt = 0u; mine = 0u;
#pragma unroll
        for (unsigned j = 0; j < 16; ++j) { const unsigned c = xb_ld(&bar[XB_XCNT(j)]); sum += c; cnt += (c > 0u) ? 1u : 0u; mine = (j == x) ? c : mine; }
        if (sum == G) break;
        __builtin_amdgcn_s_sleep(1);
        if ((++sp & 255u) == 0u) { if (xb_ld(&bar[XB_TMO])) break; if (sp > XB_SPIN_CAP) { atomicAdd(&bar[XB_TMO], 1u); break; } }
    }
    nloc = mine > 0u ? mine : 1u; nx = cnt > 0u ? cnt : 1u;
}
__device__ __forceinline__ void xcd_barrier(const XcdBarrier& b) {
    asm volatile("s_waitcnt vmcnt(0)" ::: "memory");
    __syncthreads();
    if (threadIdx.x == 0) {
        unsigned* bar = b.bar;
        __builtin_amdgcn_s_waitcnt(0);
        unsigned nloc = b.st[0], nx = b.st[1];
        if (nloc == 0u) { xcd_barrier_complete(bar, b.x, nloc, nx); b.st[0] = nloc; b.st[1] = nx; }
        const unsigned old = xb_add(&bar[XB_XSUB(b.x)], 1u);
        const unsigned gen = old / nloc;
        if (old + 1u == (gen + 1u) * nloc) {
            __builtin_amdgcn_fence(__ATOMIC_RELEASE, "agent");
            asm volatile("s_waitcnt vmcnt(0)" ::: "memory");
            const unsigned og = xb_add(&bar[XB_TOP], 1u);
            const unsigned tg = og / nx;
            if (og + 1u == (tg + 1u) * nx) xb_add(&bar[XB_TOPGEN], 1u);
            else XB_SPIN(xb_ld(&bar[XB_TOPGEN]) == tg, bar);
            __builtin_amdgcn_fence(__ATOMIC_ACQUIRE, "agent");
            xb_add(&bar[XB_XGEN(b.x)], 1u);
            asm volatile("s_waitcnt vmcnt(0)" ::: "memory");
        } else {
            XB_SPIN(xb_ld(&bar[XB_XGEN(b.x)]) == gen, bar);
            __builtin_amdgcn_fence(__ATOMIC_ACQUIRE, "agent");
            asm volatile("s_waitcnt vmcnt(0)" ::: "memory");
        }
    }
    __syncthreads();
}

struct Frame {
    LAS unsigned char* lds;
    volatile LAS unsigned* MISC;
    gu32* ctl;
    int tid, lane, wave;
    int vcu, G;
    unsigned char* ws; unsigned char* dout;
    const float* in[25];
};
constexpr size_t WS_TAB = 131072;
__device__ __forceinline__ const float* inp(const Frame& F, int i) {
    const unsigned long long v = ((const GAS unsigned long long*)(F.ws + WS_TAB))[i];
    const unsigned lo = __builtin_amdgcn_readfirstlane((unsigned)v), hi = __builtin_amdgcn_readfirstlane((unsigned)(v >> 32));
    return (const float*)(((unsigned long long)hi << 32) | lo);
}
#define INP(i) inp(F, (i))
__device__ __forceinline__ float wave_sum(float v) {
#pragma unroll
    for (int o = 1; o < 64; o <<= 1) v += __shfl_xor(v, o);
    return v;
}
__device__ __forceinline__ float wave_max(float v) {
#pragma unroll
    for (int o = 1; o < 64; o <<= 1) v = fmaxf(v, __shfl_xor(v, o));
    return v;
}
template <int CTRL> __device__ __forceinline__ float dpp_mov(float x) { return __builtin_bit_cast(float, __builtin_amdgcn_update_dpp(0, __builtin_bit_cast(int, x), CTRL, 0xf, 0xf, false)); }
__device__ __forceinline__ float red16(float x) { x += dpp_mov<0xB1>(x); x += dpp_mov<0x4E>(x); x += dpp_mov<0x124>(x); x += dpp_mov<0x128>(x); return x; }
__device__ __forceinline__ void p0_transpose_item(const float* W, int K, int N, bf16* WT, const float* kscale, LAS float* scr, int item, int lane) {
    const int nblk = N / 32, kb = item / nblk, nb = item % nblk, k0 = 64 * kb, n0 = 32 * nb;
#pragma unroll 8
    for (int i = 0; i < 32; ++i) { const int kk = 2 * i + (lane >> 5); const float s = kscale ? kscale[k0 + kk] : 1.f; scr[kk * 33 + (lane & 31)] = W[(size_t)(k0 + kk) * N + n0 + (lane & 31)] * s; }
    LDS_WAIT(); asm volatile("" ::: "memory");
    const int c = lane & 7;
#pragma unroll
    for (int j = 0; j < 4; ++j) { const int n = (lane >> 3) + 8 * j; const LAS float* s = scr + (8 * c) * 33 + n;
        v4u o; o.x = pk2(s[0 * 33], s[1 * 33]); o.y = pk2(s[2 * 33], s[3 * 33]); o.z = pk2(s[4 * 33], s[5 * 33]); o.w = pk2(s[6 * 33], s[7 * 33]);
        *(GAS v4u*)(WT + (size_t)(n0 + n) * K + k0 + 8 * c) = o; }
    LDS_WAIT(); asm volatile("" ::: "memory");
}
__device__ __forceinline__ void rms_row_to_bf16(const float* xrow, const float* g, bf16* orow, int lane) {
    const GAS f32x4* xr = (const GAS f32x4*)xrow + lane; const GAS f32x4* gr = (const GAS f32x4*)g + lane;
    f32x4 v[4]; float s = 0.f;
#pragma unroll
    for (int j = 0; j < 4; ++j) { v[j] = xr[64 * j]; s += (v[j].x * v[j].x + v[j].y * v[j].y) + (v[j].z * v[j].z + v[j].w * v[j].w); }
    const float rstd = 1.f / sqrtf(wave_sum(s) * (1.f / D) + NORM_EPS);
    GAS unsigned long long* o8 = (GAS unsigned long long*)orow + lane;
#pragma unroll
    for (int j = 0; j < 4; ++j) { const f32x4 gg = gr[64 * j]; o8[64 * j] = (unsigned long long)pk2(v[j].x * rstd * gg.x, v[j].y * rstd * gg.y) | ((unsigned long long)pk2(v[j].z * rstd * gg.z, v[j].w * rstd * gg.w) << 32); }
}
__device__ __forceinline__ void p0_prologue(Frame& F) {
    LAS float* scr = (LAS float*)(F.lds + RING_OFF + F.wave * 16384);
    const int gw = F.vcu * NWAVES + F.wave, NGW = F.G * NWAVES;
    constexpr int I_IN = (D / 64) * (NIN / 32), I_MIX = (D / 64) * (D / 32), I_KV = (D / 64) * (2 * D / 32), I_O = I_MIX, I_1 = (D / 64) * (FF / 32), I_2 = (FF / 64) * (D / 32);
    constexpr int I_LW = RW / 32, I_LG = 2 * (RW / 32);
    constexpr int NITEMS = I_IN + I_MIX + I_KV + I_O + I_1 + I_2 + 2 * I_LW + I_LG;
    for (int it = gw; it < NITEMS; it += NGW) {
        int r = it;
        if (r < I_IN) { p0_transpose_item(F.in[3], D, NIN, (bf16*)(F.ws + WS_WIN_T), nullptr, scr, r, F.lane); continue; } r -= I_IN;
        if (r < I_MIX) { p0_transpose_item(F.in[15], D, D, (bf16*)(F.ws + WS_WMIX_T), nullptr, scr, r, F.lane); continue; } r -= I_MIX;
        if (r < I_KV) { p0_transpose_item(F.in[19], D, 2 * D, (bf16*)(F.ws + WS_WXKV_T), nullptr, scr, r, F.lane); continue; } r -= I_KV;
        if (r < I_O) { p0_transpose_item(F.in[20], D, D, (bf16*)(F.ws + WS_WO_T), nullptr, scr, r, F.lane); continue; } r -= I_O;
        if (r < I_1) { p0_transpose_item(F.in[22], D, FF, (bf16*)(F.ws + WS_W1_T), F.in[21], scr, r, F.lane); continue; } r -= I_1;
        if (r < I_2) { p0_transpose_item(F.in[23], FF, D, (bf16*)(F.ws + WS_W2_T), nullptr, scr, r, F.lane); continue; } r -= I_2;
        if (r < I_LW) { p0_transpose_item(F.in[6], 64, RW, (bf16*)(F.ws + WS_LORA), nullptr, scr, r, F.lane); continue; } r -= I_LW;
        if (r < I_LW) { p0_transpose_item(F.in[8], 64, RW, (bf16*)(F.ws + WS_LORA) + RW * 64, nullptr, scr, r, F.lane); continue; } r -= I_LW;
        p0_transpose_item(F.in[9], 128, RW, (bf16*)(F.ws + WS_LORA) + 2 * RW * 64, nullptr, scr, r, F.lane);
    }
    { const float* wq = F.in[18]; const float* gx = F.in[16]; bf16* o = (bf16*)(F.ws + WS_WQ_S);
      for (int i = (F.vcu * 512 + F.tid); i < D * D / 4; i += F.G * 512) { const f32x4 v = ((const GAS f32x4*)wq)[i]; const float s = gx[(i * 4) / D];
          ((GAS unsigned long long*)o)[i] = (unsigned long long)pk2(v.x * s, v.y * s) | ((unsigned long long)pk2(v.z * s, v.w * s) << 32); } }
    for (int m = gw; m < M; m += NGW) rms_row_to_bf16(F.in[0] + (size_t)m * D, F.in[2], (bf16*)(F.ws + WS_XN) + (size_t)m * D, F.lane);
    for (int m = gw; m < MEMR; m += NGW) rms_row_to_bf16(F.in[1] + (size_t)m * D, F.in[17], (bf16*)(F.ws + WS_MEMN) + (size_t)m * D, F.lane);
}

__device__ __forceinline__ void kmean_simple(Frame& F) {
    const bf16* Z = (const bf16*)(F.ws + WS_Z); float* KM = (float*)(F.ws + WS_KMEAN);
    const int gw = F.vcu * NWAVES + F.wave, NGW = F.G * NWAVES;
    for (int u = gw; u < BATCH * NH * NBLK; u += NGW) { const int j = u % NBLK, bh = u / NBLK, b = bh / NH, h = bh % NH;
        const bf16* kp = Z + ((size_t)b * T + j * 256) * NIN + ZK + h * HD + F.lane; float s = 0.f;
        for (int i = 0; i < 256; ++i) s += bf2f(kp[(size_t)i * NIN]);
        KM[(size_t)u * HD + F.lane] = s * (1.f / 256.f); }
}
__device__ __forceinline__ void final_norm(Frame& F, const float pscale) {
    float* out = (float*)F.dout; const float* ss = (const float*)(F.ws + WS_SS) + (size_t)2 * M * 16; const float* g = INP(24);
    const int gw = F.vcu * NWAVES + F.wave, NGW = F.G * NWAVES;
    for (int m = gw; m < M; m += NGW) { const float rstd = pg8::row_rstd(ss, (size_t)m) * pscale;
        GAS f32x4* o = (GAS f32x4*)(out + (size_t)m * D) + F.lane; const GAS f32x4* gr = (const GAS f32x4*)g + F.lane;
#pragma unroll
        for (int j = 0; j < 4; ++j) { f32x4 v = o[64 * j]; const f32x4 gg = gr[64 * j]; v = v * rstd * gg; o[64 * j] = v; } }
}
namespace attn_body {
typedef unsigned short bf16;
using bf16x8=__attribute__((ext_vector_type(8)))short;
using s16x4=__attribute__((ext_vector_type(4)))short;
using f32x16=__attribute__((ext_vector_type(16)))float;
using u32x4=__attribute__((ext_vector_type(4)))unsigned;
constexpr int SEQ=8192,D=64,QP=3328,OP=1024;
constexpr int NW=8,QBLK=32,QB=QBLK*NW,KVBLK=64,NQB=SEQ/QB;
__device__ __forceinline__ int crow(int r,int hi){return (r&3)+8*(r>>2)+4*hi;}
#define SBAR() __builtin_amdgcn_sched_barrier(0)
__device__ __forceinline__ void cmask(f32x16&p0,f32x16&p1,int jb,int qrel,int hi){
  const float NEG=-INFINITY; int kb=64*jb+4*hi;
  #pragma unroll
  for(int r=0;r<16;++r){int kv=kb+(r&3)+8*(r>>2); if(kv>qrel)p0[r]=NEG; if(kv+32>qrel)p1[r]=NEG;}
}

constexpr int NSLOT=3, SLOTB=8192;
constexpr int LDS_K=0, LDS_V=NSLOT*SLOTB, LDS_WS=2*NSLOT*SLOTB, LDS_OST=LDS_WS+NW*64*4, LDS_BYTES=LDS_OST+NW*4096;
constexpr float C2=0.125f*1.4426950408889634f;
__device__ __forceinline__ void glds16(const void*gsrc,unsigned lds_dst){unsigned keep;
  asm volatile("s_mov_b32 %0, m0\n\ts_mov_b32 m0, %2\n\ts_nop 0\n\tglobal_load_lds_dwordx4 %1, off\n\ts_mov_b32 m0, %0":"=&s"(keep):"v"(gsrc),"s"(lds_dst):"memory");}
__device__ __forceinline__ float max3f(float a,float b,float c){float r;asm("v_max3_f32 %0, %1, %2, %3":"=v"(r):"v"(a),"v"(b),"v"(c));return r;}
__device__ __forceinline__ float max2f(float a,float b){float r;asm("v_max_f32_e32 %0, %1, %2":"=v"(r):"v"(a),"v"(b));return r;}
__device__ __forceinline__ float fadd_s(float a,float b){float r;asm("v_add_f32_e32 %0, %1, %2":"=v"(r):"v"(a),"v"(b));return r;}
__device__ __forceinline__ float fsub_s(float a,float b){float r;asm("v_sub_f32_e32 %0, %1, %2":"=v"(r):"v"(a),"v"(b));return r;}
typedef float f32x2_t __attribute__((ext_vector_type(2))); typedef __bf16 bf16x2_t __attribute__((ext_vector_type(2)));
__device__ __forceinline__ unsigned cvtpk_s(float lo,float hi){f32x2_t v={lo,hi};bf16x2_t b=__builtin_convertvector(v,bf16x2_t);return __builtin_bit_cast(unsigned,b);}
#define WAIT_BAR(N) asm volatile("s_waitcnt vmcnt(" #N ") lgkmcnt(0)\n\ts_barrier":::"memory")

__device__ __forceinline__ void qkt(f32x16&p0,f32x16&p1,const char*Kslot,const bf16x8*qr,const f32x16&negm,int r32,int hi){
  const char*kb=Kslot+hi*1024+r32*16;
  #pragma unroll
  for(int d0=0;d0<4;++d0){
    const bf16x8 b0=*reinterpret_cast<const bf16x8*>(kb+d0*2048);
    const bf16x8 b1=*reinterpret_cast<const bf16x8*>(kb+d0*2048+512);
    if(d0==0){p0=__builtin_amdgcn_mfma_f32_32x32x16_bf16(b0,qr[0],negm,0,0,0);p1=__builtin_amdgcn_mfma_f32_32x32x16_bf16(b1,qr[0],negm,0,0,0);}
    else{p0=__builtin_amdgcn_mfma_f32_32x32x16_bf16(b0,qr[d0],p0,0,0,0);p1=__builtin_amdgcn_mfma_f32_32x32x16_bf16(b1,qr[d0],p1,0,0,0);}}
}
typedef __attribute__((address_space(3))) const char* lds_cptr;
typedef short v4i16_t __attribute__((ext_vector_type(4)));
__device__ __forceinline__ void kload8(bf16x8*kf,lds_cptr kp){
  kf[0]=*(const __attribute__((address_space(3))) bf16x8*)(kp);      kf[1]=*(const __attribute__((address_space(3))) bf16x8*)(kp+512);
  kf[2]=*(const __attribute__((address_space(3))) bf16x8*)(kp+2048); kf[3]=*(const __attribute__((address_space(3))) bf16x8*)(kp+2560);
  kf[4]=*(const __attribute__((address_space(3))) bf16x8*)(kp+4096); kf[5]=*(const __attribute__((address_space(3))) bf16x8*)(kp+4608);
  kf[6]=*(const __attribute__((address_space(3))) bf16x8*)(kp+6144); kf[7]=*(const __attribute__((address_space(3))) bf16x8*)(kp+6656);
}
__device__ __forceinline__ void kload2(bf16x8*kf,lds_cptr kp,int j){ kf[2*j]=*(const __attribute__((address_space(3))) bf16x8*)(kp+j*2048); kf[2*j+1]=*(const __attribute__((address_space(3))) bf16x8*)(kp+j*2048+512); }
__device__ __forceinline__ s16x4 vtr(lds_cptr p){ return __builtin_bit_cast(s16x4,__builtin_amdgcn_ds_read_tr16_b64_v4i16((__attribute__((address_space(3))) v4i16_t*)p)); }
__device__ __forceinline__ float rowmax(const f32x16&p0,const f32x16&p1){
  float a=max3f(p0[0],p0[1],p1[0]),b=max3f(p0[2],p0[3],p1[1]);a=max3f(a,p1[2],p1[3]);
  #pragma unroll
  for(int r=4;r<16;r+=4){a=max3f(a,p0[r],p0[r+1]);b=max3f(b,p0[r+2],p0[r+3]);a=max3f(a,p1[r],p1[r+1]);b=max3f(b,p1[r+2],p1[r+3]);}
  const float m=max2f(a,b);
  auto rr=__builtin_amdgcn_permlane32_swap(__float_as_uint(m),__float_as_uint(m),false,false);
  return max2f(__uint_as_float(rr[0]),__uint_as_float(rr[1]));
}
__device__ __forceinline__ void pv(f32x16*o,int vb,bf16x8 pa0,bf16x8 pa1,bf16x8 pa2,bf16x8 pa3){
  #pragma unroll
  for(int d0=0;d0<2;++d0){s16x4 lo[4],hi[4];
    #pragma unroll
    for(int ks=0;ks<4;++ks){
      asm volatile("ds_read_b64_tr_b16 %0,%1 offset:%c2":"=&v"(lo[ks]):"v"(vb),"i"(d0*4096+ks*1024):"memory");
      asm volatile("ds_read_b64_tr_b16 %0,%1 offset:%c2":"=&v"(hi[ks]):"v"(vb),"i"(d0*4096+ks*1024+512):"memory");}
    asm volatile("s_waitcnt lgkmcnt(0)":::"memory");SBAR();
    #define PK(k) (bf16x8){lo[k][0],lo[k][1],lo[k][2],lo[k][3],hi[k][0],hi[k][1],hi[k][2],hi[k][3]}
    o[d0]=__builtin_amdgcn_mfma_f32_32x32x16_bf16(pa0,PK(0),o[d0],0,0,0);
    o[d0]=__builtin_amdgcn_mfma_f32_32x32x16_bf16(pa1,PK(1),o[d0],0,0,0);
    o[d0]=__builtin_amdgcn_mfma_f32_32x32x16_bf16(pa2,PK(2),o[d0],0,0,0);
    o[d0]=__builtin_amdgcn_mfma_f32_32x32x16_bf16(pa3,PK(3),o[d0],0,0,0);
    #undef PK
  }
}

#ifndef ATTN_STORE16
#define ATTN_STORE16(p,v) (*(u32x4*)(p)=(v))
#endif
template<int THRL> __device__ __forceinline__ void attn_unit(int b,int h,int qb,const bf16*Q,const bf16*__restrict__ K,const bf16*__restrict__ V,bf16*O,const float*__restrict__ KMbh,char*shm,const int wid,const int lane){
  const int r32=lane&31,hi=lane>>5;
  const long rowbase=(long)b*SEQ; const int q0=qb*QB;
  const bf16*Qw=Q+(rowbase+q0+wid*QBLK)*QP+h*D;
  const bf16*Kh=K+rowbase*QP+h*D,*Vh=V+rowbase*QP+h*D;
  unsigned selmask=0u;
  { f32x16 g=f32x16{}; bf16x8 qg[4];
    #pragma unroll
    for(int d0=0;d0<4;++d0)qg[d0]=*reinterpret_cast<const bf16x8*>(&Qw[(long)r32*QP+d0*16+hi*8]);
    #pragma unroll
    for(int d0=0;d0<4;++d0){ const float4 a0=*reinterpret_cast<const float4*>(KMbh+r32*64+d0*16+hi*8), a1=*reinterpret_cast<const float4*>(KMbh+r32*64+d0*16+hi*8+4);
      u32x4 pk; pk[0]=cvtpk_s(a0.x,a0.y); pk[1]=cvtpk_s(a0.z,a0.w); pk[2]=cvtpk_s(a1.x,a1.y); pk[3]=cvtpk_s(a1.z,a1.w);
      g=__builtin_amdgcn_mfma_f32_32x32x16_bf16(__builtin_bit_cast(bf16x8,pk),qg[d0],g,0,0,0); }
    #pragma unroll
    for(int r=0;r<16;++r){ if(crow(r,hi)>=qb) g[r]=-INFINITY; }
    #pragma unroll
    for(int n=0;n<3;++n){ float bv=-INFINITY; int bi=64;
      #pragma unroll
      for(int r=0;r<16;++r){ if(g[r]>bv){bv=g[r];bi=crow(r,hi);} }
      const float pv_=__shfl_xor(bv,32); const int pi_=__shfl_xor(bi,32);
      const bool mine=(bv>pv_)||(bv==pv_&&bi<pi_); const float wv=mine?bv:pv_; const int wi=mine?bi:pi_;
      if(wv>-INFINITY){ selmask|=1u<<wi;
        #pragma unroll
        for(int r=0;r<16;++r){ if(crow(r,hi)==wi) g[r]=-INFINITY; } } }
    selmask|=1u<<qb; }
  asm volatile("":"+v"(selmask)); SBAR();
  const unsigned lds0=(unsigned)(uintptr_t)shm;
  float*wsf=(float*)(shm+LDS_WS)+wid*64;
  const bf16*ksrc=Kh+(long)lane*QP+wid*8;
  const bf16*vsrc=Vh+(long)(16*(wid&3)+(lane>>2))*QP+(wid>>2)*32+(lane&3)*8;
  const unsigned kdst=lds0+LDS_K+wid*1024, vdst=lds0+LDS_V+wid*1024;
  #define DMA_K(t,slot) glds16(ksrc+(long)(t)*KVBLK*QP,(unsigned)__builtin_amdgcn_readfirstlane(kdst+(slot)))
  #define DMA_V(t,slot) glds16(vsrc+(long)(t)*KVBLK*QP,(unsigned)__builtin_amdgcn_readfirstlane(vdst+(slot)))
  const int vb0=(int)(lds0+LDS_V)+((lane>>4)&1)*32+(lane&3)*8+(4*hi+((lane&15)>>2))*64;
  const char*Kbase=shm+LDS_K; bf16x8 kf[8];
  const lds_cptr shm3=(lds_cptr)shm; const lds_cptr kp0=shm3+LDS_K+hi*1024+r32*16; const lds_cptr vp0=shm3+LDS_V+((lane>>4)&1)*32+(lane&3)*8+(4*hi+((lane&15)>>2))*64;
  const int NT=(q0+QB)/KVBLK;
  DMA_K(0,0);DMA_V(0,0);DMA_K(1,SLOTB);
  bf16x8 qr[4];
  #pragma unroll
  for(int d0=0;d0<4;++d0)qr[d0]=*reinterpret_cast<const bf16x8*>(&Qw[(long)r32*QP+d0*16+hi*8]);
  float nok=((selmask&1u)!=0u||qb==0)?0.f:-INFINITY;
  float mhat=0.f,l_reg=0.f;f32x16 o[2];o[0]=f32x16{};o[1]=f32x16{};f32x16 negm;
  _Pragma("unroll") for(int r=0;r<16;++r)negm[r]=nok; asm volatile("":"+v"(negm));
  const int qrel=wid*QBLK+r32;
  #define CMASK(P0,P1,t) do{int jb_=(t)-(NT-4); if(jb_>=0)cmask(P0,P1,jb_,qrel,hi);}while(0)
  bool resc=false;
  #define START(P0,P1) do{ const float rm=rowmax(P0,P1); resc=false; \
    { const float dl=(rm==-INFINITY)?0.f:rm; mhat=fadd_s(mhat,dl); \
      _Pragma("unroll") for(int r=0;r<16;++r){P0[r]=fsub_s(P0[r],dl);P1[r]=fsub_s(P1[r],dl);} \
      { const float cv_=nok-mhat; _Pragma("unroll") for(int r=0;r<16;++r)negm[r]=cv_; } asm volatile("":"+v"(negm)); } \
    _Pragma("unroll") for(int r=0;r<16;++r)P0[r]=__builtin_amdgcn_exp2f(P0[r]); }while(0)
  #define RESC() do{ if(resc){ asm volatile("s_waitcnt lgkmcnt(0)":::"memory"); \
      _Pragma("unroll") for(int d_=0;d_<2;++d_) _Pragma("unroll") for(int r=0;r<16;++r)o[d_][r]*=wsf[crow(r,hi)]; } }while(0)
  f32x16 pA0,pA1,pB0,pB1;
  int sl_prev=0,sl_cur=0,sl_next=SLOTB;
  #define ROT() do{sl_prev=sl_cur;sl_cur=sl_next;sl_next=(sl_next==(NSLOT-1)*SLOTB)?0:sl_next+SLOTB;}while(0)
  DMA_K(2,2*SLOTB);
  WAIT_BAR(3);
  qkt(pA0,pA1,Kbase,qr,negm,r32,hi);asm volatile("s_nop 15\n\ts_nop 7":"+v"(pA0),"+v"(pA1));CMASK(pA0,pA1,0);
  START(pA0,pA1);
  _Pragma("unroll") for(int r=0;r<16;++r)pA1[r]=__builtin_amdgcn_exp2f(pA1[r]);
  WAIT_BAR(0);
  DMA_K(3,0);DMA_V(1,SLOTB);
  ROT();
  kload8(kf,kp0+sl_cur);
  WAIT_BAR(2);
  s16x4 vlo[8],vhi[8]; u32x4 pw0,pw1,pw2,pw3;
  #define PKW(P,B) cvtpk_s(P[B],P[B+1])
  #define PAF(k) __builtin_bit_cast(bf16x8,pw##k)
  #define VFR(i) (bf16x8){vlo[i][0],vlo[i][1],vlo[i][2],vlo[i][3],vhi[i][0],vhi[i][1],vhi[i][2],vhi[i][3]}
  #define PIN(x) asm volatile("":"+v"(x))
  #define MX3(a,b,c) __builtin_fmaxf(__builtin_fmaxf((a),(b)),(c))
  #define GAPA(MF,A0,A1,A2,A3,W0,W1,PW) do{ MF; sacc+=A0; sacc+=A1; sacc+=A2; sacc+=A3; PIN(sacc); W0; W1; PIN(PW); SBAR(); }while(0)
  #define EX(v) __builtin_amdgcn_exp2f(v)
  #define GAPB(MF,X,B) do{ MF; X[B]=EX(X[B]); X[B+1]=EX(X[B+1]); X[B+2]=EX(X[B+2]); X[B+3]=EX(X[B+3]); PIN(X); SBAR(); }while(0)
  #define VRD(i) do{ vlo[i]=vtr(vp_+(((i)>>2)*4096+((i)&3)*1024)); vhi[i]=vtr(vp_+(((i)>>2)*4096+((i)&3)*1024+512)); }while(0)
  #define KRD(G,j) do{ if(G){ kload2(kf,kp0+sl_next,j); SBAR(); } }while(0)
  #define STEP(C0,C1,P0,P1,t,GK,GV,GL) do{ SBAR(); \
    const lds_cptr vp_=vp0+sl_prev; \
    VRD(0); SBAR(); float sacc=(P0[0]+P0[1]); \
    GAPA(C0=__builtin_amdgcn_mfma_f32_32x32x16_bf16(kf[0],qr[0],negm,0,0,0), P0[2],P0[3],P0[4],P0[5],     pw0[0]=PKW(P0,0), pw0[1]=PKW(P0,2), pw0); \
    VRD(4); SBAR(); GAPA(C1=__builtin_amdgcn_mfma_f32_32x32x16_bf16(kf[1],qr[0],negm,0,0,0), P0[6],P0[7],P0[8],P0[9],     pw0[2]=PKW(P0,4), pw0[3]=PKW(P0,6), pw0); \
    VRD(1); SBAR(); GAPA(C0=__builtin_amdgcn_mfma_f32_32x32x16_bf16(kf[2],qr[1],C0,0,0,0),   P0[10],P0[11],P0[12],P0[13], pw1[0]=PKW(P0,8), pw1[1]=PKW(P0,10), pw1); \
    VRD(5); SBAR(); GAPA(C1=__builtin_amdgcn_mfma_f32_32x32x16_bf16(kf[3],qr[1],C1,0,0,0),   P0[14],P0[15],P1[0],P1[1],   pw1[2]=PKW(P0,12),pw1[3]=PKW(P0,14), pw1); \
    VRD(2); SBAR(); GAPA(C0=__builtin_amdgcn_mfma_f32_32x32x16_bf16(kf[4],qr[2],C0,0,0,0),   P1[2],P1[3],P1[4],P1[5],     pw2[0]=PKW(P1,0), pw2[1]=PKW(P1,2), pw2); \
    VRD(6); SBAR(); GAPA(C1=__builtin_amdgcn_mfma_f32_32x32x16_bf16(kf[5],qr[2],C1,0,0,0),   P1[6],P1[7],P1[8],P1[9],     pw2[2]=PKW(P1,4), pw2[3]=PKW(P1,6), pw2); \
    VRD(3); SBAR(); GAPA(C0=__builtin_amdgcn_mfma_f32_32x32x16_bf16(kf[6],qr[3],C0,0,0,0),   P1[10],P1[11],P1[12],P1[13], pw3[0]=PKW(P1,8), pw3[1]=PKW(P1,10), pw3); \
    VRD(7); SBAR(); GAPA(C1=__builtin_amdgcn_mfma_f32_32x32x16_bf16(kf[7],qr[3],C1,0,0,0),   P1[14],P1[15],0.f,0.f,       pw3[2]=PKW(P1,12),pw3[3]=PKW(P1,14), pw3); \
    l_reg+=sacc; \
    if(GK){DMA_K((t)+3,sl_cur);} if(GV){DMA_V((t)+1,sl_next);} \
    CMASK(C0,C1,t); \
    { float a=MX3(C0[0],C0[1],C1[0]),b=MX3(C0[2],C0[3],C1[1]); a=MX3(a,C1[2],C1[3]); \
      _Pragma("unroll") for(int r=4;r<16;r+=4){a=MX3(a,C0[r],C0[r+1]);b=MX3(b,C0[r+2],C0[r+3]);a=MX3(a,C1[r],C1[r+1]);b=MX3(b,C1[r+2],C1[r+3]);} \
      float rm=__builtin_fmaxf(a,b); { auto rr=__builtin_amdgcn_permlane32_swap(__float_as_uint(rm),__float_as_uint(rm),false,false); rm=__builtin_fmaxf(__uint_as_float(rr[0]),__uint_as_float(rr[1])); } \
      resc=false; \
      if(__builtin_expect(__any(rm>(float)THRL),0)){ const float dl=__builtin_fmaxf(rm,0.f); mhat+=dl; \
        _Pragma("unroll") for(int r=0;r<16;++r){C0[r]-=dl;C1[r]-=dl;} \
        { const float cv_=nok-mhat; _Pragma("unroll") for(int r=0;r<16;++r)negm[r]=cv_; } asm volatile("":"+v"(negm)); \
        const float f=__builtin_amdgcn_exp2f(-dl); l_reg*=f; if(hi==0)wsf[r32]=f; resc=true; } } \
    SBAR(); \
    GAPB(o[0]=__builtin_amdgcn_mfma_f32_32x32x16_bf16(PAF(0),VFR(0),o[0],0,0,0), C0,0); \
    GAPB(o[1]=__builtin_amdgcn_mfma_f32_32x32x16_bf16(PAF(0),VFR(4),o[1],0,0,0), C0,4); \
    KRD(GL,0); GAPB(o[0]=__builtin_amdgcn_mfma_f32_32x32x16_bf16(PAF(1),VFR(1),o[0],0,0,0), C0,8); \
    KRD(GL,1); GAPB(o[1]=__builtin_amdgcn_mfma_f32_32x32x16_bf16(PAF(1),VFR(5),o[1],0,0,0), C0,12); \
    KRD(GL,2); GAPB(o[0]=__builtin_amdgcn_mfma_f32_32x32x16_bf16(PAF(2),VFR(2),o[0],0,0,0), C1,0); \
    KRD(GL,3); GAPB(o[1]=__builtin_amdgcn_mfma_f32_32x32x16_bf16(PAF(2),VFR(6),o[1],0,0,0), C1,4); \
    GAPB(o[0]=__builtin_amdgcn_mfma_f32_32x32x16_bf16(PAF(3),VFR(3),o[0],0,0,0), C1,8); \
    GAPB(o[1]=__builtin_amdgcn_mfma_f32_32x32x16_bf16(PAF(3),VFR(7),o[1],0,0,0), C1,12); \
    }while(0)
  #define MASKUPD(tt) do{ if((((tt))&3)==0){ nok=((selmask>>((tt)>>2))&1u)?0.f:-INFINITY; const float cv_=nok-mhat; _Pragma("unroll") for(int r=0;r<16;++r)negm[r]=cv_; asm volatile("":"+v"(negm)); } }while(0)
  int t=1;
  #undef CMASK
  #define CMASK(P0,P1,t) do{}while(0)
  for(;t+5<NT;t+=2){
    STEP(pB0,pB1,pA0,pA1,t,true,true,true);     WAIT_BAR(2); RESC(); ROT(); MASKUPD(t+1);
    STEP(pA0,pA1,pB0,pB1,t+1,true,true,true);   WAIT_BAR(2); RESC(); ROT();
  }
  #undef CMASK
  #define CMASK(P0,P1,t) do{int jb_=(t)-(NT-4); if(jb_>=0)cmask(P0,P1,jb_,qrel,hi);}while(0)
  #define ENDW(tt) do{ if((tt)+3<NT){WAIT_BAR(2);} else if((tt)+2<NT){WAIT_BAR(1);} else {WAIT_BAR(0);} }while(0)
  for(;t+1<NT;t+=2){
    STEP(pB0,pB1,pA0,pA1,t,(t+3<NT),(t+1<NT),(t+1<NT));       ENDW(t);   RESC(); ROT(); MASKUPD(t+1);
    STEP(pA0,pA1,pB0,pB1,t+1,(t+4<NT),(t+2<NT),(t+2<NT));     ENDW(t+1); RESC(); ROT();
  }
  STEP(pB0,pB1,pA0,pA1,NT-1,false,false,false); RESC();
  { float sacc=pB0[0]+pB0[1]; _Pragma("unroll") for(int r=2;r<16;++r)sacc+=pB0[r]; _Pragma("unroll") for(int r=0;r<16;++r)sacc+=pB1[r]; l_reg+=sacc;
    pw0=(u32x4){PKW(pB0,0),PKW(pB0,2),PKW(pB0,4),PKW(pB0,6)};pw1=(u32x4){PKW(pB0,8),PKW(pB0,10),PKW(pB0,12),PKW(pB0,14)};pw2=(u32x4){PKW(pB1,0),PKW(pB1,2),PKW(pB1,4),PKW(pB1,6)};pw3=(u32x4){PKW(pB1,8),PKW(pB1,10),PKW(pB1,12),PKW(pB1,14)};
    SBAR(); pv(o,vb0+sl_cur,PAF(0),PAF(1),PAF(2),PAF(3)); }
  #undef PKW
  #undef PAF
  #undef VFR
  #undef PIN
  #undef MX3
  #undef GAPA
  #undef GAPB
  #undef EX
  #undef VRD
  #undef KRD
  #undef STEP
  #undef ENDW
  #undef MASKUPD
  {auto rr=__builtin_amdgcn_permlane32_swap(__float_as_uint(l_reg),__float_as_uint(l_reg),false,false);l_reg=__uint_as_float(rr[0])+__uint_as_float(rr[1]);}
  if(hi==0)wsf[32+r32]=l_reg;asm volatile("s_waitcnt lgkmcnt(0)":::"memory");
  float rli[16];
  #pragma unroll
  for(int r=0;r<16;++r)rli[r]=__builtin_amdgcn_rcpf(wsf[32+crow(r,hi)]);
  bf16*Ow=O+(rowbase+q0+wid*QBLK)*OP+h*D;
  { bf16*stg=(bf16*)(shm+LDS_OST)+wid*2048;
    #pragma unroll
    for(int r=0;r<16;++r){const int orow=crow(r,hi);
      #pragma unroll
      for(int d0=0;d0<2;++d0)stg[orow*64+d0*32+r32]=(bf16)(cvtpk_s(o[d0][r]*rli[r],0.f)&0xffffu);}
    asm volatile("s_waitcnt lgkmcnt(0)":::"memory");
    #pragma unroll
    for(int i=0;i<4;++i){const int row=i*8+(lane>>3),ch=lane&7; const u32x4 v=*(const u32x4*)(stg+row*64+ch*8); ATTN_STORE16(Ow+(long)row*OP+ch*8,v);} }
  asm volatile("s_waitcnt lgkmcnt(0)\n\ts_barrier":::"memory");
  #undef DMA_K
  #undef DMA_V
  #undef CMASK
  #undef START
  #undef RESC
  #undef ROT
}
constexpr int ATTN_LDS_BYTES=LDS_BYTES;
#undef SBAR
#undef WAIT_BAR
}
namespace rscan {
typedef short bf16x8 __attribute__((ext_vector_type(8)));
typedef float f32x4 __attribute__((ext_vector_type(4)));
typedef float f32x16 __attribute__((ext_vector_type(16)));
typedef unsigned u32x2 __attribute__((ext_vector_type(2)));
typedef unsigned u32x4 __attribute__((ext_vector_type(4)));
constexpr int LB = 8192;
__device__ __forceinline__ int t64(int row, int chunk) { return row * 128 + ((chunk ^ ((row >> 1) & 7)) << 4); }
__device__ __forceinline__ int t128(int row, int chunk) { return row * 256 + ((chunk ^ (row & 15)) << 4); }
constexpr int NCHUNK = T / 64;
__device__ __forceinline__ unsigned pkbf(float lo, float hi) { typedef float f2 __attribute__((ext_vector_type(2))); typedef __bf16 b2 __attribute__((ext_vector_type(2))); f2 v = {lo, hi}; return __builtin_bit_cast(unsigned, __builtin_convertvector(v, b2)); }

__device__ __forceinline__ void mm(f32x4 (&acc)[2], LAS unsigned char* lds, int z1, int z2, int ta, int tbh, int fr, int fq) {
    const int o1 = z1 + t64(16 * ta + fr, fq), o2 = z2 + t64(32 * tbh + fr, fq);
    const bf16x8 a0 = *(const LAS bf16x8*)(lds + o1), a1 = *(const LAS bf16x8*)(lds + (o1 ^ 64));
    const bf16x8 b00 = *(const LAS bf16x8*)(lds + o2), b01 = *(const LAS bf16x8*)(lds + (o2 ^ 64)), b10 = *(const LAS bf16x8*)(lds + o2 + 2048), b11 = *(const LAS bf16x8*)(lds + ((o2 ^ 64) + 2048));
    acc[0] = __builtin_amdgcn_mfma_f32_16x16x32_bf16(a0, b00, acc[0], 0, 0, 0); acc[0] = __builtin_amdgcn_mfma_f32_16x16x32_bf16(a1, b01, acc[0], 0, 0, 0);
    acc[1] = __builtin_amdgcn_mfma_f32_16x16x32_bf16(a0, b10, acc[1], 0, 0, 0); acc[1] = __builtin_amdgcn_mfma_f32_16x16x32_bf16(a1, b11, acc[1], 0, 0, 0);
}
struct Fr { bf16x8 a0, a1, b00, b01, b10, b11; };
__device__ __forceinline__ void ldf(Fr& f, LAS unsigned char* lds, int z1, int z2, int ta, int tbh, int fr, int fq) {
    const int o1 = z1 + t64(16 * ta + fr, fq), o2 = z2 + t64(32 * tbh + fr, fq);
    f.a0 = *(const LAS bf16x8*)(lds + o1); f.a1 = *(const LAS bf16x8*)(lds + (o1 ^ 64));
    f.b00 = *(const LAS bf16x8*)(lds + o2); f.b01 = *(const LAS bf16x8*)(lds + (o2 ^ 64)); f.b10 = *(const LAS bf16x8*)(lds + o2 + 2048); f.b11 = *(const LAS bf16x8*)(lds + ((o2 ^ 64) + 2048));
}
__device__ __forceinline__ void mcf(f32x4 (&acc)[2], const Fr& f) {
    acc[0] = __builtin_amdgcn_mfma_f32_16x16x32_bf16(f.a0, f.b00, acc[0], 0, 0, 0); acc[1] = __builtin_amdgcn_mfma_f32_16x16x32_bf16(f.a0, f.b10, acc[1], 0, 0, 0);
    acc[0] = __builtin_amdgcn_mfma_f32_16x16x32_bf16(f.a1, f.b01, acc[0], 0, 0, 0); acc[1] = __builtin_amdgcn_mfma_f32_16x16x32_bf16(f.a1, f.b11, acc[1], 0, 0, 0);
}
template <int MASK, bool DIAG1> __device__ __forceinline__ void st_lds(const f32x4 (&acc)[2], LAS unsigned char* lds, int dst, int ta, int tbh, int fr, int fq) {
#pragma unroll
    for (int tb = 0; tb < 2; ++tb) { const int b = 32 * tbh + 16 * tb + fr, a0 = 16 * ta + 4 * fq; float v[4];
#pragma unroll
        for (int i = 0; i < 4; ++i) { const int a = a0 + i; float x = acc[tb][i];
            if (MASK == 1) x = (a < b) ? x : 0.f; if (MASK == 2) x = (a <= b) ? x : 0.f; if (MASK == 3) x = (b < a) ? x : 0.f; if (DIAG1) x = (a == b) ? 1.f : x; v[i] = x; }
        u32x2 w; w.x = pkbf(v[0], v[1]); w.y = pkbf(v[2], v[3]); *(LAS u32x2*)(lds + dst + t64(b, a0 >> 3) + (a0 & 4) * 2) = w; }
}
template <bool PERM> __device__ __forceinline__ void st_glb(const f32x4 (&acc)[2], bf16* g, int ta, int tbh, int fr, int fq) {
#pragma unroll
    for (int tb = 0; tb < 2; ++tb) { const int b = 32 * tbh + 16 * tb + fr; int a0 = 16 * ta + 4 * fq; if (PERM) a0 = (a0 & ~12) | ((a0 & 4) << 1) | ((a0 & 8) >> 1);
        u32x2 w; w.x = pkbf(acc[tb][0], acc[tb][1]); w.y = pkbf(acc[tb][2], acc[tb][3]); *(GAS u32x2*)(g + (size_t)b * RW + a0) = w; }
}

__device__ __forceinline__ float wsum_fast(float x) { x = red16(x);
    x += __builtin_bit_cast(float, __builtin_amdgcn_update_dpp(0, __builtin_bit_cast(int, x), 0x142, 0xa, 0xf, false));
    x += __builtin_bit_cast(float, __builtin_amdgcn_update_dpp(0, __builtin_bit_cast(int, x), 0x143, 0xc, 0xf, false));
    return __builtin_bit_cast(float, __builtin_amdgcn_readlane(__builtin_bit_cast(int, x), 63)); }
constexpr int LS2 = 272;
__device__ __forceinline__ void mm128(f32x4 (&acc)[2], LAS unsigned char* lds, int z1, int z2, int ta, int tbh, int fr, int fq) {
#pragma unroll
    for (int s = 0; s < 4; ++s) { const bf16x8 a = *(const LAS bf16x8*)(lds + z1 + t128(16 * ta + fr, 4 * s + fq)), b0 = *(const LAS bf16x8*)(lds + z2 + t128(32 * tbh + fr, 4 * s + fq)), b1 = *(const LAS bf16x8*)(lds + z2 + t128(32 * tbh + 16 + fr, 4 * s + fq));
        acc[0] = __builtin_amdgcn_mfma_f32_16x16x32_bf16(a, b0, acc[0], 0, 0, 0); acc[1] = __builtin_amdgcn_mfma_f32_16x16x32_bf16(a, b1, acc[1], 0, 0, 0); }
}
__device__ __forceinline__ void st_lds_f32(const f32x4 (&acc)[2], LAS unsigned char* lds, int dst, int ta, int tbh, int fr, int fq) {
#pragma unroll
    for (int tb = 0; tb < 2; ++tb) { const int b = 32 * tbh + 16 * tb + fr, a0 = 16 * ta + 4 * fq; *(LAS f32x4*)(lds + dst + b * LS2 + a0 * 4) = acc[tb]; }
}

__device__ __forceinline__ void scan_pre(Frame& F) {
    LAS unsigned char* lds = F.lds + RING_OFF;
    const int w = F.wave, lane = F.lane, fr = lane & 15, fq = lane >> 4, ta = w & 3, tbh = w >> 2;
    const bf16* Z = (const bf16*)(F.ws + WS_Z); const float* mu = INP(4);
    const bf16* WupT = (const bf16*)(F.ws + WS_LORA); const bf16* AupT = WupT + RW * 64; const bf16* GupT = AupT + RW * 64;
    bf16* aLW = (bf16*)(F.dout + DO_W); bf16* aKP = (bf16*)(F.dout + DO_KP); bf16* aKK = (bf16*)(F.dout + DO_KKN); bf16* aB = (bf16*)(F.dout + DO_B);
    bf16* oG = (bf16*)(F.ws + WS_GATE); float* oBon = (float*)(F.ws + WS_BON);
    enum { bAt = 0, bBt = LB, bKt = 2 * LB, bRt = 3 * LB, bAtT = 4 * LB, bVT = 5 * LB, bBhT = 6 * LB, bKhT = 7 * LB, b8 = 8 * LB, b9 = 9 * LB, b10 = 10 * LB, bAak = 11 * LB, bArb = 12 * LB, bArk = 13 * LB };
    enum { lXw = 0, lXa = LB, lXg = 2 * LB, lWw = 4 * LB, lWa = 5 * LB, lWg = 6 * LB, lDw = 8 * LB, lDa = lDw + 64 * LS2, lDg = lDa + 64 * LS2, lSum = lDg + 64 * LS2 };
    static_assert(lWg + 2 * LB <= 8 * LB && lSum + 2048 <= RING_BYTES, "LoRA stage LDS carve");
#ifdef PROBE_SEG
    unsigned long long sg_[8] = {0, 0, 0, 0, 0, 0, 0, 0}, sgt_;
#define SEG0() sgt_ = __builtin_amdgcn_s_memrealtime()
#define SEG(j) do { const unsigned long long n_ = __builtin_amdgcn_s_memrealtime(); sg_[j] += n_ - sgt_; sgt_ = n_; } while (0)
#else
#define SEG0() do {} while (0)
#define SEG(j) do {} while (0)
#endif
    u32x4 cur[4], prv[4]; unsigned short zr_[9], zk_[9], zv_[9];
#define PF_ISSUE(uu) do { const int c_ = (uu) % NCHUNK, bh_ = (uu) / NCHUNK, b_ = bh_ / NH, h_ = bh_ % NH; const size_t m0_ = (size_t)b_ * T + (size_t)c_ * 64; \
        { const int t_ = F.tid >> 3, g0_ = F.tid & 7; const bf16* zrow = Z + (m0_ + t_) * NIN + ZWD; const bool firstrow = (c_ == 0 && t_ == 0); \
          _Pragma("unroll") for (int i = 0; i < 4; ++i) { cur[i] = *(const GAS u32x4*)(zrow + 8 * (g0_ + 8 * i)); prv[i] = (u32x4){0u, 0u, 0u, 0u}; if (!firstrow) prv[i] = *(const GAS u32x4*)(zrow - (long)NIN + 8 * (g0_ + 8 * i)); } } \
        { const bf16* zr = Z + (m0_ + 8 * w) * NIN + h_ * HD + lane; const bool first = (c_ == 0 && w == 0); \
          zr_[0] = 0; zk_[0] = 0; zv_[0] = 0; if (!first) { zr_[0] = zr[-(long)NIN]; zk_[0] = zr[-(long)NIN + ZK_R]; zv_[0] = zr[-(long)NIN + ZV_R]; } \
          _Pragma("unroll") for (int i = 0; i < 8; ++i) { zr_[i + 1] = zr[(size_t)i * NIN]; zk_[i + 1] = zr[(size_t)i * NIN + ZK_R]; zv_[i + 1] = zr[(size_t)i * NIN + ZV_R]; } } } while (0)
    if (F.vcu < BATCH * NH * NCHUNK) PF_ISSUE(F.vcu);
    for (int u = F.vcu; u < BATCH * NH * NCHUNK; u += F.G) {
        SEG0();
        const int c = u % NCHUNK, bh = u / NCHUNK, b = bh / NH, h = bh % NH;
        const size_t m0 = (size_t)b * T + (size_t)c * 64;
        const size_t so = m0 * RW + h * HD;
        { const int t = F.tid >> 3, g0 = F.tid & 7;
          { const int row = F.tid >> 3, ch = F.tid & 7;
            *(LAS u32x4*)(lds + lWw + t64(row, ch)) = *(const GAS u32x4*)(WupT + (size_t)(h * HD + row) * 64 + ch * 8);
            *(LAS u32x4*)(lds + lWa + t64(row, ch)) = *(const GAS u32x4*)(AupT + (size_t)(h * HD + row) * 64 + ch * 8); }
#pragma unroll
          for (int i = 0; i < 2; ++i) { const int pp = F.tid + 512 * i, row = pp >> 4, ch = pp & 15; *(LAS u32x4*)(lds + lWg + t128(row, ch)) = *(const GAS u32x4*)(GupT + (size_t)(h * HD + row) * 128 + ch * 8); }
#pragma unroll
          for (int i = 0; i < 4; ++i) { const int col0 = 8 * (g0 + 8 * i); const f32x4 ma = *(const GAS f32x4*)(mu + ZWD + col0), mb = *(const GAS f32x4*)(mu + ZWD + col0 + 4);
              float z[8];
#pragma unroll
              for (int q = 0; q < 4; ++q) { const unsigned cw = cur[i][q], pw = prv[i][q]; const float c0 = bflo(cw), c1 = bfhi(cw), p0 = bflo(pw), p1 = bfhi(pw);
                  const float m0_ = q < 2 ? ma[2 * q] : mb[2 * q - 4], m1_ = q < 2 ? ma[2 * q + 1] : mb[2 * q - 3];
                  z[2 * q] = c0 + (p0 - c0) * m0_; z[2 * q + 1] = c1 + (p1 - c1) * m1_; }
#pragma unroll
              for (int q = 0; q < 8; ++q) { if (i == 0) z[q] = 1.f - 2.f * __builtin_amdgcn_rcpf(1.f + __expf(2.f * z[q])); else if (i >= 2) z[q] = __builtin_amdgcn_rcpf(1.f + __expf(-z[q])); }
              u32x4 o; o.x = pkbf(z[0], z[1]); o.y = pkbf(z[2], z[3]); o.z = pkbf(z[4], z[5]); o.w = pkbf(z[6], z[7]);
              const int dst = i == 0 ? lXw + t64(t, g0) : (i == 1 ? lXa + t64(t, g0) : lXg + t128(t, (i - 2) * 8 + g0));
              *(LAS u32x4*)(lds + dst) = o; }
        }
        __syncthreads(); SEG(0);
        { f32x4 acc[2];
          acc[0] = (f32x4){0.f, 0.f, 0.f, 0.f}; acc[1] = acc[0]; mm(acc, lds, lWw, lXw, ta, tbh, fr, fq); st_lds_f32(acc, lds, lDw, ta, tbh, fr, fq);
          acc[0] = (f32x4){0.f, 0.f, 0.f, 0.f}; acc[1] = acc[0]; mm(acc, lds, lWa, lXa, ta, tbh, fr, fq); st_lds_f32(acc, lds, lDa, ta, tbh, fr, fq);
          acc[0] = (f32x4){0.f, 0.f, 0.f, 0.f}; acc[1] = acc[0]; mm128(acc, lds, lWg, lXg, ta, tbh, fr, fq); st_lds_f32(acc, lds, lDg, ta, tbh, fr, fq); }
        __syncthreads(); SEG(1);
        { const int cg = h * HD + lane;
          const float w0_ = INP(5)[cg], a0_ = INP(7)[cg], kkc = INP(10)[cg], kac = INP(11)[cg], rkc = INP(12)[cg], mur = mu[cg], muk = mu[ZK_R + cg], muv = mu[ZV_R + cg];
          float lwv[8], e_at[8], e_bb[8], e_kp[8], e_r[8], e_v[8]; float lsum = 0.f;
#pragma unroll
          for (int i = 0; i < 8; ++i) { const int t = 8 * w + i;
              const float cr = bf2f(zr_[i + 1]), ck = bf2f(zk_[i + 1]), cv = bf2f(zv_[i + 1]), pr = bf2f(zr_[i]), pk = bf2f(zk_[i]), pv = bf2f(zv_[i]);
              const float r = cr + (pr - cr) * mur, kx = ck + (pk - ck) * muk, v = cv + (pv - cv) * muv;
              const float dw = w0_ + *(const LAS float*)(lds + lDw + t * LS2 + lane * 4), da = a0_ + *(const LAS float*)(lds + lDa + t * LS2 + lane * 4), gg = *(const LAS float*)(lds + lDg + t * LS2 + lane * 4);
              const float lw = -DECAY_SCALE * __builtin_amdgcn_rcpf(1.f + __expf(-dw)), a = __builtin_amdgcn_rcpf(1.f + __expf(-da));
              const float kk = kx * kkc; const float nn = wsum_fast(kk * kk); const float kkn = kk * __builtin_amdgcn_rsqf(fmaxf(nn, 1e-24f));
              const float kp = kx * (1.f + (a - 1.f) * kac), bb = kkn * a; const float bon = wsum_fast(r * kp * rkc);
              oG[(m0 + t) * RW + cg] = (bf16)f2bf(gg); if (lane == 0) oBon[(m0 + t) * NH + h] = bon;
              lwv[i] = lw; lsum += lw; e_at[i] = -kkn; e_bb[i] = bb; e_kp[i] = kp; e_r[i] = r; e_v[i] = v; }
          *(LAS float*)(lds + lSum + (w * 64 + lane) * 4) = lsum;
          __syncthreads(); SEG(2);
          if (u + F.G < BATCH * NH * NCHUNK) PF_ISSUE(u + F.G);
          float ltot = 0.f, lst = 0.f;
#pragma unroll
          for (int q = 0; q < 8; ++q) { const float sq = *(const LAS float*)(lds + lSum + (q * 64 + lane) * 4); if (q < w) lst += sq; ltot += sq; }
          float L = lst; unsigned short pAtT[8], pVT[8], pBhT[8], pKhT[8];
#pragma unroll
          for (int i = 0; i < 8; ++i) { const int t = 8 * w + i;
              const float Pm = __expf(L); L += lwv[i]; const float P = __expf(L), iP = __expf(-L), Ph = __expf(ltot - L);
              const unsigned short at = (unsigned short)f2bf(e_at[i] * Pm);
              const int eo = t64(t, lane >> 3) + (lane & 7) * 2;
              *(LAS unsigned short*)(lds + bAt + eo) = at; *(LAS unsigned short*)(lds + bBt + eo) = (unsigned short)f2bf(e_bb[i] * iP);
              *(LAS unsigned short*)(lds + bKt + eo) = (unsigned short)f2bf(e_kp[i] * iP); *(LAS unsigned short*)(lds + bRt + eo) = (unsigned short)f2bf(e_r[i] * P);
              pAtT[i] = at; pVT[i] = (unsigned short)f2bf(e_v[i]); pBhT[i] = (unsigned short)f2bf(e_bb[i] * Ph); pKhT[i] = (unsigned short)f2bf(e_kp[i] * Ph); }
#define RS_W16(buf, p) do { u32x4 q_; q_.x = p[0] | ((unsigned)p[1] << 16); q_.y = p[2] | ((unsigned)p[3] << 16); q_.z = p[4] | ((unsigned)p[5] << 16); q_.w = p[6] | ((unsigned)p[7] << 16); *(LAS u32x4*)(lds + (buf) + t64(lane, w)) = q_; } while (0)
          RS_W16(bAtT, pAtT); RS_W16(bVT, pVT); RS_W16(bBhT, pBhT); RS_W16(bKhT, pKhT);
#undef RS_W16
          asm volatile("" :: "v"(ltot));
          __syncthreads(); SEG(3);
          f32x4 acc[2], acc2[2], acc3[2], acc4[2], tacc[2];
#define RS_Z(a) do { a[0] = (f32x4){0.f, 0.f, 0.f, 0.f}; a[1] = (f32x4){0.f, 0.f, 0.f, 0.f}; } while (0)
#define LD(f, z1, z2) ldf(f, lds, z1, z2, ta, tbh, fr, fq)
#define ST(m, a, dst) st_lds<m, false>(a, lds, dst, ta, tbh, fr, fq)
          { Fr f0, f1, f2; LD(f0, bAt, bBt); LD(f1, bKt, bAt); LD(f2, bBt, bRt);
            RS_Z(acc); RS_Z(acc2); RS_Z(acc3); mcf(acc, f0); mcf(acc2, f1); mcf(acc3, f2);
            ST(3, acc, b9);
            ST(1, acc2, bAak);
            ST(2, acc3, bArb); }
          { Fr f3, f4; LD(f3, bKt, bRt); LD(f4, bBt, bAt); RS_Z(acc4); RS_Z(tacc); mcf(acc4, f3); mcf(tacc, f4);
            ST(2, acc4, bArk); }
#pragma unroll
          for (int tb = 0; tb < 2; ++tb)
#pragma unroll
              for (int i = 0; i < 4; ++i) { const int bb_ = 32 * tbh + 16 * tb + fr, a = 16 * ta + 4 * fq + i; tacc[tb][i] = (a < bb_) ? tacc[tb][i] : 0.f; }
          ST(0, tacc, b8);
#pragma unroll
          for (int tb = 0; tb < 2; ++tb)
#pragma unroll
              for (int i = 0; i < 4; ++i) { const int bb_ = 32 * tbh + 16 * tb + fr, a = 16 * ta + 4 * fq + i; if (a == bb_) tacc[tb][i] = 1.f; }
          ST(0, tacc, b10);
          __syncthreads();
          { Fr f0, f1; LD(f0, b9, b8); LD(f1, b8, b9); RS_Z(acc); RS_Z(acc2); mcf(acc, f0); mcf(acc2, f1); ST(0, acc, bAt); ST(0, acc2, bBt); }
          __syncthreads();
          { Fr f0, f1, f2; LD(f0, bBt, b10); LD(f1, bBt, bAt); LD(f2, bAt, bBt); RS_Z(acc); RS_Z(acc2); mcf(tacc, f0); mcf(acc, f1); mcf(acc2, f2); ST(0, tacc, bKt); ST(0, acc, b8); ST(0, acc2, b9); }
          __syncthreads();
          { Fr f0, f1, f2; LD(f0, b9, bKt); LD(f1, b9, b8); LD(f2, b8, b9); RS_Z(acc); RS_Z(acc2); mcf(tacc, f0); mcf(acc, f1); mcf(acc2, f2); ST(0, tacc, b10); ST(0, acc, bAt); ST(0, acc2, bBt); }
          __syncthreads();
          { Fr f0, f1, f2; LD(f0, bBt, b10); LD(f1, bBt, bAt); LD(f2, bAt, bBt); RS_Z(acc); RS_Z(acc2); mcf(tacc, f0); mcf(acc, f1); mcf(acc2, f2); ST(0, tacc, bKt); ST(0, acc, b8); ST(0, acc2, b9); }
          __syncthreads();
          { Fr f0, f1; LD(f0, b9, bKt); LD(f1, b8, b9); RS_Z(acc); mcf(tacc, f0); mcf(acc, f1); ST(0, tacc, b10); ST(0, acc, bBt); }
          __syncthreads();
          { Fr f0; LD(f0, bBt, b10); mcf(tacc, f0); ST(0, tacc, bKt); }
          __syncthreads(); SEG(4);
          { Fr f0, f1; LD(f0, bKt, bAtT); LD(f1, bAak, bVT); RS_Z(acc); RS_Z(acc2); mcf(acc, f0); mcf(acc2, f1); ST(0, acc, bAt); ST(0, acc2, b8); }
          __syncthreads();
          { Fr f0; LD(f0, bKt, b8); RS_Z(acc); mcf(acc, f0); ST(0, acc, b9); }
          __syncthreads();
          { Fr f0, f1, f2; LD(f0, bAt, bArb); LD(f1, b9, bArb); LD(f2, bVT, bArk);
            u32x2 rq[2];
#pragma unroll
            for (int tb = 0; tb < 2; ++tb) { const int bb_ = 32 * tbh + 16 * tb + fr, a0 = 16 * ta + 4 * fq; rq[tb] = *(const LAS u32x2*)(lds + bRt + t64(bb_, a0 >> 3) + (a0 & 4) * 2); }
            RS_Z(acc); mcf(acc, f0);
#pragma unroll
            for (int tb = 0; tb < 2; ++tb) { acc[tb][0] += bflo(rq[tb].x); acc[tb][1] += bfhi(rq[tb].x); acc[tb][2] += bflo(rq[tb].y); acc[tb][3] += bfhi(rq[tb].y); }
            st_glb<false>(acc, aLW + so, ta, tbh, fr, fq);
            RS_Z(acc2); mcf(acc2, f1); mcf(acc2, f2); st_glb<false>(acc2, aKK + so, ta, tbh, fr, fq); }
          { Fr f3, f4, f5; LD(f3, bAt, bBhT); LD(f4, bBhT, b9); LD(f5, bKhT, bVT);
            RS_Z(acc3); mcf(acc3, f3);
            { const float pc = __expf(ltot);
#pragma unroll
              for (int tb = 0; tb < 2; ++tb) { const int bb_ = 32 * tbh + 16 * tb + fr; const float pcb = __shfl(pc, bb_);
#pragma unroll
                  for (int i = 0; i < 4; ++i) { const int a = 16 * ta + 4 * fq + i; if (a == bb_) acc3[tb][i] += pcb; } } }
            st_glb<true>(acc3, aKP + so, ta, tbh, fr, fq);
            RS_Z(acc4); mcf(acc4, f4); mcf(acc4, f5); st_glb<false>(acc4, aB + so, ta, tbh, fr, fq); }
#undef LD
#undef ST
#undef RS_Z
          __syncthreads(); SEG(5);
        }
    }
#undef PF_ISSUE
#ifdef PROBE_SEG
    if (blockIdx.x == 0 && threadIdx.x == 0) { unsigned long long* st = (unsigned long long*)(F.ws + WS_CTL + 65536); st[40] = 0; st[41] = sg_[PROBE_SEG]; }
#endif
}

__device__ __forceinline__ void scan_seq(Frame& F, int bh) {
    const int lane = F.lane, r32 = lane & 31, hi = lane >> 5; const int b = bh / NH, h = bh % NH;
    const bf16* aM = (const bf16*)(F.dout + DO_KP); const bf16* aN = (const bf16*)(F.dout + DO_B); bf16* XS = (bf16*)(F.ws + WS_YRAW);
    f32x16 X[2][2];
#pragma unroll
    for (int i = 0; i < 2; ++i)
#pragma unroll
        for (int j = 0; j < 2; ++j) X[i][j] = f32x16{};
    for (int c = 0; c < NCHUNK; ++c) {
        const size_t so = ((size_t)b * T + (size_t)c * 64) * RW + h * HD;
        bf16* xs = XS + ((size_t)bh * NCHUNK + c) * 4096;
        bf16x8 am[2][2][2];
#pragma unroll
        for (int t1 = 0; t1 < 2; ++t1)
#pragma unroll
            for (int t2 = 0; t2 < 2; ++t2)
#pragma unroll
                for (int s = 0; s < 2; ++s) am[t1][t2][s] = *(const GAS bf16x8*)(aM + so + (size_t)(32 * t1 + r32) * RW + 32 * t2 + 16 * s + 8 * hi);
        u32x2 nn[2][2][4];
#pragma unroll
        for (int tk = 0; tk < 2; ++tk)
#pragma unroll
            for (int tv = 0; tv < 2; ++tv)
#pragma unroll
                for (int g = 0; g < 4; ++g) nn[tk][tv][g] = *(const GAS u32x2*)(aN + so + (size_t)(32 * tv + r32) * RW + 32 * tk + 8 * g + 4 * hi);
        bf16x8 xb[2][2][2];
#pragma unroll
        for (int tk = 0; tk < 2; ++tk)
#pragma unroll
            for (int tv = 0; tv < 2; ++tv) { unsigned pk[8];
#pragma unroll
                for (int q = 0; q < 8; ++q) pk[q] = pkbf(X[tk][tv][2 * q], X[tk][tv][2 * q + 1]);
#pragma unroll
                for (int g = 0; g < 4; ++g) { u32x2 w_; w_.x = pk[2 * g]; w_.y = pk[2 * g + 1]; *(GAS u32x2*)(xs + (size_t)(32 * tv + r32) * 64 + 32 * tk + 8 * g + 4 * hi) = w_; }
                u32x4 f0, f1; f0.x = pk[0]; f0.y = pk[1]; f0.z = pk[2]; f0.w = pk[3]; f1.x = pk[4]; f1.y = pk[5]; f1.z = pk[6]; f1.w = pk[7];
                xb[tk][tv][0] = __builtin_bit_cast(bf16x8, f0); xb[tk][tv][1] = __builtin_bit_cast(bf16x8, f1); }
#pragma unroll
        for (int t1 = 0; t1 < 2; ++t1)
#pragma unroll
            for (int tv = 0; tv < 2; ++tv) { f32x16 a;
#pragma unroll
                for (int g = 0; g < 4; ++g) { const u32x2 q_ = nn[t1][tv][g]; a[4 * g + 0] = bflo(q_.x); a[4 * g + 1] = bfhi(q_.x); a[4 * g + 2] = bflo(q_.y); a[4 * g + 3] = bfhi(q_.y); }
#pragma unroll
                for (int t2 = 0; t2 < 2; ++t2)
#pragma unroll
                    for (int s = 0; s < 2; ++s) a = __builtin_amdgcn_mfma_f32_32x32x16_bf16(am[t1][t2][s], xb[t2][tv][s], a, 0, 0, 0);
                X[t1][tv] = a; }
    }
}

__device__ __forceinline__ void scan_post(Frame& F) {
    const int lane = F.lane, fr = lane & 15, fq = lane >> 4, tb = F.wave & 3;
    const bf16* aRh = (const bf16*)(F.dout + DO_W); const bf16* aYl = (const bf16*)(F.dout + DO_KKN); const bf16* XS = (const bf16*)(F.ws + WS_YRAW);
    const bf16* Zb = (const bf16*)(F.ws + WS_Z); const float* mu = INP(4); const bf16* aG = (const bf16*)(F.ws + WS_GATE); const float* bon = (const float*)(F.ws + WS_BON);
    bf16* Y = (bf16*)(F.ws + WS_Y); const float* lnw = INP(13); const float* lnb = INP(14);
    for (int u = F.vcu * 2 + (F.wave >> 2); u < BATCH * NH * NCHUNK; u += F.G * 2) {
        const int c = u % NCHUNK, bh = u / NCHUNK, b = bh / NH, h = bh % NH;
        const size_t m0 = (size_t)b * T + (size_t)c * 64, so = m0 * RW + h * HD;
        const bf16* xs = XS + (size_t)u * 4096;
        const size_t trow = m0 + 16 * tb + fr;
        bf16x8 bf_[2];
#pragma unroll
        for (int s = 0; s < 2; ++s) bf_[s] = *(const GAS bf16x8*)(aRh + trow * RW + h * HD + 32 * s + 8 * fq);
        f32x4 acc[4];
#pragma unroll
        for (int ta = 0; ta < 4; ++ta) { const u32x2 q_ = *(const GAS u32x2*)(aYl + trow * RW + h * HD + 16 * ta + 4 * fq);
            acc[ta] = (f32x4){bflo(q_.x), bfhi(q_.x), bflo(q_.y), bfhi(q_.y)};
#pragma unroll
            for (int s = 0; s < 2; ++s) { const bf16x8 af = *(const GAS bf16x8*)(xs + (size_t)(16 * ta + fr) * 64 + 32 * s + 8 * fq); acc[ta] = __builtin_amdgcn_mfma_f32_16x16x32_bf16(af, bf_[s], acc[ta], 0, 0, 0); } }
        float s1 = 0.f;
#pragma unroll
        for (int ta = 0; ta < 4; ++ta) s1 += (acc[ta][0] + acc[ta][1]) + (acc[ta][2] + acc[ta][3]);
        s1 += __shfl_xor(s1, 16); s1 += __shfl_xor(s1, 32); const float mean = s1 * (1.f / 64.f); float s2 = 0.f;
#pragma unroll
        for (int ta = 0; ta < 4; ++ta)
#pragma unroll
            for (int i = 0; i < 4; ++i) { const float d_ = acc[ta][i] - mean; acc[ta][i] = d_; s2 += d_ * d_; }
        s2 += __shfl_xor(s2, 16); s2 += __shfl_xor(s2, 32); const float rstd = 1.f / sqrtf(s2 * (1.f / 64.f) + GN_EPS);
        const float bn = bon[trow * NH + h];
#pragma unroll
        for (int ta = 0; ta < 4; ++ta) { const int ch = h * HD + 16 * ta + 4 * fq; const f32x4 lw4 = *(const GAS f32x4*)(lnw + ch), lb4 = *(const GAS f32x4*)(lnb + ch);
            const u32x2 vc = *(const GAS u32x2*)(Zb + trow * NIN + ZV_R + ch), gq = *(const GAS u32x2*)(aG + trow * RW + ch); u32x2 vp; vp.x = 0u; vp.y = 0u;
            if ((trow % T) != 0) vp = *(const GAS u32x2*)(Zb + (trow - 1) * NIN + ZV_R + ch);
            const f32x4 mv = *(const GAS f32x4*)(mu + ZV_R + ch);
            const float v0 = bflo(vc.x) + (bflo(vp.x) - bflo(vc.x)) * mv[0], v1 = bfhi(vc.x) + (bfhi(vp.x) - bfhi(vc.x)) * mv[1], v2 = bflo(vc.y) + (bflo(vp.y) - bflo(vc.y)) * mv[2], v3 = bfhi(vc.y) + (bfhi(vp.y) - bfhi(vc.y)) * mv[3];
            const float o0 = (acc[ta][0] * rstd * lw4[0] + lb4[0] + bn * v0) * bflo(gq.x), o1 = (acc[ta][1] * rstd * lw4[1] + lb4[1] + bn * v1) * bfhi(gq.x);
            const float o2 = (acc[ta][2] * rstd * lw4[2] + lb4[2] + bn * v2) * bflo(gq.y), o3 = (acc[ta][3] * rstd * lw4[3] + lb4[3] + bn * v3) * bfhi(gq.y);
            u32x2 w_; w_.x = pkbf(o0, o1); w_.y = pkbf(o2, o3); *(GAS u32x2*)(Y + trow * D + ch) = w_; }
    }
}
}
using pg8::Unit;
constexpr size_t TILE_B = 256 * 2;
struct SchedBase { int G, c; };
struct SchedZ : SchedBase {
    __device__ __forceinline__ bool next(int i, Unit& u) const {
        const int L = i * G + c; constexpr int NZ = (M / 256) * (NIN / 256), NKV = (MEMR / 256) * (2 * D / 256);
        if (L < NZ) { pg8::tile_map(L, M / 256, NIN / 256, u.pm, u.pn); u.z = 0; u.a_off = WS_XN + (size_t)u.pm * 256 * D * 2; u.b_off = WS_WIN_T + (size_t)u.pn * 256 * D * 2; return true; }
        if (L < NZ + NKV) { const int l = L - NZ; u.pm = l / 8; u.pn = l % 8; u.z = 1; u.a_off = WS_MEMN + (size_t)u.pm * 256 * D * 2; u.b_off = WS_WXKV_T + (size_t)u.pn * 256 * D * 2; return true; }
        return false;
    }
};
struct SchedG : SchedBase {
    __device__ __forceinline__ bool next(int i, Unit& u) const {
        const int L = i * G + c; if (L >= 64) return false;
        u.z = L >> 4; u.pm = (L >> 2) & 3; u.pn = L & 3; u.a_off = WS_KV + ((size_t)u.pm * 256 * 2048 + u.z * 256) * 2; u.b_off = WS_WQ_S + ((size_t)u.pn * 256 * 1024 + u.z * 256) * 2; return true;
    }
};
struct SchedVW : SchedBase {
    __device__ __forceinline__ bool next(int i, Unit& u) const {
        const int L = i * G + (G - 1 - c); if (L >= 64) return false;
        u.z = L >> 2; u.pm = L & 3; u.pn = 0; const int b = u.z >> 2, h = u.z & 3;
        u.a_off = WS_WO_T + ((size_t)u.pm * 256 * 1024 + h * 256) * 2; u.b_off = WS_KV + ((size_t)b * 256 * 2048 + 1024 + h * 256) * 2; return true;
    }
};
struct SchedMN : SchedBase {
    int nN; size_t a_base, b_base; int lda, ldb, bsel;
    __device__ __forceinline__ bool next(int i, Unit& u) const {
        const int L = i * G + c; if (L >= (M / 256) * nN) return false;
        pg8::tile_map(L, M / 256, nN, u.pm, u.pn); u.z = 0;
        u.a_off = a_base + (size_t)u.pm * 256 * lda * 2; u.b_off = b_base + ((size_t)u.pn * 256 + (bsel ? (size_t)(u.pm >> 5) * 1024 : 0)) * ldb * 2; return true;
    }
};

constexpr int CW_MQ = 8192;
__device__ __forceinline__ void moba_attn_phase(Frame& F, int bx) {
    const bf16* Z = (const bf16*)(F.ws + WS_Z); bf16* Y = (bf16*)(F.ws + WS_Y) + RW; const float* KM = (const float*)(F.ws + WS_KMEAN);
    const bool perx = (F.G % 8 == 0); const int x = perx ? (bx & 7) : 0; const int nun = perx ? 128 : 1024;
    unsigned* qc = (unsigned*)(F.ctl + CW_MQ + 64 * x);
    volatile LAS unsigned* slot = F.MISC + 16;
    for (int it = 0;; ++it) {
        if (F.tid == 0) slot[it & 1] = __hip_atomic_fetch_add(qc, 1u, __ATOMIC_RELAXED, __HIP_MEMORY_SCOPE_AGENT);
        asm volatile("s_waitcnt vmcnt(0) lgkmcnt(0)" ::: "memory"); __builtin_amdgcn_s_barrier(); asm volatile("" ::: "memory");
        const int idx = __builtin_amdgcn_readfirstlane((int)slot[it & 1]);
        if (idx >= nun) break;
        const int bh = perx ? x * 4 + (idx & 3) : (idx & 31), qb = perx ? 31 - (idx >> 2) : 31 - (idx >> 5);
        int ln = F.lane; asm volatile("" : "+v"(ln)); ln &= 63;
        attn_body::attn_unit<8>(bh / NH, bh % NH, qb, Z + ZQ, Z + ZK, Z + ZV, Y, KM + (size_t)bh * NBLK * HD, (char*)F.lds + RING_OFF, F.wave, ln);
    }
}

#ifndef MK_N_LAUNCHES
#define MK_N_LAUNCHES 1
#endif
constexpr int PER_PHASE = 12;
constexpr int N_LAUNCHES = MK_N_LAUNCHES;
constexpr int SCAN_WGS = 64;
struct Args { const float* in[25]; float* out; unsigned char* ws; int ph_lo, ph_hi, li, pad; };
__global__ void __launch_bounds__(NWAVES * 64, 2) skel_fwd(Args args) {
    extern __shared__ __attribute__((aligned(16))) unsigned char lds[];
    Frame F;
    F.lds = (LAS unsigned char*)lds;
    F.MISC = (volatile LAS unsigned*)(F.lds + MISC_OFF);
    F.tid = threadIdx.x; F.lane = F.tid & 63; F.wave = __builtin_amdgcn_readfirstlane(F.tid >> 6) & 7;
    F.G = gridDim.x; { const int bx = blockIdx.x; F.vcu = (F.G % 8 == 0) ? (bx % 8) * (F.G / 8) + bx / 8 : bx; }
    F.ws = args.ws; F.dout = (unsigned char*)args.out;
#pragma unroll
    for (int i = 0; i < 25; ++i) F.in[i] = args.in[i];
    F.ctl = (gu32*)(F.ws + WS_CTL);
    for (int u = F.tid; u < (EPI_LDS_OFF - LDSCTL_OFF) / 4; u += NWAVES * 64) ((LAS unsigned*)(F.lds + LDSCTL_OFF))[u] = 0u;
    __syncthreads();
    XcdBarrier bar; bar.bar = (unsigned*)(F.ctl + CW_BAR); bar.x = 0; bar.st = nullptr;
    if (N_LAUNCHES == 1) bar = xcd_barrier_post((unsigned*)(F.ctl + CW_BAR), F.MISC + 8);
#ifdef PROBE_PHASE
    unsigned long long* stamps = (unsigned long long*)(F.ws + WS_CTL + 65536); int nst = 0;
#define STAMP() do { if (blockIdx.x == 0 && threadIdx.x == 0) stamps[nst] = __builtin_amdgcn_s_memrealtime(); ++nst; } while (0)
#else
#define STAMP() do {} while (0)
#endif
#define GRID_BAR() do { if (N_LAUNCHES == 1) xcd_barrier(bar); STAMP(); } while (0)
    const int lo = args.ph_lo, hi = args.ph_hi;
#ifndef PHASE_MASK
#define PHASE_MASK 0xFFFF
#endif
#define IN(k) (((PHASE_MASK >> (k)) & 1) && lo <= (k) && (k) < hi)
#define BOTH(k) (IN(k) && IN((k) + 1))
#define FRESH() do { int l_; asm volatile("v_mbcnt_lo_u32_b32 %0, -1, 0\n\tv_mbcnt_hi_u32_b32 %0, -1, %0" : "=v"(l_)); F.lane = l_ & 63; F.tid = F.wave * 64 + F.lane; } while (0)
    const char* wsc = (const char*)F.ws;
    const int bx = (int)blockIdx.x;

    STAMP();
    if (IN(0)) { FRESH(); if (blockIdx.x == 0 && F.tid == 0) { _Pragma("unroll") for (int i = 0; i < 25; ++i) ((GAS unsigned long long*)(F.ws + WS_TAB))[i] = (unsigned long long)F.in[i]; }
        p0_prologue(F); if (BOTH(0)) GRID_BAR(); }
    if (IN(1)) {
        pg8::Gemm g{wsc, wsc, D, D, D}; SchedZ S; S.G = F.G; S.c = bx;
        pg8::EpiStoreBf16 E{(bf16*)(F.ws + WS_Z), NIN, (bf16*)(F.ws + WS_KV), 2 * D, ZQ / 256, attn_body::C2, 0};
        pg8::gemm_phase<pg8::EpiStoreBf16, SchedZ, true>(F.lds + RING_OFF, g, S, E, F.wave);
        if (BOTH(1)) GRID_BAR();
    }
    if (IN(2)) {
        { pg8::Gemm g{wsc, wsc, 2 * D, D, 256}; SchedG S; S.G = F.G; S.c = bx;
          pg8::EpiStoreBf16 E{(bf16*)(F.ws + WS_GT), D, nullptr, 0, 0, 1.f, 1};
          pg8::gemm_phase<pg8::EpiStoreBf16, SchedG, true>(F.lds + RING_OFF, g, S, E, F.wave); }
        { pg8::Gemm g{wsc, wsc, D, 2 * D, 256}; SchedVW S; S.G = F.G; S.c = bx;
          pg8::EpiStoreBf16 E{(bf16*)(F.ws + WS_VWT), D, nullptr, 0, 0, 1.f, 2};
          pg8::gemm_phase<pg8::EpiStoreBf16, SchedVW, true>(F.lds + RING_OFF, g, S, E, F.wave); }
        __syncthreads();
        FRESH(); kmean_simple(F);
        if (BOTH(2)) GRID_BAR();
    }
    if (IN(3)) { FRESH(); rscan::scan_pre(F); if (BOTH(3)) GRID_BAR(); }
    if (IN(4)) {
        FRESH();
        if (bx < BATCH * NH) { if (F.wave == 0) rscan::scan_seq(F, bx); __syncthreads(); }
        moba_attn_phase(F, bx);
        if (BOTH(4)) GRID_BAR();
    }
    if (IN(5)) { FRESH(); rscan::scan_post(F); if (BOTH(5)) GRID_BAR(); }
    if (IN(6)) {
        pg8::Gemm g{wsc, wsc, D, D, D}; SchedMN S; S.G = F.G; S.c = bx; S.nN = D / 256; S.a_base = WS_Y; S.b_base = WS_WMIX_T; S.lda = D; S.ldb = D; S.bsel = 0;
        pg8::EpiRes E{INP(0), (float*)F.dout, (bf16*)(F.ws + WS_HB), (float*)(F.ws + WS_SS), D};
        pg8::gemm_phase<pg8::EpiRes, SchedMN, true>(F.lds + RING_OFF, g, S, E, F.wave);
        if (BOTH(6)) GRID_BAR();
    }
    if (IN(7)) {
        pg8::Gemm g{wsc, wsc, D, D, D}; SchedMN S; S.G = F.G; S.c = bx; S.nN = D / 256; S.a_base = WS_HB; S.b_base = WS_GT; S.lda = D; S.ldb = D; S.bsel = 1;
        pg8::EpiSoftmax E{(bf16*)(F.ws + WS_P), D, (const float*)(F.ws + WS_SS), (PG8_LAS pg8::f32x2*)(F.lds + EPI_LDS_OFF)};
        pg8::gemm_phase<pg8::EpiSoftmax, SchedMN, true>(F.lds + RING_OFF, g, S, E, F.wave);
        if (BOTH(7)) GRID_BAR();
    }
    if (IN(8)) {
        pg8::Gemm g{wsc, wsc, D, D, D}; SchedMN S; S.G = F.G; S.c = bx; S.nN = D / 256; S.a_base = WS_P; S.b_base = WS_VWT; S.lda = D; S.ldb = D; S.bsel = 1;
        pg8::EpiRes E{(const float*)F.dout, (float*)F.dout, (bf16*)(F.ws + WS_HB), (float*)(F.ws + WS_SS) + (size_t)M * 16, D};
        pg8::gemm_phase<pg8::EpiRes, SchedMN, true>(F.lds + RING_OFF, g, S, E, F.wave);
        if (BOTH(8)) GRID_BAR();
    }
    if (IN(9)) {
        pg8::Gemm g{wsc, wsc, D, D, D}; SchedMN S; S.G = F.G; S.c = bx; S.nN = FF / 256; S.a_base = WS_HB; S.b_base = WS_W1_T; S.lda = D; S.ldb = D; S.bsel = 0;
        pg8::EpiSqRelu E{(bf16*)(F.ws + WS_AH), FF, (const float*)(F.ws + WS_SS) + (size_t)M * 16};
        pg8::gemm_phase<pg8::EpiSqRelu, SchedMN, true>(F.lds + RING_OFF, g, S, E, F.wave);
        if (BOTH(9)) GRID_BAR();
    }
    if (IN(10)) {
        pg8::Gemm g{wsc, wsc, FF, FF, FF}; SchedMN S; S.G = F.G; S.c = bx; S.nN = D / 256; S.a_base = WS_AH; S.b_base = WS_W2_T; S.lda = FF; S.ldb = FF; S.bsel = 0;
        pg8::EpiRes E{(const float*)F.dout, (float*)F.dout, nullptr, (float*)(F.ws + WS_SS) + (size_t)2 * M * 16, D};
        pg8::gemm_phase<pg8::EpiRes, SchedMN, true>(F.lds + RING_OFF, g, S, E, F.wave);
        if (BOTH(10)) GRID_BAR();
    }
    if (IN(11)) { FRESH();
#ifdef PROBE_PHASE
        float pscale; { const unsigned long long* st = (const unsigned long long*)(F.ws + WS_CTL + 65536);
#ifdef PROBE_SEG
          pscale = 1.f + (float)(st[41]) * 1e-6f; }
#else
          pscale = 1.f + (float)(st[PROBE_PHASE + 1] - st[PROBE_PHASE]) * 1e-6f; }
#endif
        final_norm(F, pscale);
#else
        final_norm(F, 1.f);
#endif
    }
#undef IN
#undef BOTH
}

extern "C" void kernel_launch(void* const* d_in, const int* in_sizes, int n_in, void* d_out, int out_size, void* d_ws, size_t ws_size, hipStream_t stream) {
    static int grid = 0;
    if (grid == 0) {
        if (n_in != 25 || in_sizes[0] != M * D || out_size != M * D || ws_size < WS_END) { fprintf(stderr, "kernel_launch: unexpected problem (n_in %d, in0 %d, out %d, ws %zu); nothing launched\n", n_in, n_in > 0 ? in_sizes[0] : -1, out_size, ws_size); grid = -1; return; }
        int dev = 0, cus = 0, per_cu = 0;
        if (hipGetDevice(&dev) != hipSuccess || hipDeviceGetAttribute(&cus, hipDeviceAttributeMultiprocessorCount, dev) != hipSuccess) { grid = -1; return; }
        if (hipFuncSetAttribute((const void*)skel_fwd, hipFuncAttributeMaxDynamicSharedMemorySize, LDS_BYTES) != hipSuccess) { fprintf(stderr, "kernel_launch: hipFuncSetAttribute failed\n"); grid = -1; return; }
        if (hipOccupancyMaxActiveBlocksPerMultiprocessor(&per_cu, (const void*)skel_fwd, NWAVES * 64, LDS_BYTES) != hipSuccess || per_cu < 1)
            fprintf(stderr, "kernel_launch: note: occupancy query reports %d workgroups per CU\n", per_cu);
        (void)hipGetLastError();
        grid = cus;
    }
    if (grid < 0) return;
    if (hipMemsetAsync((char*)d_ws + WS_CTL, 0, CTL_ZERO_BYTES, stream) != hipSuccess) { fprintf(stderr, "kernel_launch: hipMemsetAsync failed\n"); return; }
    Args a{};
    for (int i = 0; i < 25; ++i) a.in[i] = (const float*)d_in[i];
    a.out = (float*)d_out; a.ws = (unsigned char*)d_ws;
    for (int li = 0; li < N_LAUNCHES; ++li) {
        a.ph_lo = (N_LAUNCHES == PER_PHASE) ? li : 0; a.ph_hi = (N_LAUNCHES == PER_PHASE) ? li + 1 : PER_PHASE; a.li = li;
        hipLaunchKernelGGL(skel_fwd, dim3(grid), dim3(NWAVES * 64), LDS_BYTES, stream, a);
        const hipError_t le = hipPeekAtLastError();
        if (le != hipSuccess) { fprintf(stderr, "kernel_launch: launch %d failed: %s\n", li, hipGetErrorName(le)); break; }
    }
}
```

```cpp
#include <hip/hip_runtime.h>
#include <cstdio>
#include <cstdint>
#include <cmath>
namespace pg8 {
#define PG8_LAS __attribute__((address_space(3)))
typedef unsigned short bf16_t;
typedef short bf16x8 __attribute__((ext_vector_type(8)));
typedef float f32x4 __attribute__((ext_vector_type(4)));
typedef float f32x2 __attribute__((ext_vector_type(2)));
typedef unsigned u32x4 __attribute__((ext_vector_type(4)));
typedef unsigned u32x2 __attribute__((ext_vector_type(2)));
constexpr int BM = 256, BK = 64, HALF = 128, HTB = HALF * BK * 2  , STAGE_BYTES = 8 * HTB, NXCD = 8, WGM = 8;

__host__ __device__ __forceinline__ int lds_byte(int r, int c) { const int st = (r >> 4) * 2 + (c >> 5), rr = r & 15, cc = c & 31, ob = rr * 64 + cc * 2; return st * 1024 + (ob ^ (((ob >> 9) & 1) << 5)); }
__host__ __device__ __forceinline__ void stage_rc(int b, int& R, int& C) { const int st = b / 1024, sb = b % 1024, swz = sb ^ (((sb >> 9) & 1) << 5); R = (st >> 1) * 16 + swz / 64; C = (st & 1) * 32 + (swz % 64) / 2; }
__host__ __device__ __forceinline__ int perm32(int rho) { const int n = rho >> 4, i = rho & 15; return 8 * (i >> 2) + 4 * n + (i & 3); }

struct Unit { int pm, pn, z; size_t a_off, b_off; };
struct Gemm { const char* A; const char* Bt; int lda, ldb, K; };

__host__ __device__ __forceinline__ void tile_map(int L, int nM, int nN, int& pm, int& pn) {
    const int nwg = nM * nN; int wgid = L;
    { const int q = nwg / NXCD, r = nwg % NXCD, xcd = wgid % NXCD, off = wgid / NXCD; wgid = (xcd < r ? xcd * (q + 1) : r * (q + 1) + (xcd - r) * q) + off; }
    const int nig = WGM * nN, gid = wgid / nig, fm = gid * WGM, gsz = (nM - fm) < WGM ? (nM - fm) : WGM;
    pm = fm + ((wgid % nig) % gsz); pn = (wgid % nig) / gsz;
}

__device__ __forceinline__ unsigned cvt_pk_bf16(float lo, float hi) { unsigned r; asm volatile("v_cvt_pk_bf16_f32 %0, %1, %2" : "=v"(r) : "v"(lo), "v"(hi)); return r; }

template <class Epi, class Sched, bool ALIGN_EPI>
__device__ __forceinline__ void gemm_phase(PG8_LAS unsigned char* lds, const Gemm g, const Sched& S, const Epi& E, const int wid_) {
    int lane_; asm volatile("v_mbcnt_lo_u32_b32 %0, -1, 0\n\tv_mbcnt_hi_u32_b32 %0, -1, %0" : "=v"(lane_));
    const int lane = lane_ & 63, wid = wid_ & 7, tid = wid * 64 + lane, wr = wid >> 2, wc = wid & 3, fr = lane & 15, fq = lane >> 4;
    const int K = g.K, nt = K / BK;
    unsigned voffA[2], voffB[2];
#pragma unroll
    for (int i = 0; i < 2; ++i) { int R, C; stage_rc(tid * 16 + i * 8192, R, C); const int Rb = Epi::PERM ? ((R & ~31) + perm32(R & 31)) : R;
        voffA[i] = (unsigned)(R * g.lda + C) * 2u; voffB[i] = (unsigned)(Rb * g.ldb + C) * 2u; }
    const size_t kstep = (size_t)(BK * 2);
    const size_t hstepA = (size_t)HALF * g.lda * 2, hstepB = (size_t)HALF * g.ldb * 2;
    const unsigned ldsw = (unsigned)wid * 1024u;
    const int aoff = lds_byte(wr * 64 + fr, fq * 8), boff = lds_byte(wc * 32 + fr, fq * 8);
#define PG8_SA(b, h) (((b) * 2 + (h)) * HTB)
#define PG8_SB(b, h) ((4 + (b) * 2 + (h)) * HTB)
#define PG8_STAGE(bufoff, gbase, voff) do { _Pragma("unroll") for (int _i = 0; _i < 2; ++_i) \
        __builtin_amdgcn_global_load_lds((const unsigned*)((const char*)(gbase) + (voff)[_i]), (PG8_LAS unsigned*)(lds + (bufoff) + ldsw + _i * 8192), 16, 0, 0); } while (0)
#define PG8_LDA(dst, b, h) do { _Pragma("unroll") for (int m = 0; m < 4; ++m) _Pragma("unroll") for (int k = 0; k < 2; ++k) dst[m][k] = *(const PG8_LAS bf16x8*)(lds + PG8_SA(b, h) + aoff + m * 2048 + k * 1024); } while (0)
#define PG8_LDB(dst, b, h) do { _Pragma("unroll") for (int n = 0; n < 2; ++n) _Pragma("unroll") for (int k = 0; k < 2; ++k) dst[n][k] = *(const PG8_LAS bf16x8*)(lds + PG8_SB(b, h) + boff + n * 2048 + k * 1024); } while (0)
#define PG8_MMA(ai, bj, At, Bt) do { __builtin_amdgcn_s_setprio(1); _Pragma("unroll") for (int m = 0; m < 4; ++m) _Pragma("unroll") for (int n = 0; n < 2; ++n) _Pragma("unroll") for (int k = 0; k < 2; ++k) \
        acc[ai][bj][m][n] = __builtin_amdgcn_mfma_f32_16x16x32_bf16(Bt[n][k], At[m][k], acc[ai][bj][m][n], 0, 0, 0); __builtin_amdgcn_s_setprio(0); } while (0)
#define PG8_WAIT_V(n) asm volatile("s_waitcnt vmcnt(" #n ")" ::: "memory")
#define PG8_WAIT_L(n) asm volatile("s_waitcnt lgkmcnt(" #n ")" ::: "memory")
#define PG8_BAR __builtin_amdgcn_s_barrier()
#define PG8_SCHED __builtin_amdgcn_sched_barrier(0)
    Unit cur, nxt; int ui = 0;
    if (!S.next(0, cur)) return;
    f32x4 acc[2][2][4][2];
#pragma unroll
    for (int a = 0; a < 2; ++a)
#pragma unroll
        for (int b = 0; b < 2; ++b)
#pragma unroll
            for (int m = 0; m < 4; ++m)
#pragma unroll
                for (int n = 0; n < 2; ++n) acc[a][b][m][n] = (f32x4){0.f, 0.f, 0.f, 0.f};
    bf16x8 At[4][2], B0[2][2], B1[2][2];
    const char* cA = g.A + cur.a_off; const char* cB = g.Bt + cur.b_off;
    PG8_STAGE(PG8_SB(0, 0), cB, voffB); PG8_STAGE(PG8_SB(0, 1), cB + hstepB, voffB); PG8_STAGE(PG8_SA(0, 0), cA, voffA); PG8_STAGE(PG8_SA(0, 1), cA + hstepA, voffA);
    if (wr == 1) PG8_BAR;
    PG8_WAIT_V(2); PG8_BAR;
    PG8_STAGE(PG8_SB(1, 0), cB + kstep, voffB); PG8_STAGE(PG8_SA(1, 0), cA + kstep, voffA); PG8_STAGE(PG8_SB(1, 1), cB + hstepB + kstep, voffB);
    PG8_WAIT_V(6); PG8_BAR;
    for (;;) {
        const bool has_next = S.next(ui + 1, nxt);
        const char* nA = has_next ? g.A + nxt.a_off : cA; const char* nB = has_next ? g.Bt + nxt.b_off : cB;
        for (int t = 0; t < nt; t += 2) {
            const bool last = (t == nt - 2);
            const char* a1 = cA + (size_t)(t + 1) * kstep;
            const char* a2 = last ? nA : cA + (size_t)(t + 2) * kstep; const char* b2 = last ? nB : cB + (size_t)(t + 2) * kstep;
            const char* a3 = a2 + kstep; const char* b3 = b2 + kstep;
            PG8_LDB(B0, 0, 0); PG8_LDB(B1, 0, 1); PG8_SCHED; PG8_LDA(At, 0, 0); PG8_STAGE(PG8_SA(1, 1), a1 + hstepA, voffA);
            PG8_WAIT_V(8); PG8_WAIT_L(0); PG8_BAR; PG8_MMA(0, 0, At, B0); PG8_MMA(0, 1, At, B1); PG8_BAR; PG8_SCHED;
            PG8_LDA(At, 0, 1); PG8_STAGE(PG8_SB(0, 0), b2, voffB); PG8_STAGE(PG8_SB(0, 1), b2 + hstepB, voffB); PG8_STAGE(PG8_SA(0, 0), a2, voffA);
            PG8_WAIT_V(8); PG8_WAIT_L(0); PG8_BAR; PG8_MMA(1, 0, At, B0); PG8_MMA(1, 1, At, B1); PG8_BAR; PG8_SCHED;
            PG8_LDB(B0, 1, 0); PG8_LDB(B1, 1, 1); PG8_SCHED; PG8_LDA(At, 1, 0); PG8_STAGE(PG8_SA(0, 1), a2 + hstepA, voffA);
            PG8_WAIT_V(8); PG8_WAIT_L(0); PG8_BAR; PG8_MMA(0, 0, At, B0); PG8_MMA(0, 1, At, B1); PG8_BAR; PG8_SCHED;
            PG8_LDA(At, 1, 1); PG8_STAGE(PG8_SB(1, 0), b3, voffB); PG8_STAGE(PG8_SB(1, 1), b3 + hstepB, voffB); PG8_STAGE(PG8_SA(1, 0), a3, voffA);
            PG8_WAIT_V(8); PG8_WAIT_L(0); PG8_BAR; PG8_MMA(1, 0, At, B0); PG8_MMA(1, 1, At, B1); PG8_BAR; PG8_SCHED;
        }
        if constexpr (ALIGN_EPI) { if (wr == 0) PG8_BAR; }
        E(acc, cur, wr, wc, fr, fq, lane);
        if (!has_next) break;
#pragma unroll
        for (int a = 0; a < 2; ++a)
#pragma unroll
            for (int b = 0; b < 2; ++b)
#pragma unroll
                for (int m = 0; m < 4; ++m)
#pragma unroll
                    for (int n = 0; n < 2; ++n) acc[a][b][m][n] = (f32x4){0.f, 0.f, 0.f, 0.f};
        cur = nxt; cA = nA; cB = nB; ++ui;
        if constexpr (ALIGN_EPI) { if (wr == 1) PG8_BAR; }
    }
    PG8_WAIT_V(0);
    if constexpr (!ALIGN_EPI) { if (wr == 0) PG8_BAR; }
    PG8_BAR;
#undef PG8_SA
#undef PG8_SB
#undef PG8_STAGE
#undef PG8_LDA
#undef PG8_LDB
#undef PG8_MMA
#undef PG8_WAIT_V
#undef PG8_WAIT_L
#undef PG8_BAR
#undef PG8_SCHED
}
}
namespace pg8 {
struct EpiStoreBf16 {
    static constexpr bool PERM = true;
    bf16_t* O0; int ldc0; bf16_t* O1; int ldc1; int qs_lo; float qscale;
    int mode;
    __device__ __forceinline__ void operator()(const f32x4 (&acc)[2][2][4][2], const Unit& u, int wr, int wc, int fr, int fq, int lane) const {
        asm volatile("" : "+v"(fr), "+v"(fq), "+v"(lane));
        bf16_t* base; int ldc; size_t row0; int colt;
        if (mode == 0) { base = u.z ? O1 : O0; ldc = u.z ? ldc1 : ldc0; row0 = (size_t)u.pm * BM; colt = u.pn * BM; }
        else if (mode == 1) { base = O0; ldc = ldc0; row0 = (size_t)u.pm * 1024 + (size_t)u.z * 256; colt = u.pn * BM; }
        else { base = O0 + (size_t)(u.z >> 2) * 1048576; ldc = ldc0; row0 = (size_t)u.pm * BM; colt = (u.z & 3) * 256; }
        const float sc = (mode == 0 && u.z == 0 && (u.pn == qs_lo || u.pn == qs_lo + 1)) ? qscale : 1.f;
        const int col0 = colt + wc * 32 + 8 * fq;
#pragma unroll
        for (int ai = 0; ai < 2; ++ai)
#pragma unroll
            for (int m = 0; m < 4; ++m) { bf16_t* rowp = base + (row0 + wr * 64 + fr + ai * HALF + m * 16) * ldc + col0;
#pragma unroll
                for (int bj = 0; bj < 2; ++bj) { const f32x4 v0 = acc[ai][bj][m][0] * sc, v1 = acc[ai][bj][m][1] * sc;
                    u32x4 w; w.x = cvt_pk_bf16(v0[0], v0[1]); w.y = cvt_pk_bf16(v0[2], v0[3]); w.z = cvt_pk_bf16(v1[0], v1[1]); w.w = cvt_pk_bf16(v1[2], v1[3]);
                    *(u32x4*)(rowp + bj * HALF) = w; } }
    }
};

__device__ __forceinline__ float row_rstd(const float* ss, size_t row) {
    const f32x4* p = (const f32x4*)(ss + row * 16); const f32x4 a = p[0], b = p[1], c = p[2], d = p[3];
    const float s = ((a[0] + a[1]) + (a[2] + a[3])) + ((b[0] + b[1]) + (b[2] + b[3])) + ((c[0] + c[1]) + (c[2] + c[3])) + ((d[0] + d[1]) + (d[2] + d[3]));
    return 1.0f / sqrtf(s * (1.0f / 1024.0f) + 1e-6f);
}
__device__ __forceinline__ void wave_rstd(float (&rs)[2][4], const float* ss, int pm, int wr, int fr, int lane) {
    const float my0 = row_rstd(ss, (size_t)pm * BM + wr * 64 + lane), my1 = row_rstd(ss, (size_t)pm * BM + HALF + wr * 64 + lane);
#pragma unroll
    for (int m = 0; m < 4; ++m) { rs[0][m] = __shfl(my0, m * 16 + fr); rs[1][m] = __shfl(my1, m * 16 + fr); }
}

template <bool BASE_BF16, bool OUT_F32> struct EpiRes {
    static constexpr bool PERM = false;
    const float* base; const bf16_t* baseb; float* out; bf16_t* hb; float* ss; int ldc;
    __device__ __forceinline__ void operator()(f32x4 (&acc)[2][2][4][2], const Unit& u, int wr, int wc, int fr, int fq, int lane) const {
        asm volatile("" : "+v"(fr), "+v"(fq), "+v"(lane));
        const int col0 = u.pn * BM + wc * 32 + 4 * fq;
#pragma unroll
        for (int ai = 0; ai < 2; ++ai)
#pragma unroll
            for (int m = 0; m < 4; ++m) { const size_t row = (size_t)u.pm * BM + ai * HALF + wr * 64 + m * 16 + fr; const size_t off = row * ldc + col0; float q = 0.f;
#pragma unroll
                for (int bj = 0; bj < 2; ++bj)
#pragma unroll
                    for (int n = 0; n < 2; ++n) { f32x4 bs;
                        if (BASE_BF16) { const u32x2 b2 = *(const u32x2*)(baseb + off + bj * HALF + n * 16); bs = (f32x4){__builtin_bit_cast(float, b2.x << 16), __builtin_bit_cast(float, b2.x & 0xffff0000u), __builtin_bit_cast(float, b2.y << 16), __builtin_bit_cast(float, b2.y & 0xffff0000u)}; }
                        else bs = *(const f32x4*)(base + off + bj * HALF + n * 16);
                        const f32x4 o = bs + acc[ai][bj][m][n];
                        if (OUT_F32) *(f32x4*)(out + off + bj * HALF + n * 16) = o;
                        q += (o[0] * o[0] + o[1] * o[1]) + (o[2] * o[2] + o[3] * o[3]);
                        u32x2 w; w.x = cvt_pk_bf16(o[0], o[1]); w.y = cvt_pk_bf16(o[2], o[3]); *(u32x2*)(hb + off + bj * HALF + n * 16) = w; }
                q += __shfl_xor(q, 16); q += __shfl_xor(q, 32);
                if (fq == 0) ss[row * 16 + u.pn * 4 + wc] = q;
                if (m & 1) asm volatile("" ::: "memory"); }
    }
};

struct EpiSqRelu {
    static constexpr bool PERM = true;
    bf16_t* O; int ldc; const float* ss;
    __device__ __forceinline__ void operator()(const f32x4 (&acc)[2][2][4][2], const Unit& u, int wr, int wc, int fr, int fq, int lane) const {
        asm volatile("" : "+v"(fr), "+v"(fq), "+v"(lane));
        float rs[2][4]; wave_rstd(rs, ss, u.pm, wr, fr, lane);
        const int col0 = u.pn * BM + wc * 32 + 8 * fq;
#pragma unroll
        for (int ai = 0; ai < 2; ++ai)
#pragma unroll
            for (int m = 0; m < 4; ++m) { bf16_t* rowp = O + ((size_t)u.pm * BM + wr * 64 + fr + ai * HALF + m * 16) * ldc + col0; const float s = rs[ai][m];
#pragma unroll
                for (int bj = 0; bj < 2; ++bj) { f32x4 v0 = acc[ai][bj][m][0] * s, v1 = acc[ai][bj][m][1] * s;
#pragma unroll
                    for (int i = 0; i < 4; ++i) { const float a = fmaxf(v0[i], 0.f), b = fmaxf(v1[i], 0.f); v0[i] = a * a; v1[i] = b * b; }
                    u32x4 w; w.x = cvt_pk_bf16(v0[0], v0[1]); w.y = cvt_pk_bf16(v0[2], v0[3]); w.z = cvt_pk_bf16(v1[0], v1[1]); w.w = cvt_pk_bf16(v1[2], v1[3]);
                    *(u32x4*)(rowp + bj * HALF) = w; } }
    }
};

struct EpiSoftmax {
    static constexpr bool PERM = true;
    bf16_t* O; int ldc; const float* ss; PG8_LAS f32x2* xl;
    __device__ __forceinline__ void operator()(f32x4 (&acc)[2][2][4][2], const Unit& u, int wr, int wc, int fr, int fq, int lane) const {
        asm volatile("" : "+v"(fr), "+v"(fq), "+v"(lane));
        float rs[2][4]; wave_rstd(rs, ss, u.pm, wr, fr, lane);
#pragma unroll
        for (int ai = 0; ai < 2; ++ai)
#pragma unroll
            for (int m = 0; m < 4; ++m) { const float s = rs[ai][m] * (0.0625f * 1.4426950408889634f); float mx = -INFINITY;
#pragma unroll
                for (int bj = 0; bj < 2; ++bj)
#pragma unroll
                    for (int n = 0; n < 2; ++n) { f32x4 v = acc[ai][bj][m][n] * s; acc[ai][bj][m][n] = v; mx = fmaxf(fmaxf(mx, fmaxf(v[0], v[1])), fmaxf(v[2], v[3])); }
                mx = fmaxf(mx, __shfl_xor(mx, 16)); mx = fmaxf(mx, __shfl_xor(mx, 32)); float sm = 0.f;
#pragma unroll
                for (int bj = 0; bj < 2; ++bj)
#pragma unroll
                    for (int n = 0; n < 2; ++n) { f32x4 v = acc[ai][bj][m][n];
#pragma unroll
                        for (int i = 0; i < 4; ++i) { v[i] = __builtin_amdgcn_exp2f(v[i] - mx); sm += v[i]; } acc[ai][bj][m][n] = v; }
                sm += __shfl_xor(sm, 16); sm += __shfl_xor(sm, 32);
                if (fq == 0) xl[(ai * HALF + wr * 64 + m * 16 + fr) * 4 + wc] = (f32x2){mx, sm}; }
        asm volatile("s_waitcnt lgkmcnt(0)" ::: "memory"); __builtin_amdgcn_s_barrier(); asm volatile("" ::: "memory");
        const int col0 = u.pn * BM + wc * 32 + 8 * fq;
#pragma unroll
        for (int ai = 0; ai < 2; ++ai)
#pragma unroll
            for (int m = 0; m < 4; ++m) { const int r = ai * HALF + wr * 64 + m * 16 + fr;
                const f32x4 x01 = *(const PG8_LAS f32x4*)(xl + r * 4), x23 = *(const PG8_LAS f32x4*)(xl + r * 4 + 2);
                const float mg = fmaxf(fmaxf(x01[0], x01[2]), fmaxf(x23[0], x23[2]));
                const float tot = x01[1] * __builtin_amdgcn_exp2f(x01[0] - mg) + x01[3] * __builtin_amdgcn_exp2f(x01[2] - mg) + x23[1] * __builtin_amdgcn_exp2f(x23[0] - mg) + x23[3] * __builtin_amdgcn_exp2f(x23[2] - mg);
                const float mown = wc == 0 ? x01[0] : (wc == 1 ? x01[2] : (wc == 2 ? x23[0] : x23[2]));
                const float f = __builtin_amdgcn_exp2f(mown - mg) / tot;
                bf16_t* rowp = O + ((size_t)u.pm * BM + r) * ldc + col0;
#pragma unroll
                for (int bj = 0; bj < 2; ++bj) { const f32x4 v0 = acc[ai][bj][m][0] * f, v1 = acc[ai][bj][m][1] * f;
                    u32x4 w; w.x = cvt_pk_bf16(v0[0], v0[1]); w.y = cvt_pk_bf16(v0[2], v0[3]); w.z = cvt_pk_bf16(v1[0], v1[1]); w.w = cvt_pk_bf16(v1[2], v1[3]);
                    *(u32x4*)(rowp + bj * HALF) = w; } }
    }
};
}
constexpr int NWAVES = 8;
constexpr int BATCH = 4, T = 8192, D = 1024, M = BATCH * T;
constexpr int NIN = 3328, RW = 512, NH = 8, HD = 64;
constexpr int ZK_R = 512, ZV_R = 1024, ZWD = 1536, ZAD = 1600, ZGD = 1664;
constexpr int ZQ = 1792, ZK = 1792 + 512, ZV = 1792 + 1024;
constexpr int MEML = 256, MEMR = BATCH * MEML, FF = 4096;
constexpr int NBLK = T / 256;
constexpr float NORM_EPS = 1e-6f, GN_EPS = 64e-5f, DECAY_SCALE = 0.6065306597126334f;

constexpr size_t MiB = 1u << 20;
constexpr size_t WS_CTL = 0, CTL_ZERO_BYTES = 1 * MiB;
constexpr size_t WS_WIN_T = 1 * MiB, WS_WMIX_T = 8 * MiB, WS_WQ_S = 10 * MiB, WS_WXKV_T = 12 * MiB, WS_WO_T = 16 * MiB, WS_W1_T = 18 * MiB, WS_W2_T = 26 * MiB;
constexpr size_t WS_MEMN = 34 * MiB, WS_KV = 36 * MiB, WS_GT = 40 * MiB, WS_VWT = 48 * MiB;
constexpr size_t WS_SS = 56 * MiB;
constexpr size_t WS_KMEAN = 62 * MiB, WS_LORA = 62 * MiB + 512 * 1024, WS_BON = 63 * MiB;
constexpr size_t WS_XN = 64 * MiB;
constexpr size_t WS_GATE = 64 * MiB, WS_YRAW = 96 * MiB;
constexpr size_t WS_HB = 64 * MiB;
constexpr size_t WS_Z = 128 * MiB;
constexpr size_t WS_Y = 336 * MiB;
constexpr size_t WS_PR = 400 * MiB, WS_PV = 432 * MiB;
constexpr size_t WS_P = 400 * MiB;
constexpr size_t WS_AH = 128 * MiB;
constexpr size_t WS_END = 512 * MiB;
constexpr size_t DO_W = 0, DO_KP = 32 * MiB, DO_KKN = 64 * MiB, DO_B = 96 * MiB;

constexpr int CW_TMO = 0, CW_CODE = 1;
constexpr int CW_BAR = 4096;

constexpr int RING_OFF = 0, RING_BYTES = 131072;
constexpr int LDSCTL_OFF = RING_BYTES, MISC_OFF = LDSCTL_OFF + 320;
constexpr int EPI_LDS_OFF = 132096;
constexpr int LDS_BYTES = 147456;
static_assert(MISC_OFF + 128 <= EPI_LDS_OFF && EPI_LDS_OFF + 8192 <= LDS_BYTES, "LDS map");

#define GAS __attribute__((address_space(1)))
#define LAS __attribute__((address_space(3)))
typedef unsigned short bf16;
typedef unsigned v4u __attribute__((ext_vector_type(4)));
typedef float f32x4 __attribute__((ext_vector_type(4)));
typedef GAS unsigned gu32;
#define RLX_AGENT __ATOMIC_RELAXED, __HIP_MEMORY_SCOPE_AGENT
#define LDS_WAIT() asm volatile("s_waitcnt lgkmcnt(0)" ::: "memory")
#define VM_WAIT() asm volatile("s_waitcnt vmcnt(0)" ::: "memory")
__device__ __forceinline__ unsigned f2bf(float f) { unsigned u = __builtin_bit_cast(unsigned, f); return (u + 0x7fffu + ((u >> 16) & 1u)) >> 16; }
__device__ __forceinline__ unsigned pk2(float lo, float hi) { return f2bf(lo) | (f2bf(hi) << 16); }
__device__ __forceinline__ float bf2f(unsigned short u) { return __builtin_bit_cast(float, (unsigned)u << 16); }
__device__ __forceinline__ float bflo(unsigned u) { return __builtin_bit_cast(float, u << 16); }
__device__ __forceinline__ float bfhi(unsigned u) { return __builtin_bit_cast(float, u & 0xffff0000u); }

#define XB_TMO      128
#define XB_XCNT(j)  (256  + 64 * (j))
#define XB_XSUB(j)  (1280 + 64 * (j))
#define XB_XGEN(j)  (2304 + 64 * (j))
#define XB_TOP      3328
#define XB_TOPGEN   3392
#define XCD_BAR_WORDS 3456
#define XB_SPIN_CAP (1u << 18)
__device__ __forceinline__ unsigned xb_ld(unsigned* p)              { return __hip_atomic_load(p, __ATOMIC_RELAXED, __HIP_MEMORY_SCOPE_AGENT); }
__device__ __forceinline__ unsigned xb_add(unsigned* p, unsigned v) { return __hip_atomic_fetch_add(p, v, __ATOMIC_RELAXED, __HIP_MEMORY_SCOPE_AGENT); }
__device__ __forceinline__ unsigned xb_xcc_id() { return (unsigned)__builtin_amdgcn_s_getreg((3 << 11) | 20) & 0xFu; }
#define XB_SPIN(cond, bar) do { unsigned _sp = 0; while (cond) { __builtin_amdgcn_s_sleep(1); \
    if ((++_sp & 255u) == 0u) { if (xb_ld(&(bar)[XB_TMO])) break; if (_sp > XB_SPIN_CAP) { atomicAdd(&(bar)[XB_TMO], 1u); break; } } } } while (0)
struct XcdBarrier { unsigned* bar; unsigned x; volatile LAS unsigned* st; };
__device__ __forceinline__ XcdBarrier xcd_barrier_post(unsigned* bar, volatile LAS unsigned* st) {
    XcdBarrier b; b.bar = bar; b.x = xb_xcc_id(); b.st = st;
    if (threadIdx.x == 0) (void)xb_add(&bar[XB_XCNT(b.x)], 1u);
    return b;
}
__device__ __forceinline__ void xcd_barrier_complete(unsigned* bar, unsigned x, unsigned& nloc, unsigned& nx) {
    const unsigned G = gridDim.x * gridDim.y * gridDim.z;
    unsigned sum, cnt, mine, sp = 0u;
    for (;;) {
        sum = 0u; cnt = 0u; mine = 0u;
#pragma unroll
        for (unsigned j = 0; j < 16; ++j) { const unsigned c = xb_ld(&bar[XB_XCNT(j)]); sum += c; cnt += (c > 0u) ? 1u : 0u; mine = (j == x) ? c : mine; }
        if (sum == G) break;
        __builtin_amdgcn_s_sleep(1);
        if ((++sp & 255u) == 0u) { if (xb_ld(&bar[XB_TMO])) break; if (sp > XB_SPIN_CAP) { atomicAdd(&bar[XB_TMO], 1u); break; } }
    }
    nloc = mine > 0u ? mine : 1u; nx = cnt > 0u ? cnt : 1u;
}
__device__ __forceinline__ void xcd_barrier(const XcdBarrier& b) {
    asm volatile("s_waitcnt vmcnt(0)" ::: "memory");
    __syncthreads();
    if (threadIdx.x == 0) {
        unsigned* bar = b.bar;
        __builtin_amdgcn_s_waitcnt(0);
        unsigned nloc = b.st[0], nx = b.st[1];
        if (nloc == 0u) { xcd_barrier_complete(bar, b.x, nloc, nx); b.st[0] = nloc; b.st[1] = nx; }
        const unsigned old = xb_add(&bar[XB_XSUB(b.x)], 1u);
        const unsigned gen = old / nloc;
        if (old + 1u == (gen + 1u) * nloc) {
            __builtin_amdgcn_fence(__ATOMIC_RELEASE, "agent");
            asm volatile("s_waitcnt vmcnt(0)" ::: "memory");
            const unsigned og = xb_add(&bar[XB_TOP], 1u);
            const unsigned tg = og / nx;
            if (og + 1u == (tg + 1u) * nx) xb_add(&bar[XB_TOPGEN], 1u);
            else XB_SPIN(xb_ld(&bar[XB_TOPGEN]) == tg, bar);
            __builtin_amdgcn_fence(__ATOMIC_ACQUIRE, "agent");
            xb_add(&bar[XB_XGEN(b.x)], 1u);
            asm volatile("s_waitcnt vmcnt(0)" ::: "memory");
        } else {
            XB_SPIN(xb_ld(&bar[XB_XGEN(b.x)]) == gen, bar);
            __builtin_amdgcn_fence(__ATOMIC_ACQUIRE, "agent");
            asm volatile("s_waitcnt vmcnt(0)" ::: "memory");
        }
    }
    __syncthreads();
}

struct Frame {
    LAS unsigned char* lds;
    volatile LAS unsigned* MISC;
    gu32* ctl;
    int tid, lane, wave;
    int vcu, G;
    unsigned char* ws; unsigned char* dout;
    const float* in[25];
};
constexpr size_t WS_TAB = 131072;
__device__ __forceinline__ const float* inp(const Frame& F, int i) {
    const unsigned long long v = ((const GAS unsigned long long*)(F.ws + WS_TAB))[i];
    const unsigned lo = __builtin_amdgcn_readfirstlane((unsigned)v), hi = __builtin_amdgcn_readfirstlane((unsigned)(v >> 32));
    return (const float*)(((unsigned long long)hi << 32) | lo);
}
#define INP(i) inp(F, (i))
__device__ __forceinline__ float wave_sum(float v) {
#pragma unroll
    for (int o = 1; o < 64; o <<= 1) v += __shfl_xor(v, o);
    return v;
}
__device__ __forceinline__ float wave_max(float v) {
#pragma unroll
    for (int o = 1; o < 64; o <<= 1) v = fmaxf(v, __shfl_xor(v, o));
    return v;
}
template <int CTRL> __device__ __forceinline__ float dpp_mov(float x) { return __builtin_bit_cast(float, __builtin_amdgcn_update_dpp(0, __builtin_bit_cast(int, x), CTRL, 0xf, 0xf, false)); }
__device__ __forceinline__ float red16(float x) { x += dpp_mov<0xB1>(x); x += dpp_mov<0x4E>(x); x += dpp_mov<0x124>(x); x += dpp_mov<0x128>(x); return x; }
__device__ __forceinline__ void p0_transpose_item(const float* W, int K, int N, bf16* WT, const float* kscale, LAS float* scr, int item, int lane) {
    const int nblk = N / 32, kb = item / nblk, nb = item % nblk, k0 = 64 * kb, n0 = 32 * nb;
#pragma unroll 8
    for (int i = 0; i < 32; ++i) { const int kk = 2 * i + (lane >> 5); const float s = kscale ? kscale[k0 + kk] : 1.f; scr[kk * 33 + (lane & 31)] = W[(size_t)(k0 + kk) * N + n0 + (lane & 31)] * s; }
    LDS_WAIT(); asm volatile("" ::: "memory");
    const int c = lane & 7;
#pragma unroll
    for (int j = 0; j < 4; ++j) { const int n = (lane >> 3) + 8 * j; const LAS float* s = scr + (8 * c) * 33 + n;
        v4u o; o.x = pk2(s[0 * 33], s[1 * 33]); o.y = pk2(s[2 * 33], s[3 * 33]); o.z = pk2(s[4 * 33], s[5 * 33]); o.w = pk2(s[6 * 33], s[7 * 33]);
        *(GAS v4u*)(WT + (size_t)(n0 + n) * K + k0 + 8 * c) = o; }
    LDS_WAIT(); asm volatile("" ::: "memory");
}
__device__ __forceinline__ void rms_row_to_bf16(const float* xrow, const float* g, bf16* orow, int lane) {
    const GAS f32x4* xr = (const GAS f32x4*)xrow + lane; const GAS f32x4* gr = (const GAS f32x4*)g + lane;
    f32x4 v[4]; float s = 0.f;
#pragma unroll
    for (int j = 0; j < 4; ++j) { v[j] = xr[64 * j]; s += (v[j].x * v[j].x + v[j].y * v[j].y) + (v[j].z * v[j].z + v[j].w * v[j].w); }
    const float rstd = 1.f / sqrtf(wave_sum(s) * (1.f / D) + NORM_EPS);
    GAS unsigned long long* o8 = (GAS unsigned long long*)orow + lane;
#pragma unroll
    for (int j = 0; j < 4; ++j) { const f32x4 gg = gr[64 * j]; o8[64 * j] = (unsigned long long)pk2(v[j].x * rstd * gg.x, v[j].y * rstd * gg.y) | ((unsigned long long)pk2(v[j].z * rstd * gg.z, v[j].w * rstd * gg.w) << 32); }
}
__device__ __forceinline__ void p0_prologue(Frame& F) {
    LAS float* scr = (LAS float*)(F.lds + RING_OFF + F.wave * 16384);
    const int gw = F.vcu * NWAVES + F.wave, NGW = F.G * NWAVES;
    constexpr int I_IN = (D / 64) * (NIN / 32), I_MIX = (D / 64) * (D / 32), I_KV = (D / 64) * (2 * D / 32), I_O = I_MIX, I_1 = (D / 64) * (FF / 32), I_2 = (FF / 64) * (D / 32);
    constexpr int I_LW = RW / 32, I_LG = 2 * (RW / 32);
    constexpr int NITEMS = I_IN + I_MIX + I_KV + I_O + I_1 + I_2 + 2 * I_LW + I_LG;
    for (int it = gw; it < NITEMS; it += NGW) {
        int r = it;
        if (r < I_IN) { p0_transpose_item(F.in[3], D, NIN, (bf16*)(F.ws + WS_WIN_T), nullptr, scr, r, F.lane); continue; } r -= I_IN;
        if (r < I_MIX) { p0_transpose_item(F.in[15], D, D, (bf16*)(F.ws + WS_WMIX_T), nullptr, scr, r, F.lane); continue; } r -= I_MIX;
        if (r < I_KV) { p0_transpose_item(F.in[19], D, 2 * D, (bf16*)(F.ws + WS_WXKV_T), nullptr, scr, r, F.lane); continue; } r -= I_KV;
        if (r < I_O) { p0_transpose_item(F.in[20], D, D, (bf16*)(F.ws + WS_WO_T), nullptr, scr, r, F.lane); continue; } r -= I_O;
        if (r < I_1) { p0_transpose_item(F.in[22], D, FF, (bf16*)(F.ws + WS_W1_T), F.in[21], scr, r, F.lane); continue; } r -= I_1;
        if (r < I_2) { p0_transpose_item(F.in[23], FF, D, (bf16*)(F.ws + WS_W2_T), nullptr, scr, r, F.lane); continue; } r -= I_2;
        if (r < I_LW) { p0_transpose_item(F.in[6], 64, RW, (bf16*)(F.ws + WS_LORA), nullptr, scr, r, F.lane); continue; } r -= I_LW;
        if (r < I_LW) { p0_transpose_item(F.in[8], 64, RW, (bf16*)(F.ws + WS_LORA) + RW * 64, nullptr, scr, r, F.lane); continue; } r -= I_LW;
        p0_transpose_item(F.in[9], 128, RW, (bf16*)(F.ws + WS_LORA) + 2 * RW * 64, nullptr, scr, r, F.lane);
    }
    { const float* wq = F.in[18]; const float* gx = F.in[16]; bf16* o = (bf16*)(F.ws + WS_WQ_S);
      for (int i = (F.vcu * 512 + F.tid); i < D * D / 4; i += F.G * 512) { const f32x4 v = ((const GAS f32x4*)wq)[i]; const float s = gx[(i * 4) / D];
          ((GAS unsigned long long*)o)[i] = (unsigned long long)pk2(v.x * s, v.y * s) | ((unsigned long long)pk2(v.z * s, v.w * s) << 32); } }
    for (int m = gw; m < M; m += NGW) rms_row_to_bf16(F.in[0] + (size_t)m * D, F.in[2], (bf16*)(F.ws + WS_XN) + (size_t)m * D, F.lane);
    for (int m = gw; m < MEMR; m += NGW) rms_row_to_bf16(F.in[1] + (size_t)m * D, F.in[17], (bf16*)(F.ws + WS_MEMN) + (size_t)m * D, F.lane);
}

__device__ __forceinline__ void kmean_simple(Frame& F) {
    const bf16* Z = (const bf16*)(F.ws + WS_Z); float* KM = (float*)(F.ws + WS_KMEAN);
    const int gw = F.vcu * NWAVES + F.wave, NGW = F.G * NWAVES;
    for (int u = gw; u < BATCH * NH * NBLK; u += NGW) { const int j = u % NBLK, bh = u / NBLK, b = bh / NH, h = bh % NH;
        const bf16* kp = Z + ((size_t)b * T + j * 256) * NIN + ZK + h * HD + F.lane; float s = 0.f;
        for (int i = 0; i < 256; ++i) s += bf2f(kp[(size_t)i * NIN]);
        KM[(size_t)u * HD + F.lane] = s * (1.f / 256.f); }
}
__device__ __forceinline__ void final_norm(Frame& F, const float pscale) {
    float* out = (float*)F.dout; const bf16* hb = (const bf16*)(F.ws + WS_HB); const float* ss = (const float*)(F.ws + WS_SS) + (size_t)2 * M * 16; const float* g = INP(24);
    const int gw = F.vcu * NWAVES + F.wave, NGW = F.G * NWAVES;
    for (int m = gw; m < M; m += NGW) { const float rstd = pg8::row_rstd(ss, (size_t)m) * pscale;
        GAS f32x4* o = (GAS f32x4*)(out + (size_t)m * D) + F.lane; const GAS f32x4* gr = (const GAS f32x4*)g + F.lane; const GAS unsigned long long* hr = (const GAS unsigned long long*)(hb + (size_t)m * D) + F.lane;
#pragma unroll
        for (int j = 0; j < 4; ++j) { const unsigned long long q = hr[64 * j]; const unsigned lo = (unsigned)q, hi = (unsigned)(q >> 32); const f32x4 gg = gr[64 * j];
            f32x4 v = (f32x4){bflo(lo), bfhi(lo), bflo(hi), bfhi(hi)}; v = v * rstd * gg; o[64 * j] = v; } }
}
namespace attn_body {
typedef unsigned short bf16;
using bf16x8=__attribute__((ext_vector_type(8)))short;
using s16x4=__attribute__((ext_vector_type(4)))short;
using f32x16=__attribute__((ext_vector_type(16)))float;
using u32x4=__attribute__((ext_vector_type(4)))unsigned;
constexpr int SEQ=8192,D=64,QP=3328,OP=1024;
constexpr int NW=8,QBLK=32,QB=QBLK*NW,KVBLK=64,NQB=SEQ/QB;
__device__ __forceinline__ int crow(int r,int hi){return (r&3)+8*(r>>2)+4*hi;}
#define SBAR() __builtin_amdgcn_sched_barrier(0)
__device__ __forceinline__ void cmask(f32x16&p0,f32x16&p1,int jb,int qrel,int hi){
  const float NEG=-INFINITY; int kb=64*jb+4*hi;
  #pragma unroll
  for(int r=0;r<16;++r){int kv=kb+(r&3)+8*(r>>2); if(kv>qrel)p0[r]=NEG; if(kv+32>qrel)p1[r]=NEG;}
}

constexpr int NSLOT=3, SLOTB=8192;
constexpr int LDS_K=0, LDS_V=NSLOT*SLOTB, LDS_WS=2*NSLOT*SLOTB, LDS_OST=LDS_WS+NW*64*4, LDS_BYTES=LDS_OST+NW*4096;
constexpr float C2=0.125f*1.4426950408889634f;
__device__ __forceinline__ void glds16(const void*gsrc,unsigned lds_dst){unsigned keep;
  asm volatile("s_mov_b32 %0, m0\n\ts_mov_b32 m0, %2\n\ts_nop 0\n\tglobal_load_lds_dwordx4 %1, off\n\ts_mov_b32 m0, %0":"=&s"(keep):"v"(gsrc),"s"(lds_dst):"memory");}
__device__ __forceinline__ float max3f(float a,float b,float c){float r;asm("v_max3_f32 %0, %1, %2, %3":"=v"(r):"v"(a),"v"(b),"v"(c));return r;}
__device__ __forceinline__ float max2f(float a,float b){float r;asm("v_max_f32_e32 %0, %1, %2":"=v"(r):"v"(a),"v"(b));return r;}
__device__ __forceinline__ float fadd_s(float a,float b){float r;asm("v_add_f32_e32 %0, %1, %2":"=v"(r):"v"(a),"v"(b));return r;}
__device__ __forceinline__ float fsub_s(float a,float b){float r;asm("v_sub_f32_e32 %0, %1, %2":"=v"(r):"v"(a),"v"(b));return r;}
typedef float f32x2_t __attribute__((ext_vector_type(2))); typedef __bf16 bf16x2_t __attribute__((ext_vector_type(2)));
__device__ __forceinline__ unsigned cvtpk_s(float lo,float hi){f32x2_t v={lo,hi};bf16x2_t b=__builtin_convertvector(v,bf16x2_t);return __builtin_bit_cast(unsigned,b);}
#define WAIT_BAR(N) asm volatile("s_waitcnt vmcnt(" #N ") lgkmcnt(0)\n\ts_barrier":::"memory")

__device__ __forceinline__ void qkt(f32x16&p0,f32x16&p1,const char*Kslot,const bf16x8*qr,const f32x16&negm,int r32,int hi){
  const char*kb=Kslot+hi*1024+r32*16;
  #pragma unroll
  for(int d0=0;d0<4;++d0){
    const bf16x8 b0=*reinterpret_cast<const bf16x8*>(kb+d0*2048);
    const bf16x8 b1=*reinterpret_cast<const bf16x8*>(kb+d0*2048+512);
    if(d0==0){p0=__builtin_amdgcn_mfma_f32_32x32x16_bf16(b0,qr[0],negm,0,0,0);p1=__builtin_amdgcn_mfma_f32_32x32x16_bf16(b1,qr[0],negm,0,0,0);}
    else{p0=__builtin_amdgcn_mfma_f32_32x32x16_bf16(b0,qr[d0],p0,0,0,0);p1=__builtin_amdgcn_mfma_f32_32x32x16_bf16(b1,qr[d0],p1,0,0,0);}}
}
typedef __attribute__((address_space(3))) const char* lds_cptr;
typedef short v4i16_t __attribute__((ext_vector_type(4)));
__device__ __forceinline__ void kload8(bf16x8*kf,lds_cptr kp){
  kf[0]=*(const __attribute__((address_space(3))) bf16x8*)(kp);      kf[1]=*(const __attribute__((address_space(3))) bf16x8*)(kp+512);
  kf[2]=*(const __attribute__((address_space(3))) bf16x8*)(kp+2048); kf[3]=*(const __attribute__((address_space(3))) bf16x8*)(kp+2560);
  kf[4]=*(const __attribute__((address_space(3))) bf16x8*)(kp+4096); kf[5]=*(const __attribute__((address_space(3))) bf16x8*)(kp+4608);
  kf[6]=*(const __attribute__((address_space(3))) bf16x8*)(kp+6144); kf[7]=*(const __attribute__((address_space(3))) bf16x8*)(kp+6656);
}
__device__ __forceinline__ void kload2(bf16x8*kf,lds_cptr kp,int j){ kf[2*j]=*(const __attribute__((address_space(3))) bf16x8*)(kp+j*2048); kf[2*j+1]=*(const __attribute__((address_space(3))) bf16x8*)(kp+j*2048+512); }
__device__ __forceinline__ s16x4 vtr(lds_cptr p){ return __builtin_bit_cast(s16x4,__builtin_amdgcn_ds_read_tr16_b64_v4i16((__attribute__((address_space(3))) v4i16_t*)p)); }
__device__ __forceinline__ float rowmax(const f32x16&p0,const f32x16&p1){
  float a=max3f(p0[0],p0[1],p1[0]),b=max3f(p0[2],p0[3],p1[1]);a=max3f(a,p1[2],p1[3]);
  #pragma unroll
  for(int r=4;r<16;r+=4){a=max3f(a,p0[r],p0[r+1]);b=max3f(b,p0[r+2],p0[r+3]);a=max3f(a,p1[r],p1[r+1]);b=max3f(b,p1[r+2],p1[r+3]);}
  const float m=max2f(a,b);
  auto rr=__builtin_amdgcn_permlane32_swap(__float_as_uint(m),__float_as_uint(m),false,false);
  return max2f(__uint_as_float(rr[0]),__uint_as_float(rr[1]));
}
__device__ __forceinline__ void pv(f32x16*o,int vb,bf16x8 pa0,bf16x8 pa1,bf16x8 pa2,bf16x8 pa3){
  #pragma unroll
  for(int d0=0;d0<2;++d0){s16x4 lo[4],hi[4];
    #pragma unroll
    for(int ks=0;ks<4;++ks){
      asm volatile("ds_read_b64_tr_b16 %0,%1 offset:%c2":"=&v"(lo[ks]):"v"(vb),"i"(d0*4096+ks*1024):"memory");
      asm volatile("ds_read_b64_tr_b16 %0,%1 offset:%c2":"=&v"(hi[ks]):"v"(vb),"i"(d0*4096+ks*1024+512):"memory");}
    asm volatile("s_waitcnt lgkmcnt(0)":::"memory");SBAR();
    #define PK(k) (bf16x8){lo[k][0],lo[k][1],lo[k][2],lo[k][3],hi[k][0],hi[k][1],hi[k][2],hi[k][3]}
    o[d0]=__builtin_amdgcn_mfma_f32_32x32x16_bf16(pa0,PK(0),o[d0],0,0,0);
    o[d0]=__builtin_amdgcn_mfma_f32_32x32x16_bf16(pa1,PK(1),o[d0],0,0,0);
    o[d0]=__builtin_amdgcn_mfma_f32_32x32x16_bf16(pa2,PK(2),o[d0],0,0,0);
    o[d0]=__builtin_amdgcn_mfma_f32_32x32x16_bf16(pa3,PK(3),o[d0],0,0,0);
    #undef PK
  }
}

#ifndef ATTN_STORE16
#define ATTN_STORE16(p,v) (*(u32x4*)(p)=(v))
#endif
template<int THRL> __device__ __forceinline__ void attn_unit(int b,int h,int qb,const bf16*Q,const bf16*__restrict__ K,const bf16*__restrict__ V,bf16*O,const float*__restrict__ KMbh,char*shm,const int wid,const int lane){
  const int r32=lane&31,hi=lane>>5;
  const long rowbase=(long)b*SEQ; const int q0=qb*QB;
  const bf16*Qw=Q+(rowbase+q0+wid*QBLK)*QP+h*D;
  const bf16*Kh=K+rowbase*QP+h*D,*Vh=V+rowbase*QP+h*D;
  unsigned selmask=0u;
  { f32x16 g=f32x16{}; bf16x8 qg[4];
    #pragma unroll
    for(int d0=0;d0<4;++d0)qg[d0]=*reinterpret_cast<const bf16x8*>(&Qw[(long)r32*QP+d0*16+hi*8]);
    #pragma unroll
    for(int d0=0;d0<4;++d0){ const float4 a0=*reinterpret_cast<const float4*>(KMbh+r32*64+d0*16+hi*8), a1=*reinterpret_cast<const float4*>(KMbh+r32*64+d0*16+hi*8+4);
      u32x4 pk; pk[0]=cvtpk_s(a0.x,a0.y); pk[1]=cvtpk_s(a0.z,a0.w); pk[2]=cvtpk_s(a1.x,a1.y); pk[3]=cvtpk_s(a1.z,a1.w);
      g=__builtin_amdgcn_mfma_f32_32x32x16_bf16(__builtin_bit_cast(bf16x8,pk),qg[d0],g,0,0,0); }
    #pragma unroll
    for(int r=0;r<16;++r){ if(crow(r,hi)>=qb) g[r]=-INFINITY; }
    #pragma unroll
    for(int n=0;n<3;++n){ float bv=-INFINITY; int bi=64;
      #pragma unroll
      for(int r=0;r<16;++r){ if(g[r]>bv){bv=g[r];bi=crow(r,hi);} }
      const float pv_=__shfl_xor(bv,32); const int pi_=__shfl_xor(bi,32);
      const bool mine=(bv>pv_)||(bv==pv_&&bi<pi_); const float wv=mine?bv:pv_; const int wi=mine?bi:pi_;
      if(wv>-INFINITY){ selmask|=1u<<wi;
        #pragma unroll
        for(int r=0;r<16;++r){ if(crow(r,hi)==wi) g[r]=-INFINITY; } } }
    selmask|=1u<<qb; }
  asm volatile("":"+v"(selmask)); SBAR();
  const unsigned lds0=(unsigned)(uintptr_t)shm;
  float*wsf=(float*)(shm+LDS_WS)+wid*64;
  const bf16*ksrc=Kh+(long)lane*QP+wid*8;
  const bf16*vsrc=Vh+(long)(16*(wid&3)+(lane>>2))*QP+(wid>>2)*32+(lane&3)*8;
  const unsigned kdst=lds0+LDS_K+wid*1024, vdst=lds0+LDS_V+wid*1024;
  #define DMA_K(t,slot) glds16(ksrc+(long)(t)*KVBLK*QP,(unsigned)__builtin_amdgcn_readfirstlane(kdst+(slot)))
  #define DMA_V(t,slot) glds16(vsrc+(long)(t)*KVBLK*QP,(unsigned)__builtin_amdgcn_readfirstlane(vdst+(slot)))
  const int vb0=(int)(lds0+LDS_V)+((lane>>4)&1)*32+(lane&3)*8+(4*hi+((lane&15)>>2))*64;
  const char*Kbase=shm+LDS_K; bf16x8 kf[8];
  const lds_cptr shm3=(lds_cptr)shm; const lds_cptr kp0=shm3+LDS_K+hi*1024+r32*16; const lds_cptr vp0=shm3+LDS_V+((lane>>4)&1)*32+(lane&3)*8+(4*hi+((lane&15)>>2))*64;
  const int NT=(q0+QB)/KVBLK;
  DMA_K(0,0);DMA_V(0,0);DMA_K(1,SLOTB);
  bf16x8 qr[4];
  #pragma unroll
  for(int d0=0;d0<4;++d0)qr[d0]=*reinterpret_cast<const bf16x8*>(&Qw[(long)r32*QP+d0*16+hi*8]);
  float nok=((selmask&1u)!=0u||qb==0)?0.f:-INFINITY;
  float mhat=0.f,l_reg=0.f;f32x16 o[2];o[0]=f32x16{};o[1]=f32x16{};f32x16 negm;
  _Pragma("unroll") for(int r=0;r<16;++r)negm[r]=nok; asm volatile("":"+v"(negm));
  const int qrel=wid*QBLK+r32;
  #define CMASK(P0,P1,t) do{int jb_=(t)-(NT-4); if(jb_>=0)cmask(P0,P1,jb_,qrel,hi);}while(0)
  bool resc=false;
  #define START(P0,P1) do{ const float rm=rowmax(P0,P1); resc=false; \
    { const float dl=(rm==-INFINITY)?0.f:rm; mhat=fadd_s(mhat,dl); \
      _Pragma("unroll") for(int r=0;r<16;++r){P0[r]=fsub_s(P0[r],dl);P1[r]=fsub_s(P1[r],dl);} \
      { const float cv_=nok-mhat; _Pragma("unroll") for(int r=0;r<16;++r)negm[r]=cv_; } asm volatile("":"+v"(negm)); } \
    _Pragma("unroll") for(int r=0;r<16;++r)P0[r]=__builtin_amdgcn_exp2f(P0[r]); }while(0)
  #define RESC() do{ if(resc){ asm volatile("s_waitcnt lgkmcnt(0)":::"memory"); \
      _Pragma("unroll") for(int d_=0;d_<2;++d_) _Pragma("unroll") for(int r=0;r<16;++r)o[d_][r]*=wsf[crow(r,hi)]; } }while(0)
  f32x16 pA0,pA1,pB0,pB1;
  int sl_prev=0,sl_cur=0,sl_next=SLOTB;
  #define ROT() do{sl_prev=sl_cur;sl_cur=sl_next;sl_next=(sl_next==(NSLOT-1)*SLOTB)?0:sl_next+SLOTB;}while(0)
  DMA_K(2,2*SLOTB);
  WAIT_BAR(3);
  qkt(pA0,pA1,Kbase,qr,negm,r32,hi);asm volatile("s_nop 15\n\ts_nop 7":"+v"(pA0),"+v"(pA1));CMASK(pA0,pA1,0);
  START(pA0,pA1);
  _Pragma("unroll") for(int r=0;r<16;++r)pA1[r]=__builtin_amdgcn_exp2f(pA1[r]);
  WAIT_BAR(0);
  DMA_K(3,0);DMA_V(1,SLOTB);
  ROT();
  kload8(kf,kp0+sl_cur);
  WAIT_BAR(2);
  s16x4 vlo[8],vhi[8]; u32x4 pw0,pw1,pw2,pw3;
  #define PKW(P,B) cvtpk_s(P[B],P[B+1])
  #define PAF(k) __builtin_bit_cast(bf16x8,pw##k)
  #define VFR(i) (bf16x8){vlo[i][0],vlo[i][1],vlo[i][2],vlo[i][3],vhi[i][0],vhi[i][1],vhi[i][2],vhi[i][3]}
  #define PIN(x) asm volatile("":"+v"(x))
  #define MX3(a,b,c) __builtin_fmaxf(__builtin_fmaxf((a),(b)),(c))
  #define GAPA(MF,A0,A1,A2,A3,W0,W1,PW) do{ MF; sacc+=A0; sacc+=A1; sacc+=A2; sacc+=A3; PIN(sacc); W0; W1; PIN(PW); SBAR(); }while(0)
  #define EX(v) __builtin_amdgcn_exp2f(v)
  #define GAPB(MF,X,B) do{ MF; X[B]=EX(X[B]); X[B+1]=EX(X[B+1]); X[B+2]=EX(X[B+2]); X[B+3]=EX(X[B+3]); PIN(X); SBAR(); }while(0)
  #define VRD(i) do{ vlo[i]=vtr(vp_+(((i)>>2)*4096+((i)&3)*1024)); vhi[i]=vtr(vp_+(((i)>>2)*4096+((i)&3)*1024+512)); }while(0)
  #define KRD(G,j) do{ if(G){ kload2(kf,kp0+sl_next,j); SBAR(); } }while(0)
  #define STEP(C0,C1,P0,P1,t,GK,GV,GL) do{ SBAR(); \
    const lds_cptr vp_=vp0+sl_prev; \
    VRD(0); SBAR(); float sacc=(P0[0]+P0[1]); \
    GAPA(C0=__builtin_amdgcn_mfma_f32_32x32x16_bf16(kf[0],qr[0],negm,0,0,0), P0[2],P0[3],P0[4],P0[5],     pw0[0]=PKW(P0,0), pw0[1]=PKW(P0,2), pw0); \
    VRD(4); SBAR(); GAPA(C1=__builtin_amdgcn_mfma_f32_32x32x16_bf16(kf[1],qr[0],negm,0,0,0), P0[6],P0[7],P0[8],P0[9],     pw0[2]=PKW(P0,4), pw0[3]=PKW(P0,6), pw0); \
    VRD(1); SBAR(); GAPA(C0=__builtin_amdgcn_mfma_f32_32x32x16_bf16(kf[2],qr[1],C0,0,0,0),   P0[10],P0[11],P0[12],P0[13], pw1[0]=PKW(P0,8), pw1[1]=PKW(P0,10), pw1); \
    VRD(5); SBAR(); GAPA(C1=__builtin_amdgcn_mfma_f32_32x32x16_bf16(kf[3],qr[1],C1,0,0,0),   P0[14],P0[15],P1[0],P1[1],   pw1[2]=PKW(P0,12),pw1[3]=PKW(P0,14), pw1); \
    VRD(2); SBAR(); GAPA(C0=__builtin_amdgcn_mfma_f32_32x32x16_bf16(kf[4],qr[2],C0,0,0,0),   P1[2],P1[3],P1[4],P1[5],     pw2[0]=PKW(P1,0), pw2[1]=PKW(P1,2), pw2); \
    VRD(6); SBAR(); GAPA(C1=__builtin_amdgcn_mfma_f32_32x32x16_bf16(kf[5],qr[2],C1,0,0,0),   P1[6],P1[7],P1[8],P1[9],     pw2[2]=PKW(P1,4), pw2[3]=PKW(P1,6), pw2); \
    VRD(3); SBAR(); GAPA(C0=__builtin_amdgcn_mfma_f32_32x32x16_bf16(kf[6],qr[3],C0,0,0,0),   P1[10],P1[11],P1[12],P1[13], pw3[0]=PKW(P1,8), pw3[1]=PKW(P1,10), pw3); \
    VRD(7); SBAR(); GAPA(C1=__builtin_amdgcn_mfma_f32_32x32x16_bf16(kf[7],qr[3],C1,0,0,0),   P1[14],P1[15],0.f,0.f,       pw3[2]=PKW(P1,12),pw3[3]=PKW(P1,14), pw3); \
    l_reg+=sacc; \
    if(GK){DMA_K((t)+3,sl_cur);} if(GV){DMA_V((t)+1,sl_next);} \
    CMASK(C0,C1,t); \
    { float a=MX3(C0[0],C0[1],C1[0]),b=MX3(C0[2],C0[3],C1[1]); a=MX3(a,C1[2],C1[3]); \
      _Pragma("unroll") for(int r=4;r<16;r+=4){a=MX3(a,C0[r],C0[r+1]);b=MX3(b,C0[r+2],C0[r+3]);a=MX3(a,C1[r],C1[r+1]);b=MX3(b,C1[r+2],C1[r+3]);} \
      float rm=__builtin_fmaxf(a,b); { auto rr=__builtin_amdgcn_permlane32_swap(__float_as_uint(rm),__float_as_uint(rm),false,false); rm=__builtin_fmaxf(__uint_as_float(rr[0]),__uint_as_float(rr[1])); } \
      resc=false; \
      if(__builtin_expect(__any(rm>(float)THRL),0)){ const float dl=__builtin_fmaxf(rm,0.f); mhat+=dl; \
        _Pragma("unroll") for(int r=0;r<16;++r){C0[r]-=dl;C1[r]-=dl;} \
        { const float cv_=nok-mhat; _Pragma("unroll") for(int r=0;r<16;++r)negm[r]=cv_; } asm volatile("":"+v"(negm)); \
        const float f=__builtin_amdgcn_exp2f(-dl); l_reg*=f; if(hi==0)wsf[r32]=f; resc=true; } } \
    SBAR(); \
    GAPB(o[0]=__builtin_amdgcn_mfma_f32_32x32x16_bf16(PAF(0),VFR(0),o[0],0,0,0), C0,0); \
    GAPB(o[1]=__builtin_amdgcn_mfma_f32_32x32x16_bf16(PAF(0),VFR(4),o[1],0,0,0), C0,4); \
    KRD(GL,0); GAPB(o[0]=__builtin_amdgcn_mfma_f32_32x32x16_bf16(PAF(1),VFR(1),o[0],0,0,0), C0,8); \
    KRD(GL,1); GAPB(o[1]=__builtin_amdgcn_mfma_f32_32x32x16_bf16(PAF(1),VFR(5),o[1],0,0,0), C0,12); \
    KRD(GL,2); GAPB(o[0]=__builtin_amdgcn_mfma_f32_32x32x16_bf16(PAF(2),VFR(2),o[0],0,0,0), C1,0); \
    KRD(GL,3); GAPB(o[1]=__builtin_amdgcn_mfma_f32_32x32x16_bf16(PAF(2),VFR(6),o[1],0,0,0), C1,4); \
    GAPB(o[0]=__builtin_amdgcn_mfma_f32_32x32x16_bf16(PAF(3),VFR(3),o[0],0,0,0), C1,8); \
    GAPB(o[1]=__builtin_amdgcn_mfma_f32_32x32x16_bf16(PAF(3),VFR(7),o[1],0,0,0), C1,12); \
    }while(0)
  #define MASKUPD(tt) do{ if((((tt))&3)==0){ nok=((selmask>>((tt)>>2))&1u)?0.f:-INFINITY; const float cv_=nok-mhat; _Pragma("unroll") for(int r=0;r<16;++r)negm[r]=cv_; asm volatile("":"+v"(negm)); } }while(0)
  int t=1;
  #undef CMASK
  #define CMASK(P0,P1,t) do{}while(0)
  for(;t+5<NT;t+=2){
    STEP(pB0,pB1,pA0,pA1,t,true,true,true);     WAIT_BAR(2); RESC(); ROT(); MASKUPD(t+1);
    STEP(pA0,pA1,pB0,pB1,t+1,true,true,true);   WAIT_BAR(2); RESC(); ROT();
  }
  #undef CMASK
  #define CMASK(P0,P1,t) do{int jb_=(t)-(NT-4); if(jb_>=0)cmask(P0,P1,jb_,qrel,hi);}while(0)
  #define ENDW(tt) do{ if((tt)+3<NT){WAIT_BAR(2);} else if((tt)+2<NT){WAIT_BAR(1);} else {WAIT_BAR(0);} }while(0)
  for(;t+1<NT;t+=2){
    STEP(pB0,pB1,pA0,pA1,t,(t+3<NT),(t+1<NT),(t+1<NT));       ENDW(t);   RESC(); ROT(); MASKUPD(t+1);
    STEP(pA0,pA1,pB0,pB1,t+1,(t+4<NT),(t+2<NT),(t+2<NT));     ENDW(t+1); RESC(); ROT();
  }
  STEP(pB0,pB1,pA0,pA1,NT-1,false,false,false); RESC();
  { float sacc=pB0[0]+pB0[1]; _Pragma("unroll") for(int r=2;r<16;++r)sacc+=pB0[r]; _Pragma("unroll") for(int r=0;r<16;++r)sacc+=pB1[r]; l_reg+=sacc;
    pw0=(u32x4){PKW(pB0,0),PKW(pB0,2),PKW(pB0,4),PKW(pB0,6)};pw1=(u32x4){PKW(pB0,8),PKW(pB0,10),PKW(pB0,12),PKW(pB0,14)};pw2=(u32x4){PKW(pB1,0),PKW(pB1,2),PKW(pB1,4),PKW(pB1,6)};pw3=(u32x4){PKW(pB1,8),PKW(pB1,10),PKW(pB1,12),PKW(pB1,14)};
    SBAR(); pv(o,vb0+sl_cur,PAF(0),PAF(1),PAF(2),PAF(3)); }
  #undef PKW
  #undef PAF
  #undef VFR
  #undef PIN
  #undef MX3
  #undef GAPA
  #undef GAPB
  #undef EX
  #undef VRD
  #undef KRD
  #undef STEP
  #undef ENDW
  #undef MASKUPD
  {auto rr=__builtin_amdgcn_permlane32_swap(__float_as_uint(l_reg),__float_as_uint(l_reg),false,false);l_reg=__uint_as_float(rr[0])+__uint_as_float(rr[1]);}
  if(hi==0)wsf[32+r32]=l_reg;asm volatile("s_waitcnt lgkmcnt(0)":::"memory");
  float rli[16];
  #pragma unroll
  for(int r=0;r<16;++r)rli[r]=__builtin_amdgcn_rcpf(wsf[32+crow(r,hi)]);
  bf16*Ow=O+(rowbase+q0+wid*QBLK)*OP+h*D;
  { bf16*stg=(bf16*)(shm+LDS_OST)+wid*2048;
    #pragma unroll
    for(int r=0;r<16;++r){const int orow=crow(r,hi);
      #pragma unroll
      for(int d0=0;d0<2;++d0)stg[orow*64+d0*32+r32]=(bf16)(cvtpk_s(o[d0][r]*rli[r],0.f)&0xffffu);}
    asm volatile("s_waitcnt lgkmcnt(0)":::"memory");
    #pragma unroll
    for(int i=0;i<4;++i){const int row=i*8+(lane>>3),ch=lane&7; const u32x4 v=*(const u32x4*)(stg+row*64+ch*8); ATTN_STORE16(Ow+(long)row*OP+ch*8,v);} }
  asm volatile("s_waitcnt lgkmcnt(0)\n\ts_barrier":::"memory");
  #undef DMA_K
  #undef DMA_V
  #undef CMASK
  #undef START
  #undef RESC
  #undef ROT
}
constexpr int ATTN_LDS_BYTES=LDS_BYTES;
#undef SBAR
#undef WAIT_BAR
}
namespace rscan {
typedef short bf16x8 __attribute__((ext_vector_type(8)));
typedef float f32x4 __attribute__((ext_vector_type(4)));
typedef float f32x16 __attribute__((ext_vector_type(16)));
typedef unsigned u32x2 __attribute__((ext_vector_type(2)));
typedef unsigned u32x4 __attribute__((ext_vector_type(4)));
constexpr int LB = 8192;
__device__ __forceinline__ int t64(int row, int chunk) { return row * 128 + ((chunk ^ ((row >> 1) & 7)) << 4); }
__device__ __forceinline__ int t128(int row, int chunk) { return row * 256 + ((chunk ^ (row & 15)) << 4); }
constexpr int NCHUNK = T / 64;
__device__ __forceinline__ unsigned pkbf(float lo, float hi) { typedef float f2 __attribute__((ext_vector_type(2))); typedef __bf16 b2 __attribute__((ext_vector_type(2))); f2 v = {lo, hi}; return __builtin_bit_cast(unsigned, __builtin_convertvector(v, b2)); }

__device__ __forceinline__ void mm(f32x4 (&acc)[2], LAS unsigned char* lds, int z1, int z2, int ta, int tbh, int fr, int fq) {
    const int o1 = z1 + t64(16 * ta + fr, fq), o2 = z2 + t64(32 * tbh + fr, fq);
    const bf16x8 a0 = *(const LAS bf16x8*)(lds + o1), a1 = *(const LAS bf16x8*)(lds + (o1 ^ 64));
    const bf16x8 b00 = *(const LAS bf16x8*)(lds + o2), b01 = *(const LAS bf16x8*)(lds + (o2 ^ 64)), b10 = *(const LAS bf16x8*)(lds + o2 + 2048), b11 = *(const LAS bf16x8*)(lds + ((o2 ^ 64) + 2048));
    acc[0] = __builtin_amdgcn_mfma_f32_16x16x32_bf16(a0, b00, acc[0], 0, 0, 0); acc[0] = __builtin_amdgcn_mfma_f32_16x16x32_bf16(a1, b01, acc[0], 0, 0, 0);
    acc[1] = __builtin_amdgcn_mfma_f32_16x16x32_bf16(a0, b10, acc[1], 0, 0, 0); acc[1] = __builtin_amdgcn_mfma_f32_16x16x32_bf16(a1, b11, acc[1], 0, 0, 0);
}
struct Fr { bf16x8 a0, a1, b00, b01, b10, b11; };
__device__ __forceinline__ void ldf(Fr& f, LAS unsigned char* lds, int z1, int z2, int ta, int tbh, int fr, int fq) {
    const int o1 = z1 + t64(16 * ta + fr, fq), o2 = z2 + t64(32 * tbh + fr, fq);
    f.a0 = *(const LAS bf16x8*)(lds + o1); f.a1 = *(const LAS bf16x8*)(lds + (o1 ^ 64));
    f.b00 = *(const LAS bf16x8*)(lds + o2); f.b01 = *(const LAS bf16x8*)(lds + (o2 ^ 64)); f.b10 = *(const LAS bf16x8*)(lds + o2 + 2048); f.b11 = *(const LAS bf16x8*)(lds + ((o2 ^ 64) + 2048));
}
__device__ __forceinline__ void mcf(f32x4 (&acc)[2], const Fr& f) {
    acc[0] = __builtin_amdgcn_mfma_f32_16x16x32_bf16(f.a0, f.b00, acc[0], 0, 0, 0); acc[1] = __builtin_amdgcn_mfma_f32_16x16x32_bf16(f.a0, f.b10, acc[1], 0, 0, 0);
    acc[0] = __builtin_amdgcn_mfma_f32_16x16x32_bf16(f.a1, f.b01, acc[0], 0, 0, 0); acc[1] = __builtin_amdgcn_mfma_f32_16x16x32_bf16(f.a1, f.b11, acc[1], 0, 0, 0);
}
template <int MASK, bool DIAG1> __device__ __forceinline__ void st_lds(const f32x4 (&acc)[2], LAS unsigned char* lds, int dst, int ta, int tbh, int fr, int fq) {
#pragma unroll
    for (int tb = 0; tb < 2; ++tb) { const int b = 32 * tbh + 16 * tb + fr, a0 = 16 * ta + 4 * fq; float v[4];
#pragma unroll
        for (int i = 0; i < 4; ++i) { const int a = a0 + i; float x = acc[tb][i];
            if (MASK == 1) x = (a < b) ? x : 0.f; if (MASK == 2) x = (a <= b) ? x : 0.f; if (MASK == 3) x = (b < a) ? x : 0.f; if (DIAG1) x = (a == b) ? 1.f : x; v[i] = x; }
        u32x2 w; w.x = pkbf(v[0], v[1]); w.y = pkbf(v[2], v[3]); *(LAS u32x2*)(lds + dst + t64(b, a0 >> 3) + (a0 & 4) * 2) = w; }
}
template <bool PERM> __device__ __forceinline__ void st_glb(const f32x4 (&acc)[2], bf16* g, int ta, int tbh, int fr, int fq) {
#pragma unroll
    for (int tb = 0; tb < 2; ++tb) { const int b = 32 * tbh + 16 * tb + fr; int a0 = 16 * ta + 4 * fq; if (PERM) a0 = (a0 & ~12) | ((a0 & 4) << 1) | ((a0 & 8) >> 1);
        u32x2 w; w.x = pkbf(acc[tb][0], acc[tb][1]); w.y = pkbf(acc[tb][2], acc[tb][3]); *(GAS u32x2*)(g + (size_t)b * RW + a0) = w; }
}

__device__ __forceinline__ float wsum_fast(float x) { x = red16(x);
    x += __builtin_bit_cast(float, __builtin_amdgcn_update_dpp(0, __builtin_bit_cast(int, x), 0x142, 0xa, 0xf, false));
    x += __builtin_bit_cast(float, __builtin_amdgcn_update_dpp(0, __builtin_bit_cast(int, x), 0x143, 0xc, 0xf, false));
    return __builtin_bit_cast(float, __builtin_amdgcn_readlane(__builtin_bit_cast(int, x), 63)); }
constexpr int LS2 = 272;
__device__ __forceinline__ void mm128(f32x4 (&acc)[2], LAS unsigned char* lds, int z1, int z2, int ta, int tbh, int fr, int fq) {
#pragma unroll
    for (int s = 0; s < 4; ++s) { const bf16x8 a = *(const LAS bf16x8*)(lds + z1 + t128(16 * ta + fr, 4 * s + fq)), b0 = *(const LAS bf16x8*)(lds + z2 + t128(32 * tbh + fr, 4 * s + fq)), b1 = *(const LAS bf16x8*)(lds + z2 + t128(32 * tbh + 16 + fr, 4 * s + fq));
        acc[0] = __builtin_amdgcn_mfma_f32_16x16x32_bf16(a, b0, acc[0], 0, 0, 0); acc[1] = __builtin_amdgcn_mfma_f32_16x16x32_bf16(a, b1, acc[1], 0, 0, 0); }
}
__device__ __forceinline__ void st_lds_f32(const f32x4 (&acc)[2], LAS unsigned char* lds, int dst, int ta, int tbh, int fr, int fq) {
#pragma unroll
    for (int tb = 0; tb < 2; ++tb) { const int b = 32 * tbh + 16 * tb + fr, a0 = 16 * ta + 4 * fq; *(LAS f32x4*)(lds + dst + b * LS2 + a0 * 4) = acc[tb]; }
}

__device__ __forceinline__ void scan_pre(Frame& F) {
    LAS unsigned char* lds = F.lds + RING_OFF;
    const int w = F.wave, lane = F.lane, fr = lane & 15, fq = lane >> 4, ta = w & 3, tbh = w >> 2;
    const bf16* Z = (const bf16*)(F.ws + WS_Z); const float* mu = INP(4);
    const bf16* WupT = (const bf16*)(F.ws + WS_LORA); const bf16* AupT = WupT + RW * 64; const bf16* GupT = AupT + RW * 64;
    bf16* aLW = (bf16*)(F.dout + DO_W); bf16* aKP = (bf16*)(F.dout + DO_KP); bf16* aKK = (bf16*)(F.dout + DO_KKN); bf16* aB = (bf16*)(F.dout + DO_B);
    bf16* oG = (bf16*)(F.ws + WS_GATE); float* oBon = (float*)(F.ws + WS_BON);
    enum { bAt = 0, bBt = LB, bKt = 2 * LB, bRt = 3 * LB, bAtT = 4 * LB, bVT = 5 * LB, bBhT = 6 * LB, bKhT = 7 * LB, b8 = 8 * LB, b9 = 9 * LB, b10 = 10 * LB, bAak = 11 * LB, bArb = 12 * LB, bArk = 13 * LB };
    enum { lXw = 0, lXa = LB, lXg = 2 * LB, lWw = 4 * LB, lWa = 5 * LB, lWg = 6 * LB, lDw = 8 * LB, lDa = lDw + 64 * LS2, lDg = lDa + 64 * LS2, lSum = lDg + 64 * LS2 };
    static_assert(lWg + 2 * LB <= 8 * LB && lSum + 2048 <= RING_BYTES, "LoRA stage LDS carve");
#ifdef PROBE_SEG
    unsigned long long sg_[8] = {0, 0, 0, 0, 0, 0, 0, 0}, sgt_;
#define SEG0() sgt_ = __builtin_amdgcn_s_memrealtime()
#define SEG(j) do { const unsigned long long n_ = __builtin_amdgcn_s_memrealtime(); sg_[j] += n_ - sgt_; sgt_ = n_; } while (0)
#else
#define SEG0() do {} while (0)
#define SEG(j) do {} while (0)
#endif
    u32x4 cur[4], prv[4]; unsigned short zr_[9], zk_[9], zv_[9];
#define PF_ISSUE(uu) do { const int c_ = (uu) % NCHUNK, bh_ = (uu) / NCHUNK, b_ = bh_ / NH, h_ = bh_ % NH; const size_t m0_ = (size_t)b_ * T + (size_t)c_ * 64; \
        { const int t_ = F.tid >> 3, g0_ = F.tid & 7; const bf16* zrow = Z + (m0_ + t_) * NIN + ZWD; const bool firstrow = (c_ == 0 && t_ == 0); \
          _Pragma("unroll") for (int i = 0; i < 4; ++i) { cur[i] = *(const GAS u32x4*)(zrow + 8 * (g0_ + 8 * i)); prv[i] = (u32x4){0u, 0u, 0u, 0u}; if (!firstrow) prv[i] = *(const GAS u32x4*)(zrow - (long)NIN + 8 * (g0_ + 8 * i)); } } \
        { const bf16* zr = Z + (m0_ + 8 * w) * NIN + h_ * HD + lane; const bool first = (c_ == 0 && w == 0); \
          zr_[0] = 0; zk_[0] = 0; zv_[0] = 0; if (!first) { zr_[0] = zr[-(long)NIN]; zk_[0] = zr[-(long)NIN + ZK_R]; zv_[0] = zr[-(long)NIN + ZV_R]; } \
          _Pragma("unroll") for (int i = 0; i < 8; ++i) { zr_[i + 1] = zr[(size_t)i * NIN]; zk_[i + 1] = zr[(size_t)i * NIN + ZK_R]; zv_[i + 1] = zr[(size_t)i * NIN + ZV_R]; } } } while (0)
    if (F.vcu < BATCH * NH * NCHUNK) PF_ISSUE(F.vcu);
    for (int u = F.vcu; u < BATCH * NH * NCHUNK; u += F.G) {
        SEG0();
        const int c = u % NCHUNK, bh = u / NCHUNK, b = bh / NH, h = bh % NH;
        const size_t m0 = (size_t)b * T + (size_t)c * 64;
        const size_t so = m0 * RW + h * HD;
        { const int t = F.tid >> 3, g0 = F.tid & 7;
          { const int row = F.tid >> 3, ch = F.tid & 7;
            *(LAS u32x4*)(lds + lWw + t64(row, ch)) = *(const GAS u32x4*)(WupT + (size_t)(h * HD + row) * 64 + ch * 8);
            *(LAS u32x4*)(lds + lWa + t64(row, ch)) = *(const GAS u32x4*)(AupT + (size_t)(h * HD + row) * 64 + ch * 8); }
#pragma unroll
          for (int i = 0; i < 2; ++i) { const int pp = F.tid + 512 * i, row = pp >> 4, ch = pp & 15; *(LAS u32x4*)(lds + lWg + t128(row, ch)) = *(const GAS u32x4*)(GupT + (size_t)(h * HD + row) * 128 + ch * 8); }
#pragma unroll
          for (int i = 0; i < 4; ++i) { const int col0 = 8 * (g0 + 8 * i); const f32x4 ma = *(const GAS f32x4*)(mu + ZWD + col0), mb = *(const GAS f32x4*)(mu + ZWD + col0 + 4);
              float z[8];
#pragma unroll
              for (int q = 0; q < 4; ++q) { const unsigned cw = cur[i][q], pw = prv[i][q]; const float c0 = bflo(cw), c1 = bfhi(cw), p0 = bflo(pw), p1 = bfhi(pw);
                  const float m0_ = q < 2 ? ma[2 * q] : mb[2 * q - 4], m1_ = q < 2 ? ma[2 * q + 1] : mb[2 * q - 3];
                  z[2 * q] = c0 + (p0 - c0) * m0_; z[2 * q + 1] = c1 + (p1 - c1) * m1_; }
#pragma unroll
              for (int q = 0; q < 8; ++q) { if (i == 0) z[q] = 1.f - 2.f * __builtin_amdgcn_rcpf(1.f + __expf(2.f * z[q])); else if (i >= 2) z[q] = __builtin_amdgcn_rcpf(1.f + __expf(-z[q])); }
              u32x4 o; o.x = pkbf(z[0], z[1]); o.y = pkbf(z[2], z[3]); o.z = pkbf(z[4], z[5]); o.w = pkbf(z[6], z[7]);
              const int dst = i == 0 ? lXw + t64(t, g0) : (i == 1 ? lXa + t64(t, g0) : lXg + t128(t, (i - 2) * 8 + g0));
              *(LAS u32x4*)(lds + dst) = o; }
        }
        __syncthreads(); SEG(0);
        { f32x4 acc[2];
          acc[0] = (f32x4){0.f, 0.f, 0.f, 0.f}; acc[1] = acc[0]; mm(acc, lds, lWw, lXw, ta, tbh, fr, fq); st_lds_f32(acc, lds, lDw, ta, tbh, fr, fq);
          acc[0] = (f32x4){0.f, 0.f, 0.f, 0.f}; acc[1] = acc[0]; mm(acc, lds, lWa, lXa, ta, tbh, fr, fq); st_lds_f32(acc, lds, lDa, ta, tbh, fr, fq);
          acc[0] = (f32x4){0.f, 0.f, 0.f, 0.f}; acc[1] = acc[0]; mm128(acc, lds, lWg, lXg, ta, tbh, fr, fq); st_lds_f32(acc, lds, lDg, ta, tbh, fr, fq); }
        __syncthreads(); SEG(1);
        { const int cg = h * HD + lane;
          const float w0_ = INP(5)[cg], a0_ = INP(7)[cg], kkc = INP(10)[cg], kac = INP(11)[cg], rkc = INP(12)[cg], mur = mu[cg], muk = mu[ZK_R + cg], muv = mu[ZV_R + cg];
          float lwv[8], e_at[8], e_bb[8], e_kp[8], e_r[8], e_v[8]; float lsum = 0.f;
#pragma unroll
          for (int i = 0; i < 8; ++i) { const int t = 8 * w + i;
              const float cr = bf2f(zr_[i + 1]), ck = bf2f(zk_[i + 1]), cv = bf2f(zv_[i + 1]), pr = bf2f(zr_[i]), pk = bf2f(zk_[i]), pv = bf2f(zv_[i]);
              const float r = cr + (pr - cr) * mur, kx = ck + (pk - ck) * muk, v = cv + (pv - cv) * muv;
              const float dw = w0_ + *(const LAS float*)(lds + lDw + t * LS2 + lane * 4), da = a0_ + *(const LAS float*)(lds + lDa + t * LS2 + lane * 4), gg = *(const LAS float*)(lds + lDg + t * LS2 + lane * 4);
              const float lw = -DECAY_SCALE * __builtin_amdgcn_rcpf(1.f + __expf(-dw)), a = __builtin_amdgcn_rcpf(1.f + __expf(-da));
              const float kk = kx * kkc; const float nn = wsum_fast(kk * kk); const float kkn = kk * __builtin_amdgcn_rsqf(fmaxf(nn, 1e-24f));
              const float kp = kx * (1.f + (a - 1.f) * kac), bb = kkn * a; const float bon = wsum_fast(r * kp * rkc);
              oG[(m0 + t) * RW + cg] = (bf16)f2bf(gg); if (lane == 0) oBon[(m0 + t) * NH + h] = bon;
              lwv[i] = lw; lsum += lw; e_at[i] = -kkn; e_bb[i] = bb; e_kp[i] = kp; e_r[i] = r; e_v[i] = v; }
          *(LAS float*)(lds + lSum + (w * 64 + lane) * 4) = lsum;
          __syncthreads(); SEG(2);
          if (u + F.G < BATCH * NH * NCHUNK) PF_ISSUE(u + F.G);
          float ltot = 0.f, lst = 0.f;
#pragma unroll
          for (int q = 0; q < 8; ++q) { const float sq = *(const LAS float*)(lds + lSum + (q * 64 + lane) * 4); if (q < w) lst += sq; ltot += sq; }
          float L = lst; unsigned short pAtT[8], pVT[8], pBhT[8], pKhT[8];
#pragma unroll
          for (int i = 0; i < 8; ++i) { const int t = 8 * w + i;
              const float Pm = __expf(L); L += lwv[i]; const float P = __expf(L), iP = __expf(-L), Ph = __expf(ltot - L);
              const unsigned short at = (unsigned short)f2bf(e_at[i] * Pm);
              const int eo = t64(t, lane >> 3) + (lane & 7) * 2;
              *(LAS unsigned short*)(lds + bAt + eo) = at; *(LAS unsigned short*)(lds + bBt + eo) = (unsigned short)f2bf(e_bb[i] * iP);
              *(LAS unsigned short*)(lds + bKt + eo) = (unsigned short)f2bf(e_kp[i] * iP); *(LAS unsigned short*)(lds + bRt + eo) = (unsigned short)f2bf(e_r[i] * P);
              pAtT[i] = at; pVT[i] = (unsigned short)f2bf(e_v[i]); pBhT[i] = (unsigned short)f2bf(e_bb[i] * Ph); pKhT[i] = (unsigned short)f2bf(e_kp[i] * Ph); }
#define RS_W16(buf, p) do { u32x4 q_; q_.x = p[0] | ((unsigned)p[1] << 16); q_.y = p[2] | ((unsigned)p[3] << 16); q_.z = p[4] | ((unsigned)p[5] << 16); q_.w = p[6] | ((unsigned)p[7] << 16); *(LAS u32x4*)(lds + (buf) + t64(lane, w)) = q_; } while (0)
          RS_W16(bAtT, pAtT); RS_W16(bVT, pVT); RS_W16(bBhT, pBhT); RS_W16(bKhT, pKhT);
#undef RS_W16
          asm volatile("" :: "v"(ltot));
          __syncthreads(); SEG(3);
          f32x4 acc[2], acc2[2], acc3[2], acc4[2], tacc[2];
#define RS_Z(a) do { a[0] = (f32x4){0.f, 0.f, 0.f, 0.f}; a[1] = (f32x4){0.f, 0.f, 0.f, 0.f}; } while (0)
#define LD(f, z1, z2) ldf(f, lds, z1, z2, ta, tbh, fr, fq)
#define ST(m, a, dst) st_lds<m, false>(a, lds, dst, ta, tbh, fr, fq)
          { Fr f0, f1, f2; LD(f0, bAt, bBt); LD(f1, bKt, bAt); LD(f2, bBt, bRt);
            RS_Z(acc); RS_Z(acc2); RS_Z(acc3); mcf(acc, f0); mcf(acc2, f1); mcf(acc3, f2);
            ST(3, acc, b9);
            ST(1, acc2, bAak);
            ST(2, acc3, bArb); }
          { Fr f3, f4; LD(f3, bKt, bRt); LD(f4, bBt, bAt); RS_Z(acc4); RS_Z(tacc); mcf(acc4, f3); mcf(tacc, f4);
            ST(2, acc4, bArk); }
#pragma unroll
          for (int tb = 0; tb < 2; ++tb)
#pragma unroll
              for (int i = 0; i < 4; ++i) { const int bb_ = 32 * tbh + 16 * tb + fr, a = 16 * ta + 4 * fq + i; tacc[tb][i] = (a < bb_) ? tacc[tb][i] : 0.f; }
          ST(0, tacc, b8);
#pragma unroll
          for (int tb = 0; tb < 2; ++tb)
#pragma unroll
              for (int i = 0; i < 4; ++i) { const int bb_ = 32 * tbh + 16 * tb + fr, a = 16 * ta + 4 * fq + i; if (a == bb_) tacc[tb][i] = 1.f; }
          ST(0, tacc, b10);
          __syncthreads();
          { Fr f0, f1; LD(f0, b9, b8); LD(f1, b8, b9); RS_Z(acc); RS_Z(acc2); mcf(acc, f0); mcf(acc2, f1); ST(0, acc, bAt); ST(0, acc2, bBt); }
          __syncthreads();
          { Fr f0, f1, f2; LD(f0, bBt, b10); LD(f1, bBt, bAt); LD(f2, bAt, bBt); RS_Z(acc); RS_Z(acc2); mcf(tacc, f0); mcf(acc, f1); mcf(acc2, f2); ST(0, tacc, bKt); ST(0, acc, b8); ST(0, acc2, b9); }
          __syncthreads();
          { Fr f0, f1, f2; LD(f0, b9, bKt); LD(f1, b9, b8); LD(f2, b8, b9); RS_Z(acc); RS_Z(acc2); mcf(tacc, f0); mcf(acc, f1); mcf(acc2, f2); ST(0, tacc, b10); ST(0, acc, bAt); ST(0, acc2, bBt); }
          __syncthreads();
          { Fr f0, f1, f2; LD(f0, bBt, b10); LD(f1, bBt, bAt); LD(f2, bAt, bBt); RS_Z(acc); RS_Z(acc2); mcf(tacc, f0); mcf(acc, f1); mcf(acc2, f2); ST(0, tacc, bKt); ST(0, acc, b8); ST(0, acc2, b9); }
          __syncthreads();
          { Fr f0, f1; LD(f0, b9, bKt); LD(f1, b8, b9); RS_Z(acc); mcf(tacc, f0); mcf(acc, f1); ST(0, tacc, b10); ST(0, acc, bBt); }
          __syncthreads();
          { Fr f0; LD(f0, bBt, b10); mcf(tacc, f0); ST(0, tacc, bKt); }
          __syncthreads(); SEG(4);
          { Fr f0, f1; LD(f0, bKt, bAtT); LD(f1, bAak, bVT); RS_Z(acc); RS_Z(acc2); mcf(acc, f0); mcf(acc2, f1); ST(0, acc, bAt); ST(0, acc2, b8); }
          __syncthreads();
          { Fr f0; LD(f0, bKt, b8); RS_Z(acc); mcf(acc, f0); ST(0, acc, b9); }
          __syncthreads();
          { Fr f0, f1, f2; LD(f0, bAt, bArb); LD(f1, b9, bArb); LD(f2, bVT, bArk);
            u32x2 rq[2];
#pragma unroll
            for (int tb = 0; tb < 2; ++tb) { const int bb_ = 32 * tbh + 16 * tb + fr, a0 = 16 * ta + 4 * fq; rq[tb] = *(const LAS u32x2*)(lds + bRt + t64(bb_, a0 >> 3) + (a0 & 4) * 2); }
            RS_Z(acc); mcf(acc, f0);
#pragma unroll
            for (int tb = 0; tb < 2; ++tb) { acc[tb][0] += bflo(rq[tb].x); acc[tb][1] += bfhi(rq[tb].x); acc[tb][2] += bflo(rq[tb].y); acc[tb][3] += bfhi(rq[tb].y); }
            st_glb<false>(acc, aLW + so, ta, tbh, fr, fq);
            RS_Z(acc2); mcf(acc2, f1); mcf(acc2, f2); st_glb<false>(acc2, aKK + so, ta, tbh, fr, fq); }
          { Fr f3, f4, f5; LD(f3, bAt, bBhT); LD(f4, bBhT, b9); LD(f5, bKhT, bVT);
            RS_Z(acc3); mcf(acc3, f3);
            { const float pc = __expf(ltot);
#pragma unroll
              for (int tb = 0; tb < 2; ++tb) { const int bb_ = 32 * tbh + 16 * tb + fr; const float pcb = __shfl(pc, bb_);
#pragma unroll
                  for (int i = 0; i < 4; ++i) { const int a = 16 * ta + 4 * fq + i; if (a == bb_) acc3[tb][i] += pcb; } } }
            st_glb<true>(acc3, aKP + so, ta, tbh, fr, fq);
            RS_Z(acc4); mcf(acc4, f4); mcf(acc4, f5); st_glb<false>(acc4, aB + so, ta, tbh, fr, fq); }
#undef LD
#undef ST
#undef RS_Z
          __syncthreads(); SEG(5);
        }
    }
#undef PF_ISSUE
#ifdef PROBE_SEG
    if (blockIdx.x == 0 && threadIdx.x == 0) { unsigned long long* st = (unsigned long long*)(F.ws + WS_CTL + 65536); st[40] = 0; st[41] = sg_[PROBE_SEG]; }
#endif
}

__device__ __forceinline__ void scan_seq(Frame& F, int bh) {
    const int lane = F.lane, r32 = lane & 31, hi = lane >> 5; const int b = bh / NH, h = bh % NH;
    const bf16* aM = (const bf16*)(F.dout + DO_KP); const bf16* aN = (const bf16*)(F.dout + DO_B); bf16* XS = (bf16*)(F.ws + WS_YRAW);
    f32x16 X[2][2];
#pragma unroll
    for (int i = 0; i < 2; ++i)
#pragma unroll
        for (int j = 0; j < 2; ++j) X[i][j] = f32x16{};
    for (int c = 0; c < NCHUNK; ++c) {
        const size_t so = ((size_t)b * T + (size_t)c * 64) * RW + h * HD;
        bf16* xs = XS + ((size_t)bh * NCHUNK + c) * 4096;
        bf16x8 am[2][2][2];
#pragma unroll
        for (int t1 = 0; t1 < 2; ++t1)
#pragma unroll
            for (int t2 = 0; t2 < 2; ++t2)
#pragma unroll
                for (int s = 0; s < 2; ++s) am[t1][t2][s] = *(const GAS bf16x8*)(aM + so + (size_t)(32 * t1 + r32) * RW + 32 * t2 + 16 * s + 8 * hi);
        u32x2 nn[2][2][4];
#pragma unroll
        for (int tk = 0; tk < 2; ++tk)
#pragma unroll
            for (int tv = 0; tv < 2; ++tv)
#pragma unroll
                for (int g = 0; g < 4; ++g) nn[tk][tv][g] = *(const GAS u32x2*)(aN + so + (size_t)(32 * tv + r32) * RW + 32 * tk + 8 * g + 4 * hi);
        bf16x8 xb[2][2][2];
#pragma unroll
        for (int tk = 0; tk < 2; ++tk)
#pragma unroll
            for (int tv = 0; tv < 2; ++tv) { unsigned pk[8];
#pragma unroll
                for (int q = 0; q < 8; ++q) pk[q] = pkbf(X[tk][tv][2 * q], X[tk][tv][2 * q + 1]);
#pragma unroll
                for (int g = 0; g < 4; ++g) { u32x2 w_; w_.x = pk[2 * g]; w_.y = pk[2 * g + 1]; *(GAS u32x2*)(xs + (size_t)(32 * tv + r32) * 64 + 32 * tk + 8 * g + 4 * hi) = w_; }
                u32x4 f0, f1; f0.x = pk[0]; f0.y = pk[1]; f0.z = pk[2]; f0.w = pk[3]; f1.x = pk[4]; f1.y = pk[5]; f1.z = pk[6]; f1.w = pk[7];
                xb[tk][tv][0] = __builtin_bit_cast(bf16x8, f0); xb[tk][tv][1] = __builtin_bit_cast(bf16x8, f1); }
#pragma unroll
        for (int t1 = 0; t1 < 2; ++t1)
#pragma unroll
            for (int tv = 0; tv < 2; ++tv) { f32x16 a;
#pragma unroll
                for (int g = 0; g < 4; ++g) { const u32x2 q_ = nn[t1][tv][g]; a[4 * g + 0] = bflo(q_.x); a[4 * g + 1] = bfhi(q_.x); a[4 * g + 2] = bflo(q_.y); a[4 * g + 3] = bfhi(q_.y); }
#pragma unroll
                for (int t2 = 0; t2 < 2; ++t2)
#pragma unroll
                    for (int s = 0; s < 2; ++s) a = __builtin_amdgcn_mfma_f32_32x32x16_bf16(am[t1][t2][s], xb[t2][tv][s], a, 0, 0, 0);
                X[t1][tv] = a; }
    }
}

__device__ __forceinline__ void scan_post(Frame& F) {
    const int lane = F.lane, fr = lane & 15, fq = lane >> 4, tb = F.wave & 3;
    const bf16* aRh = (const bf16*)(F.dout + DO_W); const bf16* aYl = (const bf16*)(F.dout + DO_KKN); const bf16* XS = (const bf16*)(F.ws + WS_YRAW);
    const bf16* Zb = (const bf16*)(F.ws + WS_Z); const float* mu = INP(4); const bf16* aG = (const bf16*)(F.ws + WS_GATE); const float* bon = (const float*)(F.ws + WS_BON);
    bf16* Y = (bf16*)(F.ws + WS_Y); const float* lnw = INP(13); const float* lnb = INP(14);
    for (int u = F.vcu * 2 + (F.wave >> 2); u < BATCH * NH * NCHUNK; u += F.G * 2) {
        const int c = u % NCHUNK, bh = u / NCHUNK, b = bh / NH, h = bh % NH;
        const size_t m0 = (size_t)b * T + (size_t)c * 64, so = m0 * RW + h * HD;
        const bf16* xs = XS + (size_t)u * 4096;
        const size_t trow = m0 + 16 * tb + fr;
        bf16x8 bf_[2];
#pragma unroll
        for (int s = 0; s < 2; ++s) bf_[s] = *(const GAS bf16x8*)(aRh + trow * RW + h * HD + 32 * s + 8 * fq);
        f32x4 acc[4];
#pragma unroll
        for (int ta = 0; ta < 4; ++ta) { const u32x2 q_ = *(const GAS u32x2*)(aYl + trow * RW + h * HD + 16 * ta + 4 * fq);
            acc[ta] = (f32x4){bflo(q_.x), bfhi(q_.x), bflo(q_.y), bfhi(q_.y)};
#pragma unroll
            for (int s = 0; s < 2; ++s) { const bf16x8 af = *(const GAS bf16x8*)(xs + (size_t)(16 * ta + fr) * 64 + 32 * s + 8 * fq); acc[ta] = __builtin_amdgcn_mfma_f32_16x16x32_bf16(af, bf_[s], acc[ta], 0, 0, 0); } }
        float s1 = 0.f;
#pragma unroll
        for (int ta = 0; ta < 4; ++ta) s1 += (acc[ta][0] + acc[ta][1]) + (acc[ta][2] + acc[ta][3]);
        s1 += __shfl_xor(s1, 16); s1 += __shfl_xor(s1, 32); const float mean = s1 * (1.f / 64.f); float s2 = 0.f;
#pragma unroll
        for (int ta = 0; ta < 4; ++ta)
#pragma unroll
            for (int i = 0; i < 4; ++i) { const float d_ = acc[ta][i] - mean; acc[ta][i] = d_; s2 += d_ * d_; }
        s2 += __shfl_xor(s2, 16); s2 += __shfl_xor(s2, 32); const float rstd = 1.f / sqrtf(s2 * (1.f / 64.f) + GN_EPS);
        const float bn = bon[trow * NH + h];
#pragma unroll
        for (int ta = 0; ta < 4; ++ta) { const int ch = h * HD + 16 * ta + 4 * fq; const f32x4 lw4 = *(const GAS f32x4*)(lnw + ch), lb4 = *(const GAS f32x4*)(lnb + ch);
            const u32x2 vc = *(const GAS u32x2*)(Zb + trow * NIN + ZV_R + ch), gq = *(const GAS u32x2*)(aG + trow * RW + ch); u32x2 vp; vp.x = 0u; vp.y = 0u;
            if ((trow % T) != 0) vp = *(const GAS u32x2*)(Zb + (trow - 1) * NIN + ZV_R + ch);
            const f32x4 mv = *(const GAS f32x4*)(mu + ZV_R + ch);
            const float v0 = bflo(vc.x) + (bflo(vp.x) - bflo(vc.x)) * mv[0], v1 = bfhi(vc.x) + (bfhi(vp.x) - bfhi(vc.x)) * mv[1], v2 = bflo(vc.y) + (bflo(vp.y) - bflo(vc.y)) * mv[2], v3 = bfhi(vc.y) + (bfhi(vp.y) - bfhi(vc.y)) * mv[3];
            const float o0 = (acc[ta][0] * rstd * lw4[0] + lb4[0] + bn * v0) * bflo(gq.x), o1 = (acc[ta][1] * rstd * lw4[1] + lb4[1] + bn * v1) * bfhi(gq.x);
            const float o2 = (acc[ta][2] * rstd * lw4[2] + lb4[2] + bn * v2) * bflo(gq.y), o3 = (acc[ta][3] * rstd * lw4[3] + lb4[3] + bn * v3) * bfhi(gq.y);
            u32x2 w_; w_.x = pkbf(o0, o1); w_.y = pkbf(o2, o3); *(GAS u32x2*)(Y + trow * D + ch) = w_; }
    }
}
}
using pg8::Unit;
constexpr size_t TILE_B = 256 * 2;
struct SchedBase { int G, c; };
struct SchedZ : SchedBase {
    __device__ __forceinline__ bool next(int i, Unit& u) const {
        const int L = i * G + c; constexpr int NZ = (M / 256) * (NIN / 256), NKV = (MEMR / 256) * (2 * D / 256);
        if (L < NZ) { pg8::tile_map(L, M / 256, NIN / 256, u.pm, u.pn); u.z = 0; u.a_off = WS_XN + (size_t)u.pm * 256 * D * 2; u.b_off = WS_WIN_T + (size_t)u.pn * 256 * D * 2; return true; }
        if (L < NZ + NKV) { const int l = L - NZ; u.pm = l / 8; u.pn = l % 8; u.z = 1; u.a_off = WS_MEMN + (size_t)u.pm * 256 * D * 2; u.b_off = WS_WXKV_T + (size_t)u.pn * 256 * D * 2; return true; }
        return false;
    }
};
struct SchedG : SchedBase {
    __device__ __forceinline__ bool next(int i, Unit& u) const {
        const int L = i * G + c; if (L >= 64) return false;
        u.z = L >> 4; u.pm = (L >> 2) & 3; u.pn = L & 3; u.a_off = WS_KV + ((size_t)u.pm * 256 * 2048 + u.z * 256) * 2; u.b_off = WS_WQ_S + ((size_t)u.pn * 256 * 1024 + u.z * 256) * 2; return true;
    }
};
struct SchedVW : SchedBase {
    __device__ __forceinline__ bool next(int i, Unit& u) const {
        const int L = i * G + (G - 1 - c); if (L >= 64) return false;
        u.z = L >> 2; u.pm = L & 3; u.pn = 0; const int b = u.z >> 2, h = u.z & 3;
        u.a_off = WS_WO_T + ((size_t)u.pm * 256 * 1024 + h * 256) * 2; u.b_off = WS_KV + ((size_t)b * 256 * 2048 + 1024 + h * 256) * 2; return true;
    }
};
struct SchedMN : SchedBase {
    int nN; size_t a_base, b_base; int lda, ldb, bsel;
    __device__ __forceinline__ bool next(int i, Unit& u) const {
        const int L = i * G + c; if (L >= (M / 256) * nN) return false;
        pg8::tile_map(L, M / 256, nN, u.pm, u.pn); u.z = 0;
        u.a_off = a_base + (size_t)u.pm * 256 * lda * 2; u.b_off = b_base + ((size_t)u.pn * 256 + (bsel ? (size_t)(u.pm >> 5) * 1024 : 0)) * ldb * 2; return true;
    }
};

constexpr int CW_MQ = 8192;
__device__ __forceinline__ void moba_attn_phase(Frame& F, int bx) {
    const bf16* Z = (const bf16*)(F.ws + WS_Z); bf16* Y = (bf16*)(F.ws + WS_Y) + RW; const float* KM = (const float*)(F.ws + WS_KMEAN);
    const bool perx = (F.G % 8 == 0); const int x = perx ? (bx & 7) : 0; const int nun = perx ? 128 : 1024;
    unsigned* qc = (unsigned*)(F.ctl + CW_MQ + 64 * x);
    volatile LAS unsigned* slot = F.MISC + 16;
    for (int it = 0;; ++it) {
        if (F.tid == 0) slot[it & 1] = __hip_atomic_fetch_add(qc, 1u, __ATOMIC_RELAXED, __HIP_MEMORY_SCOPE_AGENT);
        asm volatile("s_waitcnt vmcnt(0) lgkmcnt(0)" ::: "memory"); __builtin_amdgcn_s_barrier(); asm volatile("" ::: "memory");
        const int idx = __builtin_amdgcn_readfirstlane((int)slot[it & 1]);
        if (idx >= nun) break;
        const int bh = perx ? x * 4 + (idx & 3) : (idx & 31), qb = perx ? 31 - (idx >> 2) : 31 - (idx >> 5);
        int ln = F.lane; asm volatile("" : "+v"(ln)); ln &= 63;
        attn_body::attn_unit<8>(bh / NH, bh % NH, qb, Z + ZQ, Z + ZK, Z + ZV, Y, KM + (size_t)bh * NBLK * HD, (char*)F.lds + RING_OFF, F.wave, ln);
    }
}

#ifndef MK_N_LAUNCHES
#define MK_N_LAUNCHES 1
#endif
constexpr int PER_PHASE = 12;
constexpr int N_LAUNCHES = MK_N_LAUNCHES;
constexpr int SCAN_WGS = 64;
struct Args { const float* in[25]; float* out; unsigned char* ws; int ph_lo, ph_hi, li, pad; };
__global__ void __launch_bounds__(NWAVES * 64, 2) skel_fwd(Args args) {
    extern __shared__ __attribute__((aligned(16))) unsigned char lds[];
    Frame F;
    F.lds = (LAS unsigned char*)lds;
    F.MISC = (volatile LAS unsigned*)(F.lds + MISC_OFF);
    F.tid = threadIdx.x; F.lane = F.tid & 63; F.wave = __builtin_amdgcn_readfirstlane(F.tid >> 6) & 7;
    F.G = gridDim.x; { const int bx = blockIdx.x; F.vcu = (F.G % 8 == 0) ? (bx % 8) * (F.G / 8) + bx / 8 : bx; }
    F.ws = args.ws; F.dout = (unsigned char*)args.out;
#pragma unroll
    for (int i = 0; i < 25; ++i) F.in[i] = args.in[i];
    F.ctl = (gu32*)(F.ws + WS_CTL);
    for (int u = F.tid; u < (EPI_LDS_OFF - LDSCTL_OFF) / 4; u += NWAVES * 64) ((LAS unsigned*)(F.lds + LDSCTL_OFF))[u] = 0u;
    __syncthreads();
    XcdBarrier bar; bar.bar = (unsigned*)(F.ctl + CW_BAR); bar.x = 0; bar.st = nullptr;
    if (N_LAUNCHES == 1) bar = xcd_barrier_post((unsigned*)(F.ctl + CW_BAR), F.MISC + 8);
#ifdef PROBE_PHASE
    unsigned long long* stamps = (unsigned long long*)(F.ws + WS_CTL + 65536); int nst = 0;
#define STAMP() do { if (blockIdx.x == 0 && threadIdx.x == 0) stamps[nst] = __builtin_amdgcn_s_memrealtime(); ++nst; } while (0)
#else
#define STAMP() do {} while (0)
#endif
#define GRID_BAR() do { if (N_LAUNCHES == 1) xcd_barrier(bar); STAMP(); } while (0)
    const int lo = args.ph_lo, hi = args.ph_hi;
#ifndef PHASE_MASK
#define PHASE_MASK 0xFFFF
#endif
#define IN(k) (((PHASE_MASK >> (k)) & 1) && lo <= (k) && (k) < hi)
#define BOTH(k) (IN(k) && IN((k) + 1))
#define FRESH() do { int l_; asm volatile("v_mbcnt_lo_u32_b32 %0, -1, 0\n\tv_mbcnt_hi_u32_b32 %0, -1, %0" : "=v"(l_)); F.lane = l_ & 63; F.tid = F.wave * 64 + F.lane; } while (0)
    const char* wsc = (const char*)F.ws;
    const int bx = (int)blockIdx.x;

    STAMP();
    if (IN(0)) { FRESH(); if (blockIdx.x == 0 && F.tid == 0) { _Pragma("unroll") for (int i = 0; i < 25; ++i) ((GAS unsigned long long*)(F.ws + WS_TAB))[i] = (unsigned long long)F.in[i]; }
        p0_prologue(F); if (BOTH(0)) GRID_BAR(); }
    if (IN(1)) {
        pg8::Gemm g{wsc, wsc, D, D, D}; SchedZ S; S.G = F.G; S.c = bx;
        pg8::EpiStoreBf16 E{(bf16*)(F.ws + WS_Z), NIN, (bf16*)(F.ws + WS_KV), 2 * D, ZQ / 256, attn_body::C2, 0};
        pg8::gemm_phase<pg8::EpiStoreBf16, SchedZ, true>(F.lds + RING_OFF, g, S, E, F.wave);
        if (BOTH(1)) GRID_BAR();
    }
    if (IN(2)) {
        { pg8::Gemm g{wsc, wsc, 2 * D, D, 256}; SchedG S; S.G = F.G; S.c = bx;
          pg8::EpiStoreBf16 E{(bf16*)(F.ws + WS_GT), D, nullptr, 0, 0, 1.f, 1};
          pg8::gemm_phase<pg8::EpiStoreBf16, SchedG, true>(F.lds + RING_OFF, g, S, E, F.wave); }
        { pg8::Gemm g{wsc, wsc, D, 2 * D, 256}; SchedVW S; S.G = F.G; S.c = bx;
          pg8::EpiStoreBf16 E{(bf16*)(F.ws + WS_VWT), D, nullptr, 0, 0, 1.f, 2};
          pg8::gemm_phase<pg8::EpiStoreBf16, SchedVW, true>(F.lds + RING_OFF, g, S, E, F.wave); }
        __syncthreads();
        FRESH(); kmean_simple(F);
        if (BOTH(2)) GRID_BAR();
    }
    if (IN(3)) { FRESH(); rscan::scan_pre(F); if (BOTH(3)) GRID_BAR(); }
    if (IN(4)) {
        FRESH();
        if (bx < BATCH * NH) { if (F.wave == 0) rscan::scan_seq(F, bx); __syncthreads(); }
        moba_attn_phase(F, bx);
        if (BOTH(4)) GRID_BAR();
    }
    if (IN(5)) { FRESH(); rscan::scan_post(F); if (BOTH(5)) GRID_BAR(); }
    if (IN(6)) {
        pg8::Gemm g{wsc, wsc, D, D, D}; SchedMN S; S.G = F.G; S.c = bx; S.nN = D / 256; S.a_base = WS_Y; S.b_base = WS_WMIX_T; S.lda = D; S.ldb = D; S.bsel = 0;
        pg8::EpiRes<false, false> E{INP(0), nullptr, nullptr, (bf16*)(F.ws + WS_HB), (float*)(F.ws + WS_SS), D};
        pg8::gemm_phase<pg8::EpiRes<false, false>, SchedMN, true>(F.lds + RING_OFF, g, S, E, F.wave);
        if (BOTH(6)) GRID_BAR();
    }
    if (IN(7)) {
        pg8::Gemm g{wsc, wsc, D, D, D}; SchedMN S; S.G = F.G; S.c = bx; S.nN = D / 256; S.a_base = WS_HB; S.b_base = WS_GT; S.lda = D; S.ldb = D; S.bsel = 1;
        pg8::EpiSoftmax E{(bf16*)(F.ws + WS_P), D, (const float*)(F.ws + WS_SS), (PG8_LAS pg8::f32x2*)(F.lds + EPI_LDS_OFF)};
        pg8::gemm_phase<pg8::EpiSoftmax, SchedMN, true>(F.lds + RING_OFF, g, S, E, F.wave);
        if (BOTH(7)) GRID_BAR();
    }
    if (IN(8)) {
        pg8::Gemm g{wsc, wsc, D, D, D}; SchedMN S; S.G = F.G; S.c = bx; S.nN = D / 256; S.a_base = WS_P; S.b_base = WS_VWT; S.lda = D; S.ldb = D; S.bsel = 1;
        pg8::EpiRes<true, false> E{nullptr, (const bf16*)(F.ws + WS_HB), nullptr, (bf16*)(F.ws + WS_HB), (float*)(F.ws + WS_SS) + (size_t)M * 16, D};
        pg8::gemm_phase<pg8::EpiRes<true, false>, SchedMN, true>(F.lds + RING_OFF, g, S, E, F.wave);
        if (BOTH(8)) GRID_BAR();
    }
    if (IN(9)) {
        pg8::Gemm g{wsc, wsc, D, D, D}; SchedMN S; S.G = F.G; S.c = bx; S.nN = FF / 256; S.a_base = WS_HB; S.b_base = WS_W1_T; S.lda = D; S.ldb = D; S.bsel = 0;
        pg8::EpiSqRelu E{(bf16*)(F.ws + WS_AH), FF, (const float*)(F.ws + WS_SS) + (size_t)M * 16};
        pg8::gemm_phase<pg8::EpiSqRelu, SchedMN, true>(F.lds + RING_OFF, g, S, E, F.wave);
        if (BOTH(9)) GRID_BAR();
    }
    if (IN(10)) {
        pg8::Gemm g{wsc, wsc, FF, FF, FF}; SchedMN S; S.G = F.G; S.c = bx; S.nN = D / 256; S.a_base = WS_AH; S.b_base = WS_W2_T; S.lda = FF; S.ldb = FF; S.bsel = 0;
        pg8::EpiRes<true, false> E{nullptr, (const bf16*)(F.ws + WS_HB), nullptr, (bf16*)(F.ws + WS_HB), (float*)(F.ws + WS_SS) + (size_t)2 * M * 16, D};
        pg8::gemm_phase<pg8::EpiRes<true, false>, SchedMN, true>(F.lds + RING_OFF, g, S, E, F.wave);
        if (BOTH(10)) GRID_BAR();
    }
    if (IN(11)) { FRESH();
#ifdef PROBE_PHASE
        float pscale; { const unsigned long long* st = (const unsigned long long*)(F.ws + WS_CTL + 65536);
#ifdef PROBE_SEG
          pscale = 1.f + (float)(st[41]) * 1e-6f; }
#else
          pscale = 1.f + (float)(st[PROBE_PHASE + 1] - st[PROBE_PHASE]) * 1e-6f; }
#endif
        final_norm(F, pscale);
#else
        final_norm(F, 1.f);
#endif
    }
#undef IN
#undef BOTH
}

extern "C" void kernel_launch(void* const* d_in, const int* in_sizes, int n_in, void* d_out, int out_size, void* d_ws, size_t ws_size, hipStream_t stream) {
    static int grid = 0;
    if (grid == 0) {
        if (n_in != 25 || in_sizes[0] != M * D || out_size != M * D || ws_size < WS_END) { fprintf(stderr, "kernel_launch: unexpected problem (n_in %d, in0 %d, out %d, ws %zu); nothing launched\n", n_in, n_in > 0 ? in_sizes[0] : -1, out_size, ws_size); grid = -1; return; }
        int dev = 0, cus = 0, per_cu = 0;
        if (hipGetDevice(&dev) != hipSuccess || hipDeviceGetAttribute(&cus, hipDeviceAttributeMultiprocessorCount, dev) != hipSuccess) { grid = -1; return; }
        if (hipFuncSetAttribute((const void*)skel_fwd, hipFuncAttributeMaxDynamicSharedMemorySize, LDS_BYTES) != hipSuccess) { fprintf(stderr, "kernel_launch: hipFuncSetAttribute failed\n"); grid = -1; return; }
        if (hipOccupancyMaxActiveBlocksPerMultiprocessor(&per_cu, (const void*)skel_fwd, NWAVES * 64, LDS_BYTES) != hipSuccess || per_cu < 1)
            fprintf(stderr, "kernel_launch: note: occupancy query reports %d workgroups per CU\n", per_cu);
        (void)hipGetLastError();
        grid = cus;
    }
    if (grid < 0) return;
    if (hipMemsetAsync((char*)d_ws + WS_CTL, 0, CTL_ZERO_BYTES, stream) != hipSuccess) { fprintf(stderr, "kernel_launch: hipMemsetAsync failed\n"); return; }
    Args a{};
    for (int i = 0; i < 25; ++i) a.in[i] = (const float*)d_in[i];
    a.out = (float*)d_out; a.ws = (unsigned char*)d_ws;
    for (int li = 0; li < N_LAUNCHES; ++li) {
        a.ph_lo = (N_LAUNCHES == PER_PHASE) ? li : 0; a.ph_hi = (N_LAUNCHES == PER_PHASE) ? li + 1 : PER_PHASE; a.li = li;
        hipLaunchKernelGGL(skel_fwd, dim3(grid), dim3(NWAVES * 64), LDS_BYTES, stream, a);
        const hipError_t le = hipPeekAtLastError();
        if (le != hipSuccess) { fprintf(stderr, "kernel_launch: launch %d failed: %s\n", li, hipGetErrorName(le)); break; }
    }
}
```

```cpp
#include <hip/hip_runtime.h>
#include <cstdio>
#include <cstdint>
#include <cmath>
namespace pg8 {
#define PG8_LAS __attribute__((address_space(3)))
typedef unsigned short bf16_t;
typedef short bf16x8 __attribute__((ext_vector_type(8)));
typedef float f32x4 __attribute__((ext_vector_type(4)));
typedef float f32x2 __attribute__((ext_vector_type(2)));
typedef unsigned u32x4 __attribute__((ext_vector_type(4)));
typedef unsigned u32x2 __attribute__((ext_vector_type(2)));
constexpr int BM = 256, BK = 64, HALF = 128, HTB = HALF * BK * 2  , STAGE_BYTES = 8 * HTB, NXCD = 8, WGM = 8;

__host__ __device__ __forceinline__ int lds_byte(int r, int c) { const int st = (r >> 4) * 2 + (c >> 5), rr = r & 15, cc = c & 31, ob = rr * 64 + cc * 2; return st * 1024 + (ob ^ (((ob >> 9) & 1) << 5)); }
__host__ __device__ __forceinline__ void stage_rc(int b, int& R, int& C) { const int st = b / 1024, sb = b % 1024, swz = sb ^ (((sb >> 9) & 1) << 5); R = (st >> 1) * 16 + swz / 64; C = (st & 1) * 32 + (swz % 64) / 2; }
__host__ __device__ __forceinline__ int perm32(int rho) { const int n = rho >> 4, i = rho & 15; return 8 * (i >> 2) + 4 * n + (i & 3); }

struct Unit { int pm, pn, z; size_t a_off, b_off; };
struct Gemm { const char* A; const char* Bt; int lda, ldb, K; };

__host__ __device__ __forceinline__ void tile_map(int L, int nM, int nN, int& pm, int& pn) {
    const int nwg = nM * nN; int wgid = L;
    { const int q = nwg / NXCD, r = nwg % NXCD, xcd = wgid % NXCD, off = wgid / NXCD; wgid = (xcd < r ? xcd * (q + 1) : r * (q + 1) + (xcd - r) * q) + off; }
    const int nig = WGM * nN, gid = wgid / nig, fm = gid * WGM, gsz = (nM - fm) < WGM ? (nM - fm) : WGM;
    pm = fm + ((wgid % nig) % gsz); pn = (wgid % nig) / gsz;
}

__device__ __forceinline__ unsigned cvt_pk_bf16(float lo, float hi) { unsigned r; asm volatile("v_cvt_pk_bf16_f32 %0, %1, %2" : "=v"(r) : "v"(lo), "v"(hi)); return r; }

template <class Epi, class Sched, bool ALIGN_EPI>
__device__ __forceinline__ void gemm_phase(PG8_LAS unsigned char* lds, const Gemm g, const Sched& S, const Epi& E, const int wid_) {
    int lane_; asm volatile("v_mbcnt_lo_u32_b32 %0, -1, 0\n\tv_mbcnt_hi_u32_b32 %0, -1, %0" : "=v"(lane_));
    const int lane = lane_ & 63, wid = wid_ & 7, tid = wid * 64 + lane, wr = wid >> 2, wc = wid & 3, fr = lane & 15, fq = lane >> 4;
    const int K = g.K, nt = K / BK;
    unsigned voffA[2], voffB[2];
#pragma unroll
    for (int i = 0; i < 2; ++i) { int R, C; stage_rc(tid * 16 + i * 8192, R, C); const int Rb = Epi::PERM ? ((R & ~31) + perm32(R & 31)) : R;
        voffA[i] = (unsigned)(R * g.lda + C) * 2u; voffB[i] = (unsigned)(Rb * g.ldb + C) * 2u; }
    const size_t kstep = (size_t)(BK * 2);
    const size_t hstepA = (size_t)HALF * g.lda * 2, hstepB = (size_t)HALF * g.ldb * 2;
    const unsigned ldsw = (unsigned)wid * 1024u;
    const int aoff = lds_byte(wr * 64 + fr, fq * 8), boff = lds_byte(wc * 32 + fr, fq * 8);
#define PG8_SA(b, h) (((b) * 2 + (h)) * HTB)
#define PG8_SB(b, h) ((4 + (b) * 2 + (h)) * HTB)
#define PG8_STAGE(bufoff, gbase, voff) do { _Pragma("unroll") for (int _i = 0; _i < 2; ++_i) \
        __builtin_amdgcn_global_load_lds((const unsigned*)((const char*)(gbase) + (voff)[_i]), (PG8_LAS unsigned*)(lds + (bufoff) + ldsw + _i * 8192), 16, 0, 0); } while (0)
#define PG8_LDA(dst, b, h) do { _Pragma("unroll") for (int m = 0; m < 4; ++m) _Pragma("unroll") for (int k = 0; k < 2; ++k) dst[m][k] = *(const PG8_LAS bf16x8*)(lds + PG8_SA(b, h) + aoff + m * 2048 + k * 1024); } while (0)
#define PG8_LDB(dst, b, h) do { _Pragma("unroll") for (int n = 0; n < 2; ++n) _Pragma("unroll") for (int k = 0; k < 2; ++k) dst[n][k] = *(const PG8_LAS bf16x8*)(lds + PG8_SB(b, h) + boff + n * 2048 + k * 1024); } while (0)
#define PG8_MMA(ai, bj, At, Bt) do { __builtin_amdgcn_s_setprio(1); _Pragma("unroll") for (int m = 0; m < 4; ++m) _Pragma("unroll") for (int n = 0; n < 2; ++n) _Pragma("unroll") for (int k = 0; k < 2; ++k) \
        acc[ai][bj][m][n] = __builtin_amdgcn_mfma_f32_16x16x32_bf16(Bt[n][k], At[m][k], acc[ai][bj][m][n], 0, 0, 0); __builtin_amdgcn_s_setprio(0); } while (0)
#define PG8_WAIT_V(n) asm volatile("s_waitcnt vmcnt(" #n ")" ::: "memory")
#define PG8_WAIT_L(n) asm volatile("s_waitcnt lgkmcnt(" #n ")" ::: "memory")
#define PG8_BAR __builtin_amdgcn_s_barrier()
#define PG8_SCHED __builtin_amdgcn_sched_barrier(0)
    Unit cur, nxt; int ui = 0;
    if (!S.next(0, cur)) return;
    f32x4 acc[2][2][4][2];
#pragma unroll
    for (int a = 0; a < 2; ++a)
#pragma unroll
        for (int b = 0; b < 2; ++b)
#pragma unroll
            for (int m = 0; m < 4; ++m)
#pragma unroll
                for (int n = 0; n < 2; ++n) acc[a][b][m][n] = (f32x4){0.f, 0.f, 0.f, 0.f};
    bf16x8 At[4][2], B0[2][2], B1[2][2];
    const char* cA = g.A + cur.a_off; const char* cB = g.Bt + cur.b_off;
    PG8_STAGE(PG8_SB(0, 0), cB, voffB); PG8_STAGE(PG8_SB(0, 1), cB + hstepB, voffB); PG8_STAGE(PG8_SA(0, 0), cA, voffA); PG8_STAGE(PG8_SA(0, 1), cA + hstepA, voffA);
    if (wr == 1) PG8_BAR;
    PG8_WAIT_V(2); PG8_BAR;
    PG8_STAGE(PG8_SB(1, 0), cB + kstep, voffB); PG8_STAGE(PG8_SA(1, 0), cA + kstep, voffA); PG8_STAGE(PG8_SB(1, 1), cB + hstepB + kstep, voffB);
    PG8_WAIT_V(6); PG8_BAR;
    for (;;) {
        const bool has_next = S.next(ui + 1, nxt);
        const char* nA = has_next ? g.A + nxt.a_off : cA; const char* nB = has_next ? g.Bt + nxt.b_off : cB;
        for (int t = 0; t < nt; t += 2) {
            const bool last = (t == nt - 2);
            const char* a1 = cA + (size_t)(t + 1) * kstep;
            const char* a2 = last ? nA : cA + (size_t)(t + 2) * kstep; const char* b2 = last ? nB : cB + (size_t)(t + 2) * kstep;
            const char* a3 = a2 + kstep; const char* b3 = b2 + kstep;
            PG8_LDB(B0, 0, 0); PG8_LDB(B1, 0, 1); PG8_SCHED; PG8_LDA(At, 0, 0); PG8_STAGE(PG8_SA(1, 1), a1 + hstepA, voffA);
            PG8_WAIT_V(8); PG8_WAIT_L(0); PG8_BAR; PG8_MMA(0, 0, At, B0); PG8_MMA(0, 1, At, B1); PG8_BAR; PG8_SCHED;
            PG8_LDA(At, 0, 1); PG8_STAGE(PG8_SB(0, 0), b2, voffB); PG8_STAGE(PG8_SB(0, 1), b2 + hstepB, voffB); PG8_STAGE(PG8_SA(0, 0), a2, voffA);
            PG8_WAIT_V(8); PG8_WAIT_L(0); PG8_BAR; PG8_MMA(1, 0, At, B0); PG8_MMA(1, 1, At, B1); PG8_BAR; PG8_SCHED;
            PG8_LDB(B0, 1, 0); PG8_LDB(B1, 1, 1); PG8_SCHED; PG8_LDA(At, 1, 0); PG8_STAGE(PG8_SA(0, 1), a2 + hstepA, voffA);
            PG8_WAIT_V(8); PG8_WAIT_L(0); PG8_BAR; PG8_MMA(0, 0, At, B0); PG8_MMA(0, 1, At, B1); PG8_BAR; PG8_SCHED;
            PG8_LDA(At, 1, 1); PG8_STAGE(PG8_SB(1, 0), b3, voffB); PG8_STAGE(PG8_SB(1, 1), b3 + hstepB, voffB); PG8_STAGE(PG8_SA(1, 0), a3, voffA);
            PG8_WAIT_V(8); PG8_WAIT_L(0); PG8_BAR; PG8_MMA(1, 0, At, B0); PG8_MMA(1, 1, At, B1); PG8_BAR; PG8_SCHED;
        }
        if constexpr (ALIGN_EPI) { if (wr == 0) PG8_BAR; }
        E(acc, cur, wr, wc, fr, fq, lane);
        if (!has_next) break;
#pragma unroll
        for (int a = 0; a < 2; ++a)
#pragma unroll
            for (int b = 0; b < 2; ++b)
#pragma unroll
                for (int m = 0; m < 4; ++m)
#pragma unroll
                    for (int n = 0; n < 2; ++n) acc[a][b][m][n] = (f32x4){0.f, 0.f, 0.f, 0.f};
        cur = nxt; cA = nA; cB = nB; ++ui;
        if constexpr (ALIGN_EPI) { if (wr == 1) PG8_BAR; }
    }
    PG8_WAIT_V(0);
    if constexpr (!ALIGN_EPI) { if (wr == 0) PG8_BAR; }
    PG8_BAR;
#undef PG8_SA
#undef PG8_SB
#undef PG8_STAGE
#undef PG8_LDA
#undef PG8_LDB
#undef PG8_MMA
#undef PG8_WAIT_V
#undef PG8_WAIT_L
#undef PG8_BAR
#undef PG8_SCHED
}
}
namespace pg8 {
struct EpiStoreBf16 {
    static constexpr bool PERM = true;
    bf16_t* O0; int ldc0; bf16_t* O1; int ldc1; int qs_lo; float qscale;
    int mode;
    __device__ __forceinline__ void operator()(const f32x4 (&acc)[2][2][4][2], const Unit& u, int wr, int wc, int fr, int fq, int lane) const {
        asm volatile("" : "+v"(fr), "+v"(fq), "+v"(lane));
        bf16_t* base; int ldc; size_t row0; int colt;
        if (mode == 0) { base = u.z ? O1 : O0; ldc = u.z ? ldc1 : ldc0; row0 = (size_t)u.pm * BM; colt = u.pn * BM; }
        else if (mode == 1) { base = O0; ldc = ldc0; row0 = (size_t)u.pm * 1024 + (size_t)u.z * 256; colt = u.pn * BM; }
        else { base = O0 + (size_t)(u.z >> 2) * 1048576; ldc = ldc0; row0 = (size_t)u.pm * BM; colt = (u.z & 3) * 256; }
        const float sc = (mode == 0 && u.z == 0 && (u.pn == qs_lo || u.pn == qs_lo + 1)) ? qscale : 1.f;
        const int col0 = colt + wc * 32 + 8 * fq;
#pragma unroll
        for (int ai = 0; ai < 2; ++ai)
#pragma unroll
            for (int m = 0; m < 4; ++m) { bf16_t* rowp = base + (row0 + wr * 64 + fr + ai * HALF + m * 16) * ldc + col0;
#pragma unroll
                for (int bj = 0; bj < 2; ++bj) { const f32x4 v0 = acc[ai][bj][m][0] * sc, v1 = acc[ai][bj][m][1] * sc;
                    u32x4 w; w.x = cvt_pk_bf16(v0[0], v0[1]); w.y = cvt_pk_bf16(v0[2], v0[3]); w.z = cvt_pk_bf16(v1[0], v1[1]); w.w = cvt_pk_bf16(v1[2], v1[3]);
                    *(u32x4*)(rowp + bj * HALF) = w; } }
    }
};

__device__ __forceinline__ float row_rstd(const float* ss, size_t row) {
    const f32x4* p = (const f32x4*)(ss + row * 16); const f32x4 a = p[0], b = p[1], c = p[2], d = p[3];
    const float s = ((a[0] + a[1]) + (a[2] + a[3])) + ((b[0] + b[1]) + (b[2] + b[3])) + ((c[0] + c[1]) + (c[2] + c[3])) + ((d[0] + d[1]) + (d[2] + d[3]));
    return 1.0f / sqrtf(s * (1.0f / 1024.0f) + 1e-6f);
}
__device__ __forceinline__ void wave_rstd(float (&rs)[2][4], const float* ss, int pm, int wr, int fr, int lane) {
    const float my0 = row_rstd(ss, (size_t)pm * BM + wr * 64 + lane), my1 = row_rstd(ss, (size_t)pm * BM + HALF + wr * 64 + lane);
#pragma unroll
    for (int m = 0; m < 4; ++m) { rs[0][m] = __shfl(my0, m * 16 + fr); rs[1][m] = __shfl(my1, m * 16 + fr); }
}

template <bool BASE_BF16, bool OUT_F32> struct EpiRes {
    static constexpr bool PERM = false;
    const float* base; const bf16_t* baseb; float* out; bf16_t* hb; float* ss; int ldc;
    __device__ __forceinline__ void operator()(f32x4 (&acc)[2][2][4][2], const Unit& u, int wr, int wc, int fr, int fq, int lane) const {
        asm volatile("" : "+v"(fr), "+v"(fq), "+v"(lane));
        const int col0 = u.pn * BM + wc * 32 + 4 * fq;
#pragma unroll
        for (int ai = 0; ai < 2; ++ai)
#pragma unroll
            for (int m = 0; m < 4; ++m) { const size_t row = (size_t)u.pm * BM + ai * HALF + wr * 64 + m * 16 + fr; const size_t off = row * ldc + col0; float q = 0.f;
#pragma unroll
                for (int bj = 0; bj < 2; ++bj)
#pragma unroll
                    for (int n = 0; n < 2; ++n) { f32x4 bs;
                        if (BASE_BF16) { const u32x2 b2 = *(const u32x2*)(baseb + off + bj * HALF + n * 16); bs = (f32x4){__builtin_bit_cast(float, b2.x << 16), __builtin_bit_cast(float, b2.x & 0xffff0000u), __builtin_bit_cast(float, b2.y << 16), __builtin_bit_cast(float, b2.y & 0xffff0000u)}; }
                        else bs = *(const f32x4*)(base + off + bj * HALF + n * 16);
                        const f32x4 o = bs + acc[ai][bj][m][n];
                        if (OUT_F32) *(f32x4*)(out + off + bj * HALF + n * 16) = o;
                        q += (o[0] * o[0] + o[1] * o[1]) + (o[2] * o[2] + o[3] * o[3]);
                        u32x2 w; w.x = cvt_pk_bf16(o[0], o[1]); w.y = cvt_pk_bf16(o[2], o[3]); *(u32x2*)(hb + off + bj * HALF + n * 16) = w; }
                q += __shfl_xor(q, 16); q += __shfl_xor(q, 32);
                if (fq == 0) ss[row * 16 + u.pn * 4 + wc] = q;
                if (m & 1) asm volatile("" ::: "memory"); }
    }
};

struct EpiSqRelu {
    static constexpr bool PERM = true;
    bf16_t* O; int ldc; const float* ss;
    __device__ __forceinline__ void operator()(const f32x4 (&acc)[2][2][4][2], const Unit& u, int wr, int wc, int fr, int fq, int lane) const {
        asm volatile("" : "+v"(fr), "+v"(fq), "+v"(lane));
        float rs[2][4]; wave_rstd(rs, ss, u.pm, wr, fr, lane);
        const int col0 = u.pn * BM + wc * 32 + 8 * fq;
#pragma unroll
        for (int ai = 0; ai < 2; ++ai)
#pragma unroll
            for (int m = 0; m < 4; ++m) { bf16_t* rowp = O + ((size_t)u.pm * BM + wr * 64 + fr + ai * HALF + m * 16) * ldc + col0; const float s = rs[ai][m];
#pragma unroll
                for (int bj = 0; bj < 2; ++bj) { f32x4 v0 = acc[ai][bj][m][0] * s, v1 = acc[ai][bj][m][1] * s;
#pragma unroll
                    for (int i = 0; i < 4; ++i) { const float a = fmaxf(v0[i], 0.f), b = fmaxf(v1[i], 0.f); v0[i] = a * a; v1[i] = b * b; }
                    u32x4 w; w.x = cvt_pk_bf16(v0[0], v0[1]); w.y = cvt_pk_bf16(v0[2], v0[3]); w.z = cvt_pk_bf16(v1[0], v1[1]); w.w = cvt_pk_bf16(v1[2], v1[3]);
                    *(u32x4*)(rowp + bj * HALF) = w; } }
    }
};

struct EpiSoftmax {
    static constexpr bool PERM = true;
    bf16_t* O; int ldc; const float* ss; PG8_LAS f32x2* xl;
    __device__ __forceinline__ void operator()(f32x4 (&acc)[2][2][4][2], const Unit& u, int wr, int wc, int fr, int fq, int lane) const {
        asm volatile("" : "+v"(fr), "+v"(fq), "+v"(lane));
        float rs[2][4]; wave_rstd(rs, ss, u.pm, wr, fr, lane);
#pragma unroll
        for (int ai = 0; ai < 2; ++ai)
#pragma unroll
            for (int m = 0; m < 4; ++m) { const float s = rs[ai][m] * (0.0625f * 1.4426950408889634f); float mx = -INFINITY;
#pragma unroll
                for (int bj = 0; bj < 2; ++bj)
#pragma unroll
                    for (int n = 0; n < 2; ++n) { f32x4 v = acc[ai][bj][m][n] * s; acc[ai][bj][m][n] = v; mx = fmaxf(fmaxf(mx, fmaxf(v[0], v[1])), fmaxf(v[2], v[3])); }
                mx = fmaxf(mx, __shfl_xor(mx, 16)); mx = fmaxf(mx, __shfl_xor(mx, 32)); float sm = 0.f;
#pragma unroll
                for (int bj = 0; bj < 2; ++bj)
#pragma unroll
                    for (int n = 0; n < 2; ++n) { f32x4 v = acc[ai][bj][m][n];
#pragma unroll
                        for (int i = 0; i < 4; ++i) { v[i] = __builtin_amdgcn_exp2f(v[i] - mx); sm += v[i]; } acc[ai][bj][m][n] = v; }
                sm += __shfl_xor(sm, 16); sm += __shfl_xor(sm, 32);
                if (fq == 0) xl[(ai * HALF + wr * 64 + m * 16 + fr) * 4 + wc] = (f32x2){mx, sm}; }
        asm volatile("s_waitcnt lgkmcnt(0)" ::: "memory"); __builtin_amdgcn_s_barrier(); asm volatile("" ::: "memory");
        const int col0 = u.pn * BM + wc * 32 + 8 * fq;
#pragma unroll
        for (int ai = 0; ai < 2; ++ai)
#pragma unroll
            for (int m = 0; m < 4; ++m) { const int r = ai * HALF + wr * 64 + m * 16 + fr;
                const f32x4 x01 = *(const PG8_LAS f32x4*)(xl + r * 4), x23 = *(const PG8_LAS f32x4*)(xl + r * 4 + 2);
                const float mg = fmaxf(fmaxf(x01[0], x01[2]), fmaxf(x23[0], x23[2]));
                const float tot = x01[1] * __builtin_amdgcn_exp2f(x01[0] - mg) + x01[3] * __builtin_amdgcn_exp2f(x01[2] - mg) + x23[1] * __builtin_amdgcn_exp2f(x23[0] - mg) + x23[3] * __builtin_amdgcn_exp2f(x23[2] - mg);
                const float mown = wc == 0 ? x01[0] : (wc == 1 ? x01[2] : (wc == 2 ? x23[0] : x23[2]));
                const float f = __builtin_amdgcn_exp2f(mown - mg) / tot;
                bf16_t* rowp = O + ((size_t)u.pm * BM + r) * ldc + col0;
#pragma unroll
                for (int bj = 0; bj < 2; ++bj) { const f32x4 v0 = acc[ai][bj][m][0] * f, v1 = acc[ai][bj][m][1] * f;
                    u32x4 w; w.x = cvt_pk_bf16(v0[0], v0[1]); w.y = cvt_pk_bf16(v0[2], v0[3]); w.z = cvt_pk_bf16(v1[0], v1[1]); w.w = cvt_pk_bf16(v1[2], v1[3]);
                    *(u32x4*)(rowp + bj * HALF) = w; } }
    }
};
}
constexpr int NWAVES = 8;
constexpr int BATCH = 4, T = 8192, D = 1024, M = BATCH * T;
constexpr int NIN = 3328, RW = 512, NH = 8, HD = 64;
constexpr int ZK_R = 512, ZV_R = 1024, ZWD = 1536, ZAD = 1600, ZGD = 1664;
constexpr int ZQ = 1792, ZK = 1792 + 512, ZV = 1792 + 1024;
constexpr int MEML = 256, MEMR = BATCH * MEML, FF = 4096;
constexpr int NBLK = T / 256;
constexpr float NORM_EPS = 1e-6f, GN_EPS = 64e-5f, DECAY_SCALE = 0.6065306597126334f;

constexpr size_t MiB = 1u << 20;
constexpr size_t WS_CTL = 0, CTL_ZERO_BYTES = 1 * MiB;
constexpr size_t WS_WIN_T = 1 * MiB, WS_WMIX_T = 8 * MiB, WS_WQ_S = 10 * MiB, WS_WXKV_T = 12 * MiB, WS_WO_T = 16 * MiB, WS_W1_T = 18 * MiB, WS_W2_T = 26 * MiB;
constexpr size_t WS_MEMN = 34 * MiB, WS_KV = 36 * MiB, WS_GT = 40 * MiB, WS_VWT = 48 * MiB;
constexpr size_t WS_SS = 56 * MiB;
constexpr size_t WS_KMEAN = 62 * MiB, WS_LORA = 62 * MiB + 512 * 1024, WS_BON = 63 * MiB;
constexpr size_t WS_XN = 64 * MiB;
constexpr size_t WS_GATE = 64 * MiB, WS_YRAW = 96 * MiB;
constexpr size_t WS_HB = 64 * MiB;
constexpr size_t WS_Z = 128 * MiB;
constexpr size_t WS_Y = 336 * MiB;
constexpr size_t WS_PR = 400 * MiB, WS_PV = 432 * MiB;
constexpr size_t WS_P = 400 * MiB;
constexpr size_t WS_AH = 128 * MiB;
constexpr size_t WS_END = 512 * MiB;
constexpr size_t DO_W = 0, DO_KP = 32 * MiB, DO_KKN = 64 * MiB, DO_B = 96 * MiB;

constexpr int CW_TMO = 0, CW_CODE = 1;
constexpr int CW_BAR = 4096;

constexpr int RING_OFF = 0, RING_BYTES = 131072;
constexpr int LDSCTL_OFF = RING_BYTES, MISC_OFF = LDSCTL_OFF + 320;
constexpr int EPI_LDS_OFF = 132096;
constexpr int LDS_BYTES = 147456;
static_assert(MISC_OFF + 128 <= EPI_LDS_OFF && EPI_LDS_OFF + 8192 <= LDS_BYTES, "LDS map");

#define GAS __attribute__((address_space(1)))
#define LAS __attribute__((address_space(3)))
typedef unsigned short bf16;
typedef unsigned v4u __attribute__((ext_vector_type(4)));
typedef float f32x4 __attribute__((ext_vector_type(4)));
typedef GAS unsigned gu32;
#define RLX_AGENT __ATOMIC_RELAXED, __HIP_MEMORY_SCOPE_AGENT
#define LDS_WAIT() asm volatile("s_waitcnt lgkmcnt(0)" ::: "memory")
#define VM_WAIT() asm volatile("s_waitcnt vmcnt(0)" ::: "memory")
__device__ __forceinline__ unsigned f2bf(float f) { unsigned u = __builtin_bit_cast(unsigned, f); return (u + 0x7fffu + ((u >> 16) & 1u)) >> 16; }
__device__ __forceinline__ unsigned pk2(float lo, float hi) { return f2bf(lo) | (f2bf(hi) << 16); }
__device__ __forceinline__ float bf2f(unsigned short u) { return __builtin_bit_cast(float, (unsigned)u << 16); }
__device__ __forceinline__ float bflo(unsigned u) { return __builtin_bit_cast(float, u << 16); }
__device__ __forceinline__ float bfhi(unsigned u) { return __builtin_bit_cast(float, u & 0xffff0000u); }

#define XB_TMO      128
#define XB_XCNT(j)  (256  + 64 * (j))
#define XB_XSUB(j)  (1280 + 64 * (j))
#define XB_XGEN(j)  (2304 + 64 * (j))
#define XB_TOP      3328
#define XB_TOPGEN   3392
#define XCD_BAR_WORDS 3456
#define XB_SPIN_CAP (1u << 18)
__device__ __forceinline__ unsigned xb_ld(unsigned* p)              { return __hip_atomic_load(p, __ATOMIC_RELAXED, __HIP_MEMORY_SCOPE_AGENT); }
__device__ __forceinline__ unsigned xb_add(unsigned* p, unsigned v) { return __hip_atomic_fetch_add(p, v, __ATOMIC_RELAXED, __HIP_MEMORY_SCOPE_AGENT); }
__device__ __forceinline__ unsigned xb_xcc_id() { return (unsigned)__builtin_amdgcn_s_getreg((3 << 11) | 20) & 0xFu; }
#define XB_SPIN(cond, bar) do { unsigned _sp = 0; while (cond) { __builtin_amdgcn_s_sleep(1); \
    if ((++_sp & 255u) == 0u) { if (xb_ld(&(bar)[XB_TMO])) break; if (_sp > XB_SPIN_CAP) { atomicAdd(&(bar)[XB_TMO], 1u); break; } } } } while (0)
struct XcdBarrier { unsigned* bar; unsigned x; volatile LAS unsigned* st; };
__device__ __forceinline__ XcdBarrier xcd_barrier_post(unsigned* bar, volatile LAS unsigned* st) {
    XcdBarrier b; b.bar = bar; b.x = xb_xcc_id(); b.st = st;
    if (threadIdx.x == 0) (void)xb_add(&bar[XB_XCNT(b.x)], 1u);
    return b;
}
__device__ __forceinline__ void xcd_barrier_complete(unsigned* bar, unsigned x, unsigned& nloc, unsigned& nx) {
    const unsigned G = gridDim.x * gridDim.y * gridDim.z;
    unsigned sum, cnt, mine, sp = 0u;
    for (;;) {
        sum = 0u; cnt = 0u; mine = 0u;
#pragma unroll
        for (unsigned j = 0; j < 16; ++j) { const unsigned c = xb_ld(&bar[XB_XCNT(j)]); sum += c; cnt += (c > 0u) ? 1u : 0u; mine = (j == x) ? c : mine; }
        if (sum == G) break;
        __builtin_amdgcn_s_sleep(1);
        if ((++sp & 255u) == 0u) { if (xb_ld(&bar[XB_TMO])) break; if (sp > XB_SPIN_CAP) { atomicAdd(&bar[XB_TMO], 1u); break; } }
    }
    nloc = mine > 0u ? mine : 1u; nx = cnt > 0u ? cnt : 1u;
}
__device__ __forceinline__ void xcd_barrier(const XcdBarrier& b) {
    asm volatile("s_waitcnt vmcnt(0)" ::: "memory");
    __syncthreads();
    if (threadIdx.x == 0) {
        unsigned* bar = b.bar;
        __builtin_amdgcn_s_waitcnt(0);
        unsigned nloc = b.st[0], nx = b.st[1];
        if (nloc == 0u) { xcd_barrier_complete(bar, b.x, nloc, nx); b.st[0] = nloc; b.st[1] = nx; }
        const unsigned old = xb_add(&bar[XB_XSUB(b.x)], 1u);
        const unsigned gen = old / nloc;
        if (old + 1u == (gen + 1u) * nloc) {
            __builtin_amdgcn_fence(__ATOMIC_RELEASE, "agent");
            asm volatile("s_waitcnt vmcnt(0)" ::: "memory");
            const unsigned og = xb_add(&bar[XB_TOP], 1u);
            const unsigned tg = og / nx;
            if (og + 1u == (tg + 1u) * nx) xb_add(&bar[XB_TOPGEN], 1u);
            else XB_SPIN(xb_ld(&bar[XB_TOPGEN]) == tg, bar);
            __builtin_amdgcn_fence(__ATOMIC_ACQUIRE, "agent");
            xb_add(&bar[XB_XGEN(b.x)], 1u);
            asm volatile("s_waitcnt vmcnt(0)" ::: "memory");
        } else {
            XB_SPIN(xb_ld(&bar[XB_XGEN(b.x)]) == gen, bar);
            __builtin_amdgcn_fence(__ATOMIC_ACQUIRE, "agent");
            asm volatile("s_waitcnt vmcnt(0)" ::: "memory");
        }
    }
    __syncthreads();
}

struct Frame {
    LAS unsigned char* lds;
    volatile LAS unsigned* MISC;
    gu32* ctl;
    int tid, lane, wave;
    int vcu, G;
    unsigned char* ws; unsigned char* dout;
    const float* in[25];
};
constexpr size_t WS_TAB = 131072;
__device__ __forceinline__ const float* inp(const Frame& F, int i) {
    const unsigned long long v = ((const GAS unsigned long long*)(F.ws + WS_TAB))[i];
    const unsigned lo = __builtin_amdgcn_readfirstlane((unsigned)v), hi = __builtin_amdgcn_readfirstlane((unsigned)(v >> 32));
    return (const float*)(((unsigned long long)hi << 32) | lo);
}
#define INP(i) inp(F, (i))
__device__ __forceinline__ float wave_sum(float v) {
#pragma unroll
    for (int o = 1; o < 64; o <<= 1) v += __shfl_xor(v, o);
    return v;
}
__device__ __forceinline__ float wave_max(float v) {
#pragma unroll
    for (int o = 1; o < 64; o <<= 1) v = fmaxf(v, __shfl_xor(v, o));
    return v;
}
template <int CTRL> __device__ __forceinline__ float dpp_mov(float x) { return __builtin_bit_cast(float, __builtin_amdgcn_update_dpp(0, __builtin_bit_cast(int, x), CTRL, 0xf, 0xf, false)); }
__device__ __forceinline__ float red16(float x) { x += dpp_mov<0xB1>(x); x += dpp_mov<0x4E>(x); x += dpp_mov<0x124>(x); x += dpp_mov<0x128>(x); return x; }
__device__ __forceinline__ void p0_transpose_item(const float* W, int K, int N, bf16* WT, const float* kscale, LAS float* scr, int item, int lane) {
    const int nblk = N / 32, kb = item / nblk, nb = item % nblk, k0 = 64 * kb, n0 = 32 * nb;
#pragma unroll 8
    for (int i = 0; i < 32; ++i) { const int kk = 2 * i + (lane >> 5); const float s = kscale ? kscale[k0 + kk] : 1.f; scr[kk * 33 + (lane & 31)] = W[(size_t)(k0 + kk) * N + n0 + (lane & 31)] * s; }
    LDS_WAIT(); asm volatile("" ::: "memory");
    const int c = lane & 7;
#pragma unroll
    for (int j = 0; j < 4; ++j) { const int n = (lane >> 3) + 8 * j; const LAS float* s = scr + (8 * c) * 33 + n;
        v4u o; o.x = pk2(s[0 * 33], s[1 * 33]); o.y = pk2(s[2 * 33], s[3 * 33]); o.z = pk2(s[4 * 33], s[5 * 33]); o.w = pk2(s[6 * 33], s[7 * 33]);
        *(GAS v4u*)(WT + (size_t)(n0 + n) * K + k0 + 8 * c) = o; }
    LDS_WAIT(); asm volatile("" ::: "memory");
}
__device__ __forceinline__ void rms_row_to_bf16(const float* xrow, const float* g, bf16* orow, int lane) {
    const GAS f32x4* xr = (const GAS f32x4*)xrow + lane; const GAS f32x4* gr = (const GAS f32x4*)g + lane;
    f32x4 v[4]; float s = 0.f;
#pragma unroll
    for (int j = 0; j < 4; ++j) { v[j] = xr[64 * j]; s += (v[j].x * v[j].x + v[j].y * v[j].y) + (v[j].z * v[j].z + v[j].w * v[j].w); }
    const float rstd = 1.f / sqrtf(wave_sum(s) * (1.f / D) + NORM_EPS);
    GAS unsigned long long* o8 = (GAS unsigned long long*)orow + lane;
#pragma unroll
    for (int j = 0; j < 4; ++j) { const f32x4 gg = gr[64 * j]; o8[64 * j] = (unsigned long long)pk2(v[j].x * rstd * gg.x, v[j].y * rstd * gg.y) | ((unsigned long long)pk2(v[j].z * rstd * gg.z, v[j].w * rstd * gg.w) << 32); }
}
__device__ __forceinline__ void p0_prologue(Frame& F) {
    LAS float* scr = (LAS float*)(F.lds + RING_OFF + F.wave * 16384);
    const int gw = F.vcu * NWAVES + F.wave, NGW = F.G * NWAVES;
    constexpr int I_IN = (D / 64) * (NIN / 32), I_MIX = (D / 64) * (D / 32), I_KV = (D / 64) * (2 * D / 32), I_O = I_MIX, I_1 = (D / 64) * (FF / 32), I_2 = (FF / 64) * (D / 32);
    constexpr int I_LW = RW / 32, I_LG = 2 * (RW / 32);
    constexpr int NITEMS = I_IN + I_MIX + I_KV + I_O + I_1 + I_2 + 2 * I_LW + I_LG;
    for (int it = gw; it < NITEMS; it += NGW) {
        int r = it;
        if (r < I_IN) { p0_transpose_item(F.in[3], D, NIN, (bf16*)(F.ws + WS_WIN_T), nullptr, scr, r, F.lane); continue; } r -= I_IN;
        if (r < I_MIX) { p0_transpose_item(F.in[15], D, D, (bf16*)(F.ws + WS_WMIX_T), nullptr, scr, r, F.lane); continue; } r -= I_MIX;
        if (r < I_KV) { p0_transpose_item(F.in[19], D, 2 * D, (bf16*)(F.ws + WS_WXKV_T), nullptr, scr, r, F.lane); continue; } r -= I_KV;
        if (r < I_O) { p0_transpose_item(F.in[20], D, D, (bf16*)(F.ws + WS_WO_T), nullptr, scr, r, F.lane); continue; } r -= I_O;
        if (r < I_1) { p0_transpose_item(F.in[22], D, FF, (bf16*)(F.ws + WS_W1_T), F.in[21], scr, r, F.lane); continue; } r -= I_1;
        if (r < I_2) { p0_transpose_item(F.in[23], FF, D, (bf16*)(F.ws + WS_W2_T), nullptr, scr, r, F.lane); continue; } r -= I_2;
        if (r < I_LW) { p0_transpose_item(F.in[6], 64, RW, (bf16*)(F.ws + WS_LORA), nullptr, scr, r, F.lane); continue; } r -= I_LW;
        if (r < I_LW) { p0_transpose_item(F.in[8], 64, RW, (bf16*)(F.ws + WS_LORA) + RW * 64, nullptr, scr, r, F.lane); continue; } r -= I_LW;
        p0_transpose_item(F.in[9], 128, RW, (bf16*)(F.ws + WS_LORA) + 2 * RW * 64, nullptr, scr, r, F.lane);
    }
    { const float* wq = F.in[18]; const float* gx = F.in[16]; bf16* o = (bf16*)(F.ws + WS_WQ_S);
      for (int i = (F.vcu * 512 + F.tid); i < D * D / 4; i += F.G * 512) { const f32x4 v = ((const GAS f32x4*)wq)[i]; const float s = gx[(i * 4) / D];
          ((GAS unsigned long long*)o)[i] = (unsigned long long)pk2(v.x * s, v.y * s) | ((unsigned long long)pk2(v.z * s, v.w * s) << 32); } }
    for (int m = gw; m < M; m += NGW) rms_row_to_bf16(F.in[0] + (size_t)m * D, F.in[2], (bf16*)(F.ws + WS_XN) + (size_t)m * D, F.lane);
    for (int m = gw; m < MEMR; m += NGW) rms_row_to_bf16(F.in[1] + (size_t)m * D, F.in[17], (bf16*)(F.ws + WS_MEMN) + (size_t)m * D, F.lane);
}

__device__ __forceinline__ void kmean_simple(Frame& F) {
    const bf16* Z = (const bf16*)(F.ws + WS_Z); float* KM = (float*)(F.ws + WS_KMEAN);
    const int gw = F.vcu * NWAVES + F.wave, NGW = F.G * NWAVES;
    for (int u = gw; u < BATCH * NH * NBLK; u += NGW) { const int j = u % NBLK, bh = u / NBLK, b = bh / NH, h = bh % NH;
        const bf16* kp = Z + ((size_t)b * T + j * 256) * NIN + ZK + h * HD + F.lane; float s = 0.f;
        for (int i = 0; i < 256; ++i) s += bf2f(kp[(size_t)i * NIN]);
        KM[(size_t)u * HD + F.lane] = s * (1.f / 256.f); }
}
__device__ __forceinline__ void final_norm(Frame& F, const float pscale) {
    float* out = (float*)F.dout; const bf16* hb = (const bf16*)(F.ws + WS_HB); const float* ss = (const float*)(F.ws + WS_SS) + (size_t)2 * M * 16; const float* g = INP(24);
    const int gw = F.vcu * NWAVES + F.wave, NGW = F.G * NWAVES;
    for (int m = gw; m < M; m += NGW) { const float rstd = pg8::row_rstd(ss, (size_t)m) * pscale;
        GAS f32x4* o = (GAS f32x4*)(out + (size_t)m * D) + F.lane; const GAS f32x4* gr = (const GAS f32x4*)g + F.lane; const GAS unsigned long long* hr = (const GAS unsigned long long*)(hb + (size_t)m * D) + F.lane;
#pragma unroll
        for (int j = 0; j < 4; ++j) { const unsigned long long q = hr[64 * j]; const unsigned lo = (unsigned)q, hi = (unsigned)(q >> 32); const f32x4 gg = gr[64 * j];
            f32x4 v = (f32x4){bflo(lo), bfhi(lo), bflo(hi), bfhi(hi)}; v = v * rstd * gg; o[64 * j] = v; } }
}
namespace attn_body {
typedef unsigned short bf16;
using bf16x8=__attribute__((ext_vector_type(8)))short;
using s16x4=__attribute__((ext_vector_type(4)))short;
using f32x16=__attribute__((ext_vector_type(16)))float;
using u32x4=__attribute__((ext_vector_type(4)))unsigned;
constexpr int SEQ=8192,D=64,QP=3328,OP=1024;
constexpr int NW=8,QBLK=32,QB=QBLK*NW,KVBLK=64,NQB=SEQ/QB;
__device__ __forceinline__ int crow(int r,int hi){return (r&3)+8*(r>>2)+4*hi;}
#define SBAR() __builtin_amdgcn_sched_barrier(0)
__device__ __forceinline__ void cmask(f32x16&p0,f32x16&p1,int jb,int qrel,int hi){
  const float NEG=-INFINITY; int kb=64*jb+4*hi;
  #pragma unroll
  for(int r=0;r<16;++r){int kv=kb+(r&3)+8*(r>>2); if(kv>qrel)p0[r]=NEG; if(kv+32>qrel)p1[r]=NEG;}
}

constexpr int NSLOT=3, SLOTB=8192;
constexpr int LDS_K=0, LDS_V=NSLOT*SLOTB, LDS_WS=2*NSLOT*SLOTB, LDS_OST=LDS_WS+NW*64*4, LDS_BYTES=LDS_OST+NW*4096;
constexpr float C2=0.125f*1.4426950408889634f;
__device__ __forceinline__ void glds16(const void*gsrc,unsigned lds_dst){unsigned keep;
  asm volatile("s_mov_b32 %0, m0\n\ts_mov_b32 m0, %2\n\ts_nop 0\n\tglobal_load_lds_dwordx4 %1, off\n\ts_mov_b32 m0, %0":"=&s"(keep):"v"(gsrc),"s"(lds_dst):"memory");}
__device__ __forceinline__ float max3f(float a,float b,float c){float r;asm("v_max3_f32 %0, %1, %2, %3":"=v"(r):"v"(a),"v"(b),"v"(c));return r;}
__device__ __forceinline__ float max2f(float a,float b){float r;asm("v_max_f32_e32 %0, %1, %2":"=v"(r):"v"(a),"v"(b));return r;}
__device__ __forceinline__ float fadd_s(float a,float b){float r;asm("v_add_f32_e32 %0, %1, %2":"=v"(r):"v"(a),"v"(b));return r;}
__device__ __forceinline__ float fsub_s(float a,float b){float r;asm("v_sub_f32_e32 %0, %1, %2":"=v"(r):"v"(a),"v"(b));return r;}
typedef float f32x2_t __attribute__((ext_vector_type(2))); typedef __bf16 bf16x2_t __attribute__((ext_vector_type(2)));
__device__ __forceinline__ unsigned cvtpk_s(float lo,float hi){f32x2_t v={lo,hi};bf16x2_t b=__builtin_convertvector(v,bf16x2_t);return __builtin_bit_cast(unsigned,b);}
#define WAIT_BAR(N) asm volatile("s_waitcnt vmcnt(" #N ") lgkmcnt(0)\n\ts_barrier":::"memory")

__device__ __forceinline__ void qkt(f32x16&p0,f32x16&p1,const char*Kslot,const bf16x8*qr,const f32x16&negm,int r32,int hi){
  const char*kb=Kslot+hi*1024+r32*16;
  #pragma unroll
  for(int d0=0;d0<4;++d0){
    const bf16x8 b0=*reinterpret_cast<const bf16x8*>(kb+d0*2048);
    const bf16x8 b1=*reinterpret_cast<const bf16x8*>(kb+d0*2048+512);
    if(d0==0){p0=__builtin_amdgcn_mfma_f32_32x32x16_bf16(b0,qr[0],negm,0,0,0);p1=__builtin_amdgcn_mfma_f32_32x32x16_bf16(b1,qr[0],negm,0,0,0);}
    else{p0=__builtin_amdgcn_mfma_f32_32x32x16_bf16(b0,qr[d0],p0,0,0,0);p1=__builtin_amdgcn_mfma_f32_32x32x16_bf16(b1,qr[d0],p1,0,0,0);}}
}
typedef __attribute__((address_space(3))) const char* lds_cptr;
typedef short v4i16_t __attribute__((ext_vector_type(4)));
__device__ __forceinline__ void kload8(bf16x8*kf,lds_cptr kp){
  kf[0]=*(const __attribute__((address_space(3))) bf16x8*)(kp);      kf[1]=*(const __attribute__((address_space(3))) bf16x8*)(kp+512);
  kf[2]=*(const __attribute__((address_space(3))) bf16x8*)(kp+2048); kf[3]=*(const __attribute__((address_space(3))) bf16x8*)(kp+2560);
  kf[4]=*(const __attribute__((address_space(3))) bf16x8*)(kp+4096); kf[5]=*(const __attribute__((address_space(3))) bf16x8*)(kp+4608);
  kf[6]=*(const __attribute__((address_space(3))) bf16x8*)(kp+6144); kf[7]=*(const __attribute__((address_space(3))) bf16x8*)(kp+6656);
}
__device__ __forceinline__ void kload2(bf16x8*kf,lds_cptr kp,int j){ kf[2*j]=*(const __attribute__((address_space(3))) bf16x8*)(kp+j*2048); kf[2*j+1]=*(const __attribute__((address_space(3))) bf16x8*)(kp+j*2048+512); }
__device__ __forceinline__ s16x4 vtr(lds_cptr p){ return __builtin_bit_cast(s16x4,__builtin_amdgcn_ds_read_tr16_b64_v4i16((__attribute__((address_space(3))) v4i16_t*)p)); }
__device__ __forceinline__ float rowmax(const f32x16&p0,const f32x16&p1){
  float a=max3f(p0[0],p0[1],p1[0]),b=max3f(p0[2],p0[3],p1[1]);a=max3f(a,p1[2],p1[3]);
  #pragma unroll
  for(int r=4;r<16;r+=4){a=max3f(a,p0[r],p0[r+1]);b=max3f(b,p0[r+2],p0[r+3]);a=max3f(a,p1[r],p1[r+1]);b=max3f(b,p1[r+2],p1[r+3]);}
  const float m=max2f(a,b);
  auto rr=__builtin_amdgcn_permlane32_swap(__float_as_uint(m),__float_as_uint(m),false,false);
  return max2f(__uint_as_float(rr[0]),__uint_as_float(rr[1]));
}
__device__ __forceinline__ void pv(f32x16*o,int vb,bf16x8 pa0,bf16x8 pa1,bf16x8 pa2,bf16x8 pa3){
  #pragma unroll
  for(int d0=0;d0<2;++d0){s16x4 lo[4],hi[4];
    #pragma unroll
    for(int ks=0;ks<4;++ks){
      asm volatile("ds_read_b64_tr_b16 %0,%1 offset:%c2":"=&v"(lo[ks]):"v"(vb),"i"(d0*4096+ks*1024):"memory");
      asm volatile("ds_read_b64_tr_b16 %0,%1 offset:%c2":"=&v"(hi[ks]):"v"(vb),"i"(d0*4096+ks*1024+512):"memory");}
    asm volatile("s_waitcnt lgkmcnt(0)":::"memory");SBAR();
    #define PK(k) (bf16x8){lo[k][0],lo[k][1],lo[k][2],lo[k][3],hi[k][0],hi[k][1],hi[k][2],hi[k][3]}
    o[d0]=__builtin_amdgcn_mfma_f32_32x32x16_bf16(pa0,PK(0),o[d0],0,0,0);
    o[d0]=__builtin_amdgcn_mfma_f32_32x32x16_bf16(pa1,PK(1),o[d0],0,0,0);
    o[d0]=__builtin_amdgcn_mfma_f32_32x32x16_bf16(pa2,PK(2),o[d0],0,0,0);
    o[d0]=__builtin_amdgcn_mfma_f32_32x32x16_bf16(pa3,PK(3),o[d0],0,0,0);
    #undef PK
  }
}

#ifndef ATTN_STORE16
#define ATTN_STORE16(p,v) (*(u32x4*)(p)=(v))
#endif
template<int THRL> __device__ __forceinline__ void attn_unit(int b,int h,int qb,const bf16*Q,const bf16*__restrict__ K,const bf16*__restrict__ V,bf16*O,const float*__restrict__ KMbh,char*shm,const int wid,const int lane){
  const int r32=lane&31,hi=lane>>5;
  const long rowbase=(long)b*SEQ; const int q0=qb*QB;
  const bf16*Qw=Q+(rowbase+q0+wid*QBLK)*QP+h*D;
  const bf16*Kh=K+rowbase*QP+h*D,*Vh=V+rowbase*QP+h*D;
  unsigned selmask=0u;
  { f32x16 g=f32x16{}; bf16x8 qg[4];
    #pragma unroll
    for(int d0=0;d0<4;++d0)qg[d0]=*reinterpret_cast<const bf16x8*>(&Qw[(long)r32*QP+d0*16+hi*8]);
    #pragma unroll
    for(int d0=0;d0<4;++d0){ const float4 a0=*reinterpret_cast<const float4*>(KMbh+r32*64+d0*16+hi*8), a1=*reinterpret_cast<const float4*>(KMbh+r32*64+d0*16+hi*8+4);
      u32x4 pk; pk[0]=cvtpk_s(a0.x,a0.y); pk[1]=cvtpk_s(a0.z,a0.w); pk[2]=cvtpk_s(a1.x,a1.y); pk[3]=cvtpk_s(a1.z,a1.w);
      g=__builtin_amdgcn_mfma_f32_32x32x16_bf16(__builtin_bit_cast(bf16x8,pk),qg[d0],g,0,0,0); }
    #pragma unroll
    for(int r=0;r<16;++r){ if(crow(r,hi)>=qb) g[r]=-INFINITY; }
    #pragma unroll
    for(int n=0;n<3;++n){ float bv=-INFINITY; int bi=64;
      #pragma unroll
      for(int r=0;r<16;++r){ if(g[r]>bv){bv=g[r];bi=crow(r,hi);} }
      const float pv_=__shfl_xor(bv,32); const int pi_=__shfl_xor(bi,32);
      const bool mine=(bv>pv_)||(bv==pv_&&bi<pi_); const float wv=mine?bv:pv_; const int wi=mine?bi:pi_;
      if(wv>-INFINITY){ selmask|=1u<<wi;
        #pragma unroll
        for(int r=0;r<16;++r){ if(crow(r,hi)==wi) g[r]=-INFINITY; } } }
    selmask|=1u<<qb; }
  asm volatile("":"+v"(selmask)); SBAR();
  const unsigned lds0=(unsigned)(uintptr_t)shm;
  float*wsf=(float*)(shm+LDS_WS)+wid*64;
  const bf16*ksrc=Kh+(long)lane*QP+wid*8;
  const bf16*vsrc=Vh+(long)(16*(wid&3)+(lane>>2))*QP+(wid>>2)*32+(lane&3)*8;
  const unsigned kdst=lds0+LDS_K+wid*1024, vdst=lds0+LDS_V+wid*1024;
  #define DMA_K(t,slot) glds16(ksrc+(long)(t)*KVBLK*QP,(unsigned)__builtin_amdgcn_readfirstlane(kdst+(slot)))
  #define DMA_V(t,slot) glds16(vsrc+(long)(t)*KVBLK*QP,(unsigned)__builtin_amdgcn_readfirstlane(vdst+(slot)))
  const int vb0=(int)(lds0+LDS_V)+((lane>>4)&1)*32+(lane&3)*8+(4*hi+((lane&15)>>2))*64;
  const char*Kbase=shm+LDS_K; bf16x8 kf[8];
  const lds_cptr shm3=(lds_cptr)shm; const lds_cptr kp0=shm3+LDS_K+hi*1024+r32*16; const lds_cptr vp0=shm3+LDS_V+((lane>>4)&1)*32+(lane&3)*8+(4*hi+((lane&15)>>2))*64;
  const int NT=(q0+QB)/KVBLK;
  DMA_K(0,0);DMA_V(0,0);DMA_K(1,SLOTB);
  bf16x8 qr[4];
  #pragma unroll
  for(int d0=0;d0<4;++d0)qr[d0]=*reinterpret_cast<const bf16x8*>(&Qw[(long)r32*QP+d0*16+hi*8]);
  float nok=((selmask&1u)!=0u||qb==0)?0.f:-INFINITY;
  float mhat=0.f,l_reg=0.f;f32x16 o[2];o[0]=f32x16{};o[1]=f32x16{};f32x16 negm;
  _Pragma("unroll") for(int r=0;r<16;++r)negm[r]=nok; asm volatile("":"+v"(negm));
  const int qrel=wid*QBLK+r32;
  #define CMASK(P0,P1,t) do{int jb_=(t)-(NT-4); if(jb_>=0)cmask(P0,P1,jb_,qrel,hi);}while(0)
  bool resc=false;
  #define START(P0,P1) do{ const float rm=rowmax(P0,P1); resc=false; \
    { const float dl=(rm==-INFINITY)?0.f:rm; mhat=fadd_s(mhat,dl); \
      _Pragma("unroll") for(int r=0;r<16;++r){P0[r]=fsub_s(P0[r],dl);P1[r]=fsub_s(P1[r],dl);} \
      { const float cv_=nok-mhat; _Pragma("unroll") for(int r=0;r<16;++r)negm[r]=cv_; } asm volatile("":"+v"(negm)); } \
    _Pragma("unroll") for(int r=0;r<16;++r)P0[r]=__builtin_amdgcn_exp2f(P0[r]); }while(0)
  #define RESC() do{ if(resc){ asm volatile("s_waitcnt lgkmcnt(0)":::"memory"); \
      _Pragma("unroll") for(int d_=0;d_<2;++d_) _Pragma("unroll") for(int r=0;r<16;++r)o[d_][r]*=wsf[crow(r,hi)]; } }while(0)
  f32x16 pA0,pA1,pB0,pB1;
  int sl_prev=0,sl_cur=0,sl_next=SLOTB;
  #define ROT() do{sl_prev=sl_cur;sl_cur=sl_next;sl_next=(sl_next==(NSLOT-1)*SLOTB)?0:sl_next+SLOTB;}while(0)
  DMA_K(2,2*SLOTB);
  WAIT_BAR(3);
  qkt(pA0,pA1,Kbase,qr,negm,r32,hi);asm volatile("s_nop 15\n\ts_nop 7":"+v"(pA0),"+v"(pA1));CMASK(pA0,pA1,0);
  START(pA0,pA1);
  _Pragma("unroll") for(int r=0;r<16;++r)pA1[r]=__builtin_amdgcn_exp2f(pA1[r]);
  WAIT_BAR(0);
  DMA_K(3,0);DMA_V(1,SLOTB);
  ROT();
  kload8(kf,kp0+sl_cur);
  WAIT_BAR(2);
  s16x4 vlo[8],vhi[8]; u32x4 pw0,pw1,pw2,pw3;
  #define PKW(P,B) cvtpk_s(P[B],P[B+1])
  #define PAF(k) __builtin_bit_cast(bf16x8,pw##k)
  #define VFR(i) (bf16x8){vlo[i][0],vlo[i][1],vlo[i][2],vlo[i][3],vhi[i][0],vhi[i][1],vhi[i][2],vhi[i][3]}
  #define PIN(x) asm volatile("":"+v"(x))
  #define MX3(a,b,c) __builtin_fmaxf(__builtin_fmaxf((a),(b)),(c))
  #define GAPA(MF,A0,A1,A2,A3,W0,W1,PW) do{ MF; sacc+=A0; sacc+=A1; sacc+=A2; sacc+=A3; PIN(sacc); W0; W1; PIN(PW); SBAR(); }while(0)
  #define EX(v) __builtin_amdgcn_exp2f(v)
  #define GAPB(MF,X,B) do{ MF; X[B]=EX(X[B]); X[B+1]=EX(X[B+1]); X[B+2]=EX(X[B+2]); X[B+3]=EX(X[B+3]); PIN(X); SBAR(); }while(0)
  #define VRD(i) do{ vlo[i]=vtr(vp_+(((i)>>2)*4096+((i)&3)*1024)); vhi[i]=vtr(vp_+(((i)>>2)*4096+((i)&3)*1024+512)); }while(0)
  #define KRD(G,j) do{ if(G){ kload2(kf,kp0+sl_next,j); SBAR(); } }while(0)
  #define STEP(C0,C1,P0,P1,t,GK,GV,GL) do{ SBAR(); \
    const lds_cptr vp_=vp0+sl_prev; \
    VRD(0); SBAR(); float sacc=(P0[0]+P0[1]); \
    GAPA(C0=__builtin_amdgcn_mfma_f32_32x32x16_bf16(kf[0],qr[0],negm,0,0,0), P0[2],P0[3],P0[4],P0[5],     pw0[0]=PKW(P0,0), pw0[1]=PKW(P0,2), pw0); \
    VRD(4); SBAR(); GAPA(C1=__builtin_amdgcn_mfma_f32_32x32x16_bf16(kf[1],qr[0],negm,0,0,0), P0[6],P0[7],P0[8],P0[9],     pw0[2]=PKW(P0,4), pw0[3]=PKW(P0,6), pw0); \
    VRD(1); SBAR(); GAPA(C0=__builtin_amdgcn_mfma_f32_32x32x16_bf16(kf[2],qr[1],C0,0,0,0),   P0[10],P0[11],P0[12],P0[13], pw1[0]=PKW(P0,8), pw1[1]=PKW(P0,10), pw1); \
    VRD(5); SBAR(); GAPA(C1=__builtin_amdgcn_mfma_f32_32x32x16_bf16(kf[3],qr[1],C1,0,0,0),   P0[14],P0[15],P1[0],P1[1],   pw1[2]=PKW(P0,12),pw1[3]=PKW(P0,14), pw1); \
    VRD(2); SBAR(); GAPA(C0=__builtin_amdgcn_mfma_f32_32x32x16_bf16(kf[4],qr[2],C0,0,0,0),   P1[2],P1[3],P1[4],P1[5],     pw2[0]=PKW(P1,0), pw2[1]=PKW(P1,2), pw2); \
    VRD(6); SBAR(); GAPA(C1=__builtin_amdgcn_mfma_f32_32x32x16_bf16(kf[5],qr[2],C1,0,0,0),   P1[6],P1[7],P1[8],P1[9],     pw2[2]=PKW(P1,4), pw2[3]=PKW(P1,6), pw2); \
    VRD(3); SBAR(); GAPA(C0=__builtin_amdgcn_mfma_f32_32x32x16_bf16(kf[6],qr[3],C0,0,0,0),   P1[10],P1[11],P1[12],P1[13], pw3[0]=PKW(P1,8), pw3[1]=PKW(P1,10), pw3); \
    VRD(7); SBAR(); GAPA(C1=__builtin_amdgcn_mfma_f32_32x32x16_bf16(kf[7],qr[3],C1,0,0,0),   P1[14],P1[15],0.f,0.f,       pw3[2]=PKW(P1,12),pw3[3]=PKW(P1,14), pw3); \
    l_reg+=sacc; \
    if(GK){DMA_K((t)+3,sl_cur);} if(GV){DMA_V((t)+1,sl_next);} \
    CMASK(C0,C1,t); \
    { float a=MX3(C0[0],C0[1],C1[0]),b=MX3(C0[2],C0[3],C1[1]); a=MX3(a,C1[2],C1[3]); \
      _Pragma("unroll") for(int r=4;r<16;r+=4){a=MX3(a,C0[r],C0[r+1]);b=MX3(b,C0[r+2],C0[r+3]);a=MX3(a,C1[r],C1[r+1]);b=MX3(b,C1[r+2],C1[r+3]);} \
      float rm=__builtin_fmaxf(a,b); { auto rr=__builtin_amdgcn_permlane32_swap(__float_as_uint(rm),__float_as_uint(rm),false,false); rm=__builtin_fmaxf(__uint_as_float(rr[0]),__uint_as_float(rr[1])); } \
      resc=false; \
      if(__builtin_expect(__any(rm>(float)THRL),0)){ const float dl=__builtin_fmaxf(rm,0.f); mhat+=dl; \
        _Pragma("unroll") for(int r=0;r<16;++r){C0[r]-=dl;C1[r]-=dl;} \
        { const float cv_=nok-mhat; _Pragma("unroll") for(int r=0;r<16;++r)negm[r]=cv_; } asm volatile("":"+v"(negm)); \
        const float f=__builtin_amdgcn_exp2f(-dl); l_reg*=f; if(hi==0)wsf[r32]=f; resc=true; } } \
    SBAR(); \
    GAPB(o[0]=__builtin_amdgcn_mfma_f32_32x32x16_bf16(PAF(0),VFR(0),o[0],0,0,0), C0,0); \
    GAPB(o[1]=__builtin_amdgcn_mfma_f32_32x32x16_bf16(PAF(0),VFR(4),o[1],0,0,0), C0,4); \
    KRD(GL,0); GAPB(o[0]=__builtin_amdgcn_mfma_f32_32x32x16_bf16(PAF(1),VFR(1),o[0],0,0,0), C0,8); \
    KRD(GL,1); GAPB(o[1]=__builtin_amdgcn_mfma_f32_32x32x16_bf16(PAF(1),VFR(5),o[1],0,0,0), C0,12); \
    KRD(GL,2); GAPB(o[0]=__builtin_amdgcn_mfma_f32_32x32x16_bf16(PAF(2),VFR(2),o[0],0,0,0), C1,0); \
    KRD(GL,3); GAPB(o[1]=__builtin_amdgcn_mfma_f32_32x32x16_bf16(PAF(2),VFR(6),o[1],0,0,0), C1,4); \
    GAPB(o[0]=__builtin_amdgcn_mfma_f32_32x32x16_bf16(PAF(3),VFR(3),o[0],0,0,0), C1,8); \
    GAPB(o[1]=__builtin_amdgcn_mfma_f32_32x32x16_bf16(PAF(3),VFR(7),o[1],0,0,0), C1,12); \
    }while(0)
  #define MASKUPD(tt) do{ if((((tt))&3)==0){ nok=((selmask>>((tt)>>2))&1u)?0.f:-INFINITY; const float cv_=nok-mhat; _Pragma("unroll") for(int r=0;r<16;++r)negm[r]=cv_; asm volatile("":"+v"(negm)); } }while(0)
  int t=1;
  #undef CMASK
  #define CMASK(P0,P1,t) do{}while(0)
  for(;t+5<NT;t+=2){
    STEP(pB0,pB1,pA0,pA1,t,true,true,true);     WAIT_BAR(2); RESC(); ROT(); MASKUPD(t+1);
    STEP(pA0,pA1,pB0,pB1,t+1,true,true,true);   WAIT_BAR(2); RESC(); ROT();
  }
  #undef CMASK
  #define CMASK(P0,P1,t) do{int jb_=(t)-(NT-4); if(jb_>=0)cmask(P0,P1,jb_,qrel,hi);}while(0)
  #define ENDW(tt) do{ if((tt)+3<NT){WAIT_BAR(2);} else if((tt)+2<NT){WAIT_BAR(1);} else {WAIT_BAR(0);} }while(0)
  for(;t+1<NT;t+=2){
    STEP(pB0,pB1,pA0,pA1,t,(t+3<NT),(t+1<NT),(t+1<NT));       ENDW(t);   RESC(); ROT(); MASKUPD(t+1);
    STEP(pA0,pA1,pB0,pB1,t+1,(t+4<NT),(t+2<NT),(t+2<NT));     ENDW(t+1); RESC(); ROT();
  }
  STEP(pB0,pB1,pA0,pA1,NT-1,false,false,false); RESC();
  { float sacc=pB0[0]+pB0[1]; _Pragma("unroll") for(int r=2;r<16;++r)sacc+=pB0[r]; _Pragma("unroll") for(int r=0;r<16;++r)sacc+=pB1[r]; l_reg+=sacc;
    pw0=(u32x4){PKW(pB0,0),PKW(pB0,2),PKW(pB0,4),PKW(pB0,6)};pw1=(u32x4){PKW(pB0,8),PKW(pB0,10),PKW(pB0,12),PKW(pB0,14)};pw2=(u32x4){PKW(pB1,0),PKW(pB1,2),PKW(pB1,4),PKW(pB1,6)};pw3=(u32x4){PKW(pB1,8),PKW(pB1,10),PKW(pB1,12),PKW(pB1,14)};
    SBAR(); pv(o,vb0+sl_cur,PAF(0),PAF(1),PAF(2),PAF(3)); }
  #undef PKW
  #undef PAF
  #undef VFR
  #undef PIN
  #undef MX3
  #undef GAPA
  #undef GAPB
  #undef EX
  #undef VRD
  #undef KRD
  #undef STEP
  #undef ENDW
  #undef MASKUPD
  {auto rr=__builtin_amdgcn_permlane32_swap(__float_as_uint(l_reg),__float_as_uint(l_reg),false,false);l_reg=__uint_as_float(rr[0])+__uint_as_float(rr[1]);}
  if(hi==0)wsf[32+r32]=l_reg;asm volatile("s_waitcnt lgkmcnt(0)":::"memory");
  float rli[16];
  #pragma unroll
  for(int r=0;r<16;++r)rli[r]=__builtin_amdgcn_rcpf(wsf[32+crow(r,hi)]);
  bf16*Ow=O+(rowbase+q0+wid*QBLK)*OP+h*D;
  { bf16*stg=(bf16*)(shm+LDS_OST)+wid*2048;
    #pragma unroll
    for(int r=0;r<16;++r){const int orow=crow(r,hi);
      #pragma unroll
      for(int d0=0;d0<2;++d0)stg[orow*64+d0*32+r32]=(bf16)(cvtpk_s(o[d0][r]*rli[r],0.f)&0xffffu);}
    asm volatile("s_waitcnt lgkmcnt(0)":::"memory");
    #pragma unroll
    for(int i=0;i<4;++i){const int row=i*8+(lane>>3),ch=lane&7; const u32x4 v=*(const u32x4*)(stg+row*64+ch*8); ATTN_STORE16(Ow+(long)row*OP+ch*8,v);} }
  asm volatile("s_waitcnt lgkmcnt(0)\n\ts_barrier":::"memory");
  #undef DMA_K
  #undef DMA_V
  #undef CMASK
  #undef START
  #undef RESC
  #undef ROT
}
constexpr int ATTN_LDS_BYTES=LDS_BYTES;
#undef SBAR
#undef WAIT_BAR
}
namespace rscan {
typedef short bf16x8 __attribute__((ext_vector_type(8)));
typedef float f32x4 __attribute__((ext_vector_type(4)));
typedef float f32x16 __attribute__((ext_vector_type(16)));
typedef unsigned u32x2 __attribute__((ext_vector_type(2)));
typedef unsigned u32x4 __attribute__((ext_vector_type(4)));
constexpr int LB = 8192;
__device__ __forceinline__ int t64(int row, int chunk) { return row * 128 + ((chunk ^ ((row >> 1) & 7)) << 4); }
__device__ __forceinline__ int t128(int row, int chunk) { return row * 256 + ((chunk ^ (row & 15)) << 4); }
constexpr int NCHUNK = T / 64;
__device__ __forceinline__ unsigned pkbf(float lo, float hi) { typedef float f2 __attribute__((ext_vector_type(2))); typedef __bf16 b2 __attribute__((ext_vector_type(2))); f2 v = {lo, hi}; return __builtin_bit_cast(unsigned, __builtin_convertvector(v, b2)); }

__device__ __forceinline__ void mm(f32x4 (&acc)[2], LAS unsigned char* lds, int z1, int z2, int ta, int tbh, int fr, int fq) {
    const int o1 = z1 + t64(16 * ta + fr, fq), o2 = z2 + t64(32 * tbh + fr, fq);
    const bf16x8 a0 = *(const LAS bf16x8*)(lds + o1), a1 = *(const LAS bf16x8*)(lds + (o1 ^ 64));
    const bf16x8 b00 = *(const LAS bf16x8*)(lds + o2), b01 = *(const LAS bf16x8*)(lds + (o2 ^ 64)), b10 = *(const LAS bf16x8*)(lds + o2 + 2048), b11 = *(const LAS bf16x8*)(lds + ((o2 ^ 64) + 2048));
    acc[0] = __builtin_amdgcn_mfma_f32_16x16x32_bf16(a0, b00, acc[0], 0, 0, 0); acc[0] = __builtin_amdgcn_mfma_f32_16x16x32_bf16(a1, b01, acc[0], 0, 0, 0);
    acc[1] = __builtin_amdgcn_mfma_f32_16x16x32_bf16(a0, b10, acc[1], 0, 0, 0); acc[1] = __builtin_amdgcn_mfma_f32_16x16x32_bf16(a1, b11, acc[1], 0, 0, 0);
}
struct Fr { bf16x8 a0, a1, b00, b01, b10, b11; };
__device__ __forceinline__ void ldf(Fr& f, LAS unsigned char* lds, int z1, int z2, int ta, int tbh, int fr, int fq) {
    const int o1 = z1 + t64(16 * ta + fr, fq), o2 = z2 + t64(32 * tbh + fr, fq);
    f.a0 = *(const LAS bf16x8*)(lds + o1); f.a1 = *(const LAS bf16x8*)(lds + (o1 ^ 64));
    f.b00 = *(const LAS bf16x8*)(lds + o2); f.b01 = *(const LAS bf16x8*)(lds + (o2 ^ 64)); f.b10 = *(const LAS bf16x8*)(lds + o2 + 2048); f.b11 = *(const LAS bf16x8*)(lds + ((o2 ^ 64) + 2048));
}
__device__ __forceinline__ void mcf(f32x4 (&acc)[2], const Fr& f) {
    acc[0] = __builtin_amdgcn_mfma_f32_16x16x32_bf16(f.a0, f.b00, acc[0], 0, 0, 0); acc[1] = __builtin_amdgcn_mfma_f32_16x16x32_bf16(f.a0, f.b10, acc[1], 0, 0, 0);
    acc[0] = __builtin_amdgcn_mfma_f32_16x16x32_bf16(f.a1, f.b01, acc[0], 0, 0, 0); acc[1] = __builtin_amdgcn_mfma_f32_16x16x32_bf16(f.a1, f.b11, acc[1], 0, 0, 0);
}
template <int MASK, bool DIAG1> __device__ __forceinline__ void st_lds(const f32x4 (&acc)[2], LAS unsigned char* lds, int dst, int ta, int tbh, int fr, int fq) {
#pragma unroll
    for (int tb = 0; tb < 2; ++tb) { const int b = 32 * tbh + 16 * tb + fr, a0 = 16 * ta + 4 * fq; float v[4];
#pragma unroll
        for (int i = 0; i < 4; ++i) { const int a = a0 + i; float x = acc[tb][i];
            if (MASK == 1) x = (a < b) ? x : 0.f; if (MASK == 2) x = (a <= b) ? x : 0.f; if (MASK == 3) x = (b < a) ? x : 0.f; if (DIAG1) x = (a == b) ? 1.f : x; v[i] = x; }
        u32x2 w; w.x = pkbf(v[0], v[1]); w.y = pkbf(v[2], v[3]); *(LAS u32x2*)(lds + dst + t64(b, a0 >> 3) + (a0 & 4) * 2) = w; }
}
template <bool PERM> __device__ __forceinline__ void st_glb(const f32x4 (&acc)[2], bf16* g, int ta, int tbh, int fr, int fq) {
#pragma unroll
    for (int tb = 0; tb < 2; ++tb) { const int b = 32 * tbh + 16 * tb + fr; int a0 = 16 * ta + 4 * fq; if (PERM) a0 = (a0 & ~12) | ((a0 & 4) << 1) | ((a0 & 8) >> 1);
        u32x2 w; w.x = pkbf(acc[tb][0], acc[tb][1]); w.y = pkbf(acc[tb][2], acc[tb][3]); *(GAS u32x2*)(g + (size_t)b * RW + a0) = w; }
}

__device__ __forceinline__ float wsum_fast(float x) { x = red16(x);
    x += __builtin_bit_cast(float, __builtin_amdgcn_update_dpp(0, __builtin_bit_cast(int, x), 0x142, 0xa, 0xf, false));
    x += __builtin_bit_cast(float, __builtin_amdgcn_update_dpp(0, __builtin_bit_cast(int, x), 0x143, 0xc, 0xf, false));
    return __builtin_bit_cast(float, __builtin_amdgcn_readlane(__builtin_bit_cast(int, x), 63)); }
__device__ __forceinline__ void pk_acc(u32x2 (&d)[2], const f32x4 (&acc)[2]) {
#pragma unroll
    for (int tb = 0; tb < 2; ++tb) { d[tb].x = pkbf(acc[tb][0], acc[tb][1]); d[tb].y = pkbf(acc[tb][2], acc[tb][3]); }
}
template <bool PERM> __device__ __forceinline__ void st_pk(const u32x2 (&d)[2], bf16* g, int ta, int tbh, int fr, int fq) {
#pragma unroll
    for (int tb = 0; tb < 2; ++tb) { const int b = 32 * tbh + 16 * tb + fr; int a0 = 16 * ta + 4 * fq; if (PERM) a0 = (a0 & ~12) | ((a0 & 4) << 1) | ((a0 & 8) >> 1);
        *(GAS u32x2*)(g + (size_t)b * RW + a0) = d[tb]; }
}
constexpr int LS2 = 272;
__device__ __forceinline__ void mm128(f32x4 (&acc)[2], LAS unsigned char* lds, int z1, int z2, int ta, int tbh, int fr, int fq) {
#pragma unroll
    for (int s = 0; s < 4; ++s) { const bf16x8 a = *(const LAS bf16x8*)(lds + z1 + t128(16 * ta + fr, 4 * s + fq)), b0 = *(const LAS bf16x8*)(lds + z2 + t128(32 * tbh + fr, 4 * s + fq)), b1 = *(const LAS bf16x8*)(lds + z2 + t128(32 * tbh + 16 + fr, 4 * s + fq));
        acc[0] = __builtin_amdgcn_mfma_f32_16x16x32_bf16(a, b0, acc[0], 0, 0, 0); acc[1] = __builtin_amdgcn_mfma_f32_16x16x32_bf16(a, b1, acc[1], 0, 0, 0); }
}
__device__ __forceinline__ void st_lds_f32(const f32x4 (&acc)[2], LAS unsigned char* lds, int dst, int ta, int tbh, int fr, int fq) {
#pragma unroll
    for (int tb = 0; tb < 2; ++tb) { const int b = 32 * tbh + 16 * tb + fr, a0 = 16 * ta + 4 * fq; *(LAS f32x4*)(lds + dst + b * LS2 + a0 * 4) = acc[tb]; }
}

__device__ __forceinline__ void scan_pre(Frame& F) {
    LAS unsigned char* lds = F.lds + RING_OFF;
    const int w = F.wave, lane = F.lane, fr = lane & 15, fq = lane >> 4, ta = w & 3, tbh = w >> 2;
    const bf16* Z = (const bf16*)(F.ws + WS_Z); const float* mu = INP(4);
    const bf16* WupT = (const bf16*)(F.ws + WS_LORA); const bf16* AupT = WupT + RW * 64; const bf16* GupT = AupT + RW * 64;
    bf16* aLW = (bf16*)(F.dout + DO_W); bf16* aKP = (bf16*)(F.dout + DO_KP); bf16* aKK = (bf16*)(F.dout + DO_KKN); bf16* aB = (bf16*)(F.dout + DO_B);
    bf16* oG = (bf16*)(F.ws + WS_GATE); float* oBon = (float*)(F.ws + WS_BON);
    enum { bAt = 0, bBt = LB, bKt = 2 * LB, bRt = 3 * LB, bAtT = 4 * LB, bVT = 5 * LB, bBhT = 6 * LB, bKhT = 7 * LB, b8 = 8 * LB, b9 = 9 * LB, b10 = 10 * LB, bAak = 11 * LB, bArb = 12 * LB, bArk = 13 * LB };
    enum { lXw = 0, lXa = LB, lXg = 2 * LB, lWw = 4 * LB, lWa = 5 * LB, lWg = 6 * LB, lDw = 8 * LB, lDa = lDw + 64 * LS2, lDg = lDa + 64 * LS2, lSum = lDg + 64 * LS2 };
    static_assert(lWg + 2 * LB <= 8 * LB && lSum + 2048 <= RING_BYTES, "LoRA stage LDS carve");
#ifdef PROBE_SEG
    unsigned long long sg_[8] = {0, 0, 0, 0, 0, 0, 0, 0}, sgt_;
#define SEG0() sgt_ = __builtin_amdgcn_s_memrealtime()
#define SEG(j) do { const unsigned long long n_ = __builtin_amdgcn_s_memrealtime(); sg_[j] += n_ - sgt_; sgt_ = n_; } while (0)
#else
#define SEG0() do {} while (0)
#define SEG(j) do {} while (0)
#endif
    const float* pW0 = INP(5); const float* pA0 = INP(7); const float* pKK = INP(10); const float* pKA = INP(11); const float* pRK = INP(12);
    enum { lMu = lSum + 2048 };
    static_assert(lMu + 1024 <= RING_BYTES, "LDS carve");
    if (F.tid < 256) *(LAS float*)(lds + lMu + F.tid * 4) = mu[ZWD + F.tid];
    __syncthreads();
    float hp[8];
    u32x4 cur[4], prv[4], wpf[4]; unsigned short zr_[9], zk_[9], zv_[9];
    u32x2 dq[4][2]; size_t dso = 0; bool dpend = false;
#define PF_ISSUE(uu) do { const int c_ = (uu) % NCHUNK, bh_ = (uu) / NCHUNK, b_ = bh_ / NH, h_ = bh_ % NH; const size_t m0_ = (size_t)b_ * T + (size_t)c_ * 64; \
        { const int row_ = F.tid >> 3, ch_ = F.tid & 7; wpf[0] = *(const GAS u32x4*)(WupT + (size_t)(h_ * HD + row_) * 64 + ch_ * 8); wpf[1] = *(const GAS u32x4*)(AupT + (size_t)(h_ * HD + row_) * 64 + ch_ * 8); \
          wpf[2] = *(const GAS u32x4*)(GupT + (size_t)(h_ * HD + (F.tid >> 4)) * 128 + (F.tid & 15) * 8); wpf[3] = *(const GAS u32x4*)(GupT + (size_t)(h_ * HD + 32 + (F.tid >> 4)) * 128 + (F.tid & 15) * 8); } \
        { const int t_ = F.tid >> 3, g0_ = F.tid & 7; const bf16* zrow = Z + (m0_ + t_) * NIN + ZWD; const bool firstrow = (c_ == 0 && t_ == 0); \
          _Pragma("unroll") for (int i = 0; i < 4; ++i) { cur[i] = *(const GAS u32x4*)(zrow + 8 * (g0_ + 8 * i)); prv[i] = (u32x4){0u, 0u, 0u, 0u}; if (!firstrow) prv[i] = *(const GAS u32x4*)(zrow - (long)NIN + 8 * (g0_ + 8 * i)); } } \
        { const int cg_ = h_ * HD + lane; hp[0] = pW0[cg_]; hp[1] = pA0[cg_]; hp[2] = pKK[cg_]; hp[3] = pKA[cg_]; hp[4] = pRK[cg_]; hp[5] = mu[cg_]; hp[6] = mu[ZK_R + cg_]; hp[7] = mu[ZV_R + cg_]; } \
        { const bf16* zr = Z + (m0_ + 8 * w) * NIN + h_ * HD + lane; const bool first = (c_ == 0 && w == 0); \
          zr_[0] = 0; zk_[0] = 0; zv_[0] = 0; if (!first) { zr_[0] = zr[-(long)NIN]; zk_[0] = zr[-(long)NIN + ZK_R]; zv_[0] = zr[-(long)NIN + ZV_R]; } \
          _Pragma("unroll") for (int i = 0; i < 8; ++i) { zr_[i + 1] = zr[(size_t)i * NIN]; zk_[i + 1] = zr[(size_t)i * NIN + ZK_R]; zv_[i + 1] = zr[(size_t)i * NIN + ZV_R]; } } } while (0)
    if (F.vcu < BATCH * NH * NCHUNK) PF_ISSUE(F.vcu);
    for (int u = F.vcu; u < BATCH * NH * NCHUNK; u += F.G) {
        SEG0();
        const int c = u % NCHUNK, bh = u / NCHUNK, b = bh / NH, h = bh % NH;
        const size_t m0 = (size_t)b * T + (size_t)c * 64;
        const size_t so = m0 * RW + h * HD;
        { const int t = F.tid >> 3, g0 = F.tid & 7;
          { const int row = F.tid >> 3, ch = F.tid & 7;
            *(LAS u32x4*)(lds + lWw + t64(row, ch)) = wpf[0]; *(LAS u32x4*)(lds + lWa + t64(row, ch)) = wpf[1]; }
          { const int row = F.tid >> 4, ch = F.tid & 15; *(LAS u32x4*)(lds + lWg + t128(row, ch)) = wpf[2]; *(LAS u32x4*)(lds + lWg + t128(row + 32, ch)) = wpf[3]; }
#pragma unroll
          for (int i = 0; i < 4; ++i) { const int col0 = 8 * (g0 + 8 * i); const f32x4 ma = *(const LAS f32x4*)(lds + lMu + col0 * 4), mb = *(const LAS f32x4*)(lds + lMu + col0 * 4 + 16);
              float z[8];
#pragma unroll
              for (int q = 0; q < 4; ++q) { const unsigned cw = cur[i][q], pw = prv[i][q]; const float c0 = bflo(cw), c1 = bfhi(cw), p0 = bflo(pw), p1 = bfhi(pw);
                  const float m0_ = q < 2 ? ma[2 * q] : mb[2 * q - 4], m1_ = q < 2 ? ma[2 * q + 1] : mb[2 * q - 3];
                  z[2 * q] = c0 + (p0 - c0) * m0_; z[2 * q + 1] = c1 + (p1 - c1) * m1_; }
#pragma unroll
              for (int q = 0; q < 8; ++q) { if (i == 0) z[q] = 1.f - 2.f * __builtin_amdgcn_rcpf(1.f + __expf(2.f * z[q])); else if (i >= 2) z[q] = __builtin_amdgcn_rcpf(1.f + __expf(-z[q])); }
              u32x4 o; o.x = pkbf(z[0], z[1]); o.y = pkbf(z[2], z[3]); o.z = pkbf(z[4], z[5]); o.w = pkbf(z[6], z[7]);
              const int dst = i == 0 ? lXw + t64(t, g0) : (i == 1 ? lXa + t64(t, g0) : lXg + t128(t, (i - 2) * 8 + g0));
              *(LAS u32x4*)(lds + dst) = o; }
        }
        __syncthreads(); SEG(0);
        { f32x4 acc[2];
          acc[0] = (f32x4){0.f, 0.f, 0.f, 0.f}; acc[1] = acc[0]; mm(acc, lds, lWw, lXw, ta, tbh, fr, fq); st_lds_f32(acc, lds, lDw, ta, tbh, fr, fq);
          acc[0] = (f32x4){0.f, 0.f, 0.f, 0.f}; acc[1] = acc[0]; mm(acc, lds, lWa, lXa, ta, tbh, fr, fq); st_lds_f32(acc, lds, lDa, ta, tbh, fr, fq);
          acc[0] = (f32x4){0.f, 0.f, 0.f, 0.f}; acc[1] = acc[0]; mm128(acc, lds, lWg, lXg, ta, tbh, fr, fq); st_lds_f32(acc, lds, lDg, ta, tbh, fr, fq); }
        __syncthreads(); SEG(1);
        if (dpend) { st_pk<false>(dq[0], aLW + dso, ta, tbh, fr, fq); st_pk<false>(dq[1], aKK + dso, ta, tbh, fr, fq); st_pk<true>(dq[2], aKP + dso, ta, tbh, fr, fq); st_pk<false>(dq[3], aB + dso, ta, tbh, fr, fq); }
        { const int cg = h * HD + lane;
          const float w0_ = hp[0], a0_ = hp[1], kkc = hp[2], kac = hp[3], rkc = hp[4], mur = hp[5], muk = hp[6], muv = hp[7];
          float lwv[8], e_at[8], e_bb[8], e_kp[8], e_r[8], e_v[8]; float lsum = 0.f;
#pragma unroll
          for (int i = 0; i < 8; ++i) { const int t = 8 * w + i;
              const float cr = bf2f(zr_[i + 1]), ck = bf2f(zk_[i + 1]), cv = bf2f(zv_[i + 1]), pr = bf2f(zr_[i]), pk = bf2f(zk_[i]), pv = bf2f(zv_[i]);
              const float r = cr + (pr - cr) * mur, kx = ck + (pk - ck) * muk, v = cv + (pv - cv) * muv;
              const float dw = w0_ + *(const LAS float*)(lds + lDw + t * LS2 + lane * 4), da = a0_ + *(const LAS float*)(lds + lDa + t * LS2 + lane * 4), gg = *(const LAS float*)(lds + lDg + t * LS2 + lane * 4);
              const float lw = -DECAY_SCALE * __builtin_amdgcn_rcpf(1.f + __expf(-dw)), a = __builtin_amdgcn_rcpf(1.f + __expf(-da));
              const float kk = kx * kkc; const float nn = wsum_fast(kk * kk); const float kkn = kk * __builtin_amdgcn_rsqf(fmaxf(nn, 1e-24f));
              const float kp = kx * (1.f + (a - 1.f) * kac), bb = kkn * a; const float bon = wsum_fast(r * kp * rkc);
              oG[(m0 + t) * RW + cg] = (bf16)f2bf(gg); if (lane == 0) oBon[(m0 + t) * NH + h] = bon;
              lwv[i] = lw; lsum += lw; e_at[i] = -kkn; e_bb[i] = bb; e_kp[i] = kp; e_r[i] = r; e_v[i] = v; }
          *(LAS float*)(lds + lSum + (w * 64 + lane) * 4) = lsum;
          __syncthreads(); SEG(2);
          if (u + F.G < BATCH * NH * NCHUNK) PF_ISSUE(u + F.G);
          float ltot = 0.f, lst = 0.f;
#pragma unroll
          for (int q = 0; q < 8; ++q) { const float sq = *(const LAS float*)(lds + lSum + (q * 64 + lane) * 4); if (q < w) lst += sq; ltot += sq; }
          float L = lst; unsigned short pAtT[8], pVT[8], pBhT[8], pKhT[8];
#pragma unroll
          for (int i = 0; i < 8; ++i) { const int t = 8 * w + i;
              const float Pm = __expf(L); L += lwv[i]; const float P = __expf(L), iP = __expf(-L), Ph = __expf(ltot - L);
              const unsigned short at = (unsigned short)f2bf(e_at[i] * Pm);
              const int eo = t64(t, lane >> 3) + (lane & 7) * 2;
              *(LAS unsigned short*)(lds + bAt + eo) = at; *(LAS unsigned short*)(lds + bBt + eo) = (unsigned short)f2bf(e_bb[i] * iP);
              *(LAS unsigned short*)(lds + bKt + eo) = (unsigned short)f2bf(e_kp[i] * iP); *(LAS unsigned short*)(lds + bRt + eo) = (unsigned short)f2bf(e_r[i] * P);
              pAtT[i] = at; pVT[i] = (unsigned short)f2bf(e_v[i]); pBhT[i] = (unsigned short)f2bf(e_bb[i] * Ph); pKhT[i] = (unsigned short)f2bf(e_kp[i] * Ph); }
#define RS_W16(buf, p) do { u32x4 q_; q_.x = p[0] | ((unsigned)p[1] << 16); q_.y = p[2] | ((unsigned)p[3] << 16); q_.z = p[4] | ((unsigned)p[5] << 16); q_.w = p[6] | ((unsigned)p[7] << 16); *(LAS u32x4*)(lds + (buf) + t64(lane, w)) = q_; } while (0)
          RS_W16(bAtT, pAtT); RS_W16(bVT, pVT); RS_W16(bBhT, pBhT); RS_W16(bKhT, pKhT);
#undef RS_W16
          asm volatile("" :: "v"(ltot));
          __syncthreads(); SEG(3);
          f32x4 acc[2], acc2[2], acc3[2], acc4[2], tacc[2];
#define RS_Z(a) do { a[0] = (f32x4){0.f, 0.f, 0.f, 0.f}; a[1] = (f32x4){0.f, 0.f, 0.f, 0.f}; } while (0)
#define LD(f, z1, z2) ldf(f, lds, z1, z2, ta, tbh, fr, fq)
#define ST(m, a, dst) st_lds<m, false>(a, lds, dst, ta, tbh, fr, fq)
          { Fr f0, f1, f2; LD(f0, bAt, bBt); LD(f1, bKt, bAt); LD(f2, bBt, bRt);
            RS_Z(acc); RS_Z(acc2); RS_Z(acc3); mcf(acc, f0); mcf(acc2, f1); mcf(acc3, f2);
            ST(3, acc, b9);
            ST(1, acc2, bAak);
            ST(2, acc3, bArb); }
          { Fr f3, f4; LD(f3, bKt, bRt); LD(f4, bBt, bAt); RS_Z(acc4); RS_Z(tacc); mcf(acc4, f3); mcf(tacc, f4);
            ST(2, acc4, bArk); }
#pragma unroll
          for (int tb = 0; tb < 2; ++tb)
#pragma unroll
              for (int i = 0; i < 4; ++i) { const int bb_ = 32 * tbh + 16 * tb + fr, a = 16 * ta + 4 * fq + i; tacc[tb][i] = (a < bb_) ? tacc[tb][i] : 0.f; }
          ST(0, tacc, b8);
#pragma unroll
          for (int tb = 0; tb < 2; ++tb)
#pragma unroll
              for (int i = 0; i < 4; ++i) { const int bb_ = 32 * tbh + 16 * tb + fr, a = 16 * ta + 4 * fq + i; if (a == bb_) tacc[tb][i] = 1.f; }
          ST(0, tacc, b10);
          __syncthreads();
          { Fr f0, f1; LD(f0, b9, b8); LD(f1, b8, b9); RS_Z(acc); RS_Z(acc2); mcf(acc, f0); mcf(acc2, f1); ST(0, acc, bAt); ST(0, acc2, bBt); }
          __syncthreads();
          { Fr f0, f1, f2; LD(f0, bBt, b10); LD(f1, bBt, bAt); LD(f2, bAt, bBt); RS_Z(acc); RS_Z(acc2); mcf(tacc, f0); mcf(acc, f1); mcf(acc2, f2); ST(0, tacc, bKt); ST(0, acc, b8); ST(0, acc2, b9); }
          __syncthreads();
          { Fr f0, f1, f2; LD(f0, b9, bKt); LD(f1, b9, b8); LD(f2, b8, b9); RS_Z(acc); RS_Z(acc2); mcf(tacc, f0); mcf(acc, f1); mcf(acc2, f2); ST(0, tacc, b10); ST(0, acc, bAt); ST(0, acc2, bBt); }
          __syncthreads();
          { Fr f0, f1, f2; LD(f0, bBt, b10); LD(f1, bBt, bAt); LD(f2, bAt, bBt); RS_Z(acc); RS_Z(acc2); mcf(tacc, f0); mcf(acc, f1); mcf(acc2, f2); ST(0, tacc, bKt); ST(0, acc, b8); ST(0, acc2, b9); }
          __syncthreads();
          { Fr f0, f1; LD(f0, b9, bKt); LD(f1, b8, b9); RS_Z(acc); mcf(tacc, f0); mcf(acc, f1); ST(0, tacc, b10); ST(0, acc, bBt); }
          __syncthreads();
          { Fr f0; LD(f0, bBt, b10); mcf(tacc, f0); ST(0, tacc, bKt); }
          __syncthreads(); SEG(4);
          { Fr f0, f1; LD(f0, bKt, bAtT); LD(f1, bAak, bVT); RS_Z(acc); RS_Z(acc2); mcf(acc, f0); mcf(acc2, f1); ST(0, acc, bAt); ST(0, acc2, b8); }
          __syncthreads();
          { Fr f0; LD(f0, bKt, b8); RS_Z(acc); mcf(acc, f0); ST(0, acc, b9); }
          __syncthreads();
          { Fr f0, f1, f2; LD(f0, bAt, bArb); LD(f1, b9, bArb); LD(f2, bVT, bArk);
            u32x2 rq[2];
#pragma unroll
            for (int tb = 0; tb < 2; ++tb) { const int bb_ = 32 * tbh + 16 * tb + fr, a0 = 16 * ta + 4 * fq; rq[tb] = *(const LAS u32x2*)(lds + bRt + t64(bb_, a0 >> 3) + (a0 & 4) * 2); }
            RS_Z(acc); mcf(acc, f0);
#pragma unroll
            for (int tb = 0; tb < 2; ++tb) { acc[tb][0] += bflo(rq[tb].x); acc[tb][1] += bfhi(rq[tb].x); acc[tb][2] += bflo(rq[tb].y); acc[tb][3] += bfhi(rq[tb].y); }
            pk_acc(dq[0], acc);
            RS_Z(acc2); mcf(acc2, f1); mcf(acc2, f2); pk_acc(dq[1], acc2); }
          { Fr f3, f4, f5; LD(f3, bAt, bBhT); LD(f4, bBhT, b9); LD(f5, bKhT, bVT);
            RS_Z(acc3); mcf(acc3, f3);
            { const float pc = __expf(ltot);
#pragma unroll
              for (int tb = 0; tb < 2; ++tb) { const int bb_ = 32 * tbh + 16 * tb + fr; const float pcb = __shfl(pc, bb_);
#pragma unroll
                  for (int i = 0; i < 4; ++i) { const int a = 16 * ta + 4 * fq + i; if (a == bb_) acc3[tb][i] += pcb; } } }
            pk_acc(dq[2], acc3);
            RS_Z(acc4); mcf(acc4, f4); mcf(acc4, f5); pk_acc(dq[3], acc4); dso = so; dpend = true; }
#undef LD
#undef ST
#undef RS_Z
          __syncthreads(); SEG(5);
        }
    }
#undef PF_ISSUE
    if (dpend) { st_pk<false>(dq[0], aLW + dso, ta, tbh, fr, fq); st_pk<false>(dq[1], aKK + dso, ta, tbh, fr, fq); st_pk<true>(dq[2], aKP + dso, ta, tbh, fr, fq); st_pk<false>(dq[3], aB + dso, ta, tbh, fr, fq); }
#ifdef PROBE_SEG
    if (blockIdx.x == 0 && threadIdx.x == 0) { unsigned long long* st = (unsigned long long*)(F.ws + WS_CTL + 65536); st[40] = 0; st[41] = sg_[PROBE_SEG]; }
#endif
}

__device__ __forceinline__ void scan_seq(Frame& F, int bh) {
    LAS unsigned char* lds = F.lds + RING_OFF;
    const int lane = F.lane, w = F.wave, r32 = lane & 31, hi = lane >> 5; const int b = bh / NH, h = bh % NH;
    const bf16* aM = (const bf16*)(F.dout + DO_KP); const bf16* aN = (const bf16*)(F.dout + DO_B); bf16* XS = (bf16*)(F.ws + WS_YRAW);
    bf16x8 am[2][2][2]; u32x2 nn[2][2][4];
#define SQ_LOAD(cc) do { const size_t so_ = ((size_t)b * T + (size_t)(cc) * 64) * RW + h * HD; \
        _Pragma("unroll") for (int t1 = 0; t1 < 2; ++t1) _Pragma("unroll") for (int t2 = 0; t2 < 2; ++t2) _Pragma("unroll") for (int s = 0; s < 2; ++s) \
            am[t1][t2][s] = *(const GAS bf16x8*)(aM + so_ + (size_t)(32 * t1 + r32) * RW + 32 * t2 + 16 * s + 8 * hi); \
        _Pragma("unroll") for (int tk = 0; tk < 2; ++tk) _Pragma("unroll") for (int tv = 0; tv < 2; ++tv) _Pragma("unroll") for (int g = 0; g < 4; ++g) \
            nn[tk][tv][g] = *(const GAS u32x2*)(aN + so_ + (size_t)(32 * tv + r32) * RW + 32 * tk + 8 * g + 4 * hi); } while (0)
    SQ_LOAD(w);
    for (int i = F.tid; i < 8192 / 16; i += 512) *(LAS u32x4*)(lds + i * 16) = (u32x4){0u, 0u, 0u, 0u};
    for (int i = 0; i < NCHUNK / 8; ++i) {
#pragma unroll 1
        for (int t = 0; t < 8; ++t) {
            const int c = 8 * i + t;
            __syncthreads();
            if (t == w) {
                const int rb = (c & 1) * 8192, wb = 8192 - rb;
                bf16* xs = XS + ((size_t)bh * NCHUNK + c) * 4096;
                bf16x8 xb[2][2][2];
#pragma unroll
                for (int tk = 0; tk < 2; ++tk)
#pragma unroll
                    for (int tv = 0; tv < 2; ++tv)
#pragma unroll
                        for (int s = 0; s < 2; ++s) xb[tk][tv][s] = *(const LAS bf16x8*)(lds + rb + (((tk * 2 + tv) * 2 + s) * 1024) + lane * 16);
#pragma unroll
                for (int tk = 0; tk < 2; ++tk)
#pragma unroll
                    for (int tv = 0; tv < 2; ++tv)
#pragma unroll
                        for (int s = 0; s < 2; ++s) { const u32x4 q_ = __builtin_bit_cast(u32x4, xb[tk][tv][s]); u32x2 lo_, hi_; lo_.x = q_.x; lo_.y = q_.y; hi_.x = q_.z; hi_.y = q_.w;
                            bf16* rowp = xs + (size_t)(32 * tv + r32) * 64 + 32 * tk + 16 * s + 4 * hi; *(GAS u32x2*)(rowp) = lo_; *(GAS u32x2*)(rowp + 8) = hi_; }
#pragma unroll
                for (int t1 = 0; t1 < 2; ++t1)
#pragma unroll
                    for (int tv = 0; tv < 2; ++tv) { f32x16 a;
#pragma unroll
                        for (int g = 0; g < 4; ++g) { const u32x2 q_ = nn[t1][tv][g]; a[4 * g + 0] = bflo(q_.x); a[4 * g + 1] = bfhi(q_.x); a[4 * g + 2] = bflo(q_.y); a[4 * g + 3] = bfhi(q_.y); }
#pragma unroll
                        for (int t2 = 0; t2 < 2; ++t2)
#pragma unroll
                            for (int s = 0; s < 2; ++s) a = __builtin_amdgcn_mfma_f32_32x32x16_bf16(am[t1][t2][s], xb[t2][tv][s], a, 0, 0, 0);
                        u32x4 f0, f1; f0.x = pkbf(a[0], a[1]); f0.y = pkbf(a[2], a[3]); f0.z = pkbf(a[4], a[5]); f0.w = pkbf(a[6], a[7]); f1.x = pkbf(a[8], a[9]); f1.y = pkbf(a[10], a[11]); f1.z = pkbf(a[12], a[13]); f1.w = pkbf(a[14], a[15]);
                        *(LAS u32x4*)(lds + wb + (((t1 * 2 + tv) * 2 + 0) * 1024) + lane * 16) = f0; *(LAS u32x4*)(lds + wb + (((t1 * 2 + tv) * 2 + 1) * 1024) + lane * 16) = f1; }
                if (c + 8 < NCHUNK) SQ_LOAD(c + 8);
            }
        }
    }
    __syncthreads();
#undef SQ_LOAD
}

__device__ __forceinline__ void scan_post(Frame& F) {
    const int lane = F.lane, fr = lane & 15, fq = lane >> 4, tb = F.wave & 3;
    const bf16* aRh = (const bf16*)(F.dout + DO_W); const bf16* aYl = (const bf16*)(F.dout + DO_KKN); const bf16* XS = (const bf16*)(F.ws + WS_YRAW);
    const bf16* Zb = (const bf16*)(F.ws + WS_Z); const float* mu = INP(4); const bf16* aG = (const bf16*)(F.ws + WS_GATE); const float* bon = (const float*)(F.ws + WS_BON);
    bf16* Y = (bf16*)(F.ws + WS_Y); const float* lnw = INP(13); const float* lnb = INP(14);
    for (int u = F.vcu * 2 + (F.wave >> 2); u < BATCH * NH * NCHUNK; u += F.G * 2) {
        const int c = u % NCHUNK, bh = u / NCHUNK, b = bh / NH, h = bh % NH;
        const size_t m0 = (size_t)b * T + (size_t)c * 64, so = m0 * RW + h * HD;
        const bf16* xs = XS + (size_t)u * 4096;
        const size_t trow = m0 + 16 * tb + fr;
        bf16x8 bf_[2];
#pragma unroll
        for (int s = 0; s < 2; ++s) bf_[s] = *(const GAS bf16x8*)(aRh + trow * RW + h * HD + 32 * s + 8 * fq);
        f32x4 acc[4];
#pragma unroll
        for (int ta = 0; ta < 4; ++ta) { const u32x2 q_ = *(const GAS u32x2*)(aYl + trow * RW + h * HD + 16 * ta + 4 * fq);
            acc[ta] = (f32x4){bflo(q_.x), bfhi(q_.x), bflo(q_.y), bfhi(q_.y)};
#pragma unroll
            for (int s = 0; s < 2; ++s) { const bf16x8 af = *(const GAS bf16x8*)(xs + (size_t)(16 * ta + fr) * 64 + 32 * s + 8 * fq); acc[ta] = __builtin_amdgcn_mfma_f32_16x16x32_bf16(af, bf_[s], acc[ta], 0, 0, 0); } }
        float s1 = 0.f;
#pragma unroll
        for (int ta = 0; ta < 4; ++ta) s1 += (acc[ta][0] + acc[ta][1]) + (acc[ta][2] + acc[ta][3]);
        s1 += __shfl_xor(s1, 16); s1 += __shfl_xor(s1, 32); const float mean = s1 * (1.f / 64.f); float s2 = 0.f;
#pragma unroll
        for (int ta = 0; ta < 4; ++ta)
#pragma unroll
            for (int i = 0; i < 4; ++i) { const float d_ = acc[ta][i] - mean; acc[ta][i] = d_; s2 += d_ * d_; }
        s2 += __shfl_xor(s2, 16); s2 += __shfl_xor(s2, 32); const float rstd = 1.f / sqrtf(s2 * (1.f / 64.f) + GN_EPS);
        const float bn = bon[trow * NH + h];
#pragma unroll
        for (int ta = 0; ta < 4; ++ta) { const int ch = h * HD + 16 * ta + 4 * fq; const f32x4 lw4 = *(const GAS f32x4*)(lnw + ch), lb4 = *(const GAS f32x4*)(lnb + ch);
            const u32x2 vc = *(const GAS u32x2*)(Zb + trow * NIN + ZV_R + ch), gq = *(const GAS u32x2*)(aG + trow * RW + ch); u32x2 vp; vp.x = 0u; vp.y = 0u;
            if ((trow % T) != 0) vp = *(const GAS u32x2*)(Zb + (trow - 1) * NIN + ZV_R + ch);
            const f32x4 mv = *(const GAS f32x4*)(mu + ZV_R + ch);
            const float v0 = bflo(vc.x) + (bflo(vp.x) - bflo(vc.x)) * mv[0], v1 = bfhi(vc.x) + (bfhi(vp.x) - bfhi(vc.x)) * mv[1], v2 = bflo(vc.y) + (bflo(vp.y) - bflo(vc.y)) * mv[2], v3 = bfhi(vc.y) + (bfhi(vp.y) - bfhi(vc.y)) * mv[3];
            const float o0 = (acc[ta][0] * rstd * lw4[0] + lb4[0] + bn * v0) * bflo(gq.x), o1 = (acc[ta][1] * rstd * lw4[1] + lb4[1] + bn * v1) * bfhi(gq.x);
            const float o2 = (acc[ta][2] * rstd * lw4[2] + lb4[2] + bn * v2) * bflo(gq.y), o3 = (acc[ta][3] * rstd * lw4[3] + lb4[3] + bn * v3) * bfhi(gq.y);
            u32x2 w_; w_.x = pkbf(o0, o1); w_.y = pkbf(o2, o3); *(GAS u32x2*)(Y + trow * D + ch) = w_; }
    }
}
}
using pg8::Unit;
constexpr size_t TILE_B = 256 * 2;
struct SchedBase { int G, c; };
struct SchedZ : SchedBase {
    __device__ __forceinline__ bool next(int i, Unit& u) const {
        const int L = i * G + c; constexpr int NZ = (M / 256) * (NIN / 256), NKV = (MEMR / 256) * (2 * D / 256);
        if (L < NZ) { pg8::tile_map(L, M / 256, NIN / 256, u.pm, u.pn); u.z = 0; u.a_off = WS_XN + (size_t)u.pm * 256 * D * 2; u.b_off = WS_WIN_T + (size_t)u.pn * 256 * D * 2; return true; }
        if (L < NZ + NKV) { const int l = L - NZ; u.pm = l / 8; u.pn = l % 8; u.z = 1; u.a_off = WS_MEMN + (size_t)u.pm * 256 * D * 2; u.b_off = WS_WXKV_T + (size_t)u.pn * 256 * D * 2; return true; }
        return false;
    }
};
struct SchedG : SchedBase {
    __device__ __forceinline__ bool next(int i, Unit& u) const {
        const int L = i * G + c; if (L >= 64) return false;
        u.z = L >> 4; u.pm = (L >> 2) & 3; u.pn = L & 3; u.a_off = WS_KV + ((size_t)u.pm * 256 * 2048 + u.z * 256) * 2; u.b_off = WS_WQ_S + ((size_t)u.pn * 256 * 1024 + u.z * 256) * 2; return true;
    }
};
struct SchedVW : SchedBase {
    __device__ __forceinline__ bool next(int i, Unit& u) const {
        const int L = i * G + (G - 1 - c); if (L >= 64) return false;
        u.z = L >> 2; u.pm = L & 3; u.pn = 0; const int b = u.z >> 2, h = u.z & 3;
        u.a_off = WS_WO_T + ((size_t)u.pm * 256 * 1024 + h * 256) * 2; u.b_off = WS_KV + ((size_t)b * 256 * 2048 + 1024 + h * 256) * 2; return true;
    }
};
struct SchedMN : SchedBase {
    int nN; size_t a_base, b_base; int lda, ldb, bsel;
    __device__ __forceinline__ bool next(int i, Unit& u) const {
        const int L = i * G + c; if (L >= (M / 256) * nN) return false;
        pg8::tile_map(L, M / 256, nN, u.pm, u.pn); u.z = 0;
        u.a_off = a_base + (size_t)u.pm * 256 * lda * 2; u.b_off = b_base + ((size_t)u.pn * 256 + (bsel ? (size_t)(u.pm >> 5) * 1024 : 0)) * ldb * 2; return true;
    }
};

constexpr int CW_MQ = 8192;
__device__ __forceinline__ void moba_attn_phase(Frame& F, int bx) {
    const bf16* Z = (const bf16*)(F.ws + WS_Z); bf16* Y = (bf16*)(F.ws + WS_Y) + RW; const float* KM = (const float*)(F.ws + WS_KMEAN);
    const bool perx = (F.G % 8 == 0); const int x = perx ? (bx & 7) : 0; const int nun = perx ? 128 : 1024;
    unsigned* qc = (unsigned*)(F.ctl + CW_MQ + 64 * x);
    volatile LAS unsigned* slot = F.MISC + 16;
    for (int it = 0;; ++it) {
        if (F.tid == 0) slot[it & 1] = __hip_atomic_fetch_add(qc, 1u, __ATOMIC_RELAXED, __HIP_MEMORY_SCOPE_AGENT);
        asm volatile("s_waitcnt vmcnt(0) lgkmcnt(0)" ::: "memory"); __builtin_amdgcn_s_barrier(); asm volatile("" ::: "memory");
        const int idx = __builtin_amdgcn_readfirstlane((int)slot[it & 1]);
        if (idx >= nun) break;
        const int bh = perx ? x * 4 + (idx & 3) : (idx & 31), qb = perx ? 31 - (idx >> 2) : 31 - (idx >> 5);
        int ln = F.lane; asm volatile("" : "+v"(ln)); ln &= 63;
        attn_body::attn_unit<8>(bh / NH, bh % NH, qb, Z + ZQ, Z + ZK, Z + ZV, Y, KM + (size_t)bh * NBLK * HD, (char*)F.lds + RING_OFF, F.wave, ln);
    }
}

#ifndef MK_N_LAUNCHES
#define MK_N_LAUNCHES 1
#endif
constexpr int PER_PHASE = 12;
constexpr int N_LAUNCHES = MK_N_LAUNCHES;
constexpr int SCAN_WGS = 64;
struct Args { const float* in[25]; float* out; unsigned char* ws; int ph_lo, ph_hi, li, pad; };
__global__ void __launch_bounds__(NWAVES * 64, 2) skel_fwd(Args args) {
    extern __shared__ __attribute__((aligned(16))) unsigned char lds[];
    Frame F;
    F.lds = (LAS unsigned char*)lds;
    F.MISC = (volatile LAS unsigned*)(F.lds + MISC_OFF);
    F.tid = threadIdx.x; F.lane = F.tid & 63; F.wave = __builtin_amdgcn_readfirstlane(F.tid >> 6) & 7;
    F.G = gridDim.x; { const int bx = blockIdx.x; F.vcu = (F.G % 8 == 0) ? (bx % 8) * (F.G / 8) + bx / 8 : bx; }
    F.ws = args.ws; F.dout = (unsigned char*)args.out;
#pragma unroll
    for (int i = 0; i < 25; ++i) F.in[i] = args.in[i];
    F.ctl = (gu32*)(F.ws + WS_CTL);
    for (int u = F.tid; u < (EPI_LDS_OFF - LDSCTL_OFF) / 4; u += NWAVES * 64) ((LAS unsigned*)(F.lds + LDSCTL_OFF))[u] = 0u;
    __syncthreads();
    XcdBarrier bar; bar.bar = (unsigned*)(F.ctl + CW_BAR); bar.x = 0; bar.st = nullptr;
    if (N_LAUNCHES == 1) bar = xcd_barrier_post((unsigned*)(F.ctl + CW_BAR), F.MISC + 8);
#ifdef PROBE_PHASE
    unsigned long long* stamps = (unsigned long long*)(F.ws + WS_CTL + 65536); int nst = 0;
#define STAMP() do { if (blockIdx.x == 0 && threadIdx.x == 0) stamps[nst] = __builtin_amdgcn_s_memrealtime(); ++nst; } while (0)
#else
#define STAMP() do {} while (0)
#endif
#define GRID_BAR() do { if (N_LAUNCHES == 1) xcd_barrier(bar); STAMP(); } while (0)
    const int lo = args.ph_lo, hi = args.ph_hi;
#ifndef PHASE_MASK
#define PHASE_MASK 0xFFFF
#endif
#define IN(k) (((PHASE_MASK >> (k)) & 1) && lo <= (k) && (k) < hi)
#define BOTH(k) (IN(k) && IN((k) + 1))
#define FRESH() do { int l_; asm volatile("v_mbcnt_lo_u32_b32 %0, -1, 0\n\tv_mbcnt_hi_u32_b32 %0, -1, %0" : "=v"(l_)); F.lane = l_ & 63; F.tid = F.wave * 64 + F.lane; } while (0)
    const char* wsc = (const char*)F.ws;
    const int bx = (int)blockIdx.x;

    STAMP();
    if (IN(0)) { FRESH(); if (blockIdx.x == 0 && F.tid == 0) { _Pragma("unroll") for (int i = 0; i < 25; ++i) ((GAS unsigned long long*)(F.ws + WS_TAB))[i] = (unsigned long long)F.in[i]; }
        p0_prologue(F); if (BOTH(0)) GRID_BAR(); }
    if (IN(1)) {
        pg8::Gemm g{wsc, wsc, D, D, D}; SchedZ S; S.G = F.G; S.c = bx;
        pg8::EpiStoreBf16 E{(bf16*)(F.ws + WS_Z), NIN, (bf16*)(F.ws + WS_KV), 2 * D, ZQ / 256, attn_body::C2, 0};
        pg8::gemm_phase<pg8::EpiStoreBf16, SchedZ, true>(F.lds + RING_OFF, g, S, E, F.wave);
        if (BOTH(1)) GRID_BAR();
    }
    if (IN(2)) {
        { pg8::Gemm g{wsc, wsc, 2 * D, D, 256}; SchedG S; S.G = F.G; S.c = bx;
          pg8::EpiStoreBf16 E{(bf16*)(F.ws + WS_GT), D, nullptr, 0, 0, 1.f, 1};
          pg8::gemm_phase<pg8::EpiStoreBf16, SchedG, true>(F.lds + RING_OFF, g, S, E, F.wave); }
        { pg8::Gemm g{wsc, wsc, D, 2 * D, 256}; SchedVW S; S.G = F.G; S.c = bx;
          pg8::EpiStoreBf16 E{(bf16*)(F.ws + WS_VWT), D, nullptr, 0, 0, 1.f, 2};
          pg8::gemm_phase<pg8::EpiStoreBf16, SchedVW, true>(F.lds + RING_OFF, g, S, E, F.wave); }
        __syncthreads();
        FRESH(); kmean_simple(F);
        if (BOTH(2)) GRID_BAR();
    }
    if (IN(3)) { FRESH(); rscan::scan_pre(F); if (BOTH(3)) GRID_BAR(); }
    if (IN(4)) {
        FRESH();
#ifdef PROBE_SEQ
        { unsigned long long t0_ = __builtin_amdgcn_s_memrealtime();
          if (bx < BATCH * NH) rscan::scan_seq(F, bx);
          if (blockIdx.x == 0 && threadIdx.x == 0) { unsigned long long* st = (unsigned long long*)(F.ws + WS_CTL + 65536); st[41] = __builtin_amdgcn_s_memrealtime() - t0_; } }
#else
        if (bx < BATCH * NH) rscan::scan_seq(F, bx);
#endif
        moba_attn_phase(F, bx);
        if (BOTH(4)) GRID_BAR();
    }
    if (IN(5)) { FRESH(); rscan::scan_post(F); if (BOTH(5)) GRID_BAR(); }
    if (IN(6)) {
        pg8::Gemm g{wsc, wsc, D, D, D}; SchedMN S; S.G = F.G; S.c = bx; S.nN = D / 256; S.a_base = WS_Y; S.b_base = WS_WMIX_T; S.lda = D; S.ldb = D; S.bsel = 0;
        pg8::EpiRes<false, false> E{INP(0), nullptr, nullptr, (bf16*)(F.ws + WS_HB), (float*)(F.ws + WS_SS), D};
        pg8::gemm_phase<pg8::EpiRes<false, false>, SchedMN, true>(F.lds + RING_OFF, g, S, E, F.wave);
        if (BOTH(6)) GRID_BAR();
    }
    if (IN(7)) {
        pg8::Gemm g{wsc, wsc, D, D, D}; SchedMN S; S.G = F.G; S.c = bx; S.nN = D / 256; S.a_base = WS_HB; S.b_base = WS_GT; S.lda = D; S.ldb = D; S.bsel = 1;
        pg8::EpiSoftmax E{(bf16*)(F.ws + WS_P), D, (const float*)(F.ws + WS_SS), (PG8_LAS pg8::f32x2*)(F.lds + EPI_LDS_OFF)};
        pg8::gemm_phase<pg8::EpiSoftmax, SchedMN, true>(F.lds + RING_OFF, g, S, E, F.wave);
        if (BOTH(7)) GRID_BAR();
    }
    if (IN(8)) {
        pg8::Gemm g{wsc, wsc, D, D, D}; SchedMN S; S.G = F.G; S.c = bx; S.nN = D / 256; S.a_base = WS_P; S.b_base = WS_VWT; S.lda = D; S.ldb = D; S.bsel = 1;
        pg8::EpiRes<true, false> E{nullptr, (const bf16*)(F.ws + WS_HB), nullptr, (bf16*)(F.ws + WS_HB), (float*)(F.ws + WS_SS) + (size_t)M * 16, D};
        pg8::gemm_phase<pg8::EpiRes<true, false>, SchedMN, true>(F.lds + RING_OFF, g, S, E, F.wave);
        if (BOTH(8)) GRID_BAR();
    }
    if (IN(9)) {
        pg8::Gemm g{wsc, wsc, D, D, D}; SchedMN S; S.G = F.G; S.c = bx; S.nN = FF / 256; S.a_base = WS_HB; S.b_base = WS_W1_T; S.lda = D; S.ldb = D; S.bsel = 0;
        pg8::EpiSqRelu E{(bf16*)(F.ws + WS_AH), FF, (const float*)(F.ws + WS_SS) + (size_t)M * 16};
        pg8::gemm_phase<pg8::EpiSqRelu, SchedMN, true>(F.lds + RING_OFF, g, S, E, F.wave);
        if (BOTH(9)) GRID_BAR();
    }
    if (IN(10)) {
        pg8::Gemm g{wsc, wsc, FF, FF, FF}; SchedMN S; S.G = F.G; S.c = bx; S.nN = D / 256; S.a_base = WS_AH; S.b_base = WS_W2_T; S.lda = FF; S.ldb = FF; S.bsel = 0;
        pg8::EpiRes<true, false> E{nullptr, (const bf16*)(F.ws + WS_HB), nullptr, (bf16*)(F.ws + WS_HB), (float*)(F.ws + WS_SS) + (size_t)2 * M * 16, D};
        pg8::gemm_phase<pg8::EpiRes<true, false>, SchedMN, true>(F.lds + RING_OFF, g, S, E, F.wave);
        if (BOTH(10)) GRID_BAR();
    }
    if (IN(11)) { FRESH();
#ifdef PROBE_PHASE
        float pscale; { const unsigned long long* st = (const unsigned long long*)(F.ws + WS_CTL + 65536);
#if defined(PROBE_SEG) || defined(PROBE_SEQ)
          pscale = 1.f + (float)(st[41]) * 1e-6f; }
#else
          pscale = 1.f + (float)(st[PROBE_PHASE + 1] - st[PROBE_PHASE]) * 1e-6f; }
#endif
        final_norm(F, pscale);
#else
        final_norm(F, 1.f);
#endif
    }
#undef IN
#undef BOTH
}

extern "C" void kernel_launch(void* const* d_in, const int* in_sizes, int n_in, void* d_out, int out_size, void* d_ws, size_t ws_size, hipStream_t stream) {
    static int grid = 0;
    if (grid == 0) {
        if (n_in != 25 || in_sizes[0] != M * D || out_size != M * D || ws_size < WS_END) { fprintf(stderr, "kernel_launch: unexpected problem (n_in %d, in0 %d, out %d, ws %zu); nothing launched\n", n_in, n_in > 0 ? in_sizes[0] : -1, out_size, ws_size); grid = -1; return; }
        int dev = 0, cus = 0, per_cu = 0;
        if (hipGetDevice(&dev) != hipSuccess || hipDeviceGetAttribute(&cus, hipDeviceAttributeMultiprocessorCount, dev) != hipSuccess) { grid = -1; return; }
        if (hipFuncSetAttribute((const void*)skel_fwd, hipFuncAttributeMaxDynamicSharedMemorySize, LDS_BYTES) != hipSuccess) { fprintf(stderr, "kernel_launch: hipFuncSetAttribute failed\n"); grid = -1; return; }
        if (hipOccupancyMaxActiveBlocksPerMultiprocessor(&per_cu, (const void*)skel_fwd, NWAVES * 64, LDS_BYTES) != hipSuccess || per_cu < 1)
            fprintf(stderr, "kernel_launch: note: occupancy query reports %d workgroups per CU\n", per_cu);
        (void)hipGetLastError();
        grid = cus;
    }
    if (grid < 0) return;
    if (hipMemsetAsync((char*)d_ws + WS_CTL, 0, CTL_ZERO_BYTES, stream) != hipSuccess) { fprintf(stderr, "kernel_launch: hipMemsetAsync failed\n"); return; }
    Args a{};
    for (int i = 0; i < 25; ++i) a.in[i] = (const float*)d_in[i];
    a.out = (float*)d_out; a.ws = (unsigned char*)d_ws;
    for (int li = 0; li < N_LAUNCHES; ++li) {
        a.ph_lo = (N_LAUNCHES == PER_PHASE) ? li : 0; a.ph_hi = (N_LAUNCHES == PER_PHASE) ? li + 1 : PER_PHASE; a.li = li;
        hipLaunchKernelGGL(skel_fwd, dim3(grid), dim3(NWAVES * 64), LDS_BYTES, stream, a);
        const hipError_t le = hipPeekAtLastError();
        if (le != hipSuccess) { fprintf(stderr, "kernel_launch: launch %d failed: %s\n", li, hipGetErrorName(le)); break; }
    }
}
```

```cpp
#include <hip/hip_runtime.h>
#include <cstdio>
#include <cstdint>
#include <cmath>
namespace pg8 {
#define PG8_LAS __attribute__((address_space(3)))
typedef unsigned short bf16_t;
typedef short bf16x8 __attribute__((ext_vector_type(8)));
typedef float f32x4 __attribute__((ext_vector_type(4)));
typedef float f32x2 __attribute__((ext_vector_type(2)));
typedef unsigned u32x4 __attribute__((ext_vector_type(4)));
typedef unsigned u32x2 __attribute__((ext_vector_type(2)));
constexpr int BM = 256, BK = 64, HALF = 128, HTB = HALF * BK * 2  , STAGE_BYTES = 8 * HTB, NXCD = 8, WGM = 8;

__host__ __device__ __forceinline__ int lds_byte(int r, int c) { const int st = (r >> 4) * 2 + (c >> 5), rr = r & 15, cc = c & 31, ob = rr * 64 + cc * 2; return st * 1024 + (ob ^ (((ob >> 9) & 1) << 5)); }
__host__ __device__ __forceinline__ void stage_rc(int b, int& R, int& C) { const int st = b / 1024, sb = b % 1024, swz = sb ^ (((sb >> 9) & 1) << 5); R = (st >> 1) * 16 + swz / 64; C = (st & 1) * 32 + (swz % 64) / 2; }
__host__ __device__ __forceinline__ int perm32(int rho) { const int n = rho >> 4, i = rho & 15; return 8 * (i >> 2) + 4 * n + (i & 3); }

struct Unit { int pm, pn, z; size_t a_off, b_off; };
struct Gemm { const char* A; const char* Bt; int lda, ldb, K; };

__host__ __device__ __forceinline__ void tile_map(int L, int nM, int nN, int& pm, int& pn) {
    const int nwg = nM * nN; int wgid = L;
    { const int q = nwg / NXCD, r = nwg % NXCD, xcd = wgid % NXCD, off = wgid / NXCD; wgid = (xcd < r ? xcd * (q + 1) : r * (q + 1) + (xcd - r) * q) + off; }
    const int nig = WGM * nN, gid = wgid / nig, fm = gid * WGM, gsz = (nM - fm) < WGM ? (nM - fm) : WGM;
    pm = fm + ((wgid % nig) % gsz); pn = (wgid % nig) / gsz;
}

__device__ __forceinline__ unsigned cvt_pk_bf16(float lo, float hi) { unsigned r; asm volatile("v_cvt_pk_bf16_f32 %0, %1, %2" : "=v"(r) : "v"(lo), "v"(hi)); return r; }

template <class Epi, class Sched, bool ALIGN_EPI>
__device__ __forceinline__ void gemm_phase(PG8_LAS unsigned char* lds, const Gemm g, const Sched& S, const Epi& E, const int wid_) {
    int lane_; asm volatile("v_mbcnt_lo_u32_b32 %0, -1, 0\n\tv_mbcnt_hi_u32_b32 %0, -1, %0" : "=v"(lane_));
    const int lane = lane_ & 63, wid = wid_ & 7, tid = wid * 64 + lane, wr = wid >> 2, wc = wid & 3, fr = lane & 15, fq = lane >> 4;
    const int K = g.K, nt = K / BK;
    unsigned voffA[2], voffB[2];
#pragma unroll
    for (int i = 0; i < 2; ++i) { int R, C; stage_rc(tid * 16 + i * 8192, R, C); const int Rb = Epi::PERM ? ((R & ~31) + perm32(R & 31)) : R;
        voffA[i] = (unsigned)(R * g.lda + C) * 2u; voffB[i] = (unsigned)(Rb * g.ldb + C) * 2u; }
    const size_t kstep = (size_t)(BK * 2);
    const size_t hstepA = (size_t)HALF * g.lda * 2, hstepB = (size_t)HALF * g.ldb * 2;
    const unsigned ldsw = (unsigned)wid * 1024u;
    const int aoff = lds_byte(wr * 64 + fr, fq * 8), boff = lds_byte(wc * 32 + fr, fq * 8);
#define PG8_SA(b, h) (((b) * 2 + (h)) * HTB)
#define PG8_SB(b, h) ((4 + (b) * 2 + (h)) * HTB)
#define PG8_STAGE(bufoff, gbase, voff) do { _Pragma("unroll") for (int _i = 0; _i < 2; ++_i) \
        __builtin_amdgcn_global_load_lds((const unsigned*)((const char*)(gbase) + (voff)[_i]), (PG8_LAS unsigned*)(lds + (bufoff) + ldsw + _i * 8192), 16, 0, 0); } while (0)
#define PG8_LDA(dst, b, h) do { _Pragma("unroll") for (int m = 0; m < 4; ++m) _Pragma("unroll") for (int k = 0; k < 2; ++k) dst[m][k] = *(const PG8_LAS bf16x8*)(lds + PG8_SA(b, h) + aoff + m * 2048 + k * 1024); } while (0)
#define PG8_LDB(dst, b, h) do { _Pragma("unroll") for (int n = 0; n < 2; ++n) _Pragma("unroll") for (int k = 0; k < 2; ++k) dst[n][k] = *(const PG8_LAS bf16x8*)(lds + PG8_SB(b, h) + boff + n * 2048 + k * 1024); } while (0)
#define PG8_MMA(ai, bj, At, Bt) do { __builtin_amdgcn_s_setprio(1); _Pragma("unroll") for (int m = 0; m < 4; ++m) _Pragma("unroll") for (int n = 0; n < 2; ++n) _Pragma("unroll") for (int k = 0; k < 2; ++k) \
        acc[ai][bj][m][n] = __builtin_amdgcn_mfma_f32_16x16x32_bf16(Bt[n][k], At[m][k], acc[ai][bj][m][n], 0, 0, 0); __builtin_amdgcn_s_setprio(0); } while (0)
#define PG8_WAIT_V(n) asm volatile("s_waitcnt vmcnt(" #n ")" ::: "memory")
#define PG8_WAIT_L(n) asm volatile("s_waitcnt lgkmcnt(" #n ")" ::: "memory")
#define PG8_BAR __builtin_amdgcn_s_barrier()
#define PG8_SCHED __builtin_amdgcn_sched_barrier(0)
    Unit cur, nxt; int ui = 0;
    if (!S.next(0, cur)) return;
    f32x4 acc[2][2][4][2];
#pragma unroll
    for (int a = 0; a < 2; ++a)
#pragma unroll
        for (int b = 0; b < 2; ++b)
#pragma unroll
            for (int m = 0; m < 4; ++m)
#pragma unroll
                for (int n = 0; n < 2; ++n) acc[a][b][m][n] = (f32x4){0.f, 0.f, 0.f, 0.f};
    bf16x8 At[4][2], B0[2][2], B1[2][2];
    const char* cA = g.A + cur.a_off; const char* cB = g.Bt + cur.b_off;
    PG8_STAGE(PG8_SB(0, 0), cB, voffB); PG8_STAGE(PG8_SB(0, 1), cB + hstepB, voffB); PG8_STAGE(PG8_SA(0, 0), cA, voffA); PG8_STAGE(PG8_SA(0, 1), cA + hstepA, voffA);
    if (wr == 1) PG8_BAR;
    PG8_WAIT_V(2); PG8_BAR;
    PG8_STAGE(PG8_SB(1, 0), cB + kstep, voffB); PG8_STAGE(PG8_SA(1, 0), cA + kstep, voffA); PG8_STAGE(PG8_SB(1, 1), cB + hstepB + kstep, voffB);
    PG8_WAIT_V(6); PG8_BAR;
    for (;;) {
        const bool has_next = S.next(ui + 1, nxt);
        const char* nA = has_next ? g.A + nxt.a_off : cA; const char* nB = has_next ? g.Bt + nxt.b_off : cB;
        for (int t = 0; t < nt; t += 2) {
            const bool last = (t == nt - 2);
            const char* a1 = cA + (size_t)(t + 1) * kstep;
            const char* a2 = last ? nA : cA + (size_t)(t + 2) * kstep; const char* b2 = last ? nB : cB + (size_t)(t + 2) * kstep;
            const char* a3 = a2 + kstep; const char* b3 = b2 + kstep;
            PG8_LDB(B0, 0, 0); PG8_LDB(B1, 0, 1); PG8_SCHED; PG8_LDA(At, 0, 0); PG8_STAGE(PG8_SA(1, 1), a1 + hstepA, voffA);
            PG8_WAIT_V(8); PG8_WAIT_L(0); PG8_BAR; PG8_MMA(0, 0, At, B0); PG8_MMA(0, 1, At, B1); PG8_BAR; PG8_SCHED;
            PG8_LDA(At, 0, 1); PG8_STAGE(PG8_SB(0, 0), b2, voffB); PG8_STAGE(PG8_SB(0, 1), b2 + hstepB, voffB); PG8_STAGE(PG8_SA(0, 0), a2, voffA);
            PG8_WAIT_V(8); PG8_WAIT_L(0); PG8_BAR; PG8_MMA(1, 0, At, B0); PG8_MMA(1, 1, At, B1); PG8_BAR; PG8_SCHED;
            PG8_LDB(B0, 1, 0); PG8_LDB(B1, 1, 1); PG8_SCHED; PG8_LDA(At, 1, 0); PG8_STAGE(PG8_SA(0, 1), a2 + hstepA, voffA);
            PG8_WAIT_V(8); PG8_WAIT_L(0); PG8_BAR; PG8_MMA(0, 0, At, B0); PG8_MMA(0, 1, At, B1); PG8_BAR; PG8_SCHED;
            PG8_LDA(At, 1, 1); PG8_STAGE(PG8_SB(1, 0), b3, voffB); PG8_STAGE(PG8_SB(1, 1), b3 + hstepB, voffB); PG8_STAGE(PG8_SA(1, 0), a3, voffA);
            PG8_WAIT_V(8); PG8_WAIT_L(0); PG8_BAR; PG8_MMA(1, 0, At, B0); PG8_MMA(1, 1, At, B1); PG8_BAR; PG8_SCHED;
        }
        if constexpr (ALIGN_EPI) { if (wr == 0) PG8_BAR; }
        E(acc, cur, wr, wc, fr, fq, lane);
        if (!has_next) break;
#pragma unroll
        for (int a = 0; a < 2; ++a)
#pragma unroll
            for (int b = 0; b < 2; ++b)
#pragma unroll
                for (int m = 0; m < 4; ++m)
#pragma unroll
                    for (int n = 0; n < 2; ++n) acc[a][b][m][n] = (f32x4){0.f, 0.f, 0.f, 0.f};
        cur = nxt; cA = nA; cB = nB; ++ui;
        if constexpr (ALIGN_EPI) { if (wr == 1) PG8_BAR; }
    }
    PG8_WAIT_V(0);
    if constexpr (!ALIGN_EPI) { if (wr == 0) PG8_BAR; }
    PG8_BAR;
#undef PG8_SA
#undef PG8_SB
#undef PG8_STAGE
#undef PG8_LDA
#undef PG8_LDB
#undef PG8_MMA
#undef PG8_WAIT_V
#undef PG8_WAIT_L
#undef PG8_BAR
#undef PG8_SCHED
}
}
namespace pg8 {
struct EpiStoreBf16 {
    static constexpr bool PERM = true;
    bf16_t* O0; int ldc0; bf16_t* O1; int ldc1; int qs_lo; float qscale;
    int mode;
    __device__ __forceinline__ void operator()(const f32x4 (&acc)[2][2][4][2], const Unit& u, int wr, int wc, int fr, int fq, int lane) const {
        asm volatile("" : "+v"(fr), "+v"(fq), "+v"(lane));
        bf16_t* base; int ldc; size_t row0; int colt;
        if (mode == 0) { base = u.z ? O1 : O0; ldc = u.z ? ldc1 : ldc0; row0 = (size_t)u.pm * BM; colt = u.pn * BM; }
        else if (mode == 1) { base = O0; ldc = ldc0; row0 = (size_t)u.pm * 1024 + (size_t)u.z * 256; colt = u.pn * BM; }
        else { base = O0 + (size_t)(u.z >> 2) * 1048576; ldc = ldc0; row0 = (size_t)u.pm * BM; colt = (u.z & 3) * 256; }
        const float sc = (mode == 0 && u.z == 0 && (u.pn == qs_lo || u.pn == qs_lo + 1)) ? qscale : 1.f;
        const int col0 = colt + wc * 32 + 8 * fq;
#pragma unroll
        for (int ai = 0; ai < 2; ++ai)
#pragma unroll
            for (int m = 0; m < 4; ++m) { bf16_t* rowp = base + (row0 + wr * 64 + fr + ai * HALF + m * 16) * ldc + col0;
#pragma unroll
                for (int bj = 0; bj < 2; ++bj) { const f32x4 v0 = acc[ai][bj][m][0] * sc, v1 = acc[ai][bj][m][1] * sc;
                    u32x4 w; w.x = cvt_pk_bf16(v0[0], v0[1]); w.y = cvt_pk_bf16(v0[2], v0[3]); w.z = cvt_pk_bf16(v1[0], v1[1]); w.w = cvt_pk_bf16(v1[2], v1[3]);
                    *(u32x4*)(rowp + bj * HALF) = w; } }
    }
};

__device__ __forceinline__ float row_rstd(const float* ss, size_t row) {
    const f32x4* p = (const f32x4*)(ss + row * 16); const f32x4 a = p[0], b = p[1], c = p[2], d = p[3];
    const float s = ((a[0] + a[1]) + (a[2] + a[3])) + ((b[0] + b[1]) + (b[2] + b[3])) + ((c[0] + c[1]) + (c[2] + c[3])) + ((d[0] + d[1]) + (d[2] + d[3]));
    return 1.0f / sqrtf(s * (1.0f / 1024.0f) + 1e-6f);
}
__device__ __forceinline__ void wave_rstd(float (&rs)[2][4], const float* ss, int pm, int wr, int fr, int lane) {
    const float my0 = row_rstd(ss, (size_t)pm * BM + wr * 64 + lane), my1 = row_rstd(ss, (size_t)pm * BM + HALF + wr * 64 + lane);
#pragma unroll
    for (int m = 0; m < 4; ++m) { rs[0][m] = __shfl(my0, m * 16 + fr); rs[1][m] = __shfl(my1, m * 16 + fr); }
}

template <bool BASE_BF16, bool OUT_F32> struct EpiRes {
    static constexpr bool PERM = false;
    const float* base; const bf16_t* baseb; float* out; bf16_t* hb; float* ss; int ldc;
    __device__ __forceinline__ void operator()(f32x4 (&acc)[2][2][4][2], const Unit& u, int wr, int wc, int fr, int fq, int lane) const {
        asm volatile("" : "+v"(fr), "+v"(fq), "+v"(lane));
        const int col0 = u.pn * BM + wc * 32 + 4 * fq;
#pragma unroll
        for (int ai = 0; ai < 2; ++ai)
#pragma unroll
            for (int m = 0; m < 4; ++m) { const size_t row = (size_t)u.pm * BM + ai * HALF + wr * 64 + m * 16 + fr; const size_t off = row * ldc + col0; float q = 0.f;
#pragma unroll
                for (int bj = 0; bj < 2; ++bj)
#pragma unroll
                    for (int n = 0; n < 2; ++n) { f32x4 bs;
                        if (BASE_BF16) { const u32x2 b2 = *(const u32x2*)(baseb + off + bj * HALF + n * 16); bs = (f32x4){__builtin_bit_cast(float, b2.x << 16), __builtin_bit_cast(float, b2.x & 0xffff0000u), __builtin_bit_cast(float, b2.y << 16), __builtin_bit_cast(float, b2.y & 0xffff0000u)}; }
                        else bs = *(const f32x4*)(base + off + bj * HALF + n * 16);
                        const f32x4 o = bs + acc[ai][bj][m][n];
                        if (OUT_F32) *(f32x4*)(out + off + bj * HALF + n * 16) = o;
                        q += (o[0] * o[0] + o[1] * o[1]) + (o[2] * o[2] + o[3] * o[3]);
                        u32x2 w; w.x = cvt_pk_bf16(o[0], o[1]); w.y = cvt_pk_bf16(o[2], o[3]); *(u32x2*)(hb + off + bj * HALF + n * 16) = w; }
                q += __shfl_xor(q, 16); q += __shfl_xor(q, 32);
                if (fq == 0) ss[row * 16 + u.pn * 4 + wc] = q;
                if (m & 1) asm volatile("" ::: "memory"); }
    }
};

struct EpiSqRelu {
    static constexpr bool PERM = true;
    bf16_t* O; int ldc; const float* ss;
    __device__ __forceinline__ void operator()(const f32x4 (&acc)[2][2][4][2], const Unit& u, int wr, int wc, int fr, int fq, int lane) const {
        asm volatile("" : "+v"(fr), "+v"(fq), "+v"(lane));
        float rs[2][4]; wave_rstd(rs, ss, u.pm, wr, fr, lane);
        const int col0 = u.pn * BM + wc * 32 + 8 * fq;
#pragma unroll
        for (int ai = 0; ai < 2; ++ai)
#pragma unroll
            for (int m = 0; m < 4; ++m) { bf16_t* rowp = O + ((size_t)u.pm * BM + wr * 64 + fr + ai * HALF + m * 16) * ldc + col0; const float s = rs[ai][m];
#pragma unroll
                for (int bj = 0; bj < 2; ++bj) { f32x4 v0 = acc[ai][bj][m][0] * s, v1 = acc[ai][bj][m][1] * s;
#pragma unroll
                    for (int i = 0; i < 4; ++i) { const float a = fmaxf(v0[i], 0.f), b = fmaxf(v1[i], 0.f); v0[i] = a * a; v1[i] = b * b; }
                    u32x4 w; w.x = cvt_pk_bf16(v0[0], v0[1]); w.y = cvt_pk_bf16(v0[2], v0[3]); w.z = cvt_pk_bf16(v1[0], v1[1]); w.w = cvt_pk_bf16(v1[2], v1[3]);
                    *(u32x4*)(rowp + bj * HALF) = w; } }
    }
};

struct EpiSoftmax {
    static constexpr bool PERM = true;
    bf16_t* O; int ldc; const float* ss; PG8_LAS f32x2* xl;
    __device__ __forceinline__ void operator()(f32x4 (&acc)[2][2][4][2], const Unit& u, int wr, int wc, int fr, int fq, int lane) const {
        asm volatile("" : "+v"(fr), "+v"(fq), "+v"(lane));
        float rs[2][4]; wave_rstd(rs, ss, u.pm, wr, fr, lane);
#pragma unroll
        for (int ai = 0; ai < 2; ++ai)
#pragma unroll
            for (int m = 0; m < 4; ++m) { const float s = rs[ai][m] * (0.0625f * 1.4426950408889634f); float mx = -INFINITY;
#pragma unroll
                for (int bj = 0; bj < 2; ++bj)
#pragma unroll
                    for (int n = 0; n < 2; ++n) { f32x4 v = acc[ai][bj][m][n] * s; acc[ai][bj][m][n] = v; mx = fmaxf(fmaxf(mx, fmaxf(v[0], v[1])), fmaxf(v[2], v[3])); }
                mx = fmaxf(mx, __shfl_xor(mx, 16)); mx = fmaxf(mx, __shfl_xor(mx, 32)); float sm = 0.f;
#pragma unroll
                for (int bj = 0; bj < 2; ++bj)
#pragma unroll
                    for (int n = 0; n < 2; ++n) { f32x4 v = acc[ai][bj][m][n];
#pragma unroll
                        for (int i = 0; i < 4; ++i) { v[i] = __builtin_amdgcn_exp2f(v[i] - mx); sm += v[i]; } acc[ai][bj][m][n] = v; }
                sm += __shfl_xor(sm, 16); sm += __shfl_xor(sm, 32);
                if (fq == 0) xl[(ai * HALF + wr * 64 + m * 16 + fr) * 4 + wc] = (f32x2){mx, sm}; }
        asm volatile("s_waitcnt lgkmcnt(0)" ::: "memory"); __builtin_amdgcn_s_barrier(); asm volatile("" ::: "memory");
        const int col0 = u.pn * BM + wc * 32 + 8 * fq;
#pragma unroll
        for (int ai = 0; ai < 2; ++ai)
#pragma unroll
            for (int m = 0; m < 4; ++m) { const int r = ai * HALF + wr * 64 + m * 16 + fr;
                const f32x4 x01 = *(const PG8_LAS f32x4*)(xl + r * 4), x23 = *(const PG8_LAS f32x4*)(xl + r * 4 + 2);
                const float mg = fmaxf(fmaxf(x01[0], x01[2]), fmaxf(x23[0], x23[2]));
                const float tot = x01[1] * __builtin_amdgcn_exp2f(x01[0] - mg) + x01[3] * __builtin_amdgcn_exp2f(x01[2] - mg) + x23[1] * __builtin_amdgcn_exp2f(x23[0] - mg) + x23[3] * __builtin_amdgcn_exp2f(x23[2] - mg);
                const float mown = wc == 0 ? x01[0] : (wc == 1 ? x01[2] : (wc == 2 ? x23[0] : x23[2]));
                const float f = __builtin_amdgcn_exp2f(mown - mg) / tot;
                bf16_t* rowp = O + ((size_t)u.pm * BM + r) * ldc + col0;
#pragma unroll
                for (int bj = 0; bj < 2; ++bj) { const f32x4 v0 = acc[ai][bj][m][0] * f, v1 = acc[ai][bj][m][1] * f;
                    u32x4 w; w.x = cvt_pk_bf16(v0[0], v0[1]); w.y = cvt_pk_bf16(v0[2], v0[3]); w.z = cvt_pk_bf16(v1[0], v1[1]); w.w = cvt_pk_bf16(v1[2], v1[3]);
                    *(u32x4*)(rowp + bj * HALF) = w; } }
    }
};
}
constexpr int NWAVES = 8;
constexpr int BATCH = 4, T = 8192, D = 1024, M = BATCH * T;
constexpr int NIN = 3328, RW = 512, NH = 8, HD = 64;
constexpr int ZK_R = 512, ZV_R = 1024, ZWD = 1536, ZAD = 1600, ZGD = 1664;
constexpr int ZQ = 1792, ZK = 1792 + 512, ZV = 1792 + 1024;
constexpr int MEML = 256, MEMR = BATCH * MEML, FF = 4096;
constexpr int NBLK = T / 256;
constexpr float NORM_EPS = 1e-6f, GN_EPS = 64e-5f, DECAY_SCALE = 0.6065306597126334f;

constexpr size_t MiB = 1u << 20;
constexpr size_t WS_CTL = 0, CTL_ZERO_BYTES = 1 * MiB;
constexpr size_t WS_WIN_T = 1 * MiB, WS_WMIX_T = 8 * MiB, WS_WQ_S = 10 * MiB, WS_WXKV_T = 12 * MiB, WS_WO_T = 16 * MiB, WS_W1_T = 18 * MiB, WS_W2_T = 26 * MiB;
constexpr size_t WS_MEMN = 34 * MiB, WS_KV = 36 * MiB, WS_GT = 40 * MiB, WS_VWT = 48 * MiB;
constexpr size_t WS_SS = 56 * MiB;
constexpr size_t WS_KMEAN = 62 * MiB, WS_LORA = 62 * MiB + 512 * 1024, WS_BON = 63 * MiB;
constexpr size_t WS_XN = 64 * MiB;
constexpr size_t WS_GATE = 64 * MiB, WS_YRAW = 96 * MiB;
constexpr size_t WS_HB = 64 * MiB;
constexpr size_t WS_Z = 128 * MiB;
constexpr size_t WS_Y = 336 * MiB;
constexpr size_t WS_NT = 400 * MiB;
constexpr size_t WS_PR = 400 * MiB, WS_PV = 432 * MiB;
constexpr size_t WS_P = 400 * MiB;
constexpr size_t WS_AH = 128 * MiB;
constexpr size_t WS_END = 512 * MiB;
constexpr size_t DO_W = 0, DO_KP = 32 * MiB, DO_KKN = 64 * MiB, DO_B = 96 * MiB;

constexpr int CW_TMO = 0, CW_CODE = 1;
constexpr int CW_BAR = 4096;

constexpr int RING_OFF = 0, RING_BYTES = 131072;
constexpr int LDSCTL_OFF = RING_BYTES, MISC_OFF = LDSCTL_OFF + 320;
constexpr int EPI_LDS_OFF = 132096;
constexpr int LDS_BYTES = 147456;
static_assert(MISC_OFF + 128 <= EPI_LDS_OFF && EPI_LDS_OFF + 8192 <= LDS_BYTES, "LDS map");

#define GAS __attribute__((address_space(1)))
#define LAS __attribute__((address_space(3)))
typedef unsigned short bf16;
typedef unsigned v4u __attribute__((ext_vector_type(4)));
typedef float f32x4 __attribute__((ext_vector_type(4)));
typedef GAS unsigned gu32;
#define RLX_AGENT __ATOMIC_RELAXED, __HIP_MEMORY_SCOPE_AGENT
#define LDS_WAIT() asm volatile("s_waitcnt lgkmcnt(0)" ::: "memory")
#define VM_WAIT() asm volatile("s_waitcnt vmcnt(0)" ::: "memory")
__device__ __forceinline__ unsigned f2bf(float f) { unsigned u = __builtin_bit_cast(unsigned, f); return (u + 0x7fffu + ((u >> 16) & 1u)) >> 16; }
__device__ __forceinline__ unsigned pk2(float lo, float hi) { return f2bf(lo) | (f2bf(hi) << 16); }
__device__ __forceinline__ float bf2f(unsigned short u) { return __builtin_bit_cast(float, (unsigned)u << 16); }
__device__ __forceinline__ float bflo(unsigned u) { return __builtin_bit_cast(float, u << 16); }
__device__ __forceinline__ float bfhi(unsigned u) { return __builtin_bit_cast(float, u & 0xffff0000u); }

#define XB_TMO      128
#define XB_XCNT(j)  (256  + 64 * (j))
#define XB_XSUB(j)  (1280 + 64 * (j))
#define XB_XGEN(j)  (2304 + 64 * (j))
#define XB_TOP      3328
#define XB_TOPGEN   3392
#define XCD_BAR_WORDS 3456
#define XB_SPIN_CAP (1u << 18)
__device__ __forceinline__ unsigned xb_ld(unsigned* p)              { return __hip_atomic_load(p, __ATOMIC_RELAXED, __HIP_MEMORY_SCOPE_AGENT); }
__device__ __forceinline__ unsigned xb_add(unsigned* p, unsigned v) { return __hip_atomic_fetch_add(p, v, __ATOMIC_RELAXED, __HIP_MEMORY_SCOPE_AGENT); }
__device__ __forceinline__ unsigned xb_xcc_id() { return (unsigned)__builtin_amdgcn_s_getreg((3 << 11) | 20) & 0xFu; }
#define XB_SPIN(cond, bar) do { unsigned _sp = 0; while (cond) { __builtin_amdgcn_s_sleep(1); \
    if ((++_sp & 255u) == 0u) { if (xb_ld(&(bar)[XB_TMO])) break; if (_sp > XB_SPIN_CAP) { atomicAdd(&(bar)[XB_TMO], 1u); break; } } } } while (0)
struct XcdBarrier { unsigned* bar; unsigned x; volatile LAS unsigned* st; };
__device__ __forceinline__ XcdBarrier xcd_barrier_post(unsigned* bar, volatile LAS unsigned* st) {
    XcdBarrier b; b.bar = bar; b.x = xb_xcc_id(); b.st = st;
    if (threadIdx.x == 0) (void)xb_add(&bar[XB_XCNT(b.x)], 1u);
    return b;
}
__device__ __forceinline__ void xcd_barrier_complete(unsigned* bar, unsigned x, unsigned& nloc, unsigned& nx) {
    const unsigned G = gridDim.x * gridDim.y * gridDim.z;
    unsigned sum, cnt, mine, sp = 0u;
    for (;;) {
        sum = 0u; cnt = 0u; mine = 0u;
#pragma unroll
        for (unsigned j = 0; j < 16; ++j) { const unsigned c = xb_ld(&bar[XB_XCNT(j)]); sum += c; cnt += (c > 0u) ? 1u : 0u; mine = (j == x) ? c : mine; }
        if (sum == G) break;
        __builtin_amdgcn_s_sleep(1);
        if ((++sp & 255u) == 0u) { if (xb_ld(&bar[XB_TMO])) break; if (sp > XB_SPIN_CAP) { atomicAdd(&bar[XB_TMO], 1u); break; } }
    }
    nloc = mine > 0u ? mine : 1u; nx = cnt > 0u ? cnt : 1u;
}
__device__ __forceinline__ void xcd_barrier(const XcdBarrier& b) {
    asm volatile("s_waitcnt vmcnt(0)" ::: "memory");
    __syncthreads();
    if (threadIdx.x == 0) {
        unsigned* bar = b.bar;
        __builtin_amdgcn_s_waitcnt(0);
        unsigned nloc = b.st[0], nx = b.st[1];
        if (nloc == 0u) { xcd_barrier_complete(bar, b.x, nloc, nx); b.st[0] = nloc; b.st[1] = nx; }
        const unsigned old = xb_add(&bar[XB_XSUB(b.x)], 1u);
        const unsigned gen = old / nloc;
        if (old + 1u == (gen + 1u) * nloc) {
            __builtin_amdgcn_fence(__ATOMIC_RELEASE, "agent");
            asm volatile("s_waitcnt vmcnt(0)" ::: "memory");
            const unsigned og = xb_add(&bar[XB_TOP], 1u);
            const unsigned tg = og / nx;
            if (og + 1u == (tg + 1u) * nx) xb_add(&bar[XB_TOPGEN], 1u);
            else XB_SPIN(xb_ld(&bar[XB_TOPGEN]) == tg, bar);
            __builtin_amdgcn_fence(__ATOMIC_ACQUIRE, "agent");
            xb_add(&bar[XB_XGEN(b.x)], 1u);
            asm volatile("s_waitcnt vmcnt(0)" ::: "memory");
        } else {
            XB_SPIN(xb_ld(&bar[XB_XGEN(b.x)]) == gen, bar);
            __builtin_amdgcn_fence(__ATOMIC_ACQUIRE, "agent");
            asm volatile("s_waitcnt vmcnt(0)" ::: "memory");
        }
    }
    __syncthreads();
}

struct Frame {
    LAS unsigned char* lds;
    volatile LAS unsigned* MISC;
    gu32* ctl;
    int tid, lane, wave;
    int vcu, G;
    unsigned char* ws; unsigned char* dout;
    const float* in[25];
};
constexpr size_t WS_TAB = 131072;
__device__ __forceinline__ const float* inp(const Frame& F, int i) {
    const unsigned long long v = ((const GAS unsigned long long*)(F.ws + WS_TAB))[i];
    const unsigned lo = __builtin_amdgcn_readfirstlane((unsigned)v), hi = __builtin_amdgcn_readfirstlane((unsigned)(v >> 32));
    return (const float*)(((unsigned long long)hi << 32) | lo);
}
#define INP(i) inp(F, (i))
__device__ __forceinline__ float wave_sum(float v) {
#pragma unroll
    for (int o = 1; o < 64; o <<= 1) v += __shfl_xor(v, o);
    return v;
}
__device__ __forceinline__ float wave_max(float v) {
#pragma unroll
    for (int o = 1; o < 64; o <<= 1) v = fmaxf(v, __shfl_xor(v, o));
    return v;
}
template <int CTRL> __device__ __forceinline__ float dpp_mov(float x) { return __builtin_bit_cast(float, __builtin_amdgcn_update_dpp(0, __builtin_bit_cast(int, x), CTRL, 0xf, 0xf, false)); }
__device__ __forceinline__ float red16(float x) { x += dpp_mov<0xB1>(x); x += dpp_mov<0x4E>(x); x += dpp_mov<0x124>(x); x += dpp_mov<0x128>(x); return x; }
__device__ __forceinline__ void p0_transpose_item(const float* W, int K, int N, bf16* WT, const float* kscale, LAS float* scr, int item, int lane) {
    const int nblk = N / 32, kb = item / nblk, nb = item % nblk, k0 = 64 * kb, n0 = 32 * nb;
#pragma unroll 8
    for (int i = 0; i < 32; ++i) { const int kk = 2 * i + (lane >> 5); const float s = kscale ? kscale[k0 + kk] : 1.f; scr[kk * 33 + (lane & 31)] = W[(size_t)(k0 + kk) * N + n0 + (lane & 31)] * s; }
    LDS_WAIT(); asm volatile("" ::: "memory");
    const int c = lane & 7;
#pragma unroll
    for (int j = 0; j < 4; ++j) { const int n = (lane >> 3) + 8 * j; const LAS float* s = scr + (8 * c) * 33 + n;
        v4u o; o.x = pk2(s[0 * 33], s[1 * 33]); o.y = pk2(s[2 * 33], s[3 * 33]); o.z = pk2(s[4 * 33], s[5 * 33]); o.w = pk2(s[6 * 33], s[7 * 33]);
        *(GAS v4u*)(WT + (size_t)(n0 + n) * K + k0 + 8 * c) = o; }
    LDS_WAIT(); asm volatile("" ::: "memory");
}
__device__ __forceinline__ void rms_row_to_bf16(const float* xrow, const float* g, bf16* orow, int lane) {
    const GAS f32x4* xr = (const GAS f32x4*)xrow + lane; const GAS f32x4* gr = (const GAS f32x4*)g + lane;
    f32x4 v[4]; float s = 0.f;
#pragma unroll
    for (int j = 0; j < 4; ++j) { v[j] = xr[64 * j]; s += (v[j].x * v[j].x + v[j].y * v[j].y) + (v[j].z * v[j].z + v[j].w * v[j].w); }
    const float rstd = 1.f / sqrtf(wave_sum(s) * (1.f / D) + NORM_EPS);
    GAS unsigned long long* o8 = (GAS unsigned long long*)orow + lane;
#pragma unroll
    for (int j = 0; j < 4; ++j) { const f32x4 gg = gr[64 * j]; o8[64 * j] = (unsigned long long)pk2(v[j].x * rstd * gg.x, v[j].y * rstd * gg.y) | ((unsigned long long)pk2(v[j].z * rstd * gg.z, v[j].w * rstd * gg.w) << 32); }
}
__device__ __forceinline__ void p0_prologue(Frame& F) {
    LAS float* scr = (LAS float*)(F.lds + RING_OFF + F.wave * 16384);
    const int gw = F.vcu * NWAVES + F.wave, NGW = F.G * NWAVES;
    constexpr int I_IN = (D / 64) * (NIN / 32), I_MIX = (D / 64) * (D / 32), I_KV = (D / 64) * (2 * D / 32), I_O = I_MIX, I_1 = (D / 64) * (FF / 32), I_2 = (FF / 64) * (D / 32);
    constexpr int I_LW = RW / 32, I_LG = 2 * (RW / 32);
    constexpr int NITEMS = I_IN + I_MIX + I_KV + I_O + I_1 + I_2 + 2 * I_LW + I_LG;
    for (int it = gw; it < NITEMS; it += NGW) {
        int r = it;
        if (r < I_IN) { p0_transpose_item(F.in[3], D, NIN, (bf16*)(F.ws + WS_WIN_T), nullptr, scr, r, F.lane); continue; } r -= I_IN;
        if (r < I_MIX) { p0_transpose_item(F.in[15], D, D, (bf16*)(F.ws + WS_WMIX_T), nullptr, scr, r, F.lane); continue; } r -= I_MIX;
        if (r < I_KV) { p0_transpose_item(F.in[19], D, 2 * D, (bf16*)(F.ws + WS_WXKV_T), nullptr, scr, r, F.lane); continue; } r -= I_KV;
        if (r < I_O) { p0_transpose_item(F.in[20], D, D, (bf16*)(F.ws + WS_WO_T), nullptr, scr, r, F.lane); continue; } r -= I_O;
        if (r < I_1) { p0_transpose_item(F.in[22], D, FF, (bf16*)(F.ws + WS_W1_T), F.in[21], scr, r, F.lane); continue; } r -= I_1;
        if (r < I_2) { p0_transpose_item(F.in[23], FF, D, (bf16*)(F.ws + WS_W2_T), nullptr, scr, r, F.lane); continue; } r -= I_2;
        if (r < I_LW) { p0_transpose_item(F.in[6], 64, RW, (bf16*)(F.ws + WS_LORA), nullptr, scr, r, F.lane); continue; } r -= I_LW;
        if (r < I_LW) { p0_transpose_item(F.in[8], 64, RW, (bf16*)(F.ws + WS_LORA) + RW * 64, nullptr, scr, r, F.lane); continue; } r -= I_LW;
        p0_transpose_item(F.in[9], 128, RW, (bf16*)(F.ws + WS_LORA) + 2 * RW * 64, nullptr, scr, r, F.lane);
    }
    { const float* wq = F.in[18]; const float* gx = F.in[16]; bf16* o = (bf16*)(F.ws + WS_WQ_S);
      for (int i = (F.vcu * 512 + F.tid); i < D * D / 4; i += F.G * 512) { const f32x4 v = ((const GAS f32x4*)wq)[i]; const float s = gx[(i * 4) / D];
          ((GAS unsigned long long*)o)[i] = (unsigned long long)pk2(v.x * s, v.y * s) | ((unsigned long long)pk2(v.z * s, v.w * s) << 32); } }
    for (int m = gw; m < M; m += NGW) rms_row_to_bf16(F.in[0] + (size_t)m * D, F.in[2], (bf16*)(F.ws + WS_XN) + (size_t)m * D, F.lane);
    for (int m = gw; m < MEMR; m += NGW) rms_row_to_bf16(F.in[1] + (size_t)m * D, F.in[17], (bf16*)(F.ws + WS_MEMN) + (size_t)m * D, F.lane);
}

__device__ __forceinline__ void kmean_simple(Frame& F) {
    const bf16* Z = (const bf16*)(F.ws + WS_Z); float* KM = (float*)(F.ws + WS_KMEAN);
    const int gw = F.vcu * NWAVES + F.wave, NGW = F.G * NWAVES;
    for (int u = gw; u < BATCH * NH * NBLK; u += NGW) { const int j = u % NBLK, bh = u / NBLK, b = bh / NH, h = bh % NH;
        const bf16* kp = Z + ((size_t)b * T + j * 256) * NIN + ZK + h * HD + F.lane; float s = 0.f;
        for (int i = 0; i < 256; ++i) s += bf2f(kp[(size_t)i * NIN]);
        KM[(size_t)u * HD + F.lane] = s * (1.f / 256.f); }
}
__device__ __forceinline__ void final_norm(Frame& F, const float pscale) {
    float* out = (float*)F.dout; const bf16* hb = (const bf16*)(F.ws + WS_HB); const float* ss = (const float*)(F.ws + WS_SS) + (size_t)2 * M * 16; const float* g = INP(24);
    const int gw = F.vcu * NWAVES + F.wave, NGW = F.G * NWAVES;
    for (int m = gw; m < M; m += NGW) { const float rstd = pg8::row_rstd(ss, (size_t)m) * pscale;
        GAS f32x4* o = (GAS f32x4*)(out + (size_t)m * D) + F.lane; const GAS f32x4* gr = (const GAS f32x4*)g + F.lane; const GAS unsigned long long* hr = (const GAS unsigned long long*)(hb + (size_t)m * D) + F.lane;
#pragma unroll
        for (int j = 0; j < 4; ++j) { const unsigned long long q = hr[64 * j]; const unsigned lo = (unsigned)q, hi = (unsigned)(q >> 32); const f32x4 gg = gr[64 * j];
            f32x4 v = (f32x4){bflo(lo), bfhi(lo), bflo(hi), bfhi(hi)}; v = v * rstd * gg; o[64 * j] = v; } }
}
namespace attn_body {
typedef unsigned short bf16;
using bf16x8=__attribute__((ext_vector_type(8)))short;
using s16x4=__attribute__((ext_vector_type(4)))short;
using f32x16=__attribute__((ext_vector_type(16)))float;
using u32x4=__attribute__((ext_vector_type(4)))unsigned;
constexpr int SEQ=8192,D=64,QP=3328,OP=1024;
constexpr int NW=8,QBLK=32,QB=QBLK*NW,KVBLK=64,NQB=SEQ/QB;
__device__ __forceinline__ int crow(int r,int hi){return (r&3)+8*(r>>2)+4*hi;}
#define SBAR() __builtin_amdgcn_sched_barrier(0)
__device__ __forceinline__ void cmask(f32x16&p0,f32x16&p1,int jb,int qrel,int hi){
  const float NEG=-INFINITY; int kb=64*jb+4*hi;
  #pragma unroll
  for(int r=0;r<16;++r){int kv=kb+(r&3)+8*(r>>2); if(kv>qrel)p0[r]=NEG; if(kv+32>qrel)p1[r]=NEG;}
}

constexpr int NSLOT=3, SLOTB=8192;
constexpr int LDS_K=0, LDS_V=NSLOT*SLOTB, LDS_WS=2*NSLOT*SLOTB, LDS_OST=LDS_WS+NW*64*4, LDS_BYTES=LDS_OST+NW*4096;
constexpr float C2=0.125f*1.4426950408889634f;
__device__ __forceinline__ void glds16(const void*gsrc,unsigned lds_dst){unsigned keep;
  asm volatile("s_mov_b32 %0, m0\n\ts_mov_b32 m0, %2\n\ts_nop 0\n\tglobal_load_lds_dwordx4 %1, off\n\ts_mov_b32 m0, %0":"=&s"(keep):"v"(gsrc),"s"(lds_dst):"memory");}
__device__ __forceinline__ float max3f(float a,float b,float c){float r;asm("v_max3_f32 %0, %1, %2, %3":"=v"(r):"v"(a),"v"(b),"v"(c));return r;}
__device__ __forceinline__ float max2f(float a,float b){float r;asm("v_max_f32_e32 %0, %1, %2":"=v"(r):"v"(a),"v"(b));return r;}
__device__ __forceinline__ float fadd_s(float a,float b){float r;asm("v_add_f32_e32 %0, %1, %2":"=v"(r):"v"(a),"v"(b));return r;}
__device__ __forceinline__ float fsub_s(float a,float b){float r;asm("v_sub_f32_e32 %0, %1, %2":"=v"(r):"v"(a),"v"(b));return r;}
typedef float f32x2_t __attribute__((ext_vector_type(2))); typedef __bf16 bf16x2_t __attribute__((ext_vector_type(2)));
__device__ __forceinline__ unsigned cvtpk_s(float lo,float hi){f32x2_t v={lo,hi};bf16x2_t b=__builtin_convertvector(v,bf16x2_t);return __builtin_bit_cast(unsigned,b);}
#define WAIT_BAR(N) asm volatile("s_waitcnt vmcnt(" #N ") lgkmcnt(0)\n\ts_barrier":::"memory")

__device__ __forceinline__ void qkt(f32x16&p0,f32x16&p1,const char*Kslot,const bf16x8*qr,const f32x16&negm,int r32,int hi){
  const char*kb=Kslot+hi*1024+r32*16;
  #pragma unroll
  for(int d0=0;d0<4;++d0){
    const bf16x8 b0=*reinterpret_cast<const bf16x8*>(kb+d0*2048);
    const bf16x8 b1=*reinterpret_cast<const bf16x8*>(kb+d0*2048+512);
    if(d0==0){p0=__builtin_amdgcn_mfma_f32_32x32x16_bf16(b0,qr[0],negm,0,0,0);p1=__builtin_amdgcn_mfma_f32_32x32x16_bf16(b1,qr[0],negm,0,0,0);}
    else{p0=__builtin_amdgcn_mfma_f32_32x32x16_bf16(b0,qr[d0],p0,0,0,0);p1=__builtin_amdgcn_mfma_f32_32x32x16_bf16(b1,qr[d0],p1,0,0,0);}}
}
typedef __attribute__((address_space(3))) const char* lds_cptr;
typedef short v4i16_t __attribute__((ext_vector_type(4)));
__device__ __forceinline__ void kload8(bf16x8*kf,lds_cptr kp){
  kf[0]=*(const __attribute__((address_space(3))) bf16x8*)(kp);      kf[1]=*(const __attribute__((address_space(3))) bf16x8*)(kp+512);
  kf[2]=*(const __attribute__((address_space(3))) bf16x8*)(kp+2048); kf[3]=*(const __attribute__((address_space(3))) bf16x8*)(kp+2560);
  kf[4]=*(const __attribute__((address_space(3))) bf16x8*)(kp+4096); kf[5]=*(const __attribute__((address_space(3))) bf16x8*)(kp+4608);
  kf[6]=*(const __attribute__((address_space(3))) bf16x8*)(kp+6144); kf[7]=*(const __attribute__((address_space(3))) bf16x8*)(kp+6656);
}
__device__ __forceinline__ void kload2(bf16x8*kf,lds_cptr kp,int j){ kf[2*j]=*(const __attribute__((address_space(3))) bf16x8*)(kp+j*2048); kf[2*j+1]=*(const __attribute__((address_space(3))) bf16x8*)(kp+j*2048+512); }
__device__ __forceinline__ s16x4 vtr(lds_cptr p){ return __builtin_bit_cast(s16x4,__builtin_amdgcn_ds_read_tr16_b64_v4i16((__attribute__((address_space(3))) v4i16_t*)p)); }
__device__ __forceinline__ float rowmax(const f32x16&p0,const f32x16&p1){
  float a=max3f(p0[0],p0[1],p1[0]),b=max3f(p0[2],p0[3],p1[1]);a=max3f(a,p1[2],p1[3]);
  #pragma unroll
  for(int r=4;r<16;r+=4){a=max3f(a,p0[r],p0[r+1]);b=max3f(b,p0[r+2],p0[r+3]);a=max3f(a,p1[r],p1[r+1]);b=max3f(b,p1[r+2],p1[r+3]);}
  const float m=max2f(a,b);
  auto rr=__builtin_amdgcn_permlane32_swap(__float_as_uint(m),__float_as_uint(m),false,false);
  return max2f(__uint_as_float(rr[0]),__uint_as_float(rr[1]));
}
__device__ __forceinline__ void pv(f32x16*o,int vb,bf16x8 pa0,bf16x8 pa1,bf16x8 pa2,bf16x8 pa3){
  #pragma unroll
  for(int d0=0;d0<2;++d0){s16x4 lo[4],hi[4];
    #pragma unroll
    for(int ks=0;ks<4;++ks){
      asm volatile("ds_read_b64_tr_b16 %0,%1 offset:%c2":"=&v"(lo[ks]):"v"(vb),"i"(d0*4096+ks*1024):"memory");
      asm volatile("ds_read_b64_tr_b16 %0,%1 offset:%c2":"=&v"(hi[ks]):"v"(vb),"i"(d0*4096+ks*1024+512):"memory");}
    asm volatile("s_waitcnt lgkmcnt(0)":::"memory");SBAR();
    #define PK(k) (bf16x8){lo[k][0],lo[k][1],lo[k][2],lo[k][3],hi[k][0],hi[k][1],hi[k][2],hi[k][3]}
    o[d0]=__builtin_amdgcn_mfma_f32_32x32x16_bf16(pa0,PK(0),o[d0],0,0,0);
    o[d0]=__builtin_amdgcn_mfma_f32_32x32x16_bf16(pa1,PK(1),o[d0],0,0,0);
    o[d0]=__builtin_amdgcn_mfma_f32_32x32x16_bf16(pa2,PK(2),o[d0],0,0,0);
    o[d0]=__builtin_amdgcn_mfma_f32_32x32x16_bf16(pa3,PK(3),o[d0],0,0,0);
    #undef PK
  }
}

#ifndef ATTN_STORE16
#define ATTN_STORE16(p,v) (*(u32x4*)(p)=(v))
#endif
template<int THRL> __device__ __forceinline__ void attn_unit(int b,int h,int qb,const bf16*Q,const bf16*__restrict__ K,const bf16*__restrict__ V,bf16*O,const float*__restrict__ KMbh,char*shm,const int wid,const int lane){
  const int r32=lane&31,hi=lane>>5;
  const long rowbase=(long)b*SEQ; const int q0=qb*QB;
  const bf16*Qw=Q+(rowbase+q0+wid*QBLK)*QP+h*D;
  const bf16*Kh=K+rowbase*QP+h*D,*Vh=V+rowbase*QP+h*D;
  unsigned selmask=0u;
  { f32x16 g=f32x16{}; bf16x8 qg[4];
    #pragma unroll
    for(int d0=0;d0<4;++d0)qg[d0]=*reinterpret_cast<const bf16x8*>(&Qw[(long)r32*QP+d0*16+hi*8]);
    #pragma unroll
    for(int d0=0;d0<4;++d0){ const float4 a0=*reinterpret_cast<const float4*>(KMbh+r32*64+d0*16+hi*8), a1=*reinterpret_cast<const float4*>(KMbh+r32*64+d0*16+hi*8+4);
      u32x4 pk; pk[0]=cvtpk_s(a0.x,a0.y); pk[1]=cvtpk_s(a0.z,a0.w); pk[2]=cvtpk_s(a1.x,a1.y); pk[3]=cvtpk_s(a1.z,a1.w);
      g=__builtin_amdgcn_mfma_f32_32x32x16_bf16(__builtin_bit_cast(bf16x8,pk),qg[d0],g,0,0,0); }
    #pragma unroll
    for(int r=0;r<16;++r){ if(crow(r,hi)>=qb) g[r]=-INFINITY; }
    #pragma unroll
    for(int n=0;n<3;++n){ float bv=-INFINITY; int bi=64;
      #pragma unroll
      for(int r=0;r<16;++r){ if(g[r]>bv){bv=g[r];bi=crow(r,hi);} }
      const float pv_=__shfl_xor(bv,32); const int pi_=__shfl_xor(bi,32);
      const bool mine=(bv>pv_)||(bv==pv_&&bi<pi_); const float wv=mine?bv:pv_; const int wi=mine?bi:pi_;
      if(wv>-INFINITY){ selmask|=1u<<wi;
        #pragma unroll
        for(int r=0;r<16;++r){ if(crow(r,hi)==wi) g[r]=-INFINITY; } } }
    selmask|=1u<<qb; }
  asm volatile("":"+v"(selmask)); SBAR();
  const unsigned lds0=(unsigned)(uintptr_t)shm;
  float*wsf=(float*)(shm+LDS_WS)+wid*64;
  const bf16*ksrc=Kh+(long)lane*QP+wid*8;
  const bf16*vsrc=Vh+(long)(16*(wid&3)+(lane>>2))*QP+(wid>>2)*32+(lane&3)*8;
  const unsigned kdst=lds0+LDS_K+wid*1024, vdst=lds0+LDS_V+wid*1024;
  #define DMA_K(t,slot) glds16(ksrc+(long)(t)*KVBLK*QP,(unsigned)__builtin_amdgcn_readfirstlane(kdst+(slot)))
  #define DMA_V(t,slot) glds16(vsrc+(long)(t)*KVBLK*QP,(unsigned)__builtin_amdgcn_readfirstlane(vdst+(slot)))
  const int vb0=(int)(lds0+LDS_V)+((lane>>4)&1)*32+(lane&3)*8+(4*hi+((lane&15)>>2))*64;
  const char*Kbase=shm+LDS_K; bf16x8 kf[8];
  const lds_cptr shm3=(lds_cptr)shm; const lds_cptr kp0=shm3+LDS_K+hi*1024+r32*16; const lds_cptr vp0=shm3+LDS_V+((lane>>4)&1)*32+(lane&3)*8+(4*hi+((lane&15)>>2))*64;
  const int NT=(q0+QB)/KVBLK;
  DMA_K(0,0);DMA_V(0,0);DMA_K(1,SLOTB);
  bf16x8 qr[4];
  #pragma unroll
  for(int d0=0;d0<4;++d0)qr[d0]=*reinterpret_cast<const bf16x8*>(&Qw[(long)r32*QP+d0*16+hi*8]);
  float nok=((selmask&1u)!=0u||qb==0)?0.f:-INFINITY;
  float mhat=0.f,l_reg=0.f;f32x16 o[2];o[0]=f32x16{};o[1]=f32x16{};f32x16 negm;
  _Pragma("unroll") for(int r=0;r<16;++r)negm[r]=nok; asm volatile("":"+v"(negm));
  const int qrel=wid*QBLK+r32;
  #define CMASK(P0,P1,t) do{int jb_=(t)-(NT-4); if(jb_>=0)cmask(P0,P1,jb_,qrel,hi);}while(0)
  bool resc=false;
  #define START(P0,P1) do{ const float rm=rowmax(P0,P1); resc=false; \
    { const float dl=(rm==-INFINITY)?0.f:rm; mhat=fadd_s(mhat,dl); \
      _Pragma("unroll") for(int r=0;r<16;++r){P0[r]=fsub_s(P0[r],dl);P1[r]=fsub_s(P1[r],dl);} \
      { const float cv_=nok-mhat; _Pragma("unroll") for(int r=0;r<16;++r)negm[r]=cv_; } asm volatile("":"+v"(negm)); } \
    _Pragma("unroll") for(int r=0;r<16;++r)P0[r]=__builtin_amdgcn_exp2f(P0[r]); }while(0)
  #define RESC() do{ if(resc){ asm volatile("s_waitcnt lgkmcnt(0)":::"memory"); \
      _Pragma("unroll") for(int d_=0;d_<2;++d_) _Pragma("unroll") for(int r=0;r<16;++r)o[d_][r]*=wsf[crow(r,hi)]; } }while(0)
  f32x16 pA0,pA1,pB0,pB1;
  int sl_prev=0,sl_cur=0,sl_next=SLOTB;
  #define ROT() do{sl_prev=sl_cur;sl_cur=sl_next;sl_next=(sl_next==(NSLOT-1)*SLOTB)?0:sl_next+SLOTB;}while(0)
  DMA_K(2,2*SLOTB);
  WAIT_BAR(3);
  qkt(pA0,pA1,Kbase,qr,negm,r32,hi);asm volatile("s_nop 15\n\ts_nop 7":"+v"(pA0),"+v"(pA1));CMASK(pA0,pA1,0);
  START(pA0,pA1);
  _Pragma("unroll") for(int r=0;r<16;++r)pA1[r]=__builtin_amdgcn_exp2f(pA1[r]);
  WAIT_BAR(0);
  DMA_K(3,0);DMA_V(1,SLOTB);
  ROT();
  kload8(kf,kp0+sl_cur);
  WAIT_BAR(2);
  s16x4 vlo[8],vhi[8]; u32x4 pw0,pw1,pw2,pw3;
  #define PKW(P,B) cvtpk_s(P[B],P[B+1])
  #define PAF(k) __builtin_bit_cast(bf16x8,pw##k)
  #define VFR(i) (bf16x8){vlo[i][0],vlo[i][1],vlo[i][2],vlo[i][3],vhi[i][0],vhi[i][1],vhi[i][2],vhi[i][3]}
  #define PIN(x) asm volatile("":"+v"(x))
  #define MX3(a,b,c) __builtin_fmaxf(__builtin_fmaxf((a),(b)),(c))
  #define GAPA(MF,A0,A1,A2,A3,W0,W1,PW) do{ MF; sacc+=A0; sacc+=A1; sacc+=A2; sacc+=A3; PIN(sacc); W0; W1; PIN(PW); SBAR(); }while(0)
  #define EX(v) __builtin_amdgcn_exp2f(v)
  #define GAPB(MF,X,B) do{ MF; X[B]=EX(X[B]); X[B+1]=EX(X[B+1]); X[B+2]=EX(X[B+2]); X[B+3]=EX(X[B+3]); PIN(X); SBAR(); }while(0)
  #define VRD(i) do{ vlo[i]=vtr(vp_+(((i)>>2)*4096+((i)&3)*1024)); vhi[i]=vtr(vp_+(((i)>>2)*4096+((i)&3)*1024+512)); }while(0)
  #define KRD(G,j) do{ if(G){ kload2(kf,kp0+sl_next,j); SBAR(); } }while(0)
  #define STEP(C0,C1,P0,P1,t,GK,GV,GL) do{ SBAR(); \
    const lds_cptr vp_=vp0+sl_prev; \
    VRD(0); SBAR(); float sacc=(P0[0]+P0[1]); \
    GAPA(C0=__builtin_amdgcn_mfma_f32_32x32x16_bf16(kf[0],qr[0],negm,0,0,0), P0[2],P0[3],P0[4],P0[5],     pw0[0]=PKW(P0,0), pw0[1]=PKW(P0,2), pw0); \
    VRD(4); SBAR(); GAPA(C1=__builtin_amdgcn_mfma_f32_32x32x16_bf16(kf[1],qr[0],negm,0,0,0), P0[6],P0[7],P0[8],P0[9],     pw0[2]=PKW(P0,4), pw0[3]=PKW(P0,6), pw0); \
    VRD(1); SBAR(); GAPA(C0=__builtin_amdgcn_mfma_f32_32x32x16_bf16(kf[2],qr[1],C0,0,0,0),   P0[10],P0[11],P0[12],P0[13], pw1[0]=PKW(P0,8), pw1[1]=PKW(P0,10), pw1); \
    VRD(5); SBAR(); GAPA(C1=__builtin_amdgcn_mfma_f32_32x32x16_bf16(kf[3],qr[1],C1,0,0,0),   P0[14],P0[15],P1[0],P1[1],   pw1[2]=PKW(P0,12),pw1[3]=PKW(P0,14), pw1); \
    VRD(2); SBAR(); GAPA(C0=__builtin_amdgcn_mfma_f32_32x32x16_bf16(kf[4],qr[2],C0,0,0,0),   P1[2],P1[3],P1[4],P1[5],     pw2[0]=PKW(P1,0), pw2[1]=PKW(P1,2), pw2); \
    VRD(6); SBAR(); GAPA(C1=__builtin_amdgcn_mfma_f32_32x32x16_bf16(kf[5],qr[2],C1,0,0,0),   P1[6],P1[7],P1[8],P1[9],     pw2[2]=PKW(P1,4), pw2[3]=PKW(P1,6), pw2); \
    VRD(3); SBAR(); GAPA(C0=__builtin_amdgcn_mfma_f32_32x32x16_bf16(kf[6],qr[3],C0,0,0,0),   P1[10],P1[11],P1[12],P1[13], pw3[0]=PKW(P1,8), pw3[1]=PKW(P1,10), pw3); \
    VRD(7); SBAR(); GAPA(C1=__builtin_amdgcn_mfma_f32_32x32x16_bf16(kf[7],qr[3],C1,0,0,0),   P1[14],P1[15],0.f,0.f,       pw3[2]=PKW(P1,12),pw3[3]=PKW(P1,14), pw3); \
    l_reg+=sacc; \
    if(GK){DMA_K((t)+3,sl_cur);} if(GV){DMA_V((t)+1,sl_next);} \
    CMASK(C0,C1,t); \
    { float a=MX3(C0[0],C0[1],C1[0]),b=MX3(C0[2],C0[3],C1[1]); a=MX3(a,C1[2],C1[3]); \
      _Pragma("unroll") for(int r=4;r<16;r+=4){a=MX3(a,C0[r],C0[r+1]);b=MX3(b,C0[r+2],C0[r+3]);a=MX3(a,C1[r],C1[r+1]);b=MX3(b,C1[r+2],C1[r+3]);} \
      float rm=__builtin_fmaxf(a,b); { auto rr=__builtin_amdgcn_permlane32_swap(__float_as_uint(rm),__float_as_uint(rm),false,false); rm=__builtin_fmaxf(__uint_as_float(rr[0]),__uint_as_float(rr[1])); } \
      resc=false; \
      if(__builtin_expect(__any(rm>(float)THRL),0)){ const float dl=__builtin_fmaxf(rm,0.f); mhat+=dl; \
        _Pragma("unroll") for(int r=0;r<16;++r){C0[r]-=dl;C1[r]-=dl;} \
        { const float cv_=nok-mhat; _Pragma("unroll") for(int r=0;r<16;++r)negm[r]=cv_; } asm volatile("":"+v"(negm)); \
        const float f=__builtin_amdgcn_exp2f(-dl); l_reg*=f; if(hi==0)wsf[r32]=f; resc=true; } } \
    SBAR(); \
    GAPB(o[0]=__builtin_amdgcn_mfma_f32_32x32x16_bf16(PAF(0),VFR(0),o[0],0,0,0), C0,0); \
    GAPB(o[1]=__builtin_amdgcn_mfma_f32_32x32x16_bf16(PAF(0),VFR(4),o[1],0,0,0), C0,4); \
    KRD(GL,0); GAPB(o[0]=__builtin_amdgcn_mfma_f32_32x32x16_bf16(PAF(1),VFR(1),o[0],0,0,0), C0,8); \
    KRD(GL,1); GAPB(o[1]=__builtin_amdgcn_mfma_f32_32x32x16_bf16(PAF(1),VFR(5),o[1],0,0,0), C0,12); \
    KRD(GL,2); GAPB(o[0]=__builtin_amdgcn_mfma_f32_32x32x16_bf16(PAF(2),VFR(2),o[0],0,0,0), C1,0); \
    KRD(GL,3); GAPB(o[1]=__builtin_amdgcn_mfma_f32_32x32x16_bf16(PAF(2),VFR(6),o[1],0,0,0), C1,4); \
    GAPB(o[0]=__builtin_amdgcn_mfma_f32_32x32x16_bf16(PAF(3),VFR(3),o[0],0,0,0), C1,8); \
    GAPB(o[1]=__builtin_amdgcn_mfma_f32_32x32x16_bf16(PAF(3),VFR(7),o[1],0,0,0), C1,12); \
    }while(0)
  #define MASKUPD(tt) do{ if((((tt))&3)==0){ nok=((selmask>>((tt)>>2))&1u)?0.f:-INFINITY; const float cv_=nok-mhat; _Pragma("unroll") for(int r=0;r<16;++r)negm[r]=cv_; asm volatile("":"+v"(negm)); } }while(0)
  int t=1;
  #undef CMASK
  #define CMASK(P0,P1,t) do{}while(0)
  for(;t+5<NT;t+=2){
    STEP(pB0,pB1,pA0,pA1,t,true,true,true);     WAIT_BAR(2); RESC(); ROT(); MASKUPD(t+1);
    STEP(pA0,pA1,pB0,pB1,t+1,true,true,true);   WAIT_BAR(2); RESC(); ROT();
  }
  #undef CMASK
  #define CMASK(P0,P1,t) do{int jb_=(t)-(NT-4); if(jb_>=0)cmask(P0,P1,jb_,qrel,hi);}while(0)
  #define ENDW(tt) do{ if((tt)+3<NT){WAIT_BAR(2);} else if((tt)+2<NT){WAIT_BAR(1);} else {WAIT_BAR(0);} }while(0)
  for(;t+1<NT;t+=2){
    STEP(pB0,pB1,pA0,pA1,t,(t+3<NT),(t+1<NT),(t+1<NT));       ENDW(t);   RESC(); ROT(); MASKUPD(t+1);
    STEP(pA0,pA1,pB0,pB1,t+1,(t+4<NT),(t+2<NT),(t+2<NT));     ENDW(t+1); RESC(); ROT();
  }
  STEP(pB0,pB1,pA0,pA1,NT-1,false,false,false); RESC();
  { float sacc=pB0[0]+pB0[1]; _Pragma("unroll") for(int r=2;r<16;++r)sacc+=pB0[r]; _Pragma("unroll") for(int r=0;r<16;++r)sacc+=pB1[r]; l_reg+=sacc;
    pw0=(u32x4){PKW(pB0,0),PKW(pB0,2),PKW(pB0,4),PKW(pB0,6)};pw1=(u32x4){PKW(pB0,8),PKW(pB0,10),PKW(pB0,12),PKW(pB0,14)};pw2=(u32x4){PKW(pB1,0),PKW(pB1,2),PKW(pB1,4),PKW(pB1,6)};pw3=(u32x4){PKW(pB1,8),PKW(pB1,10),PKW(pB1,12),PKW(pB1,14)};
    SBAR(); pv(o,vb0+sl_cur,PAF(0),PAF(1),PAF(2),PAF(3)); }
  #undef PKW
  #undef PAF
  #undef VFR
  #undef PIN
  #undef MX3
  #undef GAPA
  #undef GAPB
  #undef EX
  #undef VRD
  #undef KRD
  #undef STEP
  #undef ENDW
  #undef MASKUPD
  {auto rr=__builtin_amdgcn_permlane32_swap(__float_as_uint(l_reg),__float_as_uint(l_reg),false,false);l_reg=__uint_as_float(rr[0])+__uint_as_float(rr[1]);}
  if(hi==0)wsf[32+r32]=l_reg;asm volatile("s_waitcnt lgkmcnt(0)":::"memory");
  float rli[16];
  #pragma unroll
  for(int r=0;r<16;++r)rli[r]=__builtin_amdgcn_rcpf(wsf[32+crow(r,hi)]);
  bf16*Ow=O+(rowbase+q0+wid*QBLK)*OP+h*D;
  { bf16*stg=(bf16*)(shm+LDS_OST)+wid*2048;
    #pragma unroll
    for(int r=0;r<16;++r){const int orow=crow(r,hi);
      #pragma unroll
      for(int d0=0;d0<2;++d0)stg[orow*64+d0*32+r32]=(bf16)(cvtpk_s(o[d0][r]*rli[r],0.f)&0xffffu);}
    asm volatile("s_waitcnt lgkmcnt(0)":::"memory");
    #pragma unroll
    for(int i=0;i<4;++i){const int row=i*8+(lane>>3),ch=lane&7; const u32x4 v=*(const u32x4*)(stg+row*64+ch*8); ATTN_STORE16(Ow+(long)row*OP+ch*8,v);} }
  asm volatile("s_waitcnt lgkmcnt(0)\n\ts_barrier":::"memory");
  #undef DMA_K
  #undef DMA_V
  #undef CMASK
  #undef START
  #undef RESC
  #undef ROT
}
constexpr int ATTN_LDS_BYTES=LDS_BYTES;
#undef SBAR
#undef WAIT_BAR
}
namespace rscan {
typedef short bf16x8 __attribute__((ext_vector_type(8)));
typedef float f32x4 __attribute__((ext_vector_type(4)));
typedef float f32x16 __attribute__((ext_vector_type(16)));
typedef unsigned u32x2 __attribute__((ext_vector_type(2)));
typedef unsigned u32x4 __attribute__((ext_vector_type(4)));
constexpr int LB = 8192;
__device__ __forceinline__ int t64(int row, int chunk) { return row * 128 + ((chunk ^ ((row >> 1) & 7)) << 4); }
__device__ __forceinline__ int t128(int row, int chunk) { return row * 256 + ((chunk ^ (row & 15)) << 4); }
constexpr int NCHUNK = T / 64;
__device__ __forceinline__ unsigned pkbf(float lo, float hi) { typedef float f2 __attribute__((ext_vector_type(2))); typedef __bf16 b2 __attribute__((ext_vector_type(2))); f2 v = {lo, hi}; return __builtin_bit_cast(unsigned, __builtin_convertvector(v, b2)); }

__device__ __forceinline__ void mm(f32x4 (&acc)[2], LAS unsigned char* lds, int z1, int z2, int ta, int tbh, int fr, int fq) {
    const int o1 = z1 + t64(16 * ta + fr, fq), o2 = z2 + t64(32 * tbh + fr, fq);
    const bf16x8 a0 = *(const LAS bf16x8*)(lds + o1), a1 = *(const LAS bf16x8*)(lds + (o1 ^ 64));
    const bf16x8 b00 = *(const LAS bf16x8*)(lds + o2), b01 = *(const LAS bf16x8*)(lds + (o2 ^ 64)), b10 = *(const LAS bf16x8*)(lds + o2 + 2048), b11 = *(const LAS bf16x8*)(lds + ((o2 ^ 64) + 2048));
    acc[0] = __builtin_amdgcn_mfma_f32_16x16x32_bf16(a0, b00, acc[0], 0, 0, 0); acc[0] = __builtin_amdgcn_mfma_f32_16x16x32_bf16(a1, b01, acc[0], 0, 0, 0);
    acc[1] = __builtin_amdgcn_mfma_f32_16x16x32_bf16(a0, b10, acc[1], 0, 0, 0); acc[1] = __builtin_amdgcn_mfma_f32_16x16x32_bf16(a1, b11, acc[1], 0, 0, 0);
}
struct Fr { bf16x8 a0, a1, b00, b01, b10, b11; };
__device__ __forceinline__ void ldf(Fr& f, LAS unsigned char* lds, int z1, int z2, int ta, int tbh, int fr, int fq) {
    const int o1 = z1 + t64(16 * ta + fr, fq), o2 = z2 + t64(32 * tbh + fr, fq);
    f.a0 = *(const LAS bf16x8*)(lds + o1); f.a1 = *(const LAS bf16x8*)(lds + (o1 ^ 64));
    f.b00 = *(const LAS bf16x8*)(lds + o2); f.b01 = *(const LAS bf16x8*)(lds + (o2 ^ 64)); f.b10 = *(const LAS bf16x8*)(lds + o2 + 2048); f.b11 = *(const LAS bf16x8*)(lds + ((o2 ^ 64) + 2048));
}
__device__ __forceinline__ void mcf(f32x4 (&acc)[2], const Fr& f) {
    acc[0] = __builtin_amdgcn_mfma_f32_16x16x32_bf16(f.a0, f.b00, acc[0], 0, 0, 0); acc[1] = __builtin_amdgcn_mfma_f32_16x16x32_bf16(f.a0, f.b10, acc[1], 0, 0, 0);
    acc[0] = __builtin_amdgcn_mfma_f32_16x16x32_bf16(f.a1, f.b01, acc[0], 0, 0, 0); acc[1] = __builtin_amdgcn_mfma_f32_16x16x32_bf16(f.a1, f.b11, acc[1], 0, 0, 0);
}
template <int MASK, bool DIAG1> __device__ __forceinline__ void st_lds(const f32x4 (&acc)[2], LAS unsigned char* lds, int dst, int ta, int tbh, int fr, int fq) {
#pragma unroll
    for (int tb = 0; tb < 2; ++tb) { const int b = 32 * tbh + 16 * tb + fr, a0 = 16 * ta + 4 * fq; float v[4];
#pragma unroll
        for (int i = 0; i < 4; ++i) { const int a = a0 + i; float x = acc[tb][i];
            if (MASK == 1) x = (a < b) ? x : 0.f; if (MASK == 2) x = (a <= b) ? x : 0.f; if (MASK == 3) x = (b < a) ? x : 0.f; if (DIAG1) x = (a == b) ? 1.f : x; v[i] = x; }
        u32x2 w; w.x = pkbf(v[0], v[1]); w.y = pkbf(v[2], v[3]); *(LAS u32x2*)(lds + dst + t64(b, a0 >> 3) + (a0 & 4) * 2) = w; }
}
template <bool PERM> __device__ __forceinline__ void st_glb(const f32x4 (&acc)[2], bf16* g, int ta, int tbh, int fr, int fq) {
#pragma unroll
    for (int tb = 0; tb < 2; ++tb) { const int b = 32 * tbh + 16 * tb + fr; int a0 = 16 * ta + 4 * fq; if (PERM) a0 = (a0 & ~12) | ((a0 & 4) << 1) | ((a0 & 8) >> 1);
        u32x2 w; w.x = pkbf(acc[tb][0], acc[tb][1]); w.y = pkbf(acc[tb][2], acc[tb][3]); *(GAS u32x2*)(g + (size_t)b * 64 + a0) = w; }
}

__device__ __forceinline__ float wsum_fast(float x) { x = red16(x);
    x += __builtin_bit_cast(float, __builtin_amdgcn_update_dpp(0, __builtin_bit_cast(int, x), 0x142, 0xa, 0xf, false));
    x += __builtin_bit_cast(float, __builtin_amdgcn_update_dpp(0, __builtin_bit_cast(int, x), 0x143, 0xc, 0xf, false));
    return __builtin_bit_cast(float, __builtin_amdgcn_readlane(__builtin_bit_cast(int, x), 63)); }
__device__ __forceinline__ void pk_acc(u32x2 (&d)[2], const f32x4 (&acc)[2]) {
#pragma unroll
    for (int tb = 0; tb < 2; ++tb) { d[tb].x = pkbf(acc[tb][0], acc[tb][1]); d[tb].y = pkbf(acc[tb][2], acc[tb][3]); }
}
template <bool PERM> __device__ __forceinline__ void st_pk(const u32x2 (&d)[2], bf16* g, int ta, int tbh, int fr, int fq) {
#pragma unroll
    for (int tb = 0; tb < 2; ++tb) { const int b = 32 * tbh + 16 * tb + fr; int a0 = 16 * ta + 4 * fq;
        if (PERM) { a0 = (a0 & ~12) | ((a0 & 4) << 1) | ((a0 & 8) >> 1);
            const int t1 = b >> 5, r32 = b & 31, t2 = a0 >> 5, s = (a0 >> 4) & 1, hi = (a0 >> 3) & 1;
            *(GAS u32x2*)((char*)g + (((t1 * 2 + t2) * 2 + s) * 1024) + (hi * 32 + r32) * 16 + (a0 & 7) * 2) = d[tb]; }
        else *(GAS u32x2*)(g + (size_t)b * 64 + a0) = d[tb]; }
}
__device__ __forceinline__ void st_f32(const f32x4 (&d)[2], float* g, int ta, int tbh, int fr, int fq) {
#pragma unroll
    for (int tb = 0; tb < 2; ++tb) { const int b = 32 * tbh + 16 * tb + fr, a0 = 16 * ta + 4 * fq;
        const int tv = b >> 5, r32 = b & 31, tk = a0 >> 5, gq = (a0 >> 3) & 3, hi = (a0 >> 2) & 1;
        *(GAS f32x4*)((char*)g + (((tk * 2 + tv) * 4 + gq) * 1024) + (hi * 32 + r32) * 16) = d[tb]; }
}
constexpr int LS2 = 272;
__device__ __forceinline__ void mm128(f32x4 (&acc)[2], LAS unsigned char* lds, int z1, int z2, int ta, int tbh, int fr, int fq) {
#pragma unroll
    for (int s = 0; s < 4; ++s) { const bf16x8 a = *(const LAS bf16x8*)(lds + z1 + t128(16 * ta + fr, 4 * s + fq)), b0 = *(const LAS bf16x8*)(lds + z2 + t128(32 * tbh + fr, 4 * s + fq)), b1 = *(const LAS bf16x8*)(lds + z2 + t128(32 * tbh + 16 + fr, 4 * s + fq));
        acc[0] = __builtin_amdgcn_mfma_f32_16x16x32_bf16(a, b0, acc[0], 0, 0, 0); acc[1] = __builtin_amdgcn_mfma_f32_16x16x32_bf16(a, b1, acc[1], 0, 0, 0); }
}
__device__ __forceinline__ void st_lds_f32(const f32x4 (&acc)[2], LAS unsigned char* lds, int dst, int ta, int tbh, int fr, int fq) {
#pragma unroll
    for (int tb = 0; tb < 2; ++tb) { const int b = 32 * tbh + 16 * tb + fr, a0 = 16 * ta + 4 * fq; *(LAS f32x4*)(lds + dst + b * LS2 + a0 * 4) = acc[tb]; }
}

__device__ __forceinline__ void scan_pre(Frame& F) {
    LAS unsigned char* lds = F.lds + RING_OFF;
    const int w = F.wave, lane = F.lane, fr = lane & 15, fq = lane >> 4, ta = w & 3, tbh = w >> 2;
    const bf16* Z = (const bf16*)(F.ws + WS_Z); const float* mu = INP(4);
    const bf16* WupT = (const bf16*)(F.ws + WS_LORA); const bf16* AupT = WupT + RW * 64; const bf16* GupT = AupT + RW * 64;
    bf16* aLW = (bf16*)(F.dout + DO_W); bf16* aKP = (bf16*)(F.dout + DO_KP); bf16* aKK = (bf16*)(F.dout + DO_KKN); float* aNT = (float*)(F.ws + WS_NT);
    bf16* oG = (bf16*)(F.ws + WS_GATE); float* oBon = (float*)(F.ws + WS_BON);
    enum { bAt = 0, bBt = LB, bKt = 2 * LB, bRt = 3 * LB, bAtT = 4 * LB, bVT = 5 * LB, bBhT = 6 * LB, bKhT = 7 * LB, b8 = 8 * LB, b9 = 9 * LB, b10 = 10 * LB, bAak = 11 * LB, bArb = 12 * LB, bArk = 13 * LB };
    enum { lXw = 0, lXa = LB, lXg = 2 * LB, lWw = 4 * LB, lWa = 5 * LB, lWg = 6 * LB, lDw = 8 * LB, lDa = lDw + 64 * LS2, lDg = lDa + 64 * LS2, lSum = lDg + 64 * LS2 };
    static_assert(lWg + 2 * LB <= 8 * LB && lSum + 2048 <= RING_BYTES, "LoRA stage LDS carve");
#ifdef PROBE_SEG
    unsigned long long sg_[8] = {0, 0, 0, 0, 0, 0, 0, 0}, sgt_;
#define SEG0() sgt_ = __builtin_amdgcn_s_memrealtime()
#define SEG(j) do { const unsigned long long n_ = __builtin_amdgcn_s_memrealtime(); sg_[j] += n_ - sgt_; sgt_ = n_; } while (0)
#else
#define SEG0() do {} while (0)
#define SEG(j) do {} while (0)
#endif
    const float* pW0 = INP(5); const float* pA0 = INP(7); const float* pKK = INP(10); const float* pKA = INP(11); const float* pRK = INP(12);
    enum { lMu = lSum + 2048 };
    static_assert(lMu + 1024 <= RING_BYTES, "LDS carve");
    if (F.tid < 256) *(LAS float*)(lds + lMu + F.tid * 4) = mu[ZWD + F.tid];
    __syncthreads();
    float hp[8];
    u32x4 cur[4], prv[4], wpf[4]; unsigned short zr_[9], zk_[9], zv_[9];
    u32x2 dq[3][2]; f32x4 dqn[2]; size_t dso = 0; bool dpend = false;
#define PF_ISSUE(uu) do { const int c_ = (uu) % NCHUNK, bh_ = (uu) / NCHUNK, b_ = bh_ / NH, h_ = bh_ % NH; const size_t m0_ = (size_t)b_ * T + (size_t)c_ * 64; \
        { const int row_ = F.tid >> 3, ch_ = F.tid & 7; wpf[0] = *(const GAS u32x4*)(WupT + (size_t)(h_ * HD + row_) * 64 + ch_ * 8); wpf[1] = *(const GAS u32x4*)(AupT + (size_t)(h_ * HD + row_) * 64 + ch_ * 8); \
          wpf[2] = *(const GAS u32x4*)(GupT + (size_t)(h_ * HD + (F.tid >> 4)) * 128 + (F.tid & 15) * 8); wpf[3] = *(const GAS u32x4*)(GupT + (size_t)(h_ * HD + 32 + (F.tid >> 4)) * 128 + (F.tid & 15) * 8); } \
        { const int t_ = F.tid >> 3, g0_ = F.tid & 7; const bf16* zrow = Z + (m0_ + t_) * NIN + ZWD; const bool firstrow = (c_ == 0 && t_ == 0); \
          _Pragma("unroll") for (int i = 0; i < 4; ++i) { cur[i] = *(const GAS u32x4*)(zrow + 8 * (g0_ + 8 * i)); prv[i] = (u32x4){0u, 0u, 0u, 0u}; if (!firstrow) prv[i] = *(const GAS u32x4*)(zrow - (long)NIN + 8 * (g0_ + 8 * i)); } } \
        { const int cg_ = h_ * HD + lane; hp[0] = pW0[cg_]; hp[1] = pA0[cg_]; hp[2] = pKK[cg_]; hp[3] = pKA[cg_]; hp[4] = pRK[cg_]; hp[5] = mu[cg_]; hp[6] = mu[ZK_R + cg_]; hp[7] = mu[ZV_R + cg_]; } \
        { const bf16* zr = Z + (m0_ + 8 * w) * NIN + h_ * HD + lane; const bool first = (c_ == 0 && w == 0); \
          zr_[0] = 0; zk_[0] = 0; zv_[0] = 0; if (!first) { zr_[0] = zr[-(long)NIN]; zk_[0] = zr[-(long)NIN + ZK_R]; zv_[0] = zr[-(long)NIN + ZV_R]; } \
          _Pragma("unroll") for (int i = 0; i < 8; ++i) { zr_[i + 1] = zr[(size_t)i * NIN]; zk_[i + 1] = zr[(size_t)i * NIN + ZK_R]; zv_[i + 1] = zr[(size_t)i * NIN + ZV_R]; } } } while (0)
    if (F.vcu < BATCH * NH * NCHUNK) PF_ISSUE(F.vcu);
    for (int u = F.vcu; u < BATCH * NH * NCHUNK; u += F.G) {
        SEG0();
        const int c = u % NCHUNK, bh = u / NCHUNK, b = bh / NH, h = bh % NH;
        const size_t m0 = (size_t)b * T + (size_t)c * 64;
        const size_t so = (size_t)u * 4096;
        { const int t = F.tid >> 3, g0 = F.tid & 7;
          { const int row = F.tid >> 3, ch = F.tid & 7;
            *(LAS u32x4*)(lds + lWw + t64(row, ch)) = wpf[0]; *(LAS u32x4*)(lds + lWa + t64(row, ch)) = wpf[1]; }
          { const int row = F.tid >> 4, ch = F.tid & 15; *(LAS u32x4*)(lds + lWg + t128(row, ch)) = wpf[2]; *(LAS u32x4*)(lds + lWg + t128(row + 32, ch)) = wpf[3]; }
#pragma unroll
          for (int i = 0; i < 4; ++i) { const int col0 = 8 * (g0 + 8 * i); const f32x4 ma = *(const LAS f32x4*)(lds + lMu + col0 * 4), mb = *(const LAS f32x4*)(lds + lMu + col0 * 4 + 16);
              float z[8];
#pragma unroll
              for (int q = 0; q < 4; ++q) { const unsigned cw = cur[i][q], pw = prv[i][q]; const float c0 = bflo(cw), c1 = bfhi(cw), p0 = bflo(pw), p1 = bfhi(pw);
                  const float m0_ = q < 2 ? ma[2 * q] : mb[2 * q - 4], m1_ = q < 2 ? ma[2 * q + 1] : mb[2 * q - 3];
                  z[2 * q] = c0 + (p0 - c0) * m0_; z[2 * q + 1] = c1 + (p1 - c1) * m1_; }
#pragma unroll
              for (int q = 0; q < 8; ++q) { if (i == 0) z[q] = 1.f - 2.f * __builtin_amdgcn_rcpf(1.f + __expf(2.f * z[q])); else if (i >= 2) z[q] = __builtin_amdgcn_rcpf(1.f + __expf(-z[q])); }
              u32x4 o; o.x = pkbf(z[0], z[1]); o.y = pkbf(z[2], z[3]); o.z = pkbf(z[4], z[5]); o.w = pkbf(z[6], z[7]);
              const int dst = i == 0 ? lXw + t64(t, g0) : (i == 1 ? lXa + t64(t, g0) : lXg + t128(t, (i - 2) * 8 + g0));
              *(LAS u32x4*)(lds + dst) = o; }
        }
        __syncthreads(); SEG(0);
        { f32x4 acc[2];
          acc[0] = (f32x4){0.f, 0.f, 0.f, 0.f}; acc[1] = acc[0]; mm(acc, lds, lWw, lXw, ta, tbh, fr, fq); st_lds_f32(acc, lds, lDw, ta, tbh, fr, fq);
          acc[0] = (f32x4){0.f, 0.f, 0.f, 0.f}; acc[1] = acc[0]; mm(acc, lds, lWa, lXa, ta, tbh, fr, fq); st_lds_f32(acc, lds, lDa, ta, tbh, fr, fq);
          acc[0] = (f32x4){0.f, 0.f, 0.f, 0.f}; acc[1] = acc[0]; mm128(acc, lds, lWg, lXg, ta, tbh, fr, fq); st_lds_f32(acc, lds, lDg, ta, tbh, fr, fq); }
        __syncthreads(); SEG(1);
        if (dpend) { st_pk<false>(dq[0], aLW + dso, ta, tbh, fr, fq); st_pk<false>(dq[1], aKK + dso, ta, tbh, fr, fq); st_pk<true>(dq[2], aKP + dso, ta, tbh, fr, fq); st_f32(dqn, aNT + dso, ta, tbh, fr, fq); }
        { const int cg = h * HD + lane;
          const float w0_ = hp[0], a0_ = hp[1], kkc = hp[2], kac = hp[3], rkc = hp[4], mur = hp[5], muk = hp[6], muv = hp[7];
          float lwv[8], e_at[8], e_bb[8], e_kp[8], e_r[8], e_v[8]; float lsum = 0.f;
#pragma unroll
          for (int i = 0; i < 8; ++i) { const int t = 8 * w + i;
              const float cr = bf2f(zr_[i + 1]), ck = bf2f(zk_[i + 1]), cv = bf2f(zv_[i + 1]), pr = bf2f(zr_[i]), pk = bf2f(zk_[i]), pv = bf2f(zv_[i]);
              const float r = cr + (pr - cr) * mur, kx = ck + (pk - ck) * muk, v = cv + (pv - cv) * muv;
              const float dw = w0_ + *(const LAS float*)(lds + lDw + t * LS2 + lane * 4), da = a0_ + *(const LAS float*)(lds + lDa + t * LS2 + lane * 4), gg = *(const LAS float*)(lds + lDg + t * LS2 + lane * 4);
              const float lw = -DECAY_SCALE * __builtin_amdgcn_rcpf(1.f + __expf(-dw)), a = __builtin_amdgcn_rcpf(1.f + __expf(-da));
              const float kk = kx * kkc; const float nn = wsum_fast(kk * kk); const float kkn = kk * __builtin_amdgcn_rsqf(fmaxf(nn, 1e-24f));
              const float kp = kx * (1.f + (a - 1.f) * kac), bb = kkn * a; const float bon = wsum_fast(r * kp * rkc);
              oG[(m0 + t) * RW + cg] = (bf16)f2bf(gg); if (lane == 0) oBon[(m0 + t) * NH + h] = bon;
              lwv[i] = lw; lsum += lw; e_at[i] = -kkn; e_bb[i] = bb; e_kp[i] = kp; e_r[i] = r; e_v[i] = v; }
          *(LAS float*)(lds + lSum + (w * 64 + lane) * 4) = lsum;
          __syncthreads(); SEG(2);
          if (u + F.G < BATCH * NH * NCHUNK) PF_ISSUE(u + F.G);
          float ltot = 0.f, lst = 0.f;
#pragma unroll
          for (int q = 0; q < 8; ++q) { const float sq = *(const LAS float*)(lds + lSum + (q * 64 + lane) * 4); if (q < w) lst += sq; ltot += sq; }
          float L = lst; unsigned short pAtT[8], pVT[8], pBhT[8], pKhT[8];
#pragma unroll
          for (int i = 0; i < 8; ++i) { const int t = 8 * w + i;
              const float Pm = __expf(L); L += lwv[i]; const float P = __expf(L), iP = __expf(-L), Ph = __expf(ltot - L);
              const unsigned short at = (unsigned short)f2bf(e_at[i] * Pm);
              const int eo = t64(t, lane >> 3) + (lane & 7) * 2;
              *(LAS unsigned short*)(lds + bAt + eo) = at; *(LAS unsigned short*)(lds + bBt + eo) = (unsigned short)f2bf(e_bb[i] * iP);
              *(LAS unsigned short*)(lds + bKt + eo) = (unsigned short)f2bf(e_kp[i] * iP); *(LAS unsigned short*)(lds + bRt + eo) = (unsigned short)f2bf(e_r[i] * P);
              pAtT[i] = at; pVT[i] = (unsigned short)f2bf(e_v[i]); pBhT[i] = (unsigned short)f2bf(e_bb[i] * Ph); pKhT[i] = (unsigned short)f2bf(e_kp[i] * Ph); }
#define RS_W16(buf, p) do { u32x4 q_; q_.x = p[0] | ((unsigned)p[1] << 16); q_.y = p[2] | ((unsigned)p[3] << 16); q_.z = p[4] | ((unsigned)p[5] << 16); q_.w = p[6] | ((unsigned)p[7] << 16); *(LAS u32x4*)(lds + (buf) + t64(lane, w)) = q_; } while (0)
          RS_W16(bAtT, pAtT); RS_W16(bVT, pVT); RS_W16(bBhT, pBhT); RS_W16(bKhT, pKhT);
#undef RS_W16
          asm volatile("" :: "v"(ltot));
          __syncthreads(); SEG(3);
          f32x4 acc[2], acc2[2], acc3[2], acc4[2], tacc[2];
#define RS_Z(a) do { a[0] = (f32x4){0.f, 0.f, 0.f, 0.f}; a[1] = (f32x4){0.f, 0.f, 0.f, 0.f}; } while (0)
#define LD(f, z1, z2) ldf(f, lds, z1, z2, ta, tbh, fr, fq)
#define ST(m, a, dst) st_lds<m, false>(a, lds, dst, ta, tbh, fr, fq)
          { Fr f0, f1, f2; LD(f0, bAt, bBt); LD(f1, bKt, bAt); LD(f2, bBt, bRt);
            RS_Z(acc); RS_Z(acc2); RS_Z(acc3); mcf(acc, f0); mcf(acc2, f1); mcf(acc3, f2);
            ST(3, acc, b9);
            ST(1, acc2, bAak);
            ST(2, acc3, bArb); }
          { Fr f3, f4; LD(f3, bKt, bRt); LD(f4, bBt, bAt); RS_Z(acc4); RS_Z(tacc); mcf(acc4, f3); mcf(tacc, f4);
            ST(2, acc4, bArk); }
#pragma unroll
          for (int tb = 0; tb < 2; ++tb)
#pragma unroll
              for (int i = 0; i < 4; ++i) { const int bb_ = 32 * tbh + 16 * tb + fr, a = 16 * ta + 4 * fq + i; tacc[tb][i] = (a < bb_) ? tacc[tb][i] : 0.f; }
          ST(0, tacc, b8);
#pragma unroll
          for (int tb = 0; tb < 2; ++tb)
#pragma unroll
              for (int i = 0; i < 4; ++i) { const int bb_ = 32 * tbh + 16 * tb + fr, a = 16 * ta + 4 * fq + i; if (a == bb_) tacc[tb][i] = 1.f; }
          ST(0, tacc, b10);
          __syncthreads();
          { Fr f0, f1; LD(f0, b9, b8); LD(f1, b8, b9); RS_Z(acc); RS_Z(acc2); mcf(acc, f0); mcf(acc2, f1); ST(0, acc, bAt); ST(0, acc2, bBt); }
          __syncthreads();
          { Fr f0, f1, f2; LD(f0, bBt, b10); LD(f1, bBt, bAt); LD(f2, bAt, bBt); RS_Z(acc); RS_Z(acc2); mcf(tacc, f0); mcf(acc, f1); mcf(acc2, f2); ST(0, tacc, bKt); ST(0, acc, b8); ST(0, acc2, b9); }
          __syncthreads();
          { Fr f0, f1, f2; LD(f0, b9, bKt); LD(f1, b9, b8); LD(f2, b8, b9); RS_Z(acc); RS_Z(acc2); mcf(tacc, f0); mcf(acc, f1); mcf(acc2, f2); ST(0, tacc, b10); ST(0, acc, bAt); ST(0, acc2, bBt); }
          __syncthreads();
          { Fr f0, f1, f2; LD(f0, bBt, b10); LD(f1, bBt, bAt); LD(f2, bAt, bBt); RS_Z(acc); RS_Z(acc2); mcf(tacc, f0); mcf(acc, f1); mcf(acc2, f2); ST(0, tacc, bKt); ST(0, acc, b8); ST(0, acc2, b9); }
          __syncthreads();
          { Fr f0, f1; LD(f0, b9, bKt); LD(f1, b8, b9); RS_Z(acc); mcf(tacc, f0); mcf(acc, f1); ST(0, tacc, b10); ST(0, acc, bBt); }
          __syncthreads();
          { Fr f0; LD(f0, bBt, b10); mcf(tacc, f0); ST(0, tacc, bKt); }
          __syncthreads(); SEG(4);
          { Fr f0, f1; LD(f0, bKt, bAtT); LD(f1, bAak, bVT); RS_Z(acc); RS_Z(acc2); mcf(acc, f0); mcf(acc2, f1); ST(0, acc, bAt); ST(0, acc2, b8); }
          __syncthreads();
          { Fr f0; LD(f0, bKt, b8); RS_Z(acc); mcf(acc, f0); ST(0, acc, b9); }
          __syncthreads();
          { Fr f0, f1, f2; LD(f0, bAt, bArb); LD(f1, b9, bArb); LD(f2, bVT, bArk);
            u32x2 rq[2];
#pragma unroll
            for (int tb = 0; tb < 2; ++tb) { const int bb_ = 32 * tbh + 16 * tb + fr, a0 = 16 * ta + 4 * fq; rq[tb] = *(const LAS u32x2*)(lds + bRt + t64(bb_, a0 >> 3) + (a0 & 4) * 2); }
            RS_Z(acc); mcf(acc, f0);
#pragma unroll
            for (int tb = 0; tb < 2; ++tb) { acc[tb][0] += bflo(rq[tb].x); acc[tb][1] += bfhi(rq[tb].x); acc[tb][2] += bflo(rq[tb].y); acc[tb][3] += bfhi(rq[tb].y); }
            pk_acc(dq[0], acc);
            RS_Z(acc2); mcf(acc2, f1); mcf(acc2, f2); pk_acc(dq[1], acc2); }
          { Fr f3, f4, f5; LD(f3, bAt, bBhT); LD(f4, bBhT, b9); LD(f5, bKhT, bVT);
            RS_Z(acc3); mcf(acc3, f3);
            { const float pc = __expf(ltot);
#pragma unroll
              for (int tb = 0; tb < 2; ++tb) { const int bb_ = 32 * tbh + 16 * tb + fr; const float pcb = __shfl(pc, bb_);
#pragma unroll
                  for (int i = 0; i < 4; ++i) { const int a = 16 * ta + 4 * fq + i; if (a == bb_) acc3[tb][i] += pcb; } } }
            pk_acc(dq[2], acc3);
            RS_Z(acc4); mcf(acc4, f4); mcf(acc4, f5); dqn[0] = acc4[0]; dqn[1] = acc4[1]; dso = so; dpend = true; }
#undef LD
#undef ST
#undef RS_Z
          __syncthreads(); SEG(5);
        }
    }
#undef PF_ISSUE
    if (dpend) { st_pk<false>(dq[0], aLW + dso, ta, tbh, fr, fq); st_pk<false>(dq[1], aKK + dso, ta, tbh, fr, fq); st_pk<true>(dq[2], aKP + dso, ta, tbh, fr, fq); st_f32(dqn, aNT + dso, ta, tbh, fr, fq); }
#ifdef PROBE_SEG
    if (blockIdx.x == 0 && threadIdx.x == 0) { unsigned long long* st = (unsigned long long*)(F.ws + WS_CTL + 65536); st[40] = 0; st[41] = sg_[PROBE_SEG]; }
#endif
}

__device__ __forceinline__ void scan_seq(Frame& F, int bh) {
    LAS unsigned char* lds = F.lds + RING_OFF;
    const int lane = F.lane, w = F.wave, r32 = lane & 31, hi = lane >> 5;
    const bf16* aM = (const bf16*)(F.dout + DO_KP); const float* aN = (const float*)(F.ws + WS_NT); bf16* XS = (bf16*)(F.ws + WS_YRAW);
    bf16x8 am[2][2][2]; f32x16 ci[2][2];
#define SQ_LOAD(cc) do { const size_t so_ = ((size_t)bh * NCHUNK + (cc)) * 4096; \
        _Pragma("unroll") for (int t1 = 0; t1 < 2; ++t1) _Pragma("unroll") for (int t2 = 0; t2 < 2; ++t2) _Pragma("unroll") for (int s = 0; s < 2; ++s) \
            am[t1][t2][s] = *(const GAS bf16x8*)((const char*)(aM + so_) + (((t1 * 2 + t2) * 2 + s) * 1024) + lane * 16); \
        _Pragma("unroll") for (int tk = 0; tk < 2; ++tk) _Pragma("unroll") for (int tv = 0; tv < 2; ++tv) _Pragma("unroll") for (int g = 0; g < 4; ++g) { \
            const f32x4 q_ = *(const GAS f32x4*)((const char*)(aN + so_) + (((tk * 2 + tv) * 4 + g) * 1024) + lane * 16); ci[tk][tv][4 * g + 0] = q_[0]; ci[tk][tv][4 * g + 1] = q_[1]; ci[tk][tv][4 * g + 2] = q_[2]; ci[tk][tv][4 * g + 3] = q_[3]; } } while (0)
    SQ_LOAD(w);
    for (int i = F.tid; i < 8192 / 16; i += 512) *(LAS u32x4*)(lds + i * 16) = (u32x4){0u, 0u, 0u, 0u};
    for (int c = 0; c < NCHUNK; ++c) {
        const int t = c & 7; const int rb = (c & 3) * 8192, wb = ((c + 1) & 3) * 8192;
        __syncthreads();
        if (t == w) {
            bf16x8 xb[2][2][2];
#pragma unroll
            for (int tk = 0; tk < 2; ++tk)
#pragma unroll
                for (int tv = 0; tv < 2; ++tv)
#pragma unroll
                    for (int s = 0; s < 2; ++s) xb[tk][tv][s] = *(const LAS bf16x8*)(lds + rb + (((tk * 2 + tv) * 2 + s) * 1024) + lane * 16);
#pragma unroll
            for (int t1 = 0; t1 < 2; ++t1)
#pragma unroll
                for (int tv = 0; tv < 2; ++tv) { f32x16 a = ci[t1][tv];
#pragma unroll
                    for (int t2 = 0; t2 < 2; ++t2)
#pragma unroll
                        for (int s = 0; s < 2; ++s) a = __builtin_amdgcn_mfma_f32_32x32x16_bf16(am[t1][t2][s], xb[t2][tv][s], a, 0, 0, 0);
                    u32x4 f0, f1; f0.x = pkbf(a[0], a[1]); f0.y = pkbf(a[2], a[3]); f0.z = pkbf(a[4], a[5]); f0.w = pkbf(a[6], a[7]); f1.x = pkbf(a[8], a[9]); f1.y = pkbf(a[10], a[11]); f1.z = pkbf(a[12], a[13]); f1.w = pkbf(a[14], a[15]);
                    *(LAS u32x4*)(lds + wb + (((t1 * 2 + tv) * 2 + 0) * 1024) + lane * 16) = f0; *(LAS u32x4*)(lds + wb + (((t1 * 2 + tv) * 2 + 1) * 1024) + lane * 16) = f1; }
        } else if (t == ((w + 1) & 7)) {
            if (c - 1 + 8 < NCHUNK) SQ_LOAD(c - 1 + 8);
        } else if (t == ((w + 4) & 7)) {
            char* xs = (char*)(XS + ((size_t)bh * NCHUNK + c) * 4096);
#pragma unroll
            for (int q = 0; q < 8; ++q) *(GAS u32x4*)(xs + q * 1024 + lane * 16) = *(const LAS u32x4*)(lds + rb + q * 1024 + lane * 16);
        }
    }
    __syncthreads();
#undef SQ_LOAD
}

__device__ __forceinline__ void scan_post(Frame& F) {
    const int lane = F.lane, fr = lane & 15, fq = lane >> 4, tb = F.wave & 3;
    const bf16* aRh = (const bf16*)(F.dout + DO_W); const bf16* aYl = (const bf16*)(F.dout + DO_KKN); const bf16* XS = (const bf16*)(F.ws + WS_YRAW);
    const bf16* Zb = (const bf16*)(F.ws + WS_Z); const float* mu = INP(4); const bf16* aG = (const bf16*)(F.ws + WS_GATE); const float* bon = (const float*)(F.ws + WS_BON);
    bf16* Y = (bf16*)(F.ws + WS_Y); const float* lnw = INP(13); const float* lnb = INP(14);
    for (int u = F.vcu * 2 + (F.wave >> 2); u < BATCH * NH * NCHUNK; u += F.G * 2) {
        const int c = u % NCHUNK, bh = u / NCHUNK, b = bh / NH, h = bh % NH;
        const size_t m0 = (size_t)b * T + (size_t)c * 64, so = (size_t)u * 4096;
        const bf16* xs = XS + (size_t)u * 4096;
        const size_t trow = m0 + 16 * tb + fr;
        bf16x8 bf_[2];
#pragma unroll
        for (int s = 0; s < 2; ++s) bf_[s] = *(const GAS bf16x8*)(aRh + so + (size_t)(16 * tb + fr) * 64 + 32 * s + 8 * fq);
        f32x4 acc[4];
#pragma unroll
        for (int ta = 0; ta < 4; ++ta) { const u32x2 q_ = *(const GAS u32x2*)(aYl + so + (size_t)(16 * tb + fr) * 64 + 16 * ta + 4 * fq);
            acc[ta] = (f32x4){bflo(q_.x), bfhi(q_.x), bflo(q_.y), bfhi(q_.y)};
#pragma unroll
            for (int s = 0; s < 2; ++s) {
                const char* fb = (const char*)xs + (((s * 2 + (ta >> 1)) * 2 + (fq >> 1)) * 1024) + (16 * (ta & 1) + fr) * 16 + (fq & 1) * 8;
                const u32x2 l8 = *(const GAS u32x2*)(fb), h8 = *(const GAS u32x2*)(fb + 512); u32x4 a4; a4.x = l8.x; a4.y = l8.y; a4.z = h8.x; a4.w = h8.y;
                acc[ta] = __builtin_amdgcn_mfma_f32_16x16x32_bf16(__builtin_bit_cast(bf16x8, a4), bf_[s], acc[ta], 0, 0, 0); } }
        float s1 = 0.f;
#pragma unroll
        for (int ta = 0; ta < 4; ++ta) s1 += (acc[ta][0] + acc[ta][1]) + (acc[ta][2] + acc[ta][3]);
        s1 += __shfl_xor(s1, 16); s1 += __shfl_xor(s1, 32); const float mean = s1 * (1.f / 64.f); float s2 = 0.f;
#pragma unroll
        for (int ta = 0; ta < 4; ++ta)
#pragma unroll
            for (int i = 0; i < 4; ++i) { const float d_ = acc[ta][i] - mean; acc[ta][i] = d_; s2 += d_ * d_; }
        s2 += __shfl_xor(s2, 16); s2 += __shfl_xor(s2, 32); const float rstd = 1.f / sqrtf(s2 * (1.f / 64.f) + GN_EPS);
        const float bn = bon[trow * NH + h];
#pragma unroll
        for (int ta = 0; ta < 4; ++ta) { const int ch = h * HD + 16 * ta + 4 * fq; const f32x4 lw4 = *(const GAS f32x4*)(lnw + ch), lb4 = *(const GAS f32x4*)(lnb + ch);
            const u32x2 vc = *(const GAS u32x2*)(Zb + trow * NIN + ZV_R + ch), gq = *(const GAS u32x2*)(aG + trow * RW + ch); u32x2 vp; vp.x = 0u; vp.y = 0u;
            if ((trow % T) != 0) vp = *(const GAS u32x2*)(Zb + (trow - 1) * NIN + ZV_R + ch);
            const f32x4 mv = *(const GAS f32x4*)(mu + ZV_R + ch);
            const float v0 = bflo(vc.x) + (bflo(vp.x) - bflo(vc.x)) * mv[0], v1 = bfhi(vc.x) + (bfhi(vp.x) - bfhi(vc.x)) * mv[1], v2 = bflo(vc.y) + (bflo(vp.y) - bflo(vc.y)) * mv[2], v3 = bfhi(vc.y) + (bfhi(vp.y) - bfhi(vc.y)) * mv[3];
            const float o0 = (acc[ta][0] * rstd * lw4[0] + lb4[0] + bn * v0) * bflo(gq.x), o1 = (acc[ta][1] * rstd * lw4[1] + lb4[1] + bn * v1) * bfhi(gq.x);
            const float o2 = (acc[ta][2] * rstd * lw4[2] + lb4[2] + bn * v2) * bflo(gq.y), o3 = (acc[ta][3] * rstd * lw4[3] + lb4[3] + bn * v3) * bfhi(gq.y);
            u32x2 w_; w_.x = pkbf(o0, o1); w_.y = pkbf(o2, o3); *(GAS u32x2*)(Y + trow * D + ch) = w_; }
    }
}
}
using pg8::Unit;
constexpr size_t TILE_B = 256 * 2;
struct SchedBase { int G, c; };
struct SchedZ : SchedBase {
    __device__ __forceinline__ bool next(int i, Unit& u) const {
        const int L = i * G + c; constexpr int NZ = (M / 256) * (NIN / 256), NKV = (MEMR / 256) * (2 * D / 256);
        if (L < NZ) { pg8::tile_map(L, M / 256, NIN / 256, u.pm, u.pn); u.z = 0; u.a_off = WS_XN + (size_t)u.pm * 256 * D * 2; u.b_off = WS_WIN_T + (size_t)u.pn * 256 * D * 2; return true; }
        if (L < NZ + NKV) { const int l = L - NZ; u.pm = l / 8; u.pn = l % 8; u.z = 1; u.a_off = WS_MEMN + (size_t)u.pm * 256 * D * 2; u.b_off = WS_WXKV_T + (size_t)u.pn * 256 * D * 2; return true; }
        return false;
    }
};
struct SchedG : SchedBase {
    __device__ __forceinline__ bool next(int i, Unit& u) const {
        const int L = i * G + c; if (L >= 64) return false;
        u.z = L >> 4; u.pm = (L >> 2) & 3; u.pn = L & 3; u.a_off = WS_KV + ((size_t)u.pm * 256 * 2048 + u.z * 256) * 2; u.b_off = WS_WQ_S + ((size_t)u.pn * 256 * 1024 + u.z * 256) * 2; return true;
    }
};
struct SchedVW : SchedBase {
    __device__ __forceinline__ bool next(int i, Unit& u) const {
        const int L = i * G + (G - 1 - c); if (L >= 64) return false;
        u.z = L >> 2; u.pm = L & 3; u.pn = 0; const int b = u.z >> 2, h = u.z & 3;
        u.a_off = WS_WO_T + ((size_t)u.pm * 256 * 1024 + h * 256) * 2; u.b_off = WS_KV + ((size_t)b * 256 * 2048 + 1024 + h * 256) * 2; return true;
    }
};
struct SchedMN : SchedBase {
    int nN; size_t a_base, b_base; int lda, ldb, bsel;
    __device__ __forceinline__ bool next(int i, Unit& u) const {
        const int L = i * G + c; if (L >= (M / 256) * nN) return false;
        pg8::tile_map(L, M / 256, nN, u.pm, u.pn); u.z = 0;
        u.a_off = a_base + (size_t)u.pm * 256 * lda * 2; u.b_off = b_base + ((size_t)u.pn * 256 + (bsel ? (size_t)(u.pm >> 5) * 1024 : 0)) * ldb * 2; return true;
    }
};

constexpr int CW_MQ = 8192;
__device__ __forceinline__ void moba_attn_phase(Frame& F, int bx) {
    const bf16* Z = (const bf16*)(F.ws + WS_Z); bf16* Y = (bf16*)(F.ws + WS_Y) + RW; const float* KM = (const float*)(F.ws + WS_KMEAN);
    const bool perx = (F.G % 8 == 0); const int x = perx ? (bx & 7) : 0; const int nun = perx ? 128 : 1024;
    unsigned* qc = (unsigned*)(F.ctl + CW_MQ + 64 * x);
    volatile LAS unsigned* slot = F.MISC + 16;
    for (int it = 0;; ++it) {
        if (F.tid == 0) slot[it & 1] = __hip_atomic_fetch_add(qc, 1u, __ATOMIC_RELAXED, __HIP_MEMORY_SCOPE_AGENT);
        asm volatile("s_waitcnt vmcnt(0) lgkmcnt(0)" ::: "memory"); __builtin_amdgcn_s_barrier(); asm volatile("" ::: "memory");
        const int idx = __builtin_amdgcn_readfirstlane((int)slot[it & 1]);
        if (idx >= nun) break;
        const int bh = perx ? x * 4 + (idx & 3) : (idx & 31), qb = perx ? 31 - (idx >> 2) : 31 - (idx >> 5);
        int ln = F.lane; asm volatile("" : "+v"(ln)); ln &= 63;
        attn_body::attn_unit<8>(bh / NH, bh % NH, qb, Z + ZQ, Z + ZK, Z + ZV, Y, KM + (size_t)bh * NBLK * HD, (char*)F.lds + RING_OFF, F.wave, ln);
    }
}

#ifndef MK_N_LAUNCHES
#define MK_N_LAUNCHES 1
#endif
constexpr int PER_PHASE = 12;
constexpr int N_LAUNCHES = MK_N_LAUNCHES;
constexpr int SCAN_WGS = 64;
struct Args { const float* in[25]; float* out; unsigned char* ws; int ph_lo, ph_hi, li, pad; };
__global__ void __launch_bounds__(NWAVES * 64, 2) skel_fwd(Args args) {
    extern __shared__ __attribute__((aligned(16))) unsigned char lds[];
    Frame F;
    F.lds = (LAS unsigned char*)lds;
    F.MISC = (volatile LAS unsigned*)(F.lds + MISC_OFF);
    F.tid = threadIdx.x; F.lane = F.tid & 63; F.wave = __builtin_amdgcn_readfirstlane(F.tid >> 6) & 7;
    F.G = gridDim.x; { const int bx = blockIdx.x; F.vcu = (F.G % 8 == 0) ? (bx % 8) * (F.G / 8) + bx / 8 : bx; }
    F.ws = args.ws; F.dout = (unsigned char*)args.out;
#pragma unroll
    for (int i = 0; i < 25; ++i) F.in[i] = args.in[i];
    F.ctl = (gu32*)(F.ws + WS_CTL);
    for (int u = F.tid; u < (EPI_LDS_OFF - LDSCTL_OFF) / 4; u += NWAVES * 64) ((LAS unsigned*)(F.lds + LDSCTL_OFF))[u] = 0u;
    __syncthreads();
    XcdBarrier bar; bar.bar = (unsigned*)(F.ctl + CW_BAR); bar.x = 0; bar.st = nullptr;
    if (N_LAUNCHES == 1) bar = xcd_barrier_post((unsigned*)(F.ctl + CW_BAR), F.MISC + 8);
#ifdef PROBE_PHASE
    unsigned long long* stamps = (unsigned long long*)(F.ws + WS_CTL + 65536); int nst = 0;
#define STAMP() do { if (blockIdx.x == 0 && threadIdx.x == 0) stamps[nst] = __builtin_amdgcn_s_memrealtime(); ++nst; } while (0)
#else
#define STAMP() do {} while (0)
#endif
#define GRID_BAR() do { if (N_LAUNCHES == 1) xcd_barrier(bar); STAMP(); } while (0)
    const int lo = args.ph_lo, hi = args.ph_hi;
#ifndef PHASE_MASK
#define PHASE_MASK 0xFFFF
#endif
#define IN(k) (((PHASE_MASK >> (k)) & 1) && lo <= (k) && (k) < hi)
#define BOTH(k) (IN(k) && IN((k) + 1))
#define FRESH() do { int l_; asm volatile("v_mbcnt_lo_u32_b32 %0, -1, 0\n\tv_mbcnt_hi_u32_b32 %0, -1, %0" : "=v"(l_)); F.lane = l_ & 63; F.tid = F.wave * 64 + F.lane; } while (0)
    const char* wsc = (const char*)F.ws;
    const int bx = (int)blockIdx.x;

    STAMP();
    if (IN(0)) { FRESH(); if (blockIdx.x == 0 && F.tid == 0) { _Pragma("unroll") for (int i = 0; i < 25; ++i) ((GAS unsigned long long*)(F.ws + WS_TAB))[i] = (unsigned long long)F.in[i]; }
        p0_prologue(F); if (BOTH(0)) GRID_BAR(); }
    if (IN(1)) {
        pg8::Gemm g{wsc, wsc, D, D, D}; SchedZ S; S.G = F.G; S.c = bx;
        pg8::EpiStoreBf16 E{(bf16*)(F.ws + WS_Z), NIN, (bf16*)(F.ws + WS_KV), 2 * D, ZQ / 256, attn_body::C2, 0};
        pg8::gemm_phase<pg8::EpiStoreBf16, SchedZ, true>(F.lds + RING_OFF, g, S, E, F.wave);
        if (BOTH(1)) GRID_BAR();
    }
    if (IN(2)) {
        { pg8::Gemm g{wsc, wsc, 2 * D, D, 256}; SchedG S; S.G = F.G; S.c = bx;
          pg8::EpiStoreBf16 E{(bf16*)(F.ws + WS_GT), D, nullptr, 0, 0, 1.f, 1};
          pg8::gemm_phase<pg8::EpiStoreBf16, SchedG, true>(F.lds + RING_OFF, g, S, E, F.wave); }
        { pg8::Gemm g{wsc, wsc, D, 2 * D, 256}; SchedVW S; S.G = F.G; S.c = bx;
          pg8::EpiStoreBf16 E{(bf16*)(F.ws + WS_VWT), D, nullptr, 0, 0, 1.f, 2};
          pg8::gemm_phase<pg8::EpiStoreBf16, SchedVW, true>(F.lds + RING_OFF, g, S, E, F.wave); }
        __syncthreads();
        FRESH(); kmean_simple(F);
        if (BOTH(2)) GRID_BAR();
    }
    if (IN(3)) { FRESH(); rscan::scan_pre(F); if (BOTH(3)) GRID_BAR(); }
    if (IN(4)) {
        FRESH();
#ifdef PROBE_SEQ
        { unsigned long long t0_ = __builtin_amdgcn_s_memrealtime();
          if (bx < BATCH * NH) rscan::scan_seq(F, bx);
          if (blockIdx.x == 0 && threadIdx.x == 0) { unsigned long long* st = (unsigned long long*)(F.ws + WS_CTL + 65536); st[41] = __builtin_amdgcn_s_memrealtime() - t0_; } }
#else
        if (bx < BATCH * NH) rscan::scan_seq(F, bx);
#endif
        moba_attn_phase(F, bx);
        if (BOTH(4)) GRID_BAR();
    }
    if (IN(5)) { FRESH(); rscan::scan_post(F); if (BOTH(5)) GRID_BAR(); }
    if (IN(6)) {
        pg8::Gemm g{wsc, wsc, D, D, D}; SchedMN S; S.G = F.G; S.c = bx; S.nN = D / 256; S.a_base = WS_Y; S.b_base = WS_WMIX_T; S.lda = D; S.ldb = D; S.bsel = 0;
        pg8::EpiRes<false, false> E{INP(0), nullptr, nullptr, (bf16*)(F.ws + WS_HB), (float*)(F.ws + WS_SS), D};
        pg8::gemm_phase<pg8::EpiRes<false, false>, SchedMN, true>(F.lds + RING_OFF, g, S, E, F.wave);
        if (BOTH(6)) GRID_BAR();
    }
    if (IN(7)) {
        pg8::Gemm g{wsc, wsc, D, D, D}; SchedMN S; S.G = F.G; S.c = bx; S.nN = D / 256; S.a_base = WS_HB; S.b_base = WS_GT; S.lda = D; S.ldb = D; S.bsel = 1;
        pg8::EpiSoftmax E{(bf16*)(F.ws + WS_P), D, (const float*)(F.ws + WS_SS), (PG8_LAS pg8::f32x2*)(F.lds + EPI_LDS_OFF)};
        pg8::gemm_phase<pg8::EpiSoftmax, SchedMN, true>(F.lds + RING_OFF, g, S, E, F.wave);
        if (BOTH(7)) GRID_BAR();
    }
    if (IN(8)) {
        pg8::Gemm g{wsc, wsc, D, D, D}; SchedMN S; S.G = F.G; S.c = bx; S.nN = D / 256; S.a_base = WS_P; S.b_base = WS_VWT; S.lda = D; S.ldb = D; S.bsel = 1;
        pg8::EpiRes<true, false> E{nullptr, (const bf16*)(F.ws + WS_HB), nullptr, (bf16*)(F.ws + WS_HB), (float*)(F.ws + WS_SS) + (size_t)M * 16, D};
        pg8::gemm_phase<pg8::EpiRes<true, false>, SchedMN, true>(F.lds + RING_OFF, g, S, E, F.wave);
        if (BOTH(8)) GRID_BAR();
    }
    if (IN(9)) {
        pg8::Gemm g{wsc, wsc, D, D, D}; SchedMN S; S.G = F.G; S.c = bx; S.nN = FF / 256; S.a_base = WS_HB; S.b_base = WS_W1_T; S.lda = D; S.ldb = D; S.bsel = 0;
        pg8::EpiSqRelu E{(bf16*)(F.ws + WS_AH), FF, (const float*)(F.ws + WS_SS) + (size_t)M * 16};
        pg8::gemm_phase<pg8::EpiSqRelu, SchedMN, true>(F.lds + RING_OFF, g, S, E, F.wave);
        if (BOTH(9)) GRID_BAR();
    }
    if (IN(10)) {
        pg8::Gemm g{wsc, wsc, FF, FF, FF}; SchedMN S; S.G = F.G; S.c = bx; S.nN = D / 256; S.a_base = WS_AH; S.b_base = WS_W2_T; S.lda = FF; S.ldb = FF; S.bsel = 0;
        pg8::EpiRes<true, false> E{nullptr, (const bf16*)(F.ws + WS_HB), nullptr, (bf16*)(F.ws + WS_HB), (float*)(F.ws + WS_SS) + (size_t)2 * M * 16, D};
        pg8::gemm_phase<pg8::EpiRes<true, false>, SchedMN, true>(F.lds + RING_OFF, g, S, E, F.wave);
        if (BOTH(10)) GRID_BAR();
    }
    if (IN(11)) { FRESH();
#ifdef PROBE_PHASE
        float pscale; { const unsigned long long* st = (const unsigned long long*)(F.ws + WS_CTL + 65536);
#if defined(PROBE_SEG) || defined(PROBE_SEQ)
          pscale = 1.f + (float)(st[41]) * 1e-6f; }
#else
          pscale = 1.f + (float)(st[PROBE_PHASE + 1] - st[PROBE_PHASE]) * 1e-6f; }
#endif
        final_norm(F, pscale);
#else
        final_norm(F, 1.f);
#endif
    }
#undef IN
#undef BOTH
}

extern "C" void kernel_launch(void* const* d_in, const int* in_sizes, int n_in, void* d_out, int out_size, void* d_ws, size_t ws_size, hipStream_t stream) {
    static int grid = 0;
    if (grid == 0) {
        if (n_in != 25 || in_sizes[0] != M * D || out_size != M * D || ws_size < WS_END) { fprintf(stderr, "kernel_launch: unexpected problem (n_in %d, in0 %d, out %d, ws %zu); nothing launched\n", n_in, n_in > 0 ? in_sizes[0] : -1, out_size, ws_size); grid = -1; return; }
        int dev = 0, cus = 0, per_cu = 0;
        if (hipGetDevice(&dev) != hipSuccess || hipDeviceGetAttribute(&cus, hipDeviceAttributeMultiprocessorCount, dev) != hipSuccess) { grid = -1; return; }
        if (hipFuncSetAttribute((const void*)skel_fwd, hipFuncAttributeMaxDynamicSharedMemorySize, LDS_BYTES) != hipSuccess) { fprintf(stderr, "kernel_launch: hipFuncSetAttribute failed\n"); grid = -1; return; }
        if (hipOccupancyMaxActiveBlocksPerMultiprocessor(&per_cu, (const void*)skel_fwd, NWAVES * 64, LDS_BYTES) != hipSuccess || per_cu < 1)
            fprintf(stderr, "kernel_launch: note: occupancy query reports %d workgroups per CU\n", per_cu);
        (void)hipGetLastError();
        grid = cus;
    }
    if (grid < 0) return;
    if (hipMemsetAsync((char*)d_ws + WS_CTL, 0, CTL_ZERO_BYTES, stream) != hipSuccess) { fprintf(stderr, "kernel_launch: hipMemsetAsync failed\n"); return; }
    Args a{};
    for (int i = 0; i < 25; ++i) a.in[i] = (const float*)d_in[i];
    a.out = (float*)d_out; a.ws = (unsigned char*)d_ws;
    for (int li = 0; li < N_LAUNCHES; ++li) {
        a.ph_lo = (N_LAUNCHES == PER_PHASE) ? li : 0; a.ph_hi = (N_LAUNCHES == PER_PHASE) ? li + 1 : PER_PHASE; a.li = li;
        hipLaunchKernelGGL(skel_fwd, dim3(grid), dim3(NWAVES * 64), LDS_BYTES, stream, a);
        const hipError_t le = hipPeekAtLastError();
        if (le != hipSuccess) { fprintf(stderr, "kernel_launch: launch %d failed: %s\n", li, hipGetErrorName(le)); break; }
    }
}
```

```cpp
#include <hip/hip_runtime.h>
#include <cstdio>
#include <cstdint>
#include <cmath>
namespace pg8 {
#define PG8_LAS __attribute__((address_space(3)))
typedef unsigned short bf16_t;
typedef short bf16x8 __attribute__((ext_vector_type(8)));
typedef float f32x4 __attribute__((ext_vector_type(4)));
typedef float f32x2 __attribute__((ext_vector_type(2)));
typedef unsigned u32x4 __attribute__((ext_vector_type(4)));
typedef unsigned u32x2 __attribute__((ext_vector_type(2)));
constexpr int BM = 256, BK = 64, HALF = 128, HTB = HALF * BK * 2  , STAGE_BYTES = 8 * HTB, NXCD = 8, WGM = 8;

__host__ __device__ __forceinline__ int lds_byte(int r, int c) { const int st = (r >> 4) * 2 + (c >> 5), rr = r & 15, cc = c & 31, ob = rr * 64 + cc * 2; return st * 1024 + (ob ^ (((ob >> 9) & 1) << 5)); }
__host__ __device__ __forceinline__ void stage_rc(int b, int& R, int& C) { const int st = b / 1024, sb = b % 1024, swz = sb ^ (((sb >> 9) & 1) << 5); R = (st >> 1) * 16 + swz / 64; C = (st & 1) * 32 + (swz % 64) / 2; }
__host__ __device__ __forceinline__ int perm32(int rho) { const int n = rho >> 4, i = rho & 15; return 8 * (i >> 2) + 4 * n + (i & 3); }

struct Unit { int pm, pn, z; size_t a_off, b_off; };
struct Gemm { const char* A; const char* Bt; int lda, ldb, K; };

__host__ __device__ __forceinline__ void tile_map(int L, int nM, int nN, int& pm, int& pn) {
    const int nwg = nM * nN; int wgid = L;
    { const int q = nwg / NXCD, r = nwg % NXCD, xcd = wgid % NXCD, off = wgid / NXCD; wgid = (xcd < r ? xcd * (q + 1) : r * (q + 1) + (xcd - r) * q) + off; }
    const int nig = WGM * nN, gid = wgid / nig, fm = gid * WGM, gsz = (nM - fm) < WGM ? (nM - fm) : WGM;
    pm = fm + ((wgid % nig) % gsz); pn = (wgid % nig) / gsz;
}

__device__ __forceinline__ unsigned cvt_pk_bf16(float lo, float hi) { unsigned r; asm volatile("v_cvt_pk_bf16_f32 %0, %1, %2" : "=v"(r) : "v"(lo), "v"(hi)); return r; }

template <class Epi, class Sched, bool ALIGN_EPI>
__device__ __forceinline__ void gemm_phase(PG8_LAS unsigned char* lds, const Gemm g, const Sched& S, const Epi& E, const int wid_) {
    int lane_; asm volatile("v_mbcnt_lo_u32_b32 %0, -1, 0\n\tv_mbcnt_hi_u32_b32 %0, -1, %0" : "=v"(lane_));
    const int lane = lane_ & 63, wid = wid_ & 7, tid = wid * 64 + lane, wr = wid >> 2, wc = wid & 3, fr = lane & 15, fq = lane >> 4;
    const int K = g.K, nt = K / BK;
    unsigned voffA[2], voffB[2];
#pragma unroll
    for (int i = 0; i < 2; ++i) { int R, C; stage_rc(tid * 16 + i * 8192, R, C); const int Rb = Epi::PERM ? ((R & ~31) + perm32(R & 31)) : R;
        voffA[i] = (unsigned)(R * g.lda + C) * 2u; voffB[i] = (unsigned)(Rb * g.ldb + C) * 2u; }
    const size_t kstep = (size_t)(BK * 2);
    const size_t hstepA = (size_t)HALF * g.lda * 2, hstepB = (size_t)HALF * g.ldb * 2;
    const unsigned ldsw = (unsigned)wid * 1024u;
    const int aoff = lds_byte(wr * 64 + fr, fq * 8), boff = lds_byte(wc * 32 + fr, fq * 8);
#define PG8_SA(b, h) (((b) * 2 + (h)) * HTB)
#define PG8_SB(b, h) ((4 + (b) * 2 + (h)) * HTB)
#define PG8_STAGE(bufoff, gbase, voff) do { _Pragma("unroll") for (int _i = 0; _i < 2; ++_i) \
        __builtin_amdgcn_global_load_lds((const unsigned*)((const char*)(gbase) + (voff)[_i]), (PG8_LAS unsigned*)(lds + (bufoff) + ldsw + _i * 8192), 16, 0, 0); } while (0)
#define PG8_LDA(dst, b, h) do { _Pragma("unroll") for (int m = 0; m < 4; ++m) _Pragma("unroll") for (int k = 0; k < 2; ++k) dst[m][k] = *(const PG8_LAS bf16x8*)(lds + PG8_SA(b, h) + aoff + m * 2048 + k * 1024); } while (0)
#define PG8_LDB(dst, b, h) do { _Pragma("unroll") for (int n = 0; n < 2; ++n) _Pragma("unroll") for (int k = 0; k < 2; ++k) dst[n][k] = *(const PG8_LAS bf16x8*)(lds + PG8_SB(b, h) + boff + n * 2048 + k * 1024); } while (0)
#define PG8_MMA(ai, bj, At, Bt) do { __builtin_amdgcn_s_setprio(1); _Pragma("unroll") for (int m = 0; m < 4; ++m) _Pragma("unroll") for (int n = 0; n < 2; ++n) _Pragma("unroll") for (int k = 0; k < 2; ++k) \
        acc[ai][bj][m][n] = __builtin_amdgcn_mfma_f32_16x16x32_bf16(Bt[n][k], At[m][k], acc[ai][bj][m][n], 0, 0, 0); __builtin_amdgcn_s_setprio(0); } while (0)
#define PG8_WAIT_V(n) asm volatile("s_waitcnt vmcnt(" #n ")" ::: "memory")
#define PG8_WAIT_L(n) asm volatile("s_waitcnt lgkmcnt(" #n ")" ::: "memory")
#define PG8_BAR __builtin_amdgcn_s_barrier()
#define PG8_SCHED __builtin_amdgcn_sched_barrier(0)
    Unit cur, nxt; int ui = 0;
    if (!S.next(0, cur)) return;
    f32x4 acc[2][2][4][2];
#pragma unroll
    for (int a = 0; a < 2; ++a)
#pragma unroll
        for (int b = 0; b < 2; ++b)
#pragma unroll
            for (int m = 0; m < 4; ++m)
#pragma unroll
                for (int n = 0; n < 2; ++n) acc[a][b][m][n] = (f32x4){0.f, 0.f, 0.f, 0.f};
    bf16x8 At[4][2], B0[2][2], B1[2][2];
    const char* cA = g.A + cur.a_off; const char* cB = g.Bt + cur.b_off;
    PG8_STAGE(PG8_SB(0, 0), cB, voffB); PG8_STAGE(PG8_SB(0, 1), cB + hstepB, voffB); PG8_STAGE(PG8_SA(0, 0), cA, voffA); PG8_STAGE(PG8_SA(0, 1), cA + hstepA, voffA);
    if (wr == 1) PG8_BAR;
    PG8_WAIT_V(2); PG8_BAR;
    PG8_STAGE(PG8_SB(1, 0), cB + kstep, voffB); PG8_STAGE(PG8_SA(1, 0), cA + kstep, voffA); PG8_STAGE(PG8_SB(1, 1), cB + hstepB + kstep, voffB);
    PG8_WAIT_V(6); PG8_BAR;
    for (;;) {
        const bool has_next = S.next(ui + 1, nxt);
        const char* nA = has_next ? g.A + nxt.a_off : cA; const char* nB = has_next ? g.Bt + nxt.b_off : cB;
        for (int t = 0; t < nt; t += 2) {
            const bool last = (t == nt - 2);
            const char* a1 = cA + (size_t)(t + 1) * kstep;
            const char* a2 = last ? nA : cA + (size_t)(t + 2) * kstep; const char* b2 = last ? nB : cB + (size_t)(t + 2) * kstep;
            const char* a3 = a2 + kstep; const char* b3 = b2 + kstep;
            PG8_LDB(B0, 0, 0); PG8_LDB(B1, 0, 1); PG8_SCHED; PG8_LDA(At, 0, 0); PG8_STAGE(PG8_SA(1, 1), a1 + hstepA, voffA);
            PG8_WAIT_V(8); PG8_WAIT_L(0); PG8_BAR; PG8_MMA(0, 0, At, B0); PG8_MMA(0, 1, At, B1); PG8_BAR; PG8_SCHED;
            PG8_LDA(At, 0, 1); PG8_STAGE(PG8_SB(0, 0), b2, voffB); PG8_STAGE(PG8_SB(0, 1), b2 + hstepB, voffB); PG8_STAGE(PG8_SA(0, 0), a2, voffA);
            PG8_WAIT_V(8); PG8_WAIT_L(0); PG8_BAR; PG8_MMA(1, 0, At, B0); PG8_MMA(1, 1, At, B1); PG8_BAR; PG8_SCHED;
            PG8_LDB(B0, 1, 0); PG8_LDB(B1, 1, 1); PG8_SCHED; PG8_LDA(At, 1, 0); PG8_STAGE(PG8_SA(0, 1), a2 + hstepA, voffA);
            PG8_WAIT_V(8); PG8_WAIT_L(0); PG8_BAR; PG8_MMA(0, 0, At, B0); PG8_MMA(0, 1, At, B1); PG8_BAR; PG8_SCHED;
            PG8_LDA(At, 1, 1); PG8_STAGE(PG8_SB(1, 0), b3, voffB); PG8_STAGE(PG8_SB(1, 1), b3 + hstepB, voffB); PG8_STAGE(PG8_SA(1, 0), a3, voffA);
            PG8_WAIT_V(8); PG8_WAIT_L(0); PG8_BAR; PG8_MMA(1, 0, At, B0); PG8_MMA(1, 1, At, B1); PG8_BAR; PG8_SCHED;
        }
        if constexpr (ALIGN_EPI) { if (wr == 0) PG8_BAR; }
        E(acc, cur, wr, wc, fr, fq, lane);
        if (!has_next) break;
#pragma unroll
        for (int a = 0; a < 2; ++a)
#pragma unroll
            for (int b = 0; b < 2; ++b)
#pragma unroll
                for (int m = 0; m < 4; ++m)
#pragma unroll
                    for (int n = 0; n < 2; ++n) acc[a][b][m][n] = (f32x4){0.f, 0.f, 0.f, 0.f};
        cur = nxt; cA = nA; cB = nB; ++ui;
        if constexpr (ALIGN_EPI) { if (wr == 1) PG8_BAR; }
    }
    PG8_WAIT_V(0);
    if constexpr (!ALIGN_EPI) { if (wr == 0) PG8_BAR; }
    PG8_BAR;
#undef PG8_SA
#undef PG8_SB
#undef PG8_STAGE
#undef PG8_LDA
#undef PG8_LDB
#undef PG8_MMA
#undef PG8_WAIT_V
#undef PG8_WAIT_L
#undef PG8_BAR
#undef PG8_SCHED
}
}
namespace pg8 {
struct EpiStoreBf16 {
    static constexpr bool PERM = true;
    bf16_t* O0; int ldc0; bf16_t* O1; int ldc1; int qs_lo; float qscale; float* kmean;
    int mode;
    __device__ __forceinline__ void operator()(const f32x4 (&acc)[2][2][4][2], const Unit& u, int wr, int wc, int fr, int fq, int lane) const {
        asm volatile("" : "+v"(fr), "+v"(fq), "+v"(lane));
        bf16_t* base; int ldc; size_t row0; int colt;
        if (mode == 0) { base = u.z ? O1 : O0; ldc = u.z ? ldc1 : ldc0; row0 = (size_t)u.pm * BM; colt = u.pn * BM; }
        else if (mode == 1) { base = O0; ldc = ldc0; row0 = (size_t)u.pm * 1024 + (size_t)u.z * 256; colt = u.pn * BM; }
        else { base = O0 + (size_t)(u.z >> 2) * 1048576; ldc = ldc0; row0 = (size_t)u.pm * BM; colt = (u.z & 3) * 256; }
        const float sc = (mode == 0 && u.z == 0 && (u.pn == qs_lo || u.pn == qs_lo + 1)) ? qscale : 1.f;
        const int col0 = colt + wc * 32 + 8 * fq;
#pragma unroll
        for (int ai = 0; ai < 2; ++ai)
#pragma unroll
            for (int m = 0; m < 4; ++m) { bf16_t* rowp = base + (row0 + wr * 64 + fr + ai * HALF + m * 16) * ldc + col0;
#pragma unroll
                for (int bj = 0; bj < 2; ++bj) { const f32x4 v0 = acc[ai][bj][m][0] * sc, v1 = acc[ai][bj][m][1] * sc;
                    u32x4 w; w.x = cvt_pk_bf16(v0[0], v0[1]); w.y = cvt_pk_bf16(v0[2], v0[3]); w.z = cvt_pk_bf16(v1[0], v1[1]); w.w = cvt_pk_bf16(v1[2], v1[3]);
                    *(u32x4*)(rowp + bj * HALF) = w; } }
        if (mode == 0 && u.z == 0 && kmean != nullptr && (u.pn == 9 || u.pn == 10)) {
            const int b_ = u.pm >> 5, blk = u.pm & 31;
#pragma unroll
            for (int bj = 0; bj < 2; ++bj)
#pragma unroll
                for (int n = 0; n < 2; ++n)
#pragma unroll
                    for (int i = 0; i < 4; ++i) { float s = 0.f;
#pragma unroll
                        for (int ai = 0; ai < 2; ++ai)
#pragma unroll
                            for (int m = 0; m < 4; ++m) s += acc[ai][bj][m][n][i];
                        s += __shfl_xor(s, 1); s += __shfl_xor(s, 2); s += __shfl_xor(s, 4); s += __shfl_xor(s, 8);
                        if (fr == 0) { const int kc = 256 * (u.pn - 9) + 128 * bj + 32 * wc + 8 * fq + 4 * n + i; atomicAdd(kmean + ((size_t)((b_ * 8 + (kc >> 6)) * 32 + blk)) * 64 + (kc & 63), s * (1.f / 256.f)); } }
        }
    }
};

__device__ __forceinline__ float row_rstd(const float* ss, size_t row) {
    const f32x4* p = (const f32x4*)(ss + row * 16); const f32x4 a = p[0], b = p[1], c = p[2], d = p[3];
    const float s = ((a[0] + a[1]) + (a[2] + a[3])) + ((b[0] + b[1]) + (b[2] + b[3])) + ((c[0] + c[1]) + (c[2] + c[3])) + ((d[0] + d[1]) + (d[2] + d[3]));
    return 1.0f / sqrtf(s * (1.0f / 1024.0f) + 1e-6f);
}
__device__ __forceinline__ void wave_rstd(float (&rs)[2][4], const float* ss, int pm, int wr, int fr, int lane) {
    const float my0 = row_rstd(ss, (size_t)pm * BM + wr * 64 + lane), my1 = row_rstd(ss, (size_t)pm * BM + HALF + wr * 64 + lane);
#pragma unroll
    for (int m = 0; m < 4; ++m) { rs[0][m] = __shfl(my0, m * 16 + fr); rs[1][m] = __shfl(my1, m * 16 + fr); }
}

template <bool BASE_BF16, bool OUT_F32> struct EpiRes {
    static constexpr bool PERM = false;
    const float* base; const bf16_t* baseb; float* out; bf16_t* hb; float* ss; int ldc;
    __device__ __forceinline__ void operator()(f32x4 (&acc)[2][2][4][2], const Unit& u, int wr, int wc, int fr, int fq, int lane) const {
        asm volatile("" : "+v"(fr), "+v"(fq), "+v"(lane));
        const int col0 = u.pn * BM + wc * 32 + 4 * fq;
#pragma unroll
        for (int ai = 0; ai < 2; ++ai)
#pragma unroll
            for (int m = 0; m < 4; ++m) { const size_t row = (size_t)u.pm * BM + ai * HALF + wr * 64 + m * 16 + fr; const size_t off = row * ldc + col0; float q = 0.f;
#pragma unroll
                for (int bj = 0; bj < 2; ++bj)
#pragma unroll
                    for (int n = 0; n < 2; ++n) { f32x4 bs;
                        if (BASE_BF16) { const u32x2 b2 = *(const u32x2*)(baseb + off + bj * HALF + n * 16); bs = (f32x4){__builtin_bit_cast(float, b2.x << 16), __builtin_bit_cast(float, b2.x & 0xffff0000u), __builtin_bit_cast(float, b2.y << 16), __builtin_bit_cast(float, b2.y & 0xffff0000u)}; }
                        else bs = *(const f32x4*)(base + off + bj * HALF + n * 16);
                        const f32x4 o = bs + acc[ai][bj][m][n];
                        if (OUT_F32) *(f32x4*)(out + off + bj * HALF + n * 16) = o;
                        q += (o[0] * o[0] + o[1] * o[1]) + (o[2] * o[2] + o[3] * o[3]);
                        u32x2 w; w.x = cvt_pk_bf16(o[0], o[1]); w.y = cvt_pk_bf16(o[2], o[3]); *(u32x2*)(hb + off + bj * HALF + n * 16) = w; }
                q += __shfl_xor(q, 16); q += __shfl_xor(q, 32);
                if (fq == 0) ss[row * 16 + u.pn * 4 + wc] = q;
                if (m & 1) asm volatile("" ::: "memory"); }
    }
};

struct EpiSqRelu {
    static constexpr bool PERM = true;
    bf16_t* O; int ldc; const float* ss;
    __device__ __forceinline__ void operator()(const f32x4 (&acc)[2][2][4][2], const Unit& u, int wr, int wc, int fr, int fq, int lane) const {
        asm volatile("" : "+v"(fr), "+v"(fq), "+v"(lane));
        float rs[2][4]; wave_rstd(rs, ss, u.pm, wr, fr, lane);
        const int col0 = u.pn * BM + wc * 32 + 8 * fq;
#pragma unroll
        for (int ai = 0; ai < 2; ++ai)
#pragma unroll
            for (int m = 0; m < 4; ++m) { bf16_t* rowp = O + ((size_t)u.pm * BM + wr * 64 + fr + ai * HALF + m * 16) * ldc + col0; const float s = rs[ai][m];
#pragma unroll
                for (int bj = 0; bj < 2; ++bj) { f32x4 v0 = acc[ai][bj][m][0] * s, v1 = acc[ai][bj][m][1] * s;
#pragma unroll
                    for (int i = 0; i < 4; ++i) { const float a = fmaxf(v0[i], 0.f), b = fmaxf(v1[i], 0.f); v0[i] = a * a; v1[i] = b * b; }
                    u32x4 w; w.x = cvt_pk_bf16(v0[0], v0[1]); w.y = cvt_pk_bf16(v0[2], v0[3]); w.z = cvt_pk_bf16(v1[0], v1[1]); w.w = cvt_pk_bf16(v1[2], v1[3]);
                    *(u32x4*)(rowp + bj * HALF) = w; } }
    }
};

struct EpiSoftmax {
    static constexpr bool PERM = true;
    bf16_t* O; int ldc; const float* ss; PG8_LAS f32x2* xl;
    __device__ __forceinline__ void operator()(f32x4 (&acc)[2][2][4][2], const Unit& u, int wr, int wc, int fr, int fq, int lane) const {
        asm volatile("" : "+v"(fr), "+v"(fq), "+v"(lane));
        float rs[2][4]; wave_rstd(rs, ss, u.pm, wr, fr, lane);
#pragma unroll
        for (int ai = 0; ai < 2; ++ai)
#pragma unroll
            for (int m = 0; m < 4; ++m) { const float s = rs[ai][m] * (0.0625f * 1.4426950408889634f); float mx = -INFINITY;
#pragma unroll
                for (int bj = 0; bj < 2; ++bj)
#pragma unroll
                    for (int n = 0; n < 2; ++n) { f32x4 v = acc[ai][bj][m][n] * s; acc[ai][bj][m][n] = v; mx = fmaxf(fmaxf(mx, fmaxf(v[0], v[1])), fmaxf(v[2], v[3])); }
                mx = fmaxf(mx, __shfl_xor(mx, 16)); mx = fmaxf(mx, __shfl_xor(mx, 32)); float sm = 0.f;
#pragma unroll
                for (int bj = 0; bj < 2; ++bj)
#pragma unroll
                    for (int n = 0; n < 2; ++n) { f32x4 v = acc[ai][bj][m][n];
#pragma unroll
                        for (int i = 0; i < 4; ++i) { v[i] = __builtin_amdgcn_exp2f(v[i] - mx); sm += v[i]; } acc[ai][bj][m][n] = v; }
                sm += __shfl_xor(sm, 16); sm += __shfl_xor(sm, 32);
                if (fq == 0) xl[(ai * HALF + wr * 64 + m * 16 + fr) * 4 + wc] = (f32x2){mx, sm}; }
        asm volatile("s_waitcnt lgkmcnt(0)" ::: "memory"); __builtin_amdgcn_s_barrier(); asm volatile("" ::: "memory");
        const int col0 = u.pn * BM + wc * 32 + 8 * fq;
#pragma unroll
        for (int ai = 0; ai < 2; ++ai)
#pragma unroll
            for (int m = 0; m < 4; ++m) { const int r = ai * HALF + wr * 64 + m * 16 + fr;
                const f32x4 x01 = *(const PG8_LAS f32x4*)(xl + r * 4), x23 = *(const PG8_LAS f32x4*)(xl + r * 4 + 2);
                const float mg = fmaxf(fmaxf(x01[0], x01[2]), fmaxf(x23[0], x23[2]));
                const float tot = x01[1] * __builtin_amdgcn_exp2f(x01[0] - mg) + x01[3] * __builtin_amdgcn_exp2f(x01[2] - mg) + x23[1] * __builtin_amdgcn_exp2f(x23[0] - mg) + x23[3] * __builtin_amdgcn_exp2f(x23[2] - mg);
                const float mown = wc == 0 ? x01[0] : (wc == 1 ? x01[2] : (wc == 2 ? x23[0] : x23[2]));
                const float f = __builtin_amdgcn_exp2f(mown - mg) / tot;
                bf16_t* rowp = O + ((size_t)u.pm * BM + r) * ldc + col0;
#pragma unroll
                for (int bj = 0; bj < 2; ++bj) { const f32x4 v0 = acc[ai][bj][m][0] * f, v1 = acc[ai][bj][m][1] * f;
                    u32x4 w; w.x = cvt_pk_bf16(v0[0], v0[1]); w.y = cvt_pk_bf16(v0[2], v0[3]); w.z = cvt_pk_bf16(v1[0], v1[1]); w.w = cvt_pk_bf16(v1[2], v1[3]);
                    *(u32x4*)(rowp + bj * HALF) = w; } }
    }
};
}
constexpr int NWAVES = 8;
constexpr int BATCH = 4, T = 8192, D = 1024, M = BATCH * T;
constexpr int NIN = 3328, RW = 512, NH = 8, HD = 64;
constexpr int ZK_R = 512, ZV_R = 1024, ZWD = 1536, ZAD = 1600, ZGD = 1664;
constexpr int ZQ = 1792, ZK = 1792 + 512, ZV = 1792 + 1024;
constexpr int MEML = 256, MEMR = BATCH * MEML, FF = 4096;
constexpr int NBLK = T / 256;
constexpr float NORM_EPS = 1e-6f, GN_EPS = 64e-5f, DECAY_SCALE = 0.6065306597126334f;

constexpr size_t MiB = 1u << 20;
constexpr size_t WS_CTL = 0, CTL_ZERO_BYTES = 1 * MiB;
constexpr size_t WS_WIN_T = 1 * MiB, WS_WMIX_T = 8 * MiB, WS_WQ_S = 10 * MiB, WS_WXKV_T = 12 * MiB, WS_WO_T = 16 * MiB, WS_W1_T = 18 * MiB, WS_W2_T = 26 * MiB;
constexpr size_t WS_MEMN = 34 * MiB, WS_KV = 36 * MiB, WS_GT = 40 * MiB, WS_VWT = 48 * MiB;
constexpr size_t WS_SS = 56 * MiB;
constexpr size_t WS_KMEAN = 256 * 1024  , WS_LORA = 62 * MiB + 512 * 1024, WS_BON = 63 * MiB;
constexpr size_t WS_XN = 64 * MiB;
constexpr size_t WS_GATE = 64 * MiB, WS_YRAW = 96 * MiB;
constexpr size_t WS_HB = 64 * MiB;
constexpr size_t WS_Z = 128 * MiB;
constexpr size_t WS_Y = 336 * MiB;
constexpr size_t WS_NT = 400 * MiB;
constexpr size_t WS_PR = 400 * MiB, WS_PV = 432 * MiB;
constexpr size_t WS_P = 400 * MiB;
constexpr size_t WS_AH = 128 * MiB;
constexpr size_t WS_END = 512 * MiB;
constexpr size_t DO_W = 0, DO_KP = 32 * MiB, DO_KKN = 64 * MiB, DO_B = 96 * MiB;

constexpr int CW_TMO = 0, CW_CODE = 1;
constexpr int CW_BAR = 4096;

constexpr int RING_OFF = 0, RING_BYTES = 131072;
constexpr int LDSCTL_OFF = RING_BYTES, MISC_OFF = LDSCTL_OFF + 320;
constexpr int EPI_LDS_OFF = 132096;
constexpr int LDS_BYTES = 147456;
static_assert(MISC_OFF + 128 <= EPI_LDS_OFF && EPI_LDS_OFF + 8192 <= LDS_BYTES, "LDS map");

#define GAS __attribute__((address_space(1)))
#define LAS __attribute__((address_space(3)))
typedef unsigned short bf16;
typedef unsigned v4u __attribute__((ext_vector_type(4)));
typedef float f32x4 __attribute__((ext_vector_type(4)));
typedef GAS unsigned gu32;
#define RLX_AGENT __ATOMIC_RELAXED, __HIP_MEMORY_SCOPE_AGENT
#define LDS_WAIT() asm volatile("s_waitcnt lgkmcnt(0)" ::: "memory")
#define VM_WAIT() asm volatile("s_waitcnt vmcnt(0)" ::: "memory")
__device__ __forceinline__ unsigned f2bf(float f) { unsigned u = __builtin_bit_cast(unsigned, f); return (u + 0x7fffu + ((u >> 16) & 1u)) >> 16; }
__device__ __forceinline__ unsigned pk2(float lo, float hi) { return f2bf(lo) | (f2bf(hi) << 16); }
__device__ __forceinline__ float bf2f(unsigned short u) { return __builtin_bit_cast(float, (unsigned)u << 16); }
__device__ __forceinline__ float bflo(unsigned u) { return __builtin_bit_cast(float, u << 16); }
__device__ __forceinline__ float bfhi(unsigned u) { return __builtin_bit_cast(float, u & 0xffff0000u); }

#define XB_TMO      128
#define XB_XCNT(j)  (256  + 64 * (j))
#define XB_XSUB(j)  (1280 + 64 * (j))
#define XB_XGEN(j)  (2304 + 64 * (j))
#define XB_TOP      3328
#define XB_TOPGEN   3392
#define XCD_BAR_WORDS 3456
#define XB_SPIN_CAP (1u << 18)
__device__ __forceinline__ unsigned xb_ld(unsigned* p)              { return __hip_atomic_load(p, __ATOMIC_RELAXED, __HIP_MEMORY_SCOPE_AGENT); }
__device__ __forceinline__ unsigned xb_add(unsigned* p, unsigned v) { return __hip_atomic_fetch_add(p, v, __ATOMIC_RELAXED, __HIP_MEMORY_SCOPE_AGENT); }
__device__ __forceinline__ unsigned xb_xcc_id() { return (unsigned)__builtin_amdgcn_s_getreg((3 << 11) | 20) & 0xFu; }
#define XB_SPIN(cond, bar) do { unsigned _sp = 0; while (cond) { __builtin_amdgcn_s_sleep(1); \
    if ((++_sp & 255u) == 0u) { if (xb_ld(&(bar)[XB_TMO])) break; if (_sp > XB_SPIN_CAP) { atomicAdd(&(bar)[XB_TMO], 1u); break; } } } } while (0)
struct XcdBarrier { unsigned* bar; unsigned x; volatile LAS unsigned* st; };
__device__ __forceinline__ XcdBarrier xcd_barrier_post(unsigned* bar, volatile LAS unsigned* st) {
    XcdBarrier b; b.bar = bar; b.x = xb_xcc_id(); b.st = st;
    if (threadIdx.x == 0) (void)xb_add(&bar[XB_XCNT(b.x)], 1u);
    return b;
}
__device__ __forceinline__ void xcd_barrier_complete(unsigned* bar, unsigned x, unsigned& nloc, unsigned& nx) {
    const unsigned G = gridDim.x * gridDim.y * gridDim.z;
    unsigned sum, cnt, mine, sp = 0u;
    for (;;) {
        sum = 0u; cnt = 0u; mine = 0u;
#pragma unroll
        for (unsigned j = 0; j < 16; ++j) { const unsigned c = xb_ld(&bar[XB_XCNT(j)]); sum += c; cnt += (c > 0u) ? 1u : 0u; mine = (j == x) ? c : mine; }
        if (sum == G) break;
        __builtin_amdgcn_s_sleep(1);
        if ((++sp & 255u) == 0u) { if (xb_ld(&bar[XB_TMO])) break; if (sp > XB_SPIN_CAP) { atomicAdd(&bar[XB_TMO], 1u); break; } }
    }
    nloc = mine > 0u ? mine : 1u; nx = cnt > 0u ? cnt : 1u;
}
__device__ __forceinline__ void xcd_barrier(const XcdBarrier& b) {
    asm volatile("s_waitcnt vmcnt(0)" ::: "memory");
    __syncthreads();
    if (threadIdx.x == 0) {
        unsigned* bar = b.bar;
        __builtin_amdgcn_s_waitcnt(0);
        unsigned nloc = b.st[0], nx = b.st[1];
        if (nloc == 0u) { xcd_barrier_complete(bar, b.x, nloc, nx); b.st[0] = nloc; b.st[1] = nx; }
        const unsigned old = xb_add(&bar[XB_XSUB(b.x)], 1u);
        const unsigned gen = old / nloc;
        if (old + 1u == (gen + 1u) * nloc) {
            __builtin_amdgcn_fence(__ATOMIC_RELEASE, "agent");
            asm volatile("s_waitcnt vmcnt(0)" ::: "memory");
            const unsigned og = xb_add(&bar[XB_TOP], 1u);
            const unsigned tg = og / nx;
            if (og + 1u == (tg + 1u) * nx) xb_add(&bar[XB_TOPGEN], 1u);
            else XB_SPIN(xb_ld(&bar[XB_TOPGEN]) == tg, bar);
            __builtin_amdgcn_fence(__ATOMIC_ACQUIRE, "agent");
            xb_add(&bar[XB_XGEN(b.x)], 1u);
            asm volatile("s_waitcnt vmcnt(0)" ::: "memory");
        } else {
            XB_SPIN(xb_ld(&bar[XB_XGEN(b.x)]) == gen, bar);
            __builtin_amdgcn_fence(__ATOMIC_ACQUIRE, "agent");
            asm volatile("s_waitcnt vmcnt(0)" ::: "memory");
        }
    }
    __syncthreads();
}

struct Frame {
    LAS unsigned char* lds;
    volatile LAS unsigned* MISC;
    gu32* ctl;
    int tid, lane, wave;
    int vcu, G;
    unsigned char* ws; unsigned char* dout;
    const float* in[25];
};
constexpr size_t WS_TAB = 131072;
__device__ __forceinline__ const float* inp(const Frame& F, int i) {
    const unsigned long long v = ((const GAS unsigned long long*)(F.ws + WS_TAB))[i];
    const unsigned lo = __builtin_amdgcn_readfirstlane((unsigned)v), hi = __builtin_amdgcn_readfirstlane((unsigned)(v >> 32));
    return (const float*)(((unsigned long long)hi << 32) | lo);
}
#define INP(i) inp(F, (i))
__device__ __forceinline__ float wave_sum(float v) {
#pragma unroll
    for (int o = 1; o < 64; o <<= 1) v += __shfl_xor(v, o);
    return v;
}
__device__ __forceinline__ float wave_max(float v) {
#pragma unroll
    for (int o = 1; o < 64; o <<= 1) v = fmaxf(v, __shfl_xor(v, o));
    return v;
}
template <int CTRL> __device__ __forceinline__ float dpp_mov(float x) { return __builtin_bit_cast(float, __builtin_amdgcn_update_dpp(0, __builtin_bit_cast(int, x), CTRL, 0xf, 0xf, false)); }
__device__ __forceinline__ float red16(float x) { x += dpp_mov<0xB1>(x); x += dpp_mov<0x4E>(x); x += dpp_mov<0x124>(x); x += dpp_mov<0x128>(x); return x; }
__device__ __forceinline__ void p0_transpose_item(const float* W, int K, int N, bf16* WT, const float* kscale, LAS float* scr, int item, int lane) {
    const int nblk = N / 32, kb = item / nblk, nb = item % nblk, k0 = 64 * kb, n0 = 32 * nb;
#pragma unroll 8
    for (int i = 0; i < 32; ++i) { const int kk = 2 * i + (lane >> 5); const float s = kscale ? kscale[k0 + kk] : 1.f; scr[kk * 33 + (lane & 31)] = W[(size_t)(k0 + kk) * N + n0 + (lane & 31)] * s; }
    LDS_WAIT(); asm volatile("" ::: "memory");
    const int c = lane & 7;
#pragma unroll
    for (int j = 0; j < 4; ++j) { const int n = (lane >> 3) + 8 * j; const LAS float* s = scr + (8 * c) * 33 + n;
        v4u o; o.x = pk2(s[0 * 33], s[1 * 33]); o.y = pk2(s[2 * 33], s[3 * 33]); o.z = pk2(s[4 * 33], s[5 * 33]); o.w = pk2(s[6 * 33], s[7 * 33]);
        *(GAS v4u*)(WT + (size_t)(n0 + n) * K + k0 + 8 * c) = o; }
    LDS_WAIT(); asm volatile("" ::: "memory");
}
__device__ __forceinline__ void rms_row_to_bf16(const float* xrow, const float* g, bf16* orow, int lane) {
    const GAS f32x4* xr = (const GAS f32x4*)xrow + lane; const GAS f32x4* gr = (const GAS f32x4*)g + lane;
    f32x4 v[4]; float s = 0.f;
#pragma unroll
    for (int j = 0; j < 4; ++j) { v[j] = xr[64 * j]; s += (v[j].x * v[j].x + v[j].y * v[j].y) + (v[j].z * v[j].z + v[j].w * v[j].w); }
    const float rstd = 1.f / sqrtf(wave_sum(s) * (1.f / D) + NORM_EPS);
    GAS unsigned long long* o8 = (GAS unsigned long long*)orow + lane;
#pragma unroll
    for (int j = 0; j < 4; ++j) { const f32x4 gg = gr[64 * j]; o8[64 * j] = (unsigned long long)pk2(v[j].x * rstd * gg.x, v[j].y * rstd * gg.y) | ((unsigned long long)pk2(v[j].z * rstd * gg.z, v[j].w * rstd * gg.w) << 32); }
}
__device__ __forceinline__ void p0_prologue(Frame& F) {
    LAS float* scr = (LAS float*)(F.lds + RING_OFF + F.wave * 16384);
    const int gw = F.vcu * NWAVES + F.wave, NGW = F.G * NWAVES;
    constexpr int I_IN = (D / 64) * (NIN / 32), I_MIX = (D / 64) * (D / 32), I_KV = (D / 64) * (2 * D / 32), I_O = I_MIX, I_1 = (D / 64) * (FF / 32), I_2 = (FF / 64) * (D / 32);
    constexpr int I_LW = RW / 32, I_LG = 2 * (RW / 32);
    constexpr int NITEMS = I_IN + I_MIX + I_KV + I_O + I_1 + I_2 + 2 * I_LW + I_LG;
    for (int it = gw; it < NITEMS; it += NGW) {
        int r = it;
        if (r < I_IN) { p0_transpose_item(F.in[3], D, NIN, (bf16*)(F.ws + WS_WIN_T), nullptr, scr, r, F.lane); continue; } r -= I_IN;
        if (r < I_MIX) { p0_transpose_item(F.in[15], D, D, (bf16*)(F.ws + WS_WMIX_T), nullptr, scr, r, F.lane); continue; } r -= I_MIX;
        if (r < I_KV) { p0_transpose_item(F.in[19], D, 2 * D, (bf16*)(F.ws + WS_WXKV_T), nullptr, scr, r, F.lane); continue; } r -= I_KV;
        if (r < I_O) { p0_transpose_item(F.in[20], D, D, (bf16*)(F.ws + WS_WO_T), nullptr, scr, r, F.lane); continue; } r -= I_O;
        if (r < I_1) { p0_transpose_item(F.in[22], D, FF, (bf16*)(F.ws + WS_W1_T), F.in[21], scr, r, F.lane); continue; } r -= I_1;
        if (r < I_2) { p0_transpose_item(F.in[23], FF, D, (bf16*)(F.ws + WS_W2_T), nullptr, scr, r, F.lane); continue; } r -= I_2;
        if (r < I_LW) { p0_transpose_item(F.in[6], 64, RW, (bf16*)(F.ws + WS_LORA), nullptr, scr, r, F.lane); continue; } r -= I_LW;
        if (r < I_LW) { p0_transpose_item(F.in[8], 64, RW, (bf16*)(F.ws + WS_LORA) + RW * 64, nullptr, scr, r, F.lane); continue; } r -= I_LW;
        p0_transpose_item(F.in[9], 128, RW, (bf16*)(F.ws + WS_LORA) + 2 * RW * 64, nullptr, scr, r, F.lane);
    }
    { const float* wq = F.in[18]; const float* gx = F.in[16]; bf16* o = (bf16*)(F.ws + WS_WQ_S);
      for (int i = (F.vcu * 512 + F.tid); i < D * D / 4; i += F.G * 512) { const f32x4 v = ((const GAS f32x4*)wq)[i]; const float s = gx[(i * 4) / D];
          ((GAS unsigned long long*)o)[i] = (unsigned long long)pk2(v.x * s, v.y * s) | ((unsigned long long)pk2(v.z * s, v.w * s) << 32); } }
    for (int m = gw; m < M; m += NGW) rms_row_to_bf16(F.in[0] + (size_t)m * D, F.in[2], (bf16*)(F.ws + WS_XN) + (size_t)m * D, F.lane);
    for (int m = gw; m < MEMR; m += NGW) rms_row_to_bf16(F.in[1] + (size_t)m * D, F.in[17], (bf16*)(F.ws + WS_MEMN) + (size_t)m * D, F.lane);
}

__device__ __forceinline__ void kmean_simple(Frame& F) {
    const bf16* Z = (const bf16*)(F.ws + WS_Z); float* KM = (float*)(F.ws + WS_KMEAN);
    const int gw = F.vcu * NWAVES + F.wave, NGW = F.G * NWAVES;
    for (int u = gw; u < BATCH * NH * NBLK; u += NGW) { const int j = u % NBLK, bh = u / NBLK, b = bh / NH, h = bh % NH;
        const bf16* kp = Z + ((size_t)b * T + j * 256) * NIN + ZK + h * HD + F.lane; float s = 0.f;
        for (int i = 0; i < 256; ++i) s += bf2f(kp[(size_t)i * NIN]);
        KM[(size_t)u * HD + F.lane] = s * (1.f / 256.f); }
}
__device__ __forceinline__ void final_norm(Frame& F, const float pscale) {
    float* out = (float*)F.dout; const bf16* hb = (const bf16*)(F.ws + WS_HB); const float* ss = (const float*)(F.ws + WS_SS) + (size_t)2 * M * 16; const float* g = INP(24);
    const int gw = F.vcu * NWAVES + F.wave, NGW = F.G * NWAVES;
    for (int m = gw; m < M; m += NGW) { const float rstd = pg8::row_rstd(ss, (size_t)m) * pscale;
        GAS f32x4* o = (GAS f32x4*)(out + (size_t)m * D) + F.lane; const GAS f32x4* gr = (const GAS f32x4*)g + F.lane; const GAS unsigned long long* hr = (const GAS unsigned long long*)(hb + (size_t)m * D) + F.lane;
#pragma unroll
        for (int j = 0; j < 4; ++j) { const unsigned long long q = hr[64 * j]; const unsigned lo = (unsigned)q, hi = (unsigned)(q >> 32); const f32x4 gg = gr[64 * j];
            f32x4 v = (f32x4){bflo(lo), bfhi(lo), bflo(hi), bfhi(hi)}; v = v * rstd * gg; o[64 * j] = v; } }
}
namespace attn_body {
typedef unsigned short bf16;
using bf16x8=__attribute__((ext_vector_type(8)))short;
using s16x4=__attribute__((ext_vector_type(4)))short;
using f32x16=__attribute__((ext_vector_type(16)))float;
using u32x4=__attribute__((ext_vector_type(4)))unsigned;
constexpr int SEQ=8192,D=64,QP=3328,OP=1024;
constexpr int NW=8,QBLK=32,QB=QBLK*NW,KVBLK=64,NQB=SEQ/QB;
__device__ __forceinline__ int crow(int r,int hi){return (r&3)+8*(r>>2)+4*hi;}
#define SBAR() __builtin_amdgcn_sched_barrier(0)
__device__ __forceinline__ void cmask(f32x16&p0,f32x16&p1,int jb,int qrel,int hi){
  const float NEG=-INFINITY; int kb=64*jb+4*hi;
  #pragma unroll
  for(int r=0;r<16;++r){int kv=kb+(r&3)+8*(r>>2); if(kv>qrel)p0[r]=NEG; if(kv+32>qrel)p1[r]=NEG;}
}

constexpr int NSLOT=3, SLOTB=8192;
constexpr int LDS_K=0, LDS_V=NSLOT*SLOTB, LDS_WS=2*NSLOT*SLOTB, LDS_OST=LDS_WS+NW*64*4, LDS_BYTES=LDS_OST+NW*4096;
constexpr float C2=0.125f*1.4426950408889634f;
__device__ __forceinline__ void glds16(const void*gsrc,unsigned lds_dst){unsigned keep;
  asm volatile("s_mov_b32 %0, m0\n\ts_mov_b32 m0, %2\n\ts_nop 0\n\tglobal_load_lds_dwordx4 %1, off\n\ts_mov_b32 m0, %0":"=&s"(keep):"v"(gsrc),"s"(lds_dst):"memory");}
__device__ __forceinline__ float max3f(float a,float b,float c){float r;asm("v_max3_f32 %0, %1, %2, %3":"=v"(r):"v"(a),"v"(b),"v"(c));return r;}
__device__ __forceinline__ float max2f(float a,float b){float r;asm("v_max_f32_e32 %0, %1, %2":"=v"(r):"v"(a),"v"(b));return r;}
__device__ __forceinline__ float fadd_s(float a,float b){float r;asm("v_add_f32_e32 %0, %1, %2":"=v"(r):"v"(a),"v"(b));return r;}
__device__ __forceinline__ float fsub_s(float a,float b){float r;asm("v_sub_f32_e32 %0, %1, %2":"=v"(r):"v"(a),"v"(b));return r;}
typedef float f32x2_t __attribute__((ext_vector_type(2))); typedef __bf16 bf16x2_t __attribute__((ext_vector_type(2)));
__device__ __forceinline__ unsigned cvtpk_s(float lo,float hi){f32x2_t v={lo,hi};bf16x2_t b=__builtin_convertvector(v,bf16x2_t);return __builtin_bit_cast(unsigned,b);}
#define WAIT_BAR(N) asm volatile("s_waitcnt vmcnt(" #N ") lgkmcnt(0)\n\ts_barrier":::"memory")

__device__ __forceinline__ void qkt(f32x16&p0,f32x16&p1,const char*Kslot,const bf16x8*qr,const f32x16&negm,int r32,int hi){
  const char*kb=Kslot+hi*1024+r32*16;
  #pragma unroll
  for(int d0=0;d0<4;++d0){
    const bf16x8 b0=*reinterpret_cast<const bf16x8*>(kb+d0*2048);
    const bf16x8 b1=*reinterpret_cast<const bf16x8*>(kb+d0*2048+512);
    if(d0==0){p0=__builtin_amdgcn_mfma_f32_32x32x16_bf16(b0,qr[0],negm,0,0,0);p1=__builtin_amdgcn_mfma_f32_32x32x16_bf16(b1,qr[0],negm,0,0,0);}
    else{p0=__builtin_amdgcn_mfma_f32_32x32x16_bf16(b0,qr[d0],p0,0,0,0);p1=__builtin_amdgcn_mfma_f32_32x32x16_bf16(b1,qr[d0],p1,0,0,0);}}
}
typedef __attribute__((address_space(3))) const char* lds_cptr;
typedef short v4i16_t __attribute__((ext_vector_type(4)));
__device__ __forceinline__ void kload8(bf16x8*kf,lds_cptr kp){
  kf[0]=*(const __attribute__((address_space(3))) bf16x8*)(kp);      kf[1]=*(const __attribute__((address_space(3))) bf16x8*)(kp+512);
  kf[2]=*(const __attribute__((address_space(3))) bf16x8*)(kp+2048); kf[3]=*(const __attribute__((address_space(3))) bf16x8*)(kp+2560);
  kf[4]=*(const __attribute__((address_space(3))) bf16x8*)(kp+4096); kf[5]=*(const __attribute__((address_space(3))) bf16x8*)(kp+4608);
  kf[6]=*(const __attribute__((address_space(3))) bf16x8*)(kp+6144); kf[7]=*(const __attribute__((address_space(3))) bf16x8*)(kp+6656);
}
__device__ __forceinline__ void kload2(bf16x8*kf,lds_cptr kp,int j){ kf[2*j]=*(const __attribute__((address_space(3))) bf16x8*)(kp+j*2048); kf[2*j+1]=*(const __attribute__((address_space(3))) bf16x8*)(kp+j*2048+512); }
__device__ __forceinline__ s16x4 vtr(lds_cptr p){ return __builtin_bit_cast(s16x4,__builtin_amdgcn_ds_read_tr16_b64_v4i16((__attribute__((address_space(3))) v4i16_t*)p)); }
__device__ __forceinline__ float rowmax(const f32x16&p0,const f32x16&p1){
  float a=max3f(p0[0],p0[1],p1[0]),b=max3f(p0[2],p0[3],p1[1]);a=max3f(a,p1[2],p1[3]);
  #pragma unroll
  for(int r=4;r<16;r+=4){a=max3f(a,p0[r],p0[r+1]);b=max3f(b,p0[r+2],p0[r+3]);a=max3f(a,p1[r],p1[r+1]);b=max3f(b,p1[r+2],p1[r+3]);}
  const float m=max2f(a,b);
  auto rr=__builtin_amdgcn_permlane32_swap(__float_as_uint(m),__float_as_uint(m),false,false);
  return max2f(__uint_as_float(rr[0]),__uint_as_float(rr[1]));
}
__device__ __forceinline__ void pv(f32x16*o,int vb,bf16x8 pa0,bf16x8 pa1,bf16x8 pa2,bf16x8 pa3){
  #pragma unroll
  for(int d0=0;d0<2;++d0){s16x4 lo[4],hi[4];
    #pragma unroll
    for(int ks=0;ks<4;++ks){
      asm volatile("ds_read_b64_tr_b16 %0,%1 offset:%c2":"=&v"(lo[ks]):"v"(vb),"i"(d0*4096+ks*1024):"memory");
      asm volatile("ds_read_b64_tr_b16 %0,%1 offset:%c2":"=&v"(hi[ks]):"v"(vb),"i"(d0*4096+ks*1024+512):"memory");}
    asm volatile("s_waitcnt lgkmcnt(0)":::"memory");SBAR();
    #define PK(k) (bf16x8){lo[k][0],lo[k][1],lo[k][2],lo[k][3],hi[k][0],hi[k][1],hi[k][2],hi[k][3]}
    o[d0]=__builtin_amdgcn_mfma_f32_32x32x16_bf16(pa0,PK(0),o[d0],0,0,0);
    o[d0]=__builtin_amdgcn_mfma_f32_32x32x16_bf16(pa1,PK(1),o[d0],0,0,0);
    o[d0]=__builtin_amdgcn_mfma_f32_32x32x16_bf16(pa2,PK(2),o[d0],0,0,0);
    o[d0]=__builtin_amdgcn_mfma_f32_32x32x16_bf16(pa3,PK(3),o[d0],0,0,0);
    #undef PK
  }
}

#ifndef ATTN_STORE16
#define ATTN_STORE16(p,v) (*(u32x4*)(p)=(v))
#endif
template<int THRL> __device__ __forceinline__ void attn_unit(int b,int h,int qb,const bf16*Q,const bf16*__restrict__ K,const bf16*__restrict__ V,bf16*O,const float*__restrict__ KMbh,char*shm,const int wid,const int lane){
  const int r32=lane&31,hi=lane>>5;
  const long rowbase=(long)b*SEQ; const int q0=qb*QB;
  const bf16*Qw=Q+(rowbase+q0+wid*QBLK)*QP+h*D;
  const bf16*Kh=K+rowbase*QP+h*D,*Vh=V+rowbase*QP+h*D;
  unsigned selmask=0u;
  { f32x16 g=f32x16{}; bf16x8 qg[4];
    #pragma unroll
    for(int d0=0;d0<4;++d0)qg[d0]=*reinterpret_cast<const bf16x8*>(&Qw[(long)r32*QP+d0*16+hi*8]);
    #pragma unroll
    for(int d0=0;d0<4;++d0){ const float4 a0=*reinterpret_cast<const float4*>(KMbh+r32*64+d0*16+hi*8), a1=*reinterpret_cast<const float4*>(KMbh+r32*64+d0*16+hi*8+4);
      u32x4 pk; pk[0]=cvtpk_s(a0.x,a0.y); pk[1]=cvtpk_s(a0.z,a0.w); pk[2]=cvtpk_s(a1.x,a1.y); pk[3]=cvtpk_s(a1.z,a1.w);
      g=__builtin_amdgcn_mfma_f32_32x32x16_bf16(__builtin_bit_cast(bf16x8,pk),qg[d0],g,0,0,0); }
    #pragma unroll
    for(int r=0;r<16;++r){ if(crow(r,hi)>=qb) g[r]=-INFINITY; }
    #pragma unroll
    for(int n=0;n<3;++n){ float bv=-INFINITY; int bi=64;
      #pragma unroll
      for(int r=0;r<16;++r){ if(g[r]>bv){bv=g[r];bi=crow(r,hi);} }
      const float pv_=__shfl_xor(bv,32); const int pi_=__shfl_xor(bi,32);
      const bool mine=(bv>pv_)||(bv==pv_&&bi<pi_); const float wv=mine?bv:pv_; const int wi=mine?bi:pi_;
      if(wv>-INFINITY){ selmask|=1u<<wi;
        #pragma unroll
        for(int r=0;r<16;++r){ if(crow(r,hi)==wi) g[r]=-INFINITY; } } }
    selmask|=1u<<qb; }
  asm volatile("":"+v"(selmask)); SBAR();
  const unsigned lds0=(unsigned)(uintptr_t)shm;
  float*wsf=(float*)(shm+LDS_WS)+wid*64;
  const bf16*ksrc=Kh+(long)lane*QP+wid*8;
  const bf16*vsrc=Vh+(long)(16*(wid&3)+(lane>>2))*QP+(wid>>2)*32+(lane&3)*8;
  const unsigned kdst=lds0+LDS_K+wid*1024, vdst=lds0+LDS_V+wid*1024;
  #define DMA_K(t,slot) glds16(ksrc+(long)(t)*KVBLK*QP,(unsigned)__builtin_amdgcn_readfirstlane(kdst+(slot)))
  #define DMA_V(t,slot) glds16(vsrc+(long)(t)*KVBLK*QP,(unsigned)__builtin_amdgcn_readfirstlane(vdst+(slot)))
  const int vb0=(int)(lds0+LDS_V)+((lane>>4)&1)*32+(lane&3)*8+(4*hi+((lane&15)>>2))*64;
  const char*Kbase=shm+LDS_K; bf16x8 kf[8];
  const lds_cptr shm3=(lds_cptr)shm; const lds_cptr kp0=shm3+LDS_K+hi*1024+r32*16; const lds_cptr vp0=shm3+LDS_V+((lane>>4)&1)*32+(lane&3)*8+(4*hi+((lane&15)>>2))*64;
  const int NT=(q0+QB)/KVBLK;
  DMA_K(0,0);DMA_V(0,0);DMA_K(1,SLOTB);
  bf16x8 qr[4];
  #pragma unroll
  for(int d0=0;d0<4;++d0)qr[d0]=*reinterpret_cast<const bf16x8*>(&Qw[(long)r32*QP+d0*16+hi*8]);
  float nok=((selmask&1u)!=0u||qb==0)?0.f:-INFINITY;
  float mhat=0.f,l_reg=0.f;f32x16 o[2];o[0]=f32x16{};o[1]=f32x16{};f32x16 negm;
  _Pragma("unroll") for(int r=0;r<16;++r)negm[r]=nok; asm volatile("":"+v"(negm));
  const int qrel=wid*QBLK+r32;
  #define CMASK(P0,P1,t) do{int jb_=(t)-(NT-4); if(jb_>=0)cmask(P0,P1,jb_,qrel,hi);}while(0)
  bool resc=false;
  #define START(P0,P1) do{ const float rm=rowmax(P0,P1); resc=false; \
    { const float dl=(rm==-INFINITY)?0.f:rm; mhat=fadd_s(mhat,dl); \
      _Pragma("unroll") for(int r=0;r<16;++r){P0[r]=fsub_s(P0[r],dl);P1[r]=fsub_s(P1[r],dl);} \
      { const float cv_=nok-mhat; _Pragma("unroll") for(int r=0;r<16;++r)negm[r]=cv_; } asm volatile("":"+v"(negm)); } \
    _Pragma("unroll") for(int r=0;r<16;++r)P0[r]=__builtin_amdgcn_exp2f(P0[r]); }while(0)
  #define RESC() do{ if(resc){ asm volatile("s_waitcnt lgkmcnt(0)":::"memory"); \
      _Pragma("unroll") for(int d_=0;d_<2;++d_) _Pragma("unroll") for(int r=0;r<16;++r)o[d_][r]*=wsf[crow(r,hi)]; } }while(0)
  f32x16 pA0,pA1,pB0,pB1;
  int sl_prev=0,sl_cur=0,sl_next=SLOTB;
  #define ROT() do{sl_prev=sl_cur;sl_cur=sl_next;sl_next=(sl_next==(NSLOT-1)*SLOTB)?0:sl_next+SLOTB;}while(0)
  DMA_K(2,2*SLOTB);
  WAIT_BAR(3);
  qkt(pA0,pA1,Kbase,qr,negm,r32,hi);asm volatile("s_nop 15\n\ts_nop 7":"+v"(pA0),"+v"(pA1));CMASK(pA0,pA1,0);
  START(pA0,pA1);
  _Pragma("unroll") for(int r=0;r<16;++r)pA1[r]=__builtin_amdgcn_exp2f(pA1[r]);
  WAIT_BAR(0);
  DMA_K(3,0);DMA_V(1,SLOTB);
  ROT();
  kload8(kf,kp0+sl_cur);
  WAIT_BAR(2);
  s16x4 vlo[8],vhi[8]; u32x4 pw0,pw1,pw2,pw3;
  #define PKW(P,B) cvtpk_s(P[B],P[B+1])
  #define PAF(k) __builtin_bit_cast(bf16x8,pw##k)
  #define VFR(i) (bf16x8){vlo[i][0],vlo[i][1],vlo[i][2],vlo[i][3],vhi[i][0],vhi[i][1],vhi[i][2],vhi[i][3]}
  #define PIN(x) asm volatile("":"+v"(x))
  #define MX3(a,b,c) __builtin_fmaxf(__builtin_fmaxf((a),(b)),(c))
  #define GAPA(MF,A0,A1,A2,A3,W0,W1,PW) do{ MF; sacc+=A0; sacc+=A1; sacc+=A2; sacc+=A3; PIN(sacc); W0; W1; PIN(PW); SBAR(); }while(0)
  #define EX(v) __builtin_amdgcn_exp2f(v)
  #define GAPB(MF,X,B) do{ MF; X[B]=EX(X[B]); X[B+1]=EX(X[B+1]); X[B+2]=EX(X[B+2]); X[B+3]=EX(X[B+3]); PIN(X); SBAR(); }while(0)
  #define VRD(i) do{ vlo[i]=vtr(vp_+(((i)>>2)*4096+((i)&3)*1024)); vhi[i]=vtr(vp_+(((i)>>2)*4096+((i)&3)*1024+512)); }while(0)
  #define KRD(G,j) do{ if(G){ kload2(kf,kp0+sl_next,j); SBAR(); } }while(0)
  #define STEP(C0,C1,P0,P1,t,GK,GV,GL) do{ SBAR(); \
    const lds_cptr vp_=vp0+sl_prev; \
    VRD(0); SBAR(); float sacc=(P0[0]+P0[1]); \
    GAPA(C0=__builtin_amdgcn_mfma_f32_32x32x16_bf16(kf[0],qr[0],negm,0,0,0), P0[2],P0[3],P0[4],P0[5],     pw0[0]=PKW(P0,0), pw0[1]=PKW(P0,2), pw0); \
    VRD(4); SBAR(); GAPA(C1=__builtin_amdgcn_mfma_f32_32x32x16_bf16(kf[1],qr[0],negm,0,0,0), P0[6],P0[7],P0[8],P0[9],     pw0[2]=PKW(P0,4), pw0[3]=PKW(P0,6), pw0); \
    VRD(1); SBAR(); GAPA(C0=__builtin_amdgcn_mfma_f32_32x32x16_bf16(kf[2],qr[1],C0,0,0,0),   P0[10],P0[11],P0[12],P0[13], pw1[0]=PKW(P0,8), pw1[1]=PKW(P0,10), pw1); \
    VRD(5); SBAR(); GAPA(C1=__builtin_amdgcn_mfma_f32_32x32x16_bf16(kf[3],qr[1],C1,0,0,0),   P0[14],P0[15],P1[0],P1[1],   pw1[2]=PKW(P0,12),pw1[3]=PKW(P0,14), pw1); \
    VRD(2); SBAR(); GAPA(C0=__builtin_amdgcn_mfma_f32_32x32x16_bf16(kf[4],qr[2],C0,0,0,0),   P1[2],P1[3],P1[4],P1[5],     pw2[0]=PKW(P1,0), pw2[1]=PKW(P1,2), pw2); \
    VRD(6); SBAR(); GAPA(C1=__builtin_amdgcn_mfma_f32_32x32x16_bf16(kf[5],qr[2],C1,0,0,0),   P1[6],P1[7],P1[8],P1[9],     pw2[2]=PKW(P1,4), pw2[3]=PKW(P1,6), pw2); \
    VRD(3); SBAR(); GAPA(C0=__builtin_amdgcn_mfma_f32_32x32x16_bf16(kf[6],qr[3],C0,0,0,0),   P1[10],P1[11],P1[12],P1[13], pw3[0]=PKW(P1,8), pw3[1]=PKW(P1,10), pw3); \
    VRD(7); SBAR(); GAPA(C1=__builtin_amdgcn_mfma_f32_32x32x16_bf16(kf[7],qr[3],C1,0,0,0),   P1[14],P1[15],0.f,0.f,       pw3[2]=PKW(P1,12),pw3[3]=PKW(P1,14), pw3); \
    l_reg+=sacc; \
    if(GK){DMA_K((t)+3,sl_cur);} if(GV){DMA_V((t)+1,sl_next);} \
    CMASK(C0,C1,t); \
    { float a=MX3(C0[0],C0[1],C1[0]),b=MX3(C0[2],C0[3],C1[1]); a=MX3(a,C1[2],C1[3]); \
      _Pragma("unroll") for(int r=4;r<16;r+=4){a=MX3(a,C0[r],C0[r+1]);b=MX3(b,C0[r+2],C0[r+3]);a=MX3(a,C1[r],C1[r+1]);b=MX3(b,C1[r+2],C1[r+3]);} \
      float rm=__builtin_fmaxf(a,b); { auto rr=__builtin_amdgcn_permlane32_swap(__float_as_uint(rm),__float_as_uint(rm),false,false); rm=__builtin_fmaxf(__uint_as_float(rr[0]),__uint_as_float(rr[1])); } \
      resc=false; \
      if(__builtin_expect(__any(rm>(float)THRL),0)){ const float dl=__builtin_fmaxf(rm,0.f); mhat+=dl; \
        _Pragma("unroll") for(int r=0;r<16;++r){C0[r]-=dl;C1[r]-=dl;} \
        { const float cv_=nok-mhat; _Pragma("unroll") for(int r=0;r<16;++r)negm[r]=cv_; } asm volatile("":"+v"(negm)); \
        const float f=__builtin_amdgcn_exp2f(-dl); l_reg*=f; if(hi==0)wsf[r32]=f; resc=true; } } \
    SBAR(); \
    GAPB(o[0]=__builtin_amdgcn_mfma_f32_32x32x16_bf16(PAF(0),VFR(0),o[0],0,0,0), C0,0); \
    GAPB(o[1]=__builtin_amdgcn_mfma_f32_32x32x16_bf16(PAF(0),VFR(4),o[1],0,0,0), C0,4); \
    KRD(GL,0); GAPB(o[0]=__builtin_amdgcn_mfma_f32_32x32x16_bf16(PAF(1),VFR(1),o[0],0,0,0), C0,8); \
    KRD(GL,1); GAPB(o[1]=__builtin_amdgcn_mfma_f32_32x32x16_bf16(PAF(1),VFR(5),o[1],0,0,0), C0,12); \
    KRD(GL,2); GAPB(o[0]=__builtin_amdgcn_mfma_f32_32x32x16_bf16(PAF(2),VFR(2),o[0],0,0,0), C1,0); \
    KRD(GL,3); GAPB(o[1]=__builtin_amdgcn_mfma_f32_32x32x16_bf16(PAF(2),VFR(6),o[1],0,0,0), C1,4); \
    GAPB(o[0]=__builtin_amdgcn_mfma_f32_32x32x16_bf16(PAF(3),VFR(3),o[0],0,0,0), C1,8); \
    GAPB(o[1]=__builtin_amdgcn_mfma_f32_32x32x16_bf16(PAF(3),VFR(7),o[1],0,0,0), C1,12); \
    }while(0)
  #define MASKUPD(tt) do{ if((((tt))&3)==0){ nok=((selmask>>((tt)>>2))&1u)?0.f:-INFINITY; const float cv_=nok-mhat; _Pragma("unroll") for(int r=0;r<16;++r)negm[r]=cv_; asm volatile("":"+v"(negm)); } }while(0)
  int t=1;
  #undef CMASK
  #define CMASK(P0,P1,t) do{}while(0)
  for(;t+5<NT;t+=2){
    STEP(pB0,pB1,pA0,pA1,t,true,true,true);     WAIT_BAR(2); RESC(); ROT(); MASKUPD(t+1);
    STEP(pA0,pA1,pB0,pB1,t+1,true,true,true);   WAIT_BAR(2); RESC(); ROT();
  }
  #undef CMASK
  #define CMASK(P0,P1,t) do{int jb_=(t)-(NT-4); if(jb_>=0)cmask(P0,P1,jb_,qrel,hi);}while(0)
  #define ENDW(tt) do{ if((tt)+3<NT){WAIT_BAR(2);} else if((tt)+2<NT){WAIT_BAR(1);} else {WAIT_BAR(0);} }while(0)
  for(;t+1<NT;t+=2){
    STEP(pB0,pB1,pA0,pA1,t,(t+3<NT),(t+1<NT),(t+1<NT));       ENDW(t);   RESC(); ROT(); MASKUPD(t+1);
    STEP(pA0,pA1,pB0,pB1,t+1,(t+4<NT),(t+2<NT),(t+2<NT));     ENDW(t+1); RESC(); ROT();
  }
  STEP(pB0,pB1,pA0,pA1,NT-1,false,false,false); RESC();
  { float sacc=pB0[0]+pB0[1]; _Pragma("unroll") for(int r=2;r<16;++r)sacc+=pB0[r]; _Pragma("unroll") for(int r=0;r<16;++r)sacc+=pB1[r]; l_reg+=sacc;
    pw0=(u32x4){PKW(pB0,0),PKW(pB0,2),PKW(pB0,4),PKW(pB0,6)};pw1=(u32x4){PKW(pB0,8),PKW(pB0,10),PKW(pB0,12),PKW(pB0,14)};pw2=(u32x4){PKW(pB1,0),PKW(pB1,2),PKW(pB1,4),PKW(pB1,6)};pw3=(u32x4){PKW(pB1,8),PKW(pB1,10),PKW(pB1,12),PKW(pB1,14)};
    SBAR(); pv(o,vb0+sl_cur,PAF(0),PAF(1),PAF(2),PAF(3)); }
  #undef PKW
  #undef PAF
  #undef VFR
  #undef PIN
  #undef MX3
  #undef GAPA
  #undef GAPB
  #undef EX
  #undef VRD
  #undef KRD
  #undef STEP
  #undef ENDW
  #undef MASKUPD
  {auto rr=__builtin_amdgcn_permlane32_swap(__float_as_uint(l_reg),__float_as_uint(l_reg),false,false);l_reg=__uint_as_float(rr[0])+__uint_as_float(rr[1]);}
  if(hi==0)wsf[32+r32]=l_reg;asm volatile("s_waitcnt lgkmcnt(0)":::"memory");
  float rli[16];
  #pragma unroll
  for(int r=0;r<16;++r)rli[r]=__builtin_amdgcn_rcpf(wsf[32+crow(r,hi)]);
  bf16*Ow=O+(rowbase+q0+wid*QBLK)*OP+h*D;
  { bf16*stg=(bf16*)(shm+LDS_OST)+wid*2048;
    #pragma unroll
    for(int r=0;r<16;++r){const int orow=crow(r,hi);
      #pragma unroll
      for(int d0=0;d0<2;++d0)stg[orow*64+d0*32+r32]=(bf16)(cvtpk_s(o[d0][r]*rli[r],0.f)&0xffffu);}
    asm volatile("s_waitcnt lgkmcnt(0)":::"memory");
    #pragma unroll
    for(int i=0;i<4;++i){const int row=i*8+(lane>>3),ch=lane&7; const u32x4 v=*(const u32x4*)(stg+row*64+ch*8); ATTN_STORE16(Ow+(long)row*OP+ch*8,v);} }
  asm volatile("s_waitcnt lgkmcnt(0)\n\ts_barrier":::"memory");
  #undef DMA_K
  #undef DMA_V
  #undef CMASK
  #undef START
  #undef RESC
  #undef ROT
}
constexpr int ATTN_LDS_BYTES=LDS_BYTES;
#undef SBAR
#undef WAIT_BAR
}
namespace rscan {
typedef short bf16x8 __attribute__((ext_vector_type(8)));
typedef float f32x4 __attribute__((ext_vector_type(4)));
typedef float f32x16 __attribute__((ext_vector_type(16)));
typedef unsigned u32x2 __attribute__((ext_vector_type(2)));
typedef unsigned u32x4 __attribute__((ext_vector_type(4)));
constexpr int LB = 8192;
__device__ __forceinline__ int t64(int row, int chunk) { return row * 128 + ((chunk ^ ((row >> 1) & 7)) << 4); }
__device__ __forceinline__ int t128(int row, int chunk) { return row * 256 + ((chunk ^ (row & 15)) << 4); }
constexpr int NCHUNK = T / 64;
__device__ __forceinline__ unsigned pkbf(float lo, float hi) { typedef float f2 __attribute__((ext_vector_type(2))); typedef __bf16 b2 __attribute__((ext_vector_type(2))); f2 v = {lo, hi}; return __builtin_bit_cast(unsigned, __builtin_convertvector(v, b2)); }

__device__ __forceinline__ void mm(f32x4 (&acc)[2], LAS unsigned char* lds, int z1, int z2, int ta, int tbh, int fr, int fq) {
    const int o1 = z1 + t64(16 * ta + fr, fq), o2 = z2 + t64(32 * tbh + fr, fq);
    const bf16x8 a0 = *(const LAS bf16x8*)(lds + o1), a1 = *(const LAS bf16x8*)(lds + (o1 ^ 64));
    const bf16x8 b00 = *(const LAS bf16x8*)(lds + o2), b01 = *(const LAS bf16x8*)(lds + (o2 ^ 64)), b10 = *(const LAS bf16x8*)(lds + o2 + 2048), b11 = *(const LAS bf16x8*)(lds + ((o2 ^ 64) + 2048));
    acc[0] = __builtin_amdgcn_mfma_f32_16x16x32_bf16(a0, b00, acc[0], 0, 0, 0); acc[0] = __builtin_amdgcn_mfma_f32_16x16x32_bf16(a1, b01, acc[0], 0, 0, 0);
    acc[1] = __builtin_amdgcn_mfma_f32_16x16x32_bf16(a0, b10, acc[1], 0, 0, 0); acc[1] = __builtin_amdgcn_mfma_f32_16x16x32_bf16(a1, b11, acc[1], 0, 0, 0);
}
struct Fr { bf16x8 a0, a1, b00, b01, b10, b11; };
__device__ __forceinline__ void ldf(Fr& f, LAS unsigned char* lds, int z1, int z2, int ta, int tbh, int fr, int fq) {
    const int o1 = z1 + t64(16 * ta + fr, fq), o2 = z2 + t64(32 * tbh + fr, fq);
    f.a0 = *(const LAS bf16x8*)(lds + o1); f.a1 = *(const LAS bf16x8*)(lds + (o1 ^ 64));
    f.b00 = *(const LAS bf16x8*)(lds + o2); f.b01 = *(const LAS bf16x8*)(lds + (o2 ^ 64)); f.b10 = *(const LAS bf16x8*)(lds + o2 + 2048); f.b11 = *(const LAS bf16x8*)(lds + ((o2 ^ 64) + 2048));
}
__device__ __forceinline__ void mcf(f32x4 (&acc)[2], const Fr& f) {
    acc[0] = __builtin_amdgcn_mfma_f32_16x16x32_bf16(f.a0, f.b00, acc[0], 0, 0, 0); acc[1] = __builtin_amdgcn_mfma_f32_16x16x32_bf16(f.a0, f.b10, acc[1], 0, 0, 0);
    acc[0] = __builtin_amdgcn_mfma_f32_16x16x32_bf16(f.a1, f.b01, acc[0], 0, 0, 0); acc[1] = __builtin_amdgcn_mfma_f32_16x16x32_bf16(f.a1, f.b11, acc[1], 0, 0, 0);
}
template <int MASK, bool DIAG1> __device__ __forceinline__ void st_lds(const f32x4 (&acc)[2], LAS unsigned char* lds, int dst, int ta, int tbh, int fr, int fq) {
#pragma unroll
    for (int tb = 0; tb < 2; ++tb) { const int b = 32 * tbh + 16 * tb + fr, a0 = 16 * ta + 4 * fq; float v[4];
#pragma unroll
        for (int i = 0; i < 4; ++i) { const int a = a0 + i; float x = acc[tb][i];
            if (MASK == 1) x = (a < b) ? x : 0.f; if (MASK == 2) x = (a <= b) ? x : 0.f; if (MASK == 3) x = (b < a) ? x : 0.f; if (DIAG1) x = (a == b) ? 1.f : x; v[i] = x; }
        u32x2 w; w.x = pkbf(v[0], v[1]); w.y = pkbf(v[2], v[3]); *(LAS u32x2*)(lds + dst + t64(b, a0 >> 3) + (a0 & 4) * 2) = w; }
}
template <bool PERM> __device__ __forceinline__ void st_glb(const f32x4 (&acc)[2], bf16* g, int ta, int tbh, int fr, int fq) {
#pragma unroll
    for (int tb = 0; tb < 2; ++tb) { const int b = 32 * tbh + 16 * tb + fr; int a0 = 16 * ta + 4 * fq; if (PERM) a0 = (a0 & ~12) | ((a0 & 4) << 1) | ((a0 & 8) >> 1);
        u32x2 w; w.x = pkbf(acc[tb][0], acc[tb][1]); w.y = pkbf(acc[tb][2], acc[tb][3]); *(GAS u32x2*)(g + (size_t)b * 64 + a0) = w; }
}

__device__ __forceinline__ float wsum_fast(float x) { x = red16(x);
    x += __builtin_bit_cast(float, __builtin_amdgcn_update_dpp(0, __builtin_bit_cast(int, x), 0x142, 0xa, 0xf, false));
    x += __builtin_bit_cast(float, __builtin_amdgcn_update_dpp(0, __builtin_bit_cast(int, x), 0x143, 0xc, 0xf, false));
    return __builtin_bit_cast(float, __builtin_amdgcn_readlane(__builtin_bit_cast(int, x), 63)); }
__device__ __forceinline__ void pk_acc(u32x2 (&d)[2], const f32x4 (&acc)[2]) {
#pragma unroll
    for (int tb = 0; tb < 2; ++tb) { d[tb].x = pkbf(acc[tb][0], acc[tb][1]); d[tb].y = pkbf(acc[tb][2], acc[tb][3]); }
}
template <bool PERM> __device__ __forceinline__ void st_pk(const u32x2 (&d)[2], bf16* g, int ta, int tbh, int fr, int fq) {
#pragma unroll
    for (int tb = 0; tb < 2; ++tb) { const int b = 32 * tbh + 16 * tb + fr; int a0 = 16 * ta + 4 * fq;
        if (PERM) { a0 = (a0 & ~12) | ((a0 & 4) << 1) | ((a0 & 8) >> 1);
            const int t1 = b >> 5, r32 = b & 31, t2 = a0 >> 5, s = (a0 >> 4) & 1, hi = (a0 >> 3) & 1;
            *(GAS u32x2*)((char*)g + (((t1 * 2 + t2) * 2 + s) * 1024) + (hi * 32 + r32) * 16 + (a0 & 7) * 2) = d[tb]; }
        else *(GAS u32x2*)(g + (size_t)b * 64 + a0) = d[tb]; }
}
__device__ __forceinline__ void st_f32(const f32x4 (&d)[2], float* g, int ta, int tbh, int fr, int fq) {
#pragma unroll
    for (int tb = 0; tb < 2; ++tb) { const int b = 32 * tbh + 16 * tb + fr, a0 = 16 * ta + 4 * fq;
        const int tv = b >> 5, r32 = b & 31, tk = a0 >> 5, gq = (a0 >> 3) & 3, hi = (a0 >> 2) & 1;
        *(GAS f32x4*)((char*)g + (((tk * 2 + tv) * 4 + gq) * 1024) + (hi * 32 + r32) * 16) = d[tb]; }
}
constexpr int LS2 = 272;
__device__ __forceinline__ void mm128(f32x4 (&acc)[2], LAS unsigned char* lds, int z1, int z2, int ta, int tbh, int fr, int fq) {
#pragma unroll
    for (int s = 0; s < 4; ++s) { const bf16x8 a = *(const LAS bf16x8*)(lds + z1 + t128(16 * ta + fr, 4 * s + fq)), b0 = *(const LAS bf16x8*)(lds + z2 + t128(32 * tbh + fr, 4 * s + fq)), b1 = *(const LAS bf16x8*)(lds + z2 + t128(32 * tbh + 16 + fr, 4 * s + fq));
        acc[0] = __builtin_amdgcn_mfma_f32_16x16x32_bf16(a, b0, acc[0], 0, 0, 0); acc[1] = __builtin_amdgcn_mfma_f32_16x16x32_bf16(a, b1, acc[1], 0, 0, 0); }
}
__device__ __forceinline__ void st_lds_f32(const f32x4 (&acc)[2], LAS unsigned char* lds, int dst, int ta, int tbh, int fr, int fq) {
#pragma unroll
    for (int tb = 0; tb < 2; ++tb) { const int b = 32 * tbh + 16 * tb + fr, a0 = 16 * ta + 4 * fq; *(LAS f32x4*)(lds + dst + b * LS2 + a0 * 4) = acc[tb]; }
}

__device__ __forceinline__ void scan_pre(Frame& F) {
    LAS unsigned char* lds = F.lds + RING_OFF;
    const int w = F.wave, lane = F.lane, fr = lane & 15, fq = lane >> 4, ta = w & 3, tbh = w >> 2;
    const bf16* Z = (const bf16*)(F.ws + WS_Z); const float* mu = INP(4);
    const bf16* WupT = (const bf16*)(F.ws + WS_LORA); const bf16* AupT = WupT + RW * 64; const bf16* GupT = AupT + RW * 64;
    bf16* aLW = (bf16*)(F.dout + DO_W); bf16* aKP = (bf16*)(F.dout + DO_KP); bf16* aKK = (bf16*)(F.dout + DO_KKN); float* aNT = (float*)(F.ws + WS_NT);
    bf16* oG = (bf16*)(F.ws + WS_GATE); float* oBon = (float*)(F.ws + WS_BON);
    enum { bAt = 0, bBt = LB, bKt = 2 * LB, bRt = 3 * LB, bAtT = 4 * LB, bVT = 5 * LB, bBhT = 6 * LB, bKhT = 7 * LB, b8 = 8 * LB, b9 = 9 * LB, b10 = 10 * LB, bAak = 11 * LB, bArb = 12 * LB, bArk = 13 * LB };
    enum { lXw = 0, lXa = LB, lXg = 2 * LB, lWw = 4 * LB, lWa = 5 * LB, lWg = 6 * LB, lDw = 8 * LB, lDa = lDw + 64 * LS2, lDg = lDa + 64 * LS2, lSum = lDg + 64 * LS2 };
    static_assert(lWg + 2 * LB <= 8 * LB && lSum + 2048 <= RING_BYTES, "LoRA stage LDS carve");
#ifdef PROBE_SEG
    unsigned long long sg_[8] = {0, 0, 0, 0, 0, 0, 0, 0}, sgt_;
#define SEG0() sgt_ = __builtin_amdgcn_s_memrealtime()
#define SEG(j) do { const unsigned long long n_ = __builtin_amdgcn_s_memrealtime(); sg_[j] += n_ - sgt_; sgt_ = n_; } while (0)
#else
#define SEG0() do {} while (0)
#define SEG(j) do {} while (0)
#endif
    const float* pW0 = INP(5); const float* pA0 = INP(7); const float* pKK = INP(10); const float* pKA = INP(11); const float* pRK = INP(12);
    enum { lMu = lSum + 2048 };
    static_assert(lMu + 1024 <= RING_BYTES, "LDS carve");
    if (F.tid < 256) *(LAS float*)(lds + lMu + F.tid * 4) = mu[ZWD + F.tid];
    __syncthreads();
    float hp[8];
    u32x4 cur[4], prv[4], wpf[4]; unsigned short zr_[9], zk_[9], zv_[9];
    u32x2 dq[3][2]; f32x4 dqn[2]; size_t dso = 0; bool dpend = false;
#define PF_ISSUE(uu) do { const int c_ = (uu) % NCHUNK, bh_ = (uu) / NCHUNK, b_ = bh_ / NH, h_ = bh_ % NH; const size_t m0_ = (size_t)b_ * T + (size_t)c_ * 64; \
        { const int row_ = F.tid >> 3, ch_ = F.tid & 7; wpf[0] = *(const GAS u32x4*)(WupT + (size_t)(h_ * HD + row_) * 64 + ch_ * 8); wpf[1] = *(const GAS u32x4*)(AupT + (size_t)(h_ * HD + row_) * 64 + ch_ * 8); \
          wpf[2] = *(const GAS u32x4*)(GupT + (size_t)(h_ * HD + (F.tid >> 4)) * 128 + (F.tid & 15) * 8); wpf[3] = *(const GAS u32x4*)(GupT + (size_t)(h_ * HD + 32 + (F.tid >> 4)) * 128 + (F.tid & 15) * 8); } \
        { const int t_ = F.tid >> 3, g0_ = F.tid & 7; const bf16* zrow = Z + (m0_ + t_) * NIN + ZWD; const bool firstrow = (c_ == 0 && t_ == 0); \
          _Pragma("unroll") for (int i = 0; i < 4; ++i) { cur[i] = *(const GAS u32x4*)(zrow + 8 * (g0_ + 8 * i)); prv[i] = (u32x4){0u, 0u, 0u, 0u}; if (!firstrow) prv[i] = *(const GAS u32x4*)(zrow - (long)NIN + 8 * (g0_ + 8 * i)); } } \
        { const int cg_ = h_ * HD + lane; hp[0] = pW0[cg_]; hp[1] = pA0[cg_]; hp[2] = pKK[cg_]; hp[3] = pKA[cg_]; hp[4] = pRK[cg_]; hp[5] = mu[cg_]; hp[6] = mu[ZK_R + cg_]; hp[7] = mu[ZV_R + cg_]; } \
        { const bf16* zr = Z + (m0_ + 8 * w) * NIN + h_ * HD + lane; const bool first = (c_ == 0 && w == 0); \
          zr_[0] = 0; zk_[0] = 0; zv_[0] = 0; if (!first) { zr_[0] = zr[-(long)NIN]; zk_[0] = zr[-(long)NIN + ZK_R]; zv_[0] = zr[-(long)NIN + ZV_R]; } \
          _Pragma("unroll") for (int i = 0; i < 8; ++i) { zr_[i + 1] = zr[(size_t)i * NIN]; zk_[i + 1] = zr[(size_t)i * NIN + ZK_R]; zv_[i + 1] = zr[(size_t)i * NIN + ZV_R]; } } } while (0)
    if (F.vcu < BATCH * NH * NCHUNK) PF_ISSUE(F.vcu);
    for (int u = F.vcu; u < BATCH * NH * NCHUNK; u += F.G) {
        SEG0();
        const int c = u % NCHUNK, bh = u / NCHUNK, b = bh / NH, h = bh % NH;
        const size_t m0 = (size_t)b * T + (size_t)c * 64;
        const size_t so = (size_t)u * 4096;
        { const int t = F.tid >> 3, g0 = F.tid & 7;
          { const int row = F.tid >> 3, ch = F.tid & 7;
            *(LAS u32x4*)(lds + lWw + t64(row, ch)) = wpf[0]; *(LAS u32x4*)(lds + lWa + t64(row, ch)) = wpf[1]; }
          { const int row = F.tid >> 4, ch = F.tid & 15; *(LAS u32x4*)(lds + lWg + t128(row, ch)) = wpf[2]; *(LAS u32x4*)(lds + lWg + t128(row + 32, ch)) = wpf[3]; }
#pragma unroll
          for (int i = 0; i < 4; ++i) { const int col0 = 8 * (g0 + 8 * i); const f32x4 ma = *(const LAS f32x4*)(lds + lMu + col0 * 4), mb = *(const LAS f32x4*)(lds + lMu + col0 * 4 + 16);
              float z[8];
#pragma unroll
              for (int q = 0; q < 4; ++q) { const unsigned cw = cur[i][q], pw = prv[i][q]; const float c0 = bflo(cw), c1 = bfhi(cw), p0 = bflo(pw), p1 = bfhi(pw);
                  const float m0_ = q < 2 ? ma[2 * q] : mb[2 * q - 4], m1_ = q < 2 ? ma[2 * q + 1] : mb[2 * q - 3];
                  z[2 * q] = c0 + (p0 - c0) * m0_; z[2 * q + 1] = c1 + (p1 - c1) * m1_; }
#pragma unroll
              for (int q = 0; q < 8; ++q) { if (i == 0) z[q] = 1.f - 2.f * __builtin_amdgcn_rcpf(1.f + __expf(2.f * z[q])); else if (i >= 2) z[q] = __builtin_amdgcn_rcpf(1.f + __expf(-z[q])); }
              u32x4 o; o.x = pkbf(z[0], z[1]); o.y = pkbf(z[2], z[3]); o.z = pkbf(z[4], z[5]); o.w = pkbf(z[6], z[7]);
              const int dst = i == 0 ? lXw + t64(t, g0) : (i == 1 ? lXa + t64(t, g0) : lXg + t128(t, (i - 2) * 8 + g0));
              *(LAS u32x4*)(lds + dst) = o; }
        }
        __syncthreads(); SEG(0);
        { f32x4 acc[2];
          acc[0] = (f32x4){0.f, 0.f, 0.f, 0.f}; acc[1] = acc[0]; mm(acc, lds, lWw, lXw, ta, tbh, fr, fq); st_lds_f32(acc, lds, lDw, ta, tbh, fr, fq);
          acc[0] = (f32x4){0.f, 0.f, 0.f, 0.f}; acc[1] = acc[0]; mm(acc, lds, lWa, lXa, ta, tbh, fr, fq); st_lds_f32(acc, lds, lDa, ta, tbh, fr, fq);
          acc[0] = (f32x4){0.f, 0.f, 0.f, 0.f}; acc[1] = acc[0]; mm128(acc, lds, lWg, lXg, ta, tbh, fr, fq); st_lds_f32(acc, lds, lDg, ta, tbh, fr, fq); }
        __syncthreads(); SEG(1);
        if (dpend) { st_pk<false>(dq[0], aLW + dso, ta, tbh, fr, fq); st_pk<false>(dq[1], aKK + dso, ta, tbh, fr, fq); st_pk<true>(dq[2], aKP + dso, ta, tbh, fr, fq); st_f32(dqn, aNT + dso, ta, tbh, fr, fq); }
        { const int cg = h * HD + lane;
          const float w0_ = hp[0], a0_ = hp[1], kkc = hp[2], kac = hp[3], rkc = hp[4], mur = hp[5], muk = hp[6], muv = hp[7];
          float lwv[8], e_at[8], e_bb[8], e_kp[8], e_r[8], e_v[8]; float lsum = 0.f;
#pragma unroll
          for (int i = 0; i < 8; ++i) { const int t = 8 * w + i;
              const float cr = bf2f(zr_[i + 1]), ck = bf2f(zk_[i + 1]), cv = bf2f(zv_[i + 1]), pr = bf2f(zr_[i]), pk = bf2f(zk_[i]), pv = bf2f(zv_[i]);
              const float r = cr + (pr - cr) * mur, kx = ck + (pk - ck) * muk, v = cv + (pv - cv) * muv;
              const float dw = w0_ + *(const LAS float*)(lds + lDw + t * LS2 + lane * 4), da = a0_ + *(const LAS float*)(lds + lDa + t * LS2 + lane * 4), gg = *(const LAS float*)(lds + lDg + t * LS2 + lane * 4);
              const float lw = -DECAY_SCALE * __builtin_amdgcn_rcpf(1.f + __expf(-dw)), a = __builtin_amdgcn_rcpf(1.f + __expf(-da));
              const float kk = kx * kkc; const float nn = wsum_fast(kk * kk); const float kkn = kk * __builtin_amdgcn_rsqf(fmaxf(nn, 1e-24f));
              const float kp = kx * (1.f + (a - 1.f) * kac), bb = kkn * a; const float bon = wsum_fast(r * kp * rkc);
              oG[(m0 + t) * RW + cg] = (bf16)f2bf(gg); if (lane == 0) oBon[(m0 + t) * NH + h] = bon;
              lwv[i] = lw; lsum += lw; e_at[i] = -kkn; e_bb[i] = bb; e_kp[i] = kp; e_r[i] = r; e_v[i] = v; }
          *(LAS float*)(lds + lSum + (w * 64 + lane) * 4) = lsum;
          __syncthreads(); SEG(2);
          if (u + F.G < BATCH * NH * NCHUNK) PF_ISSUE(u + F.G);
          float ltot = 0.f, lst = 0.f;
#pragma unroll
          for (int q = 0; q < 8; ++q) { const float sq = *(const LAS float*)(lds + lSum + (q * 64 + lane) * 4); if (q < w) lst += sq; ltot += sq; }
          float L = lst; unsigned short pAtT[8], pVT[8], pBhT[8], pKhT[8];
#pragma unroll
          for (int i = 0; i < 8; ++i) { const int t = 8 * w + i;
              const float Pm = __expf(L); L += lwv[i]; const float P = __expf(L), iP = __expf(-L), Ph = __expf(ltot - L);
              const unsigned short at = (unsigned short)f2bf(e_at[i] * Pm);
              const int eo = t64(t, lane >> 3) + (lane & 7) * 2;
              *(LAS unsigned short*)(lds + bAt + eo) = at; *(LAS unsigned short*)(lds + bBt + eo) = (unsigned short)f2bf(e_bb[i] * iP);
              *(LAS unsigned short*)(lds + bKt + eo) = (unsigned short)f2bf(e_kp[i] * iP); *(LAS unsigned short*)(lds + bRt + eo) = (unsigned short)f2bf(e_r[i] * P);
              pAtT[i] = at; pVT[i] = (unsigned short)f2bf(e_v[i]); pBhT[i] = (unsigned short)f2bf(e_bb[i] * Ph); pKhT[i] = (unsigned short)f2bf(e_kp[i] * Ph); }
#define RS_W16(buf, p) do { u32x4 q_; q_.x = p[0] | ((unsigned)p[1] << 16); q_.y = p[2] | ((unsigned)p[3] << 16); q_.z = p[4] | ((unsigned)p[5] << 16); q_.w = p[6] | ((unsigned)p[7] << 16); *(LAS u32x4*)(lds + (buf) + t64(lane, w)) = q_; } while (0)
          RS_W16(bAtT, pAtT); RS_W16(bVT, pVT); RS_W16(bBhT, pBhT); RS_W16(bKhT, pKhT);
#undef RS_W16
          asm volatile("" :: "v"(ltot));
          __syncthreads(); SEG(3);
          f32x4 acc[2], acc2[2], acc3[2], acc4[2], tacc[2];
#define RS_Z(a) do { a[0] = (f32x4){0.f, 0.f, 0.f, 0.f}; a[1] = (f32x4){0.f, 0.f, 0.f, 0.f}; } while (0)
#define LD(f, z1, z2) ldf(f, lds, z1, z2, ta, tbh, fr, fq)
#define ST(m, a, dst) st_lds<m, false>(a, lds, dst, ta, tbh, fr, fq)
          { Fr f0, f1, f2; LD(f0, bAt, bBt); LD(f1, bKt, bAt); LD(f2, bBt, bRt);
            RS_Z(acc); RS_Z(acc2); RS_Z(acc3); mcf(acc, f0); mcf(acc2, f1); mcf(acc3, f2);
            ST(3, acc, b9);
            ST(1, acc2, bAak);
            ST(2, acc3, bArb); }
          { Fr f3, f4; LD(f3, bKt, bRt); LD(f4, bBt, bAt); RS_Z(acc4); RS_Z(tacc); mcf(acc4, f3); mcf(tacc, f4);
            ST(2, acc4, bArk); }
#pragma unroll
          for (int tb = 0; tb < 2; ++tb)
#pragma unroll
              for (int i = 0; i < 4; ++i) { const int bb_ = 32 * tbh + 16 * tb + fr, a = 16 * ta + 4 * fq + i; tacc[tb][i] = (a < bb_) ? tacc[tb][i] : 0.f; }
          ST(0, tacc, b8);
#pragma unroll
          for (int tb = 0; tb < 2; ++tb)
#pragma unroll
              for (int i = 0; i < 4; ++i) { const int bb_ = 32 * tbh + 16 * tb + fr, a = 16 * ta + 4 * fq + i; if (a == bb_) tacc[tb][i] = 1.f; }
          ST(0, tacc, b10);
          __syncthreads();
          { Fr f0, f1; LD(f0, b9, b8); LD(f1, b8, b9); RS_Z(acc); RS_Z(acc2); mcf(acc, f0); mcf(acc2, f1); ST(0, acc, bAt); ST(0, acc2, bBt); }
          __syncthreads();
          { Fr f0, f1, f2; LD(f0, bBt, b10); LD(f1, bBt, bAt); LD(f2, bAt, bBt); RS_Z(acc); RS_Z(acc2); mcf(tacc, f0); mcf(acc, f1); mcf(acc2, f2); ST(0, tacc, bKt); ST(0, acc, b8); ST(0, acc2, b9); }
          __syncthreads();
          { Fr f0, f1, f2; LD(f0, b9, bKt); LD(f1, b9, b8); LD(f2, b8, b9); RS_Z(acc); RS_Z(acc2); mcf(tacc, f0); mcf(acc, f1); mcf(acc2, f2); ST(0, tacc, b10); ST(0, acc, bAt); ST(0, acc2, bBt); }
          __syncthreads();
          { Fr f0, f1, f2; LD(f0, bBt, b10); LD(f1, bBt, bAt); LD(f2, bAt, bBt); RS_Z(acc); RS_Z(acc2); mcf(tacc, f0); mcf(acc, f1); mcf(acc2, f2); ST(0, tacc, bKt); ST(0, acc, b8); ST(0, acc2, b9); }
          __syncthreads();
          { Fr f0, f1; LD(f0, b9, bKt); LD(f1, b8, b9); RS_Z(acc); mcf(tacc, f0); mcf(acc, f1); ST(0, tacc, b10); ST(0, acc, bBt); }
          __syncthreads();
          { Fr f0; LD(f0, bBt, b10); mcf(tacc, f0); ST(0, tacc, bKt); }
          __syncthreads(); SEG(4);
          { Fr f0, f1; LD(f0, bKt, bAtT); LD(f1, bAak, bVT); RS_Z(acc); RS_Z(acc2); mcf(acc, f0); mcf(acc2, f1); ST(0, acc, bAt); ST(0, acc2, b8); }
          __syncthreads();
          { Fr f0; LD(f0, bKt, b8); RS_Z(acc); mcf(acc, f0); ST(0, acc, b9); }
          __syncthreads();
          { Fr f0, f1, f2; LD(f0, bAt, bArb); LD(f1, b9, bArb); LD(f2, bVT, bArk);
            u32x2 rq[2];
#pragma unroll
            for (int tb = 0; tb < 2; ++tb) { const int bb_ = 32 * tbh + 16 * tb + fr, a0 = 16 * ta + 4 * fq; rq[tb] = *(const LAS u32x2*)(lds + bRt + t64(bb_, a0 >> 3) + (a0 & 4) * 2); }
            RS_Z(acc); mcf(acc, f0);
#pragma unroll
            for (int tb = 0; tb < 2; ++tb) { acc[tb][0] += bflo(rq[tb].x); acc[tb][1] += bfhi(rq[tb].x); acc[tb][2] += bflo(rq[tb].y); acc[tb][3] += bfhi(rq[tb].y); }
            pk_acc(dq[0], acc);
            RS_Z(acc2); mcf(acc2, f1); mcf(acc2, f2); pk_acc(dq[1], acc2); }
          { Fr f3, f4, f5; LD(f3, bAt, bBhT); LD(f4, bBhT, b9); LD(f5, bKhT, bVT);
            RS_Z(acc3); mcf(acc3, f3);
            { const float pc = __expf(ltot);
#pragma unroll
              for (int tb = 0; tb < 2; ++tb) { const int bb_ = 32 * tbh + 16 * tb + fr; const float pcb = __shfl(pc, bb_);
#pragma unroll
                  for (int i = 0; i < 4; ++i) { const int a = 16 * ta + 4 * fq + i; if (a == bb_) acc3[tb][i] += pcb; } } }
            pk_acc(dq[2], acc3);
            RS_Z(acc4); mcf(acc4, f4); mcf(acc4, f5); dqn[0] = acc4[0]; dqn[1] = acc4[1]; dso = so; dpend = true; }
#undef LD
#undef ST
#undef RS_Z
          __syncthreads(); SEG(5);
        }
    }
#undef PF_ISSUE
    if (dpend) { st_pk<false>(dq[0], aLW + dso, ta, tbh, fr, fq); st_pk<false>(dq[1], aKK + dso, ta, tbh, fr, fq); st_pk<true>(dq[2], aKP + dso, ta, tbh, fr, fq); st_f32(dqn, aNT + dso, ta, tbh, fr, fq); }
#ifdef PROBE_SEG
    if (blockIdx.x == 0 && threadIdx.x == 0) { unsigned long long* st = (unsigned long long*)(F.ws + WS_CTL + 65536); st[40] = 0; st[41] = sg_[PROBE_SEG]; }
#endif
}

__device__ __forceinline__ void scan_seq(Frame& F, int bh) {
    LAS unsigned char* lds = F.lds + RING_OFF;
    const int lane = F.lane, w = F.wave, r32 = lane & 31, hi = lane >> 5;
    const bf16* aM = (const bf16*)(F.dout + DO_KP); const float* aN = (const float*)(F.ws + WS_NT); bf16* XS = (bf16*)(F.ws + WS_YRAW);
    bf16x8 am[2][2][2]; f32x16 ci[2][2];
#define SQ_LOAD(cc) do { const size_t so_ = ((size_t)bh * NCHUNK + (cc)) * 4096; \
        _Pragma("unroll") for (int t1 = 0; t1 < 2; ++t1) _Pragma("unroll") for (int t2 = 0; t2 < 2; ++t2) _Pragma("unroll") for (int s = 0; s < 2; ++s) \
            am[t1][t2][s] = *(const GAS bf16x8*)((const char*)(aM + so_) + (((t1 * 2 + t2) * 2 + s) * 1024) + lane * 16); \
        _Pragma("unroll") for (int tk = 0; tk < 2; ++tk) _Pragma("unroll") for (int tv = 0; tv < 2; ++tv) _Pragma("unroll") for (int g = 0; g < 4; ++g) { \
            const f32x4 q_ = *(const GAS f32x4*)((const char*)(aN + so_) + (((tk * 2 + tv) * 4 + g) * 1024) + lane * 16); ci[tk][tv][4 * g + 0] = q_[0]; ci[tk][tv][4 * g + 1] = q_[1]; ci[tk][tv][4 * g + 2] = q_[2]; ci[tk][tv][4 * g + 3] = q_[3]; } } while (0)
    SQ_LOAD(w);
    for (int i = F.tid; i < 8192 / 16; i += 512) *(LAS u32x4*)(lds + i * 16) = (u32x4){0u, 0u, 0u, 0u};
    for (int c = 0; c < NCHUNK; ++c) {
        const int t = c & 7; const int rb = (c & 3) * 8192, wb = ((c + 1) & 3) * 8192;
        __syncthreads();
        if (t == w) {
            bf16x8 xb[2][2][2];
#pragma unroll
            for (int tk = 0; tk < 2; ++tk)
#pragma unroll
                for (int tv = 0; tv < 2; ++tv)
#pragma unroll
                    for (int s = 0; s < 2; ++s) xb[tk][tv][s] = *(const LAS bf16x8*)(lds + rb + (((tk * 2 + tv) * 2 + s) * 1024) + lane * 16);
#pragma unroll
            for (int t1 = 0; t1 < 2; ++t1)
#pragma unroll
                for (int tv = 0; tv < 2; ++tv) { f32x16 a = ci[t1][tv];
#pragma unroll
                    for (int t2 = 0; t2 < 2; ++t2)
#pragma unroll
                        for (int s = 0; s < 2; ++s) a = __builtin_amdgcn_mfma_f32_32x32x16_bf16(am[t1][t2][s], xb[t2][tv][s], a, 0, 0, 0);
                    u32x4 f0, f1; f0.x = pkbf(a[0], a[1]); f0.y = pkbf(a[2], a[3]); f0.z = pkbf(a[4], a[5]); f0.w = pkbf(a[6], a[7]); f1.x = pkbf(a[8], a[9]); f1.y = pkbf(a[10], a[11]); f1.z = pkbf(a[12], a[13]); f1.w = pkbf(a[14], a[15]);
                    *(LAS u32x4*)(lds + wb + (((t1 * 2 + tv) * 2 + 0) * 1024) + lane * 16) = f0; *(LAS u32x4*)(lds + wb + (((t1 * 2 + tv) * 2 + 1) * 1024) + lane * 16) = f1; }
        } else if (t == ((w + 1) & 7)) {
            if (c - 1 + 8 < NCHUNK) SQ_LOAD(c - 1 + 8);
        } else if (t == ((w + 4) & 7)) {
            char* xs = (char*)(XS + ((size_t)bh * NCHUNK + c) * 4096);
#pragma unroll
            for (int q = 0; q < 8; ++q) *(GAS u32x4*)(xs + q * 1024 + lane * 16) = *(const LAS u32x4*)(lds + rb + q * 1024 + lane * 16);
        }
    }
    __syncthreads();
#undef SQ_LOAD
}

__device__ __forceinline__ void scan_post(Frame& F) {
    const int lane = F.lane, fr = lane & 15, fq = lane >> 4, tb = F.wave & 3;
    const bf16* aRh = (const bf16*)(F.dout + DO_W); const bf16* aYl = (const bf16*)(F.dout + DO_KKN); const bf16* XS = (const bf16*)(F.ws + WS_YRAW);
    const bf16* Zb = (const bf16*)(F.ws + WS_Z); const float* mu = INP(4); const bf16* aG = (const bf16*)(F.ws + WS_GATE); const float* bon = (const float*)(F.ws + WS_BON);
    bf16* Y = (bf16*)(F.ws + WS_Y); const float* lnw = INP(13); const float* lnb = INP(14);
    for (int u = F.vcu * 2 + (F.wave >> 2); u < BATCH * NH * NCHUNK; u += F.G * 2) {
        const int c = u % NCHUNK, bh = u / NCHUNK, b = bh / NH, h = bh % NH;
        const size_t m0 = (size_t)b * T + (size_t)c * 64, so = (size_t)u * 4096;
        const bf16* xs = XS + (size_t)u * 4096;
        const size_t trow = m0 + 16 * tb + fr;
        bf16x8 bf_[2];
#pragma unroll
        for (int s = 0; s < 2; ++s) bf_[s] = *(const GAS bf16x8*)(aRh + so + (size_t)(16 * tb + fr) * 64 + 32 * s + 8 * fq);
        f32x4 acc[4];
#pragma unroll
        for (int ta = 0; ta < 4; ++ta) { const u32x2 q_ = *(const GAS u32x2*)(aYl + so + (size_t)(16 * tb + fr) * 64 + 16 * ta + 4 * fq);
            acc[ta] = (f32x4){bflo(q_.x), bfhi(q_.x), bflo(q_.y), bfhi(q_.y)};
#pragma unroll
            for (int s = 0; s < 2; ++s) {
                const char* fb = (const char*)xs + (((s * 2 + (ta >> 1)) * 2 + (fq >> 1)) * 1024) + (16 * (ta & 1) + fr) * 16 + (fq & 1) * 8;
                const u32x2 l8 = *(const GAS u32x2*)(fb), h8 = *(const GAS u32x2*)(fb + 512); u32x4 a4; a4.x = l8.x; a4.y = l8.y; a4.z = h8.x; a4.w = h8.y;
                acc[ta] = __builtin_amdgcn_mfma_f32_16x16x32_bf16(__builtin_bit_cast(bf16x8, a4), bf_[s], acc[ta], 0, 0, 0); } }
        float s1 = 0.f;
#pragma unroll
        for (int ta = 0; ta < 4; ++ta) s1 += (acc[ta][0] + acc[ta][1]) + (acc[ta][2] + acc[ta][3]);
        s1 += __shfl_xor(s1, 16); s1 += __shfl_xor(s1, 32); const float mean = s1 * (1.f / 64.f); float s2 = 0.f;
#pragma unroll
        for (int ta = 0; ta < 4; ++ta)
#pragma unroll
            for (int i = 0; i < 4; ++i) { const float d_ = acc[ta][i] - mean; acc[ta][i] = d_; s2 += d_ * d_; }
        s2 += __shfl_xor(s2, 16); s2 += __shfl_xor(s2, 32); const float rstd = 1.f / sqrtf(s2 * (1.f / 64.f) + GN_EPS);
        const float bn = bon[trow * NH + h];
#pragma unroll
        for (int ta = 0; ta < 4; ++ta) { const int ch = h * HD + 16 * ta + 4 * fq; const f32x4 lw4 = *(const GAS f32x4*)(lnw + ch), lb4 = *(const GAS f32x4*)(lnb + ch);
            const u32x2 vc = *(const GAS u32x2*)(Zb + trow * NIN + ZV_R + ch), gq = *(const GAS u32x2*)(aG + trow * RW + ch); u32x2 vp; vp.x = 0u; vp.y = 0u;
            if ((trow % T) != 0) vp = *(const GAS u32x2*)(Zb + (trow - 1) * NIN + ZV_R + ch);
            const f32x4 mv = *(const GAS f32x4*)(mu + ZV_R + ch);
            const float v0 = bflo(vc.x) + (bflo(vp.x) - bflo(vc.x)) * mv[0], v1 = bfhi(vc.x) + (bfhi(vp.x) - bfhi(vc.x)) * mv[1], v2 = bflo(vc.y) + (bflo(vp.y) - bflo(vc.y)) * mv[2], v3 = bfhi(vc.y) + (bfhi(vp.y) - bfhi(vc.y)) * mv[3];
            const float o0 = (acc[ta][0] * rstd * lw4[0] + lb4[0] + bn * v0) * bflo(gq.x), o1 = (acc[ta][1] * rstd * lw4[1] + lb4[1] + bn * v1) * bfhi(gq.x);
            const float o2 = (acc[ta][2] * rstd * lw4[2] + lb4[2] + bn * v2) * bflo(gq.y), o3 = (acc[ta][3] * rstd * lw4[3] + lb4[3] + bn * v3) * bfhi(gq.y);
            u32x2 w_; w_.x = pkbf(o0, o1); w_.y = pkbf(o2, o3); *(GAS u32x2*)(Y + trow * D + ch) = w_; }
    }
}
}
using pg8::Unit;
constexpr size_t TILE_B = 256 * 2;
struct SchedBase { int G, c; };
struct SchedZ : SchedBase {
    __device__ __forceinline__ bool next(int i, Unit& u) const {
        const int L = i * G + c; constexpr int NZ = (M / 256) * (NIN / 256), NKV = (MEMR / 256) * (2 * D / 256);
        if (L < NZ) { pg8::tile_map(L, M / 256, NIN / 256, u.pm, u.pn); u.z = 0; u.a_off = WS_XN + (size_t)u.pm * 256 * D * 2; u.b_off = WS_WIN_T + (size_t)u.pn * 256 * D * 2; return true; }
        if (L < NZ + NKV) { const int l = L - NZ; u.pm = l / 8; u.pn = l % 8; u.z = 1; u.a_off = WS_MEMN + (size_t)u.pm * 256 * D * 2; u.b_off = WS_WXKV_T + (size_t)u.pn * 256 * D * 2; return true; }
        return false;
    }
};
struct SchedG : SchedBase {
    __device__ __forceinline__ bool next(int i, Unit& u) const {
        const int L = i * G + c; if (L >= 64) return false;
        u.z = L >> 4; u.pm = (L >> 2) & 3; u.pn = L & 3; u.a_off = WS_KV + ((size_t)u.pm * 256 * 2048 + u.z * 256) * 2; u.b_off = WS_WQ_S + ((size_t)u.pn * 256 * 1024 + u.z * 256) * 2; return true;
    }
};
struct SchedVW : SchedBase {
    __device__ __forceinline__ bool next(int i, Unit& u) const {
        const int L = i * G + (G - 1 - c); if (L >= 64) return false;
        u.z = L >> 2; u.pm = L & 3; u.pn = 0; const int b = u.z >> 2, h = u.z & 3;
        u.a_off = WS_WO_T + ((size_t)u.pm * 256 * 1024 + h * 256) * 2; u.b_off = WS_KV + ((size_t)b * 256 * 2048 + 1024 + h * 256) * 2; return true;
    }
};
struct SchedMN : SchedBase {
    int nN; size_t a_base, b_base; int lda, ldb, bsel;
    __device__ __forceinline__ bool next(int i, Unit& u) const {
        const int L = i * G + c; if (L >= (M / 256) * nN) return false;
        pg8::tile_map(L, M / 256, nN, u.pm, u.pn); u.z = 0;
        u.a_off = a_base + (size_t)u.pm * 256 * lda * 2; u.b_off = b_base + ((size_t)u.pn * 256 + (bsel ? (size_t)(u.pm >> 5) * 1024 : 0)) * ldb * 2; return true;
    }
};

constexpr int CW_MQ = 8192;
__device__ __forceinline__ void moba_attn_phase(Frame& F, int bx) {
    const bf16* Z = (const bf16*)(F.ws + WS_Z); bf16* Y = (bf16*)(F.ws + WS_Y) + RW; const float* KM = (const float*)(F.ws + WS_KMEAN);
    const bool perx = (F.G % 8 == 0); const int x = perx ? (bx & 7) : 0; const int nun = perx ? 128 : 1024;
    unsigned* qc = (unsigned*)(F.ctl + CW_MQ + 64 * x);
    volatile LAS unsigned* slot = F.MISC + 16;
    for (int it = 0;; ++it) {
        if (F.tid == 0) slot[it & 1] = __hip_atomic_fetch_add(qc, 1u, __ATOMIC_RELAXED, __HIP_MEMORY_SCOPE_AGENT);
        asm volatile("s_waitcnt vmcnt(0) lgkmcnt(0)" ::: "memory"); __builtin_amdgcn_s_barrier(); asm volatile("" ::: "memory");
        const int idx = __builtin_amdgcn_readfirstlane((int)slot[it & 1]);
        if (idx >= nun) break;
        const int bh = perx ? x * 4 + (idx & 3) : (idx & 31), qb = perx ? 31 - (idx >> 2) : 31 - (idx >> 5);
        int ln = F.lane; asm volatile("" : "+v"(ln)); ln &= 63;
        attn_body::attn_unit<8>(bh / NH, bh % NH, qb, Z + ZQ, Z + ZK, Z + ZV, Y, KM + (size_t)bh * NBLK * HD, (char*)F.lds + RING_OFF, F.wave, ln);
    }
}

#ifndef MK_N_LAUNCHES
#define MK_N_LAUNCHES 1
#endif
constexpr int PER_PHASE = 12;
constexpr int N_LAUNCHES = MK_N_LAUNCHES;
constexpr int SCAN_WGS = 64;
struct Args { const float* in[25]; float* out; unsigned char* ws; int ph_lo, ph_hi, li, pad; };
__global__ void __launch_bounds__(NWAVES * 64, 2) skel_fwd(Args args) {
    extern __shared__ __attribute__((aligned(16))) unsigned char lds[];
    Frame F;
    F.lds = (LAS unsigned char*)lds;
    F.MISC = (volatile LAS unsigned*)(F.lds + MISC_OFF);
    F.tid = threadIdx.x; F.lane = F.tid & 63; F.wave = __builtin_amdgcn_readfirstlane(F.tid >> 6) & 7;
    F.G = gridDim.x; { const int bx = blockIdx.x; F.vcu = (F.G % 8 == 0) ? (bx % 8) * (F.G / 8) + bx / 8 : bx; }
    F.ws = args.ws; F.dout = (unsigned char*)args.out;
#pragma unroll
    for (int i = 0; i < 25; ++i) F.in[i] = args.in[i];
    F.ctl = (gu32*)(F.ws + WS_CTL);
    for (int u = F.tid; u < (EPI_LDS_OFF - LDSCTL_OFF) / 4; u += NWAVES * 64) ((LAS unsigned*)(F.lds + LDSCTL_OFF))[u] = 0u;
    __syncthreads();
    XcdBarrier bar; bar.bar = (unsigned*)(F.ctl + CW_BAR); bar.x = 0; bar.st = nullptr;
    if (N_LAUNCHES == 1) bar = xcd_barrier_post((unsigned*)(F.ctl + CW_BAR), F.MISC + 8);
#ifdef PROBE_PHASE
    unsigned long long* stamps = (unsigned long long*)(F.ws + WS_CTL + 65536); int nst = 0;
#define STAMP() do { if (blockIdx.x == 0 && threadIdx.x == 0) stamps[nst] = __builtin_amdgcn_s_memrealtime(); ++nst; } while (0)
#else
#define STAMP() do {} while (0)
#endif
#define GRID_BAR() do { if (N_LAUNCHES == 1) xcd_barrier(bar); STAMP(); } while (0)
    const int lo = args.ph_lo, hi = args.ph_hi;
#ifndef PHASE_MASK
#define PHASE_MASK 0xFFFF
#endif
#define IN(k) (((PHASE_MASK >> (k)) & 1) && lo <= (k) && (k) < hi)
#define BOTH(k) (IN(k) && IN((k) + 1))
#define FRESH() do { int l_; asm volatile("v_mbcnt_lo_u32_b32 %0, -1, 0\n\tv_mbcnt_hi_u32_b32 %0, -1, %0" : "=v"(l_)); F.lane = l_ & 63; F.tid = F.wave * 64 + F.lane; } while (0)
    const char* wsc = (const char*)F.ws;
    const int bx = (int)blockIdx.x;

    STAMP();
    if (IN(0)) { FRESH(); if (blockIdx.x == 0 && F.tid == 0) { _Pragma("unroll") for (int i = 0; i < 25; ++i) ((GAS unsigned long long*)(F.ws + WS_TAB))[i] = (unsigned long long)F.in[i]; }
        p0_prologue(F); if (BOTH(0)) GRID_BAR(); }
    if (IN(1)) {
        pg8::Gemm g{wsc, wsc, D, D, D}; SchedZ S; S.G = F.G; S.c = bx;
        pg8::EpiStoreBf16 E{(bf16*)(F.ws + WS_Z), NIN, (bf16*)(F.ws + WS_KV), 2 * D, ZQ / 256, attn_body::C2, (float*)(F.ws + WS_KMEAN), 0};
        pg8::gemm_phase<pg8::EpiStoreBf16, SchedZ, true>(F.lds + RING_OFF, g, S, E, F.wave);
        if (BOTH(1)) GRID_BAR();
    }
    if (IN(3)) { FRESH(); rscan::scan_pre(F); if (BOTH(3)) GRID_BAR(); }
    if (IN(4)) {
        { pg8::Gemm g{wsc, wsc, 2 * D, D, 256}; SchedG S; S.G = F.G; S.c = bx;
          pg8::EpiStoreBf16 E{(bf16*)(F.ws + WS_GT), D, nullptr, 0, 0, 1.f, nullptr, 1};
          pg8::gemm_phase<pg8::EpiStoreBf16, SchedG, true>(F.lds + RING_OFF, g, S, E, F.wave); }
        { pg8::Gemm g{wsc, wsc, D, 2 * D, 256}; SchedVW S; S.G = F.G; S.c = bx;
          pg8::EpiStoreBf16 E{(bf16*)(F.ws + WS_VWT), D, nullptr, 0, 0, 1.f, nullptr, 2};
          pg8::gemm_phase<pg8::EpiStoreBf16, SchedVW, true>(F.lds + RING_OFF, g, S, E, F.wave); }
        FRESH();
#ifdef PROBE_SEQ
        { unsigned long long t0_ = __builtin_amdgcn_s_memrealtime();
          if (bx < BATCH * NH) rscan::scan_seq(F, bx);
          if (blockIdx.x == 0 && threadIdx.x == 0) { unsigned long long* st = (unsigned long long*)(F.ws + WS_CTL + 65536); st[41] = __builtin_amdgcn_s_memrealtime() - t0_; } }
#else
        if (bx < BATCH * NH) rscan::scan_seq(F, bx);
#endif
        moba_attn_phase(F, bx);
        if (BOTH(4)) GRID_BAR();
    }
    if (IN(5)) { FRESH(); rscan::scan_post(F); if (BOTH(5)) GRID_BAR(); }
    if (IN(6)) {
        pg8::Gemm g{wsc, wsc, D, D, D}; SchedMN S; S.G = F.G; S.c = bx; S.nN = D / 256; S.a_base = WS_Y; S.b_base = WS_WMIX_T; S.lda = D; S.ldb = D; S.bsel = 0;
        pg8::EpiRes<false, false> E{INP(0), nullptr, nullptr, (bf16*)(F.ws + WS_HB), (float*)(F.ws + WS_SS), D};
        pg8::gemm_phase<pg8::EpiRes<false, false>, SchedMN, true>(F.lds + RING_OFF, g, S, E, F.wave);
        if (BOTH(6)) GRID_BAR();
    }
    if (IN(7)) {
        pg8::Gemm g{wsc, wsc, D, D, D}; SchedMN S; S.G = F.G; S.c = bx; S.nN = D / 256; S.a_base = WS_HB; S.b_base = WS_GT; S.lda = D; S.ldb = D; S.bsel = 1;
        pg8::EpiSoftmax E{(bf16*)(F.ws + WS_P), D, (const float*)(F.ws + WS_SS), (PG8_LAS pg8::f32x2*)(F.lds + EPI_LDS_OFF)};
        pg8::gemm_phase<pg8::EpiSoftmax, SchedMN, true>(F.lds + RING_OFF, g, S, E, F.wave);
        if (BOTH(7)) GRID_BAR();
    }
    if (IN(8)) {
        pg8::Gemm g{wsc, wsc, D, D, D}; SchedMN S; S.G = F.G; S.c = bx; S.nN = D / 256; S.a_base = WS_P; S.b_base = WS_VWT; S.lda = D; S.ldb = D; S.bsel = 1;
        pg8::EpiRes<true, false> E{nullptr, (const bf16*)(F.ws + WS_HB), nullptr, (bf16*)(F.ws + WS_HB), (float*)(F.ws + WS_SS) + (size_t)M * 16, D};
        pg8::gemm_phase<pg8::EpiRes<true, false>, SchedMN, true>(F.lds + RING_OFF, g, S, E, F.wave);
        if (BOTH(8)) GRID_BAR();
    }
    if (IN(9)) {
        pg8::Gemm g{wsc, wsc, D, D, D}; SchedMN S; S.G = F.G; S.c = bx; S.nN = FF / 256; S.a_base = WS_HB; S.b_base = WS_W1_T; S.lda = D; S.ldb = D; S.bsel = 0;
        pg8::EpiSqRelu E{(bf16*)(F.ws + WS_AH), FF, (const float*)(F.ws + WS_SS) + (size_t)M * 16};
        pg8::gemm_phase<pg8::EpiSqRelu, SchedMN, true>(F.lds + RING_OFF, g, S, E, F.wave);
        if (BOTH(9)) GRID_BAR();
    }
    if (IN(10)) {
        pg8::Gemm g{wsc, wsc, FF, FF, FF}; SchedMN S; S.G = F.G; S.c = bx; S.nN = D / 256; S.a_base = WS_AH; S.b_base = WS_W2_T; S.lda = FF; S.ldb = FF; S.bsel = 0;
        pg8::EpiRes<true, false> E{nullptr, (const bf16*)(F.ws + WS_HB), nullptr, (bf16*)(F.ws + WS_HB), (float*)(F.ws + WS_SS) + (size_t)2 * M * 16, D};
        pg8::gemm_phase<pg8::EpiRes<true, false>, SchedMN, true>(F.lds + RING_OFF, g, S, E, F.wave);
        if (BOTH(10)) GRID_BAR();
    }
    if (IN(11)) { FRESH();
#ifdef PROBE_PHASE
        float pscale; { const unsigned long long* st = (const unsigned long long*)(F.ws + WS_CTL + 65536);
#if defined(PROBE_SEG) || defined(PROBE_SEQ)
          pscale = 1.f + (float)(st[41]) * 1e-6f; }
#else
          pscale = 1.f + (float)(st[PROBE_PHASE + 1] - st[PROBE_PHASE]) * 1e-6f; }
#endif
        final_norm(F, pscale);
#else
        final_norm(F, 1.f);
#endif
    }
#undef IN
#undef BOTH
}

extern "C" void kernel_launch(void* const* d_in, const int* in_sizes, int n_in, void* d_out, int out_size, void* d_ws, size_t ws_size, hipStream_t stream) {
    static int grid = 0;
    if (grid == 0) {
        if (n_in != 25 || in_sizes[0] != M * D || out_size != M * D || ws_size < WS_END) { fprintf(stderr, "kernel_launch: unexpected problem (n_in %d, in0 %d, out %d, ws %zu); nothing launched\n", n_in, n_in > 0 ? in_sizes[0] : -1, out_size, ws_size); grid = -1; return; }
        int dev = 0, cus = 0, per_cu = 0;
        if (hipGetDevice(&dev) != hipSuccess || hipDeviceGetAttribute(&cus, hipDeviceAttributeMultiprocessorCount, dev) != hipSuccess) { grid = -1; return; }
        if (hipFuncSetAttribute((const void*)skel_fwd, hipFuncAttributeMaxDynamicSharedMemorySize, LDS_BYTES) != hipSuccess) { fprintf(stderr, "kernel_launch: hipFuncSetAttribute failed\n"); grid = -1; return; }
        if (hipOccupancyMaxActiveBlocksPerMultiprocessor(&per_cu, (const void*)skel_fwd, NWAVES * 64, LDS_BYTES) != hipSuccess || per_cu < 1)
            fprintf(stderr, "kernel_launch: note: occupancy query reports %d workgroups per CU\n", per_cu);
        (void)hipGetLastError();
        grid = cus;
    }
    if (grid < 0) return;
    if (hipMemsetAsync((char*)d_ws + WS_CTL, 0, CTL_ZERO_BYTES, stream) != hipSuccess) { fprintf(stderr, "kernel_launch: hipMemsetAsync failed\n"); return; }
    Args a{};
    for (int i = 0; i < 25; ++i) a.in[i] = (const float*)d_in[i];
    a.out = (float*)d_out; a.ws = (unsigned char*)d_ws;
    for (int li = 0; li < N_LAUNCHES; ++li) {
        a.ph_lo = (N_LAUNCHES == PER_PHASE) ? li : 0; a.ph_hi = (N_LAUNCHES == PER_PHASE) ? li + 1 : PER_PHASE; a.li = li;
        hipLaunchKernelGGL(skel_fwd, dim3(grid), dim3(NWAVES * 64), LDS_BYTES, stream, a);
        const hipError_t le = hipPeekAtLastError();
        if (le != hipSuccess) { fprintf(stderr, "kernel_launch: launch %d failed: %s\n", li, hipGetErrorName(le)); break; }
    }
}
```
